# Optimizing an MI355X kernel written in HIP

```python
import jax
import jax.numpy as jnp
from jax import lax
import numpy as np

D_MODEL = 1024
BATCH = 4
SEQ = 8192
DEPTH = 1

DN_HEADS = 4
DN_HEAD_DIM = 128
DN_WIDTH = DN_HEADS * DN_HEAD_DIM
CONV_WIDTH = 4
CHUNK = 64
SWA_Q_HEADS = 8
SWA_KV_HEADS = 2
SWA_HEAD_DIM = 64
SWA_GROUP = SWA_Q_HEADS // SWA_KV_HEADS
SWA_WIDTH = SWA_Q_HEADS * SWA_HEAD_DIM
SWA_KV_WIDTH = SWA_KV_HEADS * SWA_HEAD_DIM
WINDOW = 128
ROPE_THETA = 500000.0
ROPE_DIM = SWA_HEAD_DIM // 4
N_BRANCH = 2
BRANCH_WIDTH = DN_WIDTH
DEEPNORM_ALPHA = (2.0 * DEPTH) ** 0.25
DEEPNORM_BETA = (8.0 * DEPTH) ** -0.25
LN_EPS = 1e-5
NORM_EPS = 1e-6

IN_SIZES = (DN_WIDTH, DN_WIDTH, DN_WIDTH,
            DN_WIDTH,
            DN_HEADS, DN_HEADS,
            SWA_WIDTH, SWA_KV_WIDTH, SWA_KV_WIDTH,
            SWA_WIDTH,
            D_MODEL, D_MODEL)
IN_COLS = sum(IN_SIZES)
IN_OFFSETS = tuple(int(o) for o in np.cumsum(IN_SIZES)[:-1])

kernel_name = "hybrid_gdn_swa_sink_deepnorm"


def causal_short_conv(x, w):
    return lax.conv_general_dilated(
        x, w[:, None, :].astype(x.dtype), window_strides=(1,),
        padding=[(CONV_WIDTH - 1, 0)], dimension_numbers=("NWC", "WIO", "NWC"),
        feature_group_count=x.shape[-1])


def l2norm(t):
    t = t.astype(jnp.float32)
    return t * lax.rsqrt(jnp.sum(t * t, axis=-1, keepdims=True) + NORM_EPS)


def chunked_gated_delta_rule(q, k, v, g, beta):
    b, s, h, dk = q.shape
    dv = v.shape[-1]
    n = s // CHUNK

    def chunks(t):
        return t.reshape(b, n, CHUNK, h, -1).transpose(0, 1, 3, 2, 4)

    q, k, v = chunks(q), chunks(k), chunks(v)
    g = g.reshape(b, n, CHUNK, h).transpose(0, 1, 3, 2)
    beta = beta.reshape(b, n, CHUNK, h).transpose(0, 1, 3, 2)
    g = jnp.cumsum(g, axis=-1)

    pos = jnp.arange(CHUNK)
    causal = pos[:, None] >= pos[None, :]
    strict = pos[:, None] > pos[None, :]
    decay = jnp.where(causal, jnp.exp(jnp.where(causal, g[..., :, None] - g[..., None, :], 0.0)), 0.0)

    k_beta = k * beta[..., None]
    lower = jnp.where(strict, jnp.einsum("bnhid,bnhjd->bnhij", k_beta, k) * decay, 0.0)
    eye = jnp.eye(CHUNK, dtype=jnp.float32)
    t_inv = lax.linalg.triangular_solve(eye + lower, jnp.broadcast_to(eye, lower.shape),
                                        left_side=True, lower=True, unit_diagonal=True)
    u = jnp.einsum("bnhij,bnhjd->bnhid", t_inv, v * beta[..., None])
    w = jnp.einsum("bnhij,bnhjd->bnhid", t_inv, k_beta * jnp.exp(g)[..., None])
    intra = jnp.where(causal, jnp.einsum("bnhid,bnhjd->bnhij", q, k) * decay, 0.0)
    q_decayed = q * jnp.exp(g)[..., None]
    g_last = g[..., -1]
    k_tail = k * jnp.exp(g_last[..., None] - g)[..., None]

    def step(state, xs):
        qd_i, a_i, u_i, w_i, kt_i, gl_i = xs
        v_new = u_i - jnp.einsum("bhcd,bhde->bhce", w_i, state)
        o_i = jnp.einsum("bhcd,bhde->bhce", qd_i, state) + jnp.einsum("bhij,bhje->bhie", a_i, v_new)
        state = state * jnp.exp(gl_i)[..., None, None] + jnp.einsum("bhcd,bhce->bhde", kt_i, v_new)
        return state, o_i

    xs = tuple(jnp.moveaxis(t, 1, 0) for t in (q_decayed, intra, u, w, k_tail, g_last))
    _, out = lax.scan(step, jnp.zeros((b, h, dk, dv), jnp.float32), xs)
    return out.transpose(1, 0, 3, 2, 4).reshape(b, s, h, dv)


def rope_tables(seq):
    inv_freq = ROPE_THETA ** (-jnp.arange(0, ROPE_DIM, 2, dtype=jnp.float32) / ROPE_DIM)
    ang = jnp.arange(seq, dtype=jnp.float32)[:, None] * inv_freq[None, :]
    return jnp.cos(ang), jnp.sin(ang)


def partial_rope(t, cos, sin):
    half = ROPE_DIM // 2
    c = cos[None, :, None, :].astype(t.dtype)
    s = sin[None, :, None, :].astype(t.dtype)
    t1 = t[..., :half]
    t2 = t[..., half:ROPE_DIM]
    return jnp.concatenate([t1 * c - t2 * s, t2 * c + t1 * s, t[..., ROPE_DIM:]], axis=-1)


def banded_sink_attention(q, k, v, sinks):
    b, s, _, d = q.shape
    nb = s // WINDOW
    qb = q.reshape(b, nb, WINDOW, SWA_KV_HEADS, SWA_GROUP, d)

    def band(t):
        tb = t.reshape(b, nb, WINDOW, SWA_KV_HEADS, d)
        prev = jnp.pad(tb, ((0, 0), (1, 0), (0, 0), (0, 0), (0, 0)))[:, :-1]
        return jnp.concatenate([prev, tb], axis=2)

    kb, vb = band(k), band(v)
    scores = jnp.einsum("bnqhgd,bnkhd->bnhgqk", qb, kb).astype(jnp.float32) * (d ** -0.5)
    qpos = jnp.arange(WINDOW)[:, None] + WINDOW
    kpos = jnp.arange(2 * WINDOW)[None, :]
    dist = qpos - kpos
    in_band = (dist >= 0) & (dist < WINDOW)
    blk = jnp.arange(nb)[:, None, None]
    valid = in_band[None] & ((blk > 0) | (kpos >= WINDOW)[None])
    scores = jnp.where(valid[None, :, None, None], scores, -jnp.inf)
    sink = sinks.astype(jnp.float32).reshape(SWA_KV_HEADS, SWA_GROUP)[None, None, :, :, None, None]
    m = jnp.maximum(jnp.max(scores, axis=-1, keepdims=True), sink)
    p = jnp.exp(scores - m)
    probs = p / (jnp.sum(p, axis=-1, keepdims=True) + jnp.exp(sink - m))
    out = jnp.einsum("bnhgqk,bnkhd->bnqhgd", probs.astype(v.dtype), vb)
    return out.reshape(b, s, SWA_Q_HEADS * d)


def hybrid_layer(x, w_in, conv_w, a_log, dt_bias, dn_norm_w, sinks, w_branch, w_out, ln_g, ln_b, cos, sin):
    b, s, _ = x.shape
    h = jnp.einsum("bsd,dc->bsc", x, w_in)
    (_, _, _, dn_z, dn_b, dn_a, sw_q, sw_k, sw_v, sw_z, gate_a, gate_b) = jnp.split(h, IN_OFFSETS, axis=-1)

    qkv = jax.nn.silu(causal_short_conv(h[..., :3 * DN_WIDTH], conv_w))
    dq, dk, dv = jnp.split(qkv, 3, axis=-1)
    q_a = l2norm(dq.reshape(b, s, DN_HEADS, DN_HEAD_DIM)) * (DN_HEAD_DIM ** -0.5)
    k_a = l2norm(dk.reshape(b, s, DN_HEADS, DN_HEAD_DIM))
    v_a = dv.reshape(b, s, DN_HEADS, DN_HEAD_DIM).astype(jnp.float32)
    beta = jax.nn.sigmoid(dn_b.astype(jnp.float32))
    g = -jnp.exp(a_log.astype(jnp.float32)) * jax.nn.softplus(dn_a.astype(jnp.float32) + dt_bias.astype(jnp.float32))
    o_a = chunked_gated_delta_rule(q_a, k_a, v_a, g, beta)
    o_a = o_a * lax.rsqrt(jnp.mean(o_a * o_a, axis=-1, keepdims=True) + NORM_EPS) * dn_norm_w.astype(jnp.float32)
    y_a = (o_a.astype(x.dtype) * jax.nn.silu(dn_z.reshape(b, s, DN_HEADS, DN_HEAD_DIM))).reshape(b, s, DN_WIDTH)

    q_b = partial_rope(sw_q.reshape(b, s, SWA_Q_HEADS, SWA_HEAD_DIM), cos, sin)
    k_b = partial_rope(sw_k.reshape(b, s, SWA_KV_HEADS, SWA_HEAD_DIM), cos, sin)
    v_b = sw_v.reshape(b, s, SWA_KV_HEADS, SWA_HEAD_DIM)
    y_b = banded_sink_attention(q_b, k_b, v_b, sinks) * jax.nn.silu(sw_z)

    merged = (jax.nn.sigmoid(gate_a) * jnp.einsum("bsc,cd->bsd", y_a, w_branch[0])
              + jax.nn.sigmoid(gate_b) * jnp.einsum("bsc,cd->bsd", y_b, w_branch[1]))
    out = jnp.einsum("bsd,de->bse", merged, w_out)

    r = (DEEPNORM_ALPHA * x + out).astype(jnp.float32)
    mu = jnp.mean(r, axis=-1, keepdims=True)
    var = jnp.mean(jnp.square(r - mu), axis=-1, keepdims=True)
    y = (r - mu) * lax.rsqrt(var + LN_EPS) * ln_g.astype(jnp.float32) + ln_b.astype(jnp.float32)
    return y.astype(x.dtype)


def setup_inputs(seed: int = 0) -> dict:
    key = jax.random.key(seed)
    ks = jax.random.split(key, 11)
    x = jax.random.normal(ks[0], (BATCH, SEQ, D_MODEL), jnp.float32)
    seg_scale = (1.0, 1.0, DEEPNORM_BETA, 1.0, 1.0, 1.0, 1.0, 1.0, DEEPNORM_BETA, 1.0, 1.0, 1.0)
    col_scale = np.concatenate([np.full((n,), sc, np.float32) for n, sc in zip(IN_SIZES, seg_scale)])
    w_in = (jax.random.normal(ks[1], (DEPTH, D_MODEL, IN_COLS), jnp.float32)
            * (D_MODEL ** -0.5) * jnp.asarray(col_scale, jnp.float32))
    conv_w = jax.random.normal(ks[2], (DEPTH, CONV_WIDTH, 3 * DN_WIDTH), jnp.float32) * (CONV_WIDTH ** -0.5)
    a_log = jnp.log(jax.random.uniform(ks[3], (DEPTH, DN_HEADS), jnp.float32, minval=1.0, maxval=16.0))
    dt = jnp.exp(jax.random.uniform(ks[4], (DEPTH, DN_HEADS), jnp.float32,
                                    minval=float(np.log(1e-3)), maxval=float(np.log(1e-1))))
    dt_bias = dt + jnp.log(-jnp.expm1(-dt))
    dn_norm_w = 1.0 + 0.02 * jax.random.normal(ks[5], (DEPTH, DN_HEAD_DIM), jnp.float32)
    sinks = 0.5 * jax.random.normal(ks[6], (DEPTH, SWA_Q_HEADS), jnp.float32)
    w_branch = (jax.random.normal(ks[7], (DEPTH, N_BRANCH, BRANCH_WIDTH, D_MODEL), jnp.float32)
                * (BRANCH_WIDTH ** -0.5) * DEEPNORM_BETA)
    w_out = jax.random.normal(ks[8], (DEPTH, D_MODEL, D_MODEL), jnp.float32) * (D_MODEL ** -0.5) * DEEPNORM_BETA
    ln_g = 1.0 + 0.02 * jax.random.normal(ks[9], (DEPTH, D_MODEL), jnp.float32)
    ln_b = 0.02 * jax.random.normal(ks[10], (DEPTH, D_MODEL), jnp.float32)
    return {"x": x, "w_in": w_in, "conv_w": conv_w, "a_log": a_log, "dt_bias": dt_bias,
            "dn_norm_w": dn_norm_w, "sinks": sinks, "w_branch": w_branch, "w_out": w_out,
            "ln_g": ln_g, "ln_b": ln_b}


def reference(x, w_in, conv_w, a_log, dt_bias, dn_norm_w, sinks, w_branch, w_out, ln_g, ln_b):
    cos, sin = rope_tables(x.shape[1])
    for layer in range(DEPTH):
        x = hybrid_layer(x, w_in[layer], conv_w[layer], a_log[layer], dt_bias[layer], dn_norm_w[layer],
                         sinks[layer], w_branch[layer], w_out[layer], ln_g[layer], ln_b[layer], cos, sin)
    return x
```

```cpp
#include <hip/hip_runtime.h>
#include <hip/hip_cooperative_groups.h>
#include <cstdio>
#include <cmath>
namespace cg = cooperative_groups;

typedef unsigned short u16;
typedef short bf16x8 __attribute__((ext_vector_type(8)));
typedef float f32x4 __attribute__((ext_vector_type(4)));
typedef unsigned u32x4 __attribute__((ext_vector_type(4)));
typedef unsigned u32x2 __attribute__((ext_vector_type(2)));
#define DI __device__ __forceinline__
DI int opaque_tid_(int wave_s) { int t = (int)__builtin_amdgcn_mbcnt_hi(~0u, __builtin_amdgcn_mbcnt_lo(~0u, 0u)) + (wave_s << 6); asm volatile("" : "+v"(t)); return t; }
#define opaque_tid() opaque_tid_(wvs)

constexpr int T_TOK = 32768, SEQ = 8192, DM = 1024, NC = 5384, NCP = 5504;
constexpr int C_DNZ = 1536, C_SWQ = 2056, C_SWK = 2568, C_SWV = 2696, C_SWZ = 2824, C_GA = 3336, C_GB = 4360;
constexpr size_t OFF_WINT = 0;
constexpr size_t OFF_WAT = OFF_WINT + (size_t)NCP * 1024 * 2;
constexpr size_t OFF_WBT = OFF_WAT + 1024 * 512 * 2;
constexpr size_t OFF_WOT = OFF_WBT + 1024 * 512 * 2;
constexpr size_t OFF_ROPE = OFF_WOT + 1024 * 1024 * 2;
constexpr size_t OFF_HB = OFF_ROPE + 2 * 8192 * 8 * 4;
constexpr size_t OFF_DEC = OFF_HB + (size_t)T_TOK * 8 * 4;
constexpr size_t OFF_H = OFF_DEC + 2048 * 4;
constexpr size_t OFF_SC = OFF_H + (size_t)T_TOK * NC * 2;
constexpr size_t OPB = 73728;
constexpr size_t WS_NEED = OFF_SC + 2048 * OPB;
constexpr int SMEM_BYTES = 73728;

struct Params {
  const float *x, *w_in, *conv_w, *a_log, *dt_bias, *dn_norm_w, *sinks, *w_branch, *w_out, *ln_g, *ln_b;
  float* out; unsigned char* ws;
  float inv_freq[8];
};

typedef __bf16 bf16x2_t __attribute__((ext_vector_type(2)));
typedef float f32x2_t __attribute__((ext_vector_type(2)));
DI unsigned pk_bf16(float lo, float hi) { f32x2_t f = {lo, hi}; bf16x2_t v = __builtin_convertvector(f, bf16x2_t); return __builtin_bit_cast(unsigned, v); }
DI float bf_lo(unsigned u) { return __uint_as_float(u << 16); }
DI float bf_hi(unsigned u) { return __uint_as_float(u & 0xffff0000u); }
DI float bf2f(u16 v) { return __uint_as_float(((unsigned)v) << 16); }
DI u16 f2bf(float f) { return (u16)(pk_bf16(f, f) & 0xffffu); }
DI float silu_f(float y) { return y / (1.0f + __expf(-y)); }
DI float sigmoid_f(float y) { return 1.0f / (1.0f + __expf(-y)); }
DI f32x4 mfma16(bf16x8 a, bf16x8 b, f32x4 c) { return __builtin_amdgcn_mfma_f32_16x16x32_bf16(a, b, c, 0, 0, 0); }
DI bf16x8 as_bf8(u32x4 v) { return __builtin_bit_cast(bf16x8, v); }
DI bf16x8 pack8(f32x4 a, f32x4 b) { u32x4 w; w.x = pk_bf16(a[0], a[1]); w.y = pk_bf16(a[2], a[3]); w.z = pk_bf16(b[0], b[1]); w.w = pk_bf16(b[2], b[3]); return as_bf8(w); }

DI void phase0(const Params& p, int wvs) {
  const size_t gt = (size_t)blockIdx.x * 256 + opaque_tid(), gs = (size_t)gridDim.x * 256;
  {
    u32x4* xb = (u32x4*)(p.ws + OFF_SC);
    const float4* xs = (const float4*)p.x;
    for (size_t i = gt; i < (size_t)T_TOK * DM / 8; i += gs) {
      const float4 a = xs[2 * i], b = xs[2 * i + 1];
      u32x4 w; w.x = pk_bf16(a.x, a.y); w.y = pk_bf16(a.z, a.w); w.z = pk_bf16(b.x, b.y); w.w = pk_bf16(b.z, b.w);
      xb[i] = w;
    }
  }
  {
    u32x4* wt = (u32x4*)(p.ws + OFF_WINT);
    for (size_t i = gt; i < (size_t)NCP * 128; i += gs) {
      const int kc = (int)(i / NCP), n = (int)(i % NCP);
      float v[8];
#pragma unroll
      for (int j = 0; j < 8; ++j) v[j] = (n < NC) ? p.w_in[(size_t)(kc * 8 + j) * NC + n] : 0.f;
      u32x4 w; w.x = pk_bf16(v[0], v[1]); w.y = pk_bf16(v[2], v[3]); w.z = pk_bf16(v[4], v[5]); w.w = pk_bf16(v[6], v[7]);
      wt[(size_t)n * 128 + kc] = w;
    }
  }
  {
    for (size_t i = gt; i < (size_t)2 * 1024 * 64; i += gs) {
      const int br = (int)(i / (1024 * 64)), rem = (int)(i % (1024 * 64)), kc = rem / 1024, n = rem % 1024;
      const float* src = p.w_branch + (size_t)br * 512 * 1024;
      float v[8];
#pragma unroll
      for (int j = 0; j < 8; ++j) v[j] = src[(size_t)(kc * 8 + j) * 1024 + n];
      u32x4 w; w.x = pk_bf16(v[0], v[1]); w.y = pk_bf16(v[2], v[3]); w.z = pk_bf16(v[4], v[5]); w.w = pk_bf16(v[6], v[7]);
      ((u32x4*)(p.ws + (br ? OFF_WBT : OFF_WAT)))[(size_t)n * 64 + kc] = w;
    }
  }
  {
    for (size_t i = gt; i < (size_t)1024 * 128; i += gs) {
      const int kc = (int)(i / 1024), n = (int)(i % 1024);
      float v[8];
#pragma unroll
      for (int j = 0; j < 8; ++j) v[j] = p.w_out[(size_t)(kc * 8 + j) * 1024 + n];
      u32x4 w; w.x = pk_bf16(v[0], v[1]); w.y = pk_bf16(v[2], v[3]); w.z = pk_bf16(v[4], v[5]); w.w = pk_bf16(v[6], v[7]);
      ((u32x4*)(p.ws + OFF_WOT))[(size_t)n * 128 + kc] = w;
    }
  }
  {
    float* rc = (float*)(p.ws + OFF_ROPE); float* rs = rc + 8192 * 8;
    for (size_t i = gt; i < 8192 * 8; i += gs) {
      const int t = (int)(i >> 3), f = (int)(i & 7);
      const float ang = (float)t * p.inv_freq[f];
      const double a = (double)ang;
      const double k = __builtin_rint(a * 0.15915494309189535);
      const float r = (float)(a - k * 6.283185307179586);
      rc[i] = cosf(r); rs[i] = sinf(r);
    }
  }
}

DI int lds_off(int row, int chunk) { return row * 128 + ((chunk ^ (row & 7)) << 4); }

DI void gemm_kloop(const Params& p, int wvs, const u16* __restrict__ A, int lda, const u16* __restrict__ Bt, int ldb, int nk, int m0, int n0,
                   f32x4 (&acc)[4][4], unsigned char* smem) {
  const int tid = opaque_tid(), lane = tid & 63, wv = tid >> 6, wm = wv >> 1, wn = wv & 1, r16 = lane & 15, g = lane >> 4;
  const int lrow = tid >> 3, lc = tid & 7;
  const u16* ap = A + (size_t)(m0 + lrow) * lda + lc * 8;
  const u16* bp = Bt + (size_t)(n0 + lrow) * ldb + lc * 8;
  u32x4 ra[4], rb[4];
#pragma unroll
  for (int i = 0; i < 4; ++i) { ra[i] = *(const u32x4*)(ap + (size_t)(32 * i) * lda); rb[i] = *(const u32x4*)(bp + (size_t)(32 * i) * ldb); }
  __syncthreads();
#pragma unroll
  for (int i = 0; i < 4; ++i) {
    *(u32x4*)(smem + lds_off(lrow + 32 * i, lc)) = ra[i];
    *(u32x4*)(smem + 16384 + lds_off(lrow + 32 * i, lc)) = rb[i];
  }
  __syncthreads();
  for (int kt = 0; kt < nk; ++kt) {
    unsigned char* cur = smem + (kt & 1) * 32768;
    unsigned char* nxt = smem + ((kt + 1) & 1) * 32768;
    const bool more = (kt + 1 < nk);
    if (more) {
#pragma unroll
      for (int i = 0; i < 4; ++i) {
        ra[i] = *(const u32x4*)(ap + (size_t)(32 * i) * lda + (kt + 1) * 64);
        rb[i] = *(const u32x4*)(bp + (size_t)(32 * i) * ldb + (kt + 1) * 64);
      }
    }
#pragma unroll
    for (int ks = 0; ks < 2; ++ks) {
      bf16x8 af[4], bfr[4];
#pragma unroll
      for (int i = 0; i < 4; ++i) {
        af[i] = *(const bf16x8*)(cur + lds_off(wm * 64 + i * 16 + r16, ks * 4 + g));
        bfr[i] = *(const bf16x8*)(cur + 16384 + lds_off(wn * 64 + i * 16 + r16, ks * 4 + g));
      }
#pragma unroll
      for (int mi = 0; mi < 4; ++mi)
#pragma unroll
        for (int ni = 0; ni < 4; ++ni) acc[mi][ni] = mfma16(bfr[ni], af[mi], acc[mi][ni]);
    }
    if (more) {
#pragma unroll
      for (int i = 0; i < 4; ++i) {
        *(u32x4*)(nxt + lds_off(lrow + 32 * i, lc)) = ra[i];
        *(u32x4*)(nxt + 16384 + lds_off(lrow + 32 * i, lc)) = rb[i];
      }
    }
    __syncthreads();
  }
}

DI bool tile_of(int li, int ntn, int xcd, int& mt, int& nt) {
  if (li >= 32 * ntn) return false;
  const int grp = li / (4 * ntn), rem = li % (4 * ntn);
  nt = rem >> 2; mt = 32 * xcd + grp * 4 + (rem & 3);
  return true;
}

DI void zero_acc(f32x4 (&acc)[4][4]) {
#pragma unroll
  for (int i = 0; i < 4; ++i)
#pragma unroll
    for (int j = 0; j < 4; ++j) acc[i][j] = (f32x4){0.f, 0.f, 0.f, 0.f};
}

DI void phase1(const Params& p, int wvs, unsigned char* smem) {
  const int xcd = blockIdx.x & 7, lb = blockIdx.x >> 3, nlb = gridDim.x >> 3;
  const u16* xb = (const u16*)(p.ws + OFF_SC);
  const u16* wint = (const u16*)(p.ws + OFF_WINT);
  u16* h = (u16*)(p.ws + OFF_H);
  float* hb = (float*)(p.ws + OFF_HB);
  const int tid0 = opaque_tid(); const int lane = tid0 & 63, wv = tid0 >> 6, wm = wv >> 1, wn = wv & 1, r16 = lane & 15, g = lane >> 4;
  for (int li = lb;; li += nlb) {
    int mt, nt; if (!tile_of(li, 43, xcd, mt, nt)) break;
    f32x4 acc[4][4]; zero_acc(acc);
    gemm_kloop(p, wvs, xb, 1024, wint, 1024, 16, mt * 128, nt * 128, acc, smem);
#pragma unroll
    for (int mi = 0; mi < 4; ++mi) {
      const int row = mt * 128 + wm * 64 + mi * 16 + r16;
#pragma unroll
      for (int ni = 0; ni < 4; ++ni) {
        const int col = nt * 128 + wn * 64 + ni * 16 + 4 * g;
        if (col < NC) {
          u32x2 w; w.x = pk_bf16(acc[mi][ni][0], acc[mi][ni][1]); w.y = pk_bf16(acc[mi][ni][2], acc[mi][ni][3]);
          *(u32x2*)(h + (size_t)row * NC + col) = w;
          if (col >= 2048 && col < 2056) *(f32x4*)(hb + (size_t)row * 8 + (col - 2048)) = acc[mi][ni];
        }
      }
    }
  }
}

template <int I, int M4> DI void solve_part(const float (&xv)[64], const float* Lrow, float& a) {
  if constexpr (4 * M4 < I) {
    const f32x4 l = *(const f32x4*)(Lrow + 4 * M4);
    if constexpr (4 * M4 + 0 < I) a -= l[0] * xv[4 * M4 + 0];
    if constexpr (4 * M4 + 1 < I) a -= l[1] * xv[4 * M4 + 1];
    if constexpr (4 * M4 + 2 < I) a -= l[2] * xv[4 * M4 + 2];
    if constexpr (4 * M4 + 3 < I) a -= l[3] * xv[4 * M4 + 3];
    solve_part<I, M4 + 1>(xv, Lrow, a);
  }
}
template <int I> DI void solve_rows(float (&xv)[64], const float* Lm) {
  if constexpr (I < 64) {
    float a = xv[I];
    solve_part<I, 0>(xv, Lm + I * 68, a);
    xv[I] = a;
    __builtin_amdgcn_sched_barrier(0);
    solve_rows<I + 1>(xv, Lm);
  }
}

DI void prep_item(const Params& p, int wvs, int item, unsigned char* smem) {
  const int tid_ = opaque_tid();
  const int tid = tid_, lane = tid & 63, wv = tid >> 6, r16 = lane & 15, g = lane >> 4;
  const int hd = item & 3, n = (item >> 2) & 127, b = item >> 9;
  const int t0 = b * SEQ + n * 64;
  u16* Qs = (u16*)smem; u16* Ks = Qs + 64 * 136; u16* Vs = Ks + 64 * 136;
  float* Lm = (float*)(smem + 52224);
  float* sm_beta = (float*)(smem + 69632);
  float* sm_gc = sm_beta + 64; float* sm_rq = sm_gc + 64; float* sm_rk = sm_rq + 64;
  float* sm_fw = sm_rk + 64; float* sm_fq = sm_fw + 64; float* sm_fk = sm_fq + 64;
  const u16* h = (const u16*)(p.ws + OFF_H);
  const float* hb = (const float*)(p.ws + OFF_HB);
  unsigned char* op = p.ws + OFF_SC + (size_t)item * OPB;
  __syncthreads();
  {
    const int c2 = tid & 63, rbase = (tid >> 6) * 16;
#pragma unroll 1
    for (int mat = 0; mat < 3; ++mat) {
      const int col = mat * 512 + hd * 128 + 2 * c2;
      float wa[4], wb[4];
#pragma unroll
      for (int j = 0; j < 4; ++j) { wa[j] = p.conv_w[j * 1536 + col]; wb[j] = p.conv_w[j * 1536 + col + 1]; }
      float xa[3], xb[3];
#pragma unroll
      for (int j = 0; j < 3; ++j) {
        const int pos = n * 64 + rbase - 3 + j;
        unsigned v = 0;
        if (pos >= 0) v = *(const unsigned*)(h + (size_t)(t0 + rbase - 3 + j) * NC + col);
        xa[j] = bf_lo(v); xb[j] = bf_hi(v);
      }
      u16* dst = (mat == 0 ? Qs : (mat == 1 ? Ks : Vs));
#pragma unroll
      for (int i = 0; i < 16; ++i) {
        const unsigned v = *(const unsigned*)(h + (size_t)(t0 + rbase + i) * NC + col);
        const float a3 = bf_lo(v), b3 = bf_hi(v);
        const float ya = wa[0] * xa[0] + wa[1] * xa[1] + wa[2] * xa[2] + wa[3] * a3;
        const float yb = wb[0] * xb[0] + wb[1] * xb[1] + wb[2] * xb[2] + wb[3] * b3;
        xa[0] = xa[1]; xa[1] = xa[2]; xa[2] = a3; xb[0] = xb[1]; xb[1] = xb[2]; xb[2] = b3;
        *(unsigned*)(dst + (rbase + i) * 136 + 2 * c2) = pk_bf16(silu_f(ya), silu_f(yb));
      }
    }
  }
  __syncthreads();
  if (wv == 0) {
    const int row = t0 + lane;
    const float bl = hb[(size_t)row * 8 + hd], al = hb[(size_t)row * 8 + 4 + hd];
    const float xx = al + p.dt_bias[hd];
    const float sp = xx > 20.f ? xx : log1pf(expf(xx));
    float gg = -expf(p.a_log[hd]) * sp;
#pragma unroll
    for (int o = 1; o < 64; o <<= 1) { const float t = __shfl_up(gg, o); if (lane >= o) gg += t; }
    sm_beta[lane] = 1.0f / (1.0f + expf(-bl)); sm_gc[lane] = gg;
  } else if (wv <= 2) {
    const int r = tid - 64;
    const u16* src = (r < 64) ? (Qs + r * 136) : (Ks + (r - 64) * 136);
    float ss = 0.f;
#pragma unroll
    for (int c = 0; c < 16; ++c) {
      const u32x4 v = *(const u32x4*)(src + c * 8);
#pragma unroll
      for (int j = 0; j < 4; ++j) { const float a = bf_lo(v[j]), bb = bf_hi(v[j]); ss += a * a + bb * bb; }
    }
    const float rs = rsqrtf(ss + 1e-6f);
    if (r < 64) sm_rq[r] = rs; else sm_rk[r - 64] = rs;
  }
  __syncthreads();
  if (tid < 64) {
    const float gc = sm_gc[tid], gl = sm_gc[63], eg = expf(gc);
    sm_fw[tid] = sm_beta[tid] * eg * sm_rk[tid];
    sm_fq[tid] = sm_rq[tid] * 0.08838834764831845f * eg;
    sm_fk[tid] = sm_rk[tid] * expf(gl - gc);
    if (tid == 0) ((float*)(p.ws + OFF_DEC))[item] = expf(gl);
  }
  {
    bf16x8 kfi[4], qfi[4];
#pragma unroll
    for (int s = 0; s < 4; ++s) {
      kfi[s] = *(const bf16x8*)(Ks + (16 * wv + r16) * 136 + 32 * s + 8 * g);
      qfi[s] = *(const bf16x8*)(Qs + (16 * wv + r16) * 136 + 32 * s + 8 * g);
    }
    f32x4 at[4];
#pragma unroll
    for (int jt = 0; jt < 4; ++jt) {
      at[jt] = (f32x4){0.f, 0.f, 0.f, 0.f};
      if (jt <= wv) {
        f32x4 la = (f32x4){0.f, 0.f, 0.f, 0.f}, aa = (f32x4){0.f, 0.f, 0.f, 0.f};
#pragma unroll
        for (int s = 0; s < 4; ++s) {
          const bf16x8 kfj = *(const bf16x8*)(Ks + (16 * jt + r16) * 136 + 32 * s + 8 * g);
          la = mfma16(kfi[s], kfj, la);
          aa = mfma16(kfj, qfi[s], aa);
        }
#pragma unroll
        for (int r = 0; r < 4; ++r) {
          { const int i = 16 * wv + 4 * g + r, j = 16 * jt + r16;
            const float v = (i > j) ? sm_beta[i] * sm_rk[i] * sm_rk[j] * __expf(sm_gc[i] - sm_gc[j]) * la[r] : 0.f;
            Lm[i * 68 + j] = v; }
          { const int j = 16 * jt + 4 * g + r, i = 16 * wv + r16;
            at[jt][r] = (j <= i) ? sm_rq[i] * sm_rk[j] * 0.08838834764831845f * __expf(sm_gc[i] - sm_gc[j]) * aa[r] : 0.f; }
        }
      }
    }
#pragma unroll
    for (int s2 = 0; s2 < 2; ++s2)
      *(bf16x8*)(op + 32768 + (size_t)((wv * 2 + s2) * 64 + lane) * 16) = pack8(at[2 * s2], at[2 * s2 + 1]);
  }
  __syncthreads();
  float xv[64];
  if (tid < 128) {
#pragma unroll
    for (int i = 0; i < 64; ++i) xv[i] = sm_beta[i] * bf2f(Vs[i * 136 + tid]);
  } else {
#pragma unroll
    for (int i = 0; i < 64; ++i) xv[i] = sm_fw[i] * bf2f(Ks[i * 136 + tid - 128]);
  }
  solve_rows<1>(xv, Lm);
  if (tid < 128) {
    const int sl = tid >> 4, dvl = tid & 15;
#pragma unroll
    for (int mt = 0; mt < 4; ++mt)
#pragma unroll
      for (int gg = 0; gg < 4; ++gg) {
        u32x2 w; w.x = pk_bf16(xv[16 * mt + 4 * gg], xv[16 * mt + 4 * gg + 1]); w.y = pk_bf16(xv[16 * mt + 4 * gg + 2], xv[16 * mt + 4 * gg + 3]);
        *(u32x2*)(op + 57344 + (size_t)((sl * 4 + mt) * 64 + gg * 16 + dvl) * 8) = w;
      }
  }
  __syncthreads();
  if (tid >= 128) {
#pragma unroll
    for (int i = 0; i < 64; ++i) Vs[i * 136 + tid - 128] = f2bf(-xv[i]);
  }
  __syncthreads();
#pragma unroll
  for (int f = 0; f < 4; ++f) {
    const int e = tid + 256 * f, frag = e >> 6, ln = e & 63, lr = ln & 15, lg = ln >> 4;
    {
      const int mt = frag >> 2, s = frag & 3, row = 16 * mt + lr;
      const u32x2 lo = *(const u32x2*)(Vs + row * 136 + 32 * s + 4 * lg), hi = *(const u32x2*)(Vs + row * 136 + 32 * s + 16 + 4 * lg);
      *(u32x4*)(op + (size_t)e * 16) = (u32x4){lo.x, lo.y, hi.x, hi.y};
      const u32x2 ql = *(const u32x2*)(Qs + row * 136 + 32 * s + 4 * lg), qh = *(const u32x2*)(Qs + row * 136 + 32 * s + 16 + 4 * lg);
      const float fq = sm_fq[row];
      u32x4 w;
      w.x = pk_bf16(bf_lo(ql.x) * fq, bf_hi(ql.x) * fq); w.y = pk_bf16(bf_lo(ql.y) * fq, bf_hi(ql.y) * fq);
      w.z = pk_bf16(bf_lo(qh.x) * fq, bf_hi(qh.x) * fq); w.w = pk_bf16(bf_lo(qh.y) * fq, bf_hi(qh.y) * fq);
      *(u32x4*)(op + 16384 + (size_t)e * 16) = w;
    }
    {
      const int mt8 = frag >> 1, s2 = frag & 1, dk = 16 * mt8 + lr;
      float v[8];
#pragma unroll
      for (int j = 0; j < 8; ++j) {
        const int pos = 32 * s2 + 16 * (j >> 2) + 4 * lg + (j & 3);
        v[j] = bf2f(Ks[pos * 136 + dk]) * sm_fk[pos];
      }
      u32x4 w; w.x = pk_bf16(v[0], v[1]); w.y = pk_bf16(v[2], v[3]); w.z = pk_bf16(v[4], v[5]); w.w = pk_bf16(v[6], v[7]);
      *(u32x4*)(op + 40960 + (size_t)e * 16) = w;
    }
  }
}

struct ScanA { u32x4 wf[4]; u32x2 uf; float dec; };
struct ScanB { u32x4 qf[4], af[2], kf[4]; };

DI void scan_load_a(const Params& p, int wvs, ScanA& o, int b, int hd, int sl, int n, int q, int lane) {
  const int item = (b * 128 + n) * 4 + hd;
  const unsigned char* op = p.ws + OFF_SC + (size_t)item * OPB;
#pragma unroll
  for (int s = 0; s < 4; ++s) {
    o.wf[s] = *(const u32x4*)(op + (size_t)((q * 4 + s) * 64 + lane) * 16);
  }
  o.uf = *(const u32x2*)(op + 57344 + (size_t)((sl * 4 + q) * 64 + lane) * 8);
  o.dec = ((const float*)(p.ws + OFF_DEC))[item];
}
DI void scan_load_b(const Params& p, int wvs, ScanB& o, int b, int hd, int n, int q, int lane) {
  const int item = (b * 128 + n) * 4 + hd;
  const unsigned char* op = p.ws + OFF_SC + (size_t)item * OPB;
#pragma unroll
  for (int s = 0; s < 4; ++s) o.qf[s] = *(const u32x4*)(op + 16384 + (size_t)((q * 4 + s) * 64 + lane) * 16);
#pragma unroll
  for (int s2 = 0; s2 < 2; ++s2) o.af[s2] = *(const u32x4*)(op + 32768 + (size_t)((q * 2 + s2) * 64 + lane) * 16);
#pragma unroll
  for (int j = 0; j < 4; ++j) o.kf[j] = *(const u32x4*)(op + 40960 + (size_t)((q * 4 + j) * 64 + lane) * 16);
}

DI void scan_step(const Params& p, int wvs, const ScanA& o, const ScanB& ob, f32x4 (&S)[2], int b, int hd, int sl, int n, int q, int lane, unsigned char* smem) {
  const int r16 = lane & 15, g = lane >> 4;
  u32x4* ldsS = (u32x4*)smem;
  u32x2* ldsV = (u32x2*)(smem + 4096);
  ldsS[q * 64 + lane] = __builtin_bit_cast(u32x4, pack8(S[0], S[1]));
  __syncthreads();
  bf16x8 Sb[4];
#pragma unroll
  for (int s = 0; s < 4; ++s) Sb[s] = as_bf8(ldsS[s * 64 + lane]);
  f32x4 vn = (f32x4){bf_lo(o.uf.x), bf_hi(o.uf.x), bf_lo(o.uf.y), bf_hi(o.uf.y)};
#pragma unroll
  for (int s = 0; s < 4; ++s) vn = mfma16(as_bf8(o.wf[s]), Sb[s], vn);
  { u32x2 w; w.x = pk_bf16(vn[0], vn[1]); w.y = pk_bf16(vn[2], vn[3]); ldsV[((q >> 1) * 64 + lane) * 2 + (q & 1)] = w; }
  f32x4 oa = (f32x4){0.f, 0.f, 0.f, 0.f};
#pragma unroll
  for (int s = 0; s < 4; ++s) oa = mfma16(as_bf8(ob.qf[s]), Sb[s], oa);
  __syncthreads();
  bf16x8 Vb[2];
#pragma unroll
  for (int s2 = 0; s2 < 2; ++s2) Vb[s2] = as_bf8(*(const u32x4*)(ldsV + (s2 * 64 + lane) * 2));
#pragma unroll
  for (int s2 = 0; s2 < 2; ++s2) oa = mfma16(as_bf8(ob.af[s2]), Vb[s2], oa);
  u16* h = (u16*)(p.ws + OFF_H);
  const int t0 = b * SEQ + n * 64;
#pragma unroll
  for (int r = 0; r < 4; ++r) h[(size_t)(t0 + 16 * q + 4 * g + r) * NC + hd * 128 + 16 * sl + r16] = f2bf(oa[r]);
#pragma unroll
  for (int t = 0; t < 2; ++t) {
    S[t] = S[t] * o.dec;
#pragma unroll
    for (int s2 = 0; s2 < 2; ++s2) S[t] = mfma16(as_bf8(ob.kf[t * 2 + s2]), Vb[s2], S[t]);
  }
}

DI void scan_chain(const Params& p, int wvs, int chain, unsigned char* smem) {
  const int tid0 = opaque_tid(); const int lane = tid0 & 63, q = tid0 >> 6;
  const int xcd = chain & 7, j = chain >> 3, pair = xcd + 8 * (j >> 3), sl = j & 7, b = pair >> 2, hd = pair & 3;
  f32x4 S[2]; S[0] = (f32x4){0.f, 0.f, 0.f, 0.f}; S[1] = S[0];
  ScanA a0, a1, a2; ScanB bc, bn;
  __syncthreads();
  scan_load_a(p, wvs, a0, b, hd, sl, 0, q, lane);
  scan_load_b(p, wvs, bc, b, hd, 0, q, lane);
  scan_load_a(p, wvs, a1, b, hd, sl, 1, q, lane);
#pragma unroll 1
  for (int n = 0; n < 129; n += 3) {
    if (n + 2 < 128) scan_load_a(p, wvs, a2, b, hd, sl, n + 2, q, lane);
    if (n + 1 < 128) scan_load_b(p, wvs, bn, b, hd, n + 1, q, lane);
    if (n < 128) scan_step(p, wvs, a0, bc, S, b, hd, sl, n, q, lane, smem);
    bc = bn;
    if (n + 3 < 128) scan_load_a(p, wvs, a0, b, hd, sl, n + 3, q, lane);
    if (n + 2 < 128) scan_load_b(p, wvs, bn, b, hd, n + 2, q, lane);
    if (n + 1 < 128) scan_step(p, wvs, a1, bc, S, b, hd, sl, n + 1, q, lane, smem);
    bc = bn;
    if (n + 4 < 128) scan_load_a(p, wvs, a1, b, hd, sl, n + 4, q, lane);
    if (n + 3 < 128) scan_load_b(p, wvs, bn, b, hd, n + 3, q, lane);
    if (n + 2 < 128) scan_step(p, wvs, a2, bc, S, b, hd, sl, n + 2, q, lane, smem);
    bc = bn;
  }
}

DI void swa_item(const Params& p, int wvs, int item, unsigned char* smem) {
  const int tid_ = opaque_tid();
  const int tid = tid_, lane = tid & 63, wv = tid >> 6, r16 = lane & 15, g = lane >> 4;
  const int qt = item & 127, kvh = (item >> 7) & 1, b = item >> 8;
  const int kp0 = 64 * qt - 128;
  u16* Ksm = (u16*)smem;
  u16* Vt = (u16*)(smem + 27648);
  u16* h = (u16*)(p.ws + OFF_H);
  const float* rc = (const float*)(p.ws + OFF_ROPE); const float* rs = rc + 8192 * 8;
  __syncthreads();
  if (tid < 192) {
    const int kk = tid, pos = kp0 + kk;
    u32x4 lo = (u32x4){0, 0, 0, 0}, hi = lo;
    if (pos >= 0) {
      const u16* src = h + (size_t)(b * SEQ + pos) * NC + C_SWK + kvh * 64;
      const u32x4 a = *(const u32x4*)src, c = *(const u32x4*)(src + 8);
      const f32x4 c0 = *(const f32x4*)(rc + pos * 8), c1 = *(const f32x4*)(rc + pos * 8 + 4);
      const f32x4 s0 = *(const f32x4*)(rs + pos * 8), s1 = *(const f32x4*)(rs + pos * 8 + 4);
      float t1[8], t2[8], cs[8], sn[8], o1[8], o2[8];
#pragma unroll
      for (int j = 0; j < 4; ++j) { t1[2 * j] = bf_lo(a[j]); t1[2 * j + 1] = bf_hi(a[j]); t2[2 * j] = bf_lo(c[j]); t2[2 * j + 1] = bf_hi(c[j]);
        cs[j] = c0[j]; cs[4 + j] = c1[j]; sn[j] = s0[j]; sn[4 + j] = s1[j]; }
#pragma unroll
      for (int j = 0; j < 8; ++j) { o1[j] = t1[j] * cs[j] - t2[j] * sn[j]; o2[j] = t2[j] * cs[j] + t1[j] * sn[j]; }
#pragma unroll
      for (int j = 0; j < 4; ++j) { lo[j] = pk_bf16(o1[2 * j], o1[2 * j + 1]); hi[j] = pk_bf16(o2[2 * j], o2[2 * j + 1]); }
    }
    *(u32x4*)(Ksm + kk * 72) = lo; *(u32x4*)(Ksm + kk * 72 + 8) = hi;
  }
  for (int e = tid; e < 192 * 6; e += 256) {
    const int kk = e / 6, ch = 2 + e % 6, pos = kp0 + kk;
    u32x4 v = (u32x4){0, 0, 0, 0};
    if (pos >= 0) v = *(const u32x4*)(h + (size_t)(b * SEQ + pos) * NC + C_SWK + kvh * 64 + ch * 8);
    *(u32x4*)(Ksm + kk * 72 + ch * 8) = v;
  }
  for (int e = tid; e < 192 * 8; e += 256) {
    const int kk = e >> 3, ch = e & 7, pos = kp0 + kk;
    u32x4 v = (u32x4){0, 0, 0, 0};
    if (pos >= 0) v = *(const u32x4*)(h + (size_t)(b * SEQ + pos) * NC + C_SWV + kvh * 64 + ch * 8);
#pragma unroll
    for (int j = 0; j < 4; ++j) { Vt[(ch * 8 + 2 * j) * 200 + kk] = (u16)(v[j] & 0xffffu); Vt[(ch * 8 + 2 * j + 1) * 200 + kk] = (u16)(v[j] >> 16); }
  }
  __syncthreads();
  const int st = wv, jt0 = st < 2 ? st : 2;
  const int qi = 16 * st + r16;
  const int qpos = 64 * qt + qi, tq = b * SEQ + qpos;
#pragma unroll 1
  for (int hq = 0; hq < 4; ++hq) {
    const int head = kvh * 4 + hq;
    u16* qsrc = h + (size_t)tq * NC + C_SWQ + head * 64;
    bf16x8 qf[2];
    {
      const u32x4 a = *(const u32x4*)qsrc, c = *(const u32x4*)(qsrc + 8);
      u32x4 w = *(const u32x4*)(qsrc + 8 * g);
      if (g < 2) {
        const f32x4 c0 = *(const f32x4*)(rc + qpos * 8), c1 = *(const f32x4*)(rc + qpos * 8 + 4);
        const f32x4 s0 = *(const f32x4*)(rs + qpos * 8), s1 = *(const f32x4*)(rs + qpos * 8 + 4);
        float t1[8], t2[8], cs[8], sn[8], o[8];
#pragma unroll
        for (int j = 0; j < 4; ++j) { t1[2 * j] = bf_lo(a[j]); t1[2 * j + 1] = bf_hi(a[j]); t2[2 * j] = bf_lo(c[j]); t2[2 * j + 1] = bf_hi(c[j]);
          cs[j] = c0[j]; cs[4 + j] = c1[j]; sn[j] = s0[j]; sn[4 + j] = s1[j]; }
#pragma unroll
        for (int j = 0; j < 8; ++j) o[j] = (g == 0) ? (t1[j] * cs[j] - t2[j] * sn[j]) : (t2[j] * cs[j] + t1[j] * sn[j]);
#pragma unroll
        for (int j = 0; j < 4; ++j) w[j] = pk_bf16(o[2 * j], o[2 * j + 1]);
      }
      qf[0] = as_bf8(w);
      qf[1] = as_bf8(*(const u32x4*)(qsrc + 32 + 8 * g));
    }
    f32x4 sc[10];
#pragma unroll
    for (int t = 0; t < 10; ++t) {
      sc[t] = (f32x4){0.f, 0.f, 0.f, 0.f};
#pragma unroll
      for (int s = 0; s < 2; ++s) {
        const bf16x8 kf = *(const bf16x8*)(Ksm + (16 * (jt0 + t) + r16) * 72 + 32 * s + 8 * g);
        sc[t] = mfma16(kf, qf[s], sc[t]);
      }
    }
    const float sink = p.sinks[head];
    float mx = sink;
#pragma unroll
    for (int t = 0; t < 10; ++t)
#pragma unroll
      for (int r = 0; r < 4; ++r) {
        const int kk = 16 * (jt0 + t) + 4 * g + r, d = kk - qi;
        const bool ok = (d >= 1) && (d <= 128) && (kp0 + kk >= 0);
        const float v = ok ? sc[t][r] * 0.125f : -1e30f;
        sc[t][r] = v; mx = fmaxf(mx, v);
      }
    mx = fmaxf(mx, __shfl_xor(mx, 16)); mx = fmaxf(mx, __shfl_xor(mx, 32));
    float sum = 0.f;
#pragma unroll
    for (int t = 0; t < 10; ++t)
#pragma unroll
      for (int r = 0; r < 4; ++r) { const float e = __expf(sc[t][r] - mx); sc[t][r] = e; sum += e; }
    sum += __shfl_xor(sum, 16); sum += __shfl_xor(sum, 32);
    const float inv = 1.0f / (sum + __expf(sink - mx));
    f32x4 oacc[4];
#pragma unroll
    for (int dt = 0; dt < 4; ++dt) oacc[dt] = (f32x4){0.f, 0.f, 0.f, 0.f};
#pragma unroll
    for (int s2 = 0; s2 < 5; ++s2) {
      const bf16x8 pb = pack8(sc[2 * s2], sc[2 * s2 + 1]);
#pragma unroll
      for (int dt = 0; dt < 4; ++dt) {
        const u16* vr = Vt + (16 * dt + r16) * 200 + 16 * (jt0 + 2 * s2) + 4 * g;
        const u32x2 lo = *(const u32x2*)vr, hi = *(const u32x2*)(vr + 16);
        oacc[dt] = mfma16(as_bf8((u32x4){lo.x, lo.y, hi.x, hi.y}), pb, oacc[dt]);
      }
    }
#pragma unroll
    for (int dt = 0; dt < 4; ++dt) {
      const int dcol = head * 64 + 16 * dt + 4 * g;
      const u32x2 z = *(const u32x2*)(h + (size_t)tq * NC + C_SWZ + dcol);
      u32x2 w;
      w.x = pk_bf16(oacc[dt][0] * inv * silu_f(bf_lo(z.x)), oacc[dt][1] * inv * silu_f(bf_hi(z.x)));
      w.y = pk_bf16(oacc[dt][2] * inv * silu_f(bf_lo(z.y)), oacc[dt][3] * inv * silu_f(bf_hi(z.y)));
      *(u32x2*)(h + (size_t)tq * NC + C_SWQ + dcol) = w;
    }
  }
}

DI void phase_ya(const Params& p, int wvs) {
  u16* h = (u16*)(p.ws + OFF_H);
  const size_t gt = (size_t)blockIdx.x * 256 + opaque_tid(), gs = (size_t)gridDim.x * 256;
  for (size_t i = gt; i < (size_t)T_TOK * 64; i += gs) {
    const int tok = (int)(i >> 6), c8 = (int)(i & 63);
    u16* ptr = h + (size_t)tok * NC + c8 * 8;
    const u32x4 v = *(const u32x4*)ptr;
    const u32x4 z = *(const u32x4*)(ptr + C_DNZ);
    float o[8]; float ss = 0.f;
#pragma unroll
    for (int j = 0; j < 4; ++j) { o[2 * j] = bf_lo(v[j]); o[2 * j + 1] = bf_hi(v[j]); }
#pragma unroll
    for (int j = 0; j < 8; ++j) ss += o[j] * o[j];
    ss += __shfl_xor(ss, 1); ss += __shfl_xor(ss, 2); ss += __shfl_xor(ss, 4); ss += __shfl_xor(ss, 8);
    const float rs = rsqrtf(ss * (1.0f / 128.0f) + 1e-6f);
    const float* nw = p.dn_norm_w + (c8 & 15) * 8;
    float y[8];
#pragma unroll
    for (int j = 0; j < 4; ++j) {
      y[2 * j] = o[2 * j] * rs * nw[2 * j] * silu_f(bf_lo(z[j]));
      y[2 * j + 1] = o[2 * j + 1] * rs * nw[2 * j + 1] * silu_f(bf_hi(z[j]));
    }
    u32x4 w; w.x = pk_bf16(y[0], y[1]); w.y = pk_bf16(y[2], y[3]); w.z = pk_bf16(y[4], y[5]); w.w = pk_bf16(y[6], y[7]);
    *(u32x4*)ptr = w;
  }
}

DI void phase4(const Params& p, int wvs, unsigned char* smem) {
  const int xcd = blockIdx.x & 7, lb = blockIdx.x >> 3, nlb = gridDim.x >> 3;
  const u16* h = (const u16*)(p.ws + OFF_H);
  const u16* wat = (const u16*)(p.ws + OFF_WAT);
  const u16* wbt = (const u16*)(p.ws + OFF_WBT);
  u16* mg = (u16*)(p.ws + OFF_SC);
  const int tid0 = opaque_tid(); const int lane = tid0 & 63, wv = tid0 >> 6, wm = wv >> 1, wn = wv & 1, r16 = lane & 15, g = lane >> 4;
  for (int li = lb;; li += nlb) {
    int mt, nt; if (!tile_of(li, 8, xcd, mt, nt)) break;
    f32x4 acc[4][4]; zero_acc(acc);
    gemm_kloop(p, wvs, h, NC, wat, 512, 8, mt * 128, nt * 128, acc, smem);
#pragma unroll
    for (int mi = 0; mi < 4; ++mi) {
      const int row = mt * 128 + wm * 64 + mi * 16 + r16;
#pragma unroll
      for (int ni = 0; ni < 4; ++ni) {
        const int col = nt * 128 + wn * 64 + ni * 16 + 4 * g;
        const u32x2 ga = *(const u32x2*)(h + (size_t)row * NC + C_GA + col), gb = *(const u32x2*)(h + (size_t)row * NC + C_GB + col);
        acc[mi][ni][0] *= (1.f + __expf(-bf_lo(gb.x))) / (1.f + __expf(-bf_lo(ga.x)));
        acc[mi][ni][1] *= (1.f + __expf(-bf_hi(gb.x))) / (1.f + __expf(-bf_hi(ga.x)));
        acc[mi][ni][2] *= (1.f + __expf(-bf_lo(gb.y))) / (1.f + __expf(-bf_lo(ga.y)));
        acc[mi][ni][3] *= (1.f + __expf(-bf_hi(gb.y))) / (1.f + __expf(-bf_hi(ga.y)));
      }
      __builtin_amdgcn_sched_barrier(0);
    }
    gemm_kloop(p, wvs, h + C_SWQ, NC, wbt, 512, 8, mt * 128, nt * 128, acc, smem);
#pragma unroll
    for (int mi = 0; mi < 4; ++mi) {
      const int row = mt * 128 + wm * 64 + mi * 16 + r16;
#pragma unroll
      for (int ni = 0; ni < 4; ++ni) {
        const int col = nt * 128 + wn * 64 + ni * 16 + 4 * g;
        const u32x2 gb = *(const u32x2*)(h + (size_t)row * NC + C_GB + col);
        u32x2 w;
        w.x = pk_bf16(acc[mi][ni][0] * sigmoid_f(bf_lo(gb.x)), acc[mi][ni][1] * sigmoid_f(bf_hi(gb.x)));
        w.y = pk_bf16(acc[mi][ni][2] * sigmoid_f(bf_lo(gb.y)), acc[mi][ni][3] * sigmoid_f(bf_hi(gb.y)));
        *(u32x2*)(mg + (size_t)row * 1024 + col) = w;
      }
      __builtin_amdgcn_sched_barrier(0);
    }
  }
}

DI void phase5(const Params& p, int wvs, unsigned char* smem) {
  const int xcd = blockIdx.x & 7, lb = blockIdx.x >> 3, nlb = gridDim.x >> 3;
  const u16* mg = (const u16*)(p.ws + OFF_SC);
  const u16* wot = (const u16*)(p.ws + OFF_WOT);
  const int tid0 = opaque_tid(); const int lane = tid0 & 63, wv = tid0 >> 6, wm = wv >> 1, wn = wv & 1, r16 = lane & 15, g = lane >> 4;
  for (int li = lb;; li += nlb) {
    int mt, nt; if (!tile_of(li, 8, xcd, mt, nt)) break;
    f32x4 acc[4][4]; zero_acc(acc);
    gemm_kloop(p, wvs, mg, 1024, wot, 1024, 16, mt * 128, nt * 128, acc, smem);
#pragma unroll
    for (int mi = 0; mi < 4; ++mi) {
      const int row = mt * 128 + wm * 64 + mi * 16 + r16;
#pragma unroll
      for (int ni = 0; ni < 4; ++ni) {
        const int col = nt * 128 + wn * 64 + ni * 16 + 4 * g;
        const f32x4 xv = *(const f32x4*)(p.x + (size_t)row * 1024 + col);
        *(f32x4*)(p.out + (size_t)row * 1024 + col) = xv * 1.189207115002721f + acc[mi][ni];
      }
    }
  }
}

DI void phase6(const Params& p, int wvs, unsigned char* smem) {
  float* red = (float*)smem;
  const int tid = opaque_tid();
  const float4 gm = ((const float4*)p.ln_g)[tid], bt = ((const float4*)p.ln_b)[tid];
  __syncthreads();
  for (int r = blockIdx.x; r < T_TOK; r += gridDim.x) {
    float4* ptr = (float4*)(p.out + (size_t)r * 1024) + tid;
    const float4 v = *ptr;
    float s = v.x + v.y + v.z + v.w;
#pragma unroll
    for (int o = 32; o > 0; o >>= 1) s += __shfl_xor(s, o);
    if ((tid & 63) == 0) red[tid >> 6] = s;
    __syncthreads();
    const float mu = (red[0] + red[1] + red[2] + red[3]) * (1.0f / 1024.0f);
    const float a = v.x - mu, b = v.y - mu, c = v.z - mu, d = v.w - mu;
    float q = a * a + b * b + c * c + d * d;
#pragma unroll
    for (int o = 32; o > 0; o >>= 1) q += __shfl_xor(q, o);
    if ((tid & 63) == 0) red[4 + (tid >> 6)] = q;
    __syncthreads();
    const float rs = rsqrtf((red[4] + red[5] + red[6] + red[7]) * (1.0f / 1024.0f) + 1e-5f);
    float4 o; o.x = a * rs * gm.x + bt.x; o.y = b * rs * gm.y + bt.y; o.z = c * rs * gm.z + bt.z; o.w = d * rs * gm.w + bt.w;
    *ptr = o;
    __syncthreads();
  }
}

#ifndef MK_MULTI
#define MK_MULTI 0
#endif
#define SMEM_DECL __shared__ __attribute__((aligned(16))) unsigned char smem[SMEM_BYTES]; const int wvs = __builtin_amdgcn_readfirstlane((int)(threadIdx.x >> 6));
#if MK_MULTI
__global__ void __launch_bounds__(256, 2) k_p0(Params p) { SMEM_DECL (void)smem; phase0(p, wvs); }
__global__ void __launch_bounds__(256, 2) k_p1(Params p) { SMEM_DECL phase1(p, wvs, smem); }
__global__ void __launch_bounds__(256, 2) k_p2(Params p) { SMEM_DECL for (int it = blockIdx.x; it < 2048; it += gridDim.x) prep_item(p, wvs, it, smem); }
__global__ void __launch_bounds__(256, 2) k_p3(Params p) { SMEM_DECL
  if (blockIdx.x < 128) scan_chain(p, wvs, blockIdx.x, smem);
  else for (int it = blockIdx.x - 128; it < 1024; it += gridDim.x - 128) swa_item(p, wvs, it, smem); }
__global__ void __launch_bounds__(256, 2) k_p3b(Params p) { SMEM_DECL (void)smem; phase_ya(p, wvs); }
__global__ void __launch_bounds__(256, 2) k_p4(Params p) { SMEM_DECL phase4(p, wvs, smem); }
__global__ void __launch_bounds__(256, 2) k_p5(Params p) { SMEM_DECL phase5(p, wvs, smem); }
__global__ void __launch_bounds__(256, 2) k_p6(Params p) { SMEM_DECL phase6(p, wvs, smem); }
#else
__global__ void __launch_bounds__(256, 2) fwd_megakernel(Params p) {
  cg::grid_group grid = cg::this_grid();
  SMEM_DECL
  phase0(p, wvs);
  grid.sync();
  phase1(p, wvs, smem);
  grid.sync();
  for (int it = blockIdx.x; it < 2048; it += gridDim.x) prep_item(p, wvs, it, smem);
  grid.sync();
  if (blockIdx.x < 128) scan_chain(p, wvs, blockIdx.x, smem);
  else for (int it = blockIdx.x - 128; it < 1024; it += gridDim.x - 128) swa_item(p, wvs, it, smem);
  grid.sync();
  phase_ya(p, wvs);
  grid.sync();
  phase4(p, wvs, smem);
  grid.sync();
  phase5(p, wvs, smem);
  grid.sync();
  phase6(p, wvs, smem);
}
#endif

extern "C" void kernel_launch(void* const* d_in, const int* in_sizes, int n_in, void* d_out, int out_size,
                              void* d_ws, size_t ws_size, hipStream_t stream) {
  if (ws_size < WS_NEED) { fprintf(stderr, "workspace too small: %zu < %zu\n", ws_size, (size_t)WS_NEED); return; }
  Params p{};
  p.x = (const float*)d_in[0]; p.w_in = (const float*)d_in[1]; p.conv_w = (const float*)d_in[2]; p.a_log = (const float*)d_in[3];
  p.dt_bias = (const float*)d_in[4]; p.dn_norm_w = (const float*)d_in[5]; p.sinks = (const float*)d_in[6];
  p.w_branch = (const float*)d_in[7]; p.w_out = (const float*)d_in[8]; p.ln_g = (const float*)d_in[9]; p.ln_b = (const float*)d_in[10];
  p.out = (float*)d_out; p.ws = (unsigned char*)d_ws;
  for (int i = 0; i < 8; ++i) p.inv_freq[i] = (float)std::pow(500000.0, -(double)i / 8.0);
#if MK_MULTI
  const dim3 g(512), b(256);
  k_p0<<<g, b, 0, stream>>>(p);
  k_p1<<<g, b, 0, stream>>>(p);
  k_p2<<<g, b, 0, stream>>>(p);
  k_p3<<<g, b, 0, stream>>>(p);
  k_p3b<<<g, b, 0, stream>>>(p);
  k_p4<<<g, b, 0, stream>>>(p);
  k_p5<<<g, b, 0, stream>>>(p);
  k_p6<<<g, b, 0, stream>>>(p);
#else
  static int grid_blocks = 0;
  if (!grid_blocks) {
    int dev = 0, cus = 0, per_cu = 0;
    (void)hipGetDevice(&dev);
    (void)hipDeviceGetAttribute(&cus, hipDeviceAttributeMultiprocessorCount, dev);
    (void)hipOccupancyMaxActiveBlocksPerMultiprocessor(&per_cu, fwd_megakernel, 256, 0);
    if (per_cu > 2) per_cu = 2;
    if (per_cu < 1) per_cu = 1;
    grid_blocks = cus * per_cu;
    grid_blocks &= ~7;
  }
  void* args[] = {&p};
  hipError_t e = hipLaunchCooperativeKernel((void*)fwd_megakernel, dim3(grid_blocks), dim3(256), args, 0, stream);
  if (e != hipSuccess) fprintf(stderr, "cooperative launch failed: %s (grid %d)\n", hipGetErrorString(e), grid_blocks);
#endif
}
```

```cpp
#include <hip/hip_runtime.h>
#include <hip/hip_cooperative_groups.h>
#include <cstdio>
#include <cmath>
namespace cg = cooperative_groups;

typedef unsigned short u16;
typedef short bf16x8 __attribute__((ext_vector_type(8)));
typedef float f32x4 __attribute__((ext_vector_type(4)));
typedef unsigned u32x4 __attribute__((ext_vector_type(4)));
typedef unsigned u32x2 __attribute__((ext_vector_type(2)));
#define DI __device__ __forceinline__
DI int opaque_tid_(int wave_s) { int t = (int)__builtin_amdgcn_mbcnt_hi(~0u, __builtin_amdgcn_mbcnt_lo(~0u, 0u)) + (wave_s << 6); asm volatile("" : "+v"(t)); return t; }
#define opaque_tid() opaque_tid_(wvs)

constexpr int T_TOK = 32768, SEQ = 8192, DM = 1024, NC = 5384, NCP = 5504;
constexpr int C_DNZ = 1536, C_SWQ = 2056, C_SWK = 2568, C_SWV = 2696, C_SWZ = 2824, C_GA = 3336, C_GB = 4360;
constexpr size_t OFF_BAR = 0;
constexpr size_t BAR_BYTES = 16384;
constexpr size_t OFF_WINT = BAR_BYTES;
constexpr size_t OFF_WAT = OFF_WINT + (size_t)NCP * 1024 * 2;
constexpr size_t OFF_WBT = OFF_WAT + 1024 * 512 * 2;
constexpr size_t OFF_WOT = OFF_WBT + 1024 * 512 * 2;
constexpr size_t OFF_ROPE = OFF_WOT + 1024 * 1024 * 2;
constexpr size_t OFF_HB = OFF_ROPE + 2 * 8192 * 8 * 4;
constexpr size_t OFF_DEC = OFF_HB + (size_t)T_TOK * 8 * 4;
constexpr size_t OFF_H = OFF_DEC + 2048 * 4;
constexpr size_t OFF_SC = OFF_H + (size_t)T_TOK * NC * 2;
constexpr size_t OPB = 73728;
constexpr size_t WS_NEED = OFF_SC + 2048 * OPB;
constexpr int SMEM_BYTES = 73728;

struct Params {
  const float *x, *w_in, *conv_w, *a_log, *dt_bias, *dn_norm_w, *sinks, *w_branch, *w_out, *ln_g, *ln_b;
  float* out; unsigned char* ws;
  float inv_freq[8];
};

typedef __bf16 bf16x2_t __attribute__((ext_vector_type(2)));
typedef float f32x2_t __attribute__((ext_vector_type(2)));
DI unsigned pk_bf16(float lo, float hi) { f32x2_t f = {lo, hi}; bf16x2_t v = __builtin_convertvector(f, bf16x2_t); return __builtin_bit_cast(unsigned, v); }
DI float bf_lo(unsigned u) { return __uint_as_float(u << 16); }
DI float bf_hi(unsigned u) { return __uint_as_float(u & 0xffff0000u); }
DI float bf2f(u16 v) { return __uint_as_float(((unsigned)v) << 16); }
DI u16 f2bf(float f) { return (u16)(pk_bf16(f, f) & 0xffffu); }
DI float silu_f(float y) { return y / (1.0f + __expf(-y)); }
DI float sigmoid_f(float y) { return 1.0f / (1.0f + __expf(-y)); }
DI f32x4 mfma16(bf16x8 a, bf16x8 b, f32x4 c) { return __builtin_amdgcn_mfma_f32_16x16x32_bf16(a, b, c, 0, 0, 0); }
DI bf16x8 as_bf8(u32x4 v) { return __builtin_bit_cast(bf16x8, v); }
DI bf16x8 pack8(f32x4 a, f32x4 b) { u32x4 w; w.x = pk_bf16(a[0], a[1]); w.y = pk_bf16(a[2], a[3]); w.z = pk_bf16(b[0], b[1]); w.w = pk_bf16(b[2], b[3]); return as_bf8(w); }

DI void phase0(const Params& p, int wvs) {
  const size_t gt = (size_t)blockIdx.x * 256 + opaque_tid(), gs = (size_t)gridDim.x * 256;
  {
    u32x4* xb = (u32x4*)(p.ws + OFF_SC);
    const float4* xs = (const float4*)p.x;
    for (size_t i = gt; i < (size_t)T_TOK * DM / 8; i += gs) {
      const float4 a = xs[2 * i], b = xs[2 * i + 1];
      u32x4 w; w.x = pk_bf16(a.x, a.y); w.y = pk_bf16(a.z, a.w); w.z = pk_bf16(b.x, b.y); w.w = pk_bf16(b.z, b.w);
      xb[i] = w;
    }
  }
  {
    u32x4* wt = (u32x4*)(p.ws + OFF_WINT);
    for (size_t i = gt; i < (size_t)NCP * 128; i += gs) {
      const int kc = (int)(i / NCP), n = (int)(i % NCP);
      float v[8];
#pragma unroll
      for (int j = 0; j < 8; ++j) v[j] = (n < NC) ? p.w_in[(size_t)(kc * 8 + j) * NC + n] : 0.f;
      u32x4 w; w.x = pk_bf16(v[0], v[1]); w.y = pk_bf16(v[2], v[3]); w.z = pk_bf16(v[4], v[5]); w.w = pk_bf16(v[6], v[7]);
      wt[(size_t)n * 128 + kc] = w;
    }
  }
  {
    for (size_t i = gt; i < (size_t)2 * 1024 * 64; i += gs) {
      const int br = (int)(i / (1024 * 64)), rem = (int)(i % (1024 * 64)), kc = rem / 1024, n = rem % 1024;
      const float* src = p.w_branch + (size_t)br * 512 * 1024;
      float v[8];
#pragma unroll
      for (int j = 0; j < 8; ++j) v[j] = src[(size_t)(kc * 8 + j) * 1024 + n];
      u32x4 w; w.x = pk_bf16(v[0], v[1]); w.y = pk_bf16(v[2], v[3]); w.z = pk_bf16(v[4], v[5]); w.w = pk_bf16(v[6], v[7]);
      ((u32x4*)(p.ws + (br ? OFF_WBT : OFF_WAT)))[(size_t)n * 64 + kc] = w;
    }
  }
  {
    for (size_t i = gt; i < (size_t)1024 * 128; i += gs) {
      const int kc = (int)(i / 1024), n = (int)(i % 1024);
      float v[8];
#pragma unroll
      for (int j = 0; j < 8; ++j) v[j] = p.w_out[(size_t)(kc * 8 + j) * 1024 + n];
      u32x4 w; w.x = pk_bf16(v[0], v[1]); w.y = pk_bf16(v[2], v[3]); w.z = pk_bf16(v[4], v[5]); w.w = pk_bf16(v[6], v[7]);
      ((u32x4*)(p.ws + OFF_WOT))[(size_t)n * 128 + kc] = w;
    }
  }
  {
    float* rc = (float*)(p.ws + OFF_ROPE); float* rs = rc + 8192 * 8;
    for (size_t i = gt; i < 8192 * 8; i += gs) {
      const int t = (int)(i >> 3), f = (int)(i & 7);
      const float ang = (float)t * p.inv_freq[f];
      const double a = (double)ang;
      const double k = __builtin_rint(a * 0.15915494309189535);
      const float r = (float)(a - k * 6.283185307179586);
      rc[i] = cosf(r); rs[i] = sinf(r);
    }
  }
}

DI int lds_off(int row, int chunk) { return row * 128 + ((chunk ^ (row & 7)) << 4); }

DI void gemm_kloop(const Params& p, int wvs, const u16* __restrict__ A, int lda, const u16* __restrict__ Bt, int ldb, int nk, int m0, int n0,
                   f32x4 (&acc)[4][4], unsigned char* smem) {
  const int tid = opaque_tid(), lane = tid & 63, wv = tid >> 6, wm = wv >> 1, wn = wv & 1, r16 = lane & 15, g = lane >> 4;
  const int lrow = tid >> 3, lc = tid & 7;
  const u16* ap = A + (size_t)(m0 + lrow) * lda + lc * 8;
  const u16* bp = Bt + (size_t)(n0 + lrow) * ldb + lc * 8;
  u32x4 ra[4], rb[4];
#pragma unroll
  for (int i = 0; i < 4; ++i) { ra[i] = *(const u32x4*)(ap + (size_t)(32 * i) * lda); rb[i] = *(const u32x4*)(bp + (size_t)(32 * i) * ldb); }
  __syncthreads();
#pragma unroll
  for (int i = 0; i < 4; ++i) {
    *(u32x4*)(smem + lds_off(lrow + 32 * i, lc)) = ra[i];
    *(u32x4*)(smem + 16384 + lds_off(lrow + 32 * i, lc)) = rb[i];
  }
  __syncthreads();
  for (int kt = 0; kt < nk; ++kt) {
    unsigned char* cur = smem + (kt & 1) * 32768;
    unsigned char* nxt = smem + ((kt + 1) & 1) * 32768;
    const bool more = (kt + 1 < nk);
    if (more) {
#pragma unroll
      for (int i = 0; i < 4; ++i) {
        ra[i] = *(const u32x4*)(ap + (size_t)(32 * i) * lda + (kt + 1) * 64);
        rb[i] = *(const u32x4*)(bp + (size_t)(32 * i) * ldb + (kt + 1) * 64);
      }
    }
#pragma unroll
    for (int ks = 0; ks < 2; ++ks) {
      bf16x8 af[4], bfr[4];
#pragma unroll
      for (int i = 0; i < 4; ++i) {
        af[i] = *(const bf16x8*)(cur + lds_off(wm * 64 + i * 16 + r16, ks * 4 + g));
        bfr[i] = *(const bf16x8*)(cur + 16384 + lds_off(wn * 64 + i * 16 + r16, ks * 4 + g));
      }
#pragma unroll
      for (int mi = 0; mi < 4; ++mi)
#pragma unroll
        for (int ni = 0; ni < 4; ++ni) acc[mi][ni] = mfma16(bfr[ni], af[mi], acc[mi][ni]);
    }
    if (more) {
#pragma unroll
      for (int i = 0; i < 4; ++i) {
        *(u32x4*)(nxt + lds_off(lrow + 32 * i, lc)) = ra[i];
        *(u32x4*)(nxt + 16384 + lds_off(lrow + 32 * i, lc)) = rb[i];
      }
    }
    __syncthreads();
  }
}

DI bool tile_of(int li, int ntn, int xcd, int& mt, int& nt) {
  if (li >= 32 * ntn) return false;
  const int grp = li / (4 * ntn), rem = li % (4 * ntn);
  nt = rem >> 2; mt = 32 * xcd + grp * 4 + (rem & 3);
  return true;
}

DI void zero_acc(f32x4 (&acc)[4][4]) {
#pragma unroll
  for (int i = 0; i < 4; ++i)
#pragma unroll
    for (int j = 0; j < 4; ++j) acc[i][j] = (f32x4){0.f, 0.f, 0.f, 0.f};
}

DI void phase1(const Params& p, int wvs, unsigned char* smem) {
  const int xcd = blockIdx.x & 7, lb = blockIdx.x >> 3, nlb = gridDim.x >> 3;
  const u16* xb = (const u16*)(p.ws + OFF_SC);
  const u16* wint = (const u16*)(p.ws + OFF_WINT);
  u16* h = (u16*)(p.ws + OFF_H);
  float* hb = (float*)(p.ws + OFF_HB);
  const int tid0 = opaque_tid(); const int lane = tid0 & 63, wv = tid0 >> 6, wm = wv >> 1, wn = wv & 1, r16 = lane & 15, g = lane >> 4;
  for (int li = lb;; li += nlb) {
    int mt, nt; if (!tile_of(li, 43, xcd, mt, nt)) break;
    f32x4 acc[4][4]; zero_acc(acc);
    gemm_kloop(p, wvs, xb, 1024, wint, 1024, 16, mt * 128, nt * 128, acc, smem);
#pragma unroll
    for (int mi = 0; mi < 4; ++mi) {
      const int row = mt * 128 + wm * 64 + mi * 16 + r16;
#pragma unroll
      for (int ni = 0; ni < 4; ++ni) {
        const int col = nt * 128 + wn * 64 + ni * 16 + 4 * g;
        if (col < NC) {
          u32x2 w; w.x = pk_bf16(acc[mi][ni][0], acc[mi][ni][1]); w.y = pk_bf16(acc[mi][ni][2], acc[mi][ni][3]);
          *(u32x2*)(h + (size_t)row * NC + col) = w;
          if (col >= 2048 && col < 2056) *(f32x4*)(hb + (size_t)row * 8 + (col - 2048)) = acc[mi][ni];
        }
      }
    }
  }
}

template <int I, int M4> DI void solve_part(const float (&xv)[64], const float* Lrow, float& a) {
  if constexpr (4 * M4 < I) {
    const f32x4 l = *(const f32x4*)(Lrow + 4 * M4);
    if constexpr (4 * M4 + 0 < I) a -= l[0] * xv[4 * M4 + 0];
    if constexpr (4 * M4 + 1 < I) a -= l[1] * xv[4 * M4 + 1];
    if constexpr (4 * M4 + 2 < I) a -= l[2] * xv[4 * M4 + 2];
    if constexpr (4 * M4 + 3 < I) a -= l[3] * xv[4 * M4 + 3];
    solve_part<I, M4 + 1>(xv, Lrow, a);
  }
}
template <int I> DI void solve_rows(float (&xv)[64], const float* Lm) {
  if constexpr (I < 64) {
    float a = xv[I];
    solve_part<I, 0>(xv, Lm + I * 68, a);
    xv[I] = a;
    __builtin_amdgcn_sched_barrier(0);
    solve_rows<I + 1>(xv, Lm);
  }
}

DI void prep_item(const Params& p, int wvs, int item, unsigned char* smem) {
  const int tid_ = opaque_tid();
  const int tid = tid_, lane = tid & 63, wv = tid >> 6, r16 = lane & 15, g = lane >> 4;
  const int hd = item & 3, n = (item >> 2) & 127, b = item >> 9;
  const int t0 = b * SEQ + n * 64;
  u16* Qs = (u16*)smem; u16* Ks = Qs + 64 * 136; u16* Vs = Ks + 64 * 136;
  float* Lm = (float*)(smem + 52224);
  float* sm_beta = (float*)(smem + 69632);
  float* sm_gc = sm_beta + 64; float* sm_rq = sm_gc + 64; float* sm_rk = sm_rq + 64;
  float* sm_fw = sm_rk + 64; float* sm_fq = sm_fw + 64; float* sm_fk = sm_fq + 64;
  const u16* h = (const u16*)(p.ws + OFF_H);
  const float* hb = (const float*)(p.ws + OFF_HB);
  unsigned char* op = p.ws + OFF_SC + (size_t)item * OPB;
  __syncthreads();
  {
    const int c2 = tid & 63, rbase = (tid >> 6) * 16;
#pragma unroll 1
    for (int mat = 0; mat < 3; ++mat) {
      const int col = mat * 512 + hd * 128 + 2 * c2;
      float wa[4], wb[4];
#pragma unroll
      for (int j = 0; j < 4; ++j) { wa[j] = p.conv_w[j * 1536 + col]; wb[j] = p.conv_w[j * 1536 + col + 1]; }
      float xa[3], xb[3];
#pragma unroll
      for (int j = 0; j < 3; ++j) {
        const int pos = n * 64 + rbase - 3 + j;
        unsigned v = 0;
        if (pos >= 0) v = *(const unsigned*)(h + (size_t)(t0 + rbase - 3 + j) * NC + col);
        xa[j] = bf_lo(v); xb[j] = bf_hi(v);
      }
      u16* dst = (mat == 0 ? Qs : (mat == 1 ? Ks : Vs));
#pragma unroll
      for (int i = 0; i < 16; ++i) {
        const unsigned v = *(const unsigned*)(h + (size_t)(t0 + rbase + i) * NC + col);
        const float a3 = bf_lo(v), b3 = bf_hi(v);
        const float ya = wa[0] * xa[0] + wa[1] * xa[1] + wa[2] * xa[2] + wa[3] * a3;
        const float yb = wb[0] * xb[0] + wb[1] * xb[1] + wb[2] * xb[2] + wb[3] * b3;
        xa[0] = xa[1]; xa[1] = xa[2]; xa[2] = a3; xb[0] = xb[1]; xb[1] = xb[2]; xb[2] = b3;
        *(unsigned*)(dst + (rbase + i) * 136 + 2 * c2) = pk_bf16(silu_f(ya), silu_f(yb));
      }
    }
  }
  __syncthreads();
  if (wv == 0) {
    const int row = t0 + lane;
    const float bl = hb[(size_t)row * 8 + hd], al = hb[(size_t)row * 8 + 4 + hd];
    const float xx = al + p.dt_bias[hd];
    const float sp = xx > 20.f ? xx : log1pf(expf(xx));
    float gg = -expf(p.a_log[hd]) * sp;
#pragma unroll
    for (int o = 1; o < 64; o <<= 1) { const float t = __shfl_up(gg, o); if (lane >= o) gg += t; }
    sm_beta[lane] = 1.0f / (1.0f + expf(-bl)); sm_gc[lane] = gg;
  } else if (wv <= 2) {
    const int r = tid - 64;
    const u16* src = (r < 64) ? (Qs + r * 136) : (Ks + (r - 64) * 136);
    float ss = 0.f;
#pragma unroll
    for (int c = 0; c < 16; ++c) {
      const u32x4 v = *(const u32x4*)(src + c * 8);
#pragma unroll
      for (int j = 0; j < 4; ++j) { const float a = bf_lo(v[j]), bb = bf_hi(v[j]); ss += a * a + bb * bb; }
    }
    const float rs = rsqrtf(ss + 1e-6f);
    if (r < 64) sm_rq[r] = rs; else sm_rk[r - 64] = rs;
  }
  __syncthreads();
  if (tid < 64) {
    const float gc = sm_gc[tid], gl = sm_gc[63], eg = expf(gc);
    sm_fw[tid] = sm_beta[tid] * eg * sm_rk[tid];
    sm_fq[tid] = sm_rq[tid] * 0.08838834764831845f * eg;
    sm_fk[tid] = sm_rk[tid] * expf(gl - gc);
    if (tid == 0) ((float*)(p.ws + OFF_DEC))[item] = expf(gl);
  }
  {
    bf16x8 kfi[4], qfi[4];
#pragma unroll
    for (int s = 0; s < 4; ++s) {
      kfi[s] = *(const bf16x8*)(Ks + (16 * wv + r16) * 136 + 32 * s + 8 * g);
      qfi[s] = *(const bf16x8*)(Qs + (16 * wv + r16) * 136 + 32 * s + 8 * g);
    }
    f32x4 at[4];
#pragma unroll
    for (int jt = 0; jt < 4; ++jt) {
      at[jt] = (f32x4){0.f, 0.f, 0.f, 0.f};
      if (jt <= wv) {
        f32x4 la = (f32x4){0.f, 0.f, 0.f, 0.f}, aa = (f32x4){0.f, 0.f, 0.f, 0.f};
#pragma unroll
        for (int s = 0; s < 4; ++s) {
          const bf16x8 kfj = *(const bf16x8*)(Ks + (16 * jt + r16) * 136 + 32 * s + 8 * g);
          la = mfma16(kfi[s], kfj, la);
          aa = mfma16(kfj, qfi[s], aa);
        }
#pragma unroll
        for (int r = 0; r < 4; ++r) {
          { const int i = 16 * wv + 4 * g + r, j = 16 * jt + r16;
            const float v = (i > j) ? sm_beta[i] * sm_rk[i] * sm_rk[j] * __expf(sm_gc[i] - sm_gc[j]) * la[r] : 0.f;
            Lm[i * 68 + j] = v; }
          { const int j = 16 * jt + 4 * g + r, i = 16 * wv + r16;
            at[jt][r] = (j <= i) ? sm_rq[i] * sm_rk[j] * 0.08838834764831845f * __expf(sm_gc[i] - sm_gc[j]) * aa[r] : 0.f; }
        }
      }
    }
#pragma unroll
    for (int s2 = 0; s2 < 2; ++s2)
      *(bf16x8*)(op + 32768 + (size_t)((wv * 2 + s2) * 64 + lane) * 16) = pack8(at[2 * s2], at[2 * s2 + 1]);
  }
  __syncthreads();
  float xv[64];
  if (tid < 128) {
#pragma unroll
    for (int i = 0; i < 64; ++i) xv[i] = sm_beta[i] * bf2f(Vs[i * 136 + tid]);
  } else {
#pragma unroll
    for (int i = 0; i < 64; ++i) xv[i] = sm_fw[i] * bf2f(Ks[i * 136 + tid - 128]);
  }
  solve_rows<1>(xv, Lm);
  if (tid < 128) {
    const int sl = tid >> 4, dvl = tid & 15;
#pragma unroll
    for (int mt = 0; mt < 4; ++mt)
#pragma unroll
      for (int gg = 0; gg < 4; ++gg) {
        u32x2 w; w.x = pk_bf16(xv[16 * mt + 4 * gg], xv[16 * mt + 4 * gg + 1]); w.y = pk_bf16(xv[16 * mt + 4 * gg + 2], xv[16 * mt + 4 * gg + 3]);
        *(u32x2*)(op + 57344 + (size_t)((sl * 4 + mt) * 64 + gg * 16 + dvl) * 8) = w;
      }
  }
  __syncthreads();
  if (tid >= 128) {
#pragma unroll
    for (int i = 0; i < 64; ++i) Vs[i * 136 + tid - 128] = f2bf(-xv[i]);
  }
  __syncthreads();
#pragma unroll
  for (int f = 0; f < 4; ++f) {
    const int e = tid + 256 * f, frag = e >> 6, ln = e & 63, lr = ln & 15, lg = ln >> 4;
    {
      const int mt = frag >> 2, s = frag & 3, row = 16 * mt + lr;
      const u32x2 lo = *(const u32x2*)(Vs + row * 136 + 32 * s + 4 * lg), hi = *(const u32x2*)(Vs + row * 136 + 32 * s + 16 + 4 * lg);
      *(u32x4*)(op + (size_t)e * 16) = (u32x4){lo.x, lo.y, hi.x, hi.y};
      const u32x2 ql = *(const u32x2*)(Qs + row * 136 + 32 * s + 4 * lg), qh = *(const u32x2*)(Qs + row * 136 + 32 * s + 16 + 4 * lg);
      const float fq = sm_fq[row];
      u32x4 w;
      w.x = pk_bf16(bf_lo(ql.x) * fq, bf_hi(ql.x) * fq); w.y = pk_bf16(bf_lo(ql.y) * fq, bf_hi(ql.y) * fq);
      w.z = pk_bf16(bf_lo(qh.x) * fq, bf_hi(qh.x) * fq); w.w = pk_bf16(bf_lo(qh.y) * fq, bf_hi(qh.y) * fq);
      *(u32x4*)(op + 16384 + (size_t)e * 16) = w;
    }
    {
      const int mt8 = frag >> 1, s2 = frag & 1, dk = 16 * mt8 + lr;
      float v[8];
#pragma unroll
      for (int j = 0; j < 8; ++j) {
        const int pos = 32 * s2 + 16 * (j >> 2) + 4 * lg + (j & 3);
        v[j] = bf2f(Ks[pos * 136 + dk]) * sm_fk[pos];
      }
      u32x4 w; w.x = pk_bf16(v[0], v[1]); w.y = pk_bf16(v[2], v[3]); w.z = pk_bf16(v[4], v[5]); w.w = pk_bf16(v[6], v[7]);
      *(u32x4*)(op + 40960 + (size_t)e * 16) = w;
    }
  }
}

struct ScanA { u32x4 wf[4]; u32x2 uf; float dec; };
struct ScanB { u32x4 qf[4], af[2], kf[4]; };

DI void scan_load_a(const Params& p, int wvs, ScanA& o, int b, int hd, int sl, int n, int q, int lane) {
  const int item = (b * 128 + n) * 4 + hd;
  const unsigned char* op = p.ws + OFF_SC + (size_t)item * OPB;
#pragma unroll
  for (int s = 0; s < 4; ++s) {
    o.wf[s] = *(const u32x4*)(op + (size_t)((q * 4 + s) * 64 + lane) * 16);
  }
  o.uf = *(const u32x2*)(op + 57344 + (size_t)((sl * 4 + q) * 64 + lane) * 8);
  o.dec = ((const float*)(p.ws + OFF_DEC))[item];
}
DI void scan_load_b(const Params& p, int wvs, ScanB& o, int b, int hd, int n, int q, int lane) {
  const int item = (b * 128 + n) * 4 + hd;
  const unsigned char* op = p.ws + OFF_SC + (size_t)item * OPB;
#pragma unroll
  for (int s = 0; s < 4; ++s) o.qf[s] = *(const u32x4*)(op + 16384 + (size_t)((q * 4 + s) * 64 + lane) * 16);
#pragma unroll
  for (int s2 = 0; s2 < 2; ++s2) o.af[s2] = *(const u32x4*)(op + 32768 + (size_t)((q * 2 + s2) * 64 + lane) * 16);
#pragma unroll
  for (int j = 0; j < 4; ++j) o.kf[j] = *(const u32x4*)(op + 40960 + (size_t)((q * 4 + j) * 64 + lane) * 16);
}

DI void scan_step(const Params& p, int wvs, const ScanA& o, const ScanB& ob, f32x4 (&S)[2], int b, int hd, int sl, int n, int q, int lane, unsigned char* smem) {
  const int r16 = lane & 15, g = lane >> 4;
  u32x4* ldsS = (u32x4*)smem;
  u32x2* ldsV = (u32x2*)(smem + 4096);
  ldsS[q * 64 + lane] = __builtin_bit_cast(u32x4, pack8(S[0], S[1]));
  __syncthreads();
  bf16x8 Sb[4];
#pragma unroll
  for (int s = 0; s < 4; ++s) Sb[s] = as_bf8(ldsS[s * 64 + lane]);
  f32x4 vn = (f32x4){bf_lo(o.uf.x), bf_hi(o.uf.x), bf_lo(o.uf.y), bf_hi(o.uf.y)};
#pragma unroll
  for (int s = 0; s < 4; ++s) vn = mfma16(as_bf8(o.wf[s]), Sb[s], vn);
  { u32x2 w; w.x = pk_bf16(vn[0], vn[1]); w.y = pk_bf16(vn[2], vn[3]); ldsV[((q >> 1) * 64 + lane) * 2 + (q & 1)] = w; }
  f32x4 oa = (f32x4){0.f, 0.f, 0.f, 0.f};
#pragma unroll
  for (int s = 0; s < 4; ++s) oa = mfma16(as_bf8(ob.qf[s]), Sb[s], oa);
  __syncthreads();
  bf16x8 Vb[2];
#pragma unroll
  for (int s2 = 0; s2 < 2; ++s2) Vb[s2] = as_bf8(*(const u32x4*)(ldsV + (s2 * 64 + lane) * 2));
#pragma unroll
  for (int s2 = 0; s2 < 2; ++s2) oa = mfma16(as_bf8(ob.af[s2]), Vb[s2], oa);
  u16* h = (u16*)(p.ws + OFF_H);
  const int t0 = b * SEQ + n * 64;
#pragma unroll
  for (int r = 0; r < 4; ++r) h[(size_t)(t0 + 16 * q + 4 * g + r) * NC + hd * 128 + 16 * sl + r16] = f2bf(oa[r]);
#pragma unroll
  for (int t = 0; t < 2; ++t) {
    S[t] = S[t] * o.dec;
#pragma unroll
    for (int s2 = 0; s2 < 2; ++s2) S[t] = mfma16(as_bf8(ob.kf[t * 2 + s2]), Vb[s2], S[t]);
  }
}

DI void scan_chain(const Params& p, int wvs, int chain, unsigned char* smem) {
  const int tid0 = opaque_tid(); const int lane = tid0 & 63, q = tid0 >> 6;
  const int xcd = chain & 7, j = chain >> 3, pair = xcd + 8 * (j >> 3), sl = j & 7, b = pair >> 2, hd = pair & 3;
  f32x4 S[2]; S[0] = (f32x4){0.f, 0.f, 0.f, 0.f}; S[1] = S[0];
  ScanA a0, a1, a2; ScanB bc, bn;
  __syncthreads();
  scan_load_a(p, wvs, a0, b, hd, sl, 0, q, lane);
  scan_load_b(p, wvs, bc, b, hd, 0, q, lane);
  scan_load_a(p, wvs, a1, b, hd, sl, 1, q, lane);
#pragma unroll 1
  for (int n = 0; n < 129; n += 3) {
    if (n + 2 < 128) scan_load_a(p, wvs, a2, b, hd, sl, n + 2, q, lane);
    if (n + 1 < 128) scan_load_b(p, wvs, bn, b, hd, n + 1, q, lane);
    if (n < 128) scan_step(p, wvs, a0, bc, S, b, hd, sl, n, q, lane, smem);
    bc = bn;
    if (n + 3 < 128) scan_load_a(p, wvs, a0, b, hd, sl, n + 3, q, lane);
    if (n + 2 < 128) scan_load_b(p, wvs, bn, b, hd, n + 2, q, lane);
    if (n + 1 < 128) scan_step(p, wvs, a1, bc, S, b, hd, sl, n + 1, q, lane, smem);
    bc = bn;
    if (n + 4 < 128) scan_load_a(p, wvs, a1, b, hd, sl, n + 4, q, lane);
    if (n + 3 < 128) scan_load_b(p, wvs, bn, b, hd, n + 3, q, lane);
    if (n + 2 < 128) scan_step(p, wvs, a2, bc, S, b, hd, sl, n + 2, q, lane, smem);
    bc = bn;
  }
}

DI void swa_item(const Params& p, int wvs, int item, unsigned char* smem) {
  const int tid_ = opaque_tid();
  const int tid = tid_, lane = tid & 63, wv = tid >> 6, r16 = lane & 15, g = lane >> 4;
  const int qt = item & 127, kvh = (item >> 7) & 1, b = item >> 8;
  const int kp0 = 64 * qt - 128;
  u16* Ksm = (u16*)smem;
  u16* Vt = (u16*)(smem + 27648);
  u16* h = (u16*)(p.ws + OFF_H);
  const float* rc = (const float*)(p.ws + OFF_ROPE); const float* rs = rc + 8192 * 8;
  __syncthreads();
  if (tid < 192) {
    const int kk = tid, pos = kp0 + kk;
    u32x4 lo = (u32x4){0, 0, 0, 0}, hi = lo;
    if (pos >= 0) {
      const u16* src = h + (size_t)(b * SEQ + pos) * NC + C_SWK + kvh * 64;
      const u32x4 a = *(const u32x4*)src, c = *(const u32x4*)(src + 8);
      const f32x4 c0 = *(const f32x4*)(rc + pos * 8), c1 = *(const f32x4*)(rc + pos * 8 + 4);
      const f32x4 s0 = *(const f32x4*)(rs + pos * 8), s1 = *(const f32x4*)(rs + pos * 8 + 4);
      float t1[8], t2[8], cs[8], sn[8], o1[8], o2[8];
#pragma unroll
      for (int j = 0; j < 4; ++j) { t1[2 * j] = bf_lo(a[j]); t1[2 * j + 1] = bf_hi(a[j]); t2[2 * j] = bf_lo(c[j]); t2[2 * j + 1] = bf_hi(c[j]);
        cs[j] = c0[j]; cs[4 + j] = c1[j]; sn[j] = s0[j]; sn[4 + j] = s1[j]; }
#pragma unroll
      for (int j = 0; j < 8; ++j) { o1[j] = t1[j] * cs[j] - t2[j] * sn[j]; o2[j] = t2[j] * cs[j] + t1[j] * sn[j]; }
#pragma unroll
      for (int j = 0; j < 4; ++j) { lo[j] = pk_bf16(o1[2 * j], o1[2 * j + 1]); hi[j] = pk_bf16(o2[2 * j], o2[2 * j + 1]); }
    }
    *(u32x4*)(Ksm + kk * 72) = lo; *(u32x4*)(Ksm + kk * 72 + 8) = hi;
  }
  for (int e = tid; e < 192 * 6; e += 256) {
    const int kk = e / 6, ch = 2 + e % 6, pos = kp0 + kk;
    u32x4 v = (u32x4){0, 0, 0, 0};
    if (pos >= 0) v = *(const u32x4*)(h + (size_t)(b * SEQ + pos) * NC + C_SWK + kvh * 64 + ch * 8);
    *(u32x4*)(Ksm + kk * 72 + ch * 8) = v;
  }
  for (int e = tid; e < 192 * 8; e += 256) {
    const int kk = e >> 3, ch = e & 7, pos = kp0 + kk;
    u32x4 v = (u32x4){0, 0, 0, 0};
    if (pos >= 0) v = *(const u32x4*)(h + (size_t)(b * SEQ + pos) * NC + C_SWV + kvh * 64 + ch * 8);
#pragma unroll
    for (int j = 0; j < 4; ++j) { Vt[(ch * 8 + 2 * j) * 200 + kk] = (u16)(v[j] & 0xffffu); Vt[(ch * 8 + 2 * j + 1) * 200 + kk] = (u16)(v[j] >> 16); }
  }
  __syncthreads();
  const int st = wv, jt0 = st < 2 ? st : 2;
  const int qi = 16 * st + r16;
  const int qpos = 64 * qt + qi, tq = b * SEQ + qpos;
#pragma unroll 1
  for (int hq = 0; hq < 4; ++hq) {
    const int head = kvh * 4 + hq;
    u16* qsrc = h + (size_t)tq * NC + C_SWQ + head * 64;
    bf16x8 qf[2];
    {
      const u32x4 a = *(const u32x4*)qsrc, c = *(const u32x4*)(qsrc + 8);
      u32x4 w = *(const u32x4*)(qsrc + 8 * g);
      if (g < 2) {
        const f32x4 c0 = *(const f32x4*)(rc + qpos * 8), c1 = *(const f32x4*)(rc + qpos * 8 + 4);
        const f32x4 s0 = *(const f32x4*)(rs + qpos * 8), s1 = *(const f32x4*)(rs + qpos * 8 + 4);
        float t1[8], t2[8], cs[8], sn[8], o[8];
#pragma unroll
        for (int j = 0; j < 4; ++j) { t1[2 * j] = bf_lo(a[j]); t1[2 * j + 1] = bf_hi(a[j]); t2[2 * j] = bf_lo(c[j]); t2[2 * j + 1] = bf_hi(c[j]);
          cs[j] = c0[j]; cs[4 + j] = c1[j]; sn[j] = s0[j]; sn[4 + j] = s1[j]; }
#pragma unroll
        for (int j = 0; j < 8; ++j) o[j] = (g == 0) ? (t1[j] * cs[j] - t2[j] * sn[j]) : (t2[j] * cs[j] + t1[j] * sn[j]);
#pragma unroll
        for (int j = 0; j < 4; ++j) w[j] = pk_bf16(o[2 * j], o[2 * j + 1]);
      }
      qf[0] = as_bf8(w);
      qf[1] = as_bf8(*(const u32x4*)(qsrc + 32 + 8 * g));
    }
    f32x4 sc[10];
#pragma unroll
    for (int t = 0; t < 10; ++t) {
      sc[t] = (f32x4){0.f, 0.f, 0.f, 0.f};
#pragma unroll
      for (int s = 0; s < 2; ++s) {
        const bf16x8 kf = *(const bf16x8*)(Ksm + (16 * (jt0 + t) + r16) * 72 + 32 * s + 8 * g);
        sc[t] = mfma16(kf, qf[s], sc[t]);
      }
    }
    const float sink = p.sinks[head];
    float mx = sink;
#pragma unroll
    for (int t = 0; t < 10; ++t)
#pragma unroll
      for (int r = 0; r < 4; ++r) {
        const int kk = 16 * (jt0 + t) + 4 * g + r, d = kk - qi;
        const bool ok = (d >= 1) && (d <= 128) && (kp0 + kk >= 0);
        const float v = ok ? sc[t][r] * 0.125f : -1e30f;
        sc[t][r] = v; mx = fmaxf(mx, v);
      }
    mx = fmaxf(mx, __shfl_xor(mx, 16)); mx = fmaxf(mx, __shfl_xor(mx, 32));
    float sum = 0.f;
#pragma unroll
    for (int t = 0; t < 10; ++t)
#pragma unroll
      for (int r = 0; r < 4; ++r) { const float e = __expf(sc[t][r] - mx); sc[t][r] = e; sum += e; }
    sum += __shfl_xor(sum, 16); sum += __shfl_xor(sum, 32);
    const float inv = 1.0f / (sum + __expf(sink - mx));
    f32x4 oacc[4];
#pragma unroll
    for (int dt = 0; dt < 4; ++dt) oacc[dt] = (f32x4){0.f, 0.f, 0.f, 0.f};
#pragma unroll
    for (int s2 = 0; s2 < 5; ++s2) {
      const bf16x8 pb = pack8(sc[2 * s2], sc[2 * s2 + 1]);
#pragma unroll
      for (int dt = 0; dt < 4; ++dt) {
        const u16* vr = Vt + (16 * dt + r16) * 200 + 16 * (jt0 + 2 * s2) + 4 * g;
        const u32x2 lo = *(const u32x2*)vr, hi = *(const u32x2*)(vr + 16);
        oacc[dt] = mfma16(as_bf8((u32x4){lo.x, lo.y, hi.x, hi.y}), pb, oacc[dt]);
      }
    }
#pragma unroll
    for (int dt = 0; dt < 4; ++dt) {
      const int dcol = head * 64 + 16 * dt + 4 * g;
      const u32x2 z = *(const u32x2*)(h + (size_t)tq * NC + C_SWZ + dcol);
      u32x2 w;
      w.x = pk_bf16(oacc[dt][0] * inv * silu_f(bf_lo(z.x)), oacc[dt][1] * inv * silu_f(bf_hi(z.x)));
      w.y = pk_bf16(oacc[dt][2] * inv * silu_f(bf_lo(z.y)), oacc[dt][3] * inv * silu_f(bf_hi(z.y)));
      *(u32x2*)(h + (size_t)tq * NC + C_SWQ + dcol) = w;
    }
  }
}

DI void phase_ya(const Params& p, int wvs) {
  u16* h = (u16*)(p.ws + OFF_H);
  const size_t gt = (size_t)blockIdx.x * 256 + opaque_tid(), gs = (size_t)gridDim.x * 256;
  for (size_t i = gt; i < (size_t)T_TOK * 64; i += gs) {
    const int tok = (int)(i >> 6), c8 = (int)(i & 63);
    u16* ptr = h + (size_t)tok * NC + c8 * 8;
    const u32x4 v = *(const u32x4*)ptr;
    const u32x4 z = *(const u32x4*)(ptr + C_DNZ);
    float o[8]; float ss = 0.f;
#pragma unroll
    for (int j = 0; j < 4; ++j) { o[2 * j] = bf_lo(v[j]); o[2 * j + 1] = bf_hi(v[j]); }
#pragma unroll
    for (int j = 0; j < 8; ++j) ss += o[j] * o[j];
    ss += __shfl_xor(ss, 1); ss += __shfl_xor(ss, 2); ss += __shfl_xor(ss, 4); ss += __shfl_xor(ss, 8);
    const float rs = rsqrtf(ss * (1.0f / 128.0f) + 1e-6f);
    const float* nw = p.dn_norm_w + (c8 & 15) * 8;
    float y[8];
#pragma unroll
    for (int j = 0; j < 4; ++j) {
      y[2 * j] = o[2 * j] * rs * nw[2 * j] * silu_f(bf_lo(z[j]));
      y[2 * j + 1] = o[2 * j + 1] * rs * nw[2 * j + 1] * silu_f(bf_hi(z[j]));
    }
    u32x4 w; w.x = pk_bf16(y[0], y[1]); w.y = pk_bf16(y[2], y[3]); w.z = pk_bf16(y[4], y[5]); w.w = pk_bf16(y[6], y[7]);
    *(u32x4*)ptr = w;
  }
}

DI void phase4(const Params& p, int wvs, unsigned char* smem) {
  const int xcd = blockIdx.x & 7, lb = blockIdx.x >> 3, nlb = gridDim.x >> 3;
  const u16* h = (const u16*)(p.ws + OFF_H);
  const u16* wat = (const u16*)(p.ws + OFF_WAT);
  const u16* wbt = (const u16*)(p.ws + OFF_WBT);
  u16* mg = (u16*)(p.ws + OFF_SC);
  const int tid0 = opaque_tid(); const int lane = tid0 & 63, wv = tid0 >> 6, wm = wv >> 1, wn = wv & 1, r16 = lane & 15, g = lane >> 4;
  for (int li = lb;; li += nlb) {
    int mt, nt; if (!tile_of(li, 8, xcd, mt, nt)) break;
    f32x4 acc[4][4]; zero_acc(acc);
    gemm_kloop(p, wvs, h, NC, wat, 512, 8, mt * 128, nt * 128, acc, smem);
#pragma unroll
    for (int mi = 0; mi < 4; ++mi) {
      const int row = mt * 128 + wm * 64 + mi * 16 + r16;
#pragma unroll
      for (int ni = 0; ni < 4; ++ni) {
        const int col = nt * 128 + wn * 64 + ni * 16 + 4 * g;
        const u32x2 ga = *(const u32x2*)(h + (size_t)row * NC + C_GA + col), gb = *(const u32x2*)(h + (size_t)row * NC + C_GB + col);
        acc[mi][ni][0] *= (1.f + __expf(-bf_lo(gb.x))) / (1.f + __expf(-bf_lo(ga.x)));
        acc[mi][ni][1] *= (1.f + __expf(-bf_hi(gb.x))) / (1.f + __expf(-bf_hi(ga.x)));
        acc[mi][ni][2] *= (1.f + __expf(-bf_lo(gb.y))) / (1.f + __expf(-bf_lo(ga.y)));
        acc[mi][ni][3] *= (1.f + __expf(-bf_hi(gb.y))) / (1.f + __expf(-bf_hi(ga.y)));
      }
      __builtin_amdgcn_sched_barrier(0);
    }
    gemm_kloop(p, wvs, h + C_SWQ, NC, wbt, 512, 8, mt * 128, nt * 128, acc, smem);
#pragma unroll
    for (int mi = 0; mi < 4; ++mi) {
      const int row = mt * 128 + wm * 64 + mi * 16 + r16;
#pragma unroll
      for (int ni = 0; ni < 4; ++ni) {
        const int col = nt * 128 + wn * 64 + ni * 16 + 4 * g;
        const u32x2 gb = *(const u32x2*)(h + (size_t)row * NC + C_GB + col);
        u32x2 w;
        w.x = pk_bf16(acc[mi][ni][0] * sigmoid_f(bf_lo(gb.x)), acc[mi][ni][1] * sigmoid_f(bf_hi(gb.x)));
        w.y = pk_bf16(acc[mi][ni][2] * sigmoid_f(bf_lo(gb.y)), acc[mi][ni][3] * sigmoid_f(bf_hi(gb.y)));
        *(u32x2*)(mg + (size_t)row * 1024 + col) = w;
      }
      __builtin_amdgcn_sched_barrier(0);
    }
  }
}

DI void phase5(const Params& p, int wvs, unsigned char* smem) {
  const int xcd = blockIdx.x & 7, lb = blockIdx.x >> 3, nlb = gridDim.x >> 3;
  const u16* mg = (const u16*)(p.ws + OFF_SC);
  const u16* wot = (const u16*)(p.ws + OFF_WOT);
  const int tid0 = opaque_tid(); const int lane = tid0 & 63, wv = tid0 >> 6, wm = wv >> 1, wn = wv & 1, r16 = lane & 15, g = lane >> 4;
  for (int li = lb;; li += nlb) {
    int mt, nt; if (!tile_of(li, 8, xcd, mt, nt)) break;
    f32x4 acc[4][4]; zero_acc(acc);
    gemm_kloop(p, wvs, mg, 1024, wot, 1024, 16, mt * 128, nt * 128, acc, smem);
#pragma unroll
    for (int mi = 0; mi < 4; ++mi) {
      const int row = mt * 128 + wm * 64 + mi * 16 + r16;
#pragma unroll
      for (int ni = 0; ni < 4; ++ni) {
        const int col = nt * 128 + wn * 64 + ni * 16 + 4 * g;
        const f32x4 xv = *(const f32x4*)(p.x + (size_t)row * 1024 + col);
        *(f32x4*)(p.out + (size_t)row * 1024 + col) = xv * 1.189207115002721f + acc[mi][ni];
      }
    }
  }
}

DI void phase6(const Params& p, int wvs, unsigned char* smem) {
  float* red = (float*)smem;
  const int tid = opaque_tid();
  const float4 gm = ((const float4*)p.ln_g)[tid], bt = ((const float4*)p.ln_b)[tid];
  __syncthreads();
  for (int r = blockIdx.x; r < T_TOK; r += gridDim.x) {
    float4* ptr = (float4*)(p.out + (size_t)r * 1024) + tid;
    const float4 v = *ptr;
    float s = v.x + v.y + v.z + v.w;
#pragma unroll
    for (int o = 32; o > 0; o >>= 1) s += __shfl_xor(s, o);
    if ((tid & 63) == 0) red[tid >> 6] = s;
    __syncthreads();
    const float mu = (red[0] + red[1] + red[2] + red[3]) * (1.0f / 1024.0f);
    const float a = v.x - mu, b = v.y - mu, c = v.z - mu, d = v.w - mu;
    float q = a * a + b * b + c * c + d * d;
#pragma unroll
    for (int o = 32; o > 0; o >>= 1) q += __shfl_xor(q, o);
    if ((tid & 63) == 0) red[4 + (tid >> 6)] = q;
    __syncthreads();
    const float rs = rsqrtf((red[4] + red[5] + red[6] + red[7]) * (1.0f / 1024.0f) + 1e-5f);
    float4 o; o.x = a * rs * gm.x + bt.x; o.y = b * rs * gm.y + bt.y; o.z = c * rs * gm.z + bt.z; o.w = d * rs * gm.w + bt.w;
    *ptr = o;
    __syncthreads();
  }
}

#define XB_TMO      128
#define XB_XCNT(j)  (256  + 64 * (j))
#define XB_XSUB(j)  (1280 + 64 * (j))
#define XB_XGEN(j)  (2304 + 64 * (j))
#define XB_TOP      3328
#define XB_TOPGEN   3392
#define XCD_BAR_WORDS 3456
#define XB_SPIN_CAP (1u << 22)
#define LAS __attribute__((address_space(3)))
DI unsigned xb_ld(unsigned* p) { return __hip_atomic_load(p, __ATOMIC_RELAXED, __HIP_MEMORY_SCOPE_AGENT); }
DI unsigned xb_add(unsigned* p, unsigned v) { return __hip_atomic_fetch_add(p, v, __ATOMIC_RELAXED, __HIP_MEMORY_SCOPE_AGENT); }
DI unsigned xb_xcc_id() { return (unsigned)__builtin_amdgcn_s_getreg((3 << 11) | 20) & 0xFu; }
#define XB_SPIN(cond, bar) do { unsigned _sp = 0; while (cond) { __builtin_amdgcn_s_sleep(1); \
    if ((++_sp & 255u) == 0u) { if (xb_ld(&(bar)[XB_TMO])) break; if (_sp > XB_SPIN_CAP) { atomicAdd(&(bar)[XB_TMO], 1u); break; } } } } while (0)
struct XcdBarrier { unsigned* bar; unsigned x; volatile LAS unsigned* st; };
DI XcdBarrier xcd_barrier_post(unsigned* bar, volatile LAS unsigned* st) {
  XcdBarrier b; b.bar = bar; b.x = xb_xcc_id(); b.st = st;
  if (threadIdx.x == 0) (void)xb_add(&bar[XB_XCNT(b.x)], 1u);
  return b;
}
DI void xcd_barrier_complete(unsigned* bar, unsigned x, unsigned& nloc, unsigned& nx) {
  const unsigned G = gridDim.x * gridDim.y * gridDim.z;
  unsigned sum, cnt, mine, sp = 0u;
  for (;;) {
    sum = 0u; cnt = 0u; mine = 0u;
#pragma unroll
    for (unsigned j = 0; j < 16; ++j) { const unsigned c = xb_ld(&bar[XB_XCNT(j)]); sum += c; cnt += (c > 0u) ? 1u : 0u; mine = (j == x) ? c : mine; }
    if (sum == G) break;
    __builtin_amdgcn_s_sleep(1);
    if ((++sp & 255u) == 0u) { if (xb_ld(&bar[XB_TMO])) break; if (sp > XB_SPIN_CAP) { atomicAdd(&bar[XB_TMO], 1u); break; } }
  }
  nloc = mine > 0u ? mine : 1u; nx = cnt > 0u ? cnt : 1u;
}
DI void xcd_barrier(const XcdBarrier& b) {
  asm volatile("s_waitcnt vmcnt(0)" ::: "memory");
  __syncthreads();
  if (threadIdx.x == 0) {
    unsigned* bar = b.bar;
    __builtin_amdgcn_s_waitcnt(0);
    unsigned nloc = b.st[0], nx = b.st[1];
    if (nloc == 0u) { xcd_barrier_complete(bar, b.x, nloc, nx); b.st[0] = nloc; b.st[1] = nx; }
    const unsigned old = xb_add(&bar[XB_XSUB(b.x)], 1u);
    const unsigned gen = old / nloc;
    if (old + 1u == (gen + 1u) * nloc) {
      __builtin_amdgcn_fence(__ATOMIC_RELEASE, "agent");
      asm volatile("s_waitcnt vmcnt(0)" ::: "memory");
      const unsigned og = xb_add(&bar[XB_TOP], 1u);
      const unsigned tg = og / nx;
      if (og + 1u == (tg + 1u) * nx) xb_add(&bar[XB_TOPGEN], 1u);
      else XB_SPIN(xb_ld(&bar[XB_TOPGEN]) == tg, bar);
      __builtin_amdgcn_fence(__ATOMIC_ACQUIRE, "agent");
      xb_add(&bar[XB_XGEN(b.x)], 1u);
      asm volatile("s_waitcnt vmcnt(0)" ::: "memory");
    } else {
      XB_SPIN(xb_ld(&bar[XB_XGEN(b.x)]) == gen, bar);
      __builtin_amdgcn_fence(__ATOMIC_ACQUIRE, "agent");
      asm volatile("s_waitcnt vmcnt(0)" ::: "memory");
    }
  }
  __syncthreads();
}

#ifndef MK_MULTI
#define MK_MULTI 0
#endif
#define SMEM_DECL __shared__ __attribute__((aligned(16))) unsigned char smem[SMEM_BYTES]; const int wvs = __builtin_amdgcn_readfirstlane((int)(threadIdx.x >> 6));
#if MK_MULTI
__global__ void __launch_bounds__(256, 2) k_p0(Params p) { SMEM_DECL (void)smem; phase0(p, wvs); }
__global__ void __launch_bounds__(256, 2) k_p1(Params p) { SMEM_DECL phase1(p, wvs, smem); }
__global__ void __launch_bounds__(256, 2) k_p2(Params p) { SMEM_DECL for (int it = blockIdx.x; it < 2048; it += gridDim.x) prep_item(p, wvs, it, smem); }
__global__ void __launch_bounds__(256, 2) k_p3(Params p) { SMEM_DECL
  if (blockIdx.x < 128) scan_chain(p, wvs, blockIdx.x, smem);
  else for (int it = blockIdx.x - 128; it < 1024; it += gridDim.x - 128) swa_item(p, wvs, it, smem); }
__global__ void __launch_bounds__(256, 2) k_p3b(Params p) { SMEM_DECL (void)smem; phase_ya(p, wvs); }
__global__ void __launch_bounds__(256, 2) k_p4(Params p) { SMEM_DECL phase4(p, wvs, smem); }
__global__ void __launch_bounds__(256, 2) k_p5(Params p) { SMEM_DECL phase5(p, wvs, smem); }
__global__ void __launch_bounds__(256, 2) k_p6(Params p) { SMEM_DECL phase6(p, wvs, smem); }
#else
__global__ void __launch_bounds__(256, 2) fwd_megakernel(Params p) {
  cg::grid_group grid = cg::this_grid();
  SMEM_DECL
  volatile LAS unsigned* st = (volatile LAS unsigned*)(smem + SMEM_BYTES - 16);
  if (threadIdx.x < 4) st[threadIdx.x] = 0u;
  __syncthreads();
  const XcdBarrier xb = xcd_barrier_post((unsigned*)(p.ws + OFF_BAR), st);
  phase0(p, wvs);
  grid.sync();
  phase1(p, wvs, smem);
  xcd_barrier(xb);
  for (int it = blockIdx.x; it < 2048; it += gridDim.x) prep_item(p, wvs, it, smem);
  xcd_barrier(xb);
  if (blockIdx.x < 128) scan_chain(p, wvs, blockIdx.x, smem);
  else for (int it = blockIdx.x - 128; it < 1024; it += gridDim.x - 128) swa_item(p, wvs, it, smem);
  xcd_barrier(xb);
  phase_ya(p, wvs);
  xcd_barrier(xb);
  phase4(p, wvs, smem);
  xcd_barrier(xb);
  phase5(p, wvs, smem);
  xcd_barrier(xb);
  phase6(p, wvs, smem);
}
#endif

extern "C" void kernel_launch(void* const* d_in, const int* in_sizes, int n_in, void* d_out, int out_size,
                              void* d_ws, size_t ws_size, hipStream_t stream) {
  if (ws_size < WS_NEED) { fprintf(stderr, "workspace too small: %zu < %zu\n", ws_size, (size_t)WS_NEED); return; }
  Params p{};
  p.x = (const float*)d_in[0]; p.w_in = (const float*)d_in[1]; p.conv_w = (const float*)d_in[2]; p.a_log = (const float*)d_in[3];
  p.dt_bias = (const float*)d_in[4]; p.dn_norm_w = (const float*)d_in[5]; p.sinks = (const float*)d_in[6];
  p.w_branch = (const float*)d_in[7]; p.w_out = (const float*)d_in[8]; p.ln_g = (const float*)d_in[9]; p.ln_b = (const float*)d_in[10];
  p.out = (float*)d_out; p.ws = (unsigned char*)d_ws;
  for (int i = 0; i < 8; ++i) p.inv_freq[i] = (float)std::pow(500000.0, -(double)i / 8.0);
#if MK_MULTI
  const dim3 g(512), b(256);
  k_p0<<<g, b, 0, stream>>>(p);
  k_p1<<<g, b, 0, stream>>>(p);
  k_p2<<<g, b, 0, stream>>>(p);
  k_p3<<<g, b, 0, stream>>>(p);
  k_p3b<<<g, b, 0, stream>>>(p);
  k_p4<<<g, b, 0, stream>>>(p);
  k_p5<<<g, b, 0, stream>>>(p);
  k_p6<<<g, b, 0, stream>>>(p);
#else
  static int grid_blocks = 0;
  if (!grid_blocks) {
    int dev = 0, cus = 0, per_cu = 0;
    (void)hipGetDevice(&dev);
    (void)hipDeviceGetAttribute(&cus, hipDeviceAttributeMultiprocessorCount, dev);
    (void)hipOccupancyMaxActiveBlocksPerMultiprocessor(&per_cu, fwd_megakernel, 256, 0);
    if (per_cu > 2) per_cu = 2;
    if (per_cu < 1) per_cu = 1;
    grid_blocks = cus * per_cu;
    grid_blocks &= ~7;
  }
  (void)hipMemsetAsync(p.ws + OFF_BAR, 0, BAR_BYTES, stream);
  void* args[] = {&p};
  hipError_t e = hipLaunchCooperativeKernel((void*)fwd_megakernel, dim3(grid_blocks), dim3(256), args, 0, stream);
  if (e != hipSuccess) fprintf(stderr, "cooperative launch failed: %s (grid %d)\n", hipGetErrorString(e), grid_blocks);
#endif
}
```

```cpp
#include <hip/hip_runtime.h>
#include <hip/hip_cooperative_groups.h>
#include <cstdio>
#include <cmath>
namespace cg = cooperative_groups;

typedef unsigned short u16;
typedef short bf16x8 __attribute__((ext_vector_type(8)));
typedef float f32x4 __attribute__((ext_vector_type(4)));
typedef unsigned u32x4 __attribute__((ext_vector_type(4)));
typedef unsigned u32x2 __attribute__((ext_vector_type(2)));
#define DI __device__ __forceinline__
DI int opaque_tid_(int wave_s) { int t = (int)__builtin_amdgcn_mbcnt_hi(~0u, __builtin_amdgcn_mbcnt_lo(~0u, 0u)) + (wave_s << 6); asm volatile("" : "+v"(t)); return t; }
#define opaque_tid() opaque_tid_(wvs)

constexpr int T_TOK = 32768, SEQ = 8192, DM = 1024, NC = 5384, NCP = 5504;
constexpr int C_DNZ = 1536, C_SWQ = 2056, C_SWK = 2568, C_SWV = 2696, C_SWZ = 2824, C_GA = 3336, C_GB = 4360;
constexpr size_t OFF_BAR = 0;
constexpr size_t BAR_BYTES = 16384;
constexpr size_t OFF_WINT = BAR_BYTES;
constexpr size_t OFF_WAT = OFF_WINT + (size_t)NCP * 1024 * 2;
constexpr size_t OFF_WBT = OFF_WAT + 1024 * 512 * 2;
constexpr size_t OFF_WOT = OFF_WBT + 1024 * 512 * 2;
constexpr size_t OFF_ROPE = OFF_WOT + 1024 * 1024 * 2;
constexpr size_t OFF_HB = OFF_ROPE + 2 * 8192 * 8 * 4;
constexpr size_t OFF_DEC = OFF_HB + (size_t)T_TOK * 8 * 4;
constexpr size_t OFF_H = OFF_DEC + 2048 * 4;
constexpr size_t OFF_SC = OFF_H + (size_t)T_TOK * NC * 2;
constexpr size_t OPB = 73728;
constexpr size_t WS_NEED = OFF_SC + 2048 * OPB;
constexpr int SMEM_BYTES = 73728;

struct Params {
  const float *x, *w_in, *conv_w, *a_log, *dt_bias, *dn_norm_w, *sinks, *w_branch, *w_out, *ln_g, *ln_b;
  float* out; unsigned char* ws;
  float inv_freq[8];
};

typedef __bf16 bf16x2_t __attribute__((ext_vector_type(2)));
typedef float f32x2_t __attribute__((ext_vector_type(2)));
DI unsigned pk_bf16(float lo, float hi) { f32x2_t f = {lo, hi}; bf16x2_t v = __builtin_convertvector(f, bf16x2_t); return __builtin_bit_cast(unsigned, v); }
DI float bf_lo(unsigned u) { return __uint_as_float(u << 16); }
DI float bf_hi(unsigned u) { return __uint_as_float(u & 0xffff0000u); }
DI float bf2f(u16 v) { return __uint_as_float(((unsigned)v) << 16); }
DI u16 f2bf(float f) { return (u16)(pk_bf16(f, f) & 0xffffu); }
DI float silu_f(float y) { return y / (1.0f + __expf(-y)); }
DI float sigmoid_f(float y) { return 1.0f / (1.0f + __expf(-y)); }
DI f32x4 mfma16(bf16x8 a, bf16x8 b, f32x4 c) { return __builtin_amdgcn_mfma_f32_16x16x32_bf16(a, b, c, 0, 0, 0); }
DI bf16x8 as_bf8(u32x4 v) { return __builtin_bit_cast(bf16x8, v); }
DI bf16x8 pack8(f32x4 a, f32x4 b) { u32x4 w; w.x = pk_bf16(a[0], a[1]); w.y = pk_bf16(a[2], a[3]); w.z = pk_bf16(b[0], b[1]); w.w = pk_bf16(b[2], b[3]); return as_bf8(w); }

DI void phase0(const Params& p, int wvs) {
  const size_t gt = (size_t)blockIdx.x * 256 + opaque_tid(), gs = (size_t)gridDim.x * 256;
  {
    u32x4* xb = (u32x4*)(p.ws + OFF_SC);
    const float4* xs = (const float4*)p.x;
    for (size_t i = gt; i < (size_t)T_TOK * DM / 8; i += gs) {
      const float4 a = xs[2 * i], b = xs[2 * i + 1];
      u32x4 w; w.x = pk_bf16(a.x, a.y); w.y = pk_bf16(a.z, a.w); w.z = pk_bf16(b.x, b.y); w.w = pk_bf16(b.z, b.w);
      xb[i] = w;
    }
  }
  {
    u32x4* wt = (u32x4*)(p.ws + OFF_WINT);
    for (size_t i = gt; i < (size_t)NCP * 128; i += gs) {
      const int kc = (int)(i / NCP), n = (int)(i % NCP);
      float v[8];
#pragma unroll
      for (int j = 0; j < 8; ++j) v[j] = (n < NC) ? p.w_in[(size_t)(kc * 8 + j) * NC + n] : 0.f;
      u32x4 w; w.x = pk_bf16(v[0], v[1]); w.y = pk_bf16(v[2], v[3]); w.z = pk_bf16(v[4], v[5]); w.w = pk_bf16(v[6], v[7]);
      wt[(size_t)n * 128 + kc] = w;
    }
  }
  {
    for (size_t i = gt; i < (size_t)2 * 1024 * 64; i += gs) {
      const int br = (int)(i / (1024 * 64)), rem = (int)(i % (1024 * 64)), kc = rem / 1024, n = rem % 1024;
      const float* src = p.w_branch + (size_t)br * 512 * 1024;
      float v[8];
#pragma unroll
      for (int j = 0; j < 8; ++j) v[j] = src[(size_t)(kc * 8 + j) * 1024 + n];
      u32x4 w; w.x = pk_bf16(v[0], v[1]); w.y = pk_bf16(v[2], v[3]); w.z = pk_bf16(v[4], v[5]); w.w = pk_bf16(v[6], v[7]);
      ((u32x4*)(p.ws + (br ? OFF_WBT : OFF_WAT)))[(size_t)n * 64 + kc] = w;
    }
  }
  {
    for (size_t i = gt; i < (size_t)1024 * 128; i += gs) {
      const int kc = (int)(i / 1024), n = (int)(i % 1024);
      float v[8];
#pragma unroll
      for (int j = 0; j < 8; ++j) v[j] = p.w_out[(size_t)(kc * 8 + j) * 1024 + n];
      u32x4 w; w.x = pk_bf16(v[0], v[1]); w.y = pk_bf16(v[2], v[3]); w.z = pk_bf16(v[4], v[5]); w.w = pk_bf16(v[6], v[7]);
      ((u32x4*)(p.ws + OFF_WOT))[(size_t)n * 128 + kc] = w;
    }
  }
  {
    float* rc = (float*)(p.ws + OFF_ROPE); float* rs = rc + 8192 * 8;
    for (size_t i = gt; i < 8192 * 8; i += gs) {
      const int t = (int)(i >> 3), f = (int)(i & 7);
      const float ang = (float)t * p.inv_freq[f];
      const double a = (double)ang;
      const double k = __builtin_rint(a * 0.15915494309189535);
      const float r = (float)(a - k * 6.283185307179586);
      rc[i] = cosf(r); rs[i] = sinf(r);
    }
  }
}

DI int lds_off(int row, int chunk) { return row * 128 + ((chunk ^ (row & 7)) << 4); }

DI void gemm_kloop(const Params& p, int wvs, const u16* __restrict__ A, int lda, const u16* __restrict__ Bt, int ldb, int nk, int m0, int n0,
                   f32x4 (&acc)[4][4], unsigned char* smem) {
  const int tid = opaque_tid(), lane = tid & 63, wv = tid >> 6, wm = wv >> 1, wn = wv & 1, r16 = lane & 15, g = lane >> 4;
  const int lrow = tid >> 3, lc = (tid & 7) ^ (lrow & 7);
  const u16* ap = A + (size_t)(m0 + lrow) * lda + lc * 8;
  const u16* bp = Bt + (size_t)(n0 + lrow) * ldb + lc * 8;
  unsigned char* lbase = smem + wv * 1024;
#pragma unroll
  for (int i = 0; i < 4; ++i) {
    __builtin_amdgcn_global_load_lds((const unsigned*)(ap + (size_t)(32 * i) * lda), (unsigned*)(lbase + i * 4096), 16, 0, 0);
    __builtin_amdgcn_global_load_lds((const unsigned*)(bp + (size_t)(32 * i) * ldb), (unsigned*)(lbase + 16384 + i * 4096), 16, 0, 0);
  }
  asm volatile("s_waitcnt vmcnt(0)" ::: "memory");
  __syncthreads();
  for (int kt = 0; kt < nk; ++kt) {
    unsigned char* cur = smem + (kt & 1) * 32768;
    unsigned char* nxt = lbase + ((kt + 1) & 1) * 32768;
    if (kt + 1 < nk) {
#pragma unroll
      for (int i = 0; i < 4; ++i) {
        __builtin_amdgcn_global_load_lds((const unsigned*)(ap + (size_t)(32 * i) * lda + (kt + 1) * 64), (unsigned*)(nxt + i * 4096), 16, 0, 0);
        __builtin_amdgcn_global_load_lds((const unsigned*)(bp + (size_t)(32 * i) * ldb + (kt + 1) * 64), (unsigned*)(nxt + 16384 + i * 4096), 16, 0, 0);
      }
    }
#pragma unroll
    for (int ks = 0; ks < 2; ++ks) {
      bf16x8 af[4], bfr[4];
#pragma unroll
      for (int i = 0; i < 4; ++i) {
        af[i] = *(const bf16x8*)(cur + lds_off(wm * 64 + i * 16 + r16, ks * 4 + g));
        bfr[i] = *(const bf16x8*)(cur + 16384 + lds_off(wn * 64 + i * 16 + r16, ks * 4 + g));
      }
#pragma unroll
      for (int mi = 0; mi < 4; ++mi)
#pragma unroll
        for (int ni = 0; ni < 4; ++ni) acc[mi][ni] = mfma16(bfr[ni], af[mi], acc[mi][ni]);
    }
    asm volatile("s_waitcnt vmcnt(0)" ::: "memory");
    __syncthreads();
  }
}

DI bool tile_of(int li, int ntn, int xcd, int& mt, int& nt) {
  if (li >= 32 * ntn) return false;
  const int grp = li / (4 * ntn), rem = li % (4 * ntn);
  nt = rem >> 2; mt = 32 * xcd + grp * 4 + (rem & 3);
  return true;
}

DI void zero_acc(f32x4 (&acc)[4][4]) {
#pragma unroll
  for (int i = 0; i < 4; ++i)
#pragma unroll
    for (int j = 0; j < 4; ++j) acc[i][j] = (f32x4){0.f, 0.f, 0.f, 0.f};
}

DI void phase1(const Params& p, int wvs, unsigned char* smem) {
  const int xcd = blockIdx.x & 7, lb = blockIdx.x >> 3, nlb = gridDim.x >> 3;
  const u16* xb = (const u16*)(p.ws + OFF_SC);
  const u16* wint = (const u16*)(p.ws + OFF_WINT);
  u16* h = (u16*)(p.ws + OFF_H);
  float* hb = (float*)(p.ws + OFF_HB);
  const int tid0 = opaque_tid(); const int lane = tid0 & 63, wv = tid0 >> 6, wm = wv >> 1, wn = wv & 1, r16 = lane & 15, g = lane >> 4;
  for (int li = lb;; li += nlb) {
    int mt, nt; if (!tile_of(li, 43, xcd, mt, nt)) break;
    f32x4 acc[4][4]; zero_acc(acc);
    gemm_kloop(p, wvs, xb, 1024, wint, 1024, 16, mt * 128, nt * 128, acc, smem);
#pragma unroll
    for (int mi = 0; mi < 4; ++mi) {
      const int row = mt * 128 + wm * 64 + mi * 16 + r16;
#pragma unroll
      for (int ni = 0; ni < 4; ++ni) {
        const int col = nt * 128 + wn * 64 + ni * 16 + 4 * g;
        if (col < NC) {
          u32x2 w; w.x = pk_bf16(acc[mi][ni][0], acc[mi][ni][1]); w.y = pk_bf16(acc[mi][ni][2], acc[mi][ni][3]);
          *(u32x2*)(h + (size_t)row * NC + col) = w;
          if (col >= 2048 && col < 2056) *(f32x4*)(hb + (size_t)row * 8 + (col - 2048)) = acc[mi][ni];
        }
      }
    }
  }
}

template <int I, int M4> DI void solve_part(const float (&xv)[64], const float* Lrow, float& a) {
  if constexpr (4 * M4 < I) {
    const f32x4 l = *(const f32x4*)(Lrow + 4 * M4);
    if constexpr (4 * M4 + 0 < I) a -= l[0] * xv[4 * M4 + 0];
    if constexpr (4 * M4 + 1 < I) a -= l[1] * xv[4 * M4 + 1];
    if constexpr (4 * M4 + 2 < I) a -= l[2] * xv[4 * M4 + 2];
    if constexpr (4 * M4 + 3 < I) a -= l[3] * xv[4 * M4 + 3];
    solve_part<I, M4 + 1>(xv, Lrow, a);
  }
}
template <int I> DI void solve_rows(float (&xv)[64], const float* Lm) {
  if constexpr (I < 64) {
    float a = xv[I];
    solve_part<I, 0>(xv, Lm + I * 68, a);
    xv[I] = a;
    __builtin_amdgcn_sched_barrier(0);
    solve_rows<I + 1>(xv, Lm);
  }
}

DI void prep_item(const Params& p, int wvs, int item, unsigned char* smem) {
  const int tid_ = opaque_tid();
  const int tid = tid_, lane = tid & 63, wv = tid >> 6, r16 = lane & 15, g = lane >> 4;
  const int hd = item & 3, n = (item >> 2) & 127, b = item >> 9;
  const int t0 = b * SEQ + n * 64;
  u16* Qs = (u16*)smem; u16* Ks = Qs + 64 * 136; u16* Vs = Ks + 64 * 136;
  float* Lm = (float*)(smem + 52224);
  float* sm_beta = (float*)(smem + 69632);
  float* sm_gc = sm_beta + 64; float* sm_rq = sm_gc + 64; float* sm_rk = sm_rq + 64;
  float* sm_fw = sm_rk + 64; float* sm_fq = sm_fw + 64; float* sm_fk = sm_fq + 64;
  const u16* h = (const u16*)(p.ws + OFF_H);
  const float* hb = (const float*)(p.ws + OFF_HB);
  unsigned char* op = p.ws + OFF_SC + (size_t)item * OPB;
  __syncthreads();
  {
    const int c2 = tid & 63, rbase = (tid >> 6) * 16;
#pragma unroll 1
    for (int mat = 0; mat < 3; ++mat) {
      const int col = mat * 512 + hd * 128 + 2 * c2;
      float wa[4], wb[4];
#pragma unroll
      for (int j = 0; j < 4; ++j) { wa[j] = p.conv_w[j * 1536 + col]; wb[j] = p.conv_w[j * 1536 + col + 1]; }
      float xa[3], xb[3];
#pragma unroll
      for (int j = 0; j < 3; ++j) {
        const int pos = n * 64 + rbase - 3 + j;
        unsigned v = 0;
        if (pos >= 0) v = *(const unsigned*)(h + (size_t)(t0 + rbase - 3 + j) * NC + col);
        xa[j] = bf_lo(v); xb[j] = bf_hi(v);
      }
      u16* dst = (mat == 0 ? Qs : (mat == 1 ? Ks : Vs));
#pragma unroll
      for (int i = 0; i < 16; ++i) {
        const unsigned v = *(const unsigned*)(h + (size_t)(t0 + rbase + i) * NC + col);
        const float a3 = bf_lo(v), b3 = bf_hi(v);
        const float ya = wa[0] * xa[0] + wa[1] * xa[1] + wa[2] * xa[2] + wa[3] * a3;
        const float yb = wb[0] * xb[0] + wb[1] * xb[1] + wb[2] * xb[2] + wb[3] * b3;
        xa[0] = xa[1]; xa[1] = xa[2]; xa[2] = a3; xb[0] = xb[1]; xb[1] = xb[2]; xb[2] = b3;
        *(unsigned*)(dst + (rbase + i) * 136 + 2 * c2) = pk_bf16(silu_f(ya), silu_f(yb));
      }
    }
  }
  __syncthreads();
  if (wv == 0) {
    const int row = t0 + lane;
    const float bl = hb[(size_t)row * 8 + hd], al = hb[(size_t)row * 8 + 4 + hd];
    const float xx = al + p.dt_bias[hd];
    const float sp = xx > 20.f ? xx : log1pf(expf(xx));
    float gg = -expf(p.a_log[hd]) * sp;
#pragma unroll
    for (int o = 1; o < 64; o <<= 1) { const float t = __shfl_up(gg, o); if (lane >= o) gg += t; }
    sm_beta[lane] = 1.0f / (1.0f + expf(-bl)); sm_gc[lane] = gg;
  } else if (wv <= 2) {
    const int r = tid - 64;
    const u16* src = (r < 64) ? (Qs + r * 136) : (Ks + (r - 64) * 136);
    float ss = 0.f;
#pragma unroll
    for (int c = 0; c < 16; ++c) {
      const u32x4 v = *(const u32x4*)(src + c * 8);
#pragma unroll
      for (int j = 0; j < 4; ++j) { const float a = bf_lo(v[j]), bb = bf_hi(v[j]); ss += a * a + bb * bb; }
    }
    const float rs = rsqrtf(ss + 1e-6f);
    if (r < 64) sm_rq[r] = rs; else sm_rk[r - 64] = rs;
  }
  __syncthreads();
  if (tid < 64) {
    const float gc = sm_gc[tid], gl = sm_gc[63], eg = expf(gc);
    sm_fw[tid] = sm_beta[tid] * eg * sm_rk[tid];
    sm_fq[tid] = sm_rq[tid] * 0.08838834764831845f * eg;
    sm_fk[tid] = sm_rk[tid] * expf(gl - gc);
    if (tid == 0) ((float*)(p.ws + OFF_DEC))[item] = expf(gl);
  }
  {
    bf16x8 kfi[4], qfi[4];
#pragma unroll
    for (int s = 0; s < 4; ++s) {
      kfi[s] = *(const bf16x8*)(Ks + (16 * wv + r16) * 136 + 32 * s + 8 * g);
      qfi[s] = *(const bf16x8*)(Qs + (16 * wv + r16) * 136 + 32 * s + 8 * g);
    }
    f32x4 at[4];
#pragma unroll
    for (int jt = 0; jt < 4; ++jt) {
      at[jt] = (f32x4){0.f, 0.f, 0.f, 0.f};
      if (jt <= wv) {
        f32x4 la = (f32x4){0.f, 0.f, 0.f, 0.f}, aa = (f32x4){0.f, 0.f, 0.f, 0.f};
#pragma unroll
        for (int s = 0; s < 4; ++s) {
          const bf16x8 kfj = *(const bf16x8*)(Ks + (16 * jt + r16) * 136 + 32 * s + 8 * g);
          la = mfma16(kfi[s], kfj, la);
          aa = mfma16(kfj, qfi[s], aa);
        }
#pragma unroll
        for (int r = 0; r < 4; ++r) {
          { const int i = 16 * wv + 4 * g + r, j = 16 * jt + r16;
            const float v = (i > j) ? sm_beta[i] * sm_rk[i] * sm_rk[j] * __expf(sm_gc[i] - sm_gc[j]) * la[r] : 0.f;
            Lm[i * 68 + j] = v; }
          { const int j = 16 * jt + 4 * g + r, i = 16 * wv + r16;
            at[jt][r] = (j <= i) ? sm_rq[i] * sm_rk[j] * 0.08838834764831845f * __expf(sm_gc[i] - sm_gc[j]) * aa[r] : 0.f; }
        }
      }
    }
#pragma unroll
    for (int s2 = 0; s2 < 2; ++s2)
      *(bf16x8*)(op + 32768 + (size_t)((wv * 2 + s2) * 64 + lane) * 16) = pack8(at[2 * s2], at[2 * s2 + 1]);
  }
  __syncthreads();
  float xv[64];
  if (tid < 128) {
#pragma unroll
    for (int i = 0; i < 64; ++i) xv[i] = sm_beta[i] * bf2f(Vs[i * 136 + tid]);
  } else {
#pragma unroll
    for (int i = 0; i < 64; ++i) xv[i] = sm_fw[i] * bf2f(Ks[i * 136 + tid - 128]);
  }
  solve_rows<1>(xv, Lm);
  if (tid < 128) {
    const int sl = tid >> 4, dvl = tid & 15;
#pragma unroll
    for (int mt = 0; mt < 4; ++mt)
#pragma unroll
      for (int gg = 0; gg < 4; ++gg) {
        u32x2 w; w.x = pk_bf16(xv[16 * mt + 4 * gg], xv[16 * mt + 4 * gg + 1]); w.y = pk_bf16(xv[16 * mt + 4 * gg + 2], xv[16 * mt + 4 * gg + 3]);
        *(u32x2*)(op + 57344 + (size_t)((sl * 4 + mt) * 64 + gg * 16 + dvl) * 8) = w;
      }
  }
  __syncthreads();
  if (tid >= 128) {
#pragma unroll
    for (int i = 0; i < 64; ++i) Vs[i * 136 + tid - 128] = f2bf(-xv[i]);
  }
  __syncthreads();
#pragma unroll
  for (int f = 0; f < 4; ++f) {
    const int e = tid + 256 * f, frag = e >> 6, ln = e & 63, lr = ln & 15, lg = ln >> 4;
    {
      const int mt = frag >> 2, s = frag & 3, row = 16 * mt + lr;
      const u32x2 lo = *(const u32x2*)(Vs + row * 136 + 32 * s + 4 * lg), hi = *(const u32x2*)(Vs + row * 136 + 32 * s + 16 + 4 * lg);
      *(u32x4*)(op + (size_t)e * 16) = (u32x4){lo.x, lo.y, hi.x, hi.y};
      const u32x2 ql = *(const u32x2*)(Qs + row * 136 + 32 * s + 4 * lg), qh = *(const u32x2*)(Qs + row * 136 + 32 * s + 16 + 4 * lg);
      const float fq = sm_fq[row];
      u32x4 w;
      w.x = pk_bf16(bf_lo(ql.x) * fq, bf_hi(ql.x) * fq); w.y = pk_bf16(bf_lo(ql.y) * fq, bf_hi(ql.y) * fq);
      w.z = pk_bf16(bf_lo(qh.x) * fq, bf_hi(qh.x) * fq); w.w = pk_bf16(bf_lo(qh.y) * fq, bf_hi(qh.y) * fq);
      *(u32x4*)(op + 16384 + (size_t)e * 16) = w;
    }
    {
      const int mt8 = frag >> 1, s2 = frag & 1, dk = 16 * mt8 + lr;
      float v[8];
#pragma unroll
      for (int j = 0; j < 8; ++j) {
        const int pos = 32 * s2 + 16 * (j >> 2) + 4 * lg + (j & 3);
        v[j] = bf2f(Ks[pos * 136 + dk]) * sm_fk[pos];
      }
      u32x4 w; w.x = pk_bf16(v[0], v[1]); w.y = pk_bf16(v[2], v[3]); w.z = pk_bf16(v[4], v[5]); w.w = pk_bf16(v[6], v[7]);
      *(u32x4*)(op + 40960 + (size_t)e * 16) = w;
    }
  }
}

struct ScanA { u32x4 wf[4]; u32x2 uf; float dec; };
struct ScanB { u32x4 qf[4], af[2], kf[4]; };

DI void scan_load_a(const Params& p, int wvs, ScanA& o, int b, int hd, int sl, int n, int q, int lane) {
  const int item = (b * 128 + n) * 4 + hd;
  const unsigned char* op = p.ws + OFF_SC + (size_t)item * OPB;
#pragma unroll
  for (int s = 0; s < 4; ++s) {
    o.wf[s] = *(const u32x4*)(op + (size_t)((q * 4 + s) * 64 + lane) * 16);
  }
  o.uf = *(const u32x2*)(op + 57344 + (size_t)((sl * 4 + q) * 64 + lane) * 8);
  o.dec = ((const float*)(p.ws + OFF_DEC))[item];
}
DI void scan_load_b(const Params& p, int wvs, ScanB& o, int b, int hd, int n, int q, int lane) {
  const int item = (b * 128 + n) * 4 + hd;
  const unsigned char* op = p.ws + OFF_SC + (size_t)item * OPB;
#pragma unroll
  for (int s = 0; s < 4; ++s) o.qf[s] = *(const u32x4*)(op + 16384 + (size_t)((q * 4 + s) * 64 + lane) * 16);
#pragma unroll
  for (int s2 = 0; s2 < 2; ++s2) o.af[s2] = *(const u32x4*)(op + 32768 + (size_t)((q * 2 + s2) * 64 + lane) * 16);
#pragma unroll
  for (int j = 0; j < 4; ++j) o.kf[j] = *(const u32x4*)(op + 40960 + (size_t)((q * 4 + j) * 64 + lane) * 16);
}

DI void scan_step(const Params& p, int wvs, const ScanA& o, const ScanB& ob, f32x4 (&S)[2], int b, int hd, int sl, int n, int q, int lane, unsigned char* smem) {
  const int r16 = lane & 15, g = lane >> 4;
  u32x4* ldsS = (u32x4*)smem;
  u32x2* ldsV = (u32x2*)(smem + 4096);
  ldsS[q * 64 + lane] = __builtin_bit_cast(u32x4, pack8(S[0], S[1]));
  __syncthreads();
  bf16x8 Sb[4];
#pragma unroll
  for (int s = 0; s < 4; ++s) Sb[s] = as_bf8(ldsS[s * 64 + lane]);
  f32x4 vn = (f32x4){bf_lo(o.uf.x), bf_hi(o.uf.x), bf_lo(o.uf.y), bf_hi(o.uf.y)};
#pragma unroll
  for (int s = 0; s < 4; ++s) vn = mfma16(as_bf8(o.wf[s]), Sb[s], vn);
  { u32x2 w; w.x = pk_bf16(vn[0], vn[1]); w.y = pk_bf16(vn[2], vn[3]); ldsV[((q >> 1) * 64 + lane) * 2 + (q & 1)] = w; }
  f32x4 oa = (f32x4){0.f, 0.f, 0.f, 0.f};
#pragma unroll
  for (int s = 0; s < 4; ++s) oa = mfma16(as_bf8(ob.qf[s]), Sb[s], oa);
  __syncthreads();
  bf16x8 Vb[2];
#pragma unroll
  for (int s2 = 0; s2 < 2; ++s2) Vb[s2] = as_bf8(*(const u32x4*)(ldsV + (s2 * 64 + lane) * 2));
#pragma unroll
  for (int s2 = 0; s2 < 2; ++s2) oa = mfma16(as_bf8(ob.af[s2]), Vb[s2], oa);
  u16* h = (u16*)(p.ws + OFF_H);
  const int t0 = b * SEQ + n * 64;
#pragma unroll
  for (int r = 0; r < 4; ++r) h[(size_t)(t0 + 16 * q + 4 * g + r) * NC + hd * 128 + 16 * sl + r16] = f2bf(oa[r]);
#pragma unroll
  for (int t = 0; t < 2; ++t) {
    S[t] = S[t] * o.dec;
#pragma unroll
    for (int s2 = 0; s2 < 2; ++s2) S[t] = mfma16(as_bf8(ob.kf[t * 2 + s2]), Vb[s2], S[t]);
  }
}

DI void scan_chain(const Params& p, int wvs, int chain, unsigned char* smem) {
  const int tid0 = opaque_tid(); const int lane = tid0 & 63, q = tid0 >> 6;
  const int xcd = chain & 7, j = chain >> 3, pair = xcd + 8 * (j >> 3), sl = j & 7, b = pair >> 2, hd = pair & 3;
  f32x4 S[2]; S[0] = (f32x4){0.f, 0.f, 0.f, 0.f}; S[1] = S[0];
  ScanA a0, a1, a2; ScanB bc, bn;
  __syncthreads();
  scan_load_a(p, wvs, a0, b, hd, sl, 0, q, lane);
  scan_load_b(p, wvs, bc, b, hd, 0, q, lane);
  scan_load_a(p, wvs, a1, b, hd, sl, 1, q, lane);
#pragma unroll 1
  for (int n = 0; n < 129; n += 3) {
    if (n + 2 < 128) scan_load_a(p, wvs, a2, b, hd, sl, n + 2, q, lane);
    if (n + 1 < 128) scan_load_b(p, wvs, bn, b, hd, n + 1, q, lane);
    if (n < 128) scan_step(p, wvs, a0, bc, S, b, hd, sl, n, q, lane, smem);
    bc = bn;
    if (n + 3 < 128) scan_load_a(p, wvs, a0, b, hd, sl, n + 3, q, lane);
    if (n + 2 < 128) scan_load_b(p, wvs, bn, b, hd, n + 2, q, lane);
    if (n + 1 < 128) scan_step(p, wvs, a1, bc, S, b, hd, sl, n + 1, q, lane, smem);
    bc = bn;
    if (n + 4 < 128) scan_load_a(p, wvs, a1, b, hd, sl, n + 4, q, lane);
    if (n + 3 < 128) scan_load_b(p, wvs, bn, b, hd, n + 3, q, lane);
    if (n + 2 < 128) scan_step(p, wvs, a2, bc, S, b, hd, sl, n + 2, q, lane, smem);
    bc = bn;
  }
}

DI void swa_item(const Params& p, int wvs, int item, unsigned char* smem) {
  const int tid_ = opaque_tid();
  const int tid = tid_, lane = tid & 63, wv = tid >> 6, r16 = lane & 15, g = lane >> 4;
  const int qt = item & 127, kvh = (item >> 7) & 1, b = item >> 8;
  const int kp0 = 64 * qt - 128;
  u16* Ksm = (u16*)smem;
  u16* Vt = (u16*)(smem + 27648);
  u16* h = (u16*)(p.ws + OFF_H);
  const float* rc = (const float*)(p.ws + OFF_ROPE); const float* rs = rc + 8192 * 8;
  __syncthreads();
  if (tid < 192) {
    const int kk = tid, pos = kp0 + kk;
    u32x4 lo = (u32x4){0, 0, 0, 0}, hi = lo;
    if (pos >= 0) {
      const u16* src = h + (size_t)(b * SEQ + pos) * NC + C_SWK + kvh * 64;
      const u32x4 a = *(const u32x4*)src, c = *(const u32x4*)(src + 8);
      const f32x4 c0 = *(const f32x4*)(rc + pos * 8), c1 = *(const f32x4*)(rc + pos * 8 + 4);
      const f32x4 s0 = *(const f32x4*)(rs + pos * 8), s1 = *(const f32x4*)(rs + pos * 8 + 4);
      float t1[8], t2[8], cs[8], sn[8], o1[8], o2[8];
#pragma unroll
      for (int j = 0; j < 4; ++j) { t1[2 * j] = bf_lo(a[j]); t1[2 * j + 1] = bf_hi(a[j]); t2[2 * j] = bf_lo(c[j]); t2[2 * j + 1] = bf_hi(c[j]);
        cs[j] = c0[j]; cs[4 + j] = c1[j]; sn[j] = s0[j]; sn[4 + j] = s1[j]; }
#pragma unroll
      for (int j = 0; j < 8; ++j) { o1[j] = t1[j] * cs[j] - t2[j] * sn[j]; o2[j] = t2[j] * cs[j] + t1[j] * sn[j]; }
#pragma unroll
      for (int j = 0; j < 4; ++j) { lo[j] = pk_bf16(o1[2 * j], o1[2 * j + 1]); hi[j] = pk_bf16(o2[2 * j], o2[2 * j + 1]); }
    }
    *(u32x4*)(Ksm + kk * 72) = lo; *(u32x4*)(Ksm + kk * 72 + 8) = hi;
  }
  for (int e = tid; e < 192 * 6; e += 256) {
    const int kk = e / 6, ch = 2 + e % 6, pos = kp0 + kk;
    u32x4 v = (u32x4){0, 0, 0, 0};
    if (pos >= 0) v = *(const u32x4*)(h + (size_t)(b * SEQ + pos) * NC + C_SWK + kvh * 64 + ch * 8);
    *(u32x4*)(Ksm + kk * 72 + ch * 8) = v;
  }
  for (int e = tid; e < 192 * 8; e += 256) {
    const int kk = e >> 3, ch = e & 7, pos = kp0 + kk;
    u32x4 v = (u32x4){0, 0, 0, 0};
    if (pos >= 0) v = *(const u32x4*)(h + (size_t)(b * SEQ + pos) * NC + C_SWV + kvh * 64 + ch * 8);
#pragma unroll
    for (int j = 0; j < 4; ++j) { Vt[(ch * 8 + 2 * j) * 200 + kk] = (u16)(v[j] & 0xffffu); Vt[(ch * 8 + 2 * j + 1) * 200 + kk] = (u16)(v[j] >> 16); }
  }
  __syncthreads();
  const int st = wv, jt0 = st < 2 ? st : 2;
  const int qi = 16 * st + r16;
  const int qpos = 64 * qt + qi, tq = b * SEQ + qpos;
#pragma unroll 1
  for (int hq = 0; hq < 4; ++hq) {
    const int head = kvh * 4 + hq;
    u16* qsrc = h + (size_t)tq * NC + C_SWQ + head * 64;
    bf16x8 qf[2];
    {
      const u32x4 a = *(const u32x4*)qsrc, c = *(const u32x4*)(qsrc + 8);
      u32x4 w = *(const u32x4*)(qsrc + 8 * g);
      if (g < 2) {
        const f32x4 c0 = *(const f32x4*)(rc + qpos * 8), c1 = *(const f32x4*)(rc + qpos * 8 + 4);
        const f32x4 s0 = *(const f32x4*)(rs + qpos * 8), s1 = *(const f32x4*)(rs + qpos * 8 + 4);
        float t1[8], t2[8], cs[8], sn[8], o[8];
#pragma unroll
        for (int j = 0; j < 4; ++j) { t1[2 * j] = bf_lo(a[j]); t1[2 * j + 1] = bf_hi(a[j]); t2[2 * j] = bf_lo(c[j]); t2[2 * j + 1] = bf_hi(c[j]);
          cs[j] = c0[j]; cs[4 + j] = c1[j]; sn[j] = s0[j]; sn[4 + j] = s1[j]; }
#pragma unroll
        for (int j = 0; j < 8; ++j) o[j] = (g == 0) ? (t1[j] * cs[j] - t2[j] * sn[j]) : (t2[j] * cs[j] + t1[j] * sn[j]);
#pragma unroll
        for (int j = 0; j < 4; ++j) w[j] = pk_bf16(o[2 * j], o[2 * j + 1]);
      }
      qf[0] = as_bf8(w);
      qf[1] = as_bf8(*(const u32x4*)(qsrc + 32 + 8 * g));
    }
    f32x4 sc[10];
#pragma unroll
    for (int t = 0; t < 10; ++t) {
      sc[t] = (f32x4){0.f, 0.f, 0.f, 0.f};
#pragma unroll
      for (int s = 0; s < 2; ++s) {
        const bf16x8 kf = *(const bf16x8*)(Ksm + (16 * (jt0 + t) + r16) * 72 + 32 * s + 8 * g);
        sc[t] = mfma16(kf, qf[s], sc[t]);
      }
    }
    const float sink = p.sinks[head];
    float mx = sink;
#pragma unroll
    for (int t = 0; t < 10; ++t)
#pragma unroll
      for (int r = 0; r < 4; ++r) {
        const int kk = 16 * (jt0 + t) + 4 * g + r, d = kk - qi;
        const bool ok = (d >= 1) && (d <= 128) && (kp0 + kk >= 0);
        const float v = ok ? sc[t][r] * 0.125f : -1e30f;
        sc[t][r] = v; mx = fmaxf(mx, v);
      }
    mx = fmaxf(mx, __shfl_xor(mx, 16)); mx = fmaxf(mx, __shfl_xor(mx, 32));
    float sum = 0.f;
#pragma unroll
    for (int t = 0; t < 10; ++t)
#pragma unroll
      for (int r = 0; r < 4; ++r) { const float e = __expf(sc[t][r] - mx); sc[t][r] = e; sum += e; }
    sum += __shfl_xor(sum, 16); sum += __shfl_xor(sum, 32);
    const float inv = 1.0f / (sum + __expf(sink - mx));
    f32x4 oacc[4];
#pragma unroll
    for (int dt = 0; dt < 4; ++dt) oacc[dt] = (f32x4){0.f, 0.f, 0.f, 0.f};
#pragma unroll
    for (int s2 = 0; s2 < 5; ++s2) {
      const bf16x8 pb = pack8(sc[2 * s2], sc[2 * s2 + 1]);
#pragma unroll
      for (int dt = 0; dt < 4; ++dt) {
        const u16* vr = Vt + (16 * dt + r16) * 200 + 16 * (jt0 + 2 * s2) + 4 * g;
        const u32x2 lo = *(const u32x2*)vr, hi = *(const u32x2*)(vr + 16);
        oacc[dt] = mfma16(as_bf8((u32x4){lo.x, lo.y, hi.x, hi.y}), pb, oacc[dt]);
      }
    }
#pragma unroll
    for (int dt = 0; dt < 4; ++dt) {
      const int dcol = head * 64 + 16 * dt + 4 * g;
      const u32x2 z = *(const u32x2*)(h + (size_t)tq * NC + C_SWZ + dcol);
      u32x2 w;
      w.x = pk_bf16(oacc[dt][0] * inv * silu_f(bf_lo(z.x)), oacc[dt][1] * inv * silu_f(bf_hi(z.x)));
      w.y = pk_bf16(oacc[dt][2] * inv * silu_f(bf_lo(z.y)), oacc[dt][3] * inv * silu_f(bf_hi(z.y)));
      *(u32x2*)(h + (size_t)tq * NC + C_SWQ + dcol) = w;
    }
  }
}

DI void phase_ya(const Params& p, int wvs) {
  u16* h = (u16*)(p.ws + OFF_H);
  const size_t gt = (size_t)blockIdx.x * 256 + opaque_tid(), gs = (size_t)gridDim.x * 256;
  for (size_t i = gt; i < (size_t)T_TOK * 64; i += gs) {
    const int tok = (int)(i >> 6), c8 = (int)(i & 63);
    u16* ptr = h + (size_t)tok * NC + c8 * 8;
    const u32x4 v = *(const u32x4*)ptr;
    const u32x4 z = *(const u32x4*)(ptr + C_DNZ);
    float o[8]; float ss = 0.f;
#pragma unroll
    for (int j = 0; j < 4; ++j) { o[2 * j] = bf_lo(v[j]); o[2 * j + 1] = bf_hi(v[j]); }
#pragma unroll
    for (int j = 0; j < 8; ++j) ss += o[j] * o[j];
    ss += __shfl_xor(ss, 1); ss += __shfl_xor(ss, 2); ss += __shfl_xor(ss, 4); ss += __shfl_xor(ss, 8);
    const float rs = rsqrtf(ss * (1.0f / 128.0f) + 1e-6f);
    const float* nw = p.dn_norm_w + (c8 & 15) * 8;
    float y[8];
#pragma unroll
    for (int j = 0; j < 4; ++j) {
      y[2 * j] = o[2 * j] * rs * nw[2 * j] * silu_f(bf_lo(z[j]));
      y[2 * j + 1] = o[2 * j + 1] * rs * nw[2 * j + 1] * silu_f(bf_hi(z[j]));
    }
    u32x4 w; w.x = pk_bf16(y[0], y[1]); w.y = pk_bf16(y[2], y[3]); w.z = pk_bf16(y[4], y[5]); w.w = pk_bf16(y[6], y[7]);
    *(u32x4*)ptr = w;
  }
}

DI void phase4(const Params& p, int wvs, unsigned char* smem) {
  const int xcd = blockIdx.x & 7, lb = blockIdx.x >> 3, nlb = gridDim.x >> 3;
  const u16* h = (const u16*)(p.ws + OFF_H);
  const u16* wat = (const u16*)(p.ws + OFF_WAT);
  const u16* wbt = (const u16*)(p.ws + OFF_WBT);
  u16* mg = (u16*)(p.ws + OFF_SC);
  const int tid0 = opaque_tid(); const int lane = tid0 & 63, wv = tid0 >> 6, wm = wv >> 1, wn = wv & 1, r16 = lane & 15, g = lane >> 4;
  for (int li = lb;; li += nlb) {
    int mt, nt; if (!tile_of(li, 8, xcd, mt, nt)) break;
    f32x4 acc[4][4]; zero_acc(acc);
    gemm_kloop(p, wvs, h, NC, wat, 512, 8, mt * 128, nt * 128, acc, smem);
#pragma unroll
    for (int mi = 0; mi < 4; ++mi) {
      const int row = mt * 128 + wm * 64 + mi * 16 + r16;
#pragma unroll
      for (int ni = 0; ni < 4; ++ni) {
        const int col = nt * 128 + wn * 64 + ni * 16 + 4 * g;
        const u32x2 ga = *(const u32x2*)(h + (size_t)row * NC + C_GA + col), gb = *(const u32x2*)(h + (size_t)row * NC + C_GB + col);
        acc[mi][ni][0] *= (1.f + __expf(-bf_lo(gb.x))) / (1.f + __expf(-bf_lo(ga.x)));
        acc[mi][ni][1] *= (1.f + __expf(-bf_hi(gb.x))) / (1.f + __expf(-bf_hi(ga.x)));
        acc[mi][ni][2] *= (1.f + __expf(-bf_lo(gb.y))) / (1.f + __expf(-bf_lo(ga.y)));
        acc[mi][ni][3] *= (1.f + __expf(-bf_hi(gb.y))) / (1.f + __expf(-bf_hi(ga.y)));
      }
      __builtin_amdgcn_sched_barrier(0);
    }
    gemm_kloop(p, wvs, h + C_SWQ, NC, wbt, 512, 8, mt * 128, nt * 128, acc, smem);
#pragma unroll
    for (int mi = 0; mi < 4; ++mi) {
      const int row = mt * 128 + wm * 64 + mi * 16 + r16;
#pragma unroll
      for (int ni = 0; ni < 4; ++ni) {
        const int col = nt * 128 + wn * 64 + ni * 16 + 4 * g;
        const u32x2 gb = *(const u32x2*)(h + (size_t)row * NC + C_GB + col);
        u32x2 w;
        w.x = pk_bf16(acc[mi][ni][0] * sigmoid_f(bf_lo(gb.x)), acc[mi][ni][1] * sigmoid_f(bf_hi(gb.x)));
        w.y = pk_bf16(acc[mi][ni][2] * sigmoid_f(bf_lo(gb.y)), acc[mi][ni][3] * sigmoid_f(bf_hi(gb.y)));
        *(u32x2*)(mg + (size_t)row * 1024 + col) = w;
      }
      __builtin_amdgcn_sched_barrier(0);
    }
  }
}

DI void phase5(const Params& p, int wvs, unsigned char* smem) {
  const int xcd = blockIdx.x & 7, lb = blockIdx.x >> 3, nlb = gridDim.x >> 3;
  const u16* mg = (const u16*)(p.ws + OFF_SC);
  const u16* wot = (const u16*)(p.ws + OFF_WOT);
  const int tid0 = opaque_tid(); const int lane = tid0 & 63, wv = tid0 >> 6, wm = wv >> 1, wn = wv & 1, r16 = lane & 15, g = lane >> 4;
  for (int li = lb;; li += nlb) {
    int mt, nt; if (!tile_of(li, 8, xcd, mt, nt)) break;
    f32x4 acc[4][4]; zero_acc(acc);
    gemm_kloop(p, wvs, mg, 1024, wot, 1024, 16, mt * 128, nt * 128, acc, smem);
#pragma unroll
    for (int mi = 0; mi < 4; ++mi) {
      const int row = mt * 128 + wm * 64 + mi * 16 + r16;
#pragma unroll
      for (int ni = 0; ni < 4; ++ni) {
        const int col = nt * 128 + wn * 64 + ni * 16 + 4 * g;
        const f32x4 xv = *(const f32x4*)(p.x + (size_t)row * 1024 + col);
        *(f32x4*)(p.out + (size_t)row * 1024 + col) = xv * 1.189207115002721f + acc[mi][ni];
      }
    }
  }
}

DI void phase6(const Params& p, int wvs, unsigned char* smem) {
  float* red = (float*)smem;
  const int tid = opaque_tid();
  const float4 gm = ((const float4*)p.ln_g)[tid], bt = ((const float4*)p.ln_b)[tid];
  __syncthreads();
  for (int r = blockIdx.x; r < T_TOK; r += gridDim.x) {
    float4* ptr = (float4*)(p.out + (size_t)r * 1024) + tid;
    const float4 v = *ptr;
    float s = v.x + v.y + v.z + v.w;
#pragma unroll
    for (int o = 32; o > 0; o >>= 1) s += __shfl_xor(s, o);
    if ((tid & 63) == 0) red[tid >> 6] = s;
    __syncthreads();
    const float mu = (red[0] + red[1] + red[2] + red[3]) * (1.0f / 1024.0f);
    const float a = v.x - mu, b = v.y - mu, c = v.z - mu, d = v.w - mu;
    float q = a * a + b * b + c * c + d * d;
#pragma unroll
    for (int o = 32; o > 0; o >>= 1) q += __shfl_xor(q, o);
    if ((tid & 63) == 0) red[4 + (tid >> 6)] = q;
    __syncthreads();
    const float rs = rsqrtf((red[4] + red[5] + red[6] + red[7]) * (1.0f / 1024.0f) + 1e-5f);
    float4 o; o.x = a * rs * gm.x + bt.x; o.y = b * rs * gm.y + bt.y; o.z = c * rs * gm.z + bt.z; o.w = d * rs * gm.w + bt.w;
    *ptr = o;
    __syncthreads();
  }
}

#define XB_TMO      128
#define XB_XCNT(j)  (256  + 64 * (j))
#define XB_XSUB(j)  (1280 + 64 * (j))
#define XB_XGEN(j)  (2304 + 64 * (j))
#define XB_TOP      3328
#define XB_TOPGEN   3392
#define XCD_BAR_WORDS 3456
#define XB_SPIN_CAP (1u << 22)
#define LAS __attribute__((address_space(3)))
DI unsigned xb_ld(unsigned* p) { return __hip_atomic_load(p, __ATOMIC_RELAXED, __HIP_MEMORY_SCOPE_AGENT); }
DI unsigned xb_add(unsigned* p, unsigned v) { return __hip_atomic_fetch_add(p, v, __ATOMIC_RELAXED, __HIP_MEMORY_SCOPE_AGENT); }
DI unsigned xb_xcc_id() { return (unsigned)__builtin_amdgcn_s_getreg((3 << 11) | 20) & 0xFu; }
#define XB_SPIN(cond, bar) do { unsigned _sp = 0; while (cond) { __builtin_amdgcn_s_sleep(1); \
    if ((++_sp & 255u) == 0u) { if (xb_ld(&(bar)[XB_TMO])) break; if (_sp > XB_SPIN_CAP) { atomicAdd(&(bar)[XB_TMO], 1u); break; } } } } while (0)
struct XcdBarrier { unsigned* bar; unsigned x; volatile LAS unsigned* st; };
DI XcdBarrier xcd_barrier_post(unsigned* bar, volatile LAS unsigned* st) {
  XcdBarrier b; b.bar = bar; b.x = xb_xcc_id(); b.st = st;
  if (threadIdx.x == 0) (void)xb_add(&bar[XB_XCNT(b.x)], 1u);
  return b;
}
DI void xcd_barrier_complete(unsigned* bar, unsigned x, unsigned& nloc, unsigned& nx) {
  const unsigned G = gridDim.x * gridDim.y * gridDim.z;
  unsigned sum, cnt, mine, sp = 0u;
  for (;;) {
    sum = 0u; cnt = 0u; mine = 0u;
#pragma unroll
    for (unsigned j = 0; j < 16; ++j) { const unsigned c = xb_ld(&bar[XB_XCNT(j)]); sum += c; cnt += (c > 0u) ? 1u : 0u; mine = (j == x) ? c : mine; }
    if (sum == G) break;
    __builtin_amdgcn_s_sleep(1);
    if ((++sp & 255u) == 0u) { if (xb_ld(&bar[XB_TMO])) break; if (sp > XB_SPIN_CAP) { atomicAdd(&bar[XB_TMO], 1u); break; } }
  }
  nloc = mine > 0u ? mine : 1u; nx = cnt > 0u ? cnt : 1u;
}
DI void xcd_barrier(const XcdBarrier& b) {
  asm volatile("s_waitcnt vmcnt(0)" ::: "memory");
  __syncthreads();
  if (threadIdx.x == 0) {
    unsigned* bar = b.bar;
    __builtin_amdgcn_s_waitcnt(0);
    unsigned nloc = b.st[0], nx = b.st[1];
    if (nloc == 0u) { xcd_barrier_complete(bar, b.x, nloc, nx); b.st[0] = nloc; b.st[1] = nx; }
    const unsigned old = xb_add(&bar[XB_XSUB(b.x)], 1u);
    const unsigned gen = old / nloc;
    if (old + 1u == (gen + 1u) * nloc) {
      __builtin_amdgcn_fence(__ATOMIC_RELEASE, "agent");
      asm volatile("s_waitcnt vmcnt(0)" ::: "memory");
      const unsigned og = xb_add(&bar[XB_TOP], 1u);
      const unsigned tg = og / nx;
      if (og + 1u == (tg + 1u) * nx) xb_add(&bar[XB_TOPGEN], 1u);
      else XB_SPIN(xb_ld(&bar[XB_TOPGEN]) == tg, bar);
      __builtin_amdgcn_fence(__ATOMIC_ACQUIRE, "agent");
      xb_add(&bar[XB_XGEN(b.x)], 1u);
      asm volatile("s_waitcnt vmcnt(0)" ::: "memory");
    } else {
      XB_SPIN(xb_ld(&bar[XB_XGEN(b.x)]) == gen, bar);
      __builtin_amdgcn_fence(__ATOMIC_ACQUIRE, "agent");
      asm volatile("s_waitcnt vmcnt(0)" ::: "memory");
    }
  }
  __syncthreads();
}

#ifndef MK_MULTI
#define MK_MULTI 0
#endif
#define SMEM_DECL __shared__ __attribute__((aligned(16))) unsigned char smem[SMEM_BYTES]; const int wvs = __builtin_amdgcn_readfirstlane((int)(threadIdx.x >> 6));
#if MK_MULTI
__global__ void __launch_bounds__(256, 2) k_p0(Params p) { SMEM_DECL (void)smem; phase0(p, wvs); }
__global__ void __launch_bounds__(256, 2) k_p1(Params p) { SMEM_DECL phase1(p, wvs, smem); }
__global__ void __launch_bounds__(256, 2) k_p2(Params p) { SMEM_DECL for (int it = blockIdx.x; it < 2048; it += gridDim.x) prep_item(p, wvs, it, smem); }
__global__ void __launch_bounds__(256, 2) k_p3(Params p) { SMEM_DECL
  if (blockIdx.x < 128) scan_chain(p, wvs, blockIdx.x, smem);
  else for (int it = blockIdx.x - 128; it < 1024; it += gridDim.x - 128) swa_item(p, wvs, it, smem); }
__global__ void __launch_bounds__(256, 2) k_p3b(Params p) { SMEM_DECL (void)smem; phase_ya(p, wvs); }
__global__ void __launch_bounds__(256, 2) k_p4(Params p) { SMEM_DECL phase4(p, wvs, smem); }
__global__ void __launch_bounds__(256, 2) k_p5(Params p) { SMEM_DECL phase5(p, wvs, smem); }
__global__ void __launch_bounds__(256, 2) k_p6(Params p) { SMEM_DECL phase6(p, wvs, smem); }
#else
__global__ void __launch_bounds__(256, 2) fwd_megakernel(Params p) {
  cg::grid_group grid = cg::this_grid();
  SMEM_DECL
  volatile LAS unsigned* st = (volatile LAS unsigned*)(smem + SMEM_BYTES - 16);
  if (threadIdx.x < 4) st[threadIdx.x] = 0u;
  __syncthreads();
  const XcdBarrier xb = xcd_barrier_post((unsigned*)(p.ws + OFF_BAR), st);
  phase0(p, wvs);
  grid.sync();
  phase1(p, wvs, smem);
  xcd_barrier(xb);
  for (int it = blockIdx.x; it < 2048; it += gridDim.x) prep_item(p, wvs, it, smem);
  xcd_barrier(xb);
  if (blockIdx.x < 128) scan_chain(p, wvs, blockIdx.x, smem);
  else for (int it = blockIdx.x - 128; it < 1024; it += gridDim.x - 128) swa_item(p, wvs, it, smem);
  xcd_barrier(xb);
  phase_ya(p, wvs);
  xcd_barrier(xb);
  phase4(p, wvs, smem);
  xcd_barrier(xb);
  phase5(p, wvs, smem);
  xcd_barrier(xb);
  phase6(p, wvs, smem);
}
#endif

extern "C" void kernel_launch(void* const* d_in, const int* in_sizes, int n_in, void* d_out, int out_size,
                              void* d_ws, size_t ws_size, hipStream_t stream) {
  if (ws_size < WS_NEED) { fprintf(stderr, "workspace too small: %zu < %zu\n", ws_size, (size_t)WS_NEED); return; }
  Params p{};
  p.x = (const float*)d_in[0]; p.w_in = (const float*)d_in[1]; p.conv_w = (const float*)d_in[2]; p.a_log = (const float*)d_in[3];
  p.dt_bias = (const float*)d_in[4]; p.dn_norm_w = (const float*)d_in[5]; p.sinks = (const float*)d_in[6];
  p.w_branch = (const float*)d_in[7]; p.w_out = (const float*)d_in[8]; p.ln_g = (const float*)d_in[9]; p.ln_b = (const float*)d_in[10];
  p.out = (float*)d_out; p.ws = (unsigned char*)d_ws;
  for (int i = 0; i < 8; ++i) p.inv_freq[i] = (float)std::pow(500000.0, -(double)i / 8.0);
#if MK_MULTI
  const dim3 g(512), b(256);
  k_p0<<<g, b, 0, stream>>>(p);
  k_p1<<<g, b, 0, stream>>>(p);
  k_p2<<<g, b, 0, stream>>>(p);
  k_p3<<<g, b, 0, stream>>>(p);
  k_p3b<<<g, b, 0, stream>>>(p);
  k_p4<<<g, b, 0, stream>>>(p);
  k_p5<<<g, b, 0, stream>>>(p);
  k_p6<<<g, b, 0, stream>>>(p);
#else
  static int grid_blocks = 0;
  if (!grid_blocks) {
    int dev = 0, cus = 0, per_cu = 0;
    (void)hipGetDevice(&dev);
    (void)hipDeviceGetAttribute(&cus, hipDeviceAttributeMultiprocessorCount, dev);
    (void)hipOccupancyMaxActiveBlocksPerMultiprocessor(&per_cu, fwd_megakernel, 256, 0);
    if (per_cu > 2) per_cu = 2;
    if (per_cu < 1) per_cu = 1;
    grid_blocks = cus * per_cu;
    grid_blocks &= ~7;
  }
  (void)hipMemsetAsync(p.ws + OFF_BAR, 0, BAR_BYTES, stream);
  void* args[] = {&p};
  hipError_t e = hipLaunchCooperativeKernel((void*)fwd_megakernel, dim3(grid_blocks), dim3(256), args, 0, stream);
  if (e != hipSuccess) fprintf(stderr, "cooperative launch failed: %s (grid %d)\n", hipGetErrorString(e), grid_blocks);
#endif
}
```

```cpp
#include <hip/hip_runtime.h>
#include <hip/hip_cooperative_groups.h>
#include <cstdio>
#include <cmath>
namespace cg = cooperative_groups;

typedef unsigned short u16;
typedef short bf16x8 __attribute__((ext_vector_type(8)));
typedef float f32x4 __attribute__((ext_vector_type(4)));
typedef unsigned u32x4 __attribute__((ext_vector_type(4)));
typedef unsigned u32x2 __attribute__((ext_vector_type(2)));
#define DI __device__ __forceinline__
DI int opaque_tid_(int wave_s) { int t = (int)__builtin_amdgcn_mbcnt_hi(~0u, __builtin_amdgcn_mbcnt_lo(~0u, 0u)) + (wave_s << 6); asm volatile("" : "+v"(t)); return t; }
#define opaque_tid() opaque_tid_(wvs)

constexpr int T_TOK = 32768, SEQ = 8192, DM = 1024, NC = 5384, NCP = 5504;
constexpr int C_DNZ = 1536, C_SWQ = 2056, C_SWK = 2568, C_SWV = 2696, C_SWZ = 2824, C_GA = 3336, C_GB = 4360;
constexpr size_t OFF_BAR = 0;
constexpr size_t BAR_BYTES = 16384;
constexpr size_t OFF_WINT = BAR_BYTES;
constexpr size_t OFF_WAT = OFF_WINT + (size_t)NCP * 1024 * 2;
constexpr size_t OFF_WBT = OFF_WAT + 1024 * 512 * 2;
constexpr size_t OFF_WOT = OFF_WBT + 1024 * 512 * 2;
constexpr size_t OFF_ROPE = OFF_WOT + 1024 * 1024 * 2;
constexpr size_t OFF_HB = OFF_ROPE + 2 * 8192 * 8 * 4;
constexpr size_t OFF_DEC = OFF_HB + (size_t)T_TOK * 8 * 4;
constexpr size_t OFF_H = OFF_DEC + 2048 * 4;
constexpr size_t OFF_SC = OFF_H + (size_t)T_TOK * NC * 2;
constexpr size_t OPB = 73728;
constexpr size_t WS_NEED = OFF_SC + 2048 * OPB;
constexpr int SMEM_BYTES = 73728;

struct Params {
  const float *x, *w_in, *conv_w, *a_log, *dt_bias, *dn_norm_w, *sinks, *w_branch, *w_out, *ln_g, *ln_b;
  float* out; unsigned char* ws;
  float inv_freq[8];
};

typedef __bf16 bf16x2_t __attribute__((ext_vector_type(2)));
typedef float f32x2_t __attribute__((ext_vector_type(2)));
DI unsigned pk_bf16(float lo, float hi) { f32x2_t f = {lo, hi}; bf16x2_t v = __builtin_convertvector(f, bf16x2_t); return __builtin_bit_cast(unsigned, v); }
DI float bf_lo(unsigned u) { return __uint_as_float(u << 16); }
DI float bf_hi(unsigned u) { return __uint_as_float(u & 0xffff0000u); }
DI float bf2f(u16 v) { return __uint_as_float(((unsigned)v) << 16); }
DI u16 f2bf(float f) { return (u16)(pk_bf16(f, f) & 0xffffu); }
DI float silu_f(float y) { return y / (1.0f + __expf(-y)); }
DI float sigmoid_f(float y) { return 1.0f / (1.0f + __expf(-y)); }
DI f32x4 mfma16(bf16x8 a, bf16x8 b, f32x4 c) { return __builtin_amdgcn_mfma_f32_16x16x32_bf16(a, b, c, 0, 0, 0); }
DI bf16x8 as_bf8(u32x4 v) { return __builtin_bit_cast(bf16x8, v); }
DI bf16x8 pack8(f32x4 a, f32x4 b) { u32x4 w; w.x = pk_bf16(a[0], a[1]); w.y = pk_bf16(a[2], a[3]); w.z = pk_bf16(b[0], b[1]); w.w = pk_bf16(b[2], b[3]); return as_bf8(w); }

DI void phase0(const Params& p, int wvs) {
  const size_t gt = (size_t)blockIdx.x * 256 + opaque_tid(), gs = (size_t)gridDim.x * 256;
  {
    u32x4* xb = (u32x4*)(p.ws + OFF_SC);
    const float4* xs = (const float4*)p.x;
    for (size_t i = gt; i < (size_t)T_TOK * DM / 8; i += gs) {
      const float4 a = xs[2 * i], b = xs[2 * i + 1];
      u32x4 w; w.x = pk_bf16(a.x, a.y); w.y = pk_bf16(a.z, a.w); w.z = pk_bf16(b.x, b.y); w.w = pk_bf16(b.z, b.w);
      xb[i] = w;
    }
  }
  {
    u32x4* wt = (u32x4*)(p.ws + OFF_WINT);
    for (size_t i = gt; i < (size_t)NCP * 128; i += gs) {
      const int kc = (int)(i / NCP), n = (int)(i % NCP);
      float v[8];
#pragma unroll
      for (int j = 0; j < 8; ++j) v[j] = (n < NC) ? p.w_in[(size_t)(kc * 8 + j) * NC + n] : 0.f;
      u32x4 w; w.x = pk_bf16(v[0], v[1]); w.y = pk_bf16(v[2], v[3]); w.z = pk_bf16(v[4], v[5]); w.w = pk_bf16(v[6], v[7]);
      wt[(size_t)n * 128 + kc] = w;
    }
  }
  {
    for (size_t i = gt; i < (size_t)2 * 1024 * 64; i += gs) {
      const int br = (int)(i / (1024 * 64)), rem = (int)(i % (1024 * 64)), kc = rem / 1024, n = rem % 1024;
      const float* src = p.w_branch + (size_t)br * 512 * 1024;
      float v[8];
#pragma unroll
      for (int j = 0; j < 8; ++j) v[j] = src[(size_t)(kc * 8 + j) * 1024 + n];
      u32x4 w; w.x = pk_bf16(v[0], v[1]); w.y = pk_bf16(v[2], v[3]); w.z = pk_bf16(v[4], v[5]); w.w = pk_bf16(v[6], v[7]);
      ((u32x4*)(p.ws + (br ? OFF_WBT : OFF_WAT)))[(size_t)n * 64 + kc] = w;
    }
  }
  {
    for (size_t i = gt; i < (size_t)1024 * 128; i += gs) {
      const int kc = (int)(i / 1024), n = (int)(i % 1024);
      float v[8];
#pragma unroll
      for (int j = 0; j < 8; ++j) v[j] = p.w_out[(size_t)(kc * 8 + j) * 1024 + n];
      u32x4 w; w.x = pk_bf16(v[0], v[1]); w.y = pk_bf16(v[2], v[3]); w.z = pk_bf16(v[4], v[5]); w.w = pk_bf16(v[6], v[7]);
      ((u32x4*)(p.ws + OFF_WOT))[(size_t)n * 128 + kc] = w;
    }
  }
  {
    float* rc = (float*)(p.ws + OFF_ROPE); float* rs = rc + 8192 * 8;
    for (size_t i = gt; i < 8192 * 8; i += gs) {
      const int t = (int)(i >> 3), f = (int)(i & 7);
      const float ang = (float)t * p.inv_freq[f];
      const double a = (double)ang;
      const double k = __builtin_rint(a * 0.15915494309189535);
      const float r = (float)(a - k * 6.283185307179586);
      rc[i] = cosf(r); rs[i] = sinf(r);
    }
  }
}

DI int lds_off(int row, int chunk) { return row * 128 + ((chunk ^ (row & 7)) << 4); }

DI void gemm_kloop(const Params& p, int wvs, const u16* __restrict__ A, int lda, const u16* __restrict__ Bt, int ldb, int nk, int m0, int n0,
                   f32x4 (&acc)[4][4], unsigned char* smem) {
  const int tid = opaque_tid(), lane = tid & 63, wv = tid >> 6, wm = wv >> 1, wn = wv & 1, r16 = lane & 15, g = lane >> 4;
  const int lrow = tid >> 3, lc = (tid & 7) ^ (lrow & 7);
  const u16* ap = A + (size_t)(m0 + lrow) * lda + lc * 8;
  const u16* bp = Bt + (size_t)(n0 + lrow) * ldb + lc * 8;
  unsigned char* lbase = smem + wv * 1024;
#pragma unroll
  for (int i = 0; i < 4; ++i) {
    __builtin_amdgcn_global_load_lds((const unsigned*)(ap + (size_t)(32 * i) * lda), (unsigned*)(lbase + i * 4096), 16, 0, 0);
    __builtin_amdgcn_global_load_lds((const unsigned*)(bp + (size_t)(32 * i) * ldb), (unsigned*)(lbase + 16384 + i * 4096), 16, 0, 0);
  }
  asm volatile("s_waitcnt vmcnt(0)" ::: "memory");
  __syncthreads();
  for (int kt = 0; kt < nk; ++kt) {
    unsigned char* cur = smem + (kt & 1) * 32768;
    unsigned char* nxt = lbase + ((kt + 1) & 1) * 32768;
    if (kt + 1 < nk) {
#pragma unroll
      for (int i = 0; i < 4; ++i) {
        __builtin_amdgcn_global_load_lds((const unsigned*)(ap + (size_t)(32 * i) * lda + (kt + 1) * 64), (unsigned*)(nxt + i * 4096), 16, 0, 0);
        __builtin_amdgcn_global_load_lds((const unsigned*)(bp + (size_t)(32 * i) * ldb + (kt + 1) * 64), (unsigned*)(nxt + 16384 + i * 4096), 16, 0, 0);
      }
    }
#pragma unroll
    for (int ks = 0; ks < 2; ++ks) {
      bf16x8 af[4], bfr[4];
#pragma unroll
      for (int i = 0; i < 4; ++i) {
        af[i] = *(const bf16x8*)(cur + lds_off(wm * 64 + i * 16 + r16, ks * 4 + g));
        bfr[i] = *(const bf16x8*)(cur + 16384 + lds_off(wn * 64 + i * 16 + r16, ks * 4 + g));
      }
#pragma unroll
      for (int mi = 0; mi < 4; ++mi)
#pragma unroll
        for (int ni = 0; ni < 4; ++ni) acc[mi][ni] = mfma16(bfr[ni], af[mi], acc[mi][ni]);
    }
    asm volatile("s_waitcnt vmcnt(0)" ::: "memory");
    __syncthreads();
  }
}

DI bool tile_of(int li, int ntn, int xcd, int& mt, int& nt) {
  if (li >= 32 * ntn) return false;
  const int grp = li / (4 * ntn), rem = li % (4 * ntn);
  nt = rem >> 2; mt = 32 * xcd + grp * 4 + (rem & 3);
  return true;
}

DI void zero_acc(f32x4 (&acc)[4][4]) {
#pragma unroll
  for (int i = 0; i < 4; ++i)
#pragma unroll
    for (int j = 0; j < 4; ++j) acc[i][j] = (f32x4){0.f, 0.f, 0.f, 0.f};
}

DI void phase1(const Params& p, int wvs, unsigned char* smem) {
  const int xcd = blockIdx.x & 7, lb = blockIdx.x >> 3, nlb = gridDim.x >> 3;
  const u16* xb = (const u16*)(p.ws + OFF_SC);
  const u16* wint = (const u16*)(p.ws + OFF_WINT);
  u16* h = (u16*)(p.ws + OFF_H);
  float* hb = (float*)(p.ws + OFF_HB);
  const int tid0 = opaque_tid(); const int lane = tid0 & 63, wv = tid0 >> 6, wm = wv >> 1, wn = wv & 1, r16 = lane & 15, g = lane >> 4;
  for (int li = lb;; li += nlb) {
    int mt, nt; if (!tile_of(li, 43, xcd, mt, nt)) break;
    f32x4 acc[4][4]; zero_acc(acc);
    gemm_kloop(p, wvs, xb, 1024, wint, 1024, 16, mt * 128, nt * 128, acc, smem);
#pragma unroll
    for (int mi = 0; mi < 4; ++mi) {
      const int row = mt * 128 + wm * 64 + mi * 16 + r16;
#pragma unroll
      for (int ni = 0; ni < 4; ++ni) {
        const int col = nt * 128 + wn * 64 + ni * 16 + 4 * g;
        if (col < NC) {
          u32x2 w; w.x = pk_bf16(acc[mi][ni][0], acc[mi][ni][1]); w.y = pk_bf16(acc[mi][ni][2], acc[mi][ni][3]);
          *(u32x2*)(h + (size_t)row * NC + col) = w;
          if (col >= 2048 && col < 2056) *(f32x4*)(hb + (size_t)row * 8 + (col - 2048)) = acc[mi][ni];
        }
      }
    }
  }
}

template <int I, int M4> DI void solve_part(const float (&xv)[64], const float* Lrow, float& a) {
  if constexpr (4 * M4 < I) {
    const f32x4 l = *(const f32x4*)(Lrow + 4 * M4);
    if constexpr (4 * M4 + 0 < I) a -= l[0] * xv[4 * M4 + 0];
    if constexpr (4 * M4 + 1 < I) a -= l[1] * xv[4 * M4 + 1];
    if constexpr (4 * M4 + 2 < I) a -= l[2] * xv[4 * M4 + 2];
    if constexpr (4 * M4 + 3 < I) a -= l[3] * xv[4 * M4 + 3];
    solve_part<I, M4 + 1>(xv, Lrow, a);
  }
}
template <int I> DI void solve_rows(float (&xv)[64], const float* Lm) {
  if constexpr (I < 64) {
    float a = xv[I];
    solve_part<I, 0>(xv, Lm + I * 68, a);
    xv[I] = a;
    __builtin_amdgcn_sched_barrier(0);
    solve_rows<I + 1>(xv, Lm);
  }
}

DI void prep_item(const Params& p, int wvs, int item, unsigned char* smem) {
  const int tid_ = opaque_tid();
  const int tid = tid_, lane = tid & 63, wv = tid >> 6, r16 = lane & 15, g = lane >> 4;
  const int hd = item & 3, n = (item >> 2) & 127, b = item >> 9;
  const int t0 = b * SEQ + n * 64;
  u16* Qs = (u16*)smem; u16* Ks = Qs + 64 * 136; u16* Vs = Ks + 64 * 136;
  float* Lm = (float*)(smem + 52224);
  float* sm_beta = (float*)(smem + 69632);
  float* sm_gc = sm_beta + 64; float* sm_rq = sm_gc + 64; float* sm_rk = sm_rq + 64;
  float* sm_fw = sm_rk + 64; float* sm_fq = sm_fw + 64; float* sm_fk = sm_fq + 64;
  const u16* h = (const u16*)(p.ws + OFF_H);
  const float* hb = (const float*)(p.ws + OFF_HB);
  unsigned char* op = p.ws + OFF_SC + (size_t)item * OPB;
  __syncthreads();
  {
    const int c2 = tid & 63, rbase = (tid >> 6) * 16;
#pragma unroll 1
    for (int mat = 0; mat < 3; ++mat) {
      const int col = mat * 512 + hd * 128 + 2 * c2;
      float wa[4], wb[4];
#pragma unroll
      for (int j = 0; j < 4; ++j) { wa[j] = p.conv_w[j * 1536 + col]; wb[j] = p.conv_w[j * 1536 + col + 1]; }
      float xa[3], xb[3];
#pragma unroll
      for (int j = 0; j < 3; ++j) {
        const int pos = n * 64 + rbase - 3 + j;
        unsigned v = 0;
        if (pos >= 0) v = *(const unsigned*)(h + (size_t)(t0 + rbase - 3 + j) * NC + col);
        xa[j] = bf_lo(v); xb[j] = bf_hi(v);
      }
      u16* dst = (mat == 0 ? Qs : (mat == 1 ? Ks : Vs));
#pragma unroll
      for (int i = 0; i < 16; ++i) {
        const unsigned v = *(const unsigned*)(h + (size_t)(t0 + rbase + i) * NC + col);
        const float a3 = bf_lo(v), b3 = bf_hi(v);
        const float ya = wa[0] * xa[0] + wa[1] * xa[1] + wa[2] * xa[2] + wa[3] * a3;
        const float yb = wb[0] * xb[0] + wb[1] * xb[1] + wb[2] * xb[2] + wb[3] * b3;
        xa[0] = xa[1]; xa[1] = xa[2]; xa[2] = a3; xb[0] = xb[1]; xb[1] = xb[2]; xb[2] = b3;
        *(unsigned*)(dst + (rbase + i) * 136 + 2 * c2) = pk_bf16(silu_f(ya), silu_f(yb));
      }
    }
  }
  __syncthreads();
  if (wv == 0) {
    const int row = t0 + lane;
    const float bl = hb[(size_t)row * 8 + hd], al = hb[(size_t)row * 8 + 4 + hd];
    const float xx = al + p.dt_bias[hd];
    const float sp = xx > 20.f ? xx : log1pf(expf(xx));
    float gg = -expf(p.a_log[hd]) * sp;
#pragma unroll
    for (int o = 1; o < 64; o <<= 1) { const float t = __shfl_up(gg, o); if (lane >= o) gg += t; }
    sm_beta[lane] = 1.0f / (1.0f + expf(-bl)); sm_gc[lane] = gg;
  } else if (wv <= 2) {
    const int r = tid - 64;
    const u16* src = (r < 64) ? (Qs + r * 136) : (Ks + (r - 64) * 136);
    float ss = 0.f;
#pragma unroll
    for (int c = 0; c < 16; ++c) {
      const u32x4 v = *(const u32x4*)(src + c * 8);
#pragma unroll
      for (int j = 0; j < 4; ++j) { const float a = bf_lo(v[j]), bb = bf_hi(v[j]); ss += a * a + bb * bb; }
    }
    const float rs = rsqrtf(ss + 1e-6f);
    if (r < 64) sm_rq[r] = rs; else sm_rk[r - 64] = rs;
  }
  __syncthreads();
  if (tid < 64) {
    const float gc = sm_gc[tid], gl = sm_gc[63], eg = expf(gc);
    sm_fw[tid] = sm_beta[tid] * eg * sm_rk[tid];
    sm_fq[tid] = sm_rq[tid] * 0.08838834764831845f * eg;
    sm_fk[tid] = sm_rk[tid] * expf(gl - gc);
    if (tid == 0) ((float*)(p.ws + OFF_DEC))[item] = expf(gl);
  }
  {
    bf16x8 kfi[4], qfi[4];
#pragma unroll
    for (int s = 0; s < 4; ++s) {
      kfi[s] = *(const bf16x8*)(Ks + (16 * wv + r16) * 136 + 32 * s + 8 * g);
      qfi[s] = *(const bf16x8*)(Qs + (16 * wv + r16) * 136 + 32 * s + 8 * g);
    }
    f32x4 at[4];
#pragma unroll
    for (int jt = 0; jt < 4; ++jt) {
      at[jt] = (f32x4){0.f, 0.f, 0.f, 0.f};
      if (jt <= wv) {
        f32x4 la = (f32x4){0.f, 0.f, 0.f, 0.f}, aa = (f32x4){0.f, 0.f, 0.f, 0.f};
#pragma unroll
        for (int s = 0; s < 4; ++s) {
          const bf16x8 kfj = *(const bf16x8*)(Ks + (16 * jt + r16) * 136 + 32 * s + 8 * g);
          la = mfma16(kfi[s], kfj, la);
          aa = mfma16(kfj, qfi[s], aa);
        }
#pragma unroll
        for (int r = 0; r < 4; ++r) {
          { const int i = 16 * wv + 4 * g + r, j = 16 * jt + r16;
            const float v = (i > j) ? sm_beta[i] * sm_rk[i] * sm_rk[j] * __expf(sm_gc[i] - sm_gc[j]) * la[r] : 0.f;
            Lm[i * 68 + j] = v; }
          { const int j = 16 * jt + 4 * g + r, i = 16 * wv + r16;
            at[jt][r] = (j <= i) ? sm_rq[i] * sm_rk[j] * 0.08838834764831845f * __expf(sm_gc[i] - sm_gc[j]) * aa[r] : 0.f; }
        }
      }
    }
#pragma unroll
    for (int s2 = 0; s2 < 2; ++s2)
      *(bf16x8*)(op + 32768 + (size_t)((wv * 2 + s2) * 64 + lane) * 16) = pack8(at[2 * s2], at[2 * s2 + 1]);
  }
  __syncthreads();
  float xv[64];
  if (tid < 128) {
#pragma unroll
    for (int i = 0; i < 64; ++i) xv[i] = sm_beta[i] * bf2f(Vs[i * 136 + tid]);
  } else {
#pragma unroll
    for (int i = 0; i < 64; ++i) xv[i] = sm_fw[i] * bf2f(Ks[i * 136 + tid - 128]);
  }
  solve_rows<1>(xv, Lm);
  if (tid < 128) {
    const int sl = tid >> 4, dvl = tid & 15;
#pragma unroll
    for (int mt = 0; mt < 4; ++mt)
#pragma unroll
      for (int gg = 0; gg < 4; ++gg) {
        u32x2 w; w.x = pk_bf16(xv[16 * mt + 4 * gg], xv[16 * mt + 4 * gg + 1]); w.y = pk_bf16(xv[16 * mt + 4 * gg + 2], xv[16 * mt + 4 * gg + 3]);
        *(u32x2*)(op + 57344 + (size_t)((sl * 4 + mt) * 64 + gg * 16 + dvl) * 8) = w;
      }
  }
  __syncthreads();
  if (tid >= 128) {
#pragma unroll
    for (int i = 0; i < 64; ++i) Vs[i * 136 + tid - 128] = f2bf(-xv[i]);
  }
  __syncthreads();
#pragma unroll
  for (int f = 0; f < 4; ++f) {
    const int e = tid + 256 * f, frag = e >> 6, ln = e & 63, lr = ln & 15, lg = ln >> 4;
    {
      const int mt = frag >> 2, s = frag & 3, row = 16 * mt + lr;
      const u32x2 lo = *(const u32x2*)(Vs + row * 136 + 32 * s + 4 * lg), hi = *(const u32x2*)(Vs + row * 136 + 32 * s + 16 + 4 * lg);
      *(u32x4*)(op + (size_t)e * 16) = (u32x4){lo.x, lo.y, hi.x, hi.y};
      const u32x2 ql = *(const u32x2*)(Qs + row * 136 + 32 * s + 4 * lg), qh = *(const u32x2*)(Qs + row * 136 + 32 * s + 16 + 4 * lg);
      const float fq = sm_fq[row];
      u32x4 w;
      w.x = pk_bf16(bf_lo(ql.x) * fq, bf_hi(ql.x) * fq); w.y = pk_bf16(bf_lo(ql.y) * fq, bf_hi(ql.y) * fq);
      w.z = pk_bf16(bf_lo(qh.x) * fq, bf_hi(qh.x) * fq); w.w = pk_bf16(bf_lo(qh.y) * fq, bf_hi(qh.y) * fq);
      *(u32x4*)(op + 16384 + (size_t)e * 16) = w;
    }
    {
      const int mt8 = frag >> 1, s2 = frag & 1, dk = 16 * mt8 + lr;
      float v[8];
#pragma unroll
      for (int j = 0; j < 8; ++j) {
        const int pos = 32 * s2 + 16 * (j >> 2) + 4 * lg + (j & 3);
        v[j] = bf2f(Ks[pos * 136 + dk]) * sm_fk[pos];
      }
      u32x4 w; w.x = pk_bf16(v[0], v[1]); w.y = pk_bf16(v[2], v[3]); w.z = pk_bf16(v[4], v[5]); w.w = pk_bf16(v[6], v[7]);
      *(u32x4*)(op + 40960 + (size_t)e * 16) = w;
    }
  }
}

struct ScanA { u32x4 wf[4]; u32x2 uf; float dec; };
struct ScanB { u32x4 qf[4], af[2], kf[4]; };

DI void scan_load_a(const Params& p, int wvs, ScanA& o, int b, int hd, int sl, int n, int q, int lane) {
  const int item = (b * 128 + n) * 4 + hd;
  const unsigned char* op = p.ws + OFF_SC + (size_t)item * OPB;
#pragma unroll
  for (int s = 0; s < 4; ++s) {
    o.wf[s] = *(const u32x4*)(op + (size_t)((q * 4 + s) * 64 + lane) * 16);
  }
  o.uf = *(const u32x2*)(op + 57344 + (size_t)((sl * 4 + q) * 64 + lane) * 8);
  o.dec = ((const float*)(p.ws + OFF_DEC))[item];
}
DI void scan_load_b(const Params& p, int wvs, ScanB& o, int b, int hd, int n, int q, int lane) {
  const int item = (b * 128 + n) * 4 + hd;
  const unsigned char* op = p.ws + OFF_SC + (size_t)item * OPB;
#pragma unroll
  for (int s = 0; s < 4; ++s) o.qf[s] = *(const u32x4*)(op + 16384 + (size_t)((q * 4 + s) * 64 + lane) * 16);
#pragma unroll
  for (int s2 = 0; s2 < 2; ++s2) o.af[s2] = *(const u32x4*)(op + 32768 + (size_t)((q * 2 + s2) * 64 + lane) * 16);
#pragma unroll
  for (int j = 0; j < 4; ++j) o.kf[j] = *(const u32x4*)(op + 40960 + (size_t)((q * 4 + j) * 64 + lane) * 16);
}

DI void scan_step(const Params& p, int wvs, const ScanA& o, const ScanB& ob, f32x4 (&S)[2], int b, int hd, int sl, int n, int q, int lane, unsigned char* smem) {
  const int r16 = lane & 15, g = lane >> 4;
  u32x4* ldsS = (u32x4*)smem;
  u32x2* ldsV = (u32x2*)(smem + 4096);
  ldsS[q * 64 + lane] = __builtin_bit_cast(u32x4, pack8(S[0], S[1]));
  __syncthreads();
  bf16x8 Sb[4];
#pragma unroll
  for (int s = 0; s < 4; ++s) Sb[s] = as_bf8(ldsS[s * 64 + lane]);
  f32x4 vn = (f32x4){bf_lo(o.uf.x), bf_hi(o.uf.x), bf_lo(o.uf.y), bf_hi(o.uf.y)};
#pragma unroll
  for (int s = 0; s < 4; ++s) vn = mfma16(as_bf8(o.wf[s]), Sb[s], vn);
  { u32x2 w; w.x = pk_bf16(vn[0], vn[1]); w.y = pk_bf16(vn[2], vn[3]); ldsV[((q >> 1) * 64 + lane) * 2 + (q & 1)] = w; }
  f32x4 oa = (f32x4){0.f, 0.f, 0.f, 0.f};
#pragma unroll
  for (int s = 0; s < 4; ++s) oa = mfma16(as_bf8(ob.qf[s]), Sb[s], oa);
  __syncthreads();
  bf16x8 Vb[2];
#pragma unroll
  for (int s2 = 0; s2 < 2; ++s2) Vb[s2] = as_bf8(*(const u32x4*)(ldsV + (s2 * 64 + lane) * 2));
#pragma unroll
  for (int s2 = 0; s2 < 2; ++s2) oa = mfma16(as_bf8(ob.af[s2]), Vb[s2], oa);
  u16* h = (u16*)(p.ws + OFF_H);
  const int t0 = b * SEQ + n * 64;
#pragma unroll
  for (int r = 0; r < 4; ++r) h[(size_t)(t0 + 16 * q + 4 * g + r) * NC + hd * 128 + 16 * sl + r16] = f2bf(oa[r]);
#pragma unroll
  for (int t = 0; t < 2; ++t) {
    S[t] = S[t] * o.dec;
#pragma unroll
    for (int s2 = 0; s2 < 2; ++s2) S[t] = mfma16(as_bf8(ob.kf[t * 2 + s2]), Vb[s2], S[t]);
  }
}

DI void scan_chain(const Params& p, int wvs, int chain, unsigned char* smem) {
  const int tid0 = opaque_tid(); const int lane = tid0 & 63, q = tid0 >> 6;
  const int xcd = chain & 7, j = chain >> 3, pair = xcd + 8 * (j >> 3), sl = j & 7, b = pair >> 2, hd = pair & 3;
  f32x4 S[2]; S[0] = (f32x4){0.f, 0.f, 0.f, 0.f}; S[1] = S[0];
  ScanA a0, a1, a2; ScanB bc, bn;
  __syncthreads();
  scan_load_a(p, wvs, a0, b, hd, sl, 0, q, lane);
  scan_load_b(p, wvs, bc, b, hd, 0, q, lane);
  scan_load_a(p, wvs, a1, b, hd, sl, 1, q, lane);
#pragma unroll 1
  for (int n = 0; n < 129; n += 3) {
    if (n + 2 < 128) scan_load_a(p, wvs, a2, b, hd, sl, n + 2, q, lane);
    if (n + 1 < 128) scan_load_b(p, wvs, bn, b, hd, n + 1, q, lane);
    if (n < 128) scan_step(p, wvs, a0, bc, S, b, hd, sl, n, q, lane, smem);
    bc = bn;
    if (n + 3 < 128) scan_load_a(p, wvs, a0, b, hd, sl, n + 3, q, lane);
    if (n + 2 < 128) scan_load_b(p, wvs, bn, b, hd, n + 2, q, lane);
    if (n + 1 < 128) scan_step(p, wvs, a1, bc, S, b, hd, sl, n + 1, q, lane, smem);
    bc = bn;
    if (n + 4 < 128) scan_load_a(p, wvs, a1, b, hd, sl, n + 4, q, lane);
    if (n + 3 < 128) scan_load_b(p, wvs, bn, b, hd, n + 3, q, lane);
    if (n + 2 < 128) scan_step(p, wvs, a2, bc, S, b, hd, sl, n + 2, q, lane, smem);
    bc = bn;
  }
}

DI void swa_item(const Params& p, int wvs, int item, unsigned char* smem) {
  const int tid_ = opaque_tid();
  const int tid = tid_, lane = tid & 63, wv = tid >> 6, r16 = lane & 15, g = lane >> 4;
  const int qt = item & 127, kvh = (item >> 7) & 1, b = item >> 8;
  const int kp0 = 64 * qt - 128;
  u16* Ksm = (u16*)smem;
  u16* Vt = (u16*)(smem + 27648);
  u16* h = (u16*)(p.ws + OFF_H);
  const float* rc = (const float*)(p.ws + OFF_ROPE); const float* rs = rc + 8192 * 8;
  __syncthreads();
  if (tid < 192) {
    const int kk = tid, pos = kp0 + kk;
    u32x4 lo = (u32x4){0, 0, 0, 0}, hi = lo;
    if (pos >= 0) {
      const u16* src = h + (size_t)(b * SEQ + pos) * NC + C_SWK + kvh * 64;
      const u32x4 a = *(const u32x4*)src, c = *(const u32x4*)(src + 8);
      const f32x4 c0 = *(const f32x4*)(rc + pos * 8), c1 = *(const f32x4*)(rc + pos * 8 + 4);
      const f32x4 s0 = *(const f32x4*)(rs + pos * 8), s1 = *(const f32x4*)(rs + pos * 8 + 4);
      float t1[8], t2[8], cs[8], sn[8], o1[8], o2[8];
#pragma unroll
      for (int j = 0; j < 4; ++j) { t1[2 * j] = bf_lo(a[j]); t1[2 * j + 1] = bf_hi(a[j]); t2[2 * j] = bf_lo(c[j]); t2[2 * j + 1] = bf_hi(c[j]);
        cs[j] = c0[j]; cs[4 + j] = c1[j]; sn[j] = s0[j]; sn[4 + j] = s1[j]; }
#pragma unroll
      for (int j = 0; j < 8; ++j) { o1[j] = t1[j] * cs[j] - t2[j] * sn[j]; o2[j] = t2[j] * cs[j] + t1[j] * sn[j]; }
#pragma unroll
      for (int j = 0; j < 4; ++j) { lo[j] = pk_bf16(o1[2 * j], o1[2 * j + 1]); hi[j] = pk_bf16(o2[2 * j], o2[2 * j + 1]); }
    }
    *(u32x4*)(Ksm + kk * 72) = lo; *(u32x4*)(Ksm + kk * 72 + 8) = hi;
  }
  for (int e = tid; e < 192 * 6; e += 256) {
    const int kk = e / 6, ch = 2 + e % 6, pos = kp0 + kk;
    u32x4 v = (u32x4){0, 0, 0, 0};
    if (pos >= 0) v = *(const u32x4*)(h + (size_t)(b * SEQ + pos) * NC + C_SWK + kvh * 64 + ch * 8);
    *(u32x4*)(Ksm + kk * 72 + ch * 8) = v;
  }
  for (int e = tid; e < 192 * 8; e += 256) {
    const int kk = e >> 3, ch = e & 7, pos = kp0 + kk;
    u32x4 v = (u32x4){0, 0, 0, 0};
    if (pos >= 0) v = *(const u32x4*)(h + (size_t)(b * SEQ + pos) * NC + C_SWV + kvh * 64 + ch * 8);
#pragma unroll
    for (int j = 0; j < 4; ++j) { Vt[(ch * 8 + 2 * j) * 200 + kk] = (u16)(v[j] & 0xffffu); Vt[(ch * 8 + 2 * j + 1) * 200 + kk] = (u16)(v[j] >> 16); }
  }
  __syncthreads();
  const int st = wv, jt0 = st < 2 ? st : 2;
  const int qi = 16 * st + r16;
  const int qpos = 64 * qt + qi, tq = b * SEQ + qpos;
#pragma unroll 1
  for (int hq = 0; hq < 4; ++hq) {
    const int head = kvh * 4 + hq;
    u16* qsrc = h + (size_t)tq * NC + C_SWQ + head * 64;
    bf16x8 qf[2];
    {
      const u32x4 a = *(const u32x4*)qsrc, c = *(const u32x4*)(qsrc + 8);
      u32x4 w = *(const u32x4*)(qsrc + 8 * g);
      if (g < 2) {
        const f32x4 c0 = *(const f32x4*)(rc + qpos * 8), c1 = *(const f32x4*)(rc + qpos * 8 + 4);
        const f32x4 s0 = *(const f32x4*)(rs + qpos * 8), s1 = *(const f32x4*)(rs + qpos * 8 + 4);
        float t1[8], t2[8], cs[8], sn[8], o[8];
#pragma unroll
        for (int j = 0; j < 4; ++j) { t1[2 * j] = bf_lo(a[j]); t1[2 * j + 1] = bf_hi(a[j]); t2[2 * j] = bf_lo(c[j]); t2[2 * j + 1] = bf_hi(c[j]);
          cs[j] = c0[j]; cs[4 + j] = c1[j]; sn[j] = s0[j]; sn[4 + j] = s1[j]; }
#pragma unroll
        for (int j = 0; j < 8; ++j) o[j] = (g == 0) ? (t1[j] * cs[j] - t2[j] * sn[j]) : (t2[j] * cs[j] + t1[j] * sn[j]);
#pragma unroll
        for (int j = 0; j < 4; ++j) w[j] = pk_bf16(o[2 * j], o[2 * j + 1]);
      }
      qf[0] = as_bf8(w);
      qf[1] = as_bf8(*(const u32x4*)(qsrc + 32 + 8 * g));
    }
    f32x4 sc[10];
#pragma unroll
    for (int t = 0; t < 10; ++t) {
      sc[t] = (f32x4){0.f, 0.f, 0.f, 0.f};
#pragma unroll
      for (int s = 0; s < 2; ++s) {
        const bf16x8 kf = *(const bf16x8*)(Ksm + (16 * (jt0 + t) + r16) * 72 + 32 * s + 8 * g);
        sc[t] = mfma16(kf, qf[s], sc[t]);
      }
    }
    const float sink = p.sinks[head];
    float mx = sink;
#pragma unroll
    for (int t = 0; t < 10; ++t)
#pragma unroll
      for (int r = 0; r < 4; ++r) {
        const int kk = 16 * (jt0 + t) + 4 * g + r, d = kk - qi;
        const bool ok = (d >= 1) && (d <= 128) && (kp0 + kk >= 0);
        const float v = ok ? sc[t][r] * 0.125f : -1e30f;
        sc[t][r] = v; mx = fmaxf(mx, v);
      }
    mx = fmaxf(mx, __shfl_xor(mx, 16)); mx = fmaxf(mx, __shfl_xor(mx, 32));
    float sum = 0.f;
#pragma unroll
    for (int t = 0; t < 10; ++t)
#pragma unroll
      for (int r = 0; r < 4; ++r) { const float e = __expf(sc[t][r] - mx); sc[t][r] = e; sum += e; }
    sum += __shfl_xor(sum, 16); sum += __shfl_xor(sum, 32);
    const float inv = 1.0f / (sum + __expf(sink - mx));
    f32x4 oacc[4];
#pragma unroll
    for (int dt = 0; dt < 4; ++dt) oacc[dt] = (f32x4){0.f, 0.f, 0.f, 0.f};
#pragma unroll
    for (int s2 = 0; s2 < 5; ++s2) {
      const bf16x8 pb = pack8(sc[2 * s2], sc[2 * s2 + 1]);
#pragma unroll
      for (int dt = 0; dt < 4; ++dt) {
        const u16* vr = Vt + (16 * dt + r16) * 200 + 16 * (jt0 + 2 * s2) + 4 * g;
        const u32x2 lo = *(const u32x2*)vr, hi = *(const u32x2*)(vr + 16);
        oacc[dt] = mfma16(as_bf8((u32x4){lo.x, lo.y, hi.x, hi.y}), pb, oacc[dt]);
      }
    }
#pragma unroll
    for (int dt = 0; dt < 4; ++dt) {
      const int dcol = head * 64 + 16 * dt + 4 * g;
      const u32x2 z = *(const u32x2*)(h + (size_t)tq * NC + C_SWZ + dcol);
      u32x2 w;
      w.x = pk_bf16(oacc[dt][0] * inv * silu_f(bf_lo(z.x)), oacc[dt][1] * inv * silu_f(bf_hi(z.x)));
      w.y = pk_bf16(oacc[dt][2] * inv * silu_f(bf_lo(z.y)), oacc[dt][3] * inv * silu_f(bf_hi(z.y)));
      *(u32x2*)(h + (size_t)tq * NC + C_SWQ + dcol) = w;
    }
  }
}

DI void phase_ya(const Params& p, int wvs) {
  u16* h = (u16*)(p.ws + OFF_H);
  const size_t gt = (size_t)blockIdx.x * 256 + opaque_tid(), gs = (size_t)gridDim.x * 256;
  for (size_t i = gt; i < (size_t)T_TOK * 64; i += gs) {
    const int tok = (int)(i >> 6), c8 = (int)(i & 63);
    u16* ptr = h + (size_t)tok * NC + c8 * 8;
    const u32x4 v = *(const u32x4*)ptr;
    const u32x4 z = *(const u32x4*)(ptr + C_DNZ);
    float o[8]; float ss = 0.f;
#pragma unroll
    for (int j = 0; j < 4; ++j) { o[2 * j] = bf_lo(v[j]); o[2 * j + 1] = bf_hi(v[j]); }
#pragma unroll
    for (int j = 0; j < 8; ++j) ss += o[j] * o[j];
    ss += __shfl_xor(ss, 1); ss += __shfl_xor(ss, 2); ss += __shfl_xor(ss, 4); ss += __shfl_xor(ss, 8);
    const float rs = rsqrtf(ss * (1.0f / 128.0f) + 1e-6f);
    const float* nw = p.dn_norm_w + (c8 & 15) * 8;
    float y[8];
#pragma unroll
    for (int j = 0; j < 4; ++j) {
      y[2 * j] = o[2 * j] * rs * nw[2 * j] * silu_f(bf_lo(z[j]));
      y[2 * j + 1] = o[2 * j + 1] * rs * nw[2 * j + 1] * silu_f(bf_hi(z[j]));
    }
    u32x4 w; w.x = pk_bf16(y[0], y[1]); w.y = pk_bf16(y[2], y[3]); w.z = pk_bf16(y[4], y[5]); w.w = pk_bf16(y[6], y[7]);
    *(u32x4*)ptr = w;
  }
}

DI void phase4(const Params& p, int wvs, unsigned char* smem) {
  const int xcd = blockIdx.x & 7, lb = blockIdx.x >> 3, nlb = gridDim.x >> 3;
  const u16* h = (const u16*)(p.ws + OFF_H);
  const u16* wat = (const u16*)(p.ws + OFF_WAT);
  const u16* wbt = (const u16*)(p.ws + OFF_WBT);
  u16* mg = (u16*)(p.ws + OFF_SC);
  const int tid0 = opaque_tid(); const int lane = tid0 & 63, wv = tid0 >> 6, wm = wv >> 1, wn = wv & 1, r16 = lane & 15, g = lane >> 4;
  for (int li = lb;; li += nlb) {
    int mt, nt; if (!tile_of(li, 8, xcd, mt, nt)) break;
    f32x4 acc[4][4]; zero_acc(acc);
    gemm_kloop(p, wvs, h, NC, wat, 512, 8, mt * 128, nt * 128, acc, smem);
#pragma unroll
    for (int mi = 0; mi < 4; ++mi) {
      const int row = mt * 128 + wm * 64 + mi * 16 + r16;
#pragma unroll
      for (int ni = 0; ni < 4; ++ni) {
        const int col = nt * 128 + wn * 64 + ni * 16 + 4 * g;
        const u32x2 ga = *(const u32x2*)(h + (size_t)row * NC + C_GA + col), gb = *(const u32x2*)(h + (size_t)row * NC + C_GB + col);
        acc[mi][ni][0] *= (1.f + __expf(-bf_lo(gb.x))) / (1.f + __expf(-bf_lo(ga.x)));
        acc[mi][ni][1] *= (1.f + __expf(-bf_hi(gb.x))) / (1.f + __expf(-bf_hi(ga.x)));
        acc[mi][ni][2] *= (1.f + __expf(-bf_lo(gb.y))) / (1.f + __expf(-bf_lo(ga.y)));
        acc[mi][ni][3] *= (1.f + __expf(-bf_hi(gb.y))) / (1.f + __expf(-bf_hi(ga.y)));
      }
      __builtin_amdgcn_sched_barrier(0);
    }
    gemm_kloop(p, wvs, h + C_SWQ, NC, wbt, 512, 8, mt * 128, nt * 128, acc, smem);
#pragma unroll
    for (int mi = 0; mi < 4; ++mi) {
      const int row = mt * 128 + wm * 64 + mi * 16 + r16;
#pragma unroll
      for (int ni = 0; ni < 4; ++ni) {
        const int col = nt * 128 + wn * 64 + ni * 16 + 4 * g;
        const u32x2 gb = *(const u32x2*)(h + (size_t)row * NC + C_GB + col);
        u32x2 w;
        w.x = pk_bf16(acc[mi][ni][0] * sigmoid_f(bf_lo(gb.x)), acc[mi][ni][1] * sigmoid_f(bf_hi(gb.x)));
        w.y = pk_bf16(acc[mi][ni][2] * sigmoid_f(bf_lo(gb.y)), acc[mi][ni][3] * sigmoid_f(bf_hi(gb.y)));
        *(u32x2*)(mg + (size_t)row * 1024 + col) = w;
      }
      __builtin_amdgcn_sched_barrier(0);
    }
  }
}

DI void phase5(const Params& p, int wvs, unsigned char* smem) {
  const int xcd = blockIdx.x & 7, lb = blockIdx.x >> 3, nlb = gridDim.x >> 3;
  const u16* mg = (const u16*)(p.ws + OFF_SC);
  const u16* wot = (const u16*)(p.ws + OFF_WOT);
  const int tid0 = opaque_tid(); const int lane = tid0 & 63, wv = tid0 >> 6, wm = wv >> 1, wn = wv & 1, r16 = lane & 15, g = lane >> 4;
  for (int li = lb;; li += nlb) {
    int mt, nt; if (!tile_of(li, 8, xcd, mt, nt)) break;
    f32x4 acc[4][4]; zero_acc(acc);
    gemm_kloop(p, wvs, mg, 1024, wot, 1024, 16, mt * 128, nt * 128, acc, smem);
#pragma unroll
    for (int mi = 0; mi < 4; ++mi) {
      const int row = mt * 128 + wm * 64 + mi * 16 + r16;
#pragma unroll
      for (int ni = 0; ni < 4; ++ni) {
        const int col = nt * 128 + wn * 64 + ni * 16 + 4 * g;
        const f32x4 xv = *(const f32x4*)(p.x + (size_t)row * 1024 + col);
        *(f32x4*)(p.out + (size_t)row * 1024 + col) = xv * 1.189207115002721f + acc[mi][ni];
      }
    }
  }
}

DI void phase6(const Params& p, int wvs, unsigned char* smem) {
  float* red = (float*)smem;
  const int tid = opaque_tid();
  const float4 gm = ((const float4*)p.ln_g)[tid], bt = ((const float4*)p.ln_b)[tid];
  __syncthreads();
  for (int r = blockIdx.x; r < T_TOK; r += gridDim.x) {
    float4* ptr = (float4*)(p.out + (size_t)r * 1024) + tid;
    const float4 v = *ptr;
    float s = v.x + v.y + v.z + v.w;
#pragma unroll
    for (int o = 32; o > 0; o >>= 1) s += __shfl_xor(s, o);
    if ((tid & 63) == 0) red[tid >> 6] = s;
    __syncthreads();
    const float mu = (red[0] + red[1] + red[2] + red[3]) * (1.0f / 1024.0f);
    const float a = v.x - mu, b = v.y - mu, c = v.z - mu, d = v.w - mu;
    float q = a * a + b * b + c * c + d * d;
#pragma unroll
    for (int o = 32; o > 0; o >>= 1) q += __shfl_xor(q, o);
    if ((tid & 63) == 0) red[4 + (tid >> 6)] = q;
    __syncthreads();
    const float rs = rsqrtf((red[4] + red[5] + red[6] + red[7]) * (1.0f / 1024.0f) + 1e-5f);
    float4 o; o.x = a * rs * gm.x + bt.x; o.y = b * rs * gm.y + bt.y; o.z = c * rs * gm.z + bt.z; o.w = d * rs * gm.w + bt.w;
    *ptr = o;
    __syncthreads();
  }
}

#define XB_TMO      128
#define XB_XCNT(j)  (256  + 64 * (j))
#define XB_XSUB(j)  (1280 + 64 * (j))
#define XB_XGEN(j)  (2304 + 64 * (j))
#define XB_TOP      3328
#define XB_TOPGEN   3392
#define XCD_BAR_WORDS 3456
#define XB_SPIN_CAP (1u << 22)
#define LAS __attribute__((address_space(3)))
DI unsigned xb_ld(unsigned* p) { return __hip_atomic_load(p, __ATOMIC_RELAXED, __HIP_MEMORY_SCOPE_AGENT); }
DI unsigned xb_add(unsigned* p, unsigned v) { return __hip_atomic_fetch_add(p, v, __ATOMIC_RELAXED, __HIP_MEMORY_SCOPE_AGENT); }
DI unsigned xb_xcc_id() { return (unsigned)__builtin_amdgcn_s_getreg((3 << 11) | 20) & 0xFu; }
#define XB_SPIN(cond, bar) do { unsigned _sp = 0; while (cond) { __builtin_amdgcn_s_sleep(1); \
    if ((++_sp & 255u) == 0u) { if (xb_ld(&(bar)[XB_TMO])) break; if (_sp > XB_SPIN_CAP) { atomicAdd(&(bar)[XB_TMO], 1u); break; } } } } while (0)
struct XcdBarrier { unsigned* bar; unsigned x; volatile LAS unsigned* st; };
DI XcdBarrier xcd_barrier_post(unsigned* bar, volatile LAS unsigned* st) {
  XcdBarrier b; b.bar = bar; b.x = xb_xcc_id(); b.st = st;
  if (threadIdx.x == 0) (void)xb_add(&bar[XB_XCNT(b.x)], 1u);
  return b;
}
DI void xcd_barrier_complete(unsigned* bar, unsigned x, unsigned& nloc, unsigned& nx) {
  const unsigned G = gridDim.x * gridDim.y * gridDim.z;
  unsigned sum, cnt, mine, sp = 0u;
  for (;;) {
    sum = 0u; cnt = 0u; mine = 0u;
#pragma unroll
    for (unsigned j = 0; j < 16; ++j) { const unsigned c = xb_ld(&bar[XB_XCNT(j)]); sum += c; cnt += (c > 0u) ? 1u : 0u; mine = (j == x) ? c : mine; }
    if (sum == G) break;
    __builtin_amdgcn_s_sleep(1);
    if ((++sp & 255u) == 0u) { if (xb_ld(&bar[XB_TMO])) break; if (sp > XB_SPIN_CAP) { atomicAdd(&bar[XB_TMO], 1u); break; } }
  }
  nloc = mine > 0u ? mine : 1u; nx = cnt > 0u ? cnt : 1u;
}
DI void xcd_barrier(const XcdBarrier& b) {
  asm volatile("s_waitcnt vmcnt(0)" ::: "memory");
  __syncthreads();
  if (threadIdx.x == 0) {
    unsigned* bar = b.bar;
    __builtin_amdgcn_s_waitcnt(0);
    unsigned nloc = b.st[0], nx = b.st[1];
    if (nloc == 0u) { xcd_barrier_complete(bar, b.x, nloc, nx); b.st[0] = nloc; b.st[1] = nx; }
    const unsigned old = xb_add(&bar[XB_XSUB(b.x)], 1u);
    const unsigned gen = old / nloc;
    if (old + 1u == (gen + 1u) * nloc) {
      __builtin_amdgcn_fence(__ATOMIC_RELEASE, "agent");
      asm volatile("s_waitcnt vmcnt(0)" ::: "memory");
      const unsigned og = xb_add(&bar[XB_TOP], 1u);
      const unsigned tg = og / nx;
      if (og + 1u == (tg + 1u) * nx) xb_add(&bar[XB_TOPGEN], 1u);
      else XB_SPIN(xb_ld(&bar[XB_TOPGEN]) == tg, bar);
      __builtin_amdgcn_fence(__ATOMIC_ACQUIRE, "agent");
      xb_add(&bar[XB_XGEN(b.x)], 1u);
      asm volatile("s_waitcnt vmcnt(0)" ::: "memory");
    } else {
      XB_SPIN(xb_ld(&bar[XB_XGEN(b.x)]) == gen, bar);
      __builtin_amdgcn_fence(__ATOMIC_ACQUIRE, "agent");
      asm volatile("s_waitcnt vmcnt(0)" ::: "memory");
    }
  }
  __syncthreads();
}

#ifndef MK_MULTI
#define MK_MULTI 0
#endif
#define SMEM_DECL __shared__ __attribute__((aligned(16))) unsigned char smem[SMEM_BYTES]; const int wvs = __builtin_amdgcn_readfirstlane((int)(threadIdx.x >> 6));
#if MK_MULTI
__global__ void __launch_bounds__(256, 2) k_p0(Params p) { SMEM_DECL (void)smem; phase0(p, wvs); }
__global__ void __launch_bounds__(256, 2) k_p1(Params p) { SMEM_DECL phase1(p, wvs, smem); }
__global__ void __launch_bounds__(256, 2) k_p2(Params p) { SMEM_DECL for (int it = blockIdx.x; it < 2048; it += gridDim.x) prep_item(p, wvs, it, smem); }
__global__ void __launch_bounds__(256, 2) k_p3(Params p) { SMEM_DECL
  if (blockIdx.x < 128) scan_chain(p, wvs, blockIdx.x, smem);
  else for (int it = blockIdx.x - 128; it < 1024; it += gridDim.x - 128) swa_item(p, wvs, it, smem); }
__global__ void __launch_bounds__(256, 2) k_p3b(Params p) { SMEM_DECL (void)smem; phase_ya(p, wvs); }
__global__ void __launch_bounds__(256, 2) k_p4(Params p) { SMEM_DECL phase4(p, wvs, smem); }
__global__ void __launch_bounds__(256, 2) k_p5(Params p) { SMEM_DECL phase5(p, wvs, smem); }
__global__ void __launch_bounds__(256, 2) k_p6(Params p) { SMEM_DECL phase6(p, wvs, smem); }
#else
__global__ void __launch_bounds__(256, 2) fwd_megakernel(Params p) {
  cg::grid_group grid = cg::this_grid();
  SMEM_DECL
  volatile LAS unsigned* st = (volatile LAS unsigned*)(smem + SMEM_BYTES - 16);
  if (threadIdx.x < 4) st[threadIdx.x] = 0u;
  __syncthreads();
  const XcdBarrier xb = xcd_barrier_post((unsigned*)(p.ws + OFF_BAR), st);
  phase0(p, wvs);
  if (p.ws == nullptr) grid.sync();
  xcd_barrier(xb);
  phase1(p, wvs, smem);
  xcd_barrier(xb);
  for (int it = blockIdx.x; it < 2048; it += gridDim.x) prep_item(p, wvs, it, smem);
  xcd_barrier(xb);
  if (blockIdx.x < 128) scan_chain(p, wvs, blockIdx.x, smem);
  else for (int it = blockIdx.x - 128; it < 1024; it += gridDim.x - 128) swa_item(p, wvs, it, smem);
  xcd_barrier(xb);
  phase_ya(p, wvs);
  xcd_barrier(xb);
  phase4(p, wvs, smem);
  xcd_barrier(xb);
  phase5(p, wvs, smem);
  xcd_barrier(xb);
  phase6(p, wvs, smem);
}
#endif

extern "C" void kernel_launch(void* const* d_in, const int* in_sizes, int n_in, void* d_out, int out_size,
                              void* d_ws, size_t ws_size, hipStream_t stream) {
  if (ws_size < WS_NEED) { fprintf(stderr, "workspace too small: %zu < %zu\n", ws_size, (size_t)WS_NEED); return; }
  Params p{};
  p.x = (const float*)d_in[0]; p.w_in = (const float*)d_in[1]; p.conv_w = (const float*)d_in[2]; p.a_log = (const float*)d_in[3];
  p.dt_bias = (const float*)d_in[4]; p.dn_norm_w = (const float*)d_in[5]; p.sinks = (const float*)d_in[6];
  p.w_branch = (const float*)d_in[7]; p.w_out = (const float*)d_in[8]; p.ln_g = (const float*)d_in[9]; p.ln_b = (const float*)d_in[10];
  p.out = (float*)d_out; p.ws = (unsigned char*)d_ws;
  for (int i = 0; i < 8; ++i) p.inv_freq[i] = (float)std::pow(500000.0, -(double)i / 8.0);
#if MK_MULTI
  const dim3 g(512), b(256);
  k_p0<<<g, b, 0, stream>>>(p);
  k_p1<<<g, b, 0, stream>>>(p);
  k_p2<<<g, b, 0, stream>>>(p);
  k_p3<<<g, b, 0, stream>>>(p);
  k_p3b<<<g, b, 0, stream>>>(p);
  k_p4<<<g, b, 0, stream>>>(p);
  k_p5<<<g, b, 0, stream>>>(p);
  k_p6<<<g, b, 0, stream>>>(p);
#else
  static int grid_blocks = 0;
  if (!grid_blocks) {
    int dev = 0, cus = 0, per_cu = 0;
    (void)hipGetDevice(&dev);
    (void)hipDeviceGetAttribute(&cus, hipDeviceAttributeMultiprocessorCount, dev);
    (void)hipOccupancyMaxActiveBlocksPerMultiprocessor(&per_cu, fwd_megakernel, 256, 0);
    if (per_cu > 2) per_cu = 2;
    if (per_cu < 1) per_cu = 1;
    grid_blocks = cus * per_cu;
    grid_blocks &= ~7;
  }
  (void)hipMemsetAsync(p.ws + OFF_BAR, 0, BAR_BYTES, stream);
  void* args[] = {&p};
  hipError_t e = hipLaunchCooperativeKernel((void*)fwd_megakernel, dim3(grid_blocks), dim3(256), args, 0, stream);
  if (e != hipSuccess) fprintf(stderr, "cooperative launch failed: %s (grid %d)\n", hipGetErrorString(e), grid_blocks);
#endif
}
```

```cpp
#include <hip/hip_runtime.h>
#include <hip/hip_cooperative_groups.h>
#include <cstdio>
#include <cmath>
namespace cg = cooperative_groups;

typedef unsigned short u16;
typedef short bf16x8 __attribute__((ext_vector_type(8)));
typedef float f32x4 __attribute__((ext_vector_type(4)));
typedef unsigned u32x4 __attribute__((ext_vector_type(4)));
typedef unsigned u32x2 __attribute__((ext_vector_type(2)));
#define DI __device__ __forceinline__
DI int opaque_tid_(int wave_s) { int t = (int)__builtin_amdgcn_mbcnt_hi(~0u, __builtin_amdgcn_mbcnt_lo(~0u, 0u)) + (wave_s << 6); asm volatile("" : "+v"(t)); return t; }
#define opaque_tid() opaque_tid_(wvs)

constexpr int T_TOK = 32768, SEQ = 8192, DM = 1024, NC = 5384, NCP = 5632;
constexpr int C_DNZ = 1536, C_SWQ = 2056, C_SWK = 2568, C_SWV = 2696, C_SWZ = 2824, C_GA = 3336, C_GB = 4360;
constexpr size_t OFF_BAR = 0;
constexpr size_t BAR_BYTES = 16384;
constexpr size_t OFF_WINT = BAR_BYTES;
constexpr size_t OFF_WAT = OFF_WINT + (size_t)NCP * 1024 * 2;
constexpr size_t OFF_WBT = OFF_WAT + 1024 * 512 * 2;
constexpr size_t OFF_WOT = OFF_WBT + 1024 * 512 * 2;
constexpr size_t OFF_ROPE = OFF_WOT + 1024 * 1024 * 2;
constexpr size_t OFF_HB = OFF_ROPE + 2 * 8192 * 8 * 4;
constexpr size_t OFF_DEC = OFF_HB + (size_t)T_TOK * 8 * 4;
constexpr size_t OFF_H = OFF_DEC + 2048 * 4;
constexpr size_t OFF_SC = OFF_H + (size_t)T_TOK * NC * 2;
constexpr size_t OPB = 73728;
constexpr size_t WS_NEED = OFF_SC + 2048 * OPB;
constexpr int SMEM_BYTES = 73728 + 16;

struct Params {
  const float *x, *w_in, *conv_w, *a_log, *dt_bias, *dn_norm_w, *sinks, *w_branch, *w_out, *ln_g, *ln_b;
  float* out; unsigned char* ws;
  float inv_freq[8];
};

typedef __bf16 bf16x2_t __attribute__((ext_vector_type(2)));
typedef float f32x2_t __attribute__((ext_vector_type(2)));
DI unsigned pk_bf16(float lo, float hi) { f32x2_t f = {lo, hi}; bf16x2_t v = __builtin_convertvector(f, bf16x2_t); return __builtin_bit_cast(unsigned, v); }
DI float bf_lo(unsigned u) { return __uint_as_float(u << 16); }
DI float bf_hi(unsigned u) { return __uint_as_float(u & 0xffff0000u); }
DI float bf2f(u16 v) { return __uint_as_float(((unsigned)v) << 16); }
DI u16 f2bf(float f) { return (u16)(pk_bf16(f, f) & 0xffffu); }
DI float shx(float v, int m, int lane) { return __uint_as_float((unsigned)__builtin_amdgcn_ds_bpermute((lane ^ m) << 2, (int)__float_as_uint(v))); }
DI float rcp_f(float y) { return __builtin_amdgcn_rcpf(y); }
DI float silu_f(float y) { return y * rcp_f(1.0f + __expf(-y)); }
DI float sigmoid_f(float y) { return rcp_f(1.0f + __expf(-y)); }
DI f32x4 mfma16(bf16x8 a, bf16x8 b, f32x4 c) { return __builtin_amdgcn_mfma_f32_16x16x32_bf16(a, b, c, 0, 0, 0); }
DI bf16x8 as_bf8(u32x4 v) { return __builtin_bit_cast(bf16x8, v); }
DI bf16x8 pack8(f32x4 a, f32x4 b) { u32x4 w; w.x = pk_bf16(a[0], a[1]); w.y = pk_bf16(a[2], a[3]); w.z = pk_bf16(b[0], b[1]); w.w = pk_bf16(b[2], b[3]); return as_bf8(w); }

DI void phase0(const Params& p, int wvs) {
  const size_t gt = (size_t)blockIdx.x * 256 + opaque_tid(), gs = (size_t)gridDim.x * 256;
  {
    u32x4* xb = (u32x4*)(p.ws + OFF_SC);
    const float4* xs = (const float4*)p.x;
    for (size_t i = gt; i < (size_t)T_TOK * DM / 8; i += gs) {
      const float4 a = xs[2 * i], b = xs[2 * i + 1];
      u32x4 w; w.x = pk_bf16(a.x, a.y); w.y = pk_bf16(a.z, a.w); w.z = pk_bf16(b.x, b.y); w.w = pk_bf16(b.z, b.w);
      xb[i] = w;
    }
  }
  {
    u32x4* wt = (u32x4*)(p.ws + OFF_WINT);
    for (size_t i = gt; i < (size_t)NCP * 128; i += gs) {
      const int kc = (int)(i / NCP), n = (int)(i % NCP);
      float v[8];
#pragma unroll
      for (int j = 0; j < 8; ++j) v[j] = (n < NC) ? p.w_in[(size_t)(kc * 8 + j) * NC + n] : 0.f;
      u32x4 w; w.x = pk_bf16(v[0], v[1]); w.y = pk_bf16(v[2], v[3]); w.z = pk_bf16(v[4], v[5]); w.w = pk_bf16(v[6], v[7]);
      wt[(size_t)n * 128 + kc] = w;
    }
  }
  {
    for (size_t i = gt; i < (size_t)2 * 1024 * 64; i += gs) {
      const int br = (int)(i / (1024 * 64)), rem = (int)(i % (1024 * 64)), kc = rem / 1024, n = rem % 1024;
      const float* src = p.w_branch + (size_t)br * 512 * 1024;
      float v[8];
#pragma unroll
      for (int j = 0; j < 8; ++j) v[j] = src[(size_t)(kc * 8 + j) * 1024 + n];
      u32x4 w; w.x = pk_bf16(v[0], v[1]); w.y = pk_bf16(v[2], v[3]); w.z = pk_bf16(v[4], v[5]); w.w = pk_bf16(v[6], v[7]);
      ((u32x4*)(p.ws + (br ? OFF_WBT : OFF_WAT)))[(size_t)n * 64 + kc] = w;
    }
  }
  {
    for (size_t i = gt; i < (size_t)1024 * 128; i += gs) {
      const int kc = (int)(i / 1024), n = (int)(i % 1024);
      float v[8];
#pragma unroll
      for (int j = 0; j < 8; ++j) v[j] = p.w_out[(size_t)(kc * 8 + j) * 1024 + n];
      u32x4 w; w.x = pk_bf16(v[0], v[1]); w.y = pk_bf16(v[2], v[3]); w.z = pk_bf16(v[4], v[5]); w.w = pk_bf16(v[6], v[7]);
      ((u32x4*)(p.ws + OFF_WOT))[(size_t)n * 128 + kc] = w;
    }
  }
  {
    float* rc = (float*)(p.ws + OFF_ROPE); float* rs = rc + 8192 * 8;
    for (size_t i = gt; i < 8192 * 8; i += gs) {
      const int t = (int)(i >> 3), f = (int)(i & 7);
      const float ang = (float)t * p.inv_freq[f];
      const double a = (double)ang;
      const double k = __builtin_rint(a * 0.15915494309189535);
      const float r = (float)(a - k * 6.283185307179586);
      rc[i] = cosf(r); rs[i] = sinf(r);
    }
  }
}

DI int lds_off32(int row, int chunk) { return row * 64 + ((chunk ^ ((0 - (row >> 2)) & 3)) << 4); }
constexpr int GSTAGE = 24576;

DI void gemm_kloop(const Params& p, int wvs, const u16* __restrict__ A, int lda, const u16* __restrict__ Bt, int ldb, int nk, int m0, int n0,
                   f32x4 (&acc)[4][8], unsigned char* smem) {
  const int tid = opaque_tid(), lane = tid & 63, wv = tid >> 6, wm = wv >> 1, wn = wv & 1, r16 = lane & 15, g = lane >> 4;
  const int prow = lane >> 2, pc = (lane & 3) ^ ((0 - (prow >> 2)) & 3);
  const u16* ap = A + (size_t)(m0 + 16 * wv + prow) * lda + pc * 8;
  const u16* bp = Bt + (size_t)(n0 + 16 * wv + prow) * ldb + pc * 8;
  unsigned char* lA = smem + wv * 1024;
  unsigned char* lB = smem + 8192 + wv * 1024;
#define GEMM_ISSUE(kt_, buf_) do { \
    _Pragma("unroll") for (int i_ = 0; i_ < 2; ++i_) \
      __builtin_amdgcn_global_load_lds((const unsigned*)(ap + (size_t)(64 * i_) * lda + (kt_) * 32), (unsigned*)(lA + (buf_) * GSTAGE + i_ * 4096), 16, 0, 0); \
    _Pragma("unroll") for (int i_ = 0; i_ < 4; ++i_) \
      __builtin_amdgcn_global_load_lds((const unsigned*)(bp + (size_t)(64 * i_) * ldb + (kt_) * 32), (unsigned*)(lB + (buf_) * GSTAGE + i_ * 4096), 16, 0, 0); \
  } while (0)
  GEMM_ISSUE(0, 0);
  GEMM_ISSUE(1, 1);
  asm volatile("s_waitcnt vmcnt(6)" ::: "memory");
  __builtin_amdgcn_s_barrier();
  int cb = 0;
  for (int kt = 0; kt < nk; ++kt) {
    int ib = cb + 2; if (ib >= 3) ib -= 3;
    const bool more = (kt + 2 < nk);
    if (more) GEMM_ISSUE(kt + 2, ib);
    const unsigned char* cur = smem + cb * GSTAGE;
    bf16x8 af[4], bfr[8];
#pragma unroll
    for (int i = 0; i < 4; ++i) af[i] = *(const bf16x8*)(cur + lds_off32(wm * 64 + i * 16 + r16, g));
#pragma unroll
    for (int i = 0; i < 8; ++i) bfr[i] = *(const bf16x8*)(cur + 8192 + lds_off32(wn * 128 + i * 16 + r16, g));
#pragma unroll
    for (int mi = 0; mi < 4; ++mi)
#pragma unroll
      for (int ni = 0; ni < 8; ++ni) acc[mi][ni] = mfma16(bfr[ni], af[mi], acc[mi][ni]);
    if (more) asm volatile("s_waitcnt vmcnt(6)" ::: "memory"); else asm volatile("s_waitcnt vmcnt(0)" ::: "memory");
    asm volatile("s_waitcnt lgkmcnt(0)" ::: "memory");
    __builtin_amdgcn_s_barrier();
    cb = cb + 1; if (cb >= 3) cb = 0;
  }
#undef GEMM_ISSUE
}

DI bool tile_of(int li, int ntn, int xcd, int& mt, int& nt) {
  if (li >= 32 * ntn) return false;
  const int grp = li / (8 * ntn), rem = li % (8 * ntn);
  nt = rem >> 3; mt = 32 * xcd + grp * 8 + (rem & 7);
  return true;
}

DI void zero_acc(f32x4 (&acc)[4][8]) {
#pragma unroll
  for (int i = 0; i < 4; ++i)
#pragma unroll
    for (int j = 0; j < 8; ++j) acc[i][j] = (f32x4){0.f, 0.f, 0.f, 0.f};
}

DI void phase1(const Params& p, int wvs, unsigned char* smem) {
  const int xcd = blockIdx.x & 7, lb = blockIdx.x >> 3, nlb = gridDim.x >> 3;
  const u16* xb = (const u16*)(p.ws + OFF_SC);
  const u16* wint = (const u16*)(p.ws + OFF_WINT);
  u16* h = (u16*)(p.ws + OFF_H);
  float* hb = (float*)(p.ws + OFF_HB);
  const int tid0 = opaque_tid(); const int lane = tid0 & 63, wv = tid0 >> 6, wm = wv >> 1, wn = wv & 1, r16 = lane & 15, g = lane >> 4;
  for (int li = lb;; li += nlb) {
    int mt, nt; if (!tile_of(li, 22, xcd, mt, nt)) break;
    f32x4 acc[4][8]; zero_acc(acc);
    gemm_kloop(p, wvs, xb, 1024, wint, 1024, 32, mt * 128, nt * 256, acc, smem);
#pragma unroll
    for (int mi = 0; mi < 4; ++mi) {
      const int row = mt * 128 + wm * 64 + mi * 16 + r16;
#pragma unroll
      for (int ni = 0; ni < 8; ++ni) {
        const int col = nt * 256 + wn * 128 + ni * 16 + 4 * g;
        if (col < NC) {
          u32x2 w; w.x = pk_bf16(acc[mi][ni][0], acc[mi][ni][1]); w.y = pk_bf16(acc[mi][ni][2], acc[mi][ni][3]);
          *(u32x2*)(h + (size_t)row * NC + col) = w;
          if (col >= 2048 && col < 2056) *(f32x4*)(hb + (size_t)row * 8 + (col - 2048)) = acc[mi][ni];
        }
      }
    }
  }
}

template <int I, int M4> DI void solve_part(const float (&xv)[64], const float* Lrow, float& a0, float& a1, float& a2, float& a3) {
  if constexpr (4 * M4 < I) {
    const f32x4 l = *(const f32x4*)(Lrow + 4 * M4);
    if constexpr (4 * M4 + 0 < I) a0 -= l[0] * xv[4 * M4 + 0];
    if constexpr (4 * M4 + 1 < I) a1 -= l[1] * xv[4 * M4 + 1];
    if constexpr (4 * M4 + 2 < I) a2 -= l[2] * xv[4 * M4 + 2];
    if constexpr (4 * M4 + 3 < I) a3 -= l[3] * xv[4 * M4 + 3];
    solve_part<I, M4 + 1>(xv, Lrow, a0, a1, a2, a3);
  }
}
template <int I> DI void solve_rows(float (&xv)[64], const float* Lm) {
  if constexpr (I < 64) {
    float a0 = xv[I], a1 = 0.f, a2 = 0.f, a3 = 0.f;
    solve_part<I, 0>(xv, Lm + I * 68, a0, a1, a2, a3);
    xv[I] = (a0 + a1) + (a2 + a3);
    if constexpr ((I & 1) == 1) __builtin_amdgcn_sched_barrier(0);
    solve_rows<I + 1>(xv, Lm);
  }
}

DI void prep_item(const Params& p, int wvs, int item, unsigned char* smem) {
  const int tid_ = opaque_tid();
  const int tid = tid_, lane = tid & 63, wv = tid >> 6, r16 = lane & 15, g = lane >> 4;
  const int hd = item & 3, n = (item >> 2) & 127, b = item >> 9;
  const int t0 = b * SEQ + n * 64;
  u16* Qs = (u16*)smem; u16* Ks = Qs + 64 * 136; u16* Vs = Ks + 64 * 136;
  float* Lm = (float*)(smem + 52224);
  float* sm_beta = (float*)(smem + 69632);
  float* sm_gc = sm_beta + 64; float* sm_rq = sm_gc + 64; float* sm_rk = sm_rq + 64;
  float* sm_fw = sm_rk + 64; float* sm_fq = sm_fw + 64; float* sm_fk = sm_fq + 64;
  const u16* h = (const u16*)(p.ws + OFF_H);
  const float* hb = (const float*)(p.ws + OFF_HB);
  unsigned char* op = p.ws + OFF_SC + (size_t)item * OPB;
  __syncthreads();
  {
    const int c2 = tid & 63, rbase = (tid >> 6) * 16;
#pragma unroll
    for (int mat = 0; mat < 3; ++mat) {
      const int col = mat * 512 + hd * 128 + 2 * c2;
      float wa[4], wb[4];
#pragma unroll
      for (int j = 0; j < 4; ++j) { wa[j] = p.conv_w[j * 1536 + col]; wb[j] = p.conv_w[j * 1536 + col + 1]; }
      float xa[3], xb[3];
#pragma unroll
      for (int j = 0; j < 3; ++j) {
        const int pos = n * 64 + rbase - 3 + j;
        unsigned v = 0;
        if (pos >= 0) v = *(const unsigned*)(h + (size_t)(t0 + rbase - 3 + j) * NC + col);
        xa[j] = bf_lo(v); xb[j] = bf_hi(v);
      }
      u16* dst = (mat == 0 ? Qs : (mat == 1 ? Ks : Vs));
#pragma unroll
      for (int i = 0; i < 16; ++i) {
        const unsigned v = *(const unsigned*)(h + (size_t)(t0 + rbase + i) * NC + col);
        const float a3 = bf_lo(v), b3 = bf_hi(v);
        const float ya = wa[0] * xa[0] + wa[1] * xa[1] + wa[2] * xa[2] + wa[3] * a3;
        const float yb = wb[0] * xb[0] + wb[1] * xb[1] + wb[2] * xb[2] + wb[3] * b3;
        xa[0] = xa[1]; xa[1] = xa[2]; xa[2] = a3; xb[0] = xb[1]; xb[1] = xb[2]; xb[2] = b3;
        *(unsigned*)(dst + (rbase + i) * 136 + 2 * c2) = pk_bf16(silu_f(ya), silu_f(yb));
      }
    }
  }
  __syncthreads();
  if (wv == 0) {
    const int row = t0 + lane;
    const float bl = hb[(size_t)row * 8 + hd], al = hb[(size_t)row * 8 + 4 + hd];
    const float xx = al + p.dt_bias[hd];
    const float sp = xx > 20.f ? xx : log1pf(expf(xx));
    float gg = -expf(p.a_log[hd]) * sp;
#pragma unroll
    for (int o = 1; o < 64; o <<= 1) { const float t = __uint_as_float((unsigned)__builtin_amdgcn_ds_bpermute(((lane - o) & 63) << 2, (int)__float_as_uint(gg))); if (lane >= o) gg += t; }
    sm_beta[lane] = 1.0f / (1.0f + expf(-bl)); sm_gc[lane] = gg;
  } else if (wv <= 2) {
    const int r = tid - 64;
    const u16* src = (r < 64) ? (Qs + r * 136) : (Ks + (r - 64) * 136);
    float ss = 0.f;
#pragma unroll
    for (int c = 0; c < 16; ++c) {
      const u32x4 v = *(const u32x4*)(src + c * 8);
#pragma unroll
      for (int j = 0; j < 4; ++j) { const float a = bf_lo(v[j]), bb = bf_hi(v[j]); ss += a * a + bb * bb; }
    }
    const float rs = rsqrtf(ss + 1e-6f);
    if (r < 64) sm_rq[r] = rs; else sm_rk[r - 64] = rs;
  }
  __syncthreads();
  if (tid < 64) {
    const float gc = sm_gc[tid], gl = sm_gc[63], eg = expf(gc);
    sm_fw[tid] = sm_beta[tid] * eg * sm_rk[tid];
    sm_fq[tid] = sm_rq[tid] * 0.08838834764831845f * eg;
    sm_fk[tid] = sm_rk[tid] * expf(gl - gc);
    if (tid == 0) ((float*)(p.ws + OFF_DEC))[item] = expf(gl);
  }
  {
    bf16x8 kfi[4], qfi[4];
#pragma unroll
    for (int s = 0; s < 4; ++s) {
      kfi[s] = *(const bf16x8*)(Ks + (16 * wv + r16) * 136 + 32 * s + 8 * g);
      qfi[s] = *(const bf16x8*)(Qs + (16 * wv + r16) * 136 + 32 * s + 8 * g);
    }
    f32x4 at[4];
#pragma unroll
    for (int jt = 0; jt < 4; ++jt) {
      at[jt] = (f32x4){0.f, 0.f, 0.f, 0.f};
      if (jt <= wv) {
        f32x4 la = (f32x4){0.f, 0.f, 0.f, 0.f}, aa = (f32x4){0.f, 0.f, 0.f, 0.f};
#pragma unroll
        for (int s = 0; s < 4; ++s) {
          const bf16x8 kfj = *(const bf16x8*)(Ks + (16 * jt + r16) * 136 + 32 * s + 8 * g);
          la = mfma16(kfi[s], kfj, la);
          aa = mfma16(kfj, qfi[s], aa);
        }
#pragma unroll
        for (int r = 0; r < 4; ++r) {
          { const int i = 16 * wv + 4 * g + r, j = 16 * jt + r16;
            const float v = (i > j) ? sm_beta[i] * sm_rk[i] * sm_rk[j] * __expf(sm_gc[i] - sm_gc[j]) * la[r] : 0.f;
            Lm[i * 68 + j] = v; }
          { const int j = 16 * jt + 4 * g + r, i = 16 * wv + r16;
            at[jt][r] = (j <= i) ? sm_rq[i] * sm_rk[j] * 0.08838834764831845f * __expf(sm_gc[i] - sm_gc[j]) * aa[r] : 0.f; }
        }
      }
    }
#pragma unroll
    for (int s2 = 0; s2 < 2; ++s2)
      *(bf16x8*)(op + 32768 + (size_t)((wv * 2 + s2) * 64 + lane) * 16) = pack8(at[2 * s2], at[2 * s2 + 1]);
  }
  __syncthreads();
  float xv[64];
  if (tid < 128) {
#pragma unroll
    for (int i = 0; i < 64; ++i) xv[i] = sm_beta[i] * bf2f(Vs[i * 136 + tid]);
  } else {
#pragma unroll
    for (int i = 0; i < 64; ++i) xv[i] = sm_fw[i] * bf2f(Ks[i * 136 + tid - 128]);
  }
  solve_rows<1>(xv, Lm);
  if (tid < 128) {
    const int sl = tid >> 4, dvl = tid & 15;
#pragma unroll
    for (int mt = 0; mt < 4; ++mt)
#pragma unroll
      for (int gg = 0; gg < 4; ++gg) {
        u32x2 w; w.x = pk_bf16(xv[16 * mt + 4 * gg], xv[16 * mt + 4 * gg + 1]); w.y = pk_bf16(xv[16 * mt + 4 * gg + 2], xv[16 * mt + 4 * gg + 3]);
        *(u32x2*)(op + 57344 + (size_t)((sl * 4 + mt) * 64 + gg * 16 + dvl) * 8) = w;
      }
  }
  __syncthreads();
  if (tid >= 128) {
#pragma unroll
    for (int i = 0; i < 64; ++i) Vs[i * 136 + tid - 128] = f2bf(-xv[i]);
  }
  __syncthreads();
#pragma unroll
  for (int f = 0; f < 4; ++f) {
    const int e = tid + 256 * f, frag = e >> 6, ln = e & 63, lr = ln & 15, lg = ln >> 4;
    {
      const int mt = frag >> 2, s = frag & 3, row = 16 * mt + lr;
      const u32x2 lo = *(const u32x2*)(Vs + row * 136 + 32 * s + 4 * lg), hi = *(const u32x2*)(Vs + row * 136 + 32 * s + 16 + 4 * lg);
      *(u32x4*)(op + (size_t)e * 16) = (u32x4){lo.x, lo.y, hi.x, hi.y};
      const u32x2 ql = *(const u32x2*)(Qs + row * 136 + 32 * s + 4 * lg), qh = *(const u32x2*)(Qs + row * 136 + 32 * s + 16 + 4 * lg);
      const float fq = sm_fq[row];
      u32x4 w;
      w.x = pk_bf16(bf_lo(ql.x) * fq, bf_hi(ql.x) * fq); w.y = pk_bf16(bf_lo(ql.y) * fq, bf_hi(ql.y) * fq);
      w.z = pk_bf16(bf_lo(qh.x) * fq, bf_hi(qh.x) * fq); w.w = pk_bf16(bf_lo(qh.y) * fq, bf_hi(qh.y) * fq);
      *(u32x4*)(op + 16384 + (size_t)e * 16) = w;
    }
    {
      const int mt8 = frag >> 1, s2 = frag & 1, dk = 16 * mt8 + lr;
      float v[8];
#pragma unroll
      for (int j = 0; j < 8; ++j) {
        const int pos = 32 * s2 + 16 * (j >> 2) + 4 * lg + (j & 3);
        v[j] = bf2f(Ks[pos * 136 + dk]) * sm_fk[pos];
      }
      u32x4 w; w.x = pk_bf16(v[0], v[1]); w.y = pk_bf16(v[2], v[3]); w.z = pk_bf16(v[4], v[5]); w.w = pk_bf16(v[6], v[7]);
      *(u32x4*)(op + 40960 + (size_t)e * 16) = w;
    }
  }
}

struct ScanA { u32x4 wf[4]; u32x2 uf; float dec; };
struct ScanB { u32x4 qf[4], af[2], kf[4]; };

DI void scan_load_a(const Params& p, int wvs, ScanA& o, int b, int hd, int sl, int n, int q, int lane) {
  const int item = (b * 128 + n) * 4 + hd;
  const unsigned char* op = p.ws + OFF_SC + (size_t)item * OPB;
#pragma unroll
  for (int s = 0; s < 4; ++s) {
    o.wf[s] = *(const u32x4*)(op + (size_t)((q * 4 + s) * 64 + lane) * 16);
  }
  o.uf = *(const u32x2*)(op + 57344 + (size_t)((sl * 4 + q) * 64 + lane) * 8);
  o.dec = ((const float*)(p.ws + OFF_DEC))[item];
}
DI void scan_load_b(const Params& p, int wvs, ScanB& o, int b, int hd, int n, int q, int lane) {
  const int item = (b * 128 + n) * 4 + hd;
  const unsigned char* op = p.ws + OFF_SC + (size_t)item * OPB;
#pragma unroll
  for (int s = 0; s < 4; ++s) o.qf[s] = *(const u32x4*)(op + 16384 + (size_t)((q * 4 + s) * 64 + lane) * 16);
#pragma unroll
  for (int s2 = 0; s2 < 2; ++s2) o.af[s2] = *(const u32x4*)(op + 32768 + (size_t)((q * 2 + s2) * 64 + lane) * 16);
#pragma unroll
  for (int j = 0; j < 4; ++j) o.kf[j] = *(const u32x4*)(op + 40960 + (size_t)((q * 4 + j) * 64 + lane) * 16);
}

DI void scan_step(const Params& p, int wvs, const ScanA& o, const ScanB& ob, f32x4 (&S)[2], int b, int hd, int sl, int n, int q, int lane, unsigned char* smem) {
  const int r16 = lane & 15, g = lane >> 4;
  u32x4* ldsS = (u32x4*)smem;
  u32x2* ldsV = (u32x2*)(smem + 4096);
  ldsS[q * 64 + lane] = __builtin_bit_cast(u32x4, pack8(S[0], S[1]));
  __syncthreads();
  bf16x8 Sb[4];
#pragma unroll
  for (int s = 0; s < 4; ++s) Sb[s] = as_bf8(ldsS[s * 64 + lane]);
  f32x4 vn = (f32x4){bf_lo(o.uf.x), bf_hi(o.uf.x), bf_lo(o.uf.y), bf_hi(o.uf.y)};
#pragma unroll
  for (int s = 0; s < 4; ++s) vn = mfma16(as_bf8(o.wf[s]), Sb[s], vn);
  { u32x2 w; w.x = pk_bf16(vn[0], vn[1]); w.y = pk_bf16(vn[2], vn[3]); ldsV[((q >> 1) * 64 + lane) * 2 + (q & 1)] = w; }
  f32x4 oa = (f32x4){0.f, 0.f, 0.f, 0.f};
#pragma unroll
  for (int s = 0; s < 4; ++s) oa = mfma16(as_bf8(ob.qf[s]), Sb[s], oa);
  __syncthreads();
  bf16x8 Vb[2];
#pragma unroll
  for (int s2 = 0; s2 < 2; ++s2) Vb[s2] = as_bf8(*(const u32x4*)(ldsV + (s2 * 64 + lane) * 2));
#pragma unroll
  for (int s2 = 0; s2 < 2; ++s2) oa = mfma16(as_bf8(ob.af[s2]), Vb[s2], oa);
  u16* h = (u16*)(p.ws + OFF_H);
  const int t0 = b * SEQ + n * 64;
#pragma unroll
  for (int r = 0; r < 4; ++r) h[(size_t)(t0 + 16 * q + 4 * g + r) * NC + hd * 128 + 16 * sl + r16] = f2bf(oa[r]);
#pragma unroll
  for (int t = 0; t < 2; ++t) {
    S[t] = S[t] * o.dec;
#pragma unroll
    for (int s2 = 0; s2 < 2; ++s2) S[t] = mfma16(as_bf8(ob.kf[t * 2 + s2]), Vb[s2], S[t]);
  }
}

DI void scan_chain(const Params& p, int wvs, int chain, unsigned char* smem) {
  const int tid0 = opaque_tid(); const int lane = tid0 & 63, q = tid0 >> 6;
  const int xcd = chain & 7, j = chain >> 3, pair = xcd + 8 * (j >> 3), sl = j & 7, b = pair >> 2, hd = pair & 3;
  f32x4 S[2]; S[0] = (f32x4){0.f, 0.f, 0.f, 0.f}; S[1] = S[0];
  ScanA a0, a1, a2; ScanB bc, bn;
  __syncthreads();
  scan_load_a(p, wvs, a0, b, hd, sl, 0, q, lane);
  scan_load_b(p, wvs, bc, b, hd, 0, q, lane);
  scan_load_a(p, wvs, a1, b, hd, sl, 1, q, lane);
#pragma unroll 1
  for (int n = 0; n < 129; n += 3) {
    if (n + 2 < 128) scan_load_a(p, wvs, a2, b, hd, sl, n + 2, q, lane);
    if (n + 1 < 128) scan_load_b(p, wvs, bn, b, hd, n + 1, q, lane);
    if (n < 128) scan_step(p, wvs, a0, bc, S, b, hd, sl, n, q, lane, smem);
    bc = bn;
    if (n + 3 < 128) scan_load_a(p, wvs, a0, b, hd, sl, n + 3, q, lane);
    if (n + 2 < 128) scan_load_b(p, wvs, bn, b, hd, n + 2, q, lane);
    if (n + 1 < 128) scan_step(p, wvs, a1, bc, S, b, hd, sl, n + 1, q, lane, smem);
    bc = bn;
    if (n + 4 < 128) scan_load_a(p, wvs, a1, b, hd, sl, n + 4, q, lane);
    if (n + 3 < 128) scan_load_b(p, wvs, bn, b, hd, n + 3, q, lane);
    if (n + 2 < 128) scan_step(p, wvs, a2, bc, S, b, hd, sl, n + 2, q, lane, smem);
    bc = bn;
  }
}

DI void swa_item(const Params& p, int wvs, int item, unsigned char* smem) {
  const int tid_ = opaque_tid();
  const int tid = tid_, lane = tid & 63, wv = tid >> 6, r16 = lane & 15, g = lane >> 4;
  const int qt = item & 127, kvh = (item >> 7) & 1, b = item >> 8;
  const int kp0 = 64 * qt - 128;
  u16* Ksm = (u16*)smem;
  u16* Vt = (u16*)(smem + 27648);
  u16* h = (u16*)(p.ws + OFF_H);
  const float* rc = (const float*)(p.ws + OFF_ROPE); const float* rs = rc + 8192 * 8;
  __syncthreads();
  if (tid < 192) {
    const int kk = tid, pos = kp0 + kk;
    u32x4 lo = (u32x4){0, 0, 0, 0}, hi = lo;
    if (pos >= 0) {
      const u16* src = h + (size_t)(b * SEQ + pos) * NC + C_SWK + kvh * 64;
      const u32x4 a = *(const u32x4*)src, c = *(const u32x4*)(src + 8);
      const f32x4 c0 = *(const f32x4*)(rc + pos * 8), c1 = *(const f32x4*)(rc + pos * 8 + 4);
      const f32x4 s0 = *(const f32x4*)(rs + pos * 8), s1 = *(const f32x4*)(rs + pos * 8 + 4);
      float t1[8], t2[8], cs[8], sn[8], o1[8], o2[8];
#pragma unroll
      for (int j = 0; j < 4; ++j) { t1[2 * j] = bf_lo(a[j]); t1[2 * j + 1] = bf_hi(a[j]); t2[2 * j] = bf_lo(c[j]); t2[2 * j + 1] = bf_hi(c[j]);
        cs[j] = c0[j]; cs[4 + j] = c1[j]; sn[j] = s0[j]; sn[4 + j] = s1[j]; }
#pragma unroll
      for (int j = 0; j < 8; ++j) { o1[j] = t1[j] * cs[j] - t2[j] * sn[j]; o2[j] = t2[j] * cs[j] + t1[j] * sn[j]; }
#pragma unroll
      for (int j = 0; j < 4; ++j) { lo[j] = pk_bf16(o1[2 * j], o1[2 * j + 1]); hi[j] = pk_bf16(o2[2 * j], o2[2 * j + 1]); }
    }
    *(u32x4*)(Ksm + kk * 72) = lo; *(u32x4*)(Ksm + kk * 72 + 8) = hi;
  }
  for (int e = tid; e < 192 * 6; e += 256) {
    const int kk = e / 6, ch = 2 + e % 6, pos = kp0 + kk;
    u32x4 v = (u32x4){0, 0, 0, 0};
    if (pos >= 0) v = *(const u32x4*)(h + (size_t)(b * SEQ + pos) * NC + C_SWK + kvh * 64 + ch * 8);
    *(u32x4*)(Ksm + kk * 72 + ch * 8) = v;
  }
  for (int e = tid; e < 192 * 8; e += 256) {
    const int kk = e >> 3, ch = e & 7, pos = kp0 + kk;
    u32x4 v = (u32x4){0, 0, 0, 0};
    if (pos >= 0) v = *(const u32x4*)(h + (size_t)(b * SEQ + pos) * NC + C_SWV + kvh * 64 + ch * 8);
#pragma unroll
    for (int j = 0; j < 4; ++j) { Vt[(ch * 8 + 2 * j) * 200 + kk] = (u16)(v[j] & 0xffffu); Vt[(ch * 8 + 2 * j + 1) * 200 + kk] = (u16)(v[j] >> 16); }
  }
  __syncthreads();
  const int st = wv, jt0 = st < 2 ? st : 2;
  const int qi = 16 * st + r16;
  const int qpos = 64 * qt + qi, tq = b * SEQ + qpos;
#pragma unroll 1
  for (int hq = 0; hq < 4; ++hq) {
    const int head = kvh * 4 + hq;
    u16* qsrc = h + (size_t)tq * NC + C_SWQ + head * 64;
    bf16x8 qf[2];
    {
      const u32x4 a = *(const u32x4*)qsrc, c = *(const u32x4*)(qsrc + 8);
      u32x4 w = *(const u32x4*)(qsrc + 8 * g);
      if (g < 2) {
        const f32x4 c0 = *(const f32x4*)(rc + qpos * 8), c1 = *(const f32x4*)(rc + qpos * 8 + 4);
        const f32x4 s0 = *(const f32x4*)(rs + qpos * 8), s1 = *(const f32x4*)(rs + qpos * 8 + 4);
        float t1[8], t2[8], cs[8], sn[8], o[8];
#pragma unroll
        for (int j = 0; j < 4; ++j) { t1[2 * j] = bf_lo(a[j]); t1[2 * j + 1] = bf_hi(a[j]); t2[2 * j] = bf_lo(c[j]); t2[2 * j + 1] = bf_hi(c[j]);
          cs[j] = c0[j]; cs[4 + j] = c1[j]; sn[j] = s0[j]; sn[4 + j] = s1[j]; }
#pragma unroll
        for (int j = 0; j < 8; ++j) o[j] = (g == 0) ? (t1[j] * cs[j] - t2[j] * sn[j]) : (t2[j] * cs[j] + t1[j] * sn[j]);
#pragma unroll
        for (int j = 0; j < 4; ++j) w[j] = pk_bf16(o[2 * j], o[2 * j + 1]);
      }
      qf[0] = as_bf8(w);
      qf[1] = as_bf8(*(const u32x4*)(qsrc + 32 + 8 * g));
    }
    f32x4 sc[10];
#pragma unroll
    for (int t = 0; t < 10; ++t) {
      sc[t] = (f32x4){0.f, 0.f, 0.f, 0.f};
#pragma unroll
      for (int s = 0; s < 2; ++s) {
        const bf16x8 kf = *(const bf16x8*)(Ksm + (16 * (jt0 + t) + r16) * 72 + 32 * s + 8 * g);
        sc[t] = mfma16(kf, qf[s], sc[t]);
      }
    }
    const float sink = p.sinks[head];
    float mx = sink;
#pragma unroll
    for (int t = 0; t < 10; ++t)
#pragma unroll
      for (int r = 0; r < 4; ++r) {
        const int kk = 16 * (jt0 + t) + 4 * g + r, d = kk - qi;
        const bool ok = (d >= 1) && (d <= 128) && (kp0 + kk >= 0);
        const float v = ok ? sc[t][r] * 0.125f : -1e30f;
        sc[t][r] = v; mx = fmaxf(mx, v);
      }
    mx = fmaxf(mx, shx(mx, 16, lane)); mx = fmaxf(mx, shx(mx, 32, lane));
    float sum = 0.f;
#pragma unroll
    for (int t = 0; t < 10; ++t)
#pragma unroll
      for (int r = 0; r < 4; ++r) { const float e = __expf(sc[t][r] - mx); sc[t][r] = e; sum += e; }
    sum += shx(sum, 16, lane); sum += shx(sum, 32, lane);
    const float inv = rcp_f(sum + __expf(sink - mx));
    f32x4 oacc[4];
#pragma unroll
    for (int dt = 0; dt < 4; ++dt) oacc[dt] = (f32x4){0.f, 0.f, 0.f, 0.f};
#pragma unroll
    for (int s2 = 0; s2 < 5; ++s2) {
      const bf16x8 pb = pack8(sc[2 * s2], sc[2 * s2 + 1]);
#pragma unroll
      for (int dt = 0; dt < 4; ++dt) {
        const u16* vr = Vt + (16 * dt + r16) * 200 + 16 * (jt0 + 2 * s2) + 4 * g;
        const u32x2 lo = *(const u32x2*)vr, hi = *(const u32x2*)(vr + 16);
        oacc[dt] = mfma16(as_bf8((u32x4){lo.x, lo.y, hi.x, hi.y}), pb, oacc[dt]);
      }
    }
#pragma unroll
    for (int dt = 0; dt < 4; ++dt) {
      const int dcol = head * 64 + 16 * dt + 4 * g;
      const u32x2 z = *(const u32x2*)(h + (size_t)tq * NC + C_SWZ + dcol);
      u32x2 w;
      w.x = pk_bf16(oacc[dt][0] * inv * silu_f(bf_lo(z.x)), oacc[dt][1] * inv * silu_f(bf_hi(z.x)));
      w.y = pk_bf16(oacc[dt][2] * inv * silu_f(bf_lo(z.y)), oacc[dt][3] * inv * silu_f(bf_hi(z.y)));
      *(u32x2*)(h + (size_t)tq * NC + C_SWQ + dcol) = w;
    }
  }
}

DI void phase_ya(const Params& p, int wvs) {
  u16* h = (u16*)(p.ws + OFF_H);
  const int ltid = opaque_tid(), lane = ltid & 63;
  const size_t gt = (size_t)blockIdx.x * 256 + ltid, gs = (size_t)gridDim.x * 256;
  for (size_t i = gt; i < (size_t)T_TOK * 64; i += gs) {
    const int tok = (int)(i >> 6), c8 = (int)(i & 63);
    u16* ptr = h + (size_t)tok * NC + c8 * 8;
    const u32x4 v = *(const u32x4*)ptr;
    const u32x4 z = *(const u32x4*)(ptr + C_DNZ);
    float o[8]; float ss = 0.f;
#pragma unroll
    for (int j = 0; j < 4; ++j) { o[2 * j] = bf_lo(v[j]); o[2 * j + 1] = bf_hi(v[j]); }
#pragma unroll
    for (int j = 0; j < 8; ++j) ss += o[j] * o[j];
    ss += shx(ss, 1, lane); ss += shx(ss, 2, lane); ss += shx(ss, 4, lane); ss += shx(ss, 8, lane);
    const float rs = rsqrtf(ss * (1.0f / 128.0f) + 1e-6f);
    const float* nw = p.dn_norm_w + (c8 & 15) * 8;
    float y[8];
#pragma unroll
    for (int j = 0; j < 4; ++j) {
      y[2 * j] = o[2 * j] * rs * nw[2 * j] * silu_f(bf_lo(z[j]));
      y[2 * j + 1] = o[2 * j + 1] * rs * nw[2 * j + 1] * silu_f(bf_hi(z[j]));
    }
    u32x4 w; w.x = pk_bf16(y[0], y[1]); w.y = pk_bf16(y[2], y[3]); w.z = pk_bf16(y[4], y[5]); w.w = pk_bf16(y[6], y[7]);
    *(u32x4*)ptr = w;
  }
}

DI void phase4(const Params& p, int wvs, unsigned char* smem) {
  const int xcd = blockIdx.x & 7, lb = blockIdx.x >> 3, nlb = gridDim.x >> 3;
  const u16* h = (const u16*)(p.ws + OFF_H);
  const u16* wat = (const u16*)(p.ws + OFF_WAT);
  const u16* wbt = (const u16*)(p.ws + OFF_WBT);
  u16* mg = (u16*)(p.ws + OFF_SC);
  const int tid0 = opaque_tid(); const int lane = tid0 & 63, wv = tid0 >> 6, wm = wv >> 1, wn = wv & 1, r16 = lane & 15, g = lane >> 4;
  for (int li = lb;; li += nlb) {
    int mt, nt; if (!tile_of(li, 4, xcd, mt, nt)) break;
    f32x4 acc[4][8]; zero_acc(acc);
    gemm_kloop(p, wvs, h, NC, wat, 512, 16, mt * 128, nt * 256, acc, smem);
#pragma unroll
    for (int mi = 0; mi < 4; ++mi) {
      const int row = mt * 128 + wm * 64 + mi * 16 + r16;
#pragma unroll
      for (int ni = 0; ni < 8; ++ni) {
        const int col = nt * 256 + wn * 128 + ni * 16 + 4 * g;
        const u32x2 ga = *(const u32x2*)(h + (size_t)row * NC + C_GA + col), gb = *(const u32x2*)(h + (size_t)row * NC + C_GB + col);
        acc[mi][ni][0] *= (1.f + __expf(-bf_lo(gb.x))) * rcp_f(1.f + __expf(-bf_lo(ga.x)));
        acc[mi][ni][1] *= (1.f + __expf(-bf_hi(gb.x))) * rcp_f(1.f + __expf(-bf_hi(ga.x)));
        acc[mi][ni][2] *= (1.f + __expf(-bf_lo(gb.y))) * rcp_f(1.f + __expf(-bf_lo(ga.y)));
        acc[mi][ni][3] *= (1.f + __expf(-bf_hi(gb.y))) * rcp_f(1.f + __expf(-bf_hi(ga.y)));
      }
      __builtin_amdgcn_sched_barrier(0);
    }
    gemm_kloop(p, wvs, h + C_SWQ, NC, wbt, 512, 16, mt * 128, nt * 256, acc, smem);
#pragma unroll
    for (int mi = 0; mi < 4; ++mi) {
      const int row = mt * 128 + wm * 64 + mi * 16 + r16;
#pragma unroll
      for (int ni = 0; ni < 8; ++ni) {
        const int col = nt * 256 + wn * 128 + ni * 16 + 4 * g;
        const u32x2 gb = *(const u32x2*)(h + (size_t)row * NC + C_GB + col);
        u32x2 w;
        w.x = pk_bf16(acc[mi][ni][0] * sigmoid_f(bf_lo(gb.x)), acc[mi][ni][1] * sigmoid_f(bf_hi(gb.x)));
        w.y = pk_bf16(acc[mi][ni][2] * sigmoid_f(bf_lo(gb.y)), acc[mi][ni][3] * sigmoid_f(bf_hi(gb.y)));
        *(u32x2*)(mg + (size_t)row * 1024 + col) = w;
      }
      __builtin_amdgcn_sched_barrier(0);
    }
  }
}

DI void phase5(const Params& p, int wvs, unsigned char* smem) {
  const int xcd = blockIdx.x & 7, lb = blockIdx.x >> 3, nlb = gridDim.x >> 3;
  const u16* mg = (const u16*)(p.ws + OFF_SC);
  const u16* wot = (const u16*)(p.ws + OFF_WOT);
  const int tid0 = opaque_tid(); const int lane = tid0 & 63, wv = tid0 >> 6, wm = wv >> 1, wn = wv & 1, r16 = lane & 15, g = lane >> 4;
  for (int li = lb;; li += nlb) {
    int mt, nt; if (!tile_of(li, 4, xcd, mt, nt)) break;
    f32x4 acc[4][8]; zero_acc(acc);
    gemm_kloop(p, wvs, mg, 1024, wot, 1024, 32, mt * 128, nt * 256, acc, smem);
#pragma unroll
    for (int mi = 0; mi < 4; ++mi) {
      const int row = mt * 128 + wm * 64 + mi * 16 + r16;
#pragma unroll
      for (int ni = 0; ni < 8; ++ni) {
        const int col = nt * 256 + wn * 128 + ni * 16 + 4 * g;
        const f32x4 xv = *(const f32x4*)(p.x + (size_t)row * 1024 + col);
        *(f32x4*)(p.out + (size_t)row * 1024 + col) = xv * 1.189207115002721f + acc[mi][ni];
      }
    }
  }
}

DI void phase6(const Params& p, int wvs, unsigned char* smem) {
  float* red = (float*)smem;
  const int tid = opaque_tid();
  const float4 gm = ((const float4*)p.ln_g)[tid], bt = ((const float4*)p.ln_b)[tid];
  __syncthreads();
  const int xcd6 = blockIdx.x & 7, lb6 = blockIdx.x >> 3, nlb6 = gridDim.x >> 3;
  for (int lr = lb6; lr < 4096; lr += nlb6) {
    const int r = 4096 * xcd6 + (4095 - lr);
    float4* ptr = (float4*)(p.out + (size_t)r * 1024) + tid;
    const float4 v = *ptr;
    float s = v.x + v.y + v.z + v.w;
#pragma unroll
    for (int o = 32; o > 0; o >>= 1) s += shx(s, o, tid & 63);
    if ((tid & 63) == 0) red[tid >> 6] = s;
    __syncthreads();
    const float mu = (red[0] + red[1] + red[2] + red[3]) * (1.0f / 1024.0f);
    const float a = v.x - mu, b = v.y - mu, c = v.z - mu, d = v.w - mu;
    float q = a * a + b * b + c * c + d * d;
#pragma unroll
    for (int o = 32; o > 0; o >>= 1) q += shx(q, o, tid & 63);
    if ((tid & 63) == 0) red[4 + (tid >> 6)] = q;
    __syncthreads();
    const float rs = rsqrtf((red[4] + red[5] + red[6] + red[7]) * (1.0f / 1024.0f) + 1e-5f);
    float4 o; o.x = a * rs * gm.x + bt.x; o.y = b * rs * gm.y + bt.y; o.z = c * rs * gm.z + bt.z; o.w = d * rs * gm.w + bt.w;
    *ptr = o;
    __syncthreads();
  }
}

#define XB_TMO      128
#define XB_XCNT(j)  (256  + 64 * (j))
#define XB_XSUB(j)  (1280 + 64 * (j))
#define XB_XGEN(j)  (2304 + 64 * (j))
#define XB_TOP      3328
#define XB_TOPGEN   3392
#define XCD_BAR_WORDS 3456
#define XB_SPIN_CAP (1u << 22)
#define LAS __attribute__((address_space(3)))
DI unsigned xb_ld(unsigned* p) { return __hip_atomic_load(p, __ATOMIC_RELAXED, __HIP_MEMORY_SCOPE_AGENT); }
DI unsigned xb_add(unsigned* p, unsigned v) { return __hip_atomic_fetch_add(p, v, __ATOMIC_RELAXED, __HIP_MEMORY_SCOPE_AGENT); }
DI unsigned xb_xcc_id() { return (unsigned)__builtin_amdgcn_s_getreg((3 << 11) | 20) & 0xFu; }
#define XB_SPIN(cond, bar) do { unsigned _sp = 0; while (cond) { __builtin_amdgcn_s_sleep(1); \
    if ((++_sp & 255u) == 0u) { if (xb_ld(&(bar)[XB_TMO])) break; if (_sp > XB_SPIN_CAP) { atomicAdd(&(bar)[XB_TMO], 1u); break; } } } } while (0)
struct XcdBarrier { unsigned* bar; unsigned x; volatile LAS unsigned* st; };
DI bool xb_leader(int wvs) { return wvs == 0 && __builtin_amdgcn_mbcnt_hi(~0u, __builtin_amdgcn_mbcnt_lo(~0u, 0u)) == 0u; }
DI XcdBarrier xcd_barrier_post(unsigned* bar, volatile LAS unsigned* st, int wvs) {
  XcdBarrier b; b.bar = bar; b.x = xb_xcc_id(); b.st = st;
  if (xb_leader(wvs)) (void)xb_add(&bar[XB_XCNT(b.x)], 1u);
  return b;
}
DI void xcd_barrier_complete(unsigned* bar, unsigned x, unsigned& nloc, unsigned& nx) {
  const unsigned G = gridDim.x * gridDim.y * gridDim.z;
  unsigned sum, cnt, mine, sp = 0u;
  for (;;) {
    sum = 0u; cnt = 0u; mine = 0u;
#pragma unroll
    for (unsigned j = 0; j < 16; ++j) { const unsigned c = xb_ld(&bar[XB_XCNT(j)]); sum += c; cnt += (c > 0u) ? 1u : 0u; mine = (j == x) ? c : mine; }
    if (sum == G) break;
    __builtin_amdgcn_s_sleep(1);
    if ((++sp & 255u) == 0u) { if (xb_ld(&bar[XB_TMO])) break; if (sp > XB_SPIN_CAP) { atomicAdd(&bar[XB_TMO], 1u); break; } }
  }
  nloc = mine > 0u ? mine : 1u; nx = cnt > 0u ? cnt : 1u;
}
DI void xcd_barrier_(const XcdBarrier& b, int wvs) {
  asm volatile("s_waitcnt vmcnt(0)" ::: "memory");
  __syncthreads();
  if (xb_leader(wvs)) {
    unsigned* bar = b.bar;
    __builtin_amdgcn_s_waitcnt(0);
    unsigned nloc = b.st[0], nx = b.st[1];
    if (nloc == 0u) { xcd_barrier_complete(bar, b.x, nloc, nx); b.st[0] = nloc; b.st[1] = nx; }
    const unsigned old = xb_add(&bar[XB_XSUB(b.x)], 1u);
    const unsigned gen = old / nloc;
    if (old + 1u == (gen + 1u) * nloc) {
      __builtin_amdgcn_fence(__ATOMIC_RELEASE, "agent");
      asm volatile("s_waitcnt vmcnt(0)" ::: "memory");
      const unsigned og = xb_add(&bar[XB_TOP], 1u);
      const unsigned tg = og / nx;
      if (og + 1u == (tg + 1u) * nx) xb_add(&bar[XB_TOPGEN], 1u);
      else XB_SPIN(xb_ld(&bar[XB_TOPGEN]) == tg, bar);
      __builtin_amdgcn_fence(__ATOMIC_ACQUIRE, "agent");
      xb_add(&bar[XB_XGEN(b.x)], 1u);
      asm volatile("s_waitcnt vmcnt(0)" ::: "memory");
    } else {
      XB_SPIN(xb_ld(&bar[XB_XGEN(b.x)]) == gen, bar);
      __builtin_amdgcn_fence(__ATOMIC_ACQUIRE, "agent");
      asm volatile("s_waitcnt vmcnt(0)" ::: "memory");
    }
  }
  __syncthreads();
}

#define xcd_barrier(b) xcd_barrier_(b, wvs)
#ifndef MK_MULTI
#define MK_MULTI 0
#endif
#define SMEM_DECL __shared__ __attribute__((aligned(16))) unsigned char smem[SMEM_BYTES]; const int wvs = __builtin_amdgcn_readfirstlane((int)(threadIdx.x >> 6));
#if MK_MULTI
__global__ void __launch_bounds__(256, 2) k_p0(Params p) { SMEM_DECL (void)smem; phase0(p, wvs); }
__global__ void __launch_bounds__(256, 2) k_p1(Params p) { SMEM_DECL phase1(p, wvs, smem); }
__global__ void __launch_bounds__(256, 2) k_p2(Params p) { SMEM_DECL for (int it = blockIdx.x; it < 2048; it += gridDim.x) prep_item(p, wvs, it, smem); }
__global__ void __launch_bounds__(256, 2) k_p3(Params p) { SMEM_DECL
  if (blockIdx.x < 128) scan_chain(p, wvs, blockIdx.x, smem);
  else for (int it = blockIdx.x - 128; it < 1024; it += gridDim.x - 128) swa_item(p, wvs, it, smem); }
__global__ void __launch_bounds__(256, 2) k_p3b(Params p) { SMEM_DECL (void)smem; phase_ya(p, wvs); }
__global__ void __launch_bounds__(256, 2) k_p4(Params p) { SMEM_DECL phase4(p, wvs, smem); }
__global__ void __launch_bounds__(256, 2) k_p5(Params p) { SMEM_DECL phase5(p, wvs, smem); }
__global__ void __launch_bounds__(256, 2) k_p6(Params p) { SMEM_DECL phase6(p, wvs, smem); }
#else
__global__ void __launch_bounds__(256, 2) fwd_megakernel(Params p) {
  cg::grid_group grid = cg::this_grid();
  SMEM_DECL
  volatile LAS unsigned* st = (volatile LAS unsigned*)(smem + SMEM_BYTES - 16);
  { const int t0_ = opaque_tid(); if (t0_ < 4) st[t0_] = 0u; }
  __syncthreads();
  const XcdBarrier xb = xcd_barrier_post((unsigned*)(p.ws + OFF_BAR), st, wvs);
  phase0(p, wvs);
  if (p.ws == nullptr) grid.sync();
  xcd_barrier(xb);
  phase1(p, wvs, smem);
  xcd_barrier(xb);
  for (int it = blockIdx.x; it < 2048; it += gridDim.x) prep_item(p, wvs, it, smem);
  xcd_barrier(xb);
  if (blockIdx.x < 128) scan_chain(p, wvs, blockIdx.x, smem);
  else for (int it = blockIdx.x - 128; it < 1024; it += gridDim.x - 128) swa_item(p, wvs, it, smem);
  xcd_barrier(xb);
  phase_ya(p, wvs);
  xcd_barrier(xb);
  phase4(p, wvs, smem);
  xcd_barrier(xb);
  phase5(p, wvs, smem);
  xcd_barrier(xb);
  phase6(p, wvs, smem);
}
#endif

extern "C" void kernel_launch(void* const* d_in, const int* in_sizes, int n_in, void* d_out, int out_size,
                              void* d_ws, size_t ws_size, hipStream_t stream) {
  if (ws_size < WS_NEED) { fprintf(stderr, "workspace too small: %zu < %zu\n", ws_size, (size_t)WS_NEED); return; }
  Params p{};
  p.x = (const float*)d_in[0]; p.w_in = (const float*)d_in[1]; p.conv_w = (const float*)d_in[2]; p.a_log = (const float*)d_in[3];
  p.dt_bias = (const float*)d_in[4]; p.dn_norm_w = (const float*)d_in[5]; p.sinks = (const float*)d_in[6];
  p.w_branch = (const float*)d_in[7]; p.w_out = (const float*)d_in[8]; p.ln_g = (const float*)d_in[9]; p.ln_b = (const float*)d_in[10];
  p.out = (float*)d_out; p.ws = (unsigned char*)d_ws;
  for (int i = 0; i < 8; ++i) p.inv_freq[i] = (float)std::pow(500000.0, -(double)i / 8.0);
#if MK_MULTI
  const dim3 g(512), b(256);
  k_p0<<<g, b, 0, stream>>>(p);
  k_p1<<<g, b, 0, stream>>>(p);
  k_p2<<<g, b, 0, stream>>>(p);
  k_p3<<<g, b, 0, stream>>>(p);
  k_p3b<<<g, b, 0, stream>>>(p);
  k_p4<<<g, b, 0, stream>>>(p);
  k_p5<<<g, b, 0, stream>>>(p);
  k_p6<<<g, b, 0, stream>>>(p);
#else
  static int grid_blocks = 0;
  if (!grid_blocks) {
    int dev = 0, cus = 0, per_cu = 0;
    (void)hipGetDevice(&dev);
    (void)hipDeviceGetAttribute(&cus, hipDeviceAttributeMultiprocessorCount, dev);
    (void)hipOccupancyMaxActiveBlocksPerMultiprocessor(&per_cu, fwd_megakernel, 256, 0);
    if (per_cu > 2) per_cu = 2;
    if (per_cu < 1) per_cu = 1;
    grid_blocks = cus * per_cu;
    grid_blocks &= ~7;
  }
  (void)hipMemsetAsync(p.ws + OFF_BAR, 0, BAR_BYTES, stream);
  void* args[] = {&p};
  hipError_t e = hipLaunchCooperativeKernel((void*)fwd_megakernel, dim3(grid_blocks), dim3(256), args, 0, stream);
  if (e != hipSuccess) fprintf(stderr, "cooperative launch failed: %s (grid %d)\n", hipGetErrorString(e), grid_blocks);
#endif
}
```

```cpp
#include <hip/hip_runtime.h>
#include <hip/hip_cooperative_groups.h>
#include <cstdio>
#include <cmath>
namespace cg = cooperative_groups;

typedef unsigned short u16;
typedef short bf16x8 __attribute__((ext_vector_type(8)));
typedef float f32x4 __attribute__((ext_vector_type(4)));
typedef unsigned u32x4 __attribute__((ext_vector_type(4)));
typedef unsigned u32x2 __attribute__((ext_vector_type(2)));
#define DI __device__ __forceinline__
DI int opaque_tid_(int wave_s) { int t = (int)__builtin_amdgcn_mbcnt_hi(~0u, __builtin_amdgcn_mbcnt_lo(~0u, 0u)) + (wave_s << 6); asm volatile("" : "+v"(t)); return t; }
#define opaque_tid() opaque_tid_(wvs)

constexpr int T_TOK = 32768, SEQ = 8192, DM = 1024, NC = 5384, NCP = 5376;
constexpr int C_DNZ = 1536, C_SWQ = 2056, C_SWK = 2568, C_SWV = 2696, C_SWZ = 2824, C_GA = 3336, C_GB = 4360;
constexpr size_t OFF_BAR = 0;
constexpr size_t BAR_BYTES = 16384;
constexpr size_t OFF_WINT = BAR_BYTES;
constexpr size_t OFF_WAT = OFF_WINT + (size_t)NCP * 1024 * 2;
constexpr size_t OFF_WBT = OFF_WAT + 1024 * 512 * 2;
constexpr size_t OFF_WOT = OFF_WBT + 1024 * 512 * 2;
constexpr size_t OFF_ROPE = OFF_WOT + 1024 * 1024 * 2;
constexpr size_t OFF_HB = OFF_ROPE + 2 * 8192 * 8 * 4;
constexpr size_t OFF_DEC = OFF_HB + (size_t)T_TOK * 8 * 4;
constexpr size_t OFF_H = OFF_DEC + 2048 * 4;
constexpr size_t OFF_SC = OFF_H + (size_t)T_TOK * NC * 2;
constexpr size_t OPB = 73728;
constexpr size_t WS_NEED = OFF_SC + 2048 * OPB;
constexpr int SMEM_BYTES = 73728 + 16;

struct Params {
  const float *x, *w_in, *conv_w, *a_log, *dt_bias, *dn_norm_w, *sinks, *w_branch, *w_out, *ln_g, *ln_b;
  float* out; unsigned char* ws;
  float inv_freq[8];
};

typedef __bf16 bf16x2_t __attribute__((ext_vector_type(2)));
typedef float f32x2_t __attribute__((ext_vector_type(2)));
DI unsigned pk_bf16(float lo, float hi) { f32x2_t f = {lo, hi}; bf16x2_t v = __builtin_convertvector(f, bf16x2_t); return __builtin_bit_cast(unsigned, v); }
DI float bf_lo(unsigned u) { return __uint_as_float(u << 16); }
DI float bf_hi(unsigned u) { return __uint_as_float(u & 0xffff0000u); }
DI float bf2f(u16 v) { return __uint_as_float(((unsigned)v) << 16); }
DI u16 f2bf(float f) { return (u16)(pk_bf16(f, f) & 0xffffu); }
DI float shx(float v, int m, int lane) { return __uint_as_float((unsigned)__builtin_amdgcn_ds_bpermute((lane ^ m) << 2, (int)__float_as_uint(v))); }
DI float rcp_f(float y) { return __builtin_amdgcn_rcpf(y); }
DI float silu_f(float y) { return y * rcp_f(1.0f + __expf(-y)); }
DI float sigmoid_f(float y) { return rcp_f(1.0f + __expf(-y)); }
DI f32x4 mfma16(bf16x8 a, bf16x8 b, f32x4 c) { return __builtin_amdgcn_mfma_f32_16x16x32_bf16(a, b, c, 0, 0, 0); }
DI bf16x8 as_bf8(u32x4 v) { return __builtin_bit_cast(bf16x8, v); }
DI bf16x8 pack8(f32x4 a, f32x4 b) { u32x4 w; w.x = pk_bf16(a[0], a[1]); w.y = pk_bf16(a[2], a[3]); w.z = pk_bf16(b[0], b[1]); w.w = pk_bf16(b[2], b[3]); return as_bf8(w); }

DI void phase0(const Params& p, int wvs) {
  const size_t gt = (size_t)blockIdx.x * 256 + opaque_tid(), gs = (size_t)gridDim.x * 256;
  {
    const int ltid = (int)(gt & 255), lane = ltid & 63, wv = ltid >> 6;
    float wr[16][8];
#pragma unroll
    for (int j = 0; j < 4; ++j)
#pragma unroll
      for (int c = 0; c < 4; ++c) {
        const float* wp = p.w_in + (size_t)(4 * (lane + 64 * j) + c) * NC + 2048;
        const f32x4 a = *(const f32x4*)wp, b = *(const f32x4*)(wp + 4);
#pragma unroll
        for (int q = 0; q < 4; ++q) { wr[4 * j + c][q] = a[q]; wr[4 * j + c][4 + q] = b[q]; }
      }
    u16* xb = (u16*)(p.ws + OFF_SC);
    float* hb = (float*)(p.ws + OFF_HB);
    for (int row = blockIdx.x * 4 + wv; row < T_TOK; row += gridDim.x * 4) {
      float v[8];
#pragma unroll
      for (int q = 0; q < 8; ++q) v[q] = 0.f;
#pragma unroll
      for (int j = 0; j < 4; ++j) {
        const f32x4 xv = *(const f32x4*)(p.x + (size_t)row * DM + 4 * (lane + 64 * j));
        u32x2 w; w.x = pk_bf16(xv[0], xv[1]); w.y = pk_bf16(xv[2], xv[3]);
        *(u32x2*)(xb + (size_t)row * DM + 4 * (lane + 64 * j)) = w;
#pragma unroll
        for (int c = 0; c < 4; ++c)
#pragma unroll
          for (int q = 0; q < 8; ++q) v[q] += xv[c] * wr[4 * j + c][q];
      }
      {
        const bool up = (lane & 32) != 0;
        float k4[4];
#pragma unroll
        for (int i = 0; i < 4; ++i) { const float snd = up ? v[i] : v[i + 4]; const float kp = up ? v[i + 4] : v[i]; k4[i] = kp + shx(snd, 32, lane); }
        const bool up2 = (lane & 16) != 0;
        float k2[2];
#pragma unroll
        for (int i = 0; i < 2; ++i) { const float snd = up2 ? k4[i] : k4[i + 2]; const float kp = up2 ? k4[i + 2] : k4[i]; k2[i] = kp + shx(snd, 16, lane); }
        const bool up3 = (lane & 8) != 0;
        float k1 = (up3 ? k2[1] : k2[0]) + shx(up3 ? k2[0] : k2[1], 8, lane);
        k1 += shx(k1, 4, lane); k1 += shx(k1, 2, lane); k1 += shx(k1, 1, lane);
        if ((lane & 7) == 0) hb[(size_t)row * 8 + (lane >> 3)] = k1;
      }
    }
  }
  {
    u32x4* wt = (u32x4*)(p.ws + OFF_WINT);
    for (size_t i = gt; i < (size_t)NCP * 128; i += gs) {
      const int kc = (int)(i / NCP), n = (int)(i % NCP);
      float v[8];
#pragma unroll
      for (int j = 0; j < 8; ++j) v[j] = p.w_in[(size_t)(kc * 8 + j) * NC + n + (n >= 2048 ? 8 : 0)];
      u32x4 w; w.x = pk_bf16(v[0], v[1]); w.y = pk_bf16(v[2], v[3]); w.z = pk_bf16(v[4], v[5]); w.w = pk_bf16(v[6], v[7]);
      wt[(size_t)n * 128 + kc] = w;
    }
  }
  {
    for (size_t i = gt; i < (size_t)2 * 1024 * 64; i += gs) {
      const int br = (int)(i / (1024 * 64)), rem = (int)(i % (1024 * 64)), kc = rem / 1024, n = rem % 1024;
      const float* src = p.w_branch + (size_t)br * 512 * 1024;
      float v[8];
#pragma unroll
      for (int j = 0; j < 8; ++j) v[j] = src[(size_t)(kc * 8 + j) * 1024 + n];
      u32x4 w; w.x = pk_bf16(v[0], v[1]); w.y = pk_bf16(v[2], v[3]); w.z = pk_bf16(v[4], v[5]); w.w = pk_bf16(v[6], v[7]);
      ((u32x4*)(p.ws + (br ? OFF_WBT : OFF_WAT)))[(size_t)n * 64 + kc] = w;
    }
  }
  {
    for (size_t i = gt; i < (size_t)1024 * 128; i += gs) {
      const int kc = (int)(i / 1024), n = (int)(i % 1024);
      float v[8];
#pragma unroll
      for (int j = 0; j < 8; ++j) v[j] = p.w_out[(size_t)(kc * 8 + j) * 1024 + n];
      u32x4 w; w.x = pk_bf16(v[0], v[1]); w.y = pk_bf16(v[2], v[3]); w.z = pk_bf16(v[4], v[5]); w.w = pk_bf16(v[6], v[7]);
      ((u32x4*)(p.ws + OFF_WOT))[(size_t)n * 128 + kc] = w;
    }
  }
  {
    float* rc = (float*)(p.ws + OFF_ROPE); float* rs = rc + 8192 * 8;
    for (size_t i = gt; i < 8192 * 8; i += gs) {
      const int t = (int)(i >> 3), f = (int)(i & 7);
      const float ang = (float)t * p.inv_freq[f];
      const double a = (double)ang;
      const double k = __builtin_rint(a * 0.15915494309189535);
      const float r = (float)(a - k * 6.283185307179586);
      rc[i] = cosf(r); rs[i] = sinf(r);
    }
  }
}

DI int lds_off32(int row, int chunk) { return row * 64 + ((chunk ^ ((0 - (row >> 2)) & 3)) << 4); }
constexpr int GSTAGE = 24576;

DI void gemm_kloop(const Params& p, int wvs, const u16* __restrict__ A, int lda, const u16* __restrict__ Bt, int ldb, int nk, int m0, int n0,
                   f32x4 (&acc)[4][8], unsigned char* smem) {
  const int tid = opaque_tid(), lane = tid & 63, wv = tid >> 6, wm = wv >> 1, wn = wv & 1, r16 = lane & 15, g = lane >> 4;
  const int prow = lane >> 2, pc = (lane & 3) ^ ((0 - (prow >> 2)) & 3);
  const u16* ap = A + (size_t)(m0 + 16 * wv + prow) * lda + pc * 8;
  const u16* bp = Bt + (size_t)(n0 + 16 * wv + prow) * ldb + pc * 8;
  unsigned char* lA = smem + wv * 1024;
  unsigned char* lB = smem + 8192 + wv * 1024;
#define GEMM_ISSUE(kt_, buf_) do { \
    _Pragma("unroll") for (int i_ = 0; i_ < 2; ++i_) \
      __builtin_amdgcn_global_load_lds((const unsigned*)(ap + (size_t)(64 * i_) * lda + (kt_) * 32), (unsigned*)(lA + (buf_) * GSTAGE + i_ * 4096), 16, 0, 0); \
    _Pragma("unroll") for (int i_ = 0; i_ < 4; ++i_) \
      __builtin_amdgcn_global_load_lds((const unsigned*)(bp + (size_t)(64 * i_) * ldb + (kt_) * 32), (unsigned*)(lB + (buf_) * GSTAGE + i_ * 4096), 16, 0, 0); \
  } while (0)
  GEMM_ISSUE(0, 0);
  GEMM_ISSUE(1, 1);
  asm volatile("s_waitcnt vmcnt(6)" ::: "memory");
  __builtin_amdgcn_s_barrier();
  int cb = 0;
  for (int kt = 0; kt < nk; ++kt) {
    int ib = cb + 2; if (ib >= 3) ib -= 3;
    const bool more = (kt + 2 < nk);
    if (more) GEMM_ISSUE(kt + 2, ib);
    const unsigned char* cur = smem + cb * GSTAGE;
    bf16x8 af[4], bfr[8];
#pragma unroll
    for (int i = 0; i < 4; ++i) af[i] = *(const bf16x8*)(cur + lds_off32(wm * 64 + i * 16 + r16, g));
#pragma unroll
    for (int i = 0; i < 8; ++i) bfr[i] = *(const bf16x8*)(cur + 8192 + lds_off32(wn * 128 + i * 16 + r16, g));
#pragma unroll
    for (int mi = 0; mi < 4; ++mi)
#pragma unroll
      for (int ni = 0; ni < 8; ++ni) acc[mi][ni] = mfma16(bfr[ni], af[mi], acc[mi][ni]);
    if (more) asm volatile("s_waitcnt vmcnt(6)" ::: "memory"); else asm volatile("s_waitcnt vmcnt(0)" ::: "memory");
    asm volatile("s_waitcnt lgkmcnt(0)" ::: "memory");
    __builtin_amdgcn_s_barrier();
    cb = cb + 1; if (cb >= 3) cb = 0;
  }
#undef GEMM_ISSUE
}

DI bool tile_of(int li, int ntn, int xcd, int& mt, int& nt) {
  if (li >= 32 * ntn) return false;
  const int grp = li / (8 * ntn), rem = li % (8 * ntn);
  nt = rem >> 3; mt = 32 * xcd + grp * 8 + (rem & 7);
  return true;
}

DI void zero_acc(f32x4 (&acc)[4][8]) {
#pragma unroll
  for (int i = 0; i < 4; ++i)
#pragma unroll
    for (int j = 0; j < 8; ++j) acc[i][j] = (f32x4){0.f, 0.f, 0.f, 0.f};
}

DI void phase1(const Params& p, int wvs, unsigned char* smem) {
  const int xcd = blockIdx.x & 7, lb = blockIdx.x >> 3, nlb = gridDim.x >> 3;
  const u16* xb = (const u16*)(p.ws + OFF_SC);
  const u16* wint = (const u16*)(p.ws + OFF_WINT);
  u16* h = (u16*)(p.ws + OFF_H);
  float* hb = (float*)(p.ws + OFF_HB);
  const int tid0 = opaque_tid(); const int lane = tid0 & 63, wv = tid0 >> 6, wm = wv >> 1, wn = wv & 1, r16 = lane & 15, g = lane >> 4;
  for (int li = lb;; li += nlb) {
    int mt, nt; if (!tile_of(li, 21, xcd, mt, nt)) break;
    f32x4 acc[4][8]; zero_acc(acc);
    gemm_kloop(p, wvs, xb, 1024, wint, 1024, 32, mt * 128, nt * 256, acc, smem);
#pragma unroll
    for (int mi = 0; mi < 4; ++mi) {
      const int row = mt * 128 + wm * 64 + mi * 16 + r16;
#pragma unroll
      for (int ni = 0; ni < 8; ++ni) {
        const int col = nt * 256 + wn * 128 + ni * 16 + 4 * g;
        {
          u32x2 w; w.x = pk_bf16(acc[mi][ni][0], acc[mi][ni][1]); w.y = pk_bf16(acc[mi][ni][2], acc[mi][ni][3]);
          *(u32x2*)(h + (size_t)row * NC + col + (nt >= 8 ? 8 : 0)) = w;
        }
      }
    }
  }
}

template <int I> DI void solve_rows2(f32x2_t (&xv)[64], const float* Lm, int lane, float lcur) {
  if constexpr (I < 64) {
    float lnx = 0.f;
    if constexpr (I + 1 < 64) lnx = Lm[(I + 1) * 68 + lane];
    f32x2_t a0 = xv[I], a1 = {0.f, 0.f}, a2 = {0.f, 0.f}, a3 = {0.f, 0.f};
#pragma unroll
    for (int m = 0; m < I; ++m) {
      const float l = __builtin_bit_cast(float, __builtin_amdgcn_readlane(__builtin_bit_cast(int, lcur), m));
      const f32x2_t lv = {l, l};
      if ((m & 3) == 0) a0 -= lv * xv[m];
      else if ((m & 3) == 1) a1 -= lv * xv[m];
      else if ((m & 3) == 2) a2 -= lv * xv[m];
      else a3 -= lv * xv[m];
    }
    xv[I] = (a0 + a1) + (a2 + a3);
    solve_rows2<I + 1>(xv, Lm, lane, lnx);
  }
}

DI void prep_item(const Params& p, int wvs, int item, unsigned char* smem) {
  const int tid_ = opaque_tid();
  const int tid = tid_, lane = tid & 63, wv = tid >> 6, r16 = lane & 15, g = lane >> 4;
  const int hd = item & 3, n = (item >> 2) & 127, b = item >> 9;
  const int t0 = b * SEQ + n * 64;
  u16* Qs = (u16*)smem; u16* Ks = Qs + 64 * 136; u16* Vs = Ks + 64 * 136;
  float* Lm = (float*)(smem + 52224);
  float* sm_beta = (float*)(smem + 69632);
  float* sm_gc = sm_beta + 64; float* sm_rq = sm_gc + 64; float* sm_rk = sm_rq + 64;
  float* sm_fw = sm_rk + 64; float* sm_fq = sm_fw + 64; float* sm_fk = sm_fq + 64;
  const u16* h = (const u16*)(p.ws + OFF_H);
  const float* hb = (const float*)(p.ws + OFF_HB);
  unsigned char* op = p.ws + OFF_SC + (size_t)item * OPB;
  __syncthreads();
  {
    const int c2 = tid & 63, rbase = (tid >> 6) * 16;
    unsigned raw[3][19];
#pragma unroll
    for (int mat = 0; mat < 3; ++mat) {
      const int col = mat * 512 + hd * 128 + 2 * c2;
#pragma unroll
      for (int j = 0; j < 19; ++j) {
        const int rr = t0 + rbase - 3 + j;
        raw[mat][j] = *(const unsigned*)(h + (size_t)(rr < 0 ? 0 : rr) * NC + col);
      }
    }
    __builtin_amdgcn_sched_barrier(0);
#pragma unroll
    for (int mat = 0; mat < 3; ++mat) {
      const int col = mat * 512 + hd * 128 + 2 * c2;
      float wa[4], wb[4];
#pragma unroll
      for (int j = 0; j < 4; ++j) { wa[j] = p.conv_w[j * 1536 + col]; wb[j] = p.conv_w[j * 1536 + col + 1]; }
      float xa[3], xb[3];
#pragma unroll
      for (int j = 0; j < 3; ++j) {
        const int pos = n * 64 + rbase - 3 + j;
        const unsigned v = (pos >= 0) ? raw[mat][j] : 0u;
        xa[j] = bf_lo(v); xb[j] = bf_hi(v);
      }
      u16* dst = (mat == 0 ? Qs : (mat == 1 ? Ks : Vs));
#pragma unroll
      for (int i = 0; i < 16; ++i) {
        const unsigned v = raw[mat][3 + i];
        const float a3 = bf_lo(v), b3 = bf_hi(v);
        const float ya = wa[0] * xa[0] + wa[1] * xa[1] + wa[2] * xa[2] + wa[3] * a3;
        const float yb = wb[0] * xb[0] + wb[1] * xb[1] + wb[2] * xb[2] + wb[3] * b3;
        xa[0] = xa[1]; xa[1] = xa[2]; xa[2] = a3; xb[0] = xb[1]; xb[1] = xb[2]; xb[2] = b3;
        *(unsigned*)(dst + (rbase + i) * 136 + 2 * c2) = pk_bf16(silu_f(ya), silu_f(yb));
      }
    }
  }
  __syncthreads();
  if (wv == 0) {
    const int row = t0 + lane;
    const float bl = hb[(size_t)row * 8 + hd], al = hb[(size_t)row * 8 + 4 + hd];
    const float xx = al + p.dt_bias[hd];
    const float sp = xx > 20.f ? xx : log1pf(expf(xx));
    float gg = -expf(p.a_log[hd]) * sp;
#pragma unroll
    for (int o = 1; o < 64; o <<= 1) { const float t = __uint_as_float((unsigned)__builtin_amdgcn_ds_bpermute(((lane - o) & 63) << 2, (int)__float_as_uint(gg))); if (lane >= o) gg += t; }
    sm_beta[lane] = 1.0f / (1.0f + expf(-bl)); sm_gc[lane] = gg;
  } else if (wv <= 2) {
    const int r = tid - 64;
    const u16* src = (r < 64) ? (Qs + r * 136) : (Ks + (r - 64) * 136);
    float ss = 0.f;
#pragma unroll
    for (int c = 0; c < 16; ++c) {
      const u32x4 v = *(const u32x4*)(src + c * 8);
#pragma unroll
      for (int j = 0; j < 4; ++j) { const float a = bf_lo(v[j]), bb = bf_hi(v[j]); ss += a * a + bb * bb; }
    }
    const float rs = rsqrtf(ss + 1e-6f);
    if (r < 64) sm_rq[r] = rs; else sm_rk[r - 64] = rs;
  }
  __syncthreads();
  if (tid < 64) {
    const float gc = sm_gc[tid], gl = sm_gc[63], eg = expf(gc);
    sm_fw[tid] = sm_beta[tid] * eg * sm_rk[tid];
    sm_fq[tid] = sm_rq[tid] * 0.08838834764831845f * eg;
    sm_fk[tid] = sm_rk[tid] * expf(gl - gc);
    if (tid == 0) ((float*)(p.ws + OFF_DEC))[item] = expf(gl);
  }
  {
    bf16x8 kfi[4], qfi[4];
#pragma unroll
    for (int s = 0; s < 4; ++s) {
      kfi[s] = *(const bf16x8*)(Ks + (16 * wv + r16) * 136 + 32 * s + 8 * g);
      qfi[s] = *(const bf16x8*)(Qs + (16 * wv + r16) * 136 + 32 * s + 8 * g);
    }
    f32x4 at[4];
#pragma unroll
    for (int jt = 0; jt < 4; ++jt) {
      at[jt] = (f32x4){0.f, 0.f, 0.f, 0.f};
      if (jt <= wv) {
        f32x4 la = (f32x4){0.f, 0.f, 0.f, 0.f}, aa = (f32x4){0.f, 0.f, 0.f, 0.f};
#pragma unroll
        for (int s = 0; s < 4; ++s) {
          const bf16x8 kfj = *(const bf16x8*)(Ks + (16 * jt + r16) * 136 + 32 * s + 8 * g);
          la = mfma16(kfi[s], kfj, la);
          aa = mfma16(kfj, qfi[s], aa);
        }
#pragma unroll
        for (int r = 0; r < 4; ++r) {
          { const int i = 16 * wv + 4 * g + r, j = 16 * jt + r16;
            const float v = (i > j) ? sm_beta[i] * sm_rk[i] * sm_rk[j] * __expf(sm_gc[i] - sm_gc[j]) * la[r] : 0.f;
            Lm[i * 68 + j] = v; }
          { const int j = 16 * jt + 4 * g + r, i = 16 * wv + r16;
            at[jt][r] = (j <= i) ? sm_rq[i] * sm_rk[j] * 0.08838834764831845f * __expf(sm_gc[i] - sm_gc[j]) * aa[r] : 0.f; }
        }
      }
    }
#pragma unroll
    for (int s2 = 0; s2 < 2; ++s2)
      *(bf16x8*)(op + 32768 + (size_t)((wv * 2 + s2) * 64 + lane) * 16) = pack8(at[2 * s2], at[2 * s2 + 1]);
  }
  __syncthreads();
  f32x2_t xv[64];
  if (wv < 2) {
#pragma unroll
    for (int i = 0; i < 64; ++i) { xv[i].x = sm_beta[i] * bf2f(Vs[i * 136 + tid]); xv[i].y = sm_fw[i] * bf2f(Ks[i * 136 + tid]); }
    solve_rows2<1>(xv, Lm, lane, Lm[68 + lane]);
    const int sl = tid >> 4, dvl = tid & 15;
#pragma unroll
    for (int mt = 0; mt < 4; ++mt)
#pragma unroll
      for (int gg = 0; gg < 4; ++gg) {
        u32x2 w; w.x = pk_bf16(xv[16 * mt + 4 * gg].x, xv[16 * mt + 4 * gg + 1].x); w.y = pk_bf16(xv[16 * mt + 4 * gg + 2].x, xv[16 * mt + 4 * gg + 3].x);
        *(u32x2*)(op + 57344 + (size_t)((sl * 4 + mt) * 64 + gg * 16 + dvl) * 8) = w;
      }
  } else {
    const int t2 = tid - 128;
#pragma unroll 2
    for (int f = 0; f < 8; ++f) {
      const int e = t2 + 128 * f, frag = e >> 6, ln = e & 63, lr = ln & 15, lg = ln >> 4;
      {
        const int mt = frag >> 2, sx = frag & 3, row = 16 * mt + lr;
        const u32x2 ql = *(const u32x2*)(Qs + row * 136 + 32 * sx + 4 * lg), qh = *(const u32x2*)(Qs + row * 136 + 32 * sx + 16 + 4 * lg);
        const float fq = sm_fq[row];
        u32x4 w;
        w.x = pk_bf16(bf_lo(ql.x) * fq, bf_hi(ql.x) * fq); w.y = pk_bf16(bf_lo(ql.y) * fq, bf_hi(ql.y) * fq);
        w.z = pk_bf16(bf_lo(qh.x) * fq, bf_hi(qh.x) * fq); w.w = pk_bf16(bf_lo(qh.y) * fq, bf_hi(qh.y) * fq);
        *(u32x4*)(op + 16384 + (size_t)e * 16) = w;
      }
      {
        const int mt8 = frag >> 1, s2 = frag & 1, dk = 16 * mt8 + lr;
        float v[8];
#pragma unroll
        for (int j = 0; j < 8; ++j) {
          const int pos = 32 * s2 + 16 * (j >> 2) + 4 * lg + (j & 3);
          v[j] = bf2f(Ks[pos * 136 + dk]) * sm_fk[pos];
        }
        u32x4 w; w.x = pk_bf16(v[0], v[1]); w.y = pk_bf16(v[2], v[3]); w.z = pk_bf16(v[4], v[5]); w.w = pk_bf16(v[6], v[7]);
        *(u32x4*)(op + 40960 + (size_t)e * 16) = w;
      }
    }
  }
  __syncthreads();
  if (wv < 2) {
#pragma unroll
    for (int i = 0; i < 64; ++i) Vs[i * 136 + tid] = f2bf(-xv[i].y);
  }
  __syncthreads();
#pragma unroll
  for (int f = 0; f < 4; ++f) {
    const int e = tid + 256 * f, frag = e >> 6, ln = e & 63, lr = ln & 15, lg = ln >> 4;
    const int mt = frag >> 2, sx = frag & 3, row = 16 * mt + lr;
    const u32x2 lo = *(const u32x2*)(Vs + row * 136 + 32 * sx + 4 * lg), hi = *(const u32x2*)(Vs + row * 136 + 32 * sx + 16 + 4 * lg);
    *(u32x4*)(op + (size_t)e * 16) = (u32x4){lo.x, lo.y, hi.x, hi.y};
  }
}

struct ScanA { u32x4 wf[4]; u32x2 uf; float dec; };
struct ScanB { u32x4 qf[4], af[2], kf[4]; };

DI void scan_load_a(const Params& p, int wvs, ScanA& o, int b, int hd, int sl, int n, int q, int lane) {
  const int item = (b * 128 + n) * 4 + hd;
  const unsigned char* op = p.ws + OFF_SC + (size_t)item * OPB;
#pragma unroll
  for (int s = 0; s < 4; ++s) {
    o.wf[s] = *(const u32x4*)(op + (size_t)((q * 4 + s) * 64 + lane) * 16);
  }
  o.uf = *(const u32x2*)(op + 57344 + (size_t)((sl * 4 + q) * 64 + lane) * 8);
  o.dec = ((const float*)(p.ws + OFF_DEC))[item];
}
DI void scan_load_b(const Params& p, int wvs, ScanB& o, int b, int hd, int n, int q, int lane) {
  const int item = (b * 128 + n) * 4 + hd;
  const unsigned char* op = p.ws + OFF_SC + (size_t)item * OPB;
#pragma unroll
  for (int s = 0; s < 4; ++s) o.qf[s] = *(const u32x4*)(op + 16384 + (size_t)((q * 4 + s) * 64 + lane) * 16);
#pragma unroll
  for (int s2 = 0; s2 < 2; ++s2) o.af[s2] = *(const u32x4*)(op + 32768 + (size_t)((q * 2 + s2) * 64 + lane) * 16);
#pragma unroll
  for (int j = 0; j < 4; ++j) o.kf[j] = *(const u32x4*)(op + 40960 + (size_t)((q * 4 + j) * 64 + lane) * 16);
}

DI void scan_step(const Params& p, int wvs, const ScanA& o, const ScanB& ob, f32x4 (&S)[2], int b, int hd, int sl, int n, int q, int lane, unsigned char* smem) {
  const int r16 = lane & 15, g = lane >> 4;
  u32x4* ldsS = (u32x4*)smem;
  u32x2* ldsV = (u32x2*)(smem + 4096);
  ldsS[q * 64 + lane] = __builtin_bit_cast(u32x4, pack8(S[0], S[1]));
  __syncthreads();
  bf16x8 Sb[4];
#pragma unroll
  for (int s = 0; s < 4; ++s) Sb[s] = as_bf8(ldsS[s * 64 + lane]);
  f32x4 vn = (f32x4){bf_lo(o.uf.x), bf_hi(o.uf.x), bf_lo(o.uf.y), bf_hi(o.uf.y)};
#pragma unroll
  for (int s = 0; s < 4; ++s) vn = mfma16(as_bf8(o.wf[s]), Sb[s], vn);
  { u32x2 w; w.x = pk_bf16(vn[0], vn[1]); w.y = pk_bf16(vn[2], vn[3]); ldsV[((q >> 1) * 64 + lane) * 2 + (q & 1)] = w; }
  f32x4 oa = (f32x4){0.f, 0.f, 0.f, 0.f};
#pragma unroll
  for (int s = 0; s < 4; ++s) oa = mfma16(as_bf8(ob.qf[s]), Sb[s], oa);
  __syncthreads();
  bf16x8 Vb[2];
#pragma unroll
  for (int s2 = 0; s2 < 2; ++s2) Vb[s2] = as_bf8(*(const u32x4*)(ldsV + (s2 * 64 + lane) * 2));
#pragma unroll
  for (int s2 = 0; s2 < 2; ++s2) oa = mfma16(as_bf8(ob.af[s2]), Vb[s2], oa);
  u16* h = (u16*)(p.ws + OFF_H);
  const int t0 = b * SEQ + n * 64;
#pragma unroll
  for (int r = 0; r < 4; ++r) h[(size_t)(t0 + 16 * q + 4 * g + r) * NC + hd * 128 + 16 * sl + r16] = f2bf(oa[r]);
#pragma unroll
  for (int t = 0; t < 2; ++t) {
    S[t] = S[t] * o.dec;
#pragma unroll
    for (int s2 = 0; s2 < 2; ++s2) S[t] = mfma16(as_bf8(ob.kf[t * 2 + s2]), Vb[s2], S[t]);
  }
}

DI void scan_chain(const Params& p, int wvs, int chain, unsigned char* smem) {
  const int tid0 = opaque_tid(); const int lane = tid0 & 63, q = tid0 >> 6;
  const int xcd = chain & 7, j = chain >> 3, pair = xcd + 8 * (j >> 3), sl = j & 7, b = pair >> 2, hd = pair & 3;
  f32x4 S[2]; S[0] = (f32x4){0.f, 0.f, 0.f, 0.f}; S[1] = S[0];
  ScanA a0, a1, a2; ScanB bc, bn;
  __syncthreads();
  scan_load_a(p, wvs, a0, b, hd, sl, 0, q, lane);
  scan_load_b(p, wvs, bc, b, hd, 0, q, lane);
  scan_load_a(p, wvs, a1, b, hd, sl, 1, q, lane);
#pragma unroll 1
  for (int n = 0; n < 129; n += 3) {
    if (n + 2 < 128) scan_load_a(p, wvs, a2, b, hd, sl, n + 2, q, lane);
    if (n + 1 < 128) scan_load_b(p, wvs, bn, b, hd, n + 1, q, lane);
    if (n < 128) scan_step(p, wvs, a0, bc, S, b, hd, sl, n, q, lane, smem);
    bc = bn;
    if (n + 3 < 128) scan_load_a(p, wvs, a0, b, hd, sl, n + 3, q, lane);
    if (n + 2 < 128) scan_load_b(p, wvs, bn, b, hd, n + 2, q, lane);
    if (n + 1 < 128) scan_step(p, wvs, a1, bc, S, b, hd, sl, n + 1, q, lane, smem);
    bc = bn;
    if (n + 4 < 128) scan_load_a(p, wvs, a1, b, hd, sl, n + 4, q, lane);
    if (n + 3 < 128) scan_load_b(p, wvs, bn, b, hd, n + 3, q, lane);
    if (n + 2 < 128) scan_step(p, wvs, a2, bc, S, b, hd, sl, n + 2, q, lane, smem);
    bc = bn;
  }
}

DI void swa_item(const Params& p, int wvs, int item, unsigned char* smem) {
  const int tid_ = opaque_tid();
  const int tid = tid_, lane = tid & 63, wv = tid >> 6, r16 = lane & 15, g = lane >> 4;
  const int qt = item & 127, kvh = (item >> 7) & 1, b = item >> 8;
  const int kp0 = 64 * qt - 128;
  u16* Ksm = (u16*)smem;
  u16* Vt = (u16*)(smem + 27648);
  u16* h = (u16*)(p.ws + OFF_H);
  const float* rc = (const float*)(p.ws + OFF_ROPE); const float* rs = rc + 8192 * 8;
  __syncthreads();
  if (tid < 192) {
    const int kk = tid, pos = kp0 + kk;
    u32x4 lo = (u32x4){0, 0, 0, 0}, hi = lo;
    if (pos >= 0) {
      const u16* src = h + (size_t)(b * SEQ + pos) * NC + C_SWK + kvh * 64;
      const u32x4 a = *(const u32x4*)src, c = *(const u32x4*)(src + 8);
      const f32x4 c0 = *(const f32x4*)(rc + pos * 8), c1 = *(const f32x4*)(rc + pos * 8 + 4);
      const f32x4 s0 = *(const f32x4*)(rs + pos * 8), s1 = *(const f32x4*)(rs + pos * 8 + 4);
      float t1[8], t2[8], cs[8], sn[8], o1[8], o2[8];
#pragma unroll
      for (int j = 0; j < 4; ++j) { t1[2 * j] = bf_lo(a[j]); t1[2 * j + 1] = bf_hi(a[j]); t2[2 * j] = bf_lo(c[j]); t2[2 * j + 1] = bf_hi(c[j]);
        cs[j] = c0[j]; cs[4 + j] = c1[j]; sn[j] = s0[j]; sn[4 + j] = s1[j]; }
#pragma unroll
      for (int j = 0; j < 8; ++j) { o1[j] = t1[j] * cs[j] - t2[j] * sn[j]; o2[j] = t2[j] * cs[j] + t1[j] * sn[j]; }
#pragma unroll
      for (int j = 0; j < 4; ++j) { lo[j] = pk_bf16(o1[2 * j], o1[2 * j + 1]); hi[j] = pk_bf16(o2[2 * j], o2[2 * j + 1]); }
    }
    *(u32x4*)(Ksm + kk * 72) = lo; *(u32x4*)(Ksm + kk * 72 + 8) = hi;
  }
  for (int e = tid; e < 192 * 6; e += 256) {
    const int kk = e / 6, ch = 2 + e % 6, pos = kp0 + kk;
    u32x4 v = (u32x4){0, 0, 0, 0};
    if (pos >= 0) v = *(const u32x4*)(h + (size_t)(b * SEQ + pos) * NC + C_SWK + kvh * 64 + ch * 8);
    *(u32x4*)(Ksm + kk * 72 + ch * 8) = v;
  }
  for (int e = tid; e < 192 * 8; e += 256) {
    const int kk = e >> 3, ch = e & 7, pos = kp0 + kk;
    u32x4 v = (u32x4){0, 0, 0, 0};
    if (pos >= 0) v = *(const u32x4*)(h + (size_t)(b * SEQ + pos) * NC + C_SWV + kvh * 64 + ch * 8);
#pragma unroll
    for (int j = 0; j < 4; ++j) { Vt[(ch * 8 + 2 * j) * 200 + kk] = (u16)(v[j] & 0xffffu); Vt[(ch * 8 + 2 * j + 1) * 200 + kk] = (u16)(v[j] >> 16); }
  }
  __syncthreads();
  const int st = wv, jt0 = st < 2 ? st : 2;
  const int qi = 16 * st + r16;
  const int qpos = 64 * qt + qi, tq = b * SEQ + qpos;
#pragma unroll 1
  for (int hq = 0; hq < 4; ++hq) {
    const int head = kvh * 4 + hq;
    u16* qsrc = h + (size_t)tq * NC + C_SWQ + head * 64;
    bf16x8 qf[2];
    {
      const u32x4 a = *(const u32x4*)qsrc, c = *(const u32x4*)(qsrc + 8);
      u32x4 w = *(const u32x4*)(qsrc + 8 * g);
      if (g < 2) {
        const f32x4 c0 = *(const f32x4*)(rc + qpos * 8), c1 = *(const f32x4*)(rc + qpos * 8 + 4);
        const f32x4 s0 = *(const f32x4*)(rs + qpos * 8), s1 = *(const f32x4*)(rs + qpos * 8 + 4);
        float t1[8], t2[8], cs[8], sn[8], o[8];
#pragma unroll
        for (int j = 0; j < 4; ++j) { t1[2 * j] = bf_lo(a[j]); t1[2 * j + 1] = bf_hi(a[j]); t2[2 * j] = bf_lo(c[j]); t2[2 * j + 1] = bf_hi(c[j]);
          cs[j] = c0[j]; cs[4 + j] = c1[j]; sn[j] = s0[j]; sn[4 + j] = s1[j]; }
#pragma unroll
        for (int j = 0; j < 8; ++j) o[j] = (g == 0) ? (t1[j] * cs[j] - t2[j] * sn[j]) : (t2[j] * cs[j] + t1[j] * sn[j]);
#pragma unroll
        for (int j = 0; j < 4; ++j) w[j] = pk_bf16(o[2 * j], o[2 * j + 1]);
      }
      qf[0] = as_bf8(w);
      qf[1] = as_bf8(*(const u32x4*)(qsrc + 32 + 8 * g));
    }
    f32x4 sc[10];
#pragma unroll
    for (int t = 0; t < 10; ++t) {
      sc[t] = (f32x4){0.f, 0.f, 0.f, 0.f};
#pragma unroll
      for (int s = 0; s < 2; ++s) {
        const bf16x8 kf = *(const bf16x8*)(Ksm + (16 * (jt0 + t) + r16) * 72 + 32 * s + 8 * g);
        sc[t] = mfma16(kf, qf[s], sc[t]);
      }
    }
    const float sink = p.sinks[head];
    float mx = sink;
#pragma unroll
    for (int t = 0; t < 10; ++t)
#pragma unroll
      for (int r = 0; r < 4; ++r) {
        const int kk = 16 * (jt0 + t) + 4 * g + r, d = kk - qi;
        const bool ok = (d >= 1) && (d <= 128) && (kp0 + kk >= 0);
        const float v = ok ? sc[t][r] * 0.125f : -1e30f;
        sc[t][r] = v; mx = fmaxf(mx, v);
      }
    mx = fmaxf(mx, shx(mx, 16, lane)); mx = fmaxf(mx, shx(mx, 32, lane));
    float sum = 0.f;
#pragma unroll
    for (int t = 0; t < 10; ++t)
#pragma unroll
      for (int r = 0; r < 4; ++r) { const float e = __expf(sc[t][r] - mx); sc[t][r] = e; sum += e; }
    sum += shx(sum, 16, lane); sum += shx(sum, 32, lane);
    const float inv = rcp_f(sum + __expf(sink - mx));
    f32x4 oacc[4];
#pragma unroll
    for (int dt = 0; dt < 4; ++dt) oacc[dt] = (f32x4){0.f, 0.f, 0.f, 0.f};
#pragma unroll
    for (int s2 = 0; s2 < 5; ++s2) {
      const bf16x8 pb = pack8(sc[2 * s2], sc[2 * s2 + 1]);
#pragma unroll
      for (int dt = 0; dt < 4; ++dt) {
        const u16* vr = Vt + (16 * dt + r16) * 200 + 16 * (jt0 + 2 * s2) + 4 * g;
        const u32x2 lo = *(const u32x2*)vr, hi = *(const u32x2*)(vr + 16);
        oacc[dt] = mfma16(as_bf8((u32x4){lo.x, lo.y, hi.x, hi.y}), pb, oacc[dt]);
      }
    }
#pragma unroll
    for (int dt = 0; dt < 4; ++dt) {
      const int dcol = head * 64 + 16 * dt + 4 * g;
      const u32x2 z = *(const u32x2*)(h + (size_t)tq * NC + C_SWZ + dcol);
      u32x2 w;
      w.x = pk_bf16(oacc[dt][0] * inv * silu_f(bf_lo(z.x)), oacc[dt][1] * inv * silu_f(bf_hi(z.x)));
      w.y = pk_bf16(oacc[dt][2] * inv * silu_f(bf_lo(z.y)), oacc[dt][3] * inv * silu_f(bf_hi(z.y)));
      *(u32x2*)(h + (size_t)tq * NC + C_SWQ + dcol) = w;
    }
  }
}

DI void phase_ya(const Params& p, int wvs) {
  u16* h = (u16*)(p.ws + OFF_H);
  const int ltid = opaque_tid(), lane = ltid & 63;
  const size_t gt = (size_t)blockIdx.x * 256 + ltid, gs = (size_t)gridDim.x * 256;
  for (size_t i = gt; i < (size_t)T_TOK * 64; i += gs) {
    const int tok = (int)(i >> 6), c8 = (int)(i & 63);
    u16* ptr = h + (size_t)tok * NC + c8 * 8;
    const u32x4 v = *(const u32x4*)ptr;
    const u32x4 z = *(const u32x4*)(ptr + C_DNZ);
    float o[8]; float ss = 0.f;
#pragma unroll
    for (int j = 0; j < 4; ++j) { o[2 * j] = bf_lo(v[j]); o[2 * j + 1] = bf_hi(v[j]); }
#pragma unroll
    for (int j = 0; j < 8; ++j) ss += o[j] * o[j];
    ss += shx(ss, 1, lane); ss += shx(ss, 2, lane); ss += shx(ss, 4, lane); ss += shx(ss, 8, lane);
    const float rs = rsqrtf(ss * (1.0f / 128.0f) + 1e-6f);
    const float* nw = p.dn_norm_w + (c8 & 15) * 8;
    float y[8];
#pragma unroll
    for (int j = 0; j < 4; ++j) {
      y[2 * j] = o[2 * j] * rs * nw[2 * j] * silu_f(bf_lo(z[j]));
      y[2 * j + 1] = o[2 * j + 1] * rs * nw[2 * j + 1] * silu_f(bf_hi(z[j]));
    }
    u32x4 w; w.x = pk_bf16(y[0], y[1]); w.y = pk_bf16(y[2], y[3]); w.z = pk_bf16(y[4], y[5]); w.w = pk_bf16(y[6], y[7]);
    *(u32x4*)ptr = w;
  }
}

DI void phase4(const Params& p, int wvs, unsigned char* smem) {
  const int xcd = blockIdx.x & 7, lb = blockIdx.x >> 3, nlb = gridDim.x >> 3;
  const u16* h = (const u16*)(p.ws + OFF_H);
  const u16* wat = (const u16*)(p.ws + OFF_WAT);
  const u16* wbt = (const u16*)(p.ws + OFF_WBT);
  u16* mg = (u16*)(p.ws + OFF_SC);
  const int tid0 = opaque_tid(); const int lane = tid0 & 63, wv = tid0 >> 6, wm = wv >> 1, wn = wv & 1, r16 = lane & 15, g = lane >> 4;
  for (int li = lb;; li += nlb) {
    int mt, nt; if (!tile_of(li, 4, xcd, mt, nt)) break;
    f32x4 acc[4][8]; zero_acc(acc);
    gemm_kloop(p, wvs, h, NC, wat, 512, 16, mt * 128, nt * 256, acc, smem);
#pragma unroll
    for (int mi = 0; mi < 4; ++mi) {
      const int row = mt * 128 + wm * 64 + mi * 16 + r16;
#pragma unroll
      for (int ni = 0; ni < 8; ++ni) {
        const int col = nt * 256 + wn * 128 + ni * 16 + 4 * g;
        const u32x2 ga = *(const u32x2*)(h + (size_t)row * NC + C_GA + col), gb = *(const u32x2*)(h + (size_t)row * NC + C_GB + col);
        acc[mi][ni][0] *= (1.f + __expf(-bf_lo(gb.x))) * rcp_f(1.f + __expf(-bf_lo(ga.x)));
        acc[mi][ni][1] *= (1.f + __expf(-bf_hi(gb.x))) * rcp_f(1.f + __expf(-bf_hi(ga.x)));
        acc[mi][ni][2] *= (1.f + __expf(-bf_lo(gb.y))) * rcp_f(1.f + __expf(-bf_lo(ga.y)));
        acc[mi][ni][3] *= (1.f + __expf(-bf_hi(gb.y))) * rcp_f(1.f + __expf(-bf_hi(ga.y)));
      }
      __builtin_amdgcn_sched_barrier(0);
    }
    gemm_kloop(p, wvs, h + C_SWQ, NC, wbt, 512, 16, mt * 128, nt * 256, acc, smem);
#pragma unroll
    for (int mi = 0; mi < 4; ++mi) {
      const int row = mt * 128 + wm * 64 + mi * 16 + r16;
#pragma unroll
      for (int ni = 0; ni < 8; ++ni) {
        const int col = nt * 256 + wn * 128 + ni * 16 + 4 * g;
        const u32x2 gb = *(const u32x2*)(h + (size_t)row * NC + C_GB + col);
        u32x2 w;
        w.x = pk_bf16(acc[mi][ni][0] * sigmoid_f(bf_lo(gb.x)), acc[mi][ni][1] * sigmoid_f(bf_hi(gb.x)));
        w.y = pk_bf16(acc[mi][ni][2] * sigmoid_f(bf_lo(gb.y)), acc[mi][ni][3] * sigmoid_f(bf_hi(gb.y)));
        *(u32x2*)(mg + (size_t)row * 1024 + col) = w;
      }
      __builtin_amdgcn_sched_barrier(0);
    }
  }
}

DI void phase5(const Params& p, int wvs, unsigned char* smem) {
  const int xcd = blockIdx.x & 7, lb = blockIdx.x >> 3, nlb = gridDim.x >> 3;
  const u16* mg = (const u16*)(p.ws + OFF_SC);
  const u16* wot = (const u16*)(p.ws + OFF_WOT);
  const int tid0 = opaque_tid(); const int lane = tid0 & 63, wv = tid0 >> 6, wm = wv >> 1, wn = wv & 1, r16 = lane & 15, g = lane >> 4;
  for (int li = lb;; li += nlb) {
    int mt, nt; if (!tile_of(li, 4, xcd, mt, nt)) break;
    f32x4 acc[4][8]; zero_acc(acc);
    gemm_kloop(p, wvs, mg, 1024, wot, 1024, 32, mt * 128, nt * 256, acc, smem);
#pragma unroll
    for (int mi = 0; mi < 4; ++mi) {
      const int row = mt * 128 + wm * 64 + mi * 16 + r16;
#pragma unroll
      for (int ni = 0; ni < 8; ++ni) {
        const int col = nt * 256 + wn * 128 + ni * 16 + 4 * g;
        const f32x4 xv = *(const f32x4*)(p.x + (size_t)row * 1024 + col);
        *(f32x4*)(p.out + (size_t)row * 1024 + col) = xv * 1.189207115002721f + acc[mi][ni];
      }
    }
  }
}

DI float wave_sum(float v, int lane) {
#pragma unroll
  for (int o = 32; o > 0; o >>= 1) v += shx(v, o, lane);
  return v;
}
DI void phase6(const Params& p, int wvs, unsigned char* smem) {
  const int tid = opaque_tid(), lane = tid & 63, wv = tid >> 6;
  f32x4 gm[4], bt[4];
#pragma unroll
  for (int j = 0; j < 4; ++j) { gm[j] = *(const f32x4*)(p.ln_g + 4 * (lane + 64 * j)); bt[j] = *(const f32x4*)(p.ln_b + 4 * (lane + 64 * j)); }
  const int xcd6 = blockIdx.x & 7, lb6 = blockIdx.x >> 3, nlb6 = gridDim.x >> 3;
  for (int lr = (lb6 * 4 + wv) * 2; lr < 4096; lr += nlb6 * 8) {
    float* r0 = p.out + (size_t)(4096 * xcd6 + (4095 - lr)) * 1024;
    float* r1 = p.out + (size_t)(4096 * xcd6 + (4094 - lr)) * 1024;
    f32x4 a[4], b[4];
#pragma unroll
    for (int j = 0; j < 4; ++j) { a[j] = *(const f32x4*)(r0 + 4 * (lane + 64 * j)); b[j] = *(const f32x4*)(r1 + 4 * (lane + 64 * j)); }
    float sa = 0.f, sb = 0.f;
#pragma unroll
    for (int j = 0; j < 4; ++j) { sa += (a[j][0] + a[j][1]) + (a[j][2] + a[j][3]); sb += (b[j][0] + b[j][1]) + (b[j][2] + b[j][3]); }
    const float ma = wave_sum(sa, lane) * (1.0f / 1024.0f), mb = wave_sum(sb, lane) * (1.0f / 1024.0f);
    float qa = 0.f, qb = 0.f;
#pragma unroll
    for (int j = 0; j < 4; ++j) {
      a[j] = a[j] - ma; b[j] = b[j] - mb;
      qa += (a[j][0] * a[j][0] + a[j][1] * a[j][1]) + (a[j][2] * a[j][2] + a[j][3] * a[j][3]);
      qb += (b[j][0] * b[j][0] + b[j][1] * b[j][1]) + (b[j][2] * b[j][2] + b[j][3] * b[j][3]);
    }
    const float ra = rsqrtf(wave_sum(qa, lane) * (1.0f / 1024.0f) + 1e-5f), rb = rsqrtf(wave_sum(qb, lane) * (1.0f / 1024.0f) + 1e-5f);
#pragma unroll
    for (int j = 0; j < 4; ++j) {
      *(f32x4*)(r0 + 4 * (lane + 64 * j)) = a[j] * ra * gm[j] + bt[j];
      *(f32x4*)(r1 + 4 * (lane + 64 * j)) = b[j] * rb * gm[j] + bt[j];
    }
  }
}

#define XB_TMO      128
#define XB_XCNT(j)  (256  + 64 * (j))
#define XB_XSUB(j)  (1280 + 64 * (j))
#define XB_XGEN(j)  (2304 + 64 * (j))
#define XB_TOP      3328
#define XB_TOPGEN   3392
#define XCD_BAR_WORDS 3456
#define XB_SPIN_CAP (1u << 22)
#define LAS __attribute__((address_space(3)))
DI unsigned xb_ld(unsigned* p) { return __hip_atomic_load(p, __ATOMIC_RELAXED, __HIP_MEMORY_SCOPE_AGENT); }
DI unsigned xb_add(unsigned* p, unsigned v) { return __hip_atomic_fetch_add(p, v, __ATOMIC_RELAXED, __HIP_MEMORY_SCOPE_AGENT); }
DI unsigned xb_xcc_id() { return (unsigned)__builtin_amdgcn_s_getreg((3 << 11) | 20) & 0xFu; }
#define XB_SPIN(cond, bar) do { unsigned _sp = 0; while (cond) { __builtin_amdgcn_s_sleep(1); \
    if ((++_sp & 255u) == 0u) { if (xb_ld(&(bar)[XB_TMO])) break; if (_sp > XB_SPIN_CAP) { atomicAdd(&(bar)[XB_TMO], 1u); break; } } } } while (0)
struct XcdBarrier { unsigned* bar; unsigned x; volatile LAS unsigned* st; };
DI bool xb_leader(int wvs) { return wvs == 0 && __builtin_amdgcn_mbcnt_hi(~0u, __builtin_amdgcn_mbcnt_lo(~0u, 0u)) == 0u; }
DI XcdBarrier xcd_barrier_post(unsigned* bar, volatile LAS unsigned* st, int wvs) {
  XcdBarrier b; b.bar = bar; b.x = xb_xcc_id(); b.st = st;
  if (xb_leader(wvs)) (void)xb_add(&bar[XB_XCNT(b.x)], 1u);
  return b;
}
DI void xcd_barrier_complete(unsigned* bar, unsigned x, unsigned& nloc, unsigned& nx) {
  const unsigned G = gridDim.x * gridDim.y * gridDim.z;
  unsigned sum, cnt, mine, sp = 0u;
  for (;;) {
    sum = 0u; cnt = 0u; mine = 0u;
#pragma unroll
    for (unsigned j = 0; j < 16; ++j) { const unsigned c = xb_ld(&bar[XB_XCNT(j)]); sum += c; cnt += (c > 0u) ? 1u : 0u; mine = (j == x) ? c : mine; }
    if (sum == G) break;
    __builtin_amdgcn_s_sleep(1);
    if ((++sp & 255u) == 0u) { if (xb_ld(&bar[XB_TMO])) break; if (sp > XB_SPIN_CAP) { atomicAdd(&bar[XB_TMO], 1u); break; } }
  }
  nloc = mine > 0u ? mine : 1u; nx = cnt > 0u ? cnt : 1u;
}
DI void xcd_barrier_(const XcdBarrier& b, int wvs) {
  asm volatile("s_waitcnt vmcnt(0)" ::: "memory");
  __syncthreads();
  if (xb_leader(wvs)) {
    unsigned* bar = b.bar;
    __builtin_amdgcn_s_waitcnt(0);
    unsigned nloc = b.st[0], nx = b.st[1];
    if (nloc == 0u) { xcd_barrier_complete(bar, b.x, nloc, nx); b.st[0] = nloc; b.st[1] = nx; }
    const unsigned old = xb_add(&bar[XB_XSUB(b.x)], 1u);
    const unsigned gen = old / nloc;
    if (old + 1u == (gen + 1u) * nloc) {
      __builtin_amdgcn_fence(__ATOMIC_RELEASE, "agent");
      asm volatile("s_waitcnt vmcnt(0)" ::: "memory");
      const unsigned og = xb_add(&bar[XB_TOP], 1u);
      const unsigned tg = og / nx;
      if (og + 1u == (tg + 1u) * nx) xb_add(&bar[XB_TOPGEN], 1u);
      else XB_SPIN(xb_ld(&bar[XB_TOPGEN]) == tg, bar);
      __builtin_amdgcn_fence(__ATOMIC_ACQUIRE, "agent");
      xb_add(&bar[XB_XGEN(b.x)], 1u);
      asm volatile("s_waitcnt vmcnt(0)" ::: "memory");
    } else {
      XB_SPIN(xb_ld(&bar[XB_XGEN(b.x)]) == gen, bar);
      __builtin_amdgcn_fence(__ATOMIC_ACQUIRE, "agent");
      asm volatile("s_waitcnt vmcnt(0)" ::: "memory");
    }
  }
  __syncthreads();
}

#define xcd_barrier(b) xcd_barrier_(b, wvs)
#ifndef MK_MULTI
#define MK_MULTI 0
#endif
#define SMEM_DECL __shared__ __attribute__((aligned(16))) unsigned char smem[SMEM_BYTES]; const int wvs = __builtin_amdgcn_readfirstlane((int)(threadIdx.x >> 6));
#if MK_MULTI
__global__ void __launch_bounds__(256, 2) k_p0(Params p) { SMEM_DECL (void)smem; phase0(p, wvs); }
__global__ void __launch_bounds__(256, 2) k_p1(Params p) { SMEM_DECL phase1(p, wvs, smem); }
__global__ void __launch_bounds__(256, 2) k_p2(Params p) { SMEM_DECL for (int it = blockIdx.x; it < 2048; it += gridDim.x) prep_item(p, wvs, it, smem); }
__global__ void __launch_bounds__(256, 2) k_p3(Params p) { SMEM_DECL
  if (blockIdx.x < 128) scan_chain(p, wvs, blockIdx.x, smem);
  else for (int it = blockIdx.x - 128; it < 1024; it += gridDim.x - 128) swa_item(p, wvs, it, smem); }
__global__ void __launch_bounds__(256, 2) k_p3b(Params p) { SMEM_DECL (void)smem; phase_ya(p, wvs); }
__global__ void __launch_bounds__(256, 2) k_p4(Params p) { SMEM_DECL phase4(p, wvs, smem); }
__global__ void __launch_bounds__(256, 2) k_p5(Params p) { SMEM_DECL phase5(p, wvs, smem); }
__global__ void __launch_bounds__(256, 2) k_p6(Params p) { SMEM_DECL phase6(p, wvs, smem); }
#else
__global__ void __launch_bounds__(256, 2) fwd_megakernel(Params p) {
  cg::grid_group grid = cg::this_grid();
  SMEM_DECL
  volatile LAS unsigned* st = (volatile LAS unsigned*)(smem + SMEM_BYTES - 16);
  { const int t0_ = opaque_tid(); if (t0_ < 4) st[t0_] = 0u; }
  __syncthreads();
  const XcdBarrier xb = xcd_barrier_post((unsigned*)(p.ws + OFF_BAR), st, wvs);
  phase0(p, wvs);
  if (p.ws == nullptr) grid.sync();
  xcd_barrier(xb);
  phase1(p, wvs, smem);
  xcd_barrier(xb);
  for (int it = blockIdx.x; it < 2048; it += gridDim.x) prep_item(p, wvs, it, smem);
  xcd_barrier(xb);
  if (blockIdx.x < 128) scan_chain(p, wvs, blockIdx.x, smem);
  else for (int it = blockIdx.x - 128; it < 1024; it += gridDim.x - 128) swa_item(p, wvs, it, smem);
  xcd_barrier(xb);
  phase_ya(p, wvs);
  xcd_barrier(xb);
  phase4(p, wvs, smem);
  xcd_barrier(xb);
  phase5(p, wvs, smem);
  xcd_barrier(xb);
  phase6(p, wvs, smem);
}
#endif

extern "C" void kernel_launch(void* const* d_in, const int* in_sizes, int n_in, void* d_out, int out_size,
                              void* d_ws, size_t ws_size, hipStream_t stream) {
  if (ws_size < WS_NEED) { fprintf(stderr, "workspace too small: %zu < %zu\n", ws_size, (size_t)WS_NEED); return; }
  Params p{};
  p.x = (const float*)d_in[0]; p.w_in = (const float*)d_in[1]; p.conv_w = (const float*)d_in[2]; p.a_log = (const float*)d_in[3];
  p.dt_bias = (const float*)d_in[4]; p.dn_norm_w = (const float*)d_in[5]; p.sinks = (const float*)d_in[6];
  p.w_branch = (const float*)d_in[7]; p.w_out = (const float*)d_in[8]; p.ln_g = (const float*)d_in[9]; p.ln_b = (const float*)d_in[10];
  p.out = (float*)d_out; p.ws = (unsigned char*)d_ws;
  for (int i = 0; i < 8; ++i) p.inv_freq[i] = (float)std::pow(500000.0, -(double)i / 8.0);
#if MK_MULTI
  const dim3 g(512), b(256);
  k_p0<<<g, b, 0, stream>>>(p);
  k_p1<<<g, b, 0, stream>>>(p);
  k_p2<<<g, b, 0, stream>>>(p);
  k_p3<<<g, b, 0, stream>>>(p);
  k_p3b<<<g, b, 0, stream>>>(p);
  k_p4<<<g, b, 0, stream>>>(p);
  k_p5<<<g, b, 0, stream>>>(p);
  k_p6<<<g, b, 0, stream>>>(p);
#else
  static int grid_blocks = 0;
  if (!grid_blocks) {
    int dev = 0, cus = 0, per_cu = 0;
    (void)hipGetDevice(&dev);
    (void)hipDeviceGetAttribute(&cus, hipDeviceAttributeMultiprocessorCount, dev);
    (void)hipOccupancyMaxActiveBlocksPerMultiprocessor(&per_cu, fwd_megakernel, 256, 0);
    if (per_cu > 2) per_cu = 2;
    if (per_cu < 1) per_cu = 1;
    grid_blocks = cus * per_cu;
    grid_blocks &= ~7;
  }
  (void)hipMemsetAsync(p.ws + OFF_BAR, 0, BAR_BYTES, stream);
  void* args[] = {&p};
  hipError_t e = hipLaunchCooperativeKernel((void*)fwd_megakernel, dim3(grid_blocks), dim3(256), args, 0, stream);
  if (e != hipSuccess) fprintf(stderr, "cooperative launch failed: %s (grid %d)\n", hipGetErrorString(e), grid_blocks);
#endif
}
```

```cpp
#include <hip/hip_runtime.h>
#include <hip/hip_cooperative_groups.h>
#include <cstdio>
#include <cmath>
namespace cg = cooperative_groups;

typedef unsigned short u16;
typedef short bf16x8 __attribute__((ext_vector_type(8)));
typedef float f32x4 __attribute__((ext_vector_type(4)));
typedef unsigned u32x4 __attribute__((ext_vector_type(4)));
typedef unsigned u32x2 __attribute__((ext_vector_type(2)));
#define DI __device__ __forceinline__
DI int opaque_tid_(int wave_s) { int t = (int)__builtin_amdgcn_mbcnt_hi(~0u, __builtin_amdgcn_mbcnt_lo(~0u, 0u)) + (wave_s << 6); asm volatile("" : "+v"(t)); return t; }
#define opaque_tid() opaque_tid_(wvs)

constexpr int T_TOK = 32768, SEQ = 8192, DM = 1024, NC = 5384, NCP = 5376;
constexpr int C_DNZ = 1536, C_SWQ = 2056, C_SWK = 2568, C_SWV = 2696, C_SWZ = 2824, C_GA = 3336, C_GB = 4360;
constexpr size_t OFF_BAR = 0;
constexpr size_t BAR_BYTES = 16384;
constexpr size_t OFF_WINT = BAR_BYTES;
constexpr size_t OFF_WAT = OFF_WINT + (size_t)NCP * 1024 * 2;
constexpr size_t OFF_WBT = OFF_WAT + 1024 * 512 * 2;
constexpr size_t OFF_WOT = OFF_WBT + 1024 * 512 * 2;
constexpr size_t OFF_ROPE = OFF_WOT + 1024 * 1024 * 2;
constexpr size_t OFF_HB = OFF_ROPE + 2 * 8192 * 8 * 4;
constexpr size_t OFF_DEC = OFF_HB + (size_t)T_TOK * 8 * 4;
constexpr size_t OFF_H = OFF_DEC + 2048 * 4;
constexpr size_t OFF_SC = OFF_H + (size_t)T_TOK * NC * 2;
constexpr size_t OPB = 73728;
constexpr size_t WS_NEED = OFF_SC + 2048 * OPB;
constexpr int SMEM_BYTES = 73728 + 16;

struct Params {
  const float *x, *w_in, *conv_w, *a_log, *dt_bias, *dn_norm_w, *sinks, *w_branch, *w_out, *ln_g, *ln_b;
  float* out; unsigned char* ws;
  float inv_freq[8];
};

typedef __bf16 bf16x2_t __attribute__((ext_vector_type(2)));
typedef float f32x2_t __attribute__((ext_vector_type(2)));
DI unsigned pk_bf16(float lo, float hi) { f32x2_t f = {lo, hi}; bf16x2_t v = __builtin_convertvector(f, bf16x2_t); return __builtin_bit_cast(unsigned, v); }
DI float bf_lo(unsigned u) { return __uint_as_float(u << 16); }
DI float bf_hi(unsigned u) { return __uint_as_float(u & 0xffff0000u); }
DI float bf2f(u16 v) { return __uint_as_float(((unsigned)v) << 16); }
DI u16 f2bf(float f) { return (u16)(pk_bf16(f, f) & 0xffffu); }
DI float shx(float v, int m, int lane) { return __uint_as_float((unsigned)__builtin_amdgcn_ds_bpermute((lane ^ m) << 2, (int)__float_as_uint(v))); }
DI float rcp_f(float y) { return __builtin_amdgcn_rcpf(y); }
DI float silu_f(float y) { return y * rcp_f(1.0f + __expf(-y)); }
DI float sigmoid_f(float y) { return rcp_f(1.0f + __expf(-y)); }
DI f32x4 mfma16(bf16x8 a, bf16x8 b, f32x4 c) { return __builtin_amdgcn_mfma_f32_16x16x32_bf16(a, b, c, 0, 0, 0); }
DI bf16x8 as_bf8(u32x4 v) { return __builtin_bit_cast(bf16x8, v); }
DI bf16x8 pack8(f32x4 a, f32x4 b) { u32x4 w; w.x = pk_bf16(a[0], a[1]); w.y = pk_bf16(a[2], a[3]); w.z = pk_bf16(b[0], b[1]); w.w = pk_bf16(b[2], b[3]); return as_bf8(w); }

DI void phase0(const Params& p, int wvs) {
  const size_t gt = (size_t)blockIdx.x * 256 + opaque_tid(), gs = (size_t)gridDim.x * 256;
  {
    const int ltid = (int)(gt & 255), lane = ltid & 63, wv = ltid >> 6;
    float wr[16][8];
#pragma unroll
    for (int j = 0; j < 4; ++j)
#pragma unroll
      for (int c = 0; c < 4; ++c) {
        const float* wp = p.w_in + (size_t)(4 * (lane + 64 * j) + c) * NC + 2048;
        const f32x4 a = *(const f32x4*)wp, b = *(const f32x4*)(wp + 4);
#pragma unroll
        for (int q = 0; q < 4; ++q) { wr[4 * j + c][q] = a[q]; wr[4 * j + c][4 + q] = b[q]; }
      }
    u16* xb = (u16*)(p.ws + OFF_SC);
    float* hb = (float*)(p.ws + OFF_HB);
    const int rstep = gridDim.x * 4;
    for (int row0 = blockIdx.x * 4 + wv; row0 < T_TOK; row0 += 2 * rstep) {
      f32x4 xr[2][4];
#pragma unroll
      for (int u = 0; u < 2; ++u) {
        const int row = row0 + u * rstep;
#pragma unroll
        for (int j = 0; j < 4; ++j) xr[u][j] = (row < T_TOK) ? *(const f32x4*)(p.x + (size_t)row * DM + 4 * (lane + 64 * j)) : (f32x4){0.f, 0.f, 0.f, 0.f};
      }
#pragma unroll
      for (int u = 0; u < 2; ++u) {
        const int row = row0 + u * rstep;
        float v[8];
#pragma unroll
        for (int q = 0; q < 8; ++q) v[q] = 0.f;
#pragma unroll
        for (int j = 0; j < 4; ++j) {
          const f32x4 xv = xr[u][j];
          u32x2 w; w.x = pk_bf16(xv[0], xv[1]); w.y = pk_bf16(xv[2], xv[3]);
          if (row < T_TOK) *(u32x2*)(xb + (size_t)row * DM + 4 * (lane + 64 * j)) = w;
#pragma unroll
          for (int c = 0; c < 4; ++c)
#pragma unroll
            for (int q = 0; q < 8; ++q) v[q] += xv[c] * wr[4 * j + c][q];
        }
        const bool up = (lane & 32) != 0;
        float k4[4];
#pragma unroll
        for (int i = 0; i < 4; ++i) { const float snd = up ? v[i] : v[i + 4]; const float kp = up ? v[i + 4] : v[i]; k4[i] = kp + shx(snd, 32, lane); }
        const bool up2 = (lane & 16) != 0;
        float k2[2];
#pragma unroll
        for (int i = 0; i < 2; ++i) { const float snd = up2 ? k4[i] : k4[i + 2]; const float kp = up2 ? k4[i + 2] : k4[i]; k2[i] = kp + shx(snd, 16, lane); }
        const bool up3 = (lane & 8) != 0;
        float k1 = (up3 ? k2[1] : k2[0]) + shx(up3 ? k2[0] : k2[1], 8, lane);
        k1 += shx(k1, 4, lane); k1 += shx(k1, 2, lane); k1 += shx(k1, 1, lane);
        if ((lane & 7) == 0 && row < T_TOK) hb[(size_t)row * 8 + (lane >> 3)] = k1;
      }
    }
  }
  {
    u32x4* wt = (u32x4*)(p.ws + OFF_WINT);
    for (size_t i = gt; i < (size_t)NCP * 128; i += gs) {
      const int kc = (int)(i / NCP), n = (int)(i % NCP);
      float v[8];
#pragma unroll
      for (int j = 0; j < 8; ++j) v[j] = p.w_in[(size_t)(kc * 8 + j) * NC + n + (n >= 2048 ? 8 : 0)];
      u32x4 w; w.x = pk_bf16(v[0], v[1]); w.y = pk_bf16(v[2], v[3]); w.z = pk_bf16(v[4], v[5]); w.w = pk_bf16(v[6], v[7]);
      wt[(size_t)n * 128 + kc] = w;
    }
  }
  {
    for (size_t i = gt; i < (size_t)2 * 1024 * 64; i += gs) {
      const int br = (int)(i / (1024 * 64)), rem = (int)(i % (1024 * 64)), kc = rem / 1024, n = rem % 1024;
      const float* src = p.w_branch + (size_t)br * 512 * 1024;
      float v[8];
#pragma unroll
      for (int j = 0; j < 8; ++j) v[j] = src[(size_t)(kc * 8 + j) * 1024 + n];
      u32x4 w; w.x = pk_bf16(v[0], v[1]); w.y = pk_bf16(v[2], v[3]); w.z = pk_bf16(v[4], v[5]); w.w = pk_bf16(v[6], v[7]);
      ((u32x4*)(p.ws + (br ? OFF_WBT : OFF_WAT)))[(size_t)n * 64 + kc] = w;
    }
  }
  {
    for (size_t i = gt; i < (size_t)1024 * 128; i += gs) {
      const int kc = (int)(i / 1024), n = (int)(i % 1024);
      float v[8];
#pragma unroll
      for (int j = 0; j < 8; ++j) v[j] = p.w_out[(size_t)(kc * 8 + j) * 1024 + n];
      u32x4 w; w.x = pk_bf16(v[0], v[1]); w.y = pk_bf16(v[2], v[3]); w.z = pk_bf16(v[4], v[5]); w.w = pk_bf16(v[6], v[7]);
      ((u32x4*)(p.ws + OFF_WOT))[(size_t)n * 128 + kc] = w;
    }
  }
  {
    float* rc = (float*)(p.ws + OFF_ROPE); float* rs = rc + 8192 * 8;
    for (size_t i = gt; i < 8192 * 8; i += gs) {
      const int t = (int)(i >> 3), f = (int)(i & 7);
      const float ang = (float)t * p.inv_freq[f];
      const double a = (double)ang;
      const double k = __builtin_rint(a * 0.15915494309189535);
      const float r = (float)(a - k * 6.283185307179586);
      rc[i] = cosf(r); rs[i] = sinf(r);
    }
  }
}

DI int lds_off32(int row, int chunk) { return row * 64 + ((chunk ^ ((0 - (row >> 2)) & 3)) << 4); }
constexpr int GSTAGE = 24576;

DI void gemm_kloop(const Params& p, int wvs, const u16* __restrict__ A, int lda, const u16* __restrict__ Bt, int ldb, int nk, int m0, int n0,
                   f32x4 (&acc)[4][8], unsigned char* smem) {
  const int tid = opaque_tid(), lane = tid & 63, wv = tid >> 6, wm = wv >> 1, wn = wv & 1, r16 = lane & 15, g = lane >> 4;
  const int prow = lane >> 2, pc = (lane & 3) ^ ((0 - (prow >> 2)) & 3);
  const u16* ap = A + (size_t)(m0 + 16 * wv + prow) * lda + pc * 8;
  const u16* bp = Bt + (size_t)(n0 + 16 * wv + prow) * ldb + pc * 8;
  unsigned char* lA = smem + wv * 1024;
  unsigned char* lB = smem + 8192 + wv * 1024;
#define GEMM_ISSUE(kt_, buf_) do { \
    _Pragma("unroll") for (int i_ = 0; i_ < 2; ++i_) \
      __builtin_amdgcn_global_load_lds((const unsigned*)(ap + (size_t)(64 * i_) * lda + (kt_) * 32), (unsigned*)(lA + (buf_) * GSTAGE + i_ * 4096), 16, 0, 0); \
    _Pragma("unroll") for (int i_ = 0; i_ < 4; ++i_) \
      __builtin_amdgcn_global_load_lds((const unsigned*)(bp + (size_t)(64 * i_) * ldb + (kt_) * 32), (unsigned*)(lB + (buf_) * GSTAGE + i_ * 4096), 16, 0, 0); \
  } while (0)
  GEMM_ISSUE(0, 0);
  GEMM_ISSUE(1, 1);
  asm volatile("s_waitcnt vmcnt(6)" ::: "memory");
  __builtin_amdgcn_s_barrier();
  int cb = 0;
  for (int kt = 0; kt < nk; ++kt) {
    int ib = cb + 2; if (ib >= 3) ib -= 3;
    const bool more = (kt + 2 < nk);
    if (more) GEMM_ISSUE(kt + 2, ib);
    const unsigned char* cur = smem + cb * GSTAGE;
    bf16x8 af[4], bfr[8];
#pragma unroll
    for (int i = 0; i < 4; ++i) af[i] = *(const bf16x8*)(cur + lds_off32(wm * 64 + i * 16 + r16, g));
#pragma unroll
    for (int i = 0; i < 8; ++i) bfr[i] = *(const bf16x8*)(cur + 8192 + lds_off32(wn * 128 + i * 16 + r16, g));
#pragma unroll
    for (int mi = 0; mi < 4; ++mi)
#pragma unroll
      for (int ni = 0; ni < 8; ++ni) acc[mi][ni] = mfma16(bfr[ni], af[mi], acc[mi][ni]);
    if (more) asm volatile("s_waitcnt vmcnt(6)" ::: "memory"); else asm volatile("s_waitcnt vmcnt(0)" ::: "memory");
    asm volatile("s_waitcnt lgkmcnt(0)" ::: "memory");
    __builtin_amdgcn_s_barrier();
    cb = cb + 1; if (cb >= 3) cb = 0;
  }
#undef GEMM_ISSUE
}

DI bool tile_of(int li, int ntn, int xcd, int& mt, int& nt) {
  if (li >= 32 * ntn) return false;
  const int grp = li / (8 * ntn), rem = li % (8 * ntn);
  nt = rem >> 3; mt = 32 * xcd + grp * 8 + (rem & 7);
  return true;
}

DI void zero_acc(f32x4 (&acc)[4][8]) {
#pragma unroll
  for (int i = 0; i < 4; ++i)
#pragma unroll
    for (int j = 0; j < 8; ++j) acc[i][j] = (f32x4){0.f, 0.f, 0.f, 0.f};
}

DI void phase1(const Params& p, int wvs, unsigned char* smem) {
  const int xcd = blockIdx.x & 7, lb = blockIdx.x >> 3, nlb = gridDim.x >> 3;
  const u16* xb = (const u16*)(p.ws + OFF_SC);
  const u16* wint = (const u16*)(p.ws + OFF_WINT);
  u16* h = (u16*)(p.ws + OFF_H);
  float* hb = (float*)(p.ws + OFF_HB);
  const int tid0 = opaque_tid(); const int lane = tid0 & 63, wv = tid0 >> 6, wm = wv >> 1, wn = wv & 1, r16 = lane & 15, g = lane >> 4;
  for (int li = lb;; li += nlb) {
    int mt, nt; if (!tile_of(li, 21, xcd, mt, nt)) break;
    f32x4 acc[4][8]; zero_acc(acc);
    gemm_kloop(p, wvs, xb, 1024, wint, 1024, 32, mt * 128, nt * 256, acc, smem);
#pragma unroll
    for (int mi = 0; mi < 4; ++mi) {
      const int row = mt * 128 + wm * 64 + mi * 16 + r16;
#pragma unroll
      for (int ni = 0; ni < 8; ++ni) {
        const int col = nt * 256 + wn * 128 + ni * 16 + 4 * g;
        {
          u32x2 w; w.x = pk_bf16(acc[mi][ni][0], acc[mi][ni][1]); w.y = pk_bf16(acc[mi][ni][2], acc[mi][ni][3]);
          *(u32x2*)(h + (size_t)row * NC + col + (nt >= 8 ? 8 : 0)) = w;
        }
      }
    }
  }
}

template <int I> DI void solve_rows2(f32x2_t (&xv)[64], const float* Lm, int lane, float lcur) {
  if constexpr (I < 64) {
    float lnx = 0.f;
    if constexpr (I + 1 < 64) lnx = Lm[(I + 1) * 68 + lane];
    f32x2_t a0 = xv[I], a1 = {0.f, 0.f}, a2 = {0.f, 0.f}, a3 = {0.f, 0.f};
#pragma unroll
    for (int m = 0; m < I; ++m) {
      const float l = __builtin_bit_cast(float, __builtin_amdgcn_readlane(__builtin_bit_cast(int, lcur), m));
      const f32x2_t lv = {l, l};
      if ((m & 3) == 0) a0 -= lv * xv[m];
      else if ((m & 3) == 1) a1 -= lv * xv[m];
      else if ((m & 3) == 2) a2 -= lv * xv[m];
      else a3 -= lv * xv[m];
    }
    xv[I] = (a0 + a1) + (a2 + a3);
    solve_rows2<I + 1>(xv, Lm, lane, lnx);
  }
}

DI void prep_item(const Params& p, int wvs, int item, unsigned char* smem) {
  const int tid_ = opaque_tid();
  const int tid = tid_, lane = tid & 63, wv = tid >> 6, r16 = lane & 15, g = lane >> 4;
  const int hd = item & 3, n = (item >> 2) & 127, b = item >> 9;
  const int t0 = b * SEQ + n * 64;
  u16* Qs = (u16*)smem; u16* Ks = Qs + 64 * 136; u16* Vs = Ks + 64 * 136;
  float* Lm = (float*)(smem + 52224);
  float* sm_beta = (float*)(smem + 69632);
  float* sm_gc = sm_beta + 64; float* sm_rq = sm_gc + 64; float* sm_rk = sm_rq + 64;
  float* sm_fw = sm_rk + 64; float* sm_fq = sm_fw + 64; float* sm_fk = sm_fq + 64;
  const u16* h = (const u16*)(p.ws + OFF_H);
  const float* hb = (const float*)(p.ws + OFF_HB);
  unsigned char* op = p.ws + OFF_SC + (size_t)item * OPB;
  __syncthreads();
  {
    const int c2 = tid & 63, rbase = (tid >> 6) * 16;
    unsigned raw[3][19];
#pragma unroll
    for (int mat = 0; mat < 3; ++mat) {
      const int col = mat * 512 + hd * 128 + 2 * c2;
#pragma unroll
      for (int j = 0; j < 19; ++j) {
        const int rr = t0 + rbase - 3 + j;
        raw[mat][j] = *(const unsigned*)(h + (size_t)(rr < 0 ? 0 : rr) * NC + col);
      }
    }
    __builtin_amdgcn_sched_barrier(0);
#pragma unroll
    for (int mat = 0; mat < 3; ++mat) {
      const int col = mat * 512 + hd * 128 + 2 * c2;
      float wa[4], wb[4];
#pragma unroll
      for (int j = 0; j < 4; ++j) { wa[j] = p.conv_w[j * 1536 + col]; wb[j] = p.conv_w[j * 1536 + col + 1]; }
      float xa[3], xb[3];
#pragma unroll
      for (int j = 0; j < 3; ++j) {
        const int pos = n * 64 + rbase - 3 + j;
        const unsigned v = (pos >= 0) ? raw[mat][j] : 0u;
        xa[j] = bf_lo(v); xb[j] = bf_hi(v);
      }
      u16* dst = (mat == 0 ? Qs : (mat == 1 ? Ks : Vs));
#pragma unroll
      for (int i = 0; i < 16; ++i) {
        const unsigned v = raw[mat][3 + i];
        const float a3 = bf_lo(v), b3 = bf_hi(v);
        const float ya = wa[0] * xa[0] + wa[1] * xa[1] + wa[2] * xa[2] + wa[3] * a3;
        const float yb = wb[0] * xb[0] + wb[1] * xb[1] + wb[2] * xb[2] + wb[3] * b3;
        xa[0] = xa[1]; xa[1] = xa[2]; xa[2] = a3; xb[0] = xb[1]; xb[1] = xb[2]; xb[2] = b3;
        *(unsigned*)(dst + (rbase + i) * 136 + 2 * c2) = pk_bf16(silu_f(ya), silu_f(yb));
      }
    }
  }
  __syncthreads();
  if (wv == 0) {
    const int row = t0 + lane;
    const float bl = hb[(size_t)row * 8 + hd], al = hb[(size_t)row * 8 + 4 + hd];
    const float xx = al + p.dt_bias[hd];
    const float sp = xx > 20.f ? xx : log1pf(expf(xx));
    float gg = -expf(p.a_log[hd]) * sp;
#pragma unroll
    for (int o = 1; o < 64; o <<= 1) { const float t = __uint_as_float((unsigned)__builtin_amdgcn_ds_bpermute(((lane - o) & 63) << 2, (int)__float_as_uint(gg))); if (lane >= o) gg += t; }
    sm_beta[lane] = 1.0f / (1.0f + expf(-bl)); sm_gc[lane] = gg;
  } else if (wv <= 2) {
    const int r = tid - 64;
    const u16* src = (r < 64) ? (Qs + r * 136) : (Ks + (r - 64) * 136);
    float ss = 0.f;
#pragma unroll
    for (int c = 0; c < 16; ++c) {
      const u32x4 v = *(const u32x4*)(src + c * 8);
#pragma unroll
      for (int j = 0; j < 4; ++j) { const float a = bf_lo(v[j]), bb = bf_hi(v[j]); ss += a * a + bb * bb; }
    }
    const float rs = rsqrtf(ss + 1e-6f);
    if (r < 64) sm_rq[r] = rs; else sm_rk[r - 64] = rs;
  }
  __syncthreads();
  if (tid < 64) {
    const float gc = sm_gc[tid], gl = sm_gc[63], eg = expf(gc);
    sm_fw[tid] = sm_beta[tid] * eg * sm_rk[tid];
    sm_fq[tid] = sm_rq[tid] * 0.08838834764831845f * eg;
    sm_fk[tid] = sm_rk[tid] * expf(gl - gc);
    if (tid == 0) ((float*)(p.ws + OFF_DEC))[item] = expf(gl);
  }
  {
    bf16x8 kfi[4], qfi[4];
#pragma unroll
    for (int s = 0; s < 4; ++s) {
      kfi[s] = *(const bf16x8*)(Ks + (16 * wv + r16) * 136 + 32 * s + 8 * g);
      qfi[s] = *(const bf16x8*)(Qs + (16 * wv + r16) * 136 + 32 * s + 8 * g);
    }
    f32x4 at[4];
#pragma unroll
    for (int jt = 0; jt < 4; ++jt) {
      at[jt] = (f32x4){0.f, 0.f, 0.f, 0.f};
      if (jt <= wv) {
        f32x4 la = (f32x4){0.f, 0.f, 0.f, 0.f}, aa = (f32x4){0.f, 0.f, 0.f, 0.f};
#pragma unroll
        for (int s = 0; s < 4; ++s) {
          const bf16x8 kfj = *(const bf16x8*)(Ks + (16 * jt + r16) * 136 + 32 * s + 8 * g);
          la = mfma16(kfi[s], kfj, la);
          aa = mfma16(kfj, qfi[s], aa);
        }
#pragma unroll
        for (int r = 0; r < 4; ++r) {
          { const int i = 16 * wv + 4 * g + r, j = 16 * jt + r16;
            const float v = (i > j) ? sm_beta[i] * sm_rk[i] * sm_rk[j] * __expf(sm_gc[i] - sm_gc[j]) * la[r] : 0.f;
            Lm[i * 68 + j] = v; }
          { const int j = 16 * jt + 4 * g + r, i = 16 * wv + r16;
            at[jt][r] = (j <= i) ? sm_rq[i] * sm_rk[j] * 0.08838834764831845f * __expf(sm_gc[i] - sm_gc[j]) * aa[r] : 0.f; }
        }
      }
    }
#pragma unroll
    for (int s2 = 0; s2 < 2; ++s2)
      *(bf16x8*)(op + 32768 + (size_t)((wv * 2 + s2) * 64 + lane) * 16) = pack8(at[2 * s2], at[2 * s2 + 1]);
  }
  __syncthreads();
  f32x2_t xv[64];
  if (wv < 2) {
#pragma unroll
    for (int i = 0; i < 64; ++i) { xv[i].x = sm_beta[i] * bf2f(Vs[i * 136 + tid]); xv[i].y = sm_fw[i] * bf2f(Ks[i * 136 + tid]); }
    solve_rows2<1>(xv, Lm, lane, Lm[68 + lane]);
    const int sl = tid >> 4, dvl = tid & 15;
#pragma unroll
    for (int mt = 0; mt < 4; ++mt)
#pragma unroll
      for (int gg = 0; gg < 4; ++gg) {
        u32x2 w; w.x = pk_bf16(xv[16 * mt + 4 * gg].x, xv[16 * mt + 4 * gg + 1].x); w.y = pk_bf16(xv[16 * mt + 4 * gg + 2].x, xv[16 * mt + 4 * gg + 3].x);
        *(u32x2*)(op + 57344 + (size_t)((sl * 4 + mt) * 64 + gg * 16 + dvl) * 8) = w;
      }
  } else {
    const int t2 = tid - 128;
#pragma unroll 2
    for (int f = 0; f < 8; ++f) {
      const int e = t2 + 128 * f, frag = e >> 6, ln = e & 63, lr = ln & 15, lg = ln >> 4;
      {
        const int mt = frag >> 2, sx = frag & 3, row = 16 * mt + lr;
        const u32x2 ql = *(const u32x2*)(Qs + row * 136 + 32 * sx + 4 * lg), qh = *(const u32x2*)(Qs + row * 136 + 32 * sx + 16 + 4 * lg);
        const float fq = sm_fq[row];
        u32x4 w;
        w.x = pk_bf16(bf_lo(ql.x) * fq, bf_hi(ql.x) * fq); w.y = pk_bf16(bf_lo(ql.y) * fq, bf_hi(ql.y) * fq);
        w.z = pk_bf16(bf_lo(qh.x) * fq, bf_hi(qh.x) * fq); w.w = pk_bf16(bf_lo(qh.y) * fq, bf_hi(qh.y) * fq);
        *(u32x4*)(op + 16384 + (size_t)e * 16) = w;
      }
      {
        const int mt8 = frag >> 1, s2 = frag & 1, dk = 16 * mt8 + lr;
        float v[8];
#pragma unroll
        for (int j = 0; j < 8; ++j) {
          const int pos = 32 * s2 + 16 * (j >> 2) + 4 * lg + (j & 3);
          v[j] = bf2f(Ks[pos * 136 + dk]) * sm_fk[pos];
        }
        u32x4 w; w.x = pk_bf16(v[0], v[1]); w.y = pk_bf16(v[2], v[3]); w.z = pk_bf16(v[4], v[5]); w.w = pk_bf16(v[6], v[7]);
        *(u32x4*)(op + 40960 + (size_t)e * 16) = w;
      }
    }
  }
  __syncthreads();
  if (wv < 2) {
#pragma unroll
    for (int i = 0; i < 64; ++i) Vs[i * 136 + tid] = f2bf(-xv[i].y);
  }
  __syncthreads();
#pragma unroll
  for (int f = 0; f < 4; ++f) {
    const int e = tid + 256 * f, frag = e >> 6, ln = e & 63, lr = ln & 15, lg = ln >> 4;
    const int mt = frag >> 2, sx = frag & 3, row = 16 * mt + lr;
    const u32x2 lo = *(const u32x2*)(Vs + row * 136 + 32 * sx + 4 * lg), hi = *(const u32x2*)(Vs + row * 136 + 32 * sx + 16 + 4 * lg);
    *(u32x4*)(op + (size_t)e * 16) = (u32x4){lo.x, lo.y, hi.x, hi.y};
  }
}

struct ScanA { u32x4 wf[4]; u32x2 uf; float dec; };
struct ScanB { u32x4 qf[4], af[2], kf[4]; };

DI void scan_load_a(const Params& p, int wvs, ScanA& o, int b, int hd, int sl, int n, int q, int lane) {
  const int item = (b * 128 + n) * 4 + hd;
  const unsigned char* op = p.ws + OFF_SC + (size_t)item * OPB;
#pragma unroll
  for (int s = 0; s < 4; ++s) {
    o.wf[s] = *(const u32x4*)(op + (size_t)((q * 4 + s) * 64 + lane) * 16);
  }
  o.uf = *(const u32x2*)(op + 57344 + (size_t)((sl * 4 + q) * 64 + lane) * 8);
  o.dec = ((const float*)(p.ws + OFF_DEC))[item];
}
DI void scan_load_b(const Params& p, int wvs, ScanB& o, int b, int hd, int n, int q, int lane) {
  const int item = (b * 128 + n) * 4 + hd;
  const unsigned char* op = p.ws + OFF_SC + (size_t)item * OPB;
#pragma unroll
  for (int s = 0; s < 4; ++s) o.qf[s] = *(const u32x4*)(op + 16384 + (size_t)((q * 4 + s) * 64 + lane) * 16);
#pragma unroll
  for (int s2 = 0; s2 < 2; ++s2) o.af[s2] = *(const u32x4*)(op + 32768 + (size_t)((q * 2 + s2) * 64 + lane) * 16);
#pragma unroll
  for (int j = 0; j < 4; ++j) o.kf[j] = *(const u32x4*)(op + 40960 + (size_t)((q * 4 + j) * 64 + lane) * 16);
}

DI void scan_step(const Params& p, int wvs, const ScanA& o, const ScanB& ob, f32x4 (&S)[2], int b, int hd, int sl, int n, int q, int lane, unsigned char* smem) {
  const int r16 = lane & 15, g = lane >> 4;
  u32x4* ldsS = (u32x4*)smem;
  u32x2* ldsV = (u32x2*)(smem + 4096);
  ldsS[q * 64 + lane] = __builtin_bit_cast(u32x4, pack8(S[0], S[1]));
  __syncthreads();
  bf16x8 Sb[4];
#pragma unroll
  for (int s = 0; s < 4; ++s) Sb[s] = as_bf8(ldsS[s * 64 + lane]);
  f32x4 vn = (f32x4){bf_lo(o.uf.x), bf_hi(o.uf.x), bf_lo(o.uf.y), bf_hi(o.uf.y)};
#pragma unroll
  for (int s = 0; s < 4; ++s) vn = mfma16(as_bf8(o.wf[s]), Sb[s], vn);
  { u32x2 w; w.x = pk_bf16(vn[0], vn[1]); w.y = pk_bf16(vn[2], vn[3]); ldsV[((q >> 1) * 64 + lane) * 2 + (q & 1)] = w; }
  f32x4 oa = (f32x4){0.f, 0.f, 0.f, 0.f};
#pragma unroll
  for (int s = 0; s < 4; ++s) oa = mfma16(as_bf8(ob.qf[s]), Sb[s], oa);
  __syncthreads();
  bf16x8 Vb[2];
#pragma unroll
  for (int s2 = 0; s2 < 2; ++s2) Vb[s2] = as_bf8(*(const u32x4*)(ldsV + (s2 * 64 + lane) * 2));
#pragma unroll
  for (int s2 = 0; s2 < 2; ++s2) oa = mfma16(as_bf8(ob.af[s2]), Vb[s2], oa);
  u16* h = (u16*)(p.ws + OFF_H);
  const int t0 = b * SEQ + n * 64;
#pragma unroll
  for (int r = 0; r < 4; ++r) h[(size_t)(t0 + 16 * q + 4 * g + r) * NC + hd * 128 + 16 * sl + r16] = f2bf(oa[r]);
#pragma unroll
  for (int t = 0; t < 2; ++t) {
    S[t] = S[t] * o.dec;
#pragma unroll
    for (int s2 = 0; s2 < 2; ++s2) S[t] = mfma16(as_bf8(ob.kf[t * 2 + s2]), Vb[s2], S[t]);
  }
}

DI void scan_chain(const Params& p, int wvs, int chain, unsigned char* smem) {
  const int tid0 = opaque_tid(); const int lane = tid0 & 63, q = tid0 >> 6;
  const int xcd = chain & 7, j = chain >> 3, pair = xcd + 8 * (j >> 3), sl = j & 7, b = pair >> 2, hd = pair & 3;
  f32x4 S[2]; S[0] = (f32x4){0.f, 0.f, 0.f, 0.f}; S[1] = S[0];
  ScanA a0, a1, a2; ScanB bc, bn;
  __syncthreads();
  scan_load_a(p, wvs, a0, b, hd, sl, 0, q, lane);
  scan_load_b(p, wvs, bc, b, hd, 0, q, lane);
  scan_load_a(p, wvs, a1, b, hd, sl, 1, q, lane);
#pragma unroll 1
  for (int n = 0; n < 129; n += 3) {
    if (n + 2 < 128) scan_load_a(p, wvs, a2, b, hd, sl, n + 2, q, lane);
    if (n + 1 < 128) scan_load_b(p, wvs, bn, b, hd, n + 1, q, lane);
    if (n < 128) scan_step(p, wvs, a0, bc, S, b, hd, sl, n, q, lane, smem);
    bc = bn;
    if (n + 3 < 128) scan_load_a(p, wvs, a0, b, hd, sl, n + 3, q, lane);
    if (n + 2 < 128) scan_load_b(p, wvs, bn, b, hd, n + 2, q, lane);
    if (n + 1 < 128) scan_step(p, wvs, a1, bc, S, b, hd, sl, n + 1, q, lane, smem);
    bc = bn;
    if (n + 4 < 128) scan_load_a(p, wvs, a1, b, hd, sl, n + 4, q, lane);
    if (n + 3 < 128) scan_load_b(p, wvs, bn, b, hd, n + 3, q, lane);
    if (n + 2 < 128) scan_step(p, wvs, a2, bc, S, b, hd, sl, n + 2, q, lane, smem);
    bc = bn;
  }
}

DI void swa_item(const Params& p, int wvs, int item, unsigned char* smem) {
  const int tid_ = opaque_tid();
  const int tid = tid_, lane = tid & 63, wv = tid >> 6, r16 = lane & 15, g = lane >> 4;
  const int qt = item & 127, kvh = (item >> 7) & 1, b = item >> 8;
  const int kp0 = 64 * qt - 128;
  u16* Ksm = (u16*)smem;
  u16* Vt = (u16*)(smem + 27648);
  u16* h = (u16*)(p.ws + OFF_H);
  const float* rc = (const float*)(p.ws + OFF_ROPE); const float* rs = rc + 8192 * 8;
  __syncthreads();
  if (tid < 192) {
    const int kk = tid, pos = kp0 + kk;
    u32x4 lo = (u32x4){0, 0, 0, 0}, hi = lo;
    if (pos >= 0) {
      const u16* src = h + (size_t)(b * SEQ + pos) * NC + C_SWK + kvh * 64;
      const u32x4 a = *(const u32x4*)src, c = *(const u32x4*)(src + 8);
      const f32x4 c0 = *(const f32x4*)(rc + pos * 8), c1 = *(const f32x4*)(rc + pos * 8 + 4);
      const f32x4 s0 = *(const f32x4*)(rs + pos * 8), s1 = *(const f32x4*)(rs + pos * 8 + 4);
      float t1[8], t2[8], cs[8], sn[8], o1[8], o2[8];
#pragma unroll
      for (int j = 0; j < 4; ++j) { t1[2 * j] = bf_lo(a[j]); t1[2 * j + 1] = bf_hi(a[j]); t2[2 * j] = bf_lo(c[j]); t2[2 * j + 1] = bf_hi(c[j]);
        cs[j] = c0[j]; cs[4 + j] = c1[j]; sn[j] = s0[j]; sn[4 + j] = s1[j]; }
#pragma unroll
      for (int j = 0; j < 8; ++j) { o1[j] = t1[j] * cs[j] - t2[j] * sn[j]; o2[j] = t2[j] * cs[j] + t1[j] * sn[j]; }
#pragma unroll
      for (int j = 0; j < 4; ++j) { lo[j] = pk_bf16(o1[2 * j], o1[2 * j + 1]); hi[j] = pk_bf16(o2[2 * j], o2[2 * j + 1]); }
    }
    *(u32x4*)(Ksm + kk * 72) = lo; *(u32x4*)(Ksm + kk * 72 + 8) = hi;
  }
  for (int e = tid; e < 192 * 6; e += 256) {
    const int kk = e / 6, ch = 2 + e % 6, pos = kp0 + kk;
    u32x4 v = (u32x4){0, 0, 0, 0};
    if (pos >= 0) v = *(const u32x4*)(h + (size_t)(b * SEQ + pos) * NC + C_SWK + kvh * 64 + ch * 8);
    *(u32x4*)(Ksm + kk * 72 + ch * 8) = v;
  }
  for (int e = tid; e < 192 * 8; e += 256) {
    const int kk = e >> 3, ch = e & 7, pos = kp0 + kk;
    u32x4 v = (u32x4){0, 0, 0, 0};
    if (pos >= 0) v = *(const u32x4*)(h + (size_t)(b * SEQ + pos) * NC + C_SWV + kvh * 64 + ch * 8);
#pragma unroll
    for (int j = 0; j < 4; ++j) { Vt[(ch * 8 + 2 * j) * 200 + kk] = (u16)(v[j] & 0xffffu); Vt[(ch * 8 + 2 * j + 1) * 200 + kk] = (u16)(v[j] >> 16); }
  }
  __syncthreads();
  const int st = wv, jt0 = st < 2 ? st : 2;
  const int qi = 16 * st + r16;
  const int qpos = 64 * qt + qi, tq = b * SEQ + qpos;
#pragma unroll 1
  for (int hq = 0; hq < 4; ++hq) {
    const int head = kvh * 4 + hq;
    u16* qsrc = h + (size_t)tq * NC + C_SWQ + head * 64;
    bf16x8 qf[2];
    {
      const u32x4 a = *(const u32x4*)qsrc, c = *(const u32x4*)(qsrc + 8);
      u32x4 w = *(const u32x4*)(qsrc + 8 * g);
      if (g < 2) {
        const f32x4 c0 = *(const f32x4*)(rc + qpos * 8), c1 = *(const f32x4*)(rc + qpos * 8 + 4);
        const f32x4 s0 = *(const f32x4*)(rs + qpos * 8), s1 = *(const f32x4*)(rs + qpos * 8 + 4);
        float t1[8], t2[8], cs[8], sn[8], o[8];
#pragma unroll
        for (int j = 0; j < 4; ++j) { t1[2 * j] = bf_lo(a[j]); t1[2 * j + 1] = bf_hi(a[j]); t2[2 * j] = bf_lo(c[j]); t2[2 * j + 1] = bf_hi(c[j]);
          cs[j] = c0[j]; cs[4 + j] = c1[j]; sn[j] = s0[j]; sn[4 + j] = s1[j]; }
#pragma unroll
        for (int j = 0; j < 8; ++j) o[j] = (g == 0) ? (t1[j] * cs[j] - t2[j] * sn[j]) : (t2[j] * cs[j] + t1[j] * sn[j]);
#pragma unroll
        for (int j = 0; j < 4; ++j) w[j] = pk_bf16(o[2 * j], o[2 * j + 1]);
      }
      qf[0] = as_bf8(w);
      qf[1] = as_bf8(*(const u32x4*)(qsrc + 32 + 8 * g));
    }
    f32x4 sc[10];
#pragma unroll
    for (int t = 0; t < 10; ++t) {
      sc[t] = (f32x4){0.f, 0.f, 0.f, 0.f};
#pragma unroll
      for (int s = 0; s < 2; ++s) {
        const bf16x8 kf = *(const bf16x8*)(Ksm + (16 * (jt0 + t) + r16) * 72 + 32 * s + 8 * g);
        sc[t] = mfma16(kf, qf[s], sc[t]);
      }
    }
    const float sink = p.sinks[head];
    float mx = sink;
#pragma unroll
    for (int t = 0; t < 10; ++t)
#pragma unroll
      for (int r = 0; r < 4; ++r) {
        const int kk = 16 * (jt0 + t) + 4 * g + r, d = kk - qi;
        const bool ok = (d >= 1) && (d <= 128) && (kp0 + kk >= 0);
        const float v = ok ? sc[t][r] * 0.125f : -1e30f;
        sc[t][r] = v; mx = fmaxf(mx, v);
      }
    mx = fmaxf(mx, shx(mx, 16, lane)); mx = fmaxf(mx, shx(mx, 32, lane));
    float sum = 0.f;
#pragma unroll
    for (int t = 0; t < 10; ++t)
#pragma unroll
      for (int r = 0; r < 4; ++r) { const float e = __expf(sc[t][r] - mx); sc[t][r] = e; sum += e; }
    sum += shx(sum, 16, lane); sum += shx(sum, 32, lane);
    const float inv = rcp_f(sum + __expf(sink - mx));
    f32x4 oacc[4];
#pragma unroll
    for (int dt = 0; dt < 4; ++dt) oacc[dt] = (f32x4){0.f, 0.f, 0.f, 0.f};
#pragma unroll
    for (int s2 = 0; s2 < 5; ++s2) {
      const bf16x8 pb = pack8(sc[2 * s2], sc[2 * s2 + 1]);
#pragma unroll
      for (int dt = 0; dt < 4; ++dt) {
        const u16* vr = Vt + (16 * dt + r16) * 200 + 16 * (jt0 + 2 * s2) + 4 * g;
        const u32x2 lo = *(const u32x2*)vr, hi = *(const u32x2*)(vr + 16);
        oacc[dt] = mfma16(as_bf8((u32x4){lo.x, lo.y, hi.x, hi.y}), pb, oacc[dt]);
      }
    }
#pragma unroll
    for (int dt = 0; dt < 4; ++dt) {
      const int dcol = head * 64 + 16 * dt + 4 * g;
      const u32x2 z = *(const u32x2*)(h + (size_t)tq * NC + C_SWZ + dcol);
      u32x2 w;
      w.x = pk_bf16(oacc[dt][0] * inv * silu_f(bf_lo(z.x)), oacc[dt][1] * inv * silu_f(bf_hi(z.x)));
      w.y = pk_bf16(oacc[dt][2] * inv * silu_f(bf_lo(z.y)), oacc[dt][3] * inv * silu_f(bf_hi(z.y)));
      *(u32x2*)(h + (size_t)tq * NC + C_SWQ + dcol) = w;
    }
  }
}

DI void phase_ya(const Params& p, int wvs) {
  u16* h = (u16*)(p.ws + OFF_H);
  const int ltid = opaque_tid(), lane = ltid & 63;
  const size_t gt = (size_t)blockIdx.x * 256 + ltid, gs = (size_t)gridDim.x * 256;
  const float* nwp = p.dn_norm_w + (ltid & 15) * 8;
  const f32x4 nw0 = *(const f32x4*)nwp, nw1 = *(const f32x4*)(nwp + 4);
  for (size_t i0 = gt; i0 < (size_t)T_TOK * 64; i0 += 4 * gs) {
    u32x4 v[4], z[4];
#pragma unroll
    for (int k = 0; k < 4; ++k) {
      const size_t i = i0 + k * gs;
      if (i < (size_t)T_TOK * 64) {
        const u16* ptr = h + (size_t)(i >> 6) * NC + (i & 63) * 8;
        v[k] = *(const u32x4*)ptr; z[k] = *(const u32x4*)(ptr + C_DNZ);
      } else { v[k] = (u32x4){0, 0, 0, 0}; z[k] = v[k]; }
    }
#pragma unroll
    for (int k = 0; k < 4; ++k) {
      const size_t i = i0 + k * gs;
      float o[8]; float ss = 0.f;
#pragma unroll
      for (int j = 0; j < 4; ++j) { o[2 * j] = bf_lo(v[k][j]); o[2 * j + 1] = bf_hi(v[k][j]); }
#pragma unroll
      for (int j = 0; j < 8; ++j) ss += o[j] * o[j];
      ss += shx(ss, 1, lane); ss += shx(ss, 2, lane); ss += shx(ss, 4, lane); ss += shx(ss, 8, lane);
      const float rs = rsqrtf(ss * (1.0f / 128.0f) + 1e-6f);
      float y[8];
#pragma unroll
      for (int j = 0; j < 4; ++j) {
        const float w0 = (j < 2) ? nw0[2 * j] : nw1[2 * j - 4], w1 = (j < 2) ? nw0[2 * j + 1] : nw1[2 * j - 3];
        y[2 * j] = o[2 * j] * rs * w0 * silu_f(bf_lo(z[k][j]));
        y[2 * j + 1] = o[2 * j + 1] * rs * w1 * silu_f(bf_hi(z[k][j]));
      }
      u32x4 w; w.x = pk_bf16(y[0], y[1]); w.y = pk_bf16(y[2], y[3]); w.z = pk_bf16(y[4], y[5]); w.w = pk_bf16(y[6], y[7]);
      if (i < (size_t)T_TOK * 64) *(u32x4*)(h + (size_t)(i >> 6) * NC + (i & 63) * 8) = w;
    }
  }
}

DI void phase4(const Params& p, int wvs, unsigned char* smem) {
  const int xcd = blockIdx.x & 7, lb = blockIdx.x >> 3, nlb = gridDim.x >> 3;
  const u16* h = (const u16*)(p.ws + OFF_H);
  const u16* wat = (const u16*)(p.ws + OFF_WAT);
  const u16* wbt = (const u16*)(p.ws + OFF_WBT);
  u16* mg = (u16*)(p.ws + OFF_SC);
  const int tid0 = opaque_tid(); const int lane = tid0 & 63, wv = tid0 >> 6, wm = wv >> 1, wn = wv & 1, r16 = lane & 15, g = lane >> 4;
  for (int li = lb;; li += nlb) {
    int mt, nt; if (!tile_of(li, 4, xcd, mt, nt)) break;
    f32x4 acc[4][8]; zero_acc(acc);
    gemm_kloop(p, wvs, h, NC, wat, 512, 16, mt * 128, nt * 256, acc, smem);
#pragma unroll
    for (int mi = 0; mi < 4; ++mi) {
      const int row = mt * 128 + wm * 64 + mi * 16 + r16;
#pragma unroll
      for (int ni = 0; ni < 8; ++ni) {
        const int col = nt * 256 + wn * 128 + ni * 16 + 4 * g;
        const u32x2 ga = *(const u32x2*)(h + (size_t)row * NC + C_GA + col), gb = *(const u32x2*)(h + (size_t)row * NC + C_GB + col);
        acc[mi][ni][0] *= (1.f + __expf(-bf_lo(gb.x))) * rcp_f(1.f + __expf(-bf_lo(ga.x)));
        acc[mi][ni][1] *= (1.f + __expf(-bf_hi(gb.x))) * rcp_f(1.f + __expf(-bf_hi(ga.x)));
        acc[mi][ni][2] *= (1.f + __expf(-bf_lo(gb.y))) * rcp_f(1.f + __expf(-bf_lo(ga.y)));
        acc[mi][ni][3] *= (1.f + __expf(-bf_hi(gb.y))) * rcp_f(1.f + __expf(-bf_hi(ga.y)));
      }
      if (mi & 1) __builtin_amdgcn_sched_barrier(0);
    }
    gemm_kloop(p, wvs, h + C_SWQ, NC, wbt, 512, 16, mt * 128, nt * 256, acc, smem);
#pragma unroll
    for (int mi = 0; mi < 4; ++mi) {
      const int row = mt * 128 + wm * 64 + mi * 16 + r16;
#pragma unroll
      for (int ni = 0; ni < 8; ++ni) {
        const int col = nt * 256 + wn * 128 + ni * 16 + 4 * g;
        const u32x2 gb = *(const u32x2*)(h + (size_t)row * NC + C_GB + col);
        u32x2 w;
        w.x = pk_bf16(acc[mi][ni][0] * sigmoid_f(bf_lo(gb.x)), acc[mi][ni][1] * sigmoid_f(bf_hi(gb.x)));
        w.y = pk_bf16(acc[mi][ni][2] * sigmoid_f(bf_lo(gb.y)), acc[mi][ni][3] * sigmoid_f(bf_hi(gb.y)));
        *(u32x2*)(mg + (size_t)row * 1024 + col) = w;
      }
      if (mi & 1) __builtin_amdgcn_sched_barrier(0);
    }
  }
}

DI void phase5(const Params& p, int wvs, unsigned char* smem) {
  const int xcd = blockIdx.x & 7, lb = blockIdx.x >> 3, nlb = gridDim.x >> 3;
  const u16* mg = (const u16*)(p.ws + OFF_SC);
  const u16* wot = (const u16*)(p.ws + OFF_WOT);
  const int tid0 = opaque_tid(); const int lane = tid0 & 63, wv = tid0 >> 6, wm = wv >> 1, wn = wv & 1, r16 = lane & 15, g = lane >> 4;
  for (int li = lb;; li += nlb) {
    int mt, nt; if (!tile_of(li, 4, xcd, mt, nt)) break;
    f32x4 acc[4][8]; zero_acc(acc);
    gemm_kloop(p, wvs, mg, 1024, wot, 1024, 32, mt * 128, nt * 256, acc, smem);
#pragma unroll
    for (int mi = 0; mi < 4; ++mi) {
      const int row = mt * 128 + wm * 64 + mi * 16 + r16;
#pragma unroll
      for (int ni = 0; ni < 8; ++ni) {
        const int col = nt * 256 + wn * 128 + ni * 16 + 4 * g;
        const f32x4 xv = *(const f32x4*)(p.x + (size_t)row * 1024 + col);
        *(f32x4*)(p.out + (size_t)row * 1024 + col) = xv * 1.189207115002721f + acc[mi][ni];
      }
    }
  }
}

DI float wave_sum(float v, int lane) {
#pragma unroll
  for (int o = 32; o > 0; o >>= 1) v += shx(v, o, lane);
  return v;
}
DI void phase6(const Params& p, int wvs, unsigned char* smem) {
  const int tid = opaque_tid(), lane = tid & 63, wv = tid >> 6;
  f32x4 gm[4], bt[4];
#pragma unroll
  for (int j = 0; j < 4; ++j) { gm[j] = *(const f32x4*)(p.ln_g + 4 * (lane + 64 * j)); bt[j] = *(const f32x4*)(p.ln_b + 4 * (lane + 64 * j)); }
  const int xcd6 = blockIdx.x & 7, lb6 = blockIdx.x >> 3, nlb6 = gridDim.x >> 3;
  for (int lr = (lb6 * 4 + wv) * 2; lr < 4096; lr += nlb6 * 8) {
    float* r0 = p.out + (size_t)(4096 * xcd6 + (4095 - lr)) * 1024;
    float* r1 = p.out + (size_t)(4096 * xcd6 + (4094 - lr)) * 1024;
    f32x4 a[4], b[4];
#pragma unroll
    for (int j = 0; j < 4; ++j) { a[j] = *(const f32x4*)(r0 + 4 * (lane + 64 * j)); b[j] = *(const f32x4*)(r1 + 4 * (lane + 64 * j)); }
    float sa = 0.f, sb = 0.f;
#pragma unroll
    for (int j = 0; j < 4; ++j) { sa += (a[j][0] + a[j][1]) + (a[j][2] + a[j][3]); sb += (b[j][0] + b[j][1]) + (b[j][2] + b[j][3]); }
    const float ma = wave_sum(sa, lane) * (1.0f / 1024.0f), mb = wave_sum(sb, lane) * (1.0f / 1024.0f);
    float qa = 0.f, qb = 0.f;
#pragma unroll
    for (int j = 0; j < 4; ++j) {
      a[j] = a[j] - ma; b[j] = b[j] - mb;
      qa += (a[j][0] * a[j][0] + a[j][1] * a[j][1]) + (a[j][2] * a[j][2] + a[j][3] * a[j][3]);
      qb += (b[j][0] * b[j][0] + b[j][1] * b[j][1]) + (b[j][2] * b[j][2] + b[j][3] * b[j][3]);
    }
    const float ra = rsqrtf(wave_sum(qa, lane) * (1.0f / 1024.0f) + 1e-5f), rb = rsqrtf(wave_sum(qb, lane) * (1.0f / 1024.0f) + 1e-5f);
#pragma unroll
    for (int j = 0; j < 4; ++j) {
      *(f32x4*)(r0 + 4 * (lane + 64 * j)) = a[j] * ra * gm[j] + bt[j];
      *(f32x4*)(r1 + 4 * (lane + 64 * j)) = b[j] * rb * gm[j] + bt[j];
    }
  }
}

#define XB_TMO      128
#define XB_XCNT(j)  (256  + 64 * (j))
#define XB_XSUB(j)  (1280 + 64 * (j))
#define XB_XGEN(j)  (2304 + 64 * (j))
#define XB_TOP      3328
#define XB_TOPGEN   3392
#define XCD_BAR_WORDS 3456
#define XB_SPIN_CAP (1u << 22)
#define LAS __attribute__((address_space(3)))
DI unsigned xb_ld(unsigned* p) { return __hip_atomic_load(p, __ATOMIC_RELAXED, __HIP_MEMORY_SCOPE_AGENT); }
DI unsigned xb_add(unsigned* p, unsigned v) { return __hip_atomic_fetch_add(p, v, __ATOMIC_RELAXED, __HIP_MEMORY_SCOPE_AGENT); }
DI unsigned xb_xcc_id() { return (unsigned)__builtin_amdgcn_s_getreg((3 << 11) | 20) & 0xFu; }
#define XB_SPIN(cond, bar) do { unsigned _sp = 0; while (cond) { __builtin_amdgcn_s_sleep(1); \
    if ((++_sp & 255u) == 0u) { if (xb_ld(&(bar)[XB_TMO])) break; if (_sp > XB_SPIN_CAP) { atomicAdd(&(bar)[XB_TMO], 1u); break; } } } } while (0)
struct XcdBarrier { unsigned* bar; unsigned x; volatile LAS unsigned* st; };
DI bool xb_leader(int wvs) { return wvs == 0 && __builtin_amdgcn_mbcnt_hi(~0u, __builtin_amdgcn_mbcnt_lo(~0u, 0u)) == 0u; }
DI XcdBarrier xcd_barrier_post(unsigned* bar, volatile LAS unsigned* st, int wvs) {
  XcdBarrier b; b.bar = bar; b.x = xb_xcc_id(); b.st = st;
  if (xb_leader(wvs)) (void)xb_add(&bar[XB_XCNT(b.x)], 1u);
  return b;
}
DI void xcd_barrier_complete(unsigned* bar, unsigned x, unsigned& nloc, unsigned& nx) {
  const unsigned G = gridDim.x * gridDim.y * gridDim.z;
  unsigned sum, cnt, mine, sp = 0u;
  for (;;) {
    sum = 0u; cnt = 0u; mine = 0u;
#pragma unroll
    for (unsigned j = 0; j < 16; ++j) { const unsigned c = xb_ld(&bar[XB_XCNT(j)]); sum += c; cnt += (c > 0u) ? 1u : 0u; mine = (j == x) ? c : mine; }
    if (sum == G) break;
    __builtin_amdgcn_s_sleep(1);
    if ((++sp & 255u) == 0u) { if (xb_ld(&bar[XB_TMO])) break; if (sp > XB_SPIN_CAP) { atomicAdd(&bar[XB_TMO], 1u); break; } }
  }
  nloc = mine > 0u ? mine : 1u; nx = cnt > 0u ? cnt : 1u;
}
DI void xcd_barrier_(const XcdBarrier& b, int wvs) {
  asm volatile("s_waitcnt vmcnt(0)" ::: "memory");
  __syncthreads();
  if (xb_leader(wvs)) {
    unsigned* bar = b.bar;
    __builtin_amdgcn_s_waitcnt(0);
    unsigned nloc = b.st[0], nx = b.st[1];
    if (nloc == 0u) { xcd_barrier_complete(bar, b.x, nloc, nx); b.st[0] = nloc; b.st[1] = nx; }
    const unsigned old = xb_add(&bar[XB_XSUB(b.x)], 1u);
    const unsigned gen = old / nloc;
    if (old + 1u == (gen + 1u) * nloc) {
      __builtin_amdgcn_fence(__ATOMIC_RELEASE, "agent");
      asm volatile("s_waitcnt vmcnt(0)" ::: "memory");
      const unsigned og = xb_add(&bar[XB_TOP], 1u);
      const unsigned tg = og / nx;
      if (og + 1u == (tg + 1u) * nx) xb_add(&bar[XB_TOPGEN], 1u);
      else XB_SPIN(xb_ld(&bar[XB_TOPGEN]) == tg, bar);
      __builtin_amdgcn_fence(__ATOMIC_ACQUIRE, "agent");
      xb_add(&bar[XB_XGEN(b.x)], 1u);
      asm volatile("s_waitcnt vmcnt(0)" ::: "memory");
    } else {
      XB_SPIN(xb_ld(&bar[XB_XGEN(b.x)]) == gen, bar);
      __builtin_amdgcn_fence(__ATOMIC_ACQUIRE, "agent");
      asm volatile("s_waitcnt vmcnt(0)" ::: "memory");
    }
  }
  __syncthreads();
}

#define xcd_barrier(b) xcd_barrier_(b, wvs)
#ifndef MK_MULTI
#define MK_MULTI 0
#endif
#define SMEM_DECL __shared__ __attribute__((aligned(16))) unsigned char smem[SMEM_BYTES]; const int wvs = __builtin_amdgcn_readfirstlane((int)(threadIdx.x >> 6));
#if MK_MULTI
__global__ void __launch_bounds__(256, 2) k_p0(Params p) { SMEM_DECL (void)smem; phase0(p, wvs); }
__global__ void __launch_bounds__(256, 2) k_p1(Params p) { SMEM_DECL phase1(p, wvs, smem); }
__global__ void __launch_bounds__(256, 2) k_p2(Params p) { SMEM_DECL for (int it = blockIdx.x; it < 2048; it += gridDim.x) prep_item(p, wvs, it, smem); }
__global__ void __launch_bounds__(256, 2) k_p3(Params p) { SMEM_DECL
  if (blockIdx.x < 128) scan_chain(p, wvs, blockIdx.x, smem);
  else for (int it = blockIdx.x - 128; it < 1024; it += gridDim.x - 128) swa_item(p, wvs, it, smem); }
__global__ void __launch_bounds__(256, 2) k_p3b(Params p) { SMEM_DECL (void)smem; phase_ya(p, wvs); }
__global__ void __launch_bounds__(256, 2) k_p4(Params p) { SMEM_DECL phase4(p, wvs, smem); }
__global__ void __launch_bounds__(256, 2) k_p5(Params p) { SMEM_DECL phase5(p, wvs, smem); }
__global__ void __launch_bounds__(256, 2) k_p6(Params p) { SMEM_DECL phase6(p, wvs, smem); }
#else
__global__ void __launch_bounds__(256, 2) fwd_megakernel(Params p) {
  cg::grid_group grid = cg::this_grid();
  SMEM_DECL
  volatile LAS unsigned* st = (volatile LAS unsigned*)(smem + SMEM_BYTES - 16);
  { const int t0_ = opaque_tid(); if (t0_ < 4) st[t0_] = 0u; }
  __syncthreads();
  const XcdBarrier xb = xcd_barrier_post((unsigned*)(p.ws + OFF_BAR), st, wvs);
  phase0(p, wvs);
  if (p.ws == nullptr) grid.sync();
  xcd_barrier(xb);
  phase1(p, wvs, smem);
  xcd_barrier(xb);
  for (int it = blockIdx.x; it < 2048; it += gridDim.x) prep_item(p, wvs, it, smem);
  xcd_barrier(xb);
  if (blockIdx.x < 128) scan_chain(p, wvs, blockIdx.x, smem);
  else for (int it = blockIdx.x - 128; it < 1024; it += gridDim.x - 128) swa_item(p, wvs, it, smem);
  xcd_barrier(xb);
  phase_ya(p, wvs);
  xcd_barrier(xb);
  phase4(p, wvs, smem);
  xcd_barrier(xb);
  phase5(p, wvs, smem);
  xcd_barrier(xb);
  phase6(p, wvs, smem);
}
#endif

extern "C" void kernel_launch(void* const* d_in, const int* in_sizes, int n_in, void* d_out, int out_size,
                              void* d_ws, size_t ws_size, hipStream_t stream) {
  if (ws_size < WS_NEED) { fprintf(stderr, "workspace too small: %zu < %zu\n", ws_size, (size_t)WS_NEED); return; }
  Params p{};
  p.x = (const float*)d_in[0]; p.w_in = (const float*)d_in[1]; p.conv_w = (const float*)d_in[2]; p.a_log = (const float*)d_in[3];
  p.dt_bias = (const float*)d_in[4]; p.dn_norm_w = (const float*)d_in[5]; p.sinks = (const float*)d_in[6];
  p.w_branch = (const float*)d_in[7]; p.w_out = (const float*)d_in[8]; p.ln_g = (const float*)d_in[9]; p.ln_b = (const float*)d_in[10];
  p.out = (float*)d_out; p.ws = (unsigned char*)d_ws;
  for (int i = 0; i < 8; ++i) p.inv_freq[i] = (float)std::pow(500000.0, -(double)i / 8.0);
#if MK_MULTI
  const dim3 g(512), b(256);
  k_p0<<<g, b, 0, stream>>>(p);
  k_p1<<<g, b, 0, stream>>>(p);
  k_p2<<<g, b, 0, stream>>>(p);
  k_p3<<<g, b, 0, stream>>>(p);
  k_p3b<<<g, b, 0, stream>>>(p);
  k_p4<<<g, b, 0, stream>>>(p);
  k_p5<<<g, b, 0, stream>>>(p);
  k_p6<<<g, b, 0, stream>>>(p);
#else
  static int grid_blocks = 0;
  if (!grid_blocks) {
    int dev = 0, cus = 0, per_cu = 0;
    (void)hipGetDevice(&dev);
    (void)hipDeviceGetAttribute(&cus, hipDeviceAttributeMultiprocessorCount, dev);
    (void)hipOccupancyMaxActiveBlocksPerMultiprocessor(&per_cu, fwd_megakernel, 256, 0);
    if (per_cu > 2) per_cu = 2;
    if (per_cu < 1) per_cu = 1;
    grid_blocks = cus * per_cu;
    grid_blocks &= ~7;
  }
  (void)hipMemsetAsync(p.ws + OFF_BAR, 0, BAR_BYTES, stream);
  void* args[] = {&p};
  hipError_t e = hipLaunchCooperativeKernel((void*)fwd_megakernel, dim3(grid_blocks), dim3(256), args, 0, stream);
  if (e != hipSuccess) fprintf(stderr, "cooperative launch failed: %s (grid %d)\n", hipGetErrorString(e), grid_blocks);
#endif
}
```

```cpp
#include <hip/hip_runtime.h>
#include <hip/hip_cooperative_groups.h>
#include <cstdio>
#include <cmath>
namespace cg = cooperative_groups;

typedef unsigned short u16;
typedef short bf16x8 __attribute__((ext_vector_type(8)));
typedef float f32x4 __attribute__((ext_vector_type(4)));
typedef unsigned u32x4 __attribute__((ext_vector_type(4)));
typedef unsigned u32x2 __attribute__((ext_vector_type(2)));
#define DI __device__ __forceinline__
DI int opaque_tid_(int wave_s) { int t; asm volatile("v_mbcnt_lo_u32_b32 %0, -1, 0\n\tv_mbcnt_hi_u32_b32 %0, -1, %0" : "=v"(t)); return t + (wave_s << 6); }
#define opaque_tid() opaque_tid_(wvs)

constexpr int T_TOK = 32768, SEQ = 8192, DM = 1024, NC = 5384, NCP = 5376;
constexpr int C_DNZ = 1536, C_SWQ = 2056, C_SWK = 2568, C_SWV = 2696, C_SWZ = 2824, C_GA = 3336, C_GB = 4360;
constexpr size_t OFF_BAR = 0;
constexpr size_t BAR_BYTES = 16384;
constexpr size_t OFF_WINT = BAR_BYTES;
constexpr size_t OFF_WAT = OFF_WINT + (size_t)NCP * 1024 * 2;
constexpr size_t OFF_WBT = OFF_WAT + 1024 * 512 * 2;
constexpr size_t OFF_WOT = OFF_WBT + 1024 * 512 * 2;
constexpr size_t OFF_ROPE = OFF_WOT + 1024 * 1024 * 2;
constexpr size_t OFF_HB = OFF_ROPE + 2 * 8192 * 8 * 4;
constexpr size_t OFF_DEC = OFF_HB + (size_t)T_TOK * 8 * 4;
constexpr size_t OFF_H = OFF_DEC + 2048 * 4;
constexpr size_t OFF_SC = OFF_H + (size_t)T_TOK * NC * 2;
constexpr size_t OPB = 73728;
constexpr size_t WS_NEED = OFF_SC + 2048 * OPB;
constexpr int HALF_SMEM = 73728;
constexpr int SMEM_BYTES = 2 * HALF_SMEM + 16;

struct Params {
  const float *x, *w_in, *conv_w, *a_log, *dt_bias, *dn_norm_w, *sinks, *w_branch, *w_out, *ln_g, *ln_b;
  float* out; unsigned char* ws;
  float inv_freq[8];
};

typedef __bf16 bf16x2_t __attribute__((ext_vector_type(2)));
typedef float f32x2_t __attribute__((ext_vector_type(2)));
DI unsigned pk_bf16(float lo, float hi) { f32x2_t f = {lo, hi}; bf16x2_t v = __builtin_convertvector(f, bf16x2_t); return __builtin_bit_cast(unsigned, v); }
DI float bf_lo(unsigned u) { return __uint_as_float(u << 16); }
DI float bf_hi(unsigned u) { return __uint_as_float(u & 0xffff0000u); }
DI float bf2f(u16 v) { return __uint_as_float(((unsigned)v) << 16); }
DI u16 f2bf(float f) { return (u16)(pk_bf16(f, f) & 0xffffu); }
DI float shx(float v, int m, int lane) { return __uint_as_float((unsigned)__builtin_amdgcn_ds_bpermute((lane ^ m) << 2, (int)__float_as_uint(v))); }
DI float rcp_f(float y) { return __builtin_amdgcn_rcpf(y); }
DI float silu_f(float y) { return y * rcp_f(1.0f + __expf(-y)); }
DI float sigmoid_f(float y) { return rcp_f(1.0f + __expf(-y)); }
DI f32x4 mfma16(bf16x8 a, bf16x8 b, f32x4 c) { return __builtin_amdgcn_mfma_f32_16x16x32_bf16(a, b, c, 0, 0, 0); }
DI bf16x8 as_bf8(u32x4 v) { return __builtin_bit_cast(bf16x8, v); }
DI bf16x8 pack8(f32x4 a, f32x4 b) { u32x4 w; w.x = pk_bf16(a[0], a[1]); w.y = pk_bf16(a[2], a[3]); w.z = pk_bf16(b[0], b[1]); w.w = pk_bf16(b[2], b[3]); return as_bf8(w); }

DI void phase0(const Params& p, int wvs) {
  const size_t gt = (size_t)blockIdx.x * 512 + opaque_tid(), gs = (size_t)gridDim.x * 512;
  {
    const int ltid = (int)(gt & 511), lane = ltid & 63, wv = ltid >> 6;
    float wr[16][8];
#pragma unroll
    for (int j = 0; j < 4; ++j)
#pragma unroll
      for (int c = 0; c < 4; ++c) {
        const float* wp = p.w_in + (size_t)(4 * (lane + 64 * j) + c) * NC + 2048;
        const f32x4 a = *(const f32x4*)wp, b = *(const f32x4*)(wp + 4);
#pragma unroll
        for (int q = 0; q < 4; ++q) { wr[4 * j + c][q] = a[q]; wr[4 * j + c][4 + q] = b[q]; }
      }
    u16* xb = (u16*)(p.ws + OFF_SC);
    float* hb = (float*)(p.ws + OFF_HB);
    const int rstep = gridDim.x * 8;
    for (int row0 = blockIdx.x * 8 + wv; row0 < T_TOK; row0 += 2 * rstep) {
      f32x4 xr[2][4];
#pragma unroll
      for (int u = 0; u < 2; ++u) {
        const int row = row0 + u * rstep;
#pragma unroll
        for (int j = 0; j < 4; ++j) xr[u][j] = (row < T_TOK) ? *(const f32x4*)(p.x + (size_t)row * DM + 4 * (lane + 64 * j)) : (f32x4){0.f, 0.f, 0.f, 0.f};
      }
#pragma unroll
      for (int u = 0; u < 2; ++u) {
        const int row = row0 + u * rstep;
        float v[8];
#pragma unroll
        for (int q = 0; q < 8; ++q) v[q] = 0.f;
#pragma unroll
        for (int j = 0; j < 4; ++j) {
          const f32x4 xv = xr[u][j];
          u32x2 w; w.x = pk_bf16(xv[0], xv[1]); w.y = pk_bf16(xv[2], xv[3]);
          if (row < T_TOK) *(u32x2*)(xb + (size_t)row * DM + 4 * (lane + 64 * j)) = w;
#pragma unroll
          for (int c = 0; c < 4; ++c)
#pragma unroll
            for (int q = 0; q < 8; ++q) v[q] += xv[c] * wr[4 * j + c][q];
        }
        const bool up = (lane & 32) != 0;
        float k4[4];
#pragma unroll
        for (int i = 0; i < 4; ++i) { const float snd = up ? v[i] : v[i + 4]; const float kp = up ? v[i + 4] : v[i]; k4[i] = kp + shx(snd, 32, lane); }
        const bool up2 = (lane & 16) != 0;
        float k2[2];
#pragma unroll
        for (int i = 0; i < 2; ++i) { const float snd = up2 ? k4[i] : k4[i + 2]; const float kp = up2 ? k4[i + 2] : k4[i]; k2[i] = kp + shx(snd, 16, lane); }
        const bool up3 = (lane & 8) != 0;
        float k1 = (up3 ? k2[1] : k2[0]) + shx(up3 ? k2[0] : k2[1], 8, lane);
        k1 += shx(k1, 4, lane); k1 += shx(k1, 2, lane); k1 += shx(k1, 1, lane);
        if ((lane & 7) == 0 && row < T_TOK) hb[(size_t)row * 8 + (lane >> 3)] = k1;
      }
    }
  }
  {
    u32x4* wt = (u32x4*)(p.ws + OFF_WINT);
    for (size_t i = gt; i < (size_t)NCP * 128; i += gs) {
      const int kc = (int)(i / NCP), n = (int)(i % NCP);
      float v[8];
#pragma unroll
      for (int j = 0; j < 8; ++j) v[j] = p.w_in[(size_t)(kc * 8 + j) * NC + n + (n >= 2048 ? 8 : 0)];
      u32x4 w; w.x = pk_bf16(v[0], v[1]); w.y = pk_bf16(v[2], v[3]); w.z = pk_bf16(v[4], v[5]); w.w = pk_bf16(v[6], v[7]);
      wt[(size_t)n * 128 + kc] = w;
    }
  }
  {
    for (size_t i = gt; i < (size_t)2 * 1024 * 64; i += gs) {
      const int br = (int)(i / (1024 * 64)), rem = (int)(i % (1024 * 64)), kc = rem / 1024, n = rem % 1024;
      const float* src = p.w_branch + (size_t)br * 512 * 1024;
      float v[8];
#pragma unroll
      for (int j = 0; j < 8; ++j) v[j] = src[(size_t)(kc * 8 + j) * 1024 + n];
      u32x4 w; w.x = pk_bf16(v[0], v[1]); w.y = pk_bf16(v[2], v[3]); w.z = pk_bf16(v[4], v[5]); w.w = pk_bf16(v[6], v[7]);
      ((u32x4*)(p.ws + (br ? OFF_WBT : OFF_WAT)))[(size_t)n * 64 + kc] = w;
    }
  }
  {
    for (size_t i = gt; i < (size_t)1024 * 128; i += gs) {
      const int kc = (int)(i / 1024), n = (int)(i % 1024);
      float v[8];
#pragma unroll
      for (int j = 0; j < 8; ++j) v[j] = p.w_out[(size_t)(kc * 8 + j) * 1024 + n];
      u32x4 w; w.x = pk_bf16(v[0], v[1]); w.y = pk_bf16(v[2], v[3]); w.z = pk_bf16(v[4], v[5]); w.w = pk_bf16(v[6], v[7]);
      ((u32x4*)(p.ws + OFF_WOT))[(size_t)n * 128 + kc] = w;
    }
  }
  {
    float* rc = (float*)(p.ws + OFF_ROPE); float* rs = rc + 8192 * 8;
    for (size_t i = gt; i < 8192 * 8; i += gs) {
      const int t = (int)(i >> 3), f = (int)(i & 7);
      const float ang = (float)t * p.inv_freq[f];
      const double a = (double)ang;
      const double k = __builtin_rint(a * 0.15915494309189535);
      const float r = (float)(a - k * 6.283185307179586);
      rc[i] = cosf(r); rs[i] = sinf(r);
    }
  }
}

DI int lds_off32(int row, int chunk) { return row * 64 + ((chunk ^ ((0 - (row >> 2)) & 3)) << 4); }
constexpr int GSTAGE = 24576;

DI void gemm_kloop(const Params& p, int wvs, const u16* __restrict__ A, int lda, const u16* __restrict__ Bt, int ldb, int nk, int m0, int n0,
                   f32x4 (&acc)[4][8], unsigned char* smem) {
  const int tid = opaque_tid(), lane = tid & 63, wv = tid >> 6, wm = wv >> 1, wn = wv & 1, r16 = lane & 15, g = lane >> 4;
  const int prow = lane >> 2, pc = (lane & 3) ^ ((0 - (prow >> 2)) & 3);
  const u16* ap = A + (size_t)(m0 + 16 * wv + prow) * lda + pc * 8;
  const u16* bp = Bt + (size_t)(n0 + 16 * wv + prow) * ldb + pc * 8;
  unsigned char* lA = smem + wv * 1024;
  unsigned char* lB = smem + 8192 + wv * 1024;
#define GEMM_ISSUE(kt_, buf_) do { \
    _Pragma("unroll") for (int i_ = 0; i_ < 2; ++i_) \
      __builtin_amdgcn_global_load_lds((const unsigned*)(ap + (size_t)(64 * i_) * lda + (kt_) * 32), (unsigned*)(lA + (buf_) * GSTAGE + i_ * 4096), 16, 0, 0); \
    _Pragma("unroll") for (int i_ = 0; i_ < 4; ++i_) \
      __builtin_amdgcn_global_load_lds((const unsigned*)(bp + (size_t)(64 * i_) * ldb + (kt_) * 32), (unsigned*)(lB + (buf_) * GSTAGE + i_ * 4096), 16, 0, 0); \
  } while (0)
  GEMM_ISSUE(0, 0);
  GEMM_ISSUE(1, 1);
  asm volatile("s_waitcnt vmcnt(6)" ::: "memory");
  __builtin_amdgcn_s_barrier();
  int cb = 0;
  for (int kt = 0; kt < nk; ++kt) {
    int ib = cb + 2; if (ib >= 3) ib -= 3;
    const bool more = (kt + 2 < nk);
    if (more) GEMM_ISSUE(kt + 2, ib);
    const unsigned char* cur = smem + cb * GSTAGE;
    bf16x8 af[4], bfr[8];
#pragma unroll
    for (int i = 0; i < 4; ++i) af[i] = *(const bf16x8*)(cur + lds_off32(wm * 64 + i * 16 + r16, g));
#pragma unroll
    for (int i = 0; i < 8; ++i) bfr[i] = *(const bf16x8*)(cur + 8192 + lds_off32(wn * 128 + i * 16 + r16, g));
#pragma unroll
    for (int mi = 0; mi < 4; ++mi)
#pragma unroll
      for (int ni = 0; ni < 8; ++ni) acc[mi][ni] = mfma16(bfr[ni], af[mi], acc[mi][ni]);
    if (more) asm volatile("s_waitcnt vmcnt(6)" ::: "memory"); else asm volatile("s_waitcnt vmcnt(0)" ::: "memory");
    asm volatile("s_waitcnt lgkmcnt(0)" ::: "memory");
    __builtin_amdgcn_s_barrier();
    cb = cb + 1; if (cb >= 3) cb = 0;
  }
#undef GEMM_ISSUE
}

DI bool tile_of(int li, int ntn, int xcd, int& mt, int& nt) {
  if (li >= 32 * ntn) return false;
  const int grp = li / (8 * ntn), rem = li % (8 * ntn);
  nt = rem >> 3; mt = 32 * xcd + grp * 8 + (rem & 7);
  return true;
}

DI void zero_acc(f32x4 (&acc)[4][8]) {
#pragma unroll
  for (int i = 0; i < 4; ++i)
#pragma unroll
    for (int j = 0; j < 8; ++j) acc[i][j] = (f32x4){0.f, 0.f, 0.f, 0.f};
}

DI void phase1(const Params& p, int wvs, unsigned char* smem) {
  const int xcd = blockIdx.x & 7, lb = blockIdx.x >> 3, nlb = gridDim.x >> 3;
  const u16* xb = (const u16*)(p.ws + OFF_SC);
  const u16* wint = (const u16*)(p.ws + OFF_WINT);
  u16* h = (u16*)(p.ws + OFF_H);
  float* hb = (float*)(p.ws + OFF_HB);
  const int tid0 = opaque_tid(); const int lane = tid0 & 63, wv = tid0 >> 6, wm = wv >> 1, wn = wv & 1, r16 = lane & 15, g = lane >> 4;
  for (int li = lb;; li += nlb) {
    int mt, nt; if (!tile_of(li, 21, xcd, mt, nt)) break;
    f32x4 acc[4][8]; zero_acc(acc);
    gemm_kloop(p, wvs, xb, 1024, wint, 1024, 32, mt * 128, nt * 256, acc, smem);
#pragma unroll
    for (int mi = 0; mi < 4; ++mi) {
      const int row = mt * 128 + wm * 64 + mi * 16 + r16;
#pragma unroll
      for (int ni = 0; ni < 8; ++ni) {
        const int col = nt * 256 + wn * 128 + ni * 16 + 4 * g;
        {
          u32x2 w; w.x = pk_bf16(acc[mi][ni][0], acc[mi][ni][1]); w.y = pk_bf16(acc[mi][ni][2], acc[mi][ni][3]);
          *(u32x2*)(h + (size_t)row * NC + col + (nt >= 8 ? 8 : 0)) = w;
        }
      }
    }
  }
}

template <int I> DI void solve_rows2(f32x2_t (&xv)[64], const float* Lm, int lane, float lcur) {
  if constexpr (I < 64) {
    float lnx = 0.f;
    if constexpr (I + 1 < 64) lnx = Lm[(I + 1) * 68 + lane];
    f32x2_t a0 = xv[I], a1 = {0.f, 0.f}, a2 = {0.f, 0.f}, a3 = {0.f, 0.f};
#pragma unroll
    for (int m = 0; m < I; ++m) {
      const float l = __builtin_bit_cast(float, __builtin_amdgcn_readlane(__builtin_bit_cast(int, lcur), m));
      const f32x2_t lv = {l, l};
      if ((m & 3) == 0) a0 -= lv * xv[m];
      else if ((m & 3) == 1) a1 -= lv * xv[m];
      else if ((m & 3) == 2) a2 -= lv * xv[m];
      else a3 -= lv * xv[m];
    }
    xv[I] = (a0 + a1) + (a2 + a3);
    solve_rows2<I + 1>(xv, Lm, lane, lnx);
  }
}

DI void prep_item(const Params& p, int wvs, int item, unsigned char* smem) {
  const int tid_ = opaque_tid();
  const int tid = tid_, lane = tid & 63, wv = tid >> 6, r16 = lane & 15, g = lane >> 4;
  const int hd = item & 3, n = (item >> 2) & 127, b = item >> 9;
  const int t0 = b * SEQ + n * 64;
  u16* Qs = (u16*)smem; u16* Ks = Qs + 64 * 136; u16* Vs = Ks + 64 * 136;
  float* Lm = (float*)(smem + 52224);
  float* sm_beta = (float*)(smem + 69632);
  float* sm_gc = sm_beta + 64; float* sm_rq = sm_gc + 64; float* sm_rk = sm_rq + 64;
  float* sm_fw = sm_rk + 64; float* sm_fq = sm_fw + 64; float* sm_fk = sm_fq + 64;
  const u16* h = (const u16*)(p.ws + OFF_H);
  const float* hb = (const float*)(p.ws + OFF_HB);
  unsigned char* op = p.ws + OFF_SC + (size_t)item * OPB;
  __syncthreads();
  {
    const int c2 = tid & 63, rbase = (tid >> 6) * 16;
    unsigned raw[3][19];
#pragma unroll
    for (int mat = 0; mat < 3; ++mat) {
      const int col = mat * 512 + hd * 128 + 2 * c2;
#pragma unroll
      for (int j = 0; j < 19; ++j) {
        const int rr = t0 + rbase - 3 + j;
        raw[mat][j] = *(const unsigned*)(h + (size_t)(rr < 0 ? 0 : rr) * NC + col);
      }
    }
    __builtin_amdgcn_sched_barrier(0);
#pragma unroll
    for (int mat = 0; mat < 3; ++mat) {
      const int col = mat * 512 + hd * 128 + 2 * c2;
      float wa[4], wb[4];
#pragma unroll
      for (int j = 0; j < 4; ++j) { wa[j] = p.conv_w[j * 1536 + col]; wb[j] = p.conv_w[j * 1536 + col + 1]; }
      float xa[3], xb[3];
#pragma unroll
      for (int j = 0; j < 3; ++j) {
        const int pos = n * 64 + rbase - 3 + j;
        const unsigned v = (pos >= 0) ? raw[mat][j] : 0u;
        xa[j] = bf_lo(v); xb[j] = bf_hi(v);
      }
      u16* dst = (mat == 0 ? Qs : (mat == 1 ? Ks : Vs));
#pragma unroll
      for (int i = 0; i < 16; ++i) {
        const unsigned v = raw[mat][3 + i];
        const float a3 = bf_lo(v), b3 = bf_hi(v);
        const float ya = wa[0] * xa[0] + wa[1] * xa[1] + wa[2] * xa[2] + wa[3] * a3;
        const float yb = wb[0] * xb[0] + wb[1] * xb[1] + wb[2] * xb[2] + wb[3] * b3;
        xa[0] = xa[1]; xa[1] = xa[2]; xa[2] = a3; xb[0] = xb[1]; xb[1] = xb[2]; xb[2] = b3;
        *(unsigned*)(dst + (rbase + i) * 136 + 2 * c2) = pk_bf16(silu_f(ya), silu_f(yb));
      }
    }
  }
  __syncthreads();
  if (wv == 0) {
    const int row = t0 + lane;
    const float bl = hb[(size_t)row * 8 + hd], al = hb[(size_t)row * 8 + 4 + hd];
    const float xx = al + p.dt_bias[hd];
    const float ee = __expf(-fabsf(xx));
    const float sp = fmaxf(xx, 0.f) + ((ee < 1e-3f) ? ee * (1.f - 0.5f * ee) : __logf(1.f + ee));
    float gg = -__expf(p.a_log[hd]) * sp;
#pragma unroll
    for (int o = 1; o < 64; o <<= 1) { const float t = __uint_as_float((unsigned)__builtin_amdgcn_ds_bpermute(((lane - o) & 63) << 2, (int)__float_as_uint(gg))); if (lane >= o) gg += t; }
    sm_beta[lane] = rcp_f(1.0f + __expf(-bl)); sm_gc[lane] = gg;
  } else if (wv <= 2) {
    const int r = tid - 64;
    const u16* src = (r < 64) ? (Qs + r * 136) : (Ks + (r - 64) * 136);
    float ss = 0.f;
#pragma unroll
    for (int c = 0; c < 16; ++c) {
      const u32x4 v = *(const u32x4*)(src + c * 8);
#pragma unroll
      for (int j = 0; j < 4; ++j) { const float a = bf_lo(v[j]), bb = bf_hi(v[j]); ss += a * a + bb * bb; }
    }
    const float rs = rsqrtf(ss + 1e-6f);
    if (r < 64) sm_rq[r] = rs; else sm_rk[r - 64] = rs;
  }
  __syncthreads();
  if (tid < 64) {
    const float gc = sm_gc[tid], gl = sm_gc[63], eg = __expf(gc);
    sm_fw[tid] = sm_beta[tid] * eg * sm_rk[tid];
    sm_fq[tid] = sm_rq[tid] * 0.08838834764831845f * eg;
    sm_fk[tid] = sm_rk[tid] * __expf(gl - gc);
    if (tid == 0) ((float*)(p.ws + OFF_DEC))[item] = __expf(gl);
  }
  {
    bf16x8 kfi[4], qfi[4];
#pragma unroll
    for (int s = 0; s < 4; ++s) {
      kfi[s] = *(const bf16x8*)(Ks + (16 * wv + r16) * 136 + 32 * s + 8 * g);
      qfi[s] = *(const bf16x8*)(Qs + (16 * wv + r16) * 136 + 32 * s + 8 * g);
    }
    f32x4 at[4];
#pragma unroll
    for (int jt = 0; jt < 4; ++jt) {
      at[jt] = (f32x4){0.f, 0.f, 0.f, 0.f};
      if (jt <= wv) {
        f32x4 la = (f32x4){0.f, 0.f, 0.f, 0.f}, aa = (f32x4){0.f, 0.f, 0.f, 0.f};
#pragma unroll
        for (int s = 0; s < 4; ++s) {
          const bf16x8 kfj = *(const bf16x8*)(Ks + (16 * jt + r16) * 136 + 32 * s + 8 * g);
          la = mfma16(kfi[s], kfj, la);
          aa = mfma16(kfj, qfi[s], aa);
        }
#pragma unroll
        for (int r = 0; r < 4; ++r) {
          { const int i = 16 * wv + 4 * g + r, j = 16 * jt + r16;
            const float v = (i > j) ? sm_beta[i] * sm_rk[i] * sm_rk[j] * __expf(sm_gc[i] - sm_gc[j]) * la[r] : 0.f;
            Lm[i * 68 + j] = v; }
          { const int j = 16 * jt + 4 * g + r, i = 16 * wv + r16;
            at[jt][r] = (j <= i) ? sm_rq[i] * sm_rk[j] * 0.08838834764831845f * __expf(sm_gc[i] - sm_gc[j]) * aa[r] : 0.f; }
        }
      }
    }
#pragma unroll
    for (int s2 = 0; s2 < 2; ++s2)
      *(bf16x8*)(op + 32768 + (size_t)((wv * 2 + s2) * 64 + lane) * 16) = pack8(at[2 * s2], at[2 * s2 + 1]);
  }
  __syncthreads();
  f32x2_t xv[64];
  if (wv < 2) {
#pragma unroll
    for (int i = 0; i < 64; ++i) { xv[i].x = sm_beta[i] * bf2f(Vs[i * 136 + tid]); xv[i].y = sm_fw[i] * bf2f(Ks[i * 136 + tid]); }
    solve_rows2<1>(xv, Lm, lane, Lm[68 + lane]);
    const int sl = tid >> 4, dvl = tid & 15;
#pragma unroll
    for (int mt = 0; mt < 4; ++mt)
#pragma unroll
      for (int gg = 0; gg < 4; ++gg) {
        u32x2 w; w.x = pk_bf16(xv[16 * mt + 4 * gg].x, xv[16 * mt + 4 * gg + 1].x); w.y = pk_bf16(xv[16 * mt + 4 * gg + 2].x, xv[16 * mt + 4 * gg + 3].x);
        *(u32x2*)(op + 57344 + (size_t)((sl * 4 + mt) * 64 + gg * 16 + dvl) * 8) = w;
      }
  } else {
    const int t2 = tid - 128;
#pragma unroll 2
    for (int f = 0; f < 8; ++f) {
      const int e = t2 + 128 * f, frag = e >> 6, ln = e & 63, lr = ln & 15, lg = ln >> 4;
      {
        const int mt = frag >> 2, sx = frag & 3, row = 16 * mt + lr;
        const u32x2 ql = *(const u32x2*)(Qs + row * 136 + 32 * sx + 4 * lg), qh = *(const u32x2*)(Qs + row * 136 + 32 * sx + 16 + 4 * lg);
        const float fq = sm_fq[row];
        u32x4 w;
        w.x = pk_bf16(bf_lo(ql.x) * fq, bf_hi(ql.x) * fq); w.y = pk_bf16(bf_lo(ql.y) * fq, bf_hi(ql.y) * fq);
        w.z = pk_bf16(bf_lo(qh.x) * fq, bf_hi(qh.x) * fq); w.w = pk_bf16(bf_lo(qh.y) * fq, bf_hi(qh.y) * fq);
        *(u32x4*)(op + 16384 + (size_t)e * 16) = w;
      }
      {
        const int mt8 = frag >> 1, s2 = frag & 1, dk = 16 * mt8 + lr;
        float v[8];
#pragma unroll
        for (int j = 0; j < 8; ++j) {
          const int pos = 32 * s2 + 16 * (j >> 2) + 4 * lg + (j & 3);
          v[j] = bf2f(Ks[pos * 136 + dk]) * sm_fk[pos];
        }
        u32x4 w; w.x = pk_bf16(v[0], v[1]); w.y = pk_bf16(v[2], v[3]); w.z = pk_bf16(v[4], v[5]); w.w = pk_bf16(v[6], v[7]);
        *(u32x4*)(op + 40960 + (size_t)e * 16) = w;
      }
    }
  }
  __syncthreads();
  if (wv < 2) {
#pragma unroll
    for (int i = 0; i < 64; ++i) Vs[i * 136 + tid] = f2bf(-xv[i].y);
  }
  __syncthreads();
#pragma unroll
  for (int f = 0; f < 4; ++f) {
    const int e = tid + 256 * f, frag = e >> 6, ln = e & 63, lr = ln & 15, lg = ln >> 4;
    const int mt = frag >> 2, sx = frag & 3, row = 16 * mt + lr;
    const u32x2 lo = *(const u32x2*)(Vs + row * 136 + 32 * sx + 4 * lg), hi = *(const u32x2*)(Vs + row * 136 + 32 * sx + 16 + 4 * lg);
    *(u32x4*)(op + (size_t)e * 16) = (u32x4){lo.x, lo.y, hi.x, hi.y};
  }
}

struct ScanA { u32x4 wf[4]; u32x2 uf; float dec; };
struct ScanB { u32x4 qf[4], af[2], kf[4]; };

DI void scan_load_a(const Params& p, int wvs, ScanA& o, int b, int hd, int sl, int n, int q, int lane) {
  const int item = (b * 128 + n) * 4 + hd;
  const unsigned char* op = p.ws + OFF_SC + (size_t)item * OPB;
#pragma unroll
  for (int s = 0; s < 4; ++s) {
    o.wf[s] = *(const u32x4*)(op + (size_t)((q * 4 + s) * 64 + lane) * 16);
  }
  o.uf = *(const u32x2*)(op + 57344 + (size_t)((sl * 4 + q) * 64 + lane) * 8);
  o.dec = ((const float*)(p.ws + OFF_DEC))[item];
}
DI void scan_load_b(const Params& p, int wvs, ScanB& o, int b, int hd, int n, int q, int lane) {
  const int item = (b * 128 + n) * 4 + hd;
  const unsigned char* op = p.ws + OFF_SC + (size_t)item * OPB;
#pragma unroll
  for (int s = 0; s < 4; ++s) o.qf[s] = *(const u32x4*)(op + 16384 + (size_t)((q * 4 + s) * 64 + lane) * 16);
#pragma unroll
  for (int s2 = 0; s2 < 2; ++s2) o.af[s2] = *(const u32x4*)(op + 32768 + (size_t)((q * 2 + s2) * 64 + lane) * 16);
#pragma unroll
  for (int j = 0; j < 4; ++j) o.kf[j] = *(const u32x4*)(op + 40960 + (size_t)((q * 4 + j) * 64 + lane) * 16);
}

DI void scan_step(const Params& p, int wvs, const ScanA& o, const ScanB& ob, f32x4 (&S)[2], int b, int hd, int sl, int n, int q, int lane, unsigned char* smem) {
  const int r16 = lane & 15, g = lane >> 4;
  u32x4* ldsS = (u32x4*)smem;
  u32x2* ldsV = (u32x2*)(smem + 4096);
  ldsS[q * 64 + lane] = __builtin_bit_cast(u32x4, pack8(S[0], S[1]));
  __syncthreads();
  bf16x8 Sb[4];
#pragma unroll
  for (int s = 0; s < 4; ++s) Sb[s] = as_bf8(ldsS[s * 64 + lane]);
  f32x4 vn = (f32x4){bf_lo(o.uf.x), bf_hi(o.uf.x), bf_lo(o.uf.y), bf_hi(o.uf.y)};
#pragma unroll
  for (int s = 0; s < 4; ++s) vn = mfma16(as_bf8(o.wf[s]), Sb[s], vn);
  { u32x2 w; w.x = pk_bf16(vn[0], vn[1]); w.y = pk_bf16(vn[2], vn[3]); ldsV[((q >> 1) * 64 + lane) * 2 + (q & 1)] = w; }
  f32x4 oa = (f32x4){0.f, 0.f, 0.f, 0.f};
#pragma unroll
  for (int s = 0; s < 4; ++s) oa = mfma16(as_bf8(ob.qf[s]), Sb[s], oa);
  __syncthreads();
  bf16x8 Vb[2];
#pragma unroll
  for (int s2 = 0; s2 < 2; ++s2) Vb[s2] = as_bf8(*(const u32x4*)(ldsV + (s2 * 64 + lane) * 2));
#pragma unroll
  for (int s2 = 0; s2 < 2; ++s2) oa = mfma16(as_bf8(ob.af[s2]), Vb[s2], oa);
  u16* h = (u16*)(p.ws + OFF_H);
  const int t0 = b * SEQ + n * 64;
#pragma unroll
  for (int r = 0; r < 4; ++r) h[(size_t)(t0 + 16 * q + 4 * g + r) * NC + hd * 128 + 16 * sl + r16] = f2bf(oa[r]);
#pragma unroll
  for (int t = 0; t < 2; ++t) {
    S[t] = S[t] * o.dec;
#pragma unroll
    for (int s2 = 0; s2 < 2; ++s2) S[t] = mfma16(as_bf8(ob.kf[t * 2 + s2]), Vb[s2], S[t]);
  }
}

DI void scan_chain(const Params& p, int wvs, int pair, int sl, unsigned char* smem) {
  const int tid0 = opaque_tid(); const int lane = tid0 & 63, q = tid0 >> 6;
  const int b = pair >> 2, hd = pair & 3;
  f32x4 S[2]; S[0] = (f32x4){0.f, 0.f, 0.f, 0.f}; S[1] = S[0];
  ScanA a0, a1, a2; ScanB bc, bn;
  __syncthreads();
  scan_load_a(p, wvs, a0, b, hd, sl, 0, q, lane);
  scan_load_b(p, wvs, bc, b, hd, 0, q, lane);
  scan_load_a(p, wvs, a1, b, hd, sl, 1, q, lane);
#pragma unroll 1
  for (int n = 0; n < 129; n += 3) {
    if (n + 2 < 128) scan_load_a(p, wvs, a2, b, hd, sl, n + 2, q, lane);
    if (n + 1 < 128) scan_load_b(p, wvs, bn, b, hd, n + 1, q, lane);
    if (n < 128) scan_step(p, wvs, a0, bc, S, b, hd, sl, n, q, lane, smem);
    bc = bn;
    if (n + 3 < 128) scan_load_a(p, wvs, a0, b, hd, sl, n + 3, q, lane);
    if (n + 2 < 128) scan_load_b(p, wvs, bn, b, hd, n + 2, q, lane);
    if (n + 1 < 128) scan_step(p, wvs, a1, bc, S, b, hd, sl, n + 1, q, lane, smem);
    bc = bn;
    if (n + 4 < 128) scan_load_a(p, wvs, a1, b, hd, sl, n + 4, q, lane);
    if (n + 3 < 128) scan_load_b(p, wvs, bn, b, hd, n + 3, q, lane);
    if (n + 2 < 128) scan_step(p, wvs, a2, bc, S, b, hd, sl, n + 2, q, lane, smem);
    bc = bn;
  }
}

DI void swa_item(const Params& p, int wvs, int item, bool valid, unsigned char* smem) {
  if (!valid) { __syncthreads(); __syncthreads(); return; }
  const int tid_ = opaque_tid();
  const int tid = tid_, lane = tid & 63, wv = tid >> 6, r16 = lane & 15, g = lane >> 4;
  const int qt = item & 127, kvh = (item >> 7) & 1, b = item >> 8;
  const int kp0 = 64 * qt - 128;
  u16* Ksm = (u16*)smem;
  u16* Vt = (u16*)(smem + 27648);
  u16* h = (u16*)(p.ws + OFF_H);
  const float* rc = (const float*)(p.ws + OFF_ROPE); const float* rs = rc + 8192 * 8;
  __syncthreads();
  if (tid < 192) {
    const int kk = tid, pos = kp0 + kk;
    u32x4 lo = (u32x4){0, 0, 0, 0}, hi = lo;
    if (pos >= 0) {
      const u16* src = h + (size_t)(b * SEQ + pos) * NC + C_SWK + kvh * 64;
      const u32x4 a = *(const u32x4*)src, c = *(const u32x4*)(src + 8);
      const f32x4 c0 = *(const f32x4*)(rc + pos * 8), c1 = *(const f32x4*)(rc + pos * 8 + 4);
      const f32x4 s0 = *(const f32x4*)(rs + pos * 8), s1 = *(const f32x4*)(rs + pos * 8 + 4);
      float t1[8], t2[8], cs[8], sn[8], o1[8], o2[8];
#pragma unroll
      for (int j = 0; j < 4; ++j) { t1[2 * j] = bf_lo(a[j]); t1[2 * j + 1] = bf_hi(a[j]); t2[2 * j] = bf_lo(c[j]); t2[2 * j + 1] = bf_hi(c[j]);
        cs[j] = c0[j]; cs[4 + j] = c1[j]; sn[j] = s0[j]; sn[4 + j] = s1[j]; }
#pragma unroll
      for (int j = 0; j < 8; ++j) { o1[j] = t1[j] * cs[j] - t2[j] * sn[j]; o2[j] = t2[j] * cs[j] + t1[j] * sn[j]; }
#pragma unroll
      for (int j = 0; j < 4; ++j) { lo[j] = pk_bf16(o1[2 * j], o1[2 * j + 1]); hi[j] = pk_bf16(o2[2 * j], o2[2 * j + 1]); }
    }
    *(u32x4*)(Ksm + kk * 72) = lo; *(u32x4*)(Ksm + kk * 72 + 8) = hi;
  }
  for (int e = tid; e < 192 * 6; e += 256) {
    const int kk = e / 6, ch = 2 + e % 6, pos = kp0 + kk;
    u32x4 v = (u32x4){0, 0, 0, 0};
    if (pos >= 0) v = *(const u32x4*)(h + (size_t)(b * SEQ + pos) * NC + C_SWK + kvh * 64 + ch * 8);
    *(u32x4*)(Ksm + kk * 72 + ch * 8) = v;
  }
  for (int e = tid; e < 192 * 8; e += 256) {
    const int kk = e >> 3, ch = e & 7, pos = kp0 + kk;
    u32x4 v = (u32x4){0, 0, 0, 0};
    if (pos >= 0) v = *(const u32x4*)(h + (size_t)(b * SEQ + pos) * NC + C_SWV + kvh * 64 + ch * 8);
#pragma unroll
    for (int j = 0; j < 4; ++j) { Vt[(ch * 8 + 2 * j) * 200 + kk] = (u16)(v[j] & 0xffffu); Vt[(ch * 8 + 2 * j + 1) * 200 + kk] = (u16)(v[j] >> 16); }
  }
  __syncthreads();
  const int st = wv, jt0 = st < 2 ? st : 2;
  const int qi = 16 * st + r16;
  const int qpos = 64 * qt + qi, tq = b * SEQ + qpos;
#pragma unroll 1
  for (int hq = 0; hq < 4; ++hq) {
    const int head = kvh * 4 + hq;
    u16* qsrc = h + (size_t)tq * NC + C_SWQ + head * 64;
    bf16x8 qf[2];
    {
      const u32x4 a = *(const u32x4*)qsrc, c = *(const u32x4*)(qsrc + 8);
      u32x4 w = *(const u32x4*)(qsrc + 8 * g);
      if (g < 2) {
        const f32x4 c0 = *(const f32x4*)(rc + qpos * 8), c1 = *(const f32x4*)(rc + qpos * 8 + 4);
        const f32x4 s0 = *(const f32x4*)(rs + qpos * 8), s1 = *(const f32x4*)(rs + qpos * 8 + 4);
        float t1[8], t2[8], cs[8], sn[8], o[8];
#pragma unroll
        for (int j = 0; j < 4; ++j) { t1[2 * j] = bf_lo(a[j]); t1[2 * j + 1] = bf_hi(a[j]); t2[2 * j] = bf_lo(c[j]); t2[2 * j + 1] = bf_hi(c[j]);
          cs[j] = c0[j]; cs[4 + j] = c1[j]; sn[j] = s0[j]; sn[4 + j] = s1[j]; }
#pragma unroll
        for (int j = 0; j < 8; ++j) o[j] = (g == 0) ? (t1[j] * cs[j] - t2[j] * sn[j]) : (t2[j] * cs[j] + t1[j] * sn[j]);
#pragma unroll
        for (int j = 0; j < 4; ++j) w[j] = pk_bf16(o[2 * j], o[2 * j + 1]);
      }
      qf[0] = as_bf8(w);
      qf[1] = as_bf8(*(const u32x4*)(qsrc + 32 + 8 * g));
    }
    f32x4 sc[10];
#pragma unroll
    for (int t = 0; t < 10; ++t) {
      sc[t] = (f32x4){0.f, 0.f, 0.f, 0.f};
#pragma unroll
      for (int s = 0; s < 2; ++s) {
        const bf16x8 kf = *(const bf16x8*)(Ksm + (16 * (jt0 + t) + r16) * 72 + 32 * s + 8 * g);
        sc[t] = mfma16(kf, qf[s], sc[t]);
      }
    }
    const float sink = p.sinks[head];
    float mx = sink;
#pragma unroll
    for (int t = 0; t < 10; ++t)
#pragma unroll
      for (int r = 0; r < 4; ++r) {
        const int kk = 16 * (jt0 + t) + 4 * g + r, d = kk - qi;
        const bool ok = (d >= 1) && (d <= 128) && (kp0 + kk >= 0);
        const float v = ok ? sc[t][r] * 0.125f : -1e30f;
        sc[t][r] = v; mx = fmaxf(mx, v);
      }
    mx = fmaxf(mx, shx(mx, 16, lane)); mx = fmaxf(mx, shx(mx, 32, lane));
    float sum = 0.f;
#pragma unroll
    for (int t = 0; t < 10; ++t)
#pragma unroll
      for (int r = 0; r < 4; ++r) { const float e = __expf(sc[t][r] - mx); sc[t][r] = e; sum += e; }
    sum += shx(sum, 16, lane); sum += shx(sum, 32, lane);
    const float inv = rcp_f(sum + __expf(sink - mx));
    f32x4 oacc[4];
#pragma unroll
    for (int dt = 0; dt < 4; ++dt) oacc[dt] = (f32x4){0.f, 0.f, 0.f, 0.f};
#pragma unroll
    for (int s2 = 0; s2 < 5; ++s2) {
      const bf16x8 pb = pack8(sc[2 * s2], sc[2 * s2 + 1]);
#pragma unroll
      for (int dt = 0; dt < 4; ++dt) {
        const u16* vr = Vt + (16 * dt + r16) * 200 + 16 * (jt0 + 2 * s2) + 4 * g;
        const u32x2 lo = *(const u32x2*)vr, hi = *(const u32x2*)(vr + 16);
        oacc[dt] = mfma16(as_bf8((u32x4){lo.x, lo.y, hi.x, hi.y}), pb, oacc[dt]);
      }
    }
#pragma unroll
    for (int dt = 0; dt < 4; ++dt) {
      const int dcol = head * 64 + 16 * dt + 4 * g;
      const u32x2 z = *(const u32x2*)(h + (size_t)tq * NC + C_SWZ + dcol);
      u32x2 w;
      w.x = pk_bf16(oacc[dt][0] * inv * silu_f(bf_lo(z.x)), oacc[dt][1] * inv * silu_f(bf_hi(z.x)));
      w.y = pk_bf16(oacc[dt][2] * inv * silu_f(bf_lo(z.y)), oacc[dt][3] * inv * silu_f(bf_hi(z.y)));
      *(u32x2*)(h + (size_t)tq * NC + C_SWQ + dcol) = w;
    }
  }
}

DI void phase_ya(const Params& p, int wvs) {
  u16* h = (u16*)(p.ws + OFF_H);
  const int ltid = opaque_tid(), lane = ltid & 63;
  const size_t gt = (size_t)blockIdx.x * 512 + ltid, gs = (size_t)gridDim.x * 512;
  const float* nwp = p.dn_norm_w + (ltid & 15) * 8;
  const f32x4 nw0 = *(const f32x4*)nwp, nw1 = *(const f32x4*)(nwp + 4);
  for (size_t i0 = gt; i0 < (size_t)T_TOK * 64; i0 += 4 * gs) {
    u32x4 v[4], z[4];
#pragma unroll
    for (int k = 0; k < 4; ++k) {
      const size_t i = i0 + k * gs;
      if (i < (size_t)T_TOK * 64) {
        const u16* ptr = h + (size_t)(i >> 6) * NC + (i & 63) * 8;
        v[k] = *(const u32x4*)ptr; z[k] = *(const u32x4*)(ptr + C_DNZ);
      } else { v[k] = (u32x4){0, 0, 0, 0}; z[k] = v[k]; }
    }
#pragma unroll
    for (int k = 0; k < 4; ++k) {
      const size_t i = i0 + k * gs;
      float o[8]; float ss = 0.f;
#pragma unroll
      for (int j = 0; j < 4; ++j) { o[2 * j] = bf_lo(v[k][j]); o[2 * j + 1] = bf_hi(v[k][j]); }
#pragma unroll
      for (int j = 0; j < 8; ++j) ss += o[j] * o[j];
      ss += shx(ss, 1, lane); ss += shx(ss, 2, lane); ss += shx(ss, 4, lane); ss += shx(ss, 8, lane);
      const float rs = rsqrtf(ss * (1.0f / 128.0f) + 1e-6f);
      float y[8];
#pragma unroll
      for (int j = 0; j < 4; ++j) {
        const float w0 = (j < 2) ? nw0[2 * j] : nw1[2 * j - 4], w1 = (j < 2) ? nw0[2 * j + 1] : nw1[2 * j - 3];
        y[2 * j] = o[2 * j] * rs * w0 * silu_f(bf_lo(z[k][j]));
        y[2 * j + 1] = o[2 * j + 1] * rs * w1 * silu_f(bf_hi(z[k][j]));
      }
      u32x4 w; w.x = pk_bf16(y[0], y[1]); w.y = pk_bf16(y[2], y[3]); w.z = pk_bf16(y[4], y[5]); w.w = pk_bf16(y[6], y[7]);
      if (i < (size_t)T_TOK * 64) *(u32x4*)(h + (size_t)(i >> 6) * NC + (i & 63) * 8) = w;
    }
  }
}

DI void phase4(const Params& p, int wvs, int vb, int nvb, unsigned char* smem) {
  const int xcd = vb & 7, lb = vb >> 3, nlb = nvb >> 3;
  const u16* h = (const u16*)(p.ws + OFF_H);
  const u16* wat = (const u16*)(p.ws + OFF_WAT);
  const u16* wbt = (const u16*)(p.ws + OFF_WBT);
  u16* mg = (u16*)(p.ws + OFF_SC);
  const int tid0 = opaque_tid(); const int lane = tid0 & 63, wv = tid0 >> 6, wm = wv >> 1, wn = wv & 1, r16 = lane & 15, g = lane >> 4;
  for (int li = lb;; li += nlb) {
    int mt, nt; if (!tile_of(li, 4, xcd, mt, nt)) break;
    f32x4 acc[4][8]; zero_acc(acc);
    gemm_kloop(p, wvs, h, NC, wat, 512, 16, mt * 128, nt * 256, acc, smem);
#pragma unroll
    for (int mi = 0; mi < 4; ++mi) {
      const int row = mt * 128 + wm * 64 + mi * 16 + r16;
#pragma unroll
      for (int ni = 0; ni < 8; ++ni) {
        const int col = nt * 256 + wn * 128 + ni * 16 + 4 * g;
        const u32x2 ga = *(const u32x2*)(h + (size_t)row * NC + C_GA + col), gb = *(const u32x2*)(h + (size_t)row * NC + C_GB + col);
        acc[mi][ni][0] *= (1.f + __expf(-bf_lo(gb.x))) * rcp_f(1.f + __expf(-bf_lo(ga.x)));
        acc[mi][ni][1] *= (1.f + __expf(-bf_hi(gb.x))) * rcp_f(1.f + __expf(-bf_hi(ga.x)));
        acc[mi][ni][2] *= (1.f + __expf(-bf_lo(gb.y))) * rcp_f(1.f + __expf(-bf_lo(ga.y)));
        acc[mi][ni][3] *= (1.f + __expf(-bf_hi(gb.y))) * rcp_f(1.f + __expf(-bf_hi(ga.y)));
      }
      if (mi & 1) __builtin_amdgcn_sched_barrier(0);
    }
    gemm_kloop(p, wvs, h + C_SWQ, NC, wbt, 512, 16, mt * 128, nt * 256, acc, smem);
#pragma unroll
    for (int mi = 0; mi < 4; ++mi) {
      const int row = mt * 128 + wm * 64 + mi * 16 + r16;
#pragma unroll
      for (int ni = 0; ni < 8; ++ni) {
        const int col = nt * 256 + wn * 128 + ni * 16 + 4 * g;
        const u32x2 gb = *(const u32x2*)(h + (size_t)row * NC + C_GB + col);
        u32x2 w;
        w.x = pk_bf16(acc[mi][ni][0] * sigmoid_f(bf_lo(gb.x)), acc[mi][ni][1] * sigmoid_f(bf_hi(gb.x)));
        w.y = pk_bf16(acc[mi][ni][2] * sigmoid_f(bf_lo(gb.y)), acc[mi][ni][3] * sigmoid_f(bf_hi(gb.y)));
        *(u32x2*)(mg + (size_t)row * 1024 + col) = w;
      }
      if (mi & 1) __builtin_amdgcn_sched_barrier(0);
    }
  }
}

DI void phase5(const Params& p, int wvs, unsigned char* smem) {
  const int xcd = blockIdx.x & 7, lb = blockIdx.x >> 3, nlb = gridDim.x >> 3;
  const u16* mg = (const u16*)(p.ws + OFF_SC);
  const u16* wot = (const u16*)(p.ws + OFF_WOT);
  const int tid0 = opaque_tid(); const int lane = tid0 & 63, wv = tid0 >> 6, wm = wv >> 1, wn = wv & 1, r16 = lane & 15, g = lane >> 4;
  for (int li = lb;; li += nlb) {
    int mt, nt; if (!tile_of(li, 4, xcd, mt, nt)) break;
    f32x4 acc[4][8]; zero_acc(acc);
    gemm_kloop(p, wvs, mg, 1024, wot, 1024, 32, mt * 128, nt * 256, acc, smem);
#pragma unroll
    for (int mi = 0; mi < 4; ++mi) {
      const int row = mt * 128 + wm * 64 + mi * 16 + r16;
#pragma unroll
      for (int ni = 0; ni < 8; ++ni) {
        const int col = nt * 256 + wn * 128 + ni * 16 + 4 * g;
        const f32x4 xv = *(const f32x4*)(p.x + (size_t)row * 1024 + col);
        *(f32x4*)(p.out + (size_t)row * 1024 + col) = xv * 1.189207115002721f + acc[mi][ni];
      }
    }
  }
}

DI float wave_sum(float v, int lane) {
#pragma unroll
  for (int o = 32; o > 0; o >>= 1) v += shx(v, o, lane);
  return v;
}
DI void phase6(const Params& p, int wvs, unsigned char* smem) {
  const int tid = opaque_tid(), lane = tid & 63, wv = tid >> 6;
  f32x4 gm[4], bt[4];
#pragma unroll
  for (int j = 0; j < 4; ++j) { gm[j] = *(const f32x4*)(p.ln_g + 4 * (lane + 64 * j)); bt[j] = *(const f32x4*)(p.ln_b + 4 * (lane + 64 * j)); }
  const int xcd6 = blockIdx.x & 7, lb6 = blockIdx.x >> 3, nlb6 = gridDim.x >> 3;
  for (int lr = (lb6 * 8 + wv) * 2; lr < 4096; lr += nlb6 * 16) {
    float* r0 = p.out + (size_t)(4096 * xcd6 + (4095 - lr)) * 1024;
    float* r1 = p.out + (size_t)(4096 * xcd6 + (4094 - lr)) * 1024;
    f32x4 a[4], b[4];
#pragma unroll
    for (int j = 0; j < 4; ++j) { a[j] = *(const f32x4*)(r0 + 4 * (lane + 64 * j)); b[j] = *(const f32x4*)(r1 + 4 * (lane + 64 * j)); }
    float sa = 0.f, sb = 0.f;
#pragma unroll
    for (int j = 0; j < 4; ++j) { sa += (a[j][0] + a[j][1]) + (a[j][2] + a[j][3]); sb += (b[j][0] + b[j][1]) + (b[j][2] + b[j][3]); }
    const float ma = wave_sum(sa, lane) * (1.0f / 1024.0f), mb = wave_sum(sb, lane) * (1.0f / 1024.0f);
    float qa = 0.f, qb = 0.f;
#pragma unroll
    for (int j = 0; j < 4; ++j) {
      a[j] = a[j] - ma; b[j] = b[j] - mb;
      qa += (a[j][0] * a[j][0] + a[j][1] * a[j][1]) + (a[j][2] * a[j][2] + a[j][3] * a[j][3]);
      qb += (b[j][0] * b[j][0] + b[j][1] * b[j][1]) + (b[j][2] * b[j][2] + b[j][3] * b[j][3]);
    }
    const float ra = rsqrtf(wave_sum(qa, lane) * (1.0f / 1024.0f) + 1e-5f), rb = rsqrtf(wave_sum(qb, lane) * (1.0f / 1024.0f) + 1e-5f);
#pragma unroll
    for (int j = 0; j < 4; ++j) {
      *(f32x4*)(r0 + 4 * (lane + 64 * j)) = a[j] * ra * gm[j] + bt[j];
      *(f32x4*)(r1 + 4 * (lane + 64 * j)) = b[j] * rb * gm[j] + bt[j];
    }
  }
}

#define XB_TMO      128
#define XB_XCNT(j)  (256  + 64 * (j))
#define XB_XSUB(j)  (1280 + 64 * (j))
#define XB_XGEN(j)  (2304 + 64 * (j))
#define XB_TOP      3328
#define XB_TOPGEN   3392
#define XCD_BAR_WORDS 3456
#define XB_SPIN_CAP (1u << 22)
#define LAS __attribute__((address_space(3)))
DI unsigned xb_ld(unsigned* p) { return __hip_atomic_load(p, __ATOMIC_RELAXED, __HIP_MEMORY_SCOPE_AGENT); }
DI unsigned xb_add(unsigned* p, unsigned v) { return __hip_atomic_fetch_add(p, v, __ATOMIC_RELAXED, __HIP_MEMORY_SCOPE_AGENT); }
DI unsigned xb_xcc_id() { return (unsigned)__builtin_amdgcn_s_getreg((3 << 11) | 20) & 0xFu; }
#define XB_SPIN(cond, bar) do { unsigned _sp = 0; while (cond) { __builtin_amdgcn_s_sleep(1); \
    if ((++_sp & 255u) == 0u) { if (xb_ld(&(bar)[XB_TMO])) break; if (_sp > XB_SPIN_CAP) { atomicAdd(&(bar)[XB_TMO], 1u); break; } } } } while (0)
struct XcdBarrier { unsigned* bar; unsigned x; volatile LAS unsigned* st; };
DI bool xb_leader(int wvs) { return wvs == 0 && __builtin_amdgcn_mbcnt_hi(~0u, __builtin_amdgcn_mbcnt_lo(~0u, 0u)) == 0u; }
DI XcdBarrier xcd_barrier_post(unsigned* bar, volatile LAS unsigned* st, int wvs) {
  XcdBarrier b; b.bar = bar; b.x = xb_xcc_id(); b.st = st;
  if (xb_leader(wvs)) (void)xb_add(&bar[XB_XCNT(b.x)], 1u);
  return b;
}
DI void xcd_barrier_complete(unsigned* bar, unsigned x, unsigned& nloc, unsigned& nx) {
  const unsigned G = gridDim.x * gridDim.y * gridDim.z;
  unsigned sum, cnt, mine, sp = 0u;
  for (;;) {
    sum = 0u; cnt = 0u; mine = 0u;
#pragma unroll
    for (unsigned j = 0; j < 16; ++j) { const unsigned c = xb_ld(&bar[XB_XCNT(j)]); sum += c; cnt += (c > 0u) ? 1u : 0u; mine = (j == x) ? c : mine; }
    if (sum == G) break;
    __builtin_amdgcn_s_sleep(1);
    if ((++sp & 255u) == 0u) { if (xb_ld(&bar[XB_TMO])) break; if (sp > XB_SPIN_CAP) { atomicAdd(&bar[XB_TMO], 1u); break; } }
  }
  nloc = mine > 0u ? mine : 1u; nx = cnt > 0u ? cnt : 1u;
}
DI void xcd_barrier_(const XcdBarrier& b, int wvs) {
  asm volatile("s_waitcnt vmcnt(0)" ::: "memory");
  __syncthreads();
  if (xb_leader(wvs)) {
    unsigned* bar = b.bar;
    __builtin_amdgcn_s_waitcnt(0);
    unsigned nloc = b.st[0], nx = b.st[1];
    if (nloc == 0u) { xcd_barrier_complete(bar, b.x, nloc, nx); b.st[0] = nloc; b.st[1] = nx; }
    const unsigned old = xb_add(&bar[XB_XSUB(b.x)], 1u);
    const unsigned gen = old / nloc;
    if (old + 1u == (gen + 1u) * nloc) {
      __builtin_amdgcn_fence(__ATOMIC_RELEASE, "agent");
      asm volatile("s_waitcnt vmcnt(0)" ::: "memory");
      const unsigned og = xb_add(&bar[XB_TOP], 1u);
      const unsigned tg = og / nx;
      if (og + 1u == (tg + 1u) * nx) xb_add(&bar[XB_TOPGEN], 1u);
      else XB_SPIN(xb_ld(&bar[XB_TOPGEN]) == tg, bar);
      __builtin_amdgcn_fence(__ATOMIC_ACQUIRE, "agent");
      xb_add(&bar[XB_XGEN(b.x)], 1u);
      asm volatile("s_waitcnt vmcnt(0)" ::: "memory");
    } else {
      XB_SPIN(xb_ld(&bar[XB_XGEN(b.x)]) == gen, bar);
      __builtin_amdgcn_fence(__ATOMIC_ACQUIRE, "agent");
      asm volatile("s_waitcnt vmcnt(0)" ::: "memory");
    }
  }
  __syncthreads();
}

#define xcd_barrier(b) xcd_barrier_(b, w8)
namespace pg8 {
#define PG8_LAS __attribute__((address_space(3)))
typedef unsigned short bf16_t;
typedef short bf16x8 __attribute__((ext_vector_type(8)));
typedef float f32x4 __attribute__((ext_vector_type(4)));
typedef unsigned u32x4 __attribute__((ext_vector_type(4)));
constexpr int BM = 256, BK = 64, HALF = 128, HTB = HALF * BK * 2  , STAGE_BYTES = 8 * HTB, NXCD = 8, WGM = 8;

__host__ __device__ __forceinline__ int lds_byte(int r, int c) { const int st = (r >> 4) * 2 + (c >> 5), rr = r & 15, cc = c & 31, ob = rr * 64 + cc * 2; return st * 1024 + (ob ^ (((ob >> 9) & 1) << 5)); }
__host__ __device__ __forceinline__ void stage_rc(int b, int& R, int& C) { const int st = b / 1024, sb = b % 1024, swz = sb ^ (((sb >> 9) & 1) << 5); R = (st >> 1) * 16 + swz / 64; C = (st & 1) * 32 + (swz % 64) / 2; }
__host__ __device__ __forceinline__ int perm32(int rho) { const int n = rho >> 4, i = rho & 15; return 8 * (i >> 2) + 4 * n + (i & 3); }

struct Unit { int pm, pn; };
struct Gemm { const bf16_t* A; const bf16_t* Bt; int M, N, K; };

struct StaticOrder {
    int nM, nN, nwg, G, c;
    __host__ __device__ void init(int M, int N, int G_, int c_) { nM = M / BM; nN = N / BM; nwg = nM * nN; G = G_; c = c_; }
    __host__ __device__ bool next(int i, Unit& u) const {
        const long L = (long)i * G + c; if (L >= nwg) return false;
        int wgid = (int)L; { const int q = nwg / NXCD, r = nwg % NXCD, xcd = wgid % NXCD, off = wgid / NXCD; wgid = (xcd < r ? xcd * (q + 1) : r * (q + 1) + (xcd - r) * q) + off; }
        const int nig = WGM * nN, gid = wgid / nig, fm = gid * WGM, gsz = (nM - fm) < WGM ? (nM - fm) : WGM;
        u.pm = fm + ((wgid % nig) % gsz); u.pn = (wgid % nig) / gsz; return true;
    }
    __device__ __forceinline__ void a_ready(const Unit&) const {}
    __device__ __forceinline__ void done(const Unit&) const {}
};

template <class Epi, class Sched, bool ALIGN_EPI = false, bool SP2 = false>
__device__ __forceinline__ void gemm_phase(PG8_LAS unsigned char* lds, const Gemm g, const Sched& S, const Epi& E, const int tid) {
    const int wid = __builtin_amdgcn_readfirstlane(tid >> 6), lane = tid & 63, wr = wid >> 2, wc = wid & 3, fr = lane & 15, fq = lane >> 4;
    const int K = g.K, nt = K / BK;
    unsigned voffA[2], voffB[2];
#pragma unroll
    for (int i = 0; i < 2; ++i) { int R, C; stage_rc(tid * 16 + i * 8192, R, C); const int Rb = Epi::PERM ? ((R & ~31) + perm32(R & 31)) : R;
        voffA[i] = (unsigned)(R * K + C) * 2u; voffB[i] = (unsigned)(Rb * K + C) * 2u; }
    const size_t kstep = (size_t)(BK * 2);
    const size_t hstep = (size_t)HALF * K * 2;
    const size_t tstep = 2 * hstep;
    const unsigned ldsw = (unsigned)wid * 1024u;
    const int aoff = lds_byte(wr * 64 + fr, fq * 8), boff = lds_byte(wc * 32 + fr, fq * 8);
#define PG8_SA(b, h) (((b) * 2 + (h)) * HTB)
#define PG8_SB(b, h) ((4 + (b) * 2 + (h)) * HTB)
#define PG8_STAGE(bufoff, gbase, voff) do { _Pragma("unroll") for (int _i = 0; _i < 2; ++_i) \
        __builtin_amdgcn_global_load_lds((const unsigned*)((const char*)(gbase) + (voff)[_i]), (PG8_LAS unsigned*)(lds + (bufoff) + ldsw + _i * 8192), 16, 0, 0); } while (0)
#define PG8_LDA(dst, b, h) do { _Pragma("unroll") for (int m = 0; m < 4; ++m) _Pragma("unroll") for (int k = 0; k < 2; ++k) dst[m][k] = *(const PG8_LAS bf16x8*)(lds + PG8_SA(b, h) + aoff + m * 2048 + k * 1024); } while (0)
#define PG8_LDB(dst, b, h) do { _Pragma("unroll") for (int n = 0; n < 2; ++n) _Pragma("unroll") for (int k = 0; k < 2; ++k) dst[n][k] = *(const PG8_LAS bf16x8*)(lds + PG8_SB(b, h) + boff + n * 2048 + k * 1024); } while (0)
#define PG8_MMA(ai, bj, At, Bt) do { __builtin_amdgcn_s_setprio(1); _Pragma("unroll") for (int m = 0; m < 4; ++m) _Pragma("unroll") for (int n = 0; n < 2; ++n) _Pragma("unroll") for (int k = 0; k < 2; ++k) \
        acc[ai][bj][m][n] = __builtin_amdgcn_mfma_f32_16x16x32_bf16(Bt[n][k], At[m][k], acc[ai][bj][m][n], 0, 0, 0); __builtin_amdgcn_s_setprio(0); } while (0)
#define PG8_WAIT_V(n) asm volatile("s_waitcnt vmcnt(" #n ")" ::: "memory")
#define PG8_WAIT_L(n) asm volatile("s_waitcnt lgkmcnt(" #n ")" ::: "memory")
#define PG8_BAR __builtin_amdgcn_s_barrier()
#define PG8_SCHED __builtin_amdgcn_sched_barrier(0)
    Unit cur, nxt; int ui = 0;
    if (!S.next(0, cur)) return;
    f32x4 acc[2][2][4][2];
#pragma unroll
    for (int a = 0; a < 2; ++a)
#pragma unroll
        for (int b = 0; b < 2; ++b)
#pragma unroll
            for (int m = 0; m < 4; ++m)
#pragma unroll
                for (int n = 0; n < 2; ++n) acc[a][b][m][n] = (f32x4){0.f, 0.f, 0.f, 0.f};
    bf16x8 At[4][2], B0[2][2], B1[2][2];
    const char* cA = (const char*)g.A + (size_t)cur.pm * tstep; const char* cB = (const char*)g.Bt + (size_t)cur.pn * tstep;
    S.a_ready(cur);
    if constexpr (SP2) {
        PG8_STAGE(PG8_SB(0, 0), cB, voffB); PG8_STAGE(PG8_SB(0, 1), cB + hstep, voffB); PG8_STAGE(PG8_SA(0, 0), cA, voffA); PG8_STAGE(PG8_SA(0, 1), cA + hstep, voffA);
        if (wr == 1) PG8_BAR;
        PG8_WAIT_V(2); PG8_BAR;
        PG8_STAGE(PG8_SB(1, 0), cB + kstep, voffB); PG8_STAGE(PG8_SA(1, 0), cA + kstep, voffA); PG8_STAGE(PG8_SB(1, 1), cB + hstep + kstep, voffB);
        PG8_WAIT_V(6); PG8_BAR;
    } else {
        PG8_STAGE(PG8_SB(0, 0), cB, voffB); PG8_STAGE(PG8_SA(0, 0), cA, voffA); PG8_STAGE(PG8_SB(0, 1), cB + hstep, voffB); PG8_STAGE(PG8_SA(0, 1), cA + hstep, voffA);
        if (wr == 1) PG8_BAR;
        PG8_WAIT_V(4); PG8_BAR;
        PG8_STAGE(PG8_SB(1, 0), cB + kstep, voffB); PG8_STAGE(PG8_SA(1, 0), cA + kstep, voffA); PG8_STAGE(PG8_SB(1, 1), cB + hstep + kstep, voffB);
        PG8_WAIT_V(6); PG8_BAR;
    }
    for (;;) {
        const bool has_next = S.next(ui + 1, nxt);
        const char* nA = has_next ? (const char*)g.A + (size_t)nxt.pm * tstep : cA; const char* nB = has_next ? (const char*)g.Bt + (size_t)nxt.pn * tstep : cB;
        for (int t = 0; t < nt; t += 2) {
            const bool last = (t == nt - 2);
            const char* a1 = cA + (size_t)(t + 1) * kstep;
            const char* a2 = last ? nA : cA + (size_t)(t + 2) * kstep; const char* b2 = last ? nB : cB + (size_t)(t + 2) * kstep;
            const char* a3 = a2 + kstep; const char* b3 = b2 + kstep;
            if (last && has_next) S.a_ready(nxt);
            if constexpr (SP2) {
            PG8_LDB(B0, 0, 0); PG8_LDB(B1, 0, 1); PG8_SCHED; PG8_LDA(At, 0, 0); PG8_STAGE(PG8_SA(1, 1), a1 + hstep, voffA);
            PG8_WAIT_V(8); PG8_WAIT_L(0); PG8_BAR; PG8_MMA(0, 0, At, B0); PG8_MMA(0, 1, At, B1); PG8_BAR; PG8_SCHED;
            PG8_LDA(At, 0, 1); PG8_STAGE(PG8_SB(0, 0), b2, voffB); PG8_STAGE(PG8_SB(0, 1), b2 + hstep, voffB); PG8_STAGE(PG8_SA(0, 0), a2, voffA);
            PG8_WAIT_V(8); PG8_WAIT_L(0); PG8_BAR; PG8_MMA(1, 0, At, B0); PG8_MMA(1, 1, At, B1); PG8_BAR; PG8_SCHED;
            PG8_LDB(B0, 1, 0); PG8_LDB(B1, 1, 1); PG8_SCHED; PG8_LDA(At, 1, 0); PG8_STAGE(PG8_SA(0, 1), a2 + hstep, voffA);
            PG8_WAIT_V(8); PG8_WAIT_L(0); PG8_BAR; PG8_MMA(0, 0, At, B0); PG8_MMA(0, 1, At, B1); PG8_BAR; PG8_SCHED;
            PG8_LDA(At, 1, 1); PG8_STAGE(PG8_SB(1, 0), b3, voffB); PG8_STAGE(PG8_SB(1, 1), b3 + hstep, voffB); PG8_STAGE(PG8_SA(1, 0), a3, voffA);
            PG8_WAIT_V(8); PG8_WAIT_L(0); PG8_BAR; PG8_MMA(1, 0, At, B0); PG8_MMA(1, 1, At, B1); PG8_BAR; PG8_SCHED;
            } else {
            PG8_LDB(B0, 0, 0); PG8_SCHED; PG8_LDA(At, 0, 0); PG8_STAGE(PG8_SA(1, 1), a1 + hstep, voffA);
            PG8_WAIT_L(8); PG8_BAR; PG8_WAIT_L(0); PG8_MMA(0, 0, At, B0); PG8_BAR; PG8_SCHED;
            PG8_LDB(B1, 0, 1); PG8_STAGE(PG8_SB(0, 0), b2, voffB);
            PG8_BAR; PG8_WAIT_L(0); PG8_MMA(0, 1, At, B1); PG8_BAR;
            PG8_LDA(At, 0, 1); PG8_STAGE(PG8_SA(0, 0), a2, voffA);
            PG8_BAR; PG8_WAIT_L(0); PG8_MMA(1, 0, At, B0); PG8_BAR; PG8_SCHED;
            PG8_STAGE(PG8_SB(0, 1), b2 + hstep, voffB);
            PG8_WAIT_V(6); PG8_BAR; PG8_MMA(1, 1, At, B1); PG8_BAR;
            PG8_LDB(B0, 1, 0); PG8_SCHED; PG8_LDA(At, 1, 0); PG8_STAGE(PG8_SA(0, 1), a2 + hstep, voffA);
            PG8_WAIT_L(8); PG8_BAR; PG8_WAIT_L(0); PG8_MMA(0, 0, At, B0); PG8_BAR; PG8_SCHED;
            PG8_LDB(B1, 1, 1); PG8_STAGE(PG8_SB(1, 0), b3, voffB);
            PG8_BAR; PG8_WAIT_L(0); PG8_MMA(0, 1, At, B1); PG8_BAR;
            PG8_LDA(At, 1, 1); PG8_STAGE(PG8_SA(1, 0), a3, voffA);
            PG8_BAR; PG8_WAIT_L(0); PG8_MMA(1, 0, At, B0); PG8_BAR; PG8_SCHED;
            PG8_STAGE(PG8_SB(1, 1), b3 + hstep, voffB);
            PG8_WAIT_V(6); PG8_BAR; PG8_MMA(1, 1, At, B1); PG8_BAR;
            }
        }
        if constexpr (ALIGN_EPI) { if (wr == 0) PG8_BAR; }
        if constexpr (!Epi::AFTER_DRAIN) { E(acc, cur, wr, wc, fr, fq); S.done(cur); }
        if (!has_next) break;
#pragma unroll
        for (int a = 0; a < 2; ++a)
#pragma unroll
            for (int b = 0; b < 2; ++b)
#pragma unroll
                for (int m = 0; m < 4; ++m)
#pragma unroll
                    for (int n = 0; n < 2; ++n) acc[a][b][m][n] = (f32x4){0.f, 0.f, 0.f, 0.f};
        cur = nxt; cA = nA; cB = nB; ++ui;
        if constexpr (ALIGN_EPI) { if (wr == 1) PG8_BAR; }
    }
    PG8_WAIT_V(0);
    if constexpr (!ALIGN_EPI) { if (wr == 0) PG8_BAR; }
    PG8_BAR;
    if constexpr (Epi::AFTER_DRAIN) { E.fused(acc, cur, wr, wc, fr, fq, lds, wid, lane); S.done(cur); }
#undef PG8_SA
#undef PG8_SB
#undef PG8_STAGE
#undef PG8_LDA
#undef PG8_LDB
#undef PG8_MMA
#undef PG8_WAIT_V
#undef PG8_WAIT_L
#undef PG8_BAR
#undef PG8_SCHED
}
}

struct EpiInProj {
  static constexpr bool PERM = true, AFTER_DRAIN = false;
  u16* h;
  DI void operator()(const f32x4 (&acc)[2][2][4][2], const pg8::Unit& u, int wr, int wc, int fr, int fq) const {
    const int shift = (u.pn >= 8) ? 8 : 0;
#pragma unroll
    for (int ai = 0; ai < 2; ++ai)
#pragma unroll
      for (int m = 0; m < 4; ++m) {
        const int row = u.pm * 256 + ai * 128 + wr * 64 + m * 16 + fr;
#pragma unroll
        for (int bj = 0; bj < 2; ++bj) {
          const int col = u.pn * 256 + bj * 128 + wc * 32 + 8 * fq + shift;
          const f32x4 a = acc[ai][bj][m][0], b = acc[ai][bj][m][1];
          u32x4 w; w.x = pk_bf16(a[0], a[1]); w.y = pk_bf16(a[2], a[3]); w.z = pk_bf16(b[0], b[1]); w.w = pk_bf16(b[2], b[3]);
          *(u32x4*)(h + (size_t)row * NC + col) = w;
        }
      }
  }
};
struct EpiOut {
  static constexpr bool PERM = true, AFTER_DRAIN = false;
  const float* x; float* out;
  DI void operator()(const f32x4 (&acc)[2][2][4][2], const pg8::Unit& u, int wr, int wc, int fr, int fq) const {
#pragma unroll
    for (int ai = 0; ai < 2; ++ai)
#pragma unroll
      for (int m = 0; m < 4; ++m) {
        const int row = u.pm * 256 + ai * 128 + wr * 64 + m * 16 + fr;
#pragma unroll
        for (int bj = 0; bj < 2; ++bj) {
          const int col = u.pn * 256 + bj * 128 + wc * 32 + 8 * fq;
          const f32x4 x0 = *(const f32x4*)(x + (size_t)row * 1024 + col), x1 = *(const f32x4*)(x + (size_t)row * 1024 + col + 4);
          *(f32x4*)(out + (size_t)row * 1024 + col) = x0 * 1.189207115002721f + acc[ai][bj][m][0];
          *(f32x4*)(out + (size_t)row * 1024 + col + 4) = x1 * 1.189207115002721f + acc[ai][bj][m][1];
        }
      }
  }
};

#ifndef MK_MULTI
#define MK_MULTI 0
#endif
__global__ void __launch_bounds__(512, 2) fwd_megakernel(Params p) {
  cg::grid_group grid = cg::this_grid();
  __shared__ __attribute__((aligned(16))) unsigned char smem[SMEM_BYTES];
  const int w8 = __builtin_amdgcn_readfirstlane((int)(threadIdx.x >> 6));
  const int wvs = w8 & 3, half = w8 >> 2;
  unsigned char* hsm = smem + half * HALF_SMEM;
  const int vb = blockIdx.x + half * gridDim.x, nvb = 2 * gridDim.x;
  volatile LAS unsigned* st = (volatile LAS unsigned*)(smem + SMEM_BYTES - 16);
  { const int t0_ = opaque_tid(); if (t0_ < 4) st[t0_] = 0u; }
  __syncthreads();
  const XcdBarrier xb = xcd_barrier_post((unsigned*)(p.ws + OFF_BAR), st, w8);
  phase0(p, w8);
  if (p.ws == nullptr) grid.sync();
  xcd_barrier(xb);
  {
    pg8::Gemm g; g.A = (const pg8::bf16_t*)(p.ws + OFF_SC); g.Bt = (const pg8::bf16_t*)(p.ws + OFF_WINT); g.M = T_TOK; g.N = NCP; g.K = 1024;
    pg8::StaticOrder so; so.init(T_TOK, NCP, (int)gridDim.x, (int)blockIdx.x);
    EpiInProj e; e.h = (u16*)(p.ws + OFF_H);
    pg8::gemm_phase<EpiInProj, pg8::StaticOrder, true, true>((PG8_LAS unsigned char*)smem, g, so, e, opaque_tid_(w8));
  }
  xcd_barrier(xb);
  for (int it = vb; it < 2048; it += nvb) prep_item(p, wvs, it, hsm);
  xcd_barrier(xb);
  if (blockIdx.x < 64) scan_chain(p, wvs, (int)(blockIdx.x & 7) + 8 * half, (int)(blockIdx.x >> 3), hsm);
  else {
    const int nsw = 2 * ((int)gridDim.x - 64), vbl = ((int)blockIdx.x - 64) + half * ((int)gridDim.x - 64);
    for (int k = 0; k * nsw < 1024; ++k) { const int it = vbl + k * nsw; swa_item(p, wvs, it < 1024 ? it : 0, it < 1024, hsm); }
  }
  xcd_barrier(xb);
  phase_ya(p, w8);
  xcd_barrier(xb);
  phase4(p, wvs, vb, nvb, hsm);
  xcd_barrier(xb);
  {
    pg8::Gemm g; g.A = (const pg8::bf16_t*)(p.ws + OFF_SC); g.Bt = (const pg8::bf16_t*)(p.ws + OFF_WOT); g.M = T_TOK; g.N = 1024; g.K = 1024;
    pg8::StaticOrder so; so.init(T_TOK, 1024, (int)gridDim.x, (int)blockIdx.x);
    EpiOut e; e.x = p.x; e.out = p.out;
    pg8::gemm_phase<EpiOut, pg8::StaticOrder, true, true>((PG8_LAS unsigned char*)smem, g, so, e, opaque_tid_(w8));
  }
  xcd_barrier(xb);
  phase6(p, w8, smem);
}

extern "C" void kernel_launch(void* const* d_in, const int* in_sizes, int n_in, void* d_out, int out_size,
                              void* d_ws, size_t ws_size, hipStream_t stream) {
  if (ws_size < WS_NEED) { fprintf(stderr, "workspace too small: %zu < %zu\n", ws_size, (size_t)WS_NEED); return; }
  Params p{};
  p.x = (const float*)d_in[0]; p.w_in = (const float*)d_in[1]; p.conv_w = (const float*)d_in[2]; p.a_log = (const float*)d_in[3];
  p.dt_bias = (const float*)d_in[4]; p.dn_norm_w = (const float*)d_in[5]; p.sinks = (const float*)d_in[6];
  p.w_branch = (const float*)d_in[7]; p.w_out = (const float*)d_in[8]; p.ln_g = (const float*)d_in[9]; p.ln_b = (const float*)d_in[10];
  p.out = (float*)d_out; p.ws = (unsigned char*)d_ws;
  for (int i = 0; i < 8; ++i) p.inv_freq[i] = (float)std::pow(500000.0, -(double)i / 8.0);
  static int grid_blocks = 0;
  if (!grid_blocks) {
    int dev = 0, cus = 0, per_cu = 0;
    (void)hipGetDevice(&dev);
    (void)hipDeviceGetAttribute(&cus, hipDeviceAttributeMultiprocessorCount, dev);
    (void)hipOccupancyMaxActiveBlocksPerMultiprocessor(&per_cu, fwd_megakernel, 512, 0);
    if (per_cu < 1) fprintf(stderr, "occupancy query reports %d workgroups per CU\n", per_cu);
    grid_blocks = cus > 256 ? 256 : cus;
    grid_blocks &= ~7;
  }
  (void)hipMemsetAsync(p.ws + OFF_BAR, 0, BAR_BYTES, stream);
  void* args[] = {&p};
  hipError_t e = hipLaunchCooperativeKernel((void*)fwd_megakernel, dim3(grid_blocks), dim3(512), args, 0, stream);
  if (e != hipSuccess) fprintf(stderr, "cooperative launch failed: %s (grid %d)\n", hipGetErrorString(e), grid_blocks);
}
```

```cpp
#include <hip/hip_runtime.h>
#include <hip/hip_cooperative_groups.h>
#include <cstdio>
#include <cmath>
namespace cg = cooperative_groups;

typedef unsigned short u16;
typedef short bf16x8 __attribute__((ext_vector_type(8)));
typedef float f32x4 __attribute__((ext_vector_type(4)));
typedef unsigned u32x4 __attribute__((ext_vector_type(4)));
typedef unsigned u32x2 __attribute__((ext_vector_type(2)));
#define DI __device__ __forceinline__
DI int opaque_tid_(int wave_s) { int t; asm volatile("v_mbcnt_lo_u32_b32 %0, -1, 0\n\tv_mbcnt_hi_u32_b32 %0, -1, %0" : "=v"(t)); return t + (wave_s << 6); }
#define opaque_tid() opaque_tid_(wvs)

constexpr int T_TOK = 32768, SEQ = 8192, DM = 1024, NC = 5384, NCP = 5376;
constexpr int C_DNZ = 1536, C_SWQ = 2056, C_SWK = 2568, C_SWV = 2696, C_SWZ = 2824, C_GA = 3336, C_GB = 4360;
constexpr size_t OFF_BAR = 0;
constexpr size_t BAR_BYTES = 16384;
constexpr size_t OFF_WINT = BAR_BYTES;
constexpr size_t OFF_WAT = OFF_WINT + (size_t)NCP * 1024 * 2;
constexpr size_t OFF_WBT = OFF_WAT + 1024 * 512 * 2;
constexpr size_t OFF_WOT = OFF_WBT + 1024 * 512 * 2;
constexpr size_t OFF_ROPE = OFF_WOT + 1024 * 1024 * 2;
constexpr size_t OFF_HB = OFF_ROPE + 2 * 8192 * 8 * 4;
constexpr size_t OFF_DEC = OFF_HB + (size_t)T_TOK * 8 * 4;
constexpr size_t OFF_H = OFF_DEC + 2048 * 4;
constexpr size_t OFF_SC = OFF_H + (size_t)T_TOK * NC * 2;
constexpr size_t OPB = 73728;
constexpr size_t WS_NEED = OFF_SC + 2048 * OPB;
constexpr int HALF_SMEM = 73728;
constexpr int SMEM_BYTES = 2 * HALF_SMEM + 16;

struct Params {
  const float *x, *w_in, *conv_w, *a_log, *dt_bias, *dn_norm_w, *sinks, *w_branch, *w_out, *ln_g, *ln_b;
  float* out; unsigned char* ws;
  float inv_freq[8];
};

typedef __bf16 bf16x2_t __attribute__((ext_vector_type(2)));
typedef float f32x2_t __attribute__((ext_vector_type(2)));
DI unsigned pk_bf16(float lo, float hi) { f32x2_t f = {lo, hi}; bf16x2_t v = __builtin_convertvector(f, bf16x2_t); return __builtin_bit_cast(unsigned, v); }
DI float bf_lo(unsigned u) { return __uint_as_float(u << 16); }
DI float bf_hi(unsigned u) { return __uint_as_float(u & 0xffff0000u); }
DI float bf2f(u16 v) { return __uint_as_float(((unsigned)v) << 16); }
DI u16 f2bf(float f) { return (u16)(pk_bf16(f, f) & 0xffffu); }
DI float shx(float v, int m, int lane) { return __uint_as_float((unsigned)__builtin_amdgcn_ds_bpermute((lane ^ m) << 2, (int)__float_as_uint(v))); }
DI float rcp_f(float y) { return __builtin_amdgcn_rcpf(y); }
DI float silu_f(float y) { return y * rcp_f(1.0f + __expf(-y)); }
DI float sigmoid_f(float y) { return rcp_f(1.0f + __expf(-y)); }
DI f32x4 mfma16(bf16x8 a, bf16x8 b, f32x4 c) { return __builtin_amdgcn_mfma_f32_16x16x32_bf16(a, b, c, 0, 0, 0); }
DI bf16x8 as_bf8(u32x4 v) { return __builtin_bit_cast(bf16x8, v); }
DI bf16x8 pack8(f32x4 a, f32x4 b) { u32x4 w; w.x = pk_bf16(a[0], a[1]); w.y = pk_bf16(a[2], a[3]); w.z = pk_bf16(b[0], b[1]); w.w = pk_bf16(b[2], b[3]); return as_bf8(w); }

DI void phase0(const Params& p, int wvs) {
  const size_t gt = (size_t)blockIdx.x * 512 + opaque_tid(), gs = (size_t)gridDim.x * 512;
  {
    const int ltid = (int)(gt & 511), lane = ltid & 63, wv = ltid >> 6;
    float wr[16][8];
#pragma unroll
    for (int j = 0; j < 4; ++j)
#pragma unroll
      for (int c = 0; c < 4; ++c) {
        const float* wp = p.w_in + (size_t)(4 * (lane + 64 * j) + c) * NC + 2048;
        const f32x4 a = *(const f32x4*)wp, b = *(const f32x4*)(wp + 4);
#pragma unroll
        for (int q = 0; q < 4; ++q) { wr[4 * j + c][q] = a[q]; wr[4 * j + c][4 + q] = b[q]; }
      }
    u16* xb = (u16*)(p.ws + OFF_SC);
    float* hb = (float*)(p.ws + OFF_HB);
    const int rstep = gridDim.x * 8;
    for (int row0 = blockIdx.x * 8 + wv; row0 < T_TOK; row0 += 2 * rstep) {
      f32x4 xr[2][4];
#pragma unroll
      for (int u = 0; u < 2; ++u) {
        const int row = row0 + u * rstep;
#pragma unroll
        for (int j = 0; j < 4; ++j) xr[u][j] = (row < T_TOK) ? *(const f32x4*)(p.x + (size_t)row * DM + 4 * (lane + 64 * j)) : (f32x4){0.f, 0.f, 0.f, 0.f};
      }
#pragma unroll
      for (int u = 0; u < 2; ++u) {
        const int row = row0 + u * rstep;
        float v[8];
#pragma unroll
        for (int q = 0; q < 8; ++q) v[q] = 0.f;
#pragma unroll
        for (int j = 0; j < 4; ++j) {
          const f32x4 xv = xr[u][j];
          u32x2 w; w.x = pk_bf16(xv[0], xv[1]); w.y = pk_bf16(xv[2], xv[3]);
          if (row < T_TOK) *(u32x2*)(xb + (size_t)row * DM + 4 * (lane + 64 * j)) = w;
#pragma unroll
          for (int c = 0; c < 4; ++c)
#pragma unroll
            for (int q = 0; q < 8; ++q) v[q] += xv[c] * wr[4 * j + c][q];
        }
        const bool up = (lane & 32) != 0;
        float k4[4];
#pragma unroll
        for (int i = 0; i < 4; ++i) { const float snd = up ? v[i] : v[i + 4]; const float kp = up ? v[i + 4] : v[i]; k4[i] = kp + shx(snd, 32, lane); }
        const bool up2 = (lane & 16) != 0;
        float k2[2];
#pragma unroll
        for (int i = 0; i < 2; ++i) { const float snd = up2 ? k4[i] : k4[i + 2]; const float kp = up2 ? k4[i + 2] : k4[i]; k2[i] = kp + shx(snd, 16, lane); }
        const bool up3 = (lane & 8) != 0;
        float k1 = (up3 ? k2[1] : k2[0]) + shx(up3 ? k2[0] : k2[1], 8, lane);
        k1 += shx(k1, 4, lane); k1 += shx(k1, 2, lane); k1 += shx(k1, 1, lane);
        if ((lane & 7) == 0 && row < T_TOK) hb[(size_t)row * 8 + (lane >> 3)] = k1;
      }
    }
  }
  {
    u32x4* wt = (u32x4*)(p.ws + OFF_WINT);
    for (size_t i = gt; i < (size_t)NCP * 128; i += gs) {
      const int kc = (int)(i / NCP), n = (int)(i % NCP);
      float v[8];
#pragma unroll
      for (int j = 0; j < 8; ++j) v[j] = p.w_in[(size_t)(kc * 8 + j) * NC + n + (n >= 2048 ? 8 : 0)];
      u32x4 w; w.x = pk_bf16(v[0], v[1]); w.y = pk_bf16(v[2], v[3]); w.z = pk_bf16(v[4], v[5]); w.w = pk_bf16(v[6], v[7]);
      wt[(size_t)n * 128 + kc] = w;
    }
  }
  {
    for (size_t i = gt; i < (size_t)2 * 1024 * 64; i += gs) {
      const int br = (int)(i / (1024 * 64)), rem = (int)(i % (1024 * 64)), kc = rem / 1024, n = rem % 1024;
      const float* src = p.w_branch + (size_t)br * 512 * 1024;
      float v[8];
#pragma unroll
      for (int j = 0; j < 8; ++j) v[j] = src[(size_t)(kc * 8 + j) * 1024 + n];
      u32x4 w; w.x = pk_bf16(v[0], v[1]); w.y = pk_bf16(v[2], v[3]); w.z = pk_bf16(v[4], v[5]); w.w = pk_bf16(v[6], v[7]);
      ((u32x4*)(p.ws + (br ? OFF_WBT : OFF_WAT)))[(size_t)n * 64 + kc] = w;
    }
  }
  {
    for (size_t i = gt; i < (size_t)1024 * 128; i += gs) {
      const int kc = (int)(i / 1024), n = (int)(i % 1024);
      float v[8];
#pragma unroll
      for (int j = 0; j < 8; ++j) v[j] = p.w_out[(size_t)(kc * 8 + j) * 1024 + n];
      u32x4 w; w.x = pk_bf16(v[0], v[1]); w.y = pk_bf16(v[2], v[3]); w.z = pk_bf16(v[4], v[5]); w.w = pk_bf16(v[6], v[7]);
      ((u32x4*)(p.ws + OFF_WOT))[(size_t)n * 128 + kc] = w;
    }
  }
  {
    float* rc = (float*)(p.ws + OFF_ROPE); float* rs = rc + 8192 * 8;
    for (size_t i = gt; i < 8192 * 8; i += gs) {
      const int t = (int)(i >> 3), f = (int)(i & 7);
      const float ang = (float)t * p.inv_freq[f];
      const double a = (double)ang;
      const double k = __builtin_rint(a * 0.15915494309189535);
      const float r = (float)(a - k * 6.283185307179586);
      rc[i] = cosf(r); rs[i] = sinf(r);
    }
  }
}

DI int lds_off32(int row, int chunk) { return row * 64 + ((chunk ^ ((0 - (row >> 2)) & 3)) << 4); }
constexpr int GSTAGE = 24576;

DI void gemm_kloop(const Params& p, int wvs, const u16* __restrict__ A, int lda, const u16* __restrict__ Bt, int ldb, int nk, int m0, int n0,
                   f32x4 (&acc)[4][8], unsigned char* smem) {
  const int tid = opaque_tid(), lane = tid & 63, wv = tid >> 6, wm = wv >> 1, wn = wv & 1, r16 = lane & 15, g = lane >> 4;
  const int prow = lane >> 2, pc = (lane & 3) ^ ((0 - (prow >> 2)) & 3);
  const u16* ap = A + (size_t)(m0 + 16 * wv + prow) * lda + pc * 8;
  const u16* bp = Bt + (size_t)(n0 + 16 * wv + prow) * ldb + pc * 8;
  unsigned char* lA = smem + wv * 1024;
  unsigned char* lB = smem + 8192 + wv * 1024;
#define GEMM_ISSUE(kt_, buf_) do { \
    _Pragma("unroll") for (int i_ = 0; i_ < 2; ++i_) \
      __builtin_amdgcn_global_load_lds((const unsigned*)(ap + (size_t)(64 * i_) * lda + (kt_) * 32), (unsigned*)(lA + (buf_) * GSTAGE + i_ * 4096), 16, 0, 0); \
    _Pragma("unroll") for (int i_ = 0; i_ < 4; ++i_) \
      __builtin_amdgcn_global_load_lds((const unsigned*)(bp + (size_t)(64 * i_) * ldb + (kt_) * 32), (unsigned*)(lB + (buf_) * GSTAGE + i_ * 4096), 16, 0, 0); \
  } while (0)
  GEMM_ISSUE(0, 0);
  GEMM_ISSUE(1, 1);
  asm volatile("s_waitcnt vmcnt(6)" ::: "memory");
  __builtin_amdgcn_s_barrier();
  int cb = 0;
  for (int kt = 0; kt < nk; ++kt) {
    int ib = cb + 2; if (ib >= 3) ib -= 3;
    const bool more = (kt + 2 < nk);
    if (more) GEMM_ISSUE(kt + 2, ib);
    const unsigned char* cur = smem + cb * GSTAGE;
    bf16x8 af[4], bfr[8];
#pragma unroll
    for (int i = 0; i < 4; ++i) af[i] = *(const bf16x8*)(cur + lds_off32(wm * 64 + i * 16 + r16, g));
#pragma unroll
    for (int i = 0; i < 8; ++i) bfr[i] = *(const bf16x8*)(cur + 8192 + lds_off32(wn * 128 + i * 16 + r16, g));
#pragma unroll
    for (int mi = 0; mi < 4; ++mi)
#pragma unroll
      for (int ni = 0; ni < 8; ++ni) acc[mi][ni] = mfma16(bfr[ni], af[mi], acc[mi][ni]);
    if (more) asm volatile("s_waitcnt vmcnt(6)" ::: "memory"); else asm volatile("s_waitcnt vmcnt(0)" ::: "memory");
    asm volatile("s_waitcnt lgkmcnt(0)" ::: "memory");
    __builtin_amdgcn_s_barrier();
    cb = cb + 1; if (cb >= 3) cb = 0;
  }
#undef GEMM_ISSUE
}

DI bool tile_of(int li, int ntn, int xcd, int& mt, int& nt) {
  if (li >= 32 * ntn) return false;
  const int grp = li / (8 * ntn), rem = li % (8 * ntn);
  nt = rem >> 3; mt = 32 * xcd + grp * 8 + (rem & 7);
  return true;
}

DI void zero_acc(f32x4 (&acc)[4][8]) {
#pragma unroll
  for (int i = 0; i < 4; ++i)
#pragma unroll
    for (int j = 0; j < 8; ++j) acc[i][j] = (f32x4){0.f, 0.f, 0.f, 0.f};
}

DI void phase1(const Params& p, int wvs, unsigned char* smem) {
  const int xcd = blockIdx.x & 7, lb = blockIdx.x >> 3, nlb = gridDim.x >> 3;
  const u16* xb = (const u16*)(p.ws + OFF_SC);
  const u16* wint = (const u16*)(p.ws + OFF_WINT);
  u16* h = (u16*)(p.ws + OFF_H);
  float* hb = (float*)(p.ws + OFF_HB);
  const int tid0 = opaque_tid(); const int lane = tid0 & 63, wv = tid0 >> 6, wm = wv >> 1, wn = wv & 1, r16 = lane & 15, g = lane >> 4;
  for (int li = lb;; li += nlb) {
    int mt, nt; if (!tile_of(li, 21, xcd, mt, nt)) break;
    f32x4 acc[4][8]; zero_acc(acc);
    gemm_kloop(p, wvs, xb, 1024, wint, 1024, 32, mt * 128, nt * 256, acc, smem);
#pragma unroll
    for (int mi = 0; mi < 4; ++mi) {
      const int row = mt * 128 + wm * 64 + mi * 16 + r16;
#pragma unroll
      for (int ni = 0; ni < 8; ++ni) {
        const int col = nt * 256 + wn * 128 + ni * 16 + 4 * g;
        {
          u32x2 w; w.x = pk_bf16(acc[mi][ni][0], acc[mi][ni][1]); w.y = pk_bf16(acc[mi][ni][2], acc[mi][ni][3]);
          *(u32x2*)(h + (size_t)row * NC + col + (nt >= 8 ? 8 : 0)) = w;
        }
      }
    }
  }
}

template <int I> DI void solve_rows2(f32x2_t (&xv)[64], const float* Lm, int lane, float lcur) {
  if constexpr (I < 64) {
    float lnx = 0.f;
    if constexpr (I + 1 < 64) lnx = Lm[(I + 1) * 68 + lane];
    f32x2_t a0 = xv[I], a1 = {0.f, 0.f}, a2 = {0.f, 0.f}, a3 = {0.f, 0.f};
#pragma unroll
    for (int m = 0; m < I; ++m) {
      const float l = __builtin_bit_cast(float, __builtin_amdgcn_readlane(__builtin_bit_cast(int, lcur), m));
      const f32x2_t lv = {l, l};
      if ((m & 3) == 0) a0 -= lv * xv[m];
      else if ((m & 3) == 1) a1 -= lv * xv[m];
      else if ((m & 3) == 2) a2 -= lv * xv[m];
      else a3 -= lv * xv[m];
    }
    xv[I] = (a0 + a1) + (a2 + a3);
    solve_rows2<I + 1>(xv, Lm, lane, lnx);
  }
}

DI void prep_item(const Params& p, int wvs, int item, unsigned char* smem) {
  const int tid_ = opaque_tid();
  const int tid = tid_, lane = tid & 63, wv = tid >> 6, r16 = lane & 15, g = lane >> 4;
  const int hd = item & 3, n = (item >> 2) & 127, b = item >> 9;
  const int t0 = b * SEQ + n * 64;
  u16* Qs = (u16*)smem; u16* Ks = Qs + 64 * 136; u16* Vs = Ks + 64 * 136;
  float* Lm = (float*)(smem + 52224);
  float* sm_beta = (float*)(smem + 69632);
  float* sm_gc = sm_beta + 64; float* sm_rq = sm_gc + 64; float* sm_rk = sm_rq + 64;
  float* sm_fw = sm_rk + 64; float* sm_fq = sm_fw + 64; float* sm_fk = sm_fq + 64;
  const u16* h = (const u16*)(p.ws + OFF_H);
  const float* hb = (const float*)(p.ws + OFF_HB);
  unsigned char* op = p.ws + OFF_SC + (size_t)item * OPB;
  __syncthreads();
  {
    const int c2 = tid & 63, rbase = (tid >> 6) * 16;
    unsigned raw[3][19];
#pragma unroll
    for (int mat = 0; mat < 3; ++mat) {
      const int col = mat * 512 + hd * 128 + 2 * c2;
#pragma unroll
      for (int j = 0; j < 19; ++j) {
        const int rr = t0 + rbase - 3 + j;
        raw[mat][j] = *(const unsigned*)(h + (size_t)(rr < 0 ? 0 : rr) * NC + col);
      }
    }
    __builtin_amdgcn_sched_barrier(0);
#pragma unroll
    for (int mat = 0; mat < 3; ++mat) {
      const int col = mat * 512 + hd * 128 + 2 * c2;
      float wa[4], wb[4];
#pragma unroll
      for (int j = 0; j < 4; ++j) { wa[j] = p.conv_w[j * 1536 + col]; wb[j] = p.conv_w[j * 1536 + col + 1]; }
      float xa[3], xb[3];
#pragma unroll
      for (int j = 0; j < 3; ++j) {
        const int pos = n * 64 + rbase - 3 + j;
        const unsigned v = (pos >= 0) ? raw[mat][j] : 0u;
        xa[j] = bf_lo(v); xb[j] = bf_hi(v);
      }
      u16* dst = (mat == 0 ? Qs : (mat == 1 ? Ks : Vs));
#pragma unroll
      for (int i = 0; i < 16; ++i) {
        const unsigned v = raw[mat][3 + i];
        const float a3 = bf_lo(v), b3 = bf_hi(v);
        const float ya = wa[0] * xa[0] + wa[1] * xa[1] + wa[2] * xa[2] + wa[3] * a3;
        const float yb = wb[0] * xb[0] + wb[1] * xb[1] + wb[2] * xb[2] + wb[3] * b3;
        xa[0] = xa[1]; xa[1] = xa[2]; xa[2] = a3; xb[0] = xb[1]; xb[1] = xb[2]; xb[2] = b3;
        *(unsigned*)(dst + (rbase + i) * 136 + 2 * c2) = pk_bf16(silu_f(ya), silu_f(yb));
      }
    }
  }
  __syncthreads();
  if (wv == 0) {
    const int row = t0 + lane;
    const float bl = hb[(size_t)row * 8 + hd], al = hb[(size_t)row * 8 + 4 + hd];
    const float xx = al + p.dt_bias[hd];
    const float ee = __expf(-fabsf(xx));
    const float sp = fmaxf(xx, 0.f) + ((ee < 1e-3f) ? ee * (1.f - 0.5f * ee) : __logf(1.f + ee));
    float gg = -__expf(p.a_log[hd]) * sp;
#pragma unroll
    for (int o = 1; o < 64; o <<= 1) { const float t = __uint_as_float((unsigned)__builtin_amdgcn_ds_bpermute(((lane - o) & 63) << 2, (int)__float_as_uint(gg))); if (lane >= o) gg += t; }
    sm_beta[lane] = rcp_f(1.0f + __expf(-bl)); sm_gc[lane] = gg;
  } else if (wv <= 2) {
    const int r = tid - 64;
    const u16* src = (r < 64) ? (Qs + r * 136) : (Ks + (r - 64) * 136);
    float ss = 0.f;
#pragma unroll
    for (int c = 0; c < 16; ++c) {
      const u32x4 v = *(const u32x4*)(src + c * 8);
#pragma unroll
      for (int j = 0; j < 4; ++j) { const float a = bf_lo(v[j]), bb = bf_hi(v[j]); ss += a * a + bb * bb; }
    }
    const float rs = rsqrtf(ss + 1e-6f);
    if (r < 64) sm_rq[r] = rs; else sm_rk[r - 64] = rs;
  }
  __syncthreads();
  if (tid < 64) {
    const float gc = sm_gc[tid], gl = sm_gc[63], eg = __expf(gc);
    sm_fw[tid] = sm_beta[tid] * eg * sm_rk[tid];
    sm_fq[tid] = sm_rq[tid] * 0.08838834764831845f * eg;
    sm_fk[tid] = sm_rk[tid] * __expf(gl - gc);
    if (tid == 0) ((float*)(p.ws + OFF_DEC))[item] = __expf(gl);
  }
  {
    bf16x8 kfi[4], qfi[4];
#pragma unroll
    for (int s = 0; s < 4; ++s) {
      kfi[s] = *(const bf16x8*)(Ks + (16 * wv + r16) * 136 + 32 * s + 8 * g);
      qfi[s] = *(const bf16x8*)(Qs + (16 * wv + r16) * 136 + 32 * s + 8 * g);
    }
    f32x4 at[4];
#pragma unroll
    for (int jt = 0; jt < 4; ++jt) {
      at[jt] = (f32x4){0.f, 0.f, 0.f, 0.f};
      if (jt <= wv) {
        f32x4 la = (f32x4){0.f, 0.f, 0.f, 0.f}, aa = (f32x4){0.f, 0.f, 0.f, 0.f};
#pragma unroll
        for (int s = 0; s < 4; ++s) {
          const bf16x8 kfj = *(const bf16x8*)(Ks + (16 * jt + r16) * 136 + 32 * s + 8 * g);
          la = mfma16(kfi[s], kfj, la);
          aa = mfma16(kfj, qfi[s], aa);
        }
#pragma unroll
        for (int r = 0; r < 4; ++r) {
          { const int i = 16 * wv + 4 * g + r, j = 16 * jt + r16;
            const float v = (i > j) ? sm_beta[i] * sm_rk[i] * sm_rk[j] * __expf(sm_gc[i] - sm_gc[j]) * la[r] : 0.f;
            Lm[i * 68 + j] = v; }
          { const int j = 16 * jt + 4 * g + r, i = 16 * wv + r16;
            at[jt][r] = (j <= i) ? sm_rq[i] * sm_rk[j] * 0.08838834764831845f * __expf(sm_gc[i] - sm_gc[j]) * aa[r] : 0.f; }
        }
      }
    }
#pragma unroll
    for (int s2 = 0; s2 < 2; ++s2)
      *(bf16x8*)(op + 32768 + (size_t)((wv * 2 + s2) * 64 + lane) * 16) = pack8(at[2 * s2], at[2 * s2 + 1]);
  }
  __syncthreads();
  f32x2_t xv[64];
  if (wv < 2) {
#pragma unroll
    for (int i = 0; i < 64; ++i) { xv[i].x = sm_beta[i] * bf2f(Vs[i * 136 + tid]); xv[i].y = sm_fw[i] * bf2f(Ks[i * 136 + tid]); }
    solve_rows2<1>(xv, Lm, lane, Lm[68 + lane]);
    const int sl = tid >> 4, dvl = tid & 15;
#pragma unroll
    for (int mt = 0; mt < 4; ++mt)
#pragma unroll
      for (int gg = 0; gg < 4; ++gg) {
        u32x2 w; w.x = pk_bf16(xv[16 * mt + 4 * gg].x, xv[16 * mt + 4 * gg + 1].x); w.y = pk_bf16(xv[16 * mt + 4 * gg + 2].x, xv[16 * mt + 4 * gg + 3].x);
        *(u32x2*)(op + 57344 + (size_t)((sl * 4 + mt) * 64 + gg * 16 + dvl) * 8) = w;
      }
  } else {
    const int t2 = tid - 128;
#pragma unroll 2
    for (int f = 0; f < 8; ++f) {
      const int e = t2 + 128 * f, frag = e >> 6, ln = e & 63, lr = ln & 15, lg = ln >> 4;
      {
        const int mt = frag >> 2, sx = frag & 3, row = 16 * mt + lr;
        const u32x2 ql = *(const u32x2*)(Qs + row * 136 + 32 * sx + 4 * lg), qh = *(const u32x2*)(Qs + row * 136 + 32 * sx + 16 + 4 * lg);
        const float fq = sm_fq[row];
        u32x4 w;
        w.x = pk_bf16(bf_lo(ql.x) * fq, bf_hi(ql.x) * fq); w.y = pk_bf16(bf_lo(ql.y) * fq, bf_hi(ql.y) * fq);
        w.z = pk_bf16(bf_lo(qh.x) * fq, bf_hi(qh.x) * fq); w.w = pk_bf16(bf_lo(qh.y) * fq, bf_hi(qh.y) * fq);
        *(u32x4*)(op + 16384 + (size_t)e * 16) = w;
      }
      {
        const int mt8 = frag >> 1, s2 = frag & 1, dk = 16 * mt8 + lr;
        float v[8];
#pragma unroll
        for (int j = 0; j < 8; ++j) {
          const int pos = 32 * s2 + 16 * (j >> 2) + 4 * lg + (j & 3);
          v[j] = bf2f(Ks[pos * 136 + dk]) * sm_fk[pos];
        }
        u32x4 w; w.x = pk_bf16(v[0], v[1]); w.y = pk_bf16(v[2], v[3]); w.z = pk_bf16(v[4], v[5]); w.w = pk_bf16(v[6], v[7]);
        *(u32x4*)(op + 40960 + (size_t)e * 16) = w;
      }
    }
  }
  __syncthreads();
  if (wv < 2) {
#pragma unroll
    for (int i = 0; i < 64; ++i) Vs[i * 136 + tid] = f2bf(-xv[i].y);
  }
  __syncthreads();
#pragma unroll
  for (int f = 0; f < 4; ++f) {
    const int e = tid + 256 * f, frag = e >> 6, ln = e & 63, lr = ln & 15, lg = ln >> 4;
    const int mt = frag >> 2, sx = frag & 3, row = 16 * mt + lr;
    const u32x2 lo = *(const u32x2*)(Vs + row * 136 + 32 * sx + 4 * lg), hi = *(const u32x2*)(Vs + row * 136 + 32 * sx + 16 + 4 * lg);
    *(u32x4*)(op + (size_t)e * 16) = (u32x4){lo.x, lo.y, hi.x, hi.y};
  }
}

struct ScanA { u32x4 wf[4]; u32x2 uf; float dec; };
struct ScanB { u32x4 qf[4], af[2], kf[4]; };

DI void scan_load_a(const Params& p, int wvs, ScanA& o, int b, int hd, int sl, int n, int q, int lane) {
  const int item = (b * 128 + n) * 4 + hd;
  const unsigned char* op = p.ws + OFF_SC + (size_t)item * OPB;
#pragma unroll
  for (int s = 0; s < 4; ++s) {
    o.wf[s] = *(const u32x4*)(op + (size_t)((q * 4 + s) * 64 + lane) * 16);
  }
  o.uf = *(const u32x2*)(op + 57344 + (size_t)((sl * 4 + q) * 64 + lane) * 8);
  o.dec = ((const float*)(p.ws + OFF_DEC))[item];
}
DI void scan_load_b(const Params& p, int wvs, ScanB& o, int b, int hd, int n, int q, int lane) {
  const int item = (b * 128 + n) * 4 + hd;
  const unsigned char* op = p.ws + OFF_SC + (size_t)item * OPB;
#pragma unroll
  for (int s = 0; s < 4; ++s) o.qf[s] = *(const u32x4*)(op + 16384 + (size_t)((q * 4 + s) * 64 + lane) * 16);
#pragma unroll
  for (int s2 = 0; s2 < 2; ++s2) o.af[s2] = *(const u32x4*)(op + 32768 + (size_t)((q * 2 + s2) * 64 + lane) * 16);
#pragma unroll
  for (int j = 0; j < 4; ++j) o.kf[j] = *(const u32x4*)(op + 40960 + (size_t)((q * 4 + j) * 64 + lane) * 16);
}

DI void scan_step(const Params& p, int wvs, const ScanA& o, const ScanB& ob, f32x4 (&S)[2], int b, int hd, int sl, int n, int q, int lane, unsigned char* smem) {
  const int r16 = lane & 15, g = lane >> 4;
  u32x4* ldsS = (u32x4*)smem;
  u32x2* ldsV = (u32x2*)(smem + 4096);
  ldsS[q * 64 + lane] = __builtin_bit_cast(u32x4, pack8(S[0], S[1]));
  __syncthreads();
  bf16x8 Sb[4];
#pragma unroll
  for (int s = 0; s < 4; ++s) Sb[s] = as_bf8(ldsS[s * 64 + lane]);
  f32x4 vn = (f32x4){bf_lo(o.uf.x), bf_hi(o.uf.x), bf_lo(o.uf.y), bf_hi(o.uf.y)};
#pragma unroll
  for (int s = 0; s < 4; ++s) vn = mfma16(as_bf8(o.wf[s]), Sb[s], vn);
  { u32x2 w; w.x = pk_bf16(vn[0], vn[1]); w.y = pk_bf16(vn[2], vn[3]); ldsV[((q >> 1) * 64 + lane) * 2 + (q & 1)] = w; }
  f32x4 oa = (f32x4){0.f, 0.f, 0.f, 0.f};
#pragma unroll
  for (int s = 0; s < 4; ++s) oa = mfma16(as_bf8(ob.qf[s]), Sb[s], oa);
  __syncthreads();
  bf16x8 Vb[2];
#pragma unroll
  for (int s2 = 0; s2 < 2; ++s2) Vb[s2] = as_bf8(*(const u32x4*)(ldsV + (s2 * 64 + lane) * 2));
#pragma unroll
  for (int s2 = 0; s2 < 2; ++s2) oa = mfma16(as_bf8(ob.af[s2]), Vb[s2], oa);
  u16* h = (u16*)(p.ws + OFF_H);
  const int t0 = b * SEQ + n * 64;
#pragma unroll
  for (int r = 0; r < 4; ++r) h[(size_t)(t0 + 16 * q + 4 * g + r) * NC + hd * 128 + 16 * sl + r16] = f2bf(oa[r]);
#pragma unroll
  for (int t = 0; t < 2; ++t) {
    S[t] = S[t] * o.dec;
#pragma unroll
    for (int s2 = 0; s2 < 2; ++s2) S[t] = mfma16(as_bf8(ob.kf[t * 2 + s2]), Vb[s2], S[t]);
  }
}

DI void scan_chain(const Params& p, int wvs, int pair, int sl, unsigned char* smem) {
  const int tid0 = opaque_tid(); const int lane = tid0 & 63, q = tid0 >> 6;
  const int b = pair >> 2, hd = pair & 3;
  f32x4 S[2]; S[0] = (f32x4){0.f, 0.f, 0.f, 0.f}; S[1] = S[0];
  ScanA a0, a1, a2; ScanB bc, bn;
  __syncthreads();
  scan_load_a(p, wvs, a0, b, hd, sl, 0, q, lane);
  scan_load_b(p, wvs, bc, b, hd, 0, q, lane);
  scan_load_a(p, wvs, a1, b, hd, sl, 1, q, lane);
#pragma unroll 1
  for (int n = 0; n < 129; n += 3) {
    if (n + 2 < 128) scan_load_a(p, wvs, a2, b, hd, sl, n + 2, q, lane);
    if (n + 1 < 128) scan_load_b(p, wvs, bn, b, hd, n + 1, q, lane);
    if (n < 128) scan_step(p, wvs, a0, bc, S, b, hd, sl, n, q, lane, smem);
    bc = bn;
    if (n + 3 < 128) scan_load_a(p, wvs, a0, b, hd, sl, n + 3, q, lane);
    if (n + 2 < 128) scan_load_b(p, wvs, bn, b, hd, n + 2, q, lane);
    if (n + 1 < 128) scan_step(p, wvs, a1, bc, S, b, hd, sl, n + 1, q, lane, smem);
    bc = bn;
    if (n + 4 < 128) scan_load_a(p, wvs, a1, b, hd, sl, n + 4, q, lane);
    if (n + 3 < 128) scan_load_b(p, wvs, bn, b, hd, n + 3, q, lane);
    if (n + 2 < 128) scan_step(p, wvs, a2, bc, S, b, hd, sl, n + 2, q, lane, smem);
    bc = bn;
  }
}

DI void swa_item(const Params& p, int wvs, int item, bool valid, unsigned char* smem) {
  if (!valid) { __syncthreads(); __syncthreads(); return; }
  const int tid_ = opaque_tid();
  const int tid = tid_, lane = tid & 63, wv = tid >> 6, r16 = lane & 15, g = lane >> 4;
  const int qt = item & 127, kvh = (item >> 7) & 1, b = item >> 8;
  const int kp0 = 64 * qt - 128;
  u16* Ksm = (u16*)smem;
  u16* Vt = (u16*)(smem + 27648);
  u16* h = (u16*)(p.ws + OFF_H);
  const float* rc = (const float*)(p.ws + OFF_ROPE); const float* rs = rc + 8192 * 8;
  __syncthreads();
  if (tid < 192) {
    const int kk = tid, pos = kp0 + kk;
    u32x4 lo = (u32x4){0, 0, 0, 0}, hi = lo;
    if (pos >= 0) {
      const u16* src = h + (size_t)(b * SEQ + pos) * NC + C_SWK + kvh * 64;
      const u32x4 a = *(const u32x4*)src, c = *(const u32x4*)(src + 8);
      const f32x4 c0 = *(const f32x4*)(rc + pos * 8), c1 = *(const f32x4*)(rc + pos * 8 + 4);
      const f32x4 s0 = *(const f32x4*)(rs + pos * 8), s1 = *(const f32x4*)(rs + pos * 8 + 4);
      float t1[8], t2[8], cs[8], sn[8], o1[8], o2[8];
#pragma unroll
      for (int j = 0; j < 4; ++j) { t1[2 * j] = bf_lo(a[j]); t1[2 * j + 1] = bf_hi(a[j]); t2[2 * j] = bf_lo(c[j]); t2[2 * j + 1] = bf_hi(c[j]);
        cs[j] = c0[j]; cs[4 + j] = c1[j]; sn[j] = s0[j]; sn[4 + j] = s1[j]; }
#pragma unroll
      for (int j = 0; j < 8; ++j) { o1[j] = t1[j] * cs[j] - t2[j] * sn[j]; o2[j] = t2[j] * cs[j] + t1[j] * sn[j]; }
#pragma unroll
      for (int j = 0; j < 4; ++j) { lo[j] = pk_bf16(o1[2 * j], o1[2 * j + 1]); hi[j] = pk_bf16(o2[2 * j], o2[2 * j + 1]); }
    }
    *(u32x4*)(Ksm + kk * 72) = lo; *(u32x4*)(Ksm + kk * 72 + 8) = hi;
  }
  for (int e = tid; e < 192 * 6; e += 256) {
    const int kk = e / 6, ch = 2 + e % 6, pos = kp0 + kk;
    u32x4 v = (u32x4){0, 0, 0, 0};
    if (pos >= 0) v = *(const u32x4*)(h + (size_t)(b * SEQ + pos) * NC + C_SWK + kvh * 64 + ch * 8);
    *(u32x4*)(Ksm + kk * 72 + ch * 8) = v;
  }
  for (int e = tid; e < 192 * 8; e += 256) {
    const int kk = e >> 3, ch = e & 7, pos = kp0 + kk;
    u32x4 v = (u32x4){0, 0, 0, 0};
    if (pos >= 0) v = *(const u32x4*)(h + (size_t)(b * SEQ + pos) * NC + C_SWV + kvh * 64 + ch * 8);
#pragma unroll
    for (int j = 0; j < 4; ++j) { Vt[(ch * 8 + 2 * j) * 200 + kk] = (u16)(v[j] & 0xffffu); Vt[(ch * 8 + 2 * j + 1) * 200 + kk] = (u16)(v[j] >> 16); }
  }
  __syncthreads();
  const int st = wv, jt0 = st < 2 ? st : 2;
  const int qi = 16 * st + r16;
  const int qpos = 64 * qt + qi, tq = b * SEQ + qpos;
#pragma unroll 1
  for (int hq = 0; hq < 4; ++hq) {
    const int head = kvh * 4 + hq;
    u16* qsrc = h + (size_t)tq * NC + C_SWQ + head * 64;
    bf16x8 qf[2];
    {
      const u32x4 a = *(const u32x4*)qsrc, c = *(const u32x4*)(qsrc + 8);
      u32x4 w = *(const u32x4*)(qsrc + 8 * g);
      if (g < 2) {
        const f32x4 c0 = *(const f32x4*)(rc + qpos * 8), c1 = *(const f32x4*)(rc + qpos * 8 + 4);
        const f32x4 s0 = *(const f32x4*)(rs + qpos * 8), s1 = *(const f32x4*)(rs + qpos * 8 + 4);
        float t1[8], t2[8], cs[8], sn[8], o[8];
#pragma unroll
        for (int j = 0; j < 4; ++j) { t1[2 * j] = bf_lo(a[j]); t1[2 * j + 1] = bf_hi(a[j]); t2[2 * j] = bf_lo(c[j]); t2[2 * j + 1] = bf_hi(c[j]);
          cs[j] = c0[j]; cs[4 + j] = c1[j]; sn[j] = s0[j]; sn[4 + j] = s1[j]; }
#pragma unroll
        for (int j = 0; j < 8; ++j) o[j] = (g == 0) ? (t1[j] * cs[j] - t2[j] * sn[j]) : (t2[j] * cs[j] + t1[j] * sn[j]);
#pragma unroll
        for (int j = 0; j < 4; ++j) w[j] = pk_bf16(o[2 * j], o[2 * j + 1]);
      }
      qf[0] = as_bf8(w);
      qf[1] = as_bf8(*(const u32x4*)(qsrc + 32 + 8 * g));
    }
    f32x4 sc[10];
#pragma unroll
    for (int t = 0; t < 10; ++t) {
      sc[t] = (f32x4){0.f, 0.f, 0.f, 0.f};
#pragma unroll
      for (int s = 0; s < 2; ++s) {
        const bf16x8 kf = *(const bf16x8*)(Ksm + (16 * (jt0 + t) + r16) * 72 + 32 * s + 8 * g);
        sc[t] = mfma16(kf, qf[s], sc[t]);
      }
    }
    const float sink = p.sinks[head];
    float mx = sink;
#pragma unroll
    for (int t = 0; t < 10; ++t)
#pragma unroll
      for (int r = 0; r < 4; ++r) {
        const int kk = 16 * (jt0 + t) + 4 * g + r, d = kk - qi;
        const bool ok = (d >= 1) && (d <= 128) && (kp0 + kk >= 0);
        const float v = ok ? sc[t][r] * 0.125f : -1e30f;
        sc[t][r] = v; mx = fmaxf(mx, v);
      }
    mx = fmaxf(mx, shx(mx, 16, lane)); mx = fmaxf(mx, shx(mx, 32, lane));
    float sum = 0.f;
#pragma unroll
    for (int t = 0; t < 10; ++t)
#pragma unroll
      for (int r = 0; r < 4; ++r) { const float e = __expf(sc[t][r] - mx); sc[t][r] = e; sum += e; }
    sum += shx(sum, 16, lane); sum += shx(sum, 32, lane);
    const float inv = rcp_f(sum + __expf(sink - mx));
    f32x4 oacc[4];
#pragma unroll
    for (int dt = 0; dt < 4; ++dt) oacc[dt] = (f32x4){0.f, 0.f, 0.f, 0.f};
#pragma unroll
    for (int s2 = 0; s2 < 5; ++s2) {
      const bf16x8 pb = pack8(sc[2 * s2], sc[2 * s2 + 1]);
#pragma unroll
      for (int dt = 0; dt < 4; ++dt) {
        const u16* vr = Vt + (16 * dt + r16) * 200 + 16 * (jt0 + 2 * s2) + 4 * g;
        const u32x2 lo = *(const u32x2*)vr, hi = *(const u32x2*)(vr + 16);
        oacc[dt] = mfma16(as_bf8((u32x4){lo.x, lo.y, hi.x, hi.y}), pb, oacc[dt]);
      }
    }
#pragma unroll
    for (int dt = 0; dt < 4; ++dt) {
      const int dcol = head * 64 + 16 * dt + 4 * g;
      const u32x2 z = *(const u32x2*)(h + (size_t)tq * NC + C_SWZ + dcol);
      u32x2 w;
      w.x = pk_bf16(oacc[dt][0] * inv * silu_f(bf_lo(z.x)), oacc[dt][1] * inv * silu_f(bf_hi(z.x)));
      w.y = pk_bf16(oacc[dt][2] * inv * silu_f(bf_lo(z.y)), oacc[dt][3] * inv * silu_f(bf_hi(z.y)));
      *(u32x2*)(h + (size_t)tq * NC + C_SWQ + dcol) = w;
    }
  }
}

DI void phase_ya(const Params& p, int wvs) {
  u16* h = (u16*)(p.ws + OFF_H);
  const int ltid = opaque_tid(), lane = ltid & 63;
  const size_t gt = (size_t)blockIdx.x * 512 + ltid, gs = (size_t)gridDim.x * 512;
  const float* nwp = p.dn_norm_w + (ltid & 15) * 8;
  const f32x4 nw0 = *(const f32x4*)nwp, nw1 = *(const f32x4*)(nwp + 4);
  for (size_t i0 = gt; i0 < (size_t)T_TOK * 64; i0 += 4 * gs) {
    u32x4 v[4], z[4];
#pragma unroll
    for (int k = 0; k < 4; ++k) {
      const size_t i = i0 + k * gs;
      if (i < (size_t)T_TOK * 64) {
        const u16* ptr = h + (size_t)(i >> 6) * NC + (i & 63) * 8;
        v[k] = *(const u32x4*)ptr; z[k] = *(const u32x4*)(ptr + C_DNZ);
      } else { v[k] = (u32x4){0, 0, 0, 0}; z[k] = v[k]; }
    }
#pragma unroll
    for (int k = 0; k < 4; ++k) {
      const size_t i = i0 + k * gs;
      float o[8]; float ss = 0.f;
#pragma unroll
      for (int j = 0; j < 4; ++j) { o[2 * j] = bf_lo(v[k][j]); o[2 * j + 1] = bf_hi(v[k][j]); }
#pragma unroll
      for (int j = 0; j < 8; ++j) ss += o[j] * o[j];
      ss += shx(ss, 1, lane); ss += shx(ss, 2, lane); ss += shx(ss, 4, lane); ss += shx(ss, 8, lane);
      const float rs = rsqrtf(ss * (1.0f / 128.0f) + 1e-6f);
      float y[8];
#pragma unroll
      for (int j = 0; j < 4; ++j) {
        const float w0 = (j < 2) ? nw0[2 * j] : nw1[2 * j - 4], w1 = (j < 2) ? nw0[2 * j + 1] : nw1[2 * j - 3];
        y[2 * j] = o[2 * j] * rs * w0 * silu_f(bf_lo(z[k][j]));
        y[2 * j + 1] = o[2 * j + 1] * rs * w1 * silu_f(bf_hi(z[k][j]));
      }
      u32x4 w; w.x = pk_bf16(y[0], y[1]); w.y = pk_bf16(y[2], y[3]); w.z = pk_bf16(y[4], y[5]); w.w = pk_bf16(y[6], y[7]);
      if (i < (size_t)T_TOK * 64) *(u32x4*)(h + (size_t)(i >> 6) * NC + (i & 63) * 8) = w;
    }
  }
}

DI void phase4(const Params& p, int wvs, int vb, int nvb, unsigned char* smem) {
  const int xcd = vb & 7, lb = vb >> 3, nlb = nvb >> 3;
  const u16* h = (const u16*)(p.ws + OFF_H);
  const u16* wat = (const u16*)(p.ws + OFF_WAT);
  const u16* wbt = (const u16*)(p.ws + OFF_WBT);
  u16* mg = (u16*)(p.ws + OFF_SC);
  const int tid0 = opaque_tid(); const int lane = tid0 & 63, wv = tid0 >> 6, wm = wv >> 1, wn = wv & 1, r16 = lane & 15, g = lane >> 4;
  for (int li = lb;; li += nlb) {
    int mt, nt; if (!tile_of(li, 4, xcd, mt, nt)) break;
    f32x4 acc[4][8]; zero_acc(acc);
    gemm_kloop(p, wvs, h, NC, wat, 512, 16, mt * 128, nt * 256, acc, smem);
#pragma unroll
    for (int mi = 0; mi < 4; ++mi) {
      const int row = mt * 128 + wm * 64 + mi * 16 + r16;
#pragma unroll
      for (int ni = 0; ni < 8; ++ni) {
        const int col = nt * 256 + wn * 128 + ni * 16 + 4 * g;
        const u32x2 ga = *(const u32x2*)(h + (size_t)row * NC + C_GA + col), gb = *(const u32x2*)(h + (size_t)row * NC + C_GB + col);
        acc[mi][ni][0] *= (1.f + __expf(-bf_lo(gb.x))) * rcp_f(1.f + __expf(-bf_lo(ga.x)));
        acc[mi][ni][1] *= (1.f + __expf(-bf_hi(gb.x))) * rcp_f(1.f + __expf(-bf_hi(ga.x)));
        acc[mi][ni][2] *= (1.f + __expf(-bf_lo(gb.y))) * rcp_f(1.f + __expf(-bf_lo(ga.y)));
        acc[mi][ni][3] *= (1.f + __expf(-bf_hi(gb.y))) * rcp_f(1.f + __expf(-bf_hi(ga.y)));
      }
      if (mi & 1) __builtin_amdgcn_sched_barrier(0);
    }
    gemm_kloop(p, wvs, h + C_SWQ, NC, wbt, 512, 16, mt * 128, nt * 256, acc, smem);
#pragma unroll
    for (int mi = 0; mi < 4; ++mi) {
      const int row = mt * 128 + wm * 64 + mi * 16 + r16;
#pragma unroll
      for (int ni = 0; ni < 8; ++ni) {
        const int col = nt * 256 + wn * 128 + ni * 16 + 4 * g;
        const u32x2 gb = *(const u32x2*)(h + (size_t)row * NC + C_GB + col);
        u32x2 w;
        w.x = pk_bf16(acc[mi][ni][0] * sigmoid_f(bf_lo(gb.x)), acc[mi][ni][1] * sigmoid_f(bf_hi(gb.x)));
        w.y = pk_bf16(acc[mi][ni][2] * sigmoid_f(bf_lo(gb.y)), acc[mi][ni][3] * sigmoid_f(bf_hi(gb.y)));
        *(u32x2*)(mg + (size_t)row * 1024 + col) = w;
      }
      if (mi & 1) __builtin_amdgcn_sched_barrier(0);
    }
  }
}

DI void phase5(const Params& p, int wvs, unsigned char* smem) {
  const int xcd = blockIdx.x & 7, lb = blockIdx.x >> 3, nlb = gridDim.x >> 3;
  const u16* mg = (const u16*)(p.ws + OFF_SC);
  const u16* wot = (const u16*)(p.ws + OFF_WOT);
  const int tid0 = opaque_tid(); const int lane = tid0 & 63, wv = tid0 >> 6, wm = wv >> 1, wn = wv & 1, r16 = lane & 15, g = lane >> 4;
  for (int li = lb;; li += nlb) {
    int mt, nt; if (!tile_of(li, 4, xcd, mt, nt)) break;
    f32x4 acc[4][8]; zero_acc(acc);
    gemm_kloop(p, wvs, mg, 1024, wot, 1024, 32, mt * 128, nt * 256, acc, smem);
#pragma unroll
    for (int mi = 0; mi < 4; ++mi) {
      const int row = mt * 128 + wm * 64 + mi * 16 + r16;
#pragma unroll
      for (int ni = 0; ni < 8; ++ni) {
        const int col = nt * 256 + wn * 128 + ni * 16 + 4 * g;
        const f32x4 xv = *(const f32x4*)(p.x + (size_t)row * 1024 + col);
        *(f32x4*)(p.out + (size_t)row * 1024 + col) = xv * 1.189207115002721f + acc[mi][ni];
      }
    }
  }
}

DI float wave_sum(float v, int lane) {
#pragma unroll
  for (int o = 32; o > 0; o >>= 1) v += shx(v, o, lane);
  return v;
}
DI void phase6(const Params& p, int wvs, unsigned char* smem) {
  const int tid = opaque_tid(), lane = tid & 63, wv = tid >> 6;
  f32x4 gm[4], bt[4];
#pragma unroll
  for (int j = 0; j < 4; ++j) { gm[j] = *(const f32x4*)(p.ln_g + 4 * (lane + 64 * j)); bt[j] = *(const f32x4*)(p.ln_b + 4 * (lane + 64 * j)); }
  const int xcd6 = blockIdx.x & 7, lb6 = blockIdx.x >> 3, nlb6 = gridDim.x >> 3;
  for (int lr = (lb6 * 8 + wv) * 2; lr < 4096; lr += nlb6 * 16) {
    float* r0 = p.out + (size_t)(4096 * xcd6 + (4095 - lr)) * 1024;
    float* r1 = p.out + (size_t)(4096 * xcd6 + (4094 - lr)) * 1024;
    f32x4 a[4], b[4];
#pragma unroll
    for (int j = 0; j < 4; ++j) { a[j] = *(const f32x4*)(r0 + 4 * (lane + 64 * j)); b[j] = *(const f32x4*)(r1 + 4 * (lane + 64 * j)); }
    float sa = 0.f, sb = 0.f;
#pragma unroll
    for (int j = 0; j < 4; ++j) { sa += (a[j][0] + a[j][1]) + (a[j][2] + a[j][3]); sb += (b[j][0] + b[j][1]) + (b[j][2] + b[j][3]); }
    const float ma = wave_sum(sa, lane) * (1.0f / 1024.0f), mb = wave_sum(sb, lane) * (1.0f / 1024.0f);
    float qa = 0.f, qb = 0.f;
#pragma unroll
    for (int j = 0; j < 4; ++j) {
      a[j] = a[j] - ma; b[j] = b[j] - mb;
      qa += (a[j][0] * a[j][0] + a[j][1] * a[j][1]) + (a[j][2] * a[j][2] + a[j][3] * a[j][3]);
      qb += (b[j][0] * b[j][0] + b[j][1] * b[j][1]) + (b[j][2] * b[j][2] + b[j][3] * b[j][3]);
    }
    const float ra = rsqrtf(wave_sum(qa, lane) * (1.0f / 1024.0f) + 1e-5f), rb = rsqrtf(wave_sum(qb, lane) * (1.0f / 1024.0f) + 1e-5f);
#pragma unroll
    for (int j = 0; j < 4; ++j) {
      *(f32x4*)(r0 + 4 * (lane + 64 * j)) = a[j] * ra * gm[j] + bt[j];
      *(f32x4*)(r1 + 4 * (lane + 64 * j)) = b[j] * rb * gm[j] + bt[j];
    }
  }
}

#define XB_TMO      128
#define XB_XCNT(j)  (256  + 64 * (j))
#define XB_XSUB(j)  (1280 + 64 * (j))
#define XB_XGEN(j)  (2304 + 64 * (j))
#define XB_TOP      3328
#define XB_TOPGEN   3392
#define XCD_BAR_WORDS 3456
#define XB_SPIN_CAP (1u << 22)
#define LAS __attribute__((address_space(3)))
DI unsigned xb_ld(unsigned* p) { return __hip_atomic_load(p, __ATOMIC_RELAXED, __HIP_MEMORY_SCOPE_AGENT); }
DI unsigned xb_add(unsigned* p, unsigned v) { return __hip_atomic_fetch_add(p, v, __ATOMIC_RELAXED, __HIP_MEMORY_SCOPE_AGENT); }
DI unsigned xb_xcc_id() { return (unsigned)__builtin_amdgcn_s_getreg((3 << 11) | 20) & 0xFu; }
#define XB_SPIN(cond, bar) do { unsigned _sp = 0; while (cond) { __builtin_amdgcn_s_sleep(1); \
    if ((++_sp & 255u) == 0u) { if (xb_ld(&(bar)[XB_TMO])) break; if (_sp > XB_SPIN_CAP) { atomicAdd(&(bar)[XB_TMO], 1u); break; } } } } while (0)
struct XcdBarrier { unsigned* bar; unsigned x; volatile LAS unsigned* st; };
DI bool xb_leader(int wvs) { return wvs == 0 && __builtin_amdgcn_mbcnt_hi(~0u, __builtin_amdgcn_mbcnt_lo(~0u, 0u)) == 0u; }
DI XcdBarrier xcd_barrier_post(unsigned* bar, volatile LAS unsigned* st, int wvs) {
  XcdBarrier b; b.bar = bar; b.x = xb_xcc_id(); b.st = st;
  if (xb_leader(wvs)) (void)xb_add(&bar[XB_XCNT(b.x)], 1u);
  return b;
}
DI void xcd_barrier_complete(unsigned* bar, unsigned x, unsigned& nloc, unsigned& nx) {
  const unsigned G = gridDim.x * gridDim.y * gridDim.z;
  unsigned sum, cnt, mine, sp = 0u;
  for (;;) {
    sum = 0u; cnt = 0u; mine = 0u;
#pragma unroll
    for (unsigned j = 0; j < 16; ++j) { const unsigned c = xb_ld(&bar[XB_XCNT(j)]); sum += c; cnt += (c > 0u) ? 1u : 0u; mine = (j == x) ? c : mine; }
    if (sum == G) break;
    __builtin_amdgcn_s_sleep(1);
    if ((++sp & 255u) == 0u) { if (xb_ld(&bar[XB_TMO])) break; if (sp > XB_SPIN_CAP) { atomicAdd(&bar[XB_TMO], 1u); break; } }
  }
  nloc = mine > 0u ? mine : 1u; nx = cnt > 0u ? cnt : 1u;
}
DI void xcd_barrier_(const XcdBarrier& b, int wvs) {
  asm volatile("s_waitcnt vmcnt(0)" ::: "memory");
  __syncthreads();
  if (xb_leader(wvs)) {
    unsigned* bar = b.bar;
    __builtin_amdgcn_s_waitcnt(0);
    unsigned nloc = b.st[0], nx = b.st[1];
    if (nloc == 0u) { xcd_barrier_complete(bar, b.x, nloc, nx); b.st[0] = nloc; b.st[1] = nx; }
    const unsigned old = xb_add(&bar[XB_XSUB(b.x)], 1u);
    const unsigned gen = old / nloc;
    if (old + 1u == (gen + 1u) * nloc) {
      __builtin_amdgcn_fence(__ATOMIC_RELEASE, "agent");
      asm volatile("s_waitcnt vmcnt(0)" ::: "memory");
      const unsigned og = xb_add(&bar[XB_TOP], 1u);
      const unsigned tg = og / nx;
      if (og + 1u == (tg + 1u) * nx) xb_add(&bar[XB_TOPGEN], 1u);
      else XB_SPIN(xb_ld(&bar[XB_TOPGEN]) == tg, bar);
      __builtin_amdgcn_fence(__ATOMIC_ACQUIRE, "agent");
      xb_add(&bar[XB_XGEN(b.x)], 1u);
      asm volatile("s_waitcnt vmcnt(0)" ::: "memory");
    } else {
      XB_SPIN(xb_ld(&bar[XB_XGEN(b.x)]) == gen, bar);
      __builtin_amdgcn_fence(__ATOMIC_ACQUIRE, "agent");
      asm volatile("s_waitcnt vmcnt(0)" ::: "memory");
    }
  }
  __syncthreads();
}

#define xcd_barrier(b) xcd_barrier_(b, w8)
namespace pg8 {
#define PG8_LAS __attribute__((address_space(3)))
typedef unsigned short bf16_t;
typedef short bf16x8 __attribute__((ext_vector_type(8)));
typedef float f32x4 __attribute__((ext_vector_type(4)));
typedef unsigned u32x4 __attribute__((ext_vector_type(4)));
constexpr int BM = 256, BK = 64, HALF = 128, HTB = HALF * BK * 2  , STAGE_BYTES = 8 * HTB, NXCD = 8, WGM = 8;

__host__ __device__ __forceinline__ int lds_byte(int r, int c) { const int st = (r >> 4) * 2 + (c >> 5), rr = r & 15, cc = c & 31, ob = rr * 64 + cc * 2; return st * 1024 + (ob ^ (((ob >> 9) & 1) << 5)); }
__host__ __device__ __forceinline__ void stage_rc(int b, int& R, int& C) { const int st = b / 1024, sb = b % 1024, swz = sb ^ (((sb >> 9) & 1) << 5); R = (st >> 1) * 16 + swz / 64; C = (st & 1) * 32 + (swz % 64) / 2; }
__host__ __device__ __forceinline__ int perm32(int rho) { const int n = rho >> 4, i = rho & 15; return 8 * (i >> 2) + 4 * n + (i & 3); }

struct Unit { int pm, pn; };
struct Gemm { const bf16_t* A; const bf16_t* Bt; int M, N, K; };

struct StaticOrder {
    int nM, nN, nwg, G, c;
    __host__ __device__ void init(int M, int N, int G_, int c_) { nM = M / BM; nN = N / BM; nwg = nM * nN; G = G_; c = c_; }
    __host__ __device__ bool next(int i, Unit& u) const {
        const long L = (long)i * G + c; if (L >= nwg) return false;
        int wgid = (int)L; { const int q = nwg / NXCD, r = nwg % NXCD, xcd = wgid % NXCD, off = wgid / NXCD; wgid = (xcd < r ? xcd * (q + 1) : r * (q + 1) + (xcd - r) * q) + off; }
        const int nig = WGM * nN, gid = wgid / nig, fm = gid * WGM, gsz = (nM - fm) < WGM ? (nM - fm) : WGM;
        u.pm = fm + ((wgid % nig) % gsz); u.pn = (wgid % nig) / gsz; return true;
    }
    __device__ __forceinline__ void a_ready(const Unit&) const {}
    __device__ __forceinline__ void done(const Unit&) const {}
};

template <class Epi, class Sched, bool ALIGN_EPI = false, bool SP2 = false>
__device__ __forceinline__ void gemm_phase(PG8_LAS unsigned char* lds, const Gemm g, const Sched& S, const Epi& E, const int tid) {
    const int wid = __builtin_amdgcn_readfirstlane(tid >> 6), lane = tid & 63, wr = wid >> 2, wc = wid & 3, fr = lane & 15, fq = lane >> 4;
    const int K = g.K, nt = K / BK;
    unsigned voffA[2], voffB[2];
#pragma unroll
    for (int i = 0; i < 2; ++i) { int R, C; stage_rc(tid * 16 + i * 8192, R, C); const int Rb = Epi::PERM ? ((R & ~31) + perm32(R & 31)) : R;
        voffA[i] = (unsigned)(R * K + C) * 2u; voffB[i] = (unsigned)(Rb * K + C) * 2u; }
    const size_t kstep = (size_t)(BK * 2);
    const size_t hstep = (size_t)HALF * K * 2;
    const size_t tstep = 2 * hstep;
    const unsigned ldsw = (unsigned)wid * 1024u;
    const int aoff = lds_byte(wr * 64 + fr, fq * 8), boff = lds_byte(wc * 32 + fr, fq * 8);
#define PG8_SA(b, h) (((b) * 2 + (h)) * HTB)
#define PG8_SB(b, h) ((4 + (b) * 2 + (h)) * HTB)
#define PG8_STAGE(bufoff, gbase, voff) do { _Pragma("unroll") for (int _i = 0; _i < 2; ++_i) \
        __builtin_amdgcn_global_load_lds((const unsigned*)((const char*)(gbase) + (voff)[_i]), (PG8_LAS unsigned*)(lds + (bufoff) + ldsw + _i * 8192), 16, 0, 0); } while (0)
#define PG8_LDA(dst, b, h) do { _Pragma("unroll") for (int m = 0; m < 4; ++m) _Pragma("unroll") for (int k = 0; k < 2; ++k) dst[m][k] = *(const PG8_LAS bf16x8*)(lds + PG8_SA(b, h) + aoff + m * 2048 + k * 1024); } while (0)
#define PG8_LDB(dst, b, h) do { _Pragma("unroll") for (int n = 0; n < 2; ++n) _Pragma("unroll") for (int k = 0; k < 2; ++k) dst[n][k] = *(const PG8_LAS bf16x8*)(lds + PG8_SB(b, h) + boff + n * 2048 + k * 1024); } while (0)
#define PG8_MMA(ai, bj, At, Bt) do { __builtin_amdgcn_s_setprio(1); _Pragma("unroll") for (int m = 0; m < 4; ++m) _Pragma("unroll") for (int n = 0; n < 2; ++n) _Pragma("unroll") for (int k = 0; k < 2; ++k) \
        acc[ai][bj][m][n] = __builtin_amdgcn_mfma_f32_16x16x32_bf16(Bt[n][k], At[m][k], acc[ai][bj][m][n], 0, 0, 0); __builtin_amdgcn_s_setprio(0); } while (0)
#define PG8_WAIT_V(n) asm volatile("s_waitcnt vmcnt(" #n ")" ::: "memory")
#define PG8_WAIT_L(n) asm volatile("s_waitcnt lgkmcnt(" #n ")" ::: "memory")
#define PG8_BAR __builtin_amdgcn_s_barrier()
#define PG8_SCHED __builtin_amdgcn_sched_barrier(0)
    Unit cur, nxt; int ui = 0;
    if (!S.next(0, cur)) return;
    f32x4 acc[2][2][4][2];
#pragma unroll
    for (int a = 0; a < 2; ++a)
#pragma unroll
        for (int b = 0; b < 2; ++b)
#pragma unroll
            for (int m = 0; m < 4; ++m)
#pragma unroll
                for (int n = 0; n < 2; ++n) acc[a][b][m][n] = (f32x4){0.f, 0.f, 0.f, 0.f};
    bf16x8 At[4][2], B0[2][2], B1[2][2];
    const char* cA = (const char*)g.A + (size_t)cur.pm * tstep; const char* cB = (const char*)g.Bt + (size_t)cur.pn * tstep;
    S.a_ready(cur);
    if constexpr (SP2) {
        PG8_STAGE(PG8_SB(0, 0), cB, voffB); PG8_STAGE(PG8_SB(0, 1), cB + hstep, voffB); PG8_STAGE(PG8_SA(0, 0), cA, voffA); PG8_STAGE(PG8_SA(0, 1), cA + hstep, voffA);
        if (wr == 1) PG8_BAR;
        PG8_WAIT_V(2); PG8_BAR;
        PG8_STAGE(PG8_SB(1, 0), cB + kstep, voffB); PG8_STAGE(PG8_SA(1, 0), cA + kstep, voffA); PG8_STAGE(PG8_SB(1, 1), cB + hstep + kstep, voffB);
        PG8_WAIT_V(6); PG8_BAR;
    } else {
        PG8_STAGE(PG8_SB(0, 0), cB, voffB); PG8_STAGE(PG8_SA(0, 0), cA, voffA); PG8_STAGE(PG8_SB(0, 1), cB + hstep, voffB); PG8_STAGE(PG8_SA(0, 1), cA + hstep, voffA);
        if (wr == 1) PG8_BAR;
        PG8_WAIT_V(4); PG8_BAR;
        PG8_STAGE(PG8_SB(1, 0), cB + kstep, voffB); PG8_STAGE(PG8_SA(1, 0), cA + kstep, voffA); PG8_STAGE(PG8_SB(1, 1), cB + hstep + kstep, voffB);
        PG8_WAIT_V(6); PG8_BAR;
    }
    for (;;) {
        const bool has_next = S.next(ui + 1, nxt);
        const char* nA = has_next ? (const char*)g.A + (size_t)nxt.pm * tstep : cA; const char* nB = has_next ? (const char*)g.Bt + (size_t)nxt.pn * tstep : cB;
        for (int t = 0; t < nt; t += 2) {
            const bool last = (t == nt - 2);
            const char* a1 = cA + (size_t)(t + 1) * kstep;
            const char* a2 = last ? nA : cA + (size_t)(t + 2) * kstep; const char* b2 = last ? nB : cB + (size_t)(t + 2) * kstep;
            const char* a3 = a2 + kstep; const char* b3 = b2 + kstep;
            if (last && has_next) S.a_ready(nxt);
            if constexpr (SP2) {
            PG8_LDB(B0, 0, 0); PG8_LDB(B1, 0, 1); PG8_SCHED; PG8_LDA(At, 0, 0); PG8_STAGE(PG8_SA(1, 1), a1 + hstep, voffA);
            PG8_WAIT_V(8); PG8_WAIT_L(0); PG8_BAR; PG8_MMA(0, 0, At, B0); PG8_MMA(0, 1, At, B1); PG8_BAR; PG8_SCHED;
            PG8_LDA(At, 0, 1); PG8_STAGE(PG8_SB(0, 0), b2, voffB); PG8_STAGE(PG8_SB(0, 1), b2 + hstep, voffB); PG8_STAGE(PG8_SA(0, 0), a2, voffA);
            PG8_WAIT_V(8); PG8_WAIT_L(0); PG8_BAR; PG8_MMA(1, 0, At, B0); PG8_MMA(1, 1, At, B1); PG8_BAR; PG8_SCHED;
            PG8_LDB(B0, 1, 0); PG8_LDB(B1, 1, 1); PG8_SCHED; PG8_LDA(At, 1, 0); PG8_STAGE(PG8_SA(0, 1), a2 + hstep, voffA);
            PG8_WAIT_V(8); PG8_WAIT_L(0); PG8_BAR; PG8_MMA(0, 0, At, B0); PG8_MMA(0, 1, At, B1); PG8_BAR; PG8_SCHED;
            PG8_LDA(At, 1, 1); PG8_STAGE(PG8_SB(1, 0), b3, voffB); PG8_STAGE(PG8_SB(1, 1), b3 + hstep, voffB); PG8_STAGE(PG8_SA(1, 0), a3, voffA);
            PG8_WAIT_V(8); PG8_WAIT_L(0); PG8_BAR; PG8_MMA(1, 0, At, B0); PG8_MMA(1, 1, At, B1); PG8_BAR; PG8_SCHED;
            } else {
            PG8_LDB(B0, 0, 0); PG8_SCHED; PG8_LDA(At, 0, 0); PG8_STAGE(PG8_SA(1, 1), a1 + hstep, voffA);
            PG8_WAIT_L(8); PG8_BAR; PG8_WAIT_L(0); PG8_MMA(0, 0, At, B0); PG8_BAR; PG8_SCHED;
            PG8_LDB(B1, 0, 1); PG8_STAGE(PG8_SB(0, 0), b2, voffB);
            PG8_BAR; PG8_WAIT_L(0); PG8_MMA(0, 1, At, B1); PG8_BAR;
            PG8_LDA(At, 0, 1); PG8_STAGE(PG8_SA(0, 0), a2, voffA);
            PG8_BAR; PG8_WAIT_L(0); PG8_MMA(1, 0, At, B0); PG8_BAR; PG8_SCHED;
            PG8_STAGE(PG8_SB(0, 1), b2 + hstep, voffB);
            PG8_WAIT_V(6); PG8_BAR; PG8_MMA(1, 1, At, B1); PG8_BAR;
            PG8_LDB(B0, 1, 0); PG8_SCHED; PG8_LDA(At, 1, 0); PG8_STAGE(PG8_SA(0, 1), a2 + hstep, voffA);
            PG8_WAIT_L(8); PG8_BAR; PG8_WAIT_L(0); PG8_MMA(0, 0, At, B0); PG8_BAR; PG8_SCHED;
            PG8_LDB(B1, 1, 1); PG8_STAGE(PG8_SB(1, 0), b3, voffB);
            PG8_BAR; PG8_WAIT_L(0); PG8_MMA(0, 1, At, B1); PG8_BAR;
            PG8_LDA(At, 1, 1); PG8_STAGE(PG8_SA(1, 0), a3, voffA);
            PG8_BAR; PG8_WAIT_L(0); PG8_MMA(1, 0, At, B0); PG8_BAR; PG8_SCHED;
            PG8_STAGE(PG8_SB(1, 1), b3 + hstep, voffB);
            PG8_WAIT_V(6); PG8_BAR; PG8_MMA(1, 1, At, B1); PG8_BAR;
            }
        }
        if constexpr (ALIGN_EPI) { if (wr == 0) PG8_BAR; }
        if constexpr (!Epi::AFTER_DRAIN) { E(acc, cur, wr, wc, fr, fq); S.done(cur); }
        if (!has_next) break;
#pragma unroll
        for (int a = 0; a < 2; ++a)
#pragma unroll
            for (int b = 0; b < 2; ++b)
#pragma unroll
                for (int m = 0; m < 4; ++m)
#pragma unroll
                    for (int n = 0; n < 2; ++n) acc[a][b][m][n] = (f32x4){0.f, 0.f, 0.f, 0.f};
        cur = nxt; cA = nA; cB = nB; ++ui;
        if constexpr (ALIGN_EPI) { if (wr == 1) PG8_BAR; }
    }
    PG8_WAIT_V(0);
    if constexpr (!ALIGN_EPI) { if (wr == 0) PG8_BAR; }
    PG8_BAR;
    if constexpr (Epi::AFTER_DRAIN) { E.fused(acc, cur, wr, wc, fr, fq, lds, wid, lane); S.done(cur); }
#undef PG8_SA
#undef PG8_SB
#undef PG8_STAGE
#undef PG8_LDA
#undef PG8_LDB
#undef PG8_MMA
#undef PG8_WAIT_V
#undef PG8_WAIT_L
#undef PG8_BAR
#undef PG8_SCHED
}
}

struct EpiInProj {
  static constexpr bool PERM = true, AFTER_DRAIN = false;
  u16* h;
  DI void operator()(const f32x4 (&acc)[2][2][4][2], const pg8::Unit& u, int wr, int wc, int fr, int fq) const {
    const int shift = (u.pn >= 8) ? 8 : 0;
#pragma unroll
    for (int ai = 0; ai < 2; ++ai)
#pragma unroll
      for (int m = 0; m < 4; ++m) {
        const int row = u.pm * 256 + ai * 128 + wr * 64 + m * 16 + fr;
#pragma unroll
        for (int bj = 0; bj < 2; ++bj) {
          const int col = u.pn * 256 + bj * 128 + wc * 32 + 8 * fq + shift;
          const f32x4 a = acc[ai][bj][m][0], b = acc[ai][bj][m][1];
          u32x4 w; w.x = pk_bf16(a[0], a[1]); w.y = pk_bf16(a[2], a[3]); w.z = pk_bf16(b[0], b[1]); w.w = pk_bf16(b[2], b[3]);
          *(u32x4*)(h + (size_t)row * NC + col) = w;
        }
      }
  }
};
struct EpiOut {
  static constexpr bool PERM = true, AFTER_DRAIN = false;
  const float* x; float* out;
  DI void operator()(const f32x4 (&acc)[2][2][4][2], const pg8::Unit& u, int wr, int wc, int fr, int fq) const {
#pragma unroll
    for (int ai = 0; ai < 2; ++ai)
#pragma unroll
      for (int m = 0; m < 4; ++m) {
        const int row = u.pm * 256 + ai * 128 + wr * 64 + m * 16 + fr;
#pragma unroll
        for (int bj = 0; bj < 2; ++bj) {
          const int col = u.pn * 256 + bj * 128 + wc * 32 + 8 * fq;
          const f32x4 x0 = *(const f32x4*)(x + (size_t)row * 1024 + col), x1 = *(const f32x4*)(x + (size_t)row * 1024 + col + 4);
          *(f32x4*)(out + (size_t)row * 1024 + col) = x0 * 1.189207115002721f + acc[ai][bj][m][0];
          *(f32x4*)(out + (size_t)row * 1024 + col + 4) = x1 * 1.189207115002721f + acc[ai][bj][m][1];
        }
      }
  }
};

#ifndef MK_MULTI
#define MK_MULTI 0
#endif
__global__ void __launch_bounds__(512, 2) fwd_megakernel(Params p) {
  cg::grid_group grid = cg::this_grid();
  __shared__ __attribute__((aligned(16))) unsigned char smem[SMEM_BYTES];
  const int w8 = __builtin_amdgcn_readfirstlane((int)(threadIdx.x >> 6));
  const int wvs = w8 & 3, half = w8 >> 2;
  unsigned char* hsm = smem + half * HALF_SMEM;
  const int vb = blockIdx.x + half * gridDim.x, nvb = 2 * gridDim.x;
  volatile LAS unsigned* st = (volatile LAS unsigned*)(smem + SMEM_BYTES - 16);
  { const int t0_ = opaque_tid(); if (t0_ < 4) st[t0_] = 0u; }
  __syncthreads();
  const XcdBarrier xb = xcd_barrier_post((unsigned*)(p.ws + OFF_BAR), st, w8);
  phase0(p, w8);
  if (p.ws == nullptr) grid.sync();
  xcd_barrier(xb);
  {
    pg8::Gemm g; g.A = (const pg8::bf16_t*)(p.ws + OFF_SC); g.Bt = (const pg8::bf16_t*)(p.ws + OFF_WINT); g.M = T_TOK; g.N = NCP; g.K = 1024;
    pg8::StaticOrder so; so.init(T_TOK, NCP, (int)gridDim.x, (int)blockIdx.x);
    EpiInProj e; e.h = (u16*)(p.ws + OFF_H);
    pg8::gemm_phase<EpiInProj, pg8::StaticOrder, true, true>((PG8_LAS unsigned char*)smem, g, so, e, opaque_tid_(w8));
  }
  xcd_barrier(xb);
  for (int it = vb; it < 2048; it += nvb) prep_item(p, wvs, it, hsm);
  xcd_barrier(xb);
  if (blockIdx.x < 128) {
    if (half == 0) { const int cb = (int)blockIdx.x; scan_chain(p, wvs, (cb & 7) + 8 * ((cb >> 3) >> 3), (cb >> 3) & 7, hsm); }
    else { __syncthreads(); for (int n = 0; n < 128; ++n) { __syncthreads(); __syncthreads(); } }
  } else {
    const int nsw = 2 * ((int)gridDim.x - 128), vbl = ((int)blockIdx.x - 128) + half * ((int)gridDim.x - 128);
    for (int k = 0; k * nsw < 1024; ++k) { const int it = vbl + k * nsw; swa_item(p, wvs, it < 1024 ? it : 0, it < 1024, hsm); }
  }
  xcd_barrier(xb);
  phase_ya(p, w8);
  xcd_barrier(xb);
  phase4(p, wvs, vb, nvb, hsm);
  xcd_barrier(xb);
  {
    pg8::Gemm g; g.A = (const pg8::bf16_t*)(p.ws + OFF_SC); g.Bt = (const pg8::bf16_t*)(p.ws + OFF_WOT); g.M = T_TOK; g.N = 1024; g.K = 1024;
    pg8::StaticOrder so; so.init(T_TOK, 1024, (int)gridDim.x, (int)blockIdx.x);
    EpiOut e; e.x = p.x; e.out = p.out;
    pg8::gemm_phase<EpiOut, pg8::StaticOrder, true, true>((PG8_LAS unsigned char*)smem, g, so, e, opaque_tid_(w8));
  }
  xcd_barrier(xb);
  phase6(p, w8, smem);
}

extern "C" void kernel_launch(void* const* d_in, const int* in_sizes, int n_in, void* d_out, int out_size,
                              void* d_ws, size_t ws_size, hipStream_t stream) {
  if (ws_size < WS_NEED) { fprintf(stderr, "workspace too small: %zu < %zu\n", ws_size, (size_t)WS_NEED); return; }
  Params p{};
  p.x = (const float*)d_in[0]; p.w_in = (const float*)d_in[1]; p.conv_w = (const float*)d_in[2]; p.a_log = (const float*)d_in[3];
  p.dt_bias = (const float*)d_in[4]; p.dn_norm_w = (const float*)d_in[5]; p.sinks = (const float*)d_in[6];
  p.w_branch = (const float*)d_in[7]; p.w_out = (const float*)d_in[8]; p.ln_g = (const float*)d_in[9]; p.ln_b = (const float*)d_in[10];
  p.out = (float*)d_out; p.ws = (unsigned char*)d_ws;
  for (int i = 0; i < 8; ++i) p.inv_freq[i] = (float)std::pow(500000.0, -(double)i / 8.0);
  static int grid_blocks = 0;
  if (!grid_blocks) {
    int dev = 0, cus = 0, per_cu = 0;
    (void)hipGetDevice(&dev);
    (void)hipDeviceGetAttribute(&cus, hipDeviceAttributeMultiprocessorCount, dev);
    (void)hipOccupancyMaxActiveBlocksPerMultiprocessor(&per_cu, fwd_megakernel, 512, 0);
    if (per_cu < 1) fprintf(stderr, "occupancy query reports %d workgroups per CU\n", per_cu);
    grid_blocks = cus > 256 ? 256 : cus;
    grid_blocks &= ~7;
  }
  (void)hipMemsetAsync(p.ws + OFF_BAR, 0, BAR_BYTES, stream);
  void* args[] = {&p};
  hipError_t e = hipLaunchCooperativeKernel((void*)fwd_megakernel, dim3(grid_blocks), dim3(512), args, 0, stream);
  if (e != hipSuccess) fprintf(stderr, "cooperative launch failed: %s (grid %d)\n", hipGetErrorString(e), grid_blocks);
}
```

```cpp
#include <hip/hip_runtime.h>
#include <hip/hip_cooperative_groups.h>
#include <cstdio>
#include <cmath>
namespace cg = cooperative_groups;

typedef unsigned short u16;
typedef short bf16x8 __attribute__((ext_vector_type(8)));
typedef float f32x4 __attribute__((ext_vector_type(4)));
typedef unsigned u32x4 __attribute__((ext_vector_type(4)));
typedef unsigned u32x2 __attribute__((ext_vector_type(2)));
#define DI __device__ __forceinline__
DI int opaque_tid_(int wave_s) { int t; asm volatile("v_mbcnt_lo_u32_b32 %0, -1, 0\n\tv_mbcnt_hi_u32_b32 %0, -1, %0" : "=v"(t)); return t + (wave_s << 6); }
#define opaque_tid() opaque_tid_(wvs)

constexpr int T_TOK = 32768, SEQ = 8192, DM = 1024, NC = 5384, NCP = 5376;
constexpr int C_DNZ = 1536, C_SWQ = 2056, C_SWK = 2568, C_SWV = 2696, C_SWZ = 2824, C_GA = 3336, C_GB = 4360;
constexpr size_t OFF_BAR = 0;
constexpr size_t BAR_BYTES = 16384;
constexpr size_t OFF_WINT = BAR_BYTES;
constexpr size_t OFF_WAT = OFF_WINT + (size_t)NCP * 1024 * 2;
constexpr size_t OFF_WBT = OFF_WAT + 1024 * 512 * 2;
constexpr size_t OFF_WOT = OFF_WBT + 1024 * 512 * 2;
constexpr size_t OFF_ROPE = OFF_WOT + 1024 * 1024 * 2;
constexpr size_t OFF_HB = OFF_ROPE + 2 * 8192 * 8 * 4;
constexpr size_t OFF_DEC = OFF_HB + (size_t)T_TOK * 8 * 4;
constexpr size_t OFF_H = OFF_DEC + 2048 * 4;
constexpr size_t OFF_SC = OFF_H + (size_t)T_TOK * NC * 2;
constexpr size_t OPB = 73728;
constexpr size_t WS_NEED = OFF_SC + 2048 * OPB;
constexpr int HALF_SMEM = 73728;
constexpr int SMEM_BYTES = 2 * HALF_SMEM + 16;

struct Params {
  const float *x, *w_in, *conv_w, *a_log, *dt_bias, *dn_norm_w, *sinks, *w_branch, *w_out, *ln_g, *ln_b;
  float* out; unsigned char* ws;
  float inv_freq[8];
};

typedef __bf16 bf16x2_t __attribute__((ext_vector_type(2)));
typedef float f32x2_t __attribute__((ext_vector_type(2)));
DI unsigned pk_bf16(float lo, float hi) { f32x2_t f = {lo, hi}; bf16x2_t v = __builtin_convertvector(f, bf16x2_t); return __builtin_bit_cast(unsigned, v); }
DI float bf_lo(unsigned u) { return __uint_as_float(u << 16); }
DI float bf_hi(unsigned u) { return __uint_as_float(u & 0xffff0000u); }
DI float bf2f(u16 v) { return __uint_as_float(((unsigned)v) << 16); }
DI u16 f2bf(float f) { return (u16)(pk_bf16(f, f) & 0xffffu); }
DI float shx(float v, int m, int lane) { return __uint_as_float((unsigned)__builtin_amdgcn_ds_bpermute((lane ^ m) << 2, (int)__float_as_uint(v))); }
DI float rcp_f(float y) { return __builtin_amdgcn_rcpf(y); }
DI float silu_f(float y) { return y * rcp_f(1.0f + __expf(-y)); }
DI float sigmoid_f(float y) { return rcp_f(1.0f + __expf(-y)); }
DI f32x4 mfma16(bf16x8 a, bf16x8 b, f32x4 c) { return __builtin_amdgcn_mfma_f32_16x16x32_bf16(a, b, c, 0, 0, 0); }
DI bf16x8 as_bf8(u32x4 v) { return __builtin_bit_cast(bf16x8, v); }
DI bf16x8 pack8(f32x4 a, f32x4 b) { u32x4 w; w.x = pk_bf16(a[0], a[1]); w.y = pk_bf16(a[2], a[3]); w.z = pk_bf16(b[0], b[1]); w.w = pk_bf16(b[2], b[3]); return as_bf8(w); }

DI void phase0(const Params& p, int wvs) {
  const size_t gt = (size_t)blockIdx.x * 512 + opaque_tid(), gs = (size_t)gridDim.x * 512;
  {
    const int ltid = (int)(gt & 511), lane = ltid & 63, wv = ltid >> 6;
    float wr[16][8];
#pragma unroll
    for (int j = 0; j < 4; ++j)
#pragma unroll
      for (int c = 0; c < 4; ++c) {
        const float* wp = p.w_in + (size_t)(4 * (lane + 64 * j) + c) * NC + 2048;
        const f32x4 a = *(const f32x4*)wp, b = *(const f32x4*)(wp + 4);
#pragma unroll
        for (int q = 0; q < 4; ++q) { wr[4 * j + c][q] = a[q]; wr[4 * j + c][4 + q] = b[q]; }
      }
    u16* xb = (u16*)(p.ws + OFF_SC);
    float* hb = (float*)(p.ws + OFF_HB);
    const int rstep = gridDim.x * 8;
    for (int row0 = blockIdx.x * 8 + wv; row0 < T_TOK; row0 += 2 * rstep) {
      f32x4 xr[2][4];
#pragma unroll
      for (int u = 0; u < 2; ++u) {
        const int row = row0 + u * rstep;
#pragma unroll
        for (int j = 0; j < 4; ++j) xr[u][j] = (row < T_TOK) ? *(const f32x4*)(p.x + (size_t)row * DM + 4 * (lane + 64 * j)) : (f32x4){0.f, 0.f, 0.f, 0.f};
      }
#pragma unroll
      for (int u = 0; u < 2; ++u) {
        const int row = row0 + u * rstep;
        float v[8];
#pragma unroll
        for (int q = 0; q < 8; ++q) v[q] = 0.f;
#pragma unroll
        for (int j = 0; j < 4; ++j) {
          const f32x4 xv = xr[u][j];
          u32x2 w; w.x = pk_bf16(xv[0], xv[1]); w.y = pk_bf16(xv[2], xv[3]);
          if (row < T_TOK) *(u32x2*)(xb + (size_t)row * DM + 4 * (lane + 64 * j)) = w;
#pragma unroll
          for (int c = 0; c < 4; ++c)
#pragma unroll
            for (int q = 0; q < 8; ++q) v[q] += xv[c] * wr[4 * j + c][q];
        }
        const bool up = (lane & 32) != 0;
        float k4[4];
#pragma unroll
        for (int i = 0; i < 4; ++i) { const float snd = up ? v[i] : v[i + 4]; const float kp = up ? v[i + 4] : v[i]; k4[i] = kp + shx(snd, 32, lane); }
        const bool up2 = (lane & 16) != 0;
        float k2[2];
#pragma unroll
        for (int i = 0; i < 2; ++i) { const float snd = up2 ? k4[i] : k4[i + 2]; const float kp = up2 ? k4[i + 2] : k4[i]; k2[i] = kp + shx(snd, 16, lane); }
        const bool up3 = (lane & 8) != 0;
        float k1 = (up3 ? k2[1] : k2[0]) + shx(up3 ? k2[0] : k2[1], 8, lane);
        k1 += shx(k1, 4, lane); k1 += shx(k1, 2, lane); k1 += shx(k1, 1, lane);
        if ((lane & 7) == 0 && row < T_TOK) hb[(size_t)row * 8 + (lane >> 3)] = k1;
      }
    }
  }
  {
    u32x4* wt = (u32x4*)(p.ws + OFF_WINT);
    for (size_t i = gt; i < (size_t)NCP * 128; i += gs) {
      const int kc = (int)(i / NCP), n = (int)(i % NCP);
      float v[8];
#pragma unroll
      for (int j = 0; j < 8; ++j) v[j] = p.w_in[(size_t)(kc * 8 + j) * NC + n + (n >= 2048 ? 8 : 0)];
      u32x4 w; w.x = pk_bf16(v[0], v[1]); w.y = pk_bf16(v[2], v[3]); w.z = pk_bf16(v[4], v[5]); w.w = pk_bf16(v[6], v[7]);
      wt[(size_t)n * 128 + kc] = w;
    }
  }
  {
    for (size_t i = gt; i < (size_t)2 * 1024 * 64; i += gs) {
      const int br = (int)(i / (1024 * 64)), rem = (int)(i % (1024 * 64)), kc = rem / 1024, n = rem % 1024;
      const float* src = p.w_branch + (size_t)br * 512 * 1024;
      float v[8];
#pragma unroll
      for (int j = 0; j < 8; ++j) v[j] = src[(size_t)(kc * 8 + j) * 1024 + n];
      u32x4 w; w.x = pk_bf16(v[0], v[1]); w.y = pk_bf16(v[2], v[3]); w.z = pk_bf16(v[4], v[5]); w.w = pk_bf16(v[6], v[7]);
      ((u32x4*)(p.ws + (br ? OFF_WBT : OFF_WAT)))[(size_t)n * 64 + kc] = w;
    }
  }
  {
    for (size_t i = gt; i < (size_t)1024 * 128; i += gs) {
      const int kc = (int)(i / 1024), n = (int)(i % 1024);
      float v[8];
#pragma unroll
      for (int j = 0; j < 8; ++j) v[j] = p.w_out[(size_t)(kc * 8 + j) * 1024 + n];
      u32x4 w; w.x = pk_bf16(v[0], v[1]); w.y = pk_bf16(v[2], v[3]); w.z = pk_bf16(v[4], v[5]); w.w = pk_bf16(v[6], v[7]);
      ((u32x4*)(p.ws + OFF_WOT))[(size_t)n * 128 + kc] = w;
    }
  }
  {
    float* rc = (float*)(p.ws + OFF_ROPE); float* rs = rc + 8192 * 8;
    for (size_t i = gt; i < 8192 * 8; i += gs) {
      const int t = (int)(i >> 3), f = (int)(i & 7);
      const float ang = (float)t * p.inv_freq[f];
      const double a = (double)ang;
      const double k = __builtin_rint(a * 0.15915494309189535);
      const float r = (float)(a - k * 6.283185307179586);
      rc[i] = cosf(r); rs[i] = sinf(r);
    }
  }
}

DI int lds_off32(int row, int chunk) { return row * 64 + ((chunk ^ ((0 - (row >> 2)) & 3)) << 4); }
constexpr int GSTAGE = 24576;

DI void gemm_kloop(const Params& p, int wvs, const u16* __restrict__ A, int lda, const u16* __restrict__ Bt, int ldb, int nk, int m0, int n0,
                   f32x4 (&acc)[4][8], unsigned char* smem) {
  const int tid = opaque_tid(), lane = tid & 63, wv = tid >> 6, wm = wv >> 1, wn = wv & 1, r16 = lane & 15, g = lane >> 4;
  const int prow = lane >> 2, pc = (lane & 3) ^ ((0 - (prow >> 2)) & 3);
  const u16* ap = A + (size_t)(m0 + 16 * wv + prow) * lda + pc * 8;
  const u16* bp = Bt + (size_t)(n0 + 16 * wv + prow) * ldb + pc * 8;
  unsigned char* lA = smem + wv * 1024;
  unsigned char* lB = smem + 8192 + wv * 1024;
#define GEMM_ISSUE(kt_, buf_) do { \
    _Pragma("unroll") for (int i_ = 0; i_ < 2; ++i_) \
      __builtin_amdgcn_global_load_lds((const unsigned*)(ap + (size_t)(64 * i_) * lda + (kt_) * 32), (unsigned*)(lA + (buf_) * GSTAGE + i_ * 4096), 16, 0, 0); \
    _Pragma("unroll") for (int i_ = 0; i_ < 4; ++i_) \
      __builtin_amdgcn_global_load_lds((const unsigned*)(bp + (size_t)(64 * i_) * ldb + (kt_) * 32), (unsigned*)(lB + (buf_) * GSTAGE + i_ * 4096), 16, 0, 0); \
  } while (0)
  GEMM_ISSUE(0, 0);
  GEMM_ISSUE(1, 1);
  asm volatile("s_waitcnt vmcnt(6)" ::: "memory");
  __builtin_amdgcn_s_barrier();
  int cb = 0;
  for (int kt = 0; kt < nk; ++kt) {
    int ib = cb + 2; if (ib >= 3) ib -= 3;
    const bool more = (kt + 2 < nk);
    if (more) GEMM_ISSUE(kt + 2, ib);
    const unsigned char* cur = smem + cb * GSTAGE;
    bf16x8 af[4], bfr[8];
#pragma unroll
    for (int i = 0; i < 4; ++i) af[i] = *(const bf16x8*)(cur + lds_off32(wm * 64 + i * 16 + r16, g));
#pragma unroll
    for (int i = 0; i < 8; ++i) bfr[i] = *(const bf16x8*)(cur + 8192 + lds_off32(wn * 128 + i * 16 + r16, g));
#pragma unroll
    for (int mi = 0; mi < 4; ++mi)
#pragma unroll
      for (int ni = 0; ni < 8; ++ni) acc[mi][ni] = mfma16(bfr[ni], af[mi], acc[mi][ni]);
    if (more) asm volatile("s_waitcnt vmcnt(6)" ::: "memory"); else asm volatile("s_waitcnt vmcnt(0)" ::: "memory");
    asm volatile("s_waitcnt lgkmcnt(0)" ::: "memory");
    __builtin_amdgcn_s_barrier();
    cb = cb + 1; if (cb >= 3) cb = 0;
  }
#undef GEMM_ISSUE
}

DI bool tile_of(int li, int ntn, int xcd, int& mt, int& nt) {
  if (li >= 32 * ntn) return false;
  const int grp = li / (8 * ntn), rem = li % (8 * ntn);
  nt = rem >> 3; mt = 32 * xcd + grp * 8 + (rem & 7);
  return true;
}

DI void zero_acc(f32x4 (&acc)[4][8]) {
#pragma unroll
  for (int i = 0; i < 4; ++i)
#pragma unroll
    for (int j = 0; j < 8; ++j) acc[i][j] = (f32x4){0.f, 0.f, 0.f, 0.f};
}

DI void phase1(const Params& p, int wvs, unsigned char* smem) {
  const int xcd = blockIdx.x & 7, lb = blockIdx.x >> 3, nlb = gridDim.x >> 3;
  const u16* xb = (const u16*)(p.ws + OFF_SC);
  const u16* wint = (const u16*)(p.ws + OFF_WINT);
  u16* h = (u16*)(p.ws + OFF_H);
  float* hb = (float*)(p.ws + OFF_HB);
  const int tid0 = opaque_tid(); const int lane = tid0 & 63, wv = tid0 >> 6, wm = wv >> 1, wn = wv & 1, r16 = lane & 15, g = lane >> 4;
  for (int li = lb;; li += nlb) {
    int mt, nt; if (!tile_of(li, 21, xcd, mt, nt)) break;
    f32x4 acc[4][8]; zero_acc(acc);
    gemm_kloop(p, wvs, xb, 1024, wint, 1024, 32, mt * 128, nt * 256, acc, smem);
#pragma unroll
    for (int mi = 0; mi < 4; ++mi) {
      const int row = mt * 128 + wm * 64 + mi * 16 + r16;
#pragma unroll
      for (int ni = 0; ni < 8; ++ni) {
        const int col = nt * 256 + wn * 128 + ni * 16 + 4 * g;
        {
          u32x2 w; w.x = pk_bf16(acc[mi][ni][0], acc[mi][ni][1]); w.y = pk_bf16(acc[mi][ni][2], acc[mi][ni][3]);
          *(u32x2*)(h + (size_t)row * NC + col + (nt >= 8 ? 8 : 0)) = w;
        }
      }
    }
  }
}

template <int I> DI void solve_rows2(f32x2_t (&xv)[64], const float* Lm, int lane, float lcur) {
  if constexpr (I < 64) {
    float lnx = 0.f;
    if constexpr (I + 1 < 64) lnx = Lm[(I + 1) * 68 + lane];
    f32x2_t a0 = xv[I], a1 = {0.f, 0.f}, a2 = {0.f, 0.f}, a3 = {0.f, 0.f};
#pragma unroll
    for (int m = 0; m < I; ++m) {
      const float l = __builtin_bit_cast(float, __builtin_amdgcn_readlane(__builtin_bit_cast(int, lcur), m));
      const f32x2_t lv = {l, l};
      if ((m & 3) == 0) a0 -= lv * xv[m];
      else if ((m & 3) == 1) a1 -= lv * xv[m];
      else if ((m & 3) == 2) a2 -= lv * xv[m];
      else a3 -= lv * xv[m];
    }
    xv[I] = (a0 + a1) + (a2 + a3);
    solve_rows2<I + 1>(xv, Lm, lane, lnx);
  }
}

DI void prep_item(const Params& p, int wvs, int item, unsigned char* smem) {
  const int tid_ = opaque_tid();
  const int tid = tid_, lane = tid & 63, wv = tid >> 6, r16 = lane & 15, g = lane >> 4;
  const int hd = item & 3, n = (item >> 2) & 127, b = item >> 9;
  const int t0 = b * SEQ + n * 64;
  u16* Qs = (u16*)smem; u16* Ks = Qs + 64 * 136; u16* Vs = Ks + 64 * 136;
  float* Lm = (float*)(smem + 52224);
  float* sm_beta = (float*)(smem + 69632);
  float* sm_gc = sm_beta + 64; float* sm_rq = sm_gc + 64; float* sm_rk = sm_rq + 64;
  float* sm_fw = sm_rk + 64; float* sm_fq = sm_fw + 64; float* sm_fk = sm_fq + 64;
  const u16* h = (const u16*)(p.ws + OFF_H);
  const float* hb = (const float*)(p.ws + OFF_HB);
  unsigned char* op = p.ws + OFF_SC + (size_t)item * OPB;
  __syncthreads();
  {
    const int c2 = tid & 63, rbase = (tid >> 6) * 16;
    unsigned raw[3][19];
#pragma unroll
    for (int mat = 0; mat < 3; ++mat) {
      const int col = mat * 512 + hd * 128 + 2 * c2;
#pragma unroll
      for (int j = 0; j < 19; ++j) {
        const int rr = t0 + rbase - 3 + j;
        raw[mat][j] = *(const unsigned*)(h + (size_t)(rr < 0 ? 0 : rr) * NC + col);
      }
    }
    __builtin_amdgcn_sched_barrier(0);
#pragma unroll
    for (int mat = 0; mat < 3; ++mat) {
      const int col = mat * 512 + hd * 128 + 2 * c2;
      float wa[4], wb[4];
#pragma unroll
      for (int j = 0; j < 4; ++j) { wa[j] = p.conv_w[j * 1536 + col]; wb[j] = p.conv_w[j * 1536 + col + 1]; }
      float xa[3], xb[3];
#pragma unroll
      for (int j = 0; j < 3; ++j) {
        const int pos = n * 64 + rbase - 3 + j;
        const unsigned v = (pos >= 0) ? raw[mat][j] : 0u;
        xa[j] = bf_lo(v); xb[j] = bf_hi(v);
      }
      u16* dst = (mat == 0 ? Qs : (mat == 1 ? Ks : Vs));
#pragma unroll
      for (int i = 0; i < 16; ++i) {
        const unsigned v = raw[mat][3 + i];
        const float a3 = bf_lo(v), b3 = bf_hi(v);
        const float ya = wa[0] * xa[0] + wa[1] * xa[1] + wa[2] * xa[2] + wa[3] * a3;
        const float yb = wb[0] * xb[0] + wb[1] * xb[1] + wb[2] * xb[2] + wb[3] * b3;
        xa[0] = xa[1]; xa[1] = xa[2]; xa[2] = a3; xb[0] = xb[1]; xb[1] = xb[2]; xb[2] = b3;
        *(unsigned*)(dst + (rbase + i) * 136 + 2 * c2) = pk_bf16(silu_f(ya), silu_f(yb));
      }
    }
  }
  __syncthreads();
  if (wv == 0) {
    const int row = t0 + lane;
    const float bl = hb[(size_t)row * 8 + hd], al = hb[(size_t)row * 8 + 4 + hd];
    const float xx = al + p.dt_bias[hd];
    const float ee = __expf(-fabsf(xx));
    const float sp = fmaxf(xx, 0.f) + ((ee < 1e-3f) ? ee * (1.f - 0.5f * ee) : __logf(1.f + ee));
    float gg = -__expf(p.a_log[hd]) * sp;
#pragma unroll
    for (int o = 1; o < 64; o <<= 1) { const float t = __uint_as_float((unsigned)__builtin_amdgcn_ds_bpermute(((lane - o) & 63) << 2, (int)__float_as_uint(gg))); if (lane >= o) gg += t; }
    sm_beta[lane] = rcp_f(1.0f + __expf(-bl)); sm_gc[lane] = gg;
  } else if (wv <= 2) {
    const int r = tid - 64;
    const u16* src = (r < 64) ? (Qs + r * 136) : (Ks + (r - 64) * 136);
    float ss = 0.f;
#pragma unroll
    for (int c = 0; c < 16; ++c) {
      const u32x4 v = *(const u32x4*)(src + c * 8);
#pragma unroll
      for (int j = 0; j < 4; ++j) { const float a = bf_lo(v[j]), bb = bf_hi(v[j]); ss += a * a + bb * bb; }
    }
    const float rs = rsqrtf(ss + 1e-6f);
    if (r < 64) sm_rq[r] = rs; else sm_rk[r - 64] = rs;
  }
  __syncthreads();
  if (tid < 64) {
    const float gc = sm_gc[tid], gl = sm_gc[63], eg = __expf(gc);
    sm_fw[tid] = sm_beta[tid] * eg * sm_rk[tid];
    sm_fq[tid] = sm_rq[tid] * 0.08838834764831845f * eg;
    sm_fk[tid] = sm_rk[tid] * __expf(gl - gc);
    if (tid == 0) ((float*)(p.ws + OFF_DEC))[item] = __expf(gl);
  }
  {
    bf16x8 kfi[4], qfi[4];
#pragma unroll
    for (int s = 0; s < 4; ++s) {
      kfi[s] = *(const bf16x8*)(Ks + (16 * wv + r16) * 136 + 32 * s + 8 * g);
      qfi[s] = *(const bf16x8*)(Qs + (16 * wv + r16) * 136 + 32 * s + 8 * g);
    }
    f32x4 at[4];
#pragma unroll
    for (int jt = 0; jt < 4; ++jt) {
      at[jt] = (f32x4){0.f, 0.f, 0.f, 0.f};
      if (jt <= wv) {
        f32x4 la = (f32x4){0.f, 0.f, 0.f, 0.f}, aa = (f32x4){0.f, 0.f, 0.f, 0.f};
#pragma unroll
        for (int s = 0; s < 4; ++s) {
          const bf16x8 kfj = *(const bf16x8*)(Ks + (16 * jt + r16) * 136 + 32 * s + 8 * g);
          la = mfma16(kfi[s], kfj, la);
          aa = mfma16(kfj, qfi[s], aa);
        }
#pragma unroll
        for (int r = 0; r < 4; ++r) {
          { const int i = 16 * wv + 4 * g + r, j = 16 * jt + r16;
            const float v = (i > j) ? sm_beta[i] * sm_rk[i] * sm_rk[j] * __expf(sm_gc[i] - sm_gc[j]) * la[r] : 0.f;
            Lm[i * 68 + j] = v; }
          { const int j = 16 * jt + 4 * g + r, i = 16 * wv + r16;
            at[jt][r] = (j <= i) ? sm_rq[i] * sm_rk[j] * 0.08838834764831845f * __expf(sm_gc[i] - sm_gc[j]) * aa[r] : 0.f; }
        }
      }
    }
#pragma unroll
    for (int s2 = 0; s2 < 2; ++s2)
      *(bf16x8*)(op + 32768 + (size_t)((wv * 2 + s2) * 64 + lane) * 16) = pack8(at[2 * s2], at[2 * s2 + 1]);
  }
  __syncthreads();
  f32x2_t xv[64];
  if (wv < 2) {
#pragma unroll
    for (int i = 0; i < 64; ++i) { xv[i].x = sm_beta[i] * bf2f(Vs[i * 136 + tid]); xv[i].y = sm_fw[i] * bf2f(Ks[i * 136 + tid]); }
    solve_rows2<1>(xv, Lm, lane, Lm[68 + lane]);
    const int sl = tid >> 4, dvl = tid & 15;
#pragma unroll
    for (int mt = 0; mt < 4; ++mt)
#pragma unroll
      for (int gg = 0; gg < 4; ++gg) {
        u32x2 w; w.x = pk_bf16(xv[16 * mt + 4 * gg].x, xv[16 * mt + 4 * gg + 1].x); w.y = pk_bf16(xv[16 * mt + 4 * gg + 2].x, xv[16 * mt + 4 * gg + 3].x);
        *(u32x2*)(op + 57344 + (size_t)((sl * 4 + mt) * 64 + gg * 16 + dvl) * 8) = w;
      }
  } else {
    const int t2 = tid - 128;
#pragma unroll 2
    for (int f = 0; f < 8; ++f) {
      const int e = t2 + 128 * f, frag = e >> 6, ln = e & 63, lr = ln & 15, lg = ln >> 4;
      {
        const int mt = frag >> 2, sx = frag & 3, row = 16 * mt + lr;
        const u32x2 ql = *(const u32x2*)(Qs + row * 136 + 32 * sx + 4 * lg), qh = *(const u32x2*)(Qs + row * 136 + 32 * sx + 16 + 4 * lg);
        const float fq = sm_fq[row];
        u32x4 w;
        w.x = pk_bf16(bf_lo(ql.x) * fq, bf_hi(ql.x) * fq); w.y = pk_bf16(bf_lo(ql.y) * fq, bf_hi(ql.y) * fq);
        w.z = pk_bf16(bf_lo(qh.x) * fq, bf_hi(qh.x) * fq); w.w = pk_bf16(bf_lo(qh.y) * fq, bf_hi(qh.y) * fq);
        *(u32x4*)(op + 16384 + (size_t)e * 16) = w;
      }
      {
        const int mt8 = frag >> 1, s2 = frag & 1, dk = 16 * mt8 + lr;
        float v[8];
#pragma unroll
        for (int j = 0; j < 8; ++j) {
          const int pos = 32 * s2 + 16 * (j >> 2) + 4 * lg + (j & 3);
          v[j] = bf2f(Ks[pos * 136 + dk]) * sm_fk[pos];
        }
        u32x4 w; w.x = pk_bf16(v[0], v[1]); w.y = pk_bf16(v[2], v[3]); w.z = pk_bf16(v[4], v[5]); w.w = pk_bf16(v[6], v[7]);
        *(u32x4*)(op + 40960 + (size_t)e * 16) = w;
      }
    }
  }
  __syncthreads();
  if (wv < 2) {
#pragma unroll
    for (int i = 0; i < 64; ++i) Vs[i * 136 + tid] = f2bf(-xv[i].y);
  }
  __syncthreads();
#pragma unroll
  for (int f = 0; f < 4; ++f) {
    const int e = tid + 256 * f, frag = e >> 6, ln = e & 63, lr = ln & 15, lg = ln >> 4;
    const int mt = frag >> 2, sx = frag & 3, row = 16 * mt + lr;
    const u32x2 lo = *(const u32x2*)(Vs + row * 136 + 32 * sx + 4 * lg), hi = *(const u32x2*)(Vs + row * 136 + 32 * sx + 16 + 4 * lg);
    *(u32x4*)(op + (size_t)e * 16) = (u32x4){lo.x, lo.y, hi.x, hi.y};
  }
}

struct ScanA { u32x4 wf[4]; u32x2 uf; float dec; };
struct ScanB { u32x4 qf[4], af[2], kf[4]; };

DI void scan_load_a(const Params& p, int wvs, ScanA& o, int b, int hd, int sl, int n, int q, int lane) {
  const int item = (b * 128 + n) * 4 + hd;
  const unsigned char* op = p.ws + OFF_SC + (size_t)item * OPB;
#pragma unroll
  for (int s = 0; s < 4; ++s) {
    o.wf[s] = *(const u32x4*)(op + (size_t)((q * 4 + s) * 64 + lane) * 16);
  }
  o.uf = *(const u32x2*)(op + 57344 + (size_t)((sl * 4 + q) * 64 + lane) * 8);
  o.dec = ((const float*)(p.ws + OFF_DEC))[item];
}
DI void scan_load_b(const Params& p, int wvs, ScanB& o, int b, int hd, int n, int q, int lane) {
  const int item = (b * 128 + n) * 4 + hd;
  const unsigned char* op = p.ws + OFF_SC + (size_t)item * OPB;
#pragma unroll
  for (int s = 0; s < 4; ++s) o.qf[s] = *(const u32x4*)(op + 16384 + (size_t)((q * 4 + s) * 64 + lane) * 16);
#pragma unroll
  for (int s2 = 0; s2 < 2; ++s2) o.af[s2] = *(const u32x4*)(op + 32768 + (size_t)((q * 2 + s2) * 64 + lane) * 16);
#pragma unroll
  for (int j = 0; j < 4; ++j) o.kf[j] = *(const u32x4*)(op + 40960 + (size_t)((q * 4 + j) * 64 + lane) * 16);
}

DI void scan_step(const Params& p, int wvs, const ScanA& o, const ScanB& ob, f32x4 (&S)[2], int b, int hd, int sl, int n, int q, int lane, unsigned char* smem) {
  const int r16 = lane & 15, g = lane >> 4;
  u32x4* ldsS = (u32x4*)smem;
  u32x2* ldsV = (u32x2*)(smem + 4096);
  ldsS[q * 64 + lane] = __builtin_bit_cast(u32x4, pack8(S[0], S[1]));
  __syncthreads();
  bf16x8 Sb[4];
#pragma unroll
  for (int s = 0; s < 4; ++s) Sb[s] = as_bf8(ldsS[s * 64 + lane]);
  f32x4 vn = (f32x4){bf_lo(o.uf.x), bf_hi(o.uf.x), bf_lo(o.uf.y), bf_hi(o.uf.y)};
#pragma unroll
  for (int s = 0; s < 4; ++s) vn = mfma16(as_bf8(o.wf[s]), Sb[s], vn);
  { u32x2 w; w.x = pk_bf16(vn[0], vn[1]); w.y = pk_bf16(vn[2], vn[3]); ldsV[((q >> 1) * 64 + lane) * 2 + (q & 1)] = w; }
  f32x4 oa = (f32x4){0.f, 0.f, 0.f, 0.f};
#pragma unroll
  for (int s = 0; s < 4; ++s) oa = mfma16(as_bf8(ob.qf[s]), Sb[s], oa);
  __syncthreads();
  bf16x8 Vb[2];
#pragma unroll
  for (int s2 = 0; s2 < 2; ++s2) Vb[s2] = as_bf8(*(const u32x4*)(ldsV + (s2 * 64 + lane) * 2));
#pragma unroll
  for (int s2 = 0; s2 < 2; ++s2) oa = mfma16(as_bf8(ob.af[s2]), Vb[s2], oa);
  u16* h = (u16*)(p.ws + OFF_H);
  const int t0 = b * SEQ + n * 64;
#pragma unroll
  for (int r = 0; r < 4; ++r) h[(size_t)(t0 + 16 * q + 4 * g + r) * NC + hd * 128 + 16 * sl + r16] = f2bf(oa[r]);
#pragma unroll
  for (int t = 0; t < 2; ++t) {
    S[t] = S[t] * o.dec;
#pragma unroll
    for (int s2 = 0; s2 < 2; ++s2) S[t] = mfma16(as_bf8(ob.kf[t * 2 + s2]), Vb[s2], S[t]);
  }
}

DI void scan_chain(const Params& p, int wvs, int pair, int sl, unsigned char* smem) {
  const int tid0 = opaque_tid(); const int lane = tid0 & 63, q = tid0 >> 6;
  const int b = pair >> 2, hd = pair & 3;
  f32x4 S[2]; S[0] = (f32x4){0.f, 0.f, 0.f, 0.f}; S[1] = S[0];
  ScanA a0, a1, a2; ScanB bc, bn;
  __syncthreads();
  scan_load_a(p, wvs, a0, b, hd, sl, 0, q, lane);
  scan_load_b(p, wvs, bc, b, hd, 0, q, lane);
  scan_load_a(p, wvs, a1, b, hd, sl, 1, q, lane);
#pragma unroll 1
  for (int n = 0; n < 129; n += 3) {
    if (n + 2 < 128) scan_load_a(p, wvs, a2, b, hd, sl, n + 2, q, lane);
    if (n + 1 < 128) scan_load_b(p, wvs, bn, b, hd, n + 1, q, lane);
    if (n < 128) scan_step(p, wvs, a0, bc, S, b, hd, sl, n, q, lane, smem);
    bc = bn;
    if (n + 3 < 128) scan_load_a(p, wvs, a0, b, hd, sl, n + 3, q, lane);
    if (n + 2 < 128) scan_load_b(p, wvs, bn, b, hd, n + 2, q, lane);
    if (n + 1 < 128) scan_step(p, wvs, a1, bc, S, b, hd, sl, n + 1, q, lane, smem);
    bc = bn;
    if (n + 4 < 128) scan_load_a(p, wvs, a1, b, hd, sl, n + 4, q, lane);
    if (n + 3 < 128) scan_load_b(p, wvs, bn, b, hd, n + 3, q, lane);
    if (n + 2 < 128) scan_step(p, wvs, a2, bc, S, b, hd, sl, n + 2, q, lane, smem);
    bc = bn;
  }
}

DI void swa_item(const Params& p, int wvs, int item, bool valid, unsigned char* smem) {
  if (!valid) { __syncthreads(); __syncthreads(); return; }
  const int tid_ = opaque_tid();
  const int tid = tid_, lane = tid & 63, wv = tid >> 6, r16 = lane & 15, g = lane >> 4;
  const int qt = item & 127, kvh = (item >> 7) & 1, b = item >> 8;
  const int kp0 = 64 * qt - 128;
  u16* Ksm = (u16*)smem;
  u16* Vt = (u16*)(smem + 27648);
  u16* h = (u16*)(p.ws + OFF_H);
  const float* rc = (const float*)(p.ws + OFF_ROPE); const float* rs = rc + 8192 * 8;
  __syncthreads();
  if (tid < 192) {
    const int kk = tid, pos = kp0 + kk;
    u32x4 lo = (u32x4){0, 0, 0, 0}, hi = lo;
    if (pos >= 0) {
      const u16* src = h + (size_t)(b * SEQ + pos) * NC + C_SWK + kvh * 64;
      const u32x4 a = *(const u32x4*)src, c = *(const u32x4*)(src + 8);
      const f32x4 c0 = *(const f32x4*)(rc + pos * 8), c1 = *(const f32x4*)(rc + pos * 8 + 4);
      const f32x4 s0 = *(const f32x4*)(rs + pos * 8), s1 = *(const f32x4*)(rs + pos * 8 + 4);
      float t1[8], t2[8], cs[8], sn[8], o1[8], o2[8];
#pragma unroll
      for (int j = 0; j < 4; ++j) { t1[2 * j] = bf_lo(a[j]); t1[2 * j + 1] = bf_hi(a[j]); t2[2 * j] = bf_lo(c[j]); t2[2 * j + 1] = bf_hi(c[j]);
        cs[j] = c0[j]; cs[4 + j] = c1[j]; sn[j] = s0[j]; sn[4 + j] = s1[j]; }
#pragma unroll
      for (int j = 0; j < 8; ++j) { o1[j] = t1[j] * cs[j] - t2[j] * sn[j]; o2[j] = t2[j] * cs[j] + t1[j] * sn[j]; }
#pragma unroll
      for (int j = 0; j < 4; ++j) { lo[j] = pk_bf16(o1[2 * j], o1[2 * j + 1]); hi[j] = pk_bf16(o2[2 * j], o2[2 * j + 1]); }
    }
    *(u32x4*)(Ksm + kk * 72) = lo; *(u32x4*)(Ksm + kk * 72 + 8) = hi;
  }
  for (int e = tid; e < 192 * 6; e += 256) {
    const int kk = e / 6, ch = 2 + e % 6, pos = kp0 + kk;
    u32x4 v = (u32x4){0, 0, 0, 0};
    if (pos >= 0) v = *(const u32x4*)(h + (size_t)(b * SEQ + pos) * NC + C_SWK + kvh * 64 + ch * 8);
    *(u32x4*)(Ksm + kk * 72 + ch * 8) = v;
  }
  for (int e = tid; e < 192 * 8; e += 256) {
    const int kk = e >> 3, ch = e & 7, pos = kp0 + kk;
    u32x4 v = (u32x4){0, 0, 0, 0};
    if (pos >= 0) v = *(const u32x4*)(h + (size_t)(b * SEQ + pos) * NC + C_SWV + kvh * 64 + ch * 8);
#pragma unroll
    for (int j = 0; j < 4; ++j) { Vt[(ch * 8 + 2 * j) * 200 + kk] = (u16)(v[j] & 0xffffu); Vt[(ch * 8 + 2 * j + 1) * 200 + kk] = (u16)(v[j] >> 16); }
  }
  __syncthreads();
  const int st = wv, jt0 = st < 2 ? st : 2;
  const int qi = 16 * st + r16;
  const int qpos = 64 * qt + qi, tq = b * SEQ + qpos;
#pragma unroll 1
  for (int hq = 0; hq < 4; ++hq) {
    const int head = kvh * 4 + hq;
    u16* qsrc = h + (size_t)tq * NC + C_SWQ + head * 64;
    bf16x8 qf[2];
    {
      const u32x4 a = *(const u32x4*)qsrc, c = *(const u32x4*)(qsrc + 8);
      u32x4 w = *(const u32x4*)(qsrc + 8 * g);
      if (g < 2) {
        const f32x4 c0 = *(const f32x4*)(rc + qpos * 8), c1 = *(const f32x4*)(rc + qpos * 8 + 4);
        const f32x4 s0 = *(const f32x4*)(rs + qpos * 8), s1 = *(const f32x4*)(rs + qpos * 8 + 4);
        float t1[8], t2[8], cs[8], sn[8], o[8];
#pragma unroll
        for (int j = 0; j < 4; ++j) { t1[2 * j] = bf_lo(a[j]); t1[2 * j + 1] = bf_hi(a[j]); t2[2 * j] = bf_lo(c[j]); t2[2 * j + 1] = bf_hi(c[j]);
          cs[j] = c0[j]; cs[4 + j] = c1[j]; sn[j] = s0[j]; sn[4 + j] = s1[j]; }
#pragma unroll
        for (int j = 0; j < 8; ++j) o[j] = (g == 0) ? (t1[j] * cs[j] - t2[j] * sn[j]) : (t2[j] * cs[j] + t1[j] * sn[j]);
#pragma unroll
        for (int j = 0; j < 4; ++j) w[j] = pk_bf16(o[2 * j], o[2 * j + 1]);
      }
      qf[0] = as_bf8(w);
      qf[1] = as_bf8(*(const u32x4*)(qsrc + 32 + 8 * g));
    }
    f32x4 sc[10];
#pragma unroll
    for (int t = 0; t < 10; ++t) {
      sc[t] = (f32x4){0.f, 0.f, 0.f, 0.f};
#pragma unroll
      for (int s = 0; s < 2; ++s) {
        const bf16x8 kf = *(const bf16x8*)(Ksm + (16 * (jt0 + t) + r16) * 72 + 32 * s + 8 * g);
        sc[t] = mfma16(kf, qf[s], sc[t]);
      }
    }
    const float sink = p.sinks[head];
    float mx = sink;
#pragma unroll
    for (int t = 0; t < 10; ++t)
#pragma unroll
      for (int r = 0; r < 4; ++r) {
        const int kk = 16 * (jt0 + t) + 4 * g + r, d = kk - qi;
        const bool ok = (d >= 1) && (d <= 128) && (kp0 + kk >= 0);
        const float v = ok ? sc[t][r] * 0.125f : -1e30f;
        sc[t][r] = v; mx = fmaxf(mx, v);
      }
    mx = fmaxf(mx, shx(mx, 16, lane)); mx = fmaxf(mx, shx(mx, 32, lane));
    float sum = 0.f;
#pragma unroll
    for (int t = 0; t < 10; ++t)
#pragma unroll
      for (int r = 0; r < 4; ++r) { const float e = __expf(sc[t][r] - mx); sc[t][r] = e; sum += e; }
    sum += shx(sum, 16, lane); sum += shx(sum, 32, lane);
    const float inv = rcp_f(sum + __expf(sink - mx));
    f32x4 oacc[4];
#pragma unroll
    for (int dt = 0; dt < 4; ++dt) oacc[dt] = (f32x4){0.f, 0.f, 0.f, 0.f};
#pragma unroll
    for (int s2 = 0; s2 < 5; ++s2) {
      const bf16x8 pb = pack8(sc[2 * s2], sc[2 * s2 + 1]);
#pragma unroll
      for (int dt = 0; dt < 4; ++dt) {
        const u16* vr = Vt + (16 * dt + r16) * 200 + 16 * (jt0 + 2 * s2) + 4 * g;
        const u32x2 lo = *(const u32x2*)vr, hi = *(const u32x2*)(vr + 16);
        oacc[dt] = mfma16(as_bf8((u32x4){lo.x, lo.y, hi.x, hi.y}), pb, oacc[dt]);
      }
    }
#pragma unroll
    for (int dt = 0; dt < 4; ++dt) {
      const int dcol = head * 64 + 16 * dt + 4 * g;
      const u32x2 z = *(const u32x2*)(h + (size_t)tq * NC + C_SWZ + dcol);
      u32x2 w;
      w.x = pk_bf16(oacc[dt][0] * inv * silu_f(bf_lo(z.x)), oacc[dt][1] * inv * silu_f(bf_hi(z.x)));
      w.y = pk_bf16(oacc[dt][2] * inv * silu_f(bf_lo(z.y)), oacc[dt][3] * inv * silu_f(bf_hi(z.y)));
      *(u32x2*)(h + (size_t)tq * NC + C_SWQ + dcol) = w;
    }
  }
}

DI void phase_ya(const Params& p, int wvs) {
  u16* h = (u16*)(p.ws + OFF_H);
  const int ltid = opaque_tid(), lane = ltid & 63;
  const size_t gt = (size_t)blockIdx.x * 512 + ltid, gs = (size_t)gridDim.x * 512;
  const float* nwp = p.dn_norm_w + (ltid & 15) * 8;
  const f32x4 nw0 = *(const f32x4*)nwp, nw1 = *(const f32x4*)(nwp + 4);
  for (size_t i0 = gt; i0 < (size_t)T_TOK * 64; i0 += 4 * gs) {
    u32x4 v[4], z[4];
#pragma unroll
    for (int k = 0; k < 4; ++k) {
      const size_t i = i0 + k * gs;
      if (i < (size_t)T_TOK * 64) {
        const u16* ptr = h + (size_t)(i >> 6) * NC + (i & 63) * 8;
        v[k] = *(const u32x4*)ptr; z[k] = *(const u32x4*)(ptr + C_DNZ);
      } else { v[k] = (u32x4){0, 0, 0, 0}; z[k] = v[k]; }
    }
#pragma unroll
    for (int k = 0; k < 4; ++k) {
      const size_t i = i0 + k * gs;
      float o[8]; float ss = 0.f;
#pragma unroll
      for (int j = 0; j < 4; ++j) { o[2 * j] = bf_lo(v[k][j]); o[2 * j + 1] = bf_hi(v[k][j]); }
#pragma unroll
      for (int j = 0; j < 8; ++j) ss += o[j] * o[j];
      ss += shx(ss, 1, lane); ss += shx(ss, 2, lane); ss += shx(ss, 4, lane); ss += shx(ss, 8, lane);
      const float rs = rsqrtf(ss * (1.0f / 128.0f) + 1e-6f);
      float y[8];
#pragma unroll
      for (int j = 0; j < 4; ++j) {
        const float w0 = (j < 2) ? nw0[2 * j] : nw1[2 * j - 4], w1 = (j < 2) ? nw0[2 * j + 1] : nw1[2 * j - 3];
        y[2 * j] = o[2 * j] * rs * w0 * silu_f(bf_lo(z[k][j]));
        y[2 * j + 1] = o[2 * j + 1] * rs * w1 * silu_f(bf_hi(z[k][j]));
      }
      u32x4 w; w.x = pk_bf16(y[0], y[1]); w.y = pk_bf16(y[2], y[3]); w.z = pk_bf16(y[4], y[5]); w.w = pk_bf16(y[6], y[7]);
      if (i < (size_t)T_TOK * 64) *(u32x4*)(h + (size_t)(i >> 6) * NC + (i & 63) * 8) = w;
    }
  }
}

DI void phase4(const Params& p, int wvs, int vb, int nvb, unsigned char* smem) {
  const int xcd = vb & 7, lb = vb >> 3, nlb = nvb >> 3;
  const u16* h = (const u16*)(p.ws + OFF_H);
  const u16* wat = (const u16*)(p.ws + OFF_WAT);
  const u16* wbt = (const u16*)(p.ws + OFF_WBT);
  u16* mg = (u16*)(p.ws + OFF_SC);
  const int tid0 = opaque_tid(); const int lane = tid0 & 63, wv = tid0 >> 6, wm = wv >> 1, wn = wv & 1, r16 = lane & 15, g = lane >> 4;
  for (int li = lb;; li += nlb) {
    int mt, nt; if (!tile_of(li, 4, xcd, mt, nt)) break;
    f32x4 acc[4][8]; zero_acc(acc);
    gemm_kloop(p, wvs, h, NC, wat, 512, 16, mt * 128, nt * 256, acc, smem);
#pragma unroll
    for (int mi = 0; mi < 4; ++mi) {
      const int row = mt * 128 + wm * 64 + mi * 16 + r16;
#pragma unroll
      for (int ni = 0; ni < 8; ++ni) {
        const int col = nt * 256 + wn * 128 + ni * 16 + 4 * g;
        const u32x2 ga = *(const u32x2*)(h + (size_t)row * NC + C_GA + col), gb = *(const u32x2*)(h + (size_t)row * NC + C_GB + col);
        acc[mi][ni][0] *= (1.f + __expf(-bf_lo(gb.x))) * rcp_f(1.f + __expf(-bf_lo(ga.x)));
        acc[mi][ni][1] *= (1.f + __expf(-bf_hi(gb.x))) * rcp_f(1.f + __expf(-bf_hi(ga.x)));
        acc[mi][ni][2] *= (1.f + __expf(-bf_lo(gb.y))) * rcp_f(1.f + __expf(-bf_lo(ga.y)));
        acc[mi][ni][3] *= (1.f + __expf(-bf_hi(gb.y))) * rcp_f(1.f + __expf(-bf_hi(ga.y)));
      }
      if (mi & 1) __builtin_amdgcn_sched_barrier(0);
    }
    gemm_kloop(p, wvs, h + C_SWQ, NC, wbt, 512, 16, mt * 128, nt * 256, acc, smem);
#pragma unroll
    for (int mi = 0; mi < 4; ++mi) {
      const int row = mt * 128 + wm * 64 + mi * 16 + r16;
#pragma unroll
      for (int ni = 0; ni < 8; ++ni) {
        const int col = nt * 256 + wn * 128 + ni * 16 + 4 * g;
        const u32x2 gb = *(const u32x2*)(h + (size_t)row * NC + C_GB + col);
        u32x2 w;
        w.x = pk_bf16(acc[mi][ni][0] * sigmoid_f(bf_lo(gb.x)), acc[mi][ni][1] * sigmoid_f(bf_hi(gb.x)));
        w.y = pk_bf16(acc[mi][ni][2] * sigmoid_f(bf_lo(gb.y)), acc[mi][ni][3] * sigmoid_f(bf_hi(gb.y)));
        *(u32x2*)(mg + (size_t)row * 1024 + col) = w;
      }
      if (mi & 1) __builtin_amdgcn_sched_barrier(0);
    }
  }
}

DI void phase5(const Params& p, int wvs, unsigned char* smem) {
  const int xcd = blockIdx.x & 7, lb = blockIdx.x >> 3, nlb = gridDim.x >> 3;
  const u16* mg = (const u16*)(p.ws + OFF_SC);
  const u16* wot = (const u16*)(p.ws + OFF_WOT);
  const int tid0 = opaque_tid(); const int lane = tid0 & 63, wv = tid0 >> 6, wm = wv >> 1, wn = wv & 1, r16 = lane & 15, g = lane >> 4;
  for (int li = lb;; li += nlb) {
    int mt, nt; if (!tile_of(li, 4, xcd, mt, nt)) break;
    f32x4 acc[4][8]; zero_acc(acc);
    gemm_kloop(p, wvs, mg, 1024, wot, 1024, 32, mt * 128, nt * 256, acc, smem);
#pragma unroll
    for (int mi = 0; mi < 4; ++mi) {
      const int row = mt * 128 + wm * 64 + mi * 16 + r16;
#pragma unroll
      for (int ni = 0; ni < 8; ++ni) {
        const int col = nt * 256 + wn * 128 + ni * 16 + 4 * g;
        const f32x4 xv = *(const f32x4*)(p.x + (size_t)row * 1024 + col);
        *(f32x4*)(p.out + (size_t)row * 1024 + col) = xv * 1.189207115002721f + acc[mi][ni];
      }
    }
  }
}

DI float wave_sum(float v, int lane) {
#pragma unroll
  for (int o = 32; o > 0; o >>= 1) v += shx(v, o, lane);
  return v;
}
DI void phase6(const Params& p, int wvs, unsigned char* smem) {
  const int tid = opaque_tid(), lane = tid & 63, wv = tid >> 6;
  f32x4 gm[4], bt[4];
#pragma unroll
  for (int j = 0; j < 4; ++j) { gm[j] = *(const f32x4*)(p.ln_g + 4 * (lane + 64 * j)); bt[j] = *(const f32x4*)(p.ln_b + 4 * (lane + 64 * j)); }
  const int xcd6 = blockIdx.x & 7, lb6 = blockIdx.x >> 3, nlb6 = gridDim.x >> 3;
  for (int lr = (lb6 * 8 + wv) * 2; lr < 4096; lr += nlb6 * 16) {
    float* r0 = p.out + (size_t)(4096 * xcd6 + (4095 - lr)) * 1024;
    float* r1 = p.out + (size_t)(4096 * xcd6 + (4094 - lr)) * 1024;
    f32x4 a[4], b[4];
#pragma unroll
    for (int j = 0; j < 4; ++j) { a[j] = *(const f32x4*)(r0 + 4 * (lane + 64 * j)); b[j] = *(const f32x4*)(r1 + 4 * (lane + 64 * j)); }
    float sa = 0.f, sb = 0.f;
#pragma unroll
    for (int j = 0; j < 4; ++j) { sa += (a[j][0] + a[j][1]) + (a[j][2] + a[j][3]); sb += (b[j][0] + b[j][1]) + (b[j][2] + b[j][3]); }
    const float ma = wave_sum(sa, lane) * (1.0f / 1024.0f), mb = wave_sum(sb, lane) * (1.0f / 1024.0f);
    float qa = 0.f, qb = 0.f;
#pragma unroll
    for (int j = 0; j < 4; ++j) {
      a[j] = a[j] - ma; b[j] = b[j] - mb;
      qa += (a[j][0] * a[j][0] + a[j][1] * a[j][1]) + (a[j][2] * a[j][2] + a[j][3] * a[j][3]);
      qb += (b[j][0] * b[j][0] + b[j][1] * b[j][1]) + (b[j][2] * b[j][2] + b[j][3] * b[j][3]);
    }
    const float ra = rsqrtf(wave_sum(qa, lane) * (1.0f / 1024.0f) + 1e-5f), rb = rsqrtf(wave_sum(qb, lane) * (1.0f / 1024.0f) + 1e-5f);
#pragma unroll
    for (int j = 0; j < 4; ++j) {
      *(f32x4*)(r0 + 4 * (lane + 64 * j)) = a[j] * ra * gm[j] + bt[j];
      *(f32x4*)(r1 + 4 * (lane + 64 * j)) = b[j] * rb * gm[j] + bt[j];
    }
  }
}

#define XB_TMO      128
#define XB_XCNT(j)  (256  + 64 * (j))
#define XB_XSUB(j)  (1280 + 64 * (j))
#define XB_XGEN(j)  (2304 + 64 * (j))
#define XB_TOP      3328
#define XB_TOPGEN   3392
#define XCD_BAR_WORDS 3456
#define XB_SPIN_CAP (1u << 22)
#define LAS __attribute__((address_space(3)))
DI unsigned xb_ld(unsigned* p) { return __hip_atomic_load(p, __ATOMIC_RELAXED, __HIP_MEMORY_SCOPE_AGENT); }
DI unsigned xb_add(unsigned* p, unsigned v) { return __hip_atomic_fetch_add(p, v, __ATOMIC_RELAXED, __HIP_MEMORY_SCOPE_AGENT); }
DI unsigned xb_xcc_id() { return (unsigned)__builtin_amdgcn_s_getreg((3 << 11) | 20) & 0xFu; }
#define XB_SPIN(cond, bar) do { unsigned _sp = 0; while (cond) { __builtin_amdgcn_s_sleep(1); \
    if ((++_sp & 255u) == 0u) { if (xb_ld(&(bar)[XB_TMO])) break; if (_sp > XB_SPIN_CAP) { atomicAdd(&(bar)[XB_TMO], 1u); break; } } } } while (0)
struct XcdBarrier { unsigned* bar; unsigned x; volatile LAS unsigned* st; };
DI bool xb_leader(int wvs) { return wvs == 0 && __builtin_amdgcn_mbcnt_hi(~0u, __builtin_amdgcn_mbcnt_lo(~0u, 0u)) == 0u; }
DI XcdBarrier xcd_barrier_post(unsigned* bar, volatile LAS unsigned* st, int wvs) {
  XcdBarrier b; b.bar = bar; b.x = xb_xcc_id(); b.st = st;
  if (xb_leader(wvs)) (void)xb_add(&bar[XB_XCNT(b.x)], 1u);
  return b;
}
DI void xcd_barrier_complete(unsigned* bar, unsigned x, unsigned& nloc, unsigned& nx) {
  const unsigned G = gridDim.x * gridDim.y * gridDim.z;
  unsigned sum, cnt, mine, sp = 0u;
  for (;;) {
    sum = 0u; cnt = 0u; mine = 0u;
#pragma unroll
    for (unsigned j = 0; j < 16; ++j) { const unsigned c = xb_ld(&bar[XB_XCNT(j)]); sum += c; cnt += (c > 0u) ? 1u : 0u; mine = (j == x) ? c : mine; }
    if (sum == G) break;
    __builtin_amdgcn_s_sleep(1);
    if ((++sp & 255u) == 0u) { if (xb_ld(&bar[XB_TMO])) break; if (sp > XB_SPIN_CAP) { atomicAdd(&bar[XB_TMO], 1u); break; } }
  }
  nloc = mine > 0u ? mine : 1u; nx = cnt > 0u ? cnt : 1u;
}
DI void xcd_barrier_(const XcdBarrier& b, int wvs) {
  asm volatile("s_waitcnt vmcnt(0)" ::: "memory");
  __syncthreads();
  if (xb_leader(wvs)) {
    unsigned* bar = b.bar;
    __builtin_amdgcn_s_waitcnt(0);
    unsigned nloc = b.st[0], nx = b.st[1];
    if (nloc == 0u) { xcd_barrier_complete(bar, b.x, nloc, nx); b.st[0] = nloc; b.st[1] = nx; }
    const unsigned old = xb_add(&bar[XB_XSUB(b.x)], 1u);
    const unsigned gen = old / nloc;
    if (old + 1u == (gen + 1u) * nloc) {
      __builtin_amdgcn_fence(__ATOMIC_RELEASE, "agent");
      asm volatile("s_waitcnt vmcnt(0)" ::: "memory");
      const unsigned og = xb_add(&bar[XB_TOP], 1u);
      const unsigned tg = og / nx;
      if (og + 1u == (tg + 1u) * nx) xb_add(&bar[XB_TOPGEN], 1u);
      else XB_SPIN(xb_ld(&bar[XB_TOPGEN]) == tg, bar);
      __builtin_amdgcn_fence(__ATOMIC_ACQUIRE, "agent");
      xb_add(&bar[XB_XGEN(b.x)], 1u);
      asm volatile("s_waitcnt vmcnt(0)" ::: "memory");
    } else {
      XB_SPIN(xb_ld(&bar[XB_XGEN(b.x)]) == gen, bar);
      __builtin_amdgcn_fence(__ATOMIC_ACQUIRE, "agent");
      asm volatile("s_waitcnt vmcnt(0)" ::: "memory");
    }
  }
  __syncthreads();
}

#define xcd_barrier(b) xcd_barrier_(b, w8)
namespace pg8 {
#define PG8_LAS __attribute__((address_space(3)))
typedef unsigned short bf16_t;
typedef short bf16x8 __attribute__((ext_vector_type(8)));
typedef float f32x4 __attribute__((ext_vector_type(4)));
typedef unsigned u32x4 __attribute__((ext_vector_type(4)));
constexpr int BM = 256, BK = 64, HALF = 128, HTB = HALF * BK * 2  , STAGE_BYTES = 8 * HTB, NXCD = 8, WGM = 8;

__host__ __device__ __forceinline__ int lds_byte(int r, int c) { const int st = (r >> 4) * 2 + (c >> 5), rr = r & 15, cc = c & 31, ob = rr * 64 + cc * 2; return st * 1024 + (ob ^ (((ob >> 9) & 1) << 5)); }
__host__ __device__ __forceinline__ void stage_rc(int b, int& R, int& C) { const int st = b / 1024, sb = b % 1024, swz = sb ^ (((sb >> 9) & 1) << 5); R = (st >> 1) * 16 + swz / 64; C = (st & 1) * 32 + (swz % 64) / 2; }
__host__ __device__ __forceinline__ int perm32(int rho) { const int n = rho >> 4, i = rho & 15; return 8 * (i >> 2) + 4 * n + (i & 3); }

struct Unit { int pm, pn; };
struct Gemm { const bf16_t* A; const bf16_t* Bt; int M, N, K; };

struct StaticOrder {
    int nM, nN, nwg, G, c;
    __host__ __device__ void init(int M, int N, int G_, int c_) { nM = M / BM; nN = N / BM; nwg = nM * nN; G = G_; c = c_; }
    __host__ __device__ bool next(int i, Unit& u) const {
        const long L = (long)i * G + c; if (L >= nwg) return false;
        int wgid = (int)L; { const int q = nwg / NXCD, r = nwg % NXCD, xcd = wgid % NXCD, off = wgid / NXCD; wgid = (xcd < r ? xcd * (q + 1) : r * (q + 1) + (xcd - r) * q) + off; }
        const int nig = WGM * nN, gid = wgid / nig, fm = gid * WGM, gsz = (nM - fm) < WGM ? (nM - fm) : WGM;
        u.pm = fm + ((wgid % nig) % gsz); u.pn = (wgid % nig) / gsz; return true;
    }
    __device__ __forceinline__ void a_ready(const Unit&) const {}
    __device__ __forceinline__ void done(const Unit&) const {}
};

template <class Epi, class Sched, bool ALIGN_EPI = false, bool SP2 = false>
__device__ __forceinline__ void gemm_phase(PG8_LAS unsigned char* lds, const Gemm g, const Sched& S, const Epi& E, const int tid) {
    const int wid = __builtin_amdgcn_readfirstlane(tid >> 6), lane = tid & 63, wr = wid >> 2, wc = wid & 3, fr = lane & 15, fq = lane >> 4;
    const int K = g.K, nt = K / BK;
    unsigned voffA[2], voffB[2];
#pragma unroll
    for (int i = 0; i < 2; ++i) { int R, C; stage_rc(tid * 16 + i * 8192, R, C); const int Rb = Epi::PERM ? ((R & ~31) + perm32(R & 31)) : R;
        voffA[i] = (unsigned)(R * K + C) * 2u; voffB[i] = (unsigned)(Rb * K + C) * 2u; }
    const size_t kstep = (size_t)(BK * 2);
    const size_t hstep = (size_t)HALF * K * 2;
    const size_t tstep = 2 * hstep;
    const unsigned ldsw = (unsigned)wid * 1024u;
    const int aoff = lds_byte(wr * 64 + fr, fq * 8), boff = lds_byte(wc * 32 + fr, fq * 8);
#define PG8_SA(b, h) (((b) * 2 + (h)) * HTB)
#define PG8_SB(b, h) ((4 + (b) * 2 + (h)) * HTB)
#define PG8_STAGE(bufoff, gbase, voff) do { _Pragma("unroll") for (int _i = 0; _i < 2; ++_i) \
        __builtin_amdgcn_global_load_lds((const unsigned*)((const char*)(gbase) + (voff)[_i]), (PG8_LAS unsigned*)(lds + (bufoff) + ldsw + _i * 8192), 16, 0, 0); } while (0)
#define PG8_LDA(dst, b, h) do { _Pragma("unroll") for (int m = 0; m < 4; ++m) _Pragma("unroll") for (int k = 0; k < 2; ++k) dst[m][k] = *(const PG8_LAS bf16x8*)(lds + PG8_SA(b, h) + aoff + m * 2048 + k * 1024); } while (0)
#define PG8_LDB(dst, b, h) do { _Pragma("unroll") for (int n = 0; n < 2; ++n) _Pragma("unroll") for (int k = 0; k < 2; ++k) dst[n][k] = *(const PG8_LAS bf16x8*)(lds + PG8_SB(b, h) + boff + n * 2048 + k * 1024); } while (0)
#define PG8_MMA(ai, bj, At, Bt) do { __builtin_amdgcn_s_setprio(1); _Pragma("unroll") for (int m = 0; m < 4; ++m) _Pragma("unroll") for (int n = 0; n < 2; ++n) _Pragma("unroll") for (int k = 0; k < 2; ++k) \
        acc[ai][bj][m][n] = __builtin_amdgcn_mfma_f32_16x16x32_bf16(Bt[n][k], At[m][k], acc[ai][bj][m][n], 0, 0, 0); __builtin_amdgcn_s_setprio(0); } while (0)
#define PG8_WAIT_V(n) asm volatile("s_waitcnt vmcnt(" #n ")" ::: "memory")
#define PG8_WAIT_L(n) asm volatile("s_waitcnt lgkmcnt(" #n ")" ::: "memory")
#define PG8_BAR __builtin_amdgcn_s_barrier()
#define PG8_SCHED __builtin_amdgcn_sched_barrier(0)
    Unit cur, nxt; int ui = 0;
    if (!S.next(0, cur)) return;
    f32x4 acc[2][2][4][2];
#pragma unroll
    for (int a = 0; a < 2; ++a)
#pragma unroll
        for (int b = 0; b < 2; ++b)
#pragma unroll
            for (int m = 0; m < 4; ++m)
#pragma unroll
                for (int n = 0; n < 2; ++n) acc[a][b][m][n] = (f32x4){0.f, 0.f, 0.f, 0.f};
    bf16x8 At[4][2], B0[2][2], B1[2][2];
    const char* cA = (const char*)g.A + (size_t)cur.pm * tstep; const char* cB = (const char*)g.Bt + (size_t)cur.pn * tstep;
    S.a_ready(cur);
    if constexpr (SP2) {
        PG8_STAGE(PG8_SB(0, 0), cB, voffB); PG8_STAGE(PG8_SB(0, 1), cB + hstep, voffB); PG8_STAGE(PG8_SA(0, 0), cA, voffA); PG8_STAGE(PG8_SA(0, 1), cA + hstep, voffA);
        if (wr == 1) PG8_BAR;
        PG8_WAIT_V(2); PG8_BAR;
        PG8_STAGE(PG8_SB(1, 0), cB + kstep, voffB); PG8_STAGE(PG8_SA(1, 0), cA + kstep, voffA); PG8_STAGE(PG8_SB(1, 1), cB + hstep + kstep, voffB);
        PG8_WAIT_V(6); PG8_BAR;
    } else {
        PG8_STAGE(PG8_SB(0, 0), cB, voffB); PG8_STAGE(PG8_SA(0, 0), cA, voffA); PG8_STAGE(PG8_SB(0, 1), cB + hstep, voffB); PG8_STAGE(PG8_SA(0, 1), cA + hstep, voffA);
        if (wr == 1) PG8_BAR;
        PG8_WAIT_V(4); PG8_BAR;
        PG8_STAGE(PG8_SB(1, 0), cB + kstep, voffB); PG8_STAGE(PG8_SA(1, 0), cA + kstep, voffA); PG8_STAGE(PG8_SB(1, 1), cB + hstep + kstep, voffB);
        PG8_WAIT_V(6); PG8_BAR;
    }
    for (;;) {
        const bool has_next = S.next(ui + 1, nxt);
        const char* nA = has_next ? (const char*)g.A + (size_t)nxt.pm * tstep : cA; const char* nB = has_next ? (const char*)g.Bt + (size_t)nxt.pn * tstep : cB;
        for (int t = 0; t < nt; t += 2) {
            const bool last = (t == nt - 2);
            const char* a1 = cA + (size_t)(t + 1) * kstep;
            const char* a2 = last ? nA : cA + (size_t)(t + 2) * kstep; const char* b2 = last ? nB : cB + (size_t)(t + 2) * kstep;
            const char* a3 = a2 + kstep; const char* b3 = b2 + kstep;
            if (last && has_next) S.a_ready(nxt);
            if constexpr (SP2) {
            PG8_LDB(B0, 0, 0); PG8_LDB(B1, 0, 1); PG8_SCHED; PG8_LDA(At, 0, 0); PG8_STAGE(PG8_SA(1, 1), a1 + hstep, voffA);
            PG8_WAIT_V(8); PG8_WAIT_L(0); PG8_BAR; PG8_MMA(0, 0, At, B0); PG8_MMA(0, 1, At, B1); PG8_BAR; PG8_SCHED;
            PG8_LDA(At, 0, 1); PG8_STAGE(PG8_SB(0, 0), b2, voffB); PG8_STAGE(PG8_SB(0, 1), b2 + hstep, voffB); PG8_STAGE(PG8_SA(0, 0), a2, voffA);
            PG8_WAIT_V(8); PG8_WAIT_L(0); PG8_BAR; PG8_MMA(1, 0, At, B0); PG8_MMA(1, 1, At, B1); PG8_BAR; PG8_SCHED;
            PG8_LDB(B0, 1, 0); PG8_LDB(B1, 1, 1); PG8_SCHED; PG8_LDA(At, 1, 0); PG8_STAGE(PG8_SA(0, 1), a2 + hstep, voffA);
            PG8_WAIT_V(8); PG8_WAIT_L(0); PG8_BAR; PG8_MMA(0, 0, At, B0); PG8_MMA(0, 1, At, B1); PG8_BAR; PG8_SCHED;
            PG8_LDA(At, 1, 1); PG8_STAGE(PG8_SB(1, 0), b3, voffB); PG8_STAGE(PG8_SB(1, 1), b3 + hstep, voffB); PG8_STAGE(PG8_SA(1, 0), a3, voffA);
            PG8_WAIT_V(8); PG8_WAIT_L(0); PG8_BAR; PG8_MMA(1, 0, At, B0); PG8_MMA(1, 1, At, B1); PG8_BAR; PG8_SCHED;
            } else {
            PG8_LDB(B0, 0, 0); PG8_SCHED; PG8_LDA(At, 0, 0); PG8_STAGE(PG8_SA(1, 1), a1 + hstep, voffA);
            PG8_WAIT_L(8); PG8_BAR; PG8_WAIT_L(0); PG8_MMA(0, 0, At, B0); PG8_BAR; PG8_SCHED;
            PG8_LDB(B1, 0, 1); PG8_STAGE(PG8_SB(0, 0), b2, voffB);
            PG8_BAR; PG8_WAIT_L(0); PG8_MMA(0, 1, At, B1); PG8_BAR;
            PG8_LDA(At, 0, 1); PG8_STAGE(PG8_SA(0, 0), a2, voffA);
            PG8_BAR; PG8_WAIT_L(0); PG8_MMA(1, 0, At, B0); PG8_BAR; PG8_SCHED;
            PG8_STAGE(PG8_SB(0, 1), b2 + hstep, voffB);
            PG8_WAIT_V(6); PG8_BAR; PG8_MMA(1, 1, At, B1); PG8_BAR;
            PG8_LDB(B0, 1, 0); PG8_SCHED; PG8_LDA(At, 1, 0); PG8_STAGE(PG8_SA(0, 1), a2 + hstep, voffA);
            PG8_WAIT_L(8); PG8_BAR; PG8_WAIT_L(0); PG8_MMA(0, 0, At, B0); PG8_BAR; PG8_SCHED;
            PG8_LDB(B1, 1, 1); PG8_STAGE(PG8_SB(1, 0), b3, voffB);
            PG8_BAR; PG8_WAIT_L(0); PG8_MMA(0, 1, At, B1); PG8_BAR;
            PG8_LDA(At, 1, 1); PG8_STAGE(PG8_SA(1, 0), a3, voffA);
            PG8_BAR; PG8_WAIT_L(0); PG8_MMA(1, 0, At, B0); PG8_BAR; PG8_SCHED;
            PG8_STAGE(PG8_SB(1, 1), b3 + hstep, voffB);
            PG8_WAIT_V(6); PG8_BAR; PG8_MMA(1, 1, At, B1); PG8_BAR;
            }
        }
        if constexpr (ALIGN_EPI) { if (wr == 0) PG8_BAR; }
        if constexpr (!Epi::AFTER_DRAIN) { E(acc, cur, wr, wc, fr, fq); S.done(cur); }
        if (!has_next) break;
#pragma unroll
        for (int a = 0; a < 2; ++a)
#pragma unroll
            for (int b = 0; b < 2; ++b)
#pragma unroll
                for (int m = 0; m < 4; ++m)
#pragma unroll
                    for (int n = 0; n < 2; ++n) acc[a][b][m][n] = (f32x4){0.f, 0.f, 0.f, 0.f};
        cur = nxt; cA = nA; cB = nB; ++ui;
        if constexpr (ALIGN_EPI) { if (wr == 1) PG8_BAR; }
    }
    PG8_WAIT_V(0);
    if constexpr (!ALIGN_EPI) { if (wr == 0) PG8_BAR; }
    PG8_BAR;
    if constexpr (Epi::AFTER_DRAIN) { E.fused(acc, cur, wr, wc, fr, fq, lds, wid, lane); S.done(cur); }
#undef PG8_SA
#undef PG8_SB
#undef PG8_STAGE
#undef PG8_LDA
#undef PG8_LDB
#undef PG8_MMA
#undef PG8_WAIT_V
#undef PG8_WAIT_L
#undef PG8_BAR
#undef PG8_SCHED
}

struct Unit2 { int pm, pn, part; };
struct Gemm2 { const bf16_t* A0; const bf16_t* A1; const bf16_t* B0; const bf16_t* B1; int lda, K; };
struct StaticOrder2 {
    int nM, nN, nwg, G, c;
    __host__ __device__ void init(int M, int N, int G_, int c_) { nM = M / BM; nN = N / BM; nwg = nM * nN; G = G_; c = c_; }
    __host__ __device__ bool next(int i, Unit2& u) const {
        const long L = (long)(i >> 1) * G + c; if (L >= nwg) return false;
        int wgid = (int)L; { const int q = nwg / NXCD, r = nwg % NXCD, xcd = wgid % NXCD, off = wgid / NXCD; wgid = (xcd < r ? xcd * (q + 1) : r * (q + 1) + (xcd - r) * q) + off; }
        const int nig = WGM * nN, gid = wgid / nig, fm = gid * WGM, gsz = (nM - fm) < WGM ? (nM - fm) : WGM;
        u.pm = fm + ((wgid % nig) % gsz); u.pn = (wgid % nig) / gsz; u.part = i & 1; return true;
    }
    __device__ __forceinline__ void a_ready(const Unit2&) const {}
    __device__ __forceinline__ void done(const Unit2&) const {}
};
template <class Epi, class Sched, bool ALIGN_EPI = false, bool SP2 = false>
__device__ __forceinline__ void gemm_phase2(PG8_LAS unsigned char* lds, const Gemm2 g, const Sched& S, const Epi& E, const int tid) {
    const int wid = __builtin_amdgcn_readfirstlane(tid >> 6), lane = tid & 63, wr = wid >> 2, wc = wid & 3, fr = lane & 15, fq = lane >> 4;
    const int K = g.K, nt = K / BK;
    unsigned voffA[2], voffB[2];
#pragma unroll
    for (int i = 0; i < 2; ++i) { int R, C; stage_rc(tid * 16 + i * 8192, R, C); const int Rb = Epi::PERM ? ((R & ~31) + perm32(R & 31)) : R;
        voffA[i] = (unsigned)(R * g.lda + C) * 2u; voffB[i] = (unsigned)(Rb * K + C) * 2u; }
    const size_t kstep = (size_t)(BK * 2);
    const size_t hstep = (size_t)HALF * K * 2;
    const size_t tstep = 2 * hstep;
    const size_t hstepA = (size_t)HALF * g.lda * 2, tstepA = 2 * hstepA;
    const unsigned ldsw = (unsigned)wid * 1024u;
    const int aoff = lds_byte(wr * 64 + fr, fq * 8), boff = lds_byte(wc * 32 + fr, fq * 8);
#define PG8_SA(b, h) (((b) * 2 + (h)) * HTB)
#define PG8_SB(b, h) ((4 + (b) * 2 + (h)) * HTB)
#define PG8_STAGE(bufoff, gbase, voff) do { _Pragma("unroll") for (int _i = 0; _i < 2; ++_i) \
        __builtin_amdgcn_global_load_lds((const unsigned*)((const char*)(gbase) + (voff)[_i]), (PG8_LAS unsigned*)(lds + (bufoff) + ldsw + _i * 8192), 16, 0, 0); } while (0)
#define PG8_LDA(dst, b, h) do { _Pragma("unroll") for (int m = 0; m < 4; ++m) _Pragma("unroll") for (int k = 0; k < 2; ++k) dst[m][k] = *(const PG8_LAS bf16x8*)(lds + PG8_SA(b, h) + aoff + m * 2048 + k * 1024); } while (0)
#define PG8_LDB(dst, b, h) do { _Pragma("unroll") for (int n = 0; n < 2; ++n) _Pragma("unroll") for (int k = 0; k < 2; ++k) dst[n][k] = *(const PG8_LAS bf16x8*)(lds + PG8_SB(b, h) + boff + n * 2048 + k * 1024); } while (0)
#define PG8_MMA(ai, bj, At, Bt) do { __builtin_amdgcn_s_setprio(1); _Pragma("unroll") for (int m = 0; m < 4; ++m) _Pragma("unroll") for (int n = 0; n < 2; ++n) _Pragma("unroll") for (int k = 0; k < 2; ++k) \
        acc[ai][bj][m][n] = __builtin_amdgcn_mfma_f32_16x16x32_bf16(Bt[n][k], At[m][k], acc[ai][bj][m][n], 0, 0, 0); __builtin_amdgcn_s_setprio(0); } while (0)
#define PG8_WAIT_V(n) asm volatile("s_waitcnt vmcnt(" #n ")" ::: "memory")
#define PG8_WAIT_L(n) asm volatile("s_waitcnt lgkmcnt(" #n ")" ::: "memory")
#define PG8_BAR __builtin_amdgcn_s_barrier()
#define PG8_SCHED __builtin_amdgcn_sched_barrier(0)
    Unit2 cur, nxt; int ui = 0;
    if (!S.next(0, cur)) return;
    f32x4 acc[2][2][4][2];
#pragma unroll
    for (int a = 0; a < 2; ++a)
#pragma unroll
        for (int b = 0; b < 2; ++b)
#pragma unroll
            for (int m = 0; m < 4; ++m)
#pragma unroll
                for (int n = 0; n < 2; ++n) acc[a][b][m][n] = (f32x4){0.f, 0.f, 0.f, 0.f};
    bf16x8 At[4][2], B0[2][2], B1[2][2];
    const char* cA = (const char*)(cur.part ? g.A1 : g.A0) + (size_t)cur.pm * tstepA; const char* cB = (const char*)(cur.part ? g.B1 : g.B0) + (size_t)cur.pn * tstep;
    S.a_ready(cur);
    if constexpr (SP2) {
        PG8_STAGE(PG8_SB(0, 0), cB, voffB); PG8_STAGE(PG8_SB(0, 1), cB + hstep, voffB); PG8_STAGE(PG8_SA(0, 0), cA, voffA); PG8_STAGE(PG8_SA(0, 1), cA + hstepA, voffA);
        if (wr == 1) PG8_BAR;
        PG8_WAIT_V(2); PG8_BAR;
        PG8_STAGE(PG8_SB(1, 0), cB + kstep, voffB); PG8_STAGE(PG8_SA(1, 0), cA + kstep, voffA); PG8_STAGE(PG8_SB(1, 1), cB + hstep + kstep, voffB);
        PG8_WAIT_V(6); PG8_BAR;
    } else {
        PG8_STAGE(PG8_SB(0, 0), cB, voffB); PG8_STAGE(PG8_SA(0, 0), cA, voffA); PG8_STAGE(PG8_SB(0, 1), cB + hstep, voffB); PG8_STAGE(PG8_SA(0, 1), cA + hstepA, voffA);
        if (wr == 1) PG8_BAR;
        PG8_WAIT_V(4); PG8_BAR;
        PG8_STAGE(PG8_SB(1, 0), cB + kstep, voffB); PG8_STAGE(PG8_SA(1, 0), cA + kstep, voffA); PG8_STAGE(PG8_SB(1, 1), cB + hstep + kstep, voffB);
        PG8_WAIT_V(6); PG8_BAR;
    }
    for (;;) {
        const bool has_next = S.next(ui + 1, nxt);
        const char* nA = has_next ? (const char*)(nxt.part ? g.A1 : g.A0) + (size_t)nxt.pm * tstepA : cA; const char* nB = has_next ? (const char*)(nxt.part ? g.B1 : g.B0) + (size_t)nxt.pn * tstep : cB;
        for (int t = 0; t < nt; t += 2) {
            const bool last = (t == nt - 2);
            const char* a1 = cA + (size_t)(t + 1) * kstep;
            const char* a2 = last ? nA : cA + (size_t)(t + 2) * kstep; const char* b2 = last ? nB : cB + (size_t)(t + 2) * kstep;
            const char* a3 = a2 + kstep; const char* b3 = b2 + kstep;
            if (last && has_next) S.a_ready(nxt);
            if constexpr (SP2) {
            PG8_LDB(B0, 0, 0); PG8_LDB(B1, 0, 1); PG8_SCHED; PG8_LDA(At, 0, 0); PG8_STAGE(PG8_SA(1, 1), a1 + hstepA, voffA);
            PG8_WAIT_V(8); PG8_WAIT_L(0); PG8_BAR; PG8_MMA(0, 0, At, B0); PG8_MMA(0, 1, At, B1); PG8_BAR; PG8_SCHED;
            PG8_LDA(At, 0, 1); PG8_STAGE(PG8_SB(0, 0), b2, voffB); PG8_STAGE(PG8_SB(0, 1), b2 + hstep, voffB); PG8_STAGE(PG8_SA(0, 0), a2, voffA);
            PG8_WAIT_V(8); PG8_WAIT_L(0); PG8_BAR; PG8_MMA(1, 0, At, B0); PG8_MMA(1, 1, At, B1); PG8_BAR; PG8_SCHED;
            PG8_LDB(B0, 1, 0); PG8_LDB(B1, 1, 1); PG8_SCHED; PG8_LDA(At, 1, 0); PG8_STAGE(PG8_SA(0, 1), a2 + hstepA, voffA);
            PG8_WAIT_V(8); PG8_WAIT_L(0); PG8_BAR; PG8_MMA(0, 0, At, B0); PG8_MMA(0, 1, At, B1); PG8_BAR; PG8_SCHED;
            PG8_LDA(At, 1, 1); PG8_STAGE(PG8_SB(1, 0), b3, voffB); PG8_STAGE(PG8_SB(1, 1), b3 + hstep, voffB); PG8_STAGE(PG8_SA(1, 0), a3, voffA);
            PG8_WAIT_V(8); PG8_WAIT_L(0); PG8_BAR; PG8_MMA(1, 0, At, B0); PG8_MMA(1, 1, At, B1); PG8_BAR; PG8_SCHED;
            } else {
            PG8_LDB(B0, 0, 0); PG8_SCHED; PG8_LDA(At, 0, 0); PG8_STAGE(PG8_SA(1, 1), a1 + hstepA, voffA);
            PG8_WAIT_L(8); PG8_BAR; PG8_WAIT_L(0); PG8_MMA(0, 0, At, B0); PG8_BAR; PG8_SCHED;
            PG8_LDB(B1, 0, 1); PG8_STAGE(PG8_SB(0, 0), b2, voffB);
            PG8_BAR; PG8_WAIT_L(0); PG8_MMA(0, 1, At, B1); PG8_BAR;
            PG8_LDA(At, 0, 1); PG8_STAGE(PG8_SA(0, 0), a2, voffA);
            PG8_BAR; PG8_WAIT_L(0); PG8_MMA(1, 0, At, B0); PG8_BAR; PG8_SCHED;
            PG8_STAGE(PG8_SB(0, 1), b2 + hstep, voffB);
            PG8_WAIT_V(6); PG8_BAR; PG8_MMA(1, 1, At, B1); PG8_BAR;
            PG8_LDB(B0, 1, 0); PG8_SCHED; PG8_LDA(At, 1, 0); PG8_STAGE(PG8_SA(0, 1), a2 + hstepA, voffA);
            PG8_WAIT_L(8); PG8_BAR; PG8_WAIT_L(0); PG8_MMA(0, 0, At, B0); PG8_BAR; PG8_SCHED;
            PG8_LDB(B1, 1, 1); PG8_STAGE(PG8_SB(1, 0), b3, voffB);
            PG8_BAR; PG8_WAIT_L(0); PG8_MMA(0, 1, At, B1); PG8_BAR;
            PG8_LDA(At, 1, 1); PG8_STAGE(PG8_SA(1, 0), a3, voffA);
            PG8_BAR; PG8_WAIT_L(0); PG8_MMA(1, 0, At, B0); PG8_BAR; PG8_SCHED;
            PG8_STAGE(PG8_SB(1, 1), b3 + hstep, voffB);
            PG8_WAIT_V(6); PG8_BAR; PG8_MMA(1, 1, At, B1); PG8_BAR;
            }
        }
        if constexpr (ALIGN_EPI) { if (wr == 0) PG8_BAR; }
        if (cur.part == 0) E.mid(acc, cur, wr, wc, fr, fq); else E(acc, cur, wr, wc, fr, fq);
        if (!has_next) break;
        if (cur.part == 1) {
#pragma unroll
        for (int a = 0; a < 2; ++a)
#pragma unroll
            for (int b = 0; b < 2; ++b)
#pragma unroll
                for (int m = 0; m < 4; ++m)
#pragma unroll
                    for (int n = 0; n < 2; ++n) acc[a][b][m][n] = (f32x4){0.f, 0.f, 0.f, 0.f};
        }
        cur = nxt; cA = nA; cB = nB; ++ui;
        if constexpr (ALIGN_EPI) { if (wr == 1) PG8_BAR; }
    }
    PG8_WAIT_V(0);
    if constexpr (!ALIGN_EPI) { if (wr == 0) PG8_BAR; }
    PG8_BAR;
#undef PG8_SA
#undef PG8_SB
#undef PG8_STAGE
#undef PG8_LDA
#undef PG8_LDB
#undef PG8_MMA
#undef PG8_WAIT_V
#undef PG8_WAIT_L
#undef PG8_BAR
#undef PG8_SCHED
}
}

struct EpiInProj {
  static constexpr bool PERM = true, AFTER_DRAIN = false;
  u16* h;
  DI void operator()(const f32x4 (&acc)[2][2][4][2], const pg8::Unit& u, int wr, int wc, int fr, int fq) const {
    const int shift = (u.pn >= 8) ? 8 : 0;
#pragma unroll
    for (int ai = 0; ai < 2; ++ai)
#pragma unroll
      for (int m = 0; m < 4; ++m) {
        const int row = u.pm * 256 + ai * 128 + wr * 64 + m * 16 + fr;
#pragma unroll
        for (int bj = 0; bj < 2; ++bj) {
          const int col = u.pn * 256 + bj * 128 + wc * 32 + 8 * fq + shift;
          const f32x4 a = acc[ai][bj][m][0], b = acc[ai][bj][m][1];
          u32x4 w; w.x = pk_bf16(a[0], a[1]); w.y = pk_bf16(a[2], a[3]); w.z = pk_bf16(b[0], b[1]); w.w = pk_bf16(b[2], b[3]);
          *(u32x4*)(h + (size_t)row * NC + col) = w;
        }
      }
  }
};

struct EpiMerge {
  static constexpr bool PERM = true, AFTER_DRAIN = false;
  const u16* h; u16* mg;
  DI void mid(f32x4 (&acc)[2][2][4][2], const pg8::Unit2& u, int wr, int wc, int fr, int fq) const {
#pragma unroll
    for (int ai = 0; ai < 2; ++ai)
#pragma unroll
      for (int m = 0; m < 4; ++m) {
        const int row = u.pm * 256 + ai * 128 + wr * 64 + m * 16 + fr;
#pragma unroll
        for (int bj = 0; bj < 2; ++bj) {
          const int col = u.pn * 256 + bj * 128 + wc * 32 + 8 * fq;
          const u32x4 ga = *(const u32x4*)(h + (size_t)row * NC + C_GA + col), gb = *(const u32x4*)(h + (size_t)row * NC + C_GB + col);
#pragma unroll
          for (int j = 0; j < 4; ++j) {
            const float r0 = (1.f + __expf(-bf_lo(gb[j]))) * rcp_f(1.f + __expf(-bf_lo(ga[j])));
            const float r1 = (1.f + __expf(-bf_hi(gb[j]))) * rcp_f(1.f + __expf(-bf_hi(ga[j])));
            acc[ai][bj][m][j >> 1][2 * (j & 1)] *= r0; acc[ai][bj][m][j >> 1][2 * (j & 1) + 1] *= r1;
          }
        }
        __builtin_amdgcn_sched_barrier(0);
      }
  }
  DI void operator()(const f32x4 (&acc)[2][2][4][2], const pg8::Unit2& u, int wr, int wc, int fr, int fq) const {
#pragma unroll
    for (int ai = 0; ai < 2; ++ai)
#pragma unroll
      for (int m = 0; m < 4; ++m) {
        const int row = u.pm * 256 + ai * 128 + wr * 64 + m * 16 + fr;
#pragma unroll
        for (int bj = 0; bj < 2; ++bj) {
          const int col = u.pn * 256 + bj * 128 + wc * 32 + 8 * fq;
          const u32x4 gb = *(const u32x4*)(h + (size_t)row * NC + C_GB + col);
          const f32x4 a = acc[ai][bj][m][0], b = acc[ai][bj][m][1];
          u32x4 w;
          w.x = pk_bf16(a[0] * sigmoid_f(bf_lo(gb[0])), a[1] * sigmoid_f(bf_hi(gb[0])));
          w.y = pk_bf16(a[2] * sigmoid_f(bf_lo(gb[1])), a[3] * sigmoid_f(bf_hi(gb[1])));
          w.z = pk_bf16(b[0] * sigmoid_f(bf_lo(gb[2])), b[1] * sigmoid_f(bf_hi(gb[2])));
          w.w = pk_bf16(b[2] * sigmoid_f(bf_lo(gb[3])), b[3] * sigmoid_f(bf_hi(gb[3])));
          *(u32x4*)(mg + (size_t)row * 1024 + col) = w;
        }
        __builtin_amdgcn_sched_barrier(0);
      }
  }
};

struct EpiOut {
  static constexpr bool PERM = true, AFTER_DRAIN = false;
  const float* x; float* out;
  DI void operator()(const f32x4 (&acc)[2][2][4][2], const pg8::Unit& u, int wr, int wc, int fr, int fq) const {
#pragma unroll
    for (int ai = 0; ai < 2; ++ai)
#pragma unroll
      for (int m = 0; m < 4; ++m) {
        const int row = u.pm * 256 + ai * 128 + wr * 64 + m * 16 + fr;
#pragma unroll
        for (int bj = 0; bj < 2; ++bj) {
          const int col = u.pn * 256 + bj * 128 + wc * 32 + 8 * fq;
          const f32x4 x0 = *(const f32x4*)(x + (size_t)row * 1024 + col), x1 = *(const f32x4*)(x + (size_t)row * 1024 + col + 4);
          *(f32x4*)(out + (size_t)row * 1024 + col) = x0 * 1.189207115002721f + acc[ai][bj][m][0];
          *(f32x4*)(out + (size_t)row * 1024 + col + 4) = x1 * 1.189207115002721f + acc[ai][bj][m][1];
        }
      }
  }
};

#ifndef MK_MULTI
#define MK_MULTI 0
#endif
__global__ void __launch_bounds__(512, 2) fwd_megakernel(Params p) {
  cg::grid_group grid = cg::this_grid();
  __shared__ __attribute__((aligned(16))) unsigned char smem[SMEM_BYTES];
  const int w8 = __builtin_amdgcn_readfirstlane((int)(threadIdx.x >> 6));
  const int wvs = w8 & 3, half = w8 >> 2;
  unsigned char* hsm = smem + half * HALF_SMEM;
  const int vb = blockIdx.x + half * gridDim.x, nvb = 2 * gridDim.x;
  volatile LAS unsigned* st = (volatile LAS unsigned*)(smem + SMEM_BYTES - 16);
  { const int t0_ = opaque_tid(); if (t0_ < 4) st[t0_] = 0u; }
  __syncthreads();
  const XcdBarrier xb = xcd_barrier_post((unsigned*)(p.ws + OFF_BAR), st, w8);
  phase0(p, w8);
  if (p.ws == nullptr) grid.sync();
  xcd_barrier(xb);
  {
    pg8::Gemm g; g.A = (const pg8::bf16_t*)(p.ws + OFF_SC); g.Bt = (const pg8::bf16_t*)(p.ws + OFF_WINT); g.M = T_TOK; g.N = NCP; g.K = 1024;
    pg8::StaticOrder so; so.init(T_TOK, NCP, (int)gridDim.x, (int)blockIdx.x);
    EpiInProj e; e.h = (u16*)(p.ws + OFF_H);
    pg8::gemm_phase<EpiInProj, pg8::StaticOrder, true, true>((PG8_LAS unsigned char*)smem, g, so, e, opaque_tid_(w8));
  }
  xcd_barrier(xb);
  for (int it = vb; it < 2048; it += nvb) prep_item(p, wvs, it, hsm);
  xcd_barrier(xb);
  if (blockIdx.x < 128) {
    if (half == 0) { const int cb = (int)blockIdx.x; scan_chain(p, wvs, (cb & 7) + 8 * ((cb >> 3) >> 3), (cb >> 3) & 7, hsm); }
    else { __syncthreads(); for (int n = 0; n < 128; ++n) { __syncthreads(); __syncthreads(); } }
  } else {
    const int nsw = 2 * ((int)gridDim.x - 128), vbl = ((int)blockIdx.x - 128) + half * ((int)gridDim.x - 128);
    for (int k = 0; k * nsw < 1024; ++k) { const int it = vbl + k * nsw; swa_item(p, wvs, it < 1024 ? it : 0, it < 1024, hsm); }
  }
  xcd_barrier(xb);
  phase_ya(p, w8);
  xcd_barrier(xb);
  {
    pg8::Gemm2 g; g.A0 = (const pg8::bf16_t*)(p.ws + OFF_H); g.A1 = g.A0 + C_SWQ; g.B0 = (const pg8::bf16_t*)(p.ws + OFF_WAT); g.B1 = (const pg8::bf16_t*)(p.ws + OFF_WBT);
    g.lda = NC; g.K = 512;
    pg8::StaticOrder2 so; so.init(T_TOK, 1024, (int)gridDim.x, (int)blockIdx.x);
    EpiMerge e; e.h = (const u16*)(p.ws + OFF_H); e.mg = (u16*)(p.ws + OFF_SC);
    pg8::gemm_phase2<EpiMerge, pg8::StaticOrder2, true, true>((PG8_LAS unsigned char*)smem, g, so, e, opaque_tid_(w8));
  }
  xcd_barrier(xb);
  {
    pg8::Gemm g; g.A = (const pg8::bf16_t*)(p.ws + OFF_SC); g.Bt = (const pg8::bf16_t*)(p.ws + OFF_WOT); g.M = T_TOK; g.N = 1024; g.K = 1024;
    pg8::StaticOrder so; so.init(T_TOK, 1024, (int)gridDim.x, (int)blockIdx.x);
    EpiOut e; e.x = p.x; e.out = p.out;
    pg8::gemm_phase<EpiOut, pg8::StaticOrder, true, true>((PG8_LAS unsigned char*)smem, g, so, e, opaque_tid_(w8));
  }
  xcd_barrier(xb);
  phase6(p, w8, smem);
}

extern "C" void kernel_launch(void* const* d_in, const int* in_sizes, int n_in, void* d_out, int out_size,
                              void* d_ws, size_t ws_size, hipStream_t stream) {
  if (ws_size < WS_NEED) { fprintf(stderr, "workspace too small: %zu < %zu\n", ws_size, (size_t)WS_NEED); return; }
  Params p{};
  p.x = (const float*)d_in[0]; p.w_in = (const float*)d_in[1]; p.conv_w = (const float*)d_in[2]; p.a_log = (const float*)d_in[3];
  p.dt_bias = (const float*)d_in[4]; p.dn_norm_w = (const float*)d_in[5]; p.sinks = (const float*)d_in[6];
  p.w_branch = (const float*)d_in[7]; p.w_out = (const float*)d_in[8]; p.ln_g = (const float*)d_in[9]; p.ln_b = (const float*)d_in[10];
  p.out = (float*)d_out; p.ws = (unsigned char*)d_ws;
  for (int i = 0; i < 8; ++i) p.inv_freq[i] = (float)std::pow(500000.0, -(double)i / 8.0);
  static int grid_blocks = 0;
  if (!grid_blocks) {
    int dev = 0, cus = 0, per_cu = 0;
    (void)hipGetDevice(&dev);
    (void)hipDeviceGetAttribute(&cus, hipDeviceAttributeMultiprocessorCount, dev);
    (void)hipOccupancyMaxActiveBlocksPerMultiprocessor(&per_cu, fwd_megakernel, 512, 0);
    if (per_cu < 1) fprintf(stderr, "occupancy query reports %d workgroups per CU\n", per_cu);
    grid_blocks = cus > 256 ? 256 : cus;
    grid_blocks &= ~7;
  }
  (void)hipMemsetAsync(p.ws + OFF_BAR, 0, BAR_BYTES, stream);
  void* args[] = {&p};
  hipError_t e = hipLaunchCooperativeKernel((void*)fwd_megakernel, dim3(grid_blocks), dim3(512), args, 0, stream);
  if (e != hipSuccess) fprintf(stderr, "cooperative launch failed: %s (grid %d)\n", hipGetErrorString(e), grid_blocks);
}
```

```cpp
#include <hip/hip_runtime.h>
#include <hip/hip_cooperative_groups.h>
#include <cstdio>
#include <cmath>
namespace cg = cooperative_groups;

typedef unsigned short u16;
typedef short bf16x8 __attribute__((ext_vector_type(8)));
typedef float f32x4 __attribute__((ext_vector_type(4)));
typedef unsigned u32x4 __attribute__((ext_vector_type(4)));
typedef unsigned u32x2 __attribute__((ext_vector_type(2)));
#define DI __device__ __forceinline__
DI int opaque_tid_(int wave_s) { int t; asm volatile("v_mbcnt_lo_u32_b32 %0, -1, 0\n\tv_mbcnt_hi_u32_b32 %0, -1, %0" : "=v"(t)); return t + (wave_s << 6); }
#define opaque_tid() opaque_tid_(wvs)

constexpr int T_TOK = 32768, SEQ = 8192, DM = 1024, NC = 5384, NCP = 5376;
constexpr int C_DNZ = 1536, C_SWQ = 2056, C_SWK = 2568, C_SWV = 2696, C_SWZ = 2824, C_GA = 3336, C_GB = 4360;
constexpr size_t OFF_BAR = 0;
constexpr size_t BAR_BYTES = 16384;
constexpr size_t OFF_WINT = BAR_BYTES;
constexpr size_t OFF_WAT = OFF_WINT + (size_t)NCP * 1024 * 2;
constexpr size_t OFF_WBT = OFF_WAT + 1024 * 512 * 2;
constexpr size_t OFF_WOT = OFF_WBT + 1024 * 512 * 2;
constexpr size_t OFF_ROPE = OFF_WOT + 1024 * 1024 * 2;
constexpr size_t OFF_HB = OFF_ROPE + 2 * 8192 * 8 * 4;
constexpr size_t OFF_DEC = OFF_HB + (size_t)T_TOK * 8 * 4;
constexpr size_t OFF_H = OFF_DEC + 2048 * 4;
constexpr size_t OFF_SC = OFF_H + (size_t)T_TOK * NC * 2;
constexpr size_t OPB = 73728;
constexpr size_t WS_NEED = OFF_SC + 2048 * OPB;
constexpr int HALF_SMEM = 73728;
constexpr int SMEM_BYTES = 2 * HALF_SMEM + 16;

struct Params {
  const float *x, *w_in, *conv_w, *a_log, *dt_bias, *dn_norm_w, *sinks, *w_branch, *w_out, *ln_g, *ln_b;
  float* out; unsigned char* ws;
  float inv_freq[8];
};

typedef __bf16 bf16x2_t __attribute__((ext_vector_type(2)));
typedef float f32x2_t __attribute__((ext_vector_type(2)));
DI unsigned pk_bf16(float lo, float hi) { f32x2_t f = {lo, hi}; bf16x2_t v = __builtin_convertvector(f, bf16x2_t); return __builtin_bit_cast(unsigned, v); }
DI float bf_lo(unsigned u) { return __uint_as_float(u << 16); }
DI float bf_hi(unsigned u) { return __uint_as_float(u & 0xffff0000u); }
DI float bf2f(u16 v) { return __uint_as_float(((unsigned)v) << 16); }
DI u16 f2bf(float f) { return (u16)(pk_bf16(f, f) & 0xffffu); }
DI float shx(float v, int m, int lane) { return __uint_as_float((unsigned)__builtin_amdgcn_ds_bpermute((lane ^ m) << 2, (int)__float_as_uint(v))); }
DI float rcp_f(float y) { return __builtin_amdgcn_rcpf(y); }
DI float silu_f(float y) { return y * rcp_f(1.0f + __expf(-y)); }
DI float sigmoid_f(float y) { return rcp_f(1.0f + __expf(-y)); }
DI f32x4 mfma16(bf16x8 a, bf16x8 b, f32x4 c) { return __builtin_amdgcn_mfma_f32_16x16x32_bf16(a, b, c, 0, 0, 0); }
DI bf16x8 as_bf8(u32x4 v) { return __builtin_bit_cast(bf16x8, v); }
DI bf16x8 pack8(f32x4 a, f32x4 b) { u32x4 w; w.x = pk_bf16(a[0], a[1]); w.y = pk_bf16(a[2], a[3]); w.z = pk_bf16(b[0], b[1]); w.w = pk_bf16(b[2], b[3]); return as_bf8(w); }

DI void phase0(const Params& p, int wvs) {
  const size_t gt = (size_t)blockIdx.x * 512 + opaque_tid(), gs = (size_t)gridDim.x * 512;
  {
    const int ltid = (int)(gt & 511), lane = ltid & 63, wv = ltid >> 6;
    float wr[16][8];
#pragma unroll
    for (int j = 0; j < 4; ++j)
#pragma unroll
      for (int c = 0; c < 4; ++c) {
        const float* wp = p.w_in + (size_t)(4 * (lane + 64 * j) + c) * NC + 2048;
        const f32x4 a = *(const f32x4*)wp, b = *(const f32x4*)(wp + 4);
#pragma unroll
        for (int q = 0; q < 4; ++q) { wr[4 * j + c][q] = a[q]; wr[4 * j + c][4 + q] = b[q]; }
      }
    u16* xb = (u16*)(p.ws + OFF_SC);
    float* hb = (float*)(p.ws + OFF_HB);
    const int rstep = gridDim.x * 8;
    for (int row0 = blockIdx.x * 8 + wv; row0 < T_TOK; row0 += 2 * rstep) {
      f32x4 xr[2][4];
#pragma unroll
      for (int u = 0; u < 2; ++u) {
        const int row = row0 + u * rstep;
#pragma unroll
        for (int j = 0; j < 4; ++j) xr[u][j] = (row < T_TOK) ? *(const f32x4*)(p.x + (size_t)row * DM + 4 * (lane + 64 * j)) : (f32x4){0.f, 0.f, 0.f, 0.f};
      }
#pragma unroll
      for (int u = 0; u < 2; ++u) {
        const int row = row0 + u * rstep;
        float v[8];
#pragma unroll
        for (int q = 0; q < 8; ++q) v[q] = 0.f;
#pragma unroll
        for (int j = 0; j < 4; ++j) {
          const f32x4 xv = xr[u][j];
          u32x2 w; w.x = pk_bf16(xv[0], xv[1]); w.y = pk_bf16(xv[2], xv[3]);
          if (row < T_TOK) *(u32x2*)(xb + (size_t)row * DM + 4 * (lane + 64 * j)) = w;
#pragma unroll
          for (int c = 0; c < 4; ++c)
#pragma unroll
            for (int q = 0; q < 8; ++q) v[q] += xv[c] * wr[4 * j + c][q];
        }
        const bool up = (lane & 32) != 0;
        float k4[4];
#pragma unroll
        for (int i = 0; i < 4; ++i) { const float snd = up ? v[i] : v[i + 4]; const float kp = up ? v[i + 4] : v[i]; k4[i] = kp + shx(snd, 32, lane); }
        const bool up2 = (lane & 16) != 0;
        float k2[2];
#pragma unroll
        for (int i = 0; i < 2; ++i) { const float snd = up2 ? k4[i] : k4[i + 2]; const float kp = up2 ? k4[i + 2] : k4[i]; k2[i] = kp + shx(snd, 16, lane); }
        const bool up3 = (lane & 8) != 0;
        float k1 = (up3 ? k2[1] : k2[0]) + shx(up3 ? k2[0] : k2[1], 8, lane);
        k1 += shx(k1, 4, lane); k1 += shx(k1, 2, lane); k1 += shx(k1, 1, lane);
        if ((lane & 7) == 0 && row < T_TOK) hb[(size_t)row * 8 + (lane >> 3)] = k1;
      }
    }
  }
  {
    u32x4* wt = (u32x4*)(p.ws + OFF_WINT);
    for (size_t i = gt; i < (size_t)NCP * 128; i += gs) {
      const int kc = (int)(i / NCP), n = (int)(i % NCP);
      float v[8];
#pragma unroll
      for (int j = 0; j < 8; ++j) v[j] = p.w_in[(size_t)(kc * 8 + j) * NC + n + (n >= 2048 ? 8 : 0)];
      u32x4 w; w.x = pk_bf16(v[0], v[1]); w.y = pk_bf16(v[2], v[3]); w.z = pk_bf16(v[4], v[5]); w.w = pk_bf16(v[6], v[7]);
      wt[(size_t)n * 128 + kc] = w;
    }
  }
  {
    for (size_t i = gt; i < (size_t)2 * 1024 * 64; i += gs) {
      const int br = (int)(i / (1024 * 64)), rem = (int)(i % (1024 * 64)), kc = rem / 1024, n = rem % 1024;
      const float* src = p.w_branch + (size_t)br * 512 * 1024;
      float v[8];
#pragma unroll
      for (int j = 0; j < 8; ++j) v[j] = src[(size_t)(kc * 8 + j) * 1024 + n];
      u32x4 w; w.x = pk_bf16(v[0], v[1]); w.y = pk_bf16(v[2], v[3]); w.z = pk_bf16(v[4], v[5]); w.w = pk_bf16(v[6], v[7]);
      ((u32x4*)(p.ws + (br ? OFF_WBT : OFF_WAT)))[(size_t)n * 64 + kc] = w;
    }
  }
  {
    for (size_t i = gt; i < (size_t)1024 * 128; i += gs) {
      const int kc = (int)(i / 1024), n = (int)(i % 1024);
      float v[8];
#pragma unroll
      for (int j = 0; j < 8; ++j) v[j] = p.w_out[(size_t)(kc * 8 + j) * 1024 + n];
      u32x4 w; w.x = pk_bf16(v[0], v[1]); w.y = pk_bf16(v[2], v[3]); w.z = pk_bf16(v[4], v[5]); w.w = pk_bf16(v[6], v[7]);
      ((u32x4*)(p.ws + OFF_WOT))[(size_t)n * 128 + kc] = w;
    }
  }
  {
    float* rc = (float*)(p.ws + OFF_ROPE); float* rs = rc + 8192 * 8;
    for (size_t i = gt; i < 8192 * 8; i += gs) {
      const int t = (int)(i >> 3), f = (int)(i & 7);
      const float ang = (float)t * p.inv_freq[f];
      const double a = (double)ang;
      const double k = __builtin_rint(a * 0.15915494309189535);
      const float r = (float)(a - k * 6.283185307179586);
      rc[i] = cosf(r); rs[i] = sinf(r);
    }
  }
}

DI int lds_off32(int row, int chunk) { return row * 64 + ((chunk ^ ((0 - (row >> 2)) & 3)) << 4); }
constexpr int GSTAGE = 24576;

DI void gemm_kloop(const Params& p, int wvs, const u16* __restrict__ A, int lda, const u16* __restrict__ Bt, int ldb, int nk, int m0, int n0,
                   f32x4 (&acc)[4][8], unsigned char* smem) {
  const int tid = opaque_tid(), lane = tid & 63, wv = tid >> 6, wm = wv >> 1, wn = wv & 1, r16 = lane & 15, g = lane >> 4;
  const int prow = lane >> 2, pc = (lane & 3) ^ ((0 - (prow >> 2)) & 3);
  const u16* ap = A + (size_t)(m0 + 16 * wv + prow) * lda + pc * 8;
  const u16* bp = Bt + (size_t)(n0 + 16 * wv + prow) * ldb + pc * 8;
  unsigned char* lA = smem + wv * 1024;
  unsigned char* lB = smem + 8192 + wv * 1024;
#define GEMM_ISSUE(kt_, buf_) do { \
    _Pragma("unroll") for (int i_ = 0; i_ < 2; ++i_) \
      __builtin_amdgcn_global_load_lds((const unsigned*)(ap + (size_t)(64 * i_) * lda + (kt_) * 32), (unsigned*)(lA + (buf_) * GSTAGE + i_ * 4096), 16, 0, 0); \
    _Pragma("unroll") for (int i_ = 0; i_ < 4; ++i_) \
      __builtin_amdgcn_global_load_lds((const unsigned*)(bp + (size_t)(64 * i_) * ldb + (kt_) * 32), (unsigned*)(lB + (buf_) * GSTAGE + i_ * 4096), 16, 0, 0); \
  } while (0)
  GEMM_ISSUE(0, 0);
  GEMM_ISSUE(1, 1);
  asm volatile("s_waitcnt vmcnt(6)" ::: "memory");
  __builtin_amdgcn_s_barrier();
  int cb = 0;
  for (int kt = 0; kt < nk; ++kt) {
    int ib = cb + 2; if (ib >= 3) ib -= 3;
    const bool more = (kt + 2 < nk);
    if (more) GEMM_ISSUE(kt + 2, ib);
    const unsigned char* cur = smem + cb * GSTAGE;
    bf16x8 af[4], bfr[8];
#pragma unroll
    for (int i = 0; i < 4; ++i) af[i] = *(const bf16x8*)(cur + lds_off32(wm * 64 + i * 16 + r16, g));
#pragma unroll
    for (int i = 0; i < 8; ++i) bfr[i] = *(const bf16x8*)(cur + 8192 + lds_off32(wn * 128 + i * 16 + r16, g));
#pragma unroll
    for (int mi = 0; mi < 4; ++mi)
#pragma unroll
      for (int ni = 0; ni < 8; ++ni) acc[mi][ni] = mfma16(bfr[ni], af[mi], acc[mi][ni]);
    if (more) asm volatile("s_waitcnt vmcnt(6)" ::: "memory"); else asm volatile("s_waitcnt vmcnt(0)" ::: "memory");
    asm volatile("s_waitcnt lgkmcnt(0)" ::: "memory");
    __builtin_amdgcn_s_barrier();
    cb = cb + 1; if (cb >= 3) cb = 0;
  }
#undef GEMM_ISSUE
}

DI bool tile_of(int li, int ntn, int xcd, int& mt, int& nt) {
  if (li >= 32 * ntn) return false;
  const int grp = li / (8 * ntn), rem = li % (8 * ntn);
  nt = rem >> 3; mt = 32 * xcd + grp * 8 + (rem & 7);
  return true;
}

DI void zero_acc(f32x4 (&acc)[4][8]) {
#pragma unroll
  for (int i = 0; i < 4; ++i)
#pragma unroll
    for (int j = 0; j < 8; ++j) acc[i][j] = (f32x4){0.f, 0.f, 0.f, 0.f};
}

DI void phase1(const Params& p, int wvs, unsigned char* smem) {
  const int xcd = blockIdx.x & 7, lb = blockIdx.x >> 3, nlb = gridDim.x >> 3;
  const u16* xb = (const u16*)(p.ws + OFF_SC);
  const u16* wint = (const u16*)(p.ws + OFF_WINT);
  u16* h = (u16*)(p.ws + OFF_H);
  float* hb = (float*)(p.ws + OFF_HB);
  const int tid0 = opaque_tid(); const int lane = tid0 & 63, wv = tid0 >> 6, wm = wv >> 1, wn = wv & 1, r16 = lane & 15, g = lane >> 4;
  for (int li = lb;; li += nlb) {
    int mt, nt; if (!tile_of(li, 21, xcd, mt, nt)) break;
    f32x4 acc[4][8]; zero_acc(acc);
    gemm_kloop(p, wvs, xb, 1024, wint, 1024, 32, mt * 128, nt * 256, acc, smem);
#pragma unroll
    for (int mi = 0; mi < 4; ++mi) {
      const int row = mt * 128 + wm * 64 + mi * 16 + r16;
#pragma unroll
      for (int ni = 0; ni < 8; ++ni) {
        const int col = nt * 256 + wn * 128 + ni * 16 + 4 * g;
        {
          u32x2 w; w.x = pk_bf16(acc[mi][ni][0], acc[mi][ni][1]); w.y = pk_bf16(acc[mi][ni][2], acc[mi][ni][3]);
          *(u32x2*)(h + (size_t)row * NC + col + (nt >= 8 ? 8 : 0)) = w;
        }
      }
    }
  }
}

template <int I> DI void solve_rows2(f32x2_t (&xv)[64], const float* Lm, int lane, float lcur) {
  if constexpr (I < 64) {
    float lnx = 0.f;
    if constexpr (I + 1 < 64) lnx = Lm[(I + 1) * 68 + lane];
    f32x2_t a0 = xv[I], a1 = {0.f, 0.f}, a2 = {0.f, 0.f}, a3 = {0.f, 0.f};
#pragma unroll
    for (int m = 0; m < I; ++m) {
      const float l = __builtin_bit_cast(float, __builtin_amdgcn_readlane(__builtin_bit_cast(int, lcur), m));
      const f32x2_t lv = {l, l};
      if ((m & 3) == 0) a0 -= lv * xv[m];
      else if ((m & 3) == 1) a1 -= lv * xv[m];
      else if ((m & 3) == 2) a2 -= lv * xv[m];
      else a3 -= lv * xv[m];
    }
    xv[I] = (a0 + a1) + (a2 + a3);
    solve_rows2<I + 1>(xv, Lm, lane, lnx);
  }
}

DI void prep_item(const Params& p, int wvs, int item, unsigned char* smem) {
  const int tid_ = opaque_tid();
  const int tid = tid_, lane = tid & 63, wv = tid >> 6, r16 = lane & 15, g = lane >> 4;
  const int hd = item & 3, n = (item >> 2) & 127, b = item >> 9;
  const int t0 = b * SEQ + n * 64;
  u16* Qs = (u16*)smem; u16* Ks = Qs + 64 * 136; u16* Vs = Ks + 64 * 136;
  float* Lm = (float*)(smem + 52224);
  float* sm_beta = (float*)(smem + 69632);
  float* sm_gc = sm_beta + 64; float* sm_rq = sm_gc + 64; float* sm_rk = sm_rq + 64;
  float* sm_fw = sm_rk + 64; float* sm_fq = sm_fw + 64; float* sm_fk = sm_fq + 64;
  const u16* h = (const u16*)(p.ws + OFF_H);
  const float* hb = (const float*)(p.ws + OFF_HB);
  unsigned char* op = p.ws + OFF_SC + (size_t)item * OPB;
  __syncthreads();
  {
    const int c2 = tid & 63, rbase = (tid >> 6) * 16;
    unsigned raw[3][19];
#pragma unroll
    for (int mat = 0; mat < 3; ++mat) {
      const int col = mat * 512 + hd * 128 + 2 * c2;
#pragma unroll
      for (int j = 0; j < 19; ++j) {
        const int rr = t0 + rbase - 3 + j;
        raw[mat][j] = *(const unsigned*)(h + (size_t)(rr < 0 ? 0 : rr) * NC + col);
      }
    }
    __builtin_amdgcn_sched_barrier(0);
#pragma unroll
    for (int mat = 0; mat < 3; ++mat) {
      const int col = mat * 512 + hd * 128 + 2 * c2;
      float wa[4], wb[4];
#pragma unroll
      for (int j = 0; j < 4; ++j) { wa[j] = p.conv_w[j * 1536 + col]; wb[j] = p.conv_w[j * 1536 + col + 1]; }
      float xa[3], xb[3];
#pragma unroll
      for (int j = 0; j < 3; ++j) {
        const int pos = n * 64 + rbase - 3 + j;
        const unsigned v = (pos >= 0) ? raw[mat][j] : 0u;
        xa[j] = bf_lo(v); xb[j] = bf_hi(v);
      }
      u16* dst = (mat == 0 ? Qs : (mat == 1 ? Ks : Vs));
#pragma unroll
      for (int i = 0; i < 16; ++i) {
        const unsigned v = raw[mat][3 + i];
        const float a3 = bf_lo(v), b3 = bf_hi(v);
        const float ya = wa[0] * xa[0] + wa[1] * xa[1] + wa[2] * xa[2] + wa[3] * a3;
        const float yb = wb[0] * xb[0] + wb[1] * xb[1] + wb[2] * xb[2] + wb[3] * b3;
        xa[0] = xa[1]; xa[1] = xa[2]; xa[2] = a3; xb[0] = xb[1]; xb[1] = xb[2]; xb[2] = b3;
        *(unsigned*)(dst + (rbase + i) * 136 + 2 * c2) = pk_bf16(silu_f(ya), silu_f(yb));
      }
    }
  }
  __syncthreads();
  if (wv == 0) {
    const int row = t0 + lane;
    const float bl = hb[(size_t)row * 8 + hd], al = hb[(size_t)row * 8 + 4 + hd];
    const float xx = al + p.dt_bias[hd];
    const float ee = __expf(-fabsf(xx));
    const float sp = fmaxf(xx, 0.f) + ((ee < 1e-3f) ? ee * (1.f - 0.5f * ee) : __logf(1.f + ee));
    float gg = -__expf(p.a_log[hd]) * sp;
#pragma unroll
    for (int o = 1; o < 64; o <<= 1) { const float t = __uint_as_float((unsigned)__builtin_amdgcn_ds_bpermute(((lane - o) & 63) << 2, (int)__float_as_uint(gg))); if (lane >= o) gg += t; }
    sm_beta[lane] = rcp_f(1.0f + __expf(-bl)); sm_gc[lane] = gg;
  } else if (wv <= 2) {
    const int r = tid - 64;
    const u16* src = (r < 64) ? (Qs + r * 136) : (Ks + (r - 64) * 136);
    float ss = 0.f;
#pragma unroll
    for (int c = 0; c < 16; ++c) {
      const u32x4 v = *(const u32x4*)(src + c * 8);
#pragma unroll
      for (int j = 0; j < 4; ++j) { const float a = bf_lo(v[j]), bb = bf_hi(v[j]); ss += a * a + bb * bb; }
    }
    const float rs = rsqrtf(ss + 1e-6f);
    if (r < 64) sm_rq[r] = rs; else sm_rk[r - 64] = rs;
  }
  __syncthreads();
  if (tid < 64) {
    const float gc = sm_gc[tid], gl = sm_gc[63], eg = __expf(gc);
    sm_fw[tid] = sm_beta[tid] * eg * sm_rk[tid];
    sm_fq[tid] = sm_rq[tid] * 0.08838834764831845f * eg;
    sm_fk[tid] = sm_rk[tid] * __expf(gl - gc);
    if (tid == 0) ((float*)(p.ws + OFF_DEC))[item] = __expf(gl);
  }
  {
    bf16x8 kfi[4], qfi[4];
#pragma unroll
    for (int s = 0; s < 4; ++s) {
      kfi[s] = *(const bf16x8*)(Ks + (16 * wv + r16) * 136 + 32 * s + 8 * g);
      qfi[s] = *(const bf16x8*)(Qs + (16 * wv + r16) * 136 + 32 * s + 8 * g);
    }
    f32x4 at[4];
#pragma unroll
    for (int jt = 0; jt < 4; ++jt) {
      at[jt] = (f32x4){0.f, 0.f, 0.f, 0.f};
      if (jt <= wv) {
        f32x4 la = (f32x4){0.f, 0.f, 0.f, 0.f}, aa = (f32x4){0.f, 0.f, 0.f, 0.f};
#pragma unroll
        for (int s = 0; s < 4; ++s) {
          const bf16x8 kfj = *(const bf16x8*)(Ks + (16 * jt + r16) * 136 + 32 * s + 8 * g);
          la = mfma16(kfi[s], kfj, la);
          aa = mfma16(kfj, qfi[s], aa);
        }
#pragma unroll
        for (int r = 0; r < 4; ++r) {
          { const int i = 16 * wv + 4 * g + r, j = 16 * jt + r16;
            const float v = (i > j) ? sm_beta[i] * sm_rk[i] * sm_rk[j] * __expf(sm_gc[i] - sm_gc[j]) * la[r] : 0.f;
            Lm[i * 68 + j] = v; }
          { const int j = 16 * jt + 4 * g + r, i = 16 * wv + r16;
            at[jt][r] = (j <= i) ? sm_rq[i] * sm_rk[j] * 0.08838834764831845f * __expf(sm_gc[i] - sm_gc[j]) * aa[r] : 0.f; }
        }
      }
    }
#pragma unroll
    for (int s2 = 0; s2 < 2; ++s2)
      *(bf16x8*)(op + 32768 + (size_t)((wv * 2 + s2) * 64 + lane) * 16) = pack8(at[2 * s2], at[2 * s2 + 1]);
  }
  __syncthreads();
  f32x2_t xv[64];
  if (wv < 2) {
#pragma unroll
    for (int i = 0; i < 64; ++i) { xv[i].x = sm_beta[i] * bf2f(Vs[i * 136 + tid]); xv[i].y = sm_fw[i] * bf2f(Ks[i * 136 + tid]); }
    solve_rows2<1>(xv, Lm, lane, Lm[68 + lane]);
    const int sl = tid >> 4, dvl = tid & 15;
#pragma unroll
    for (int mt = 0; mt < 4; ++mt)
#pragma unroll
      for (int gg = 0; gg < 4; ++gg) {
        u32x2 w; w.x = pk_bf16(xv[16 * mt + 4 * gg].x, xv[16 * mt + 4 * gg + 1].x); w.y = pk_bf16(xv[16 * mt + 4 * gg + 2].x, xv[16 * mt + 4 * gg + 3].x);
        *(u32x2*)(op + 57344 + (size_t)((sl * 4 + mt) * 64 + gg * 16 + dvl) * 8) = w;
      }
  } else {
    const int t2 = tid - 128;
#pragma unroll 2
    for (int f = 0; f < 8; ++f) {
      const int e = t2 + 128 * f, frag = e >> 6, ln = e & 63, lr = ln & 15, lg = ln >> 4;
      {
        const int mt = frag >> 2, sx = frag & 3, row = 16 * mt + lr;
        const u32x2 ql = *(const u32x2*)(Qs + row * 136 + 32 * sx + 4 * lg), qh = *(const u32x2*)(Qs + row * 136 + 32 * sx + 16 + 4 * lg);
        const float fq = sm_fq[row];
        u32x4 w;
        w.x = pk_bf16(bf_lo(ql.x) * fq, bf_hi(ql.x) * fq); w.y = pk_bf16(bf_lo(ql.y) * fq, bf_hi(ql.y) * fq);
        w.z = pk_bf16(bf_lo(qh.x) * fq, bf_hi(qh.x) * fq); w.w = pk_bf16(bf_lo(qh.y) * fq, bf_hi(qh.y) * fq);
        *(u32x4*)(op + 16384 + (size_t)e * 16) = w;
      }
      {
        const int mt8 = frag >> 1, s2 = frag & 1, dk = 16 * mt8 + lr;
        float v[8];
#pragma unroll
        for (int j = 0; j < 8; ++j) {
          const int pos = 32 * s2 + 16 * (j >> 2) + 4 * lg + (j & 3);
          v[j] = bf2f(Ks[pos * 136 + dk]) * sm_fk[pos];
        }
        u32x4 w; w.x = pk_bf16(v[0], v[1]); w.y = pk_bf16(v[2], v[3]); w.z = pk_bf16(v[4], v[5]); w.w = pk_bf16(v[6], v[7]);
        *(u32x4*)(op + 40960 + (size_t)e * 16) = w;
      }
    }
  }
  __syncthreads();
  if (wv < 2) {
#pragma unroll
    for (int i = 0; i < 64; ++i) Vs[i * 136 + tid] = f2bf(-xv[i].y);
  }
  __syncthreads();
#pragma unroll
  for (int f = 0; f < 4; ++f) {
    const int e = tid + 256 * f, frag = e >> 6, ln = e & 63, lr = ln & 15, lg = ln >> 4;
    const int mt = frag >> 2, sx = frag & 3, row = 16 * mt + lr;
    const u32x2 lo = *(const u32x2*)(Vs + row * 136 + 32 * sx + 4 * lg), hi = *(const u32x2*)(Vs + row * 136 + 32 * sx + 16 + 4 * lg);
    *(u32x4*)(op + (size_t)e * 16) = (u32x4){lo.x, lo.y, hi.x, hi.y};
  }
}

struct ScanA { u32x4 wf[4]; u32x2 uf; float dec; };
struct ScanB { u32x4 qf[4], af[2], kf[4]; };

DI void scan_load_a(const Params& p, int wvs, ScanA& o, int b, int hd, int sl, int n, int q, int lane) {
  const int item = (b * 128 + n) * 4 + hd;
  const unsigned char* op = p.ws + OFF_SC + (size_t)item * OPB;
#pragma unroll
  for (int s = 0; s < 4; ++s) {
    o.wf[s] = *(const u32x4*)(op + (size_t)((q * 4 + s) * 64 + lane) * 16);
  }
  o.uf = *(const u32x2*)(op + 57344 + (size_t)((sl * 4 + q) * 64 + lane) * 8);
  o.dec = ((const float*)(p.ws + OFF_DEC))[item];
}
DI void scan_load_b(const Params& p, int wvs, ScanB& o, int b, int hd, int n, int q, int lane) {
  const int item = (b * 128 + n) * 4 + hd;
  const unsigned char* op = p.ws + OFF_SC + (size_t)item * OPB;
#pragma unroll
  for (int s = 0; s < 4; ++s) o.qf[s] = *(const u32x4*)(op + 16384 + (size_t)((q * 4 + s) * 64 + lane) * 16);
#pragma unroll
  for (int s2 = 0; s2 < 2; ++s2) o.af[s2] = *(const u32x4*)(op + 32768 + (size_t)((q * 2 + s2) * 64 + lane) * 16);
#pragma unroll
  for (int j = 0; j < 4; ++j) o.kf[j] = *(const u32x4*)(op + 40960 + (size_t)((q * 4 + j) * 64 + lane) * 16);
}

DI void scan_step(const Params& p, int wvs, const ScanA& o, const ScanB& ob, f32x4 (&S)[2], int b, int hd, int sl, int n, int q, int lane, unsigned char* smem) {
  const int r16 = lane & 15, g = lane >> 4;
  u32x4* ldsS = (u32x4*)smem;
  u32x2* ldsV = (u32x2*)(smem + 4096);
  ldsS[q * 64 + lane] = __builtin_bit_cast(u32x4, pack8(S[0], S[1]));
  __syncthreads();
  bf16x8 Sb[4];
#pragma unroll
  for (int s = 0; s < 4; ++s) Sb[s] = as_bf8(ldsS[s * 64 + lane]);
  f32x4 vn = (f32x4){bf_lo(o.uf.x), bf_hi(o.uf.x), bf_lo(o.uf.y), bf_hi(o.uf.y)};
#pragma unroll
  for (int s = 0; s < 4; ++s) vn = mfma16(as_bf8(o.wf[s]), Sb[s], vn);
  { u32x2 w; w.x = pk_bf16(vn[0], vn[1]); w.y = pk_bf16(vn[2], vn[3]); ldsV[((q >> 1) * 64 + lane) * 2 + (q & 1)] = w; }
  f32x4 oa = (f32x4){0.f, 0.f, 0.f, 0.f};
#pragma unroll
  for (int s = 0; s < 4; ++s) oa = mfma16(as_bf8(ob.qf[s]), Sb[s], oa);
  __syncthreads();
  bf16x8 Vb[2];
#pragma unroll
  for (int s2 = 0; s2 < 2; ++s2) Vb[s2] = as_bf8(*(const u32x4*)(ldsV + (s2 * 64 + lane) * 2));
#pragma unroll
  for (int s2 = 0; s2 < 2; ++s2) oa = mfma16(as_bf8(ob.af[s2]), Vb[s2], oa);
  u16* h = (u16*)(p.ws + OFF_H);
  const int t0 = b * SEQ + n * 64;
#pragma unroll
  for (int r = 0; r < 4; ++r) h[(size_t)(t0 + 16 * q + 4 * g + r) * NC + hd * 128 + 16 * sl + r16] = f2bf(oa[r]);
#pragma unroll
  for (int t = 0; t < 2; ++t) {
    S[t] = S[t] * o.dec;
#pragma unroll
    for (int s2 = 0; s2 < 2; ++s2) S[t] = mfma16(as_bf8(ob.kf[t * 2 + s2]), Vb[s2], S[t]);
  }
}

DI void scan_chain(const Params& p, int wvs, int pair, int sl, unsigned char* smem) {
  const int tid0 = opaque_tid(); const int lane = tid0 & 63, q = tid0 >> 6;
  const int b = pair >> 2, hd = pair & 3;
  f32x4 S[2]; S[0] = (f32x4){0.f, 0.f, 0.f, 0.f}; S[1] = S[0];
  ScanA a0, a1, a2; ScanB bc, bn;
  __syncthreads();
  scan_load_a(p, wvs, a0, b, hd, sl, 0, q, lane);
  scan_load_b(p, wvs, bc, b, hd, 0, q, lane);
  scan_load_a(p, wvs, a1, b, hd, sl, 1, q, lane);
#pragma unroll 1
  for (int n = 0; n < 129; n += 3) {
    if (n + 2 < 128) scan_load_a(p, wvs, a2, b, hd, sl, n + 2, q, lane);
    if (n + 1 < 128) scan_load_b(p, wvs, bn, b, hd, n + 1, q, lane);
    if (n < 128) scan_step(p, wvs, a0, bc, S, b, hd, sl, n, q, lane, smem);
    bc = bn;
    if (n + 3 < 128) scan_load_a(p, wvs, a0, b, hd, sl, n + 3, q, lane);
    if (n + 2 < 128) scan_load_b(p, wvs, bn, b, hd, n + 2, q, lane);
    if (n + 1 < 128) scan_step(p, wvs, a1, bc, S, b, hd, sl, n + 1, q, lane, smem);
    bc = bn;
    if (n + 4 < 128) scan_load_a(p, wvs, a1, b, hd, sl, n + 4, q, lane);
    if (n + 3 < 128) scan_load_b(p, wvs, bn, b, hd, n + 3, q, lane);
    if (n + 2 < 128) scan_step(p, wvs, a2, bc, S, b, hd, sl, n + 2, q, lane, smem);
    bc = bn;
  }
}

DI void swa_item(const Params& p, int wvs, int item, bool valid, unsigned char* smem) {
  if (!valid) { __syncthreads(); __syncthreads(); return; }
  const int tid_ = opaque_tid();
  const int tid = tid_, lane = tid & 63, wv = tid >> 6, r16 = lane & 15, g = lane >> 4;
  const int qt = item & 127, kvh = (item >> 7) & 1, b = item >> 8;
  const int kp0 = 64 * qt - 128;
  u16* Ksm = (u16*)smem;
  u16* Vt = (u16*)(smem + 27648);
  u16* h = (u16*)(p.ws + OFF_H);
  const float* rc = (const float*)(p.ws + OFF_ROPE); const float* rs = rc + 8192 * 8;
  __syncthreads();
  if (tid < 192) {
    const int kk = tid, pos = kp0 + kk;
    u32x4 lo = (u32x4){0, 0, 0, 0}, hi = lo;
    if (pos >= 0) {
      const u16* src = h + (size_t)(b * SEQ + pos) * NC + C_SWK + kvh * 64;
      const u32x4 a = *(const u32x4*)src, c = *(const u32x4*)(src + 8);
      const f32x4 c0 = *(const f32x4*)(rc + pos * 8), c1 = *(const f32x4*)(rc + pos * 8 + 4);
      const f32x4 s0 = *(const f32x4*)(rs + pos * 8), s1 = *(const f32x4*)(rs + pos * 8 + 4);
      float t1[8], t2[8], cs[8], sn[8], o1[8], o2[8];
#pragma unroll
      for (int j = 0; j < 4; ++j) { t1[2 * j] = bf_lo(a[j]); t1[2 * j + 1] = bf_hi(a[j]); t2[2 * j] = bf_lo(c[j]); t2[2 * j + 1] = bf_hi(c[j]);
        cs[j] = c0[j]; cs[4 + j] = c1[j]; sn[j] = s0[j]; sn[4 + j] = s1[j]; }
#pragma unroll
      for (int j = 0; j < 8; ++j) { o1[j] = t1[j] * cs[j] - t2[j] * sn[j]; o2[j] = t2[j] * cs[j] + t1[j] * sn[j]; }
#pragma unroll
      for (int j = 0; j < 4; ++j) { lo[j] = pk_bf16(o1[2 * j], o1[2 * j + 1]); hi[j] = pk_bf16(o2[2 * j], o2[2 * j + 1]); }
    }
    *(u32x4*)(Ksm + kk * 72) = lo; *(u32x4*)(Ksm + kk * 72 + 8) = hi;
  }
  for (int e = tid; e < 192 * 6; e += 256) {
    const int kk = e / 6, ch = 2 + e % 6, pos = kp0 + kk;
    u32x4 v = (u32x4){0, 0, 0, 0};
    if (pos >= 0) v = *(const u32x4*)(h + (size_t)(b * SEQ + pos) * NC + C_SWK + kvh * 64 + ch * 8);
    *(u32x4*)(Ksm + kk * 72 + ch * 8) = v;
  }
  for (int e = tid; e < 192 * 8; e += 256) {
    const int kk = e >> 3, ch = e & 7, pos = kp0 + kk;
    u32x4 v = (u32x4){0, 0, 0, 0};
    if (pos >= 0) v = *(const u32x4*)(h + (size_t)(b * SEQ + pos) * NC + C_SWV + kvh * 64 + ch * 8);
#pragma unroll
    for (int j = 0; j < 4; ++j) { Vt[(ch * 8 + 2 * j) * 200 + kk] = (u16)(v[j] & 0xffffu); Vt[(ch * 8 + 2 * j + 1) * 200 + kk] = (u16)(v[j] >> 16); }
  }
  __syncthreads();
  const int st = wv, jt0 = st < 2 ? st : 2;
  const int qi = 16 * st + r16;
  const int qpos = 64 * qt + qi, tq = b * SEQ + qpos;
#pragma unroll 1
  for (int hq = 0; hq < 4; ++hq) {
    const int head = kvh * 4 + hq;
    u16* qsrc = h + (size_t)tq * NC + C_SWQ + head * 64;
    bf16x8 qf[2];
    {
      const u32x4 a = *(const u32x4*)qsrc, c = *(const u32x4*)(qsrc + 8);
      u32x4 w = *(const u32x4*)(qsrc + 8 * g);
      if (g < 2) {
        const f32x4 c0 = *(const f32x4*)(rc + qpos * 8), c1 = *(const f32x4*)(rc + qpos * 8 + 4);
        const f32x4 s0 = *(const f32x4*)(rs + qpos * 8), s1 = *(const f32x4*)(rs + qpos * 8 + 4);
        float t1[8], t2[8], cs[8], sn[8], o[8];
#pragma unroll
        for (int j = 0; j < 4; ++j) { t1[2 * j] = bf_lo(a[j]); t1[2 * j + 1] = bf_hi(a[j]); t2[2 * j] = bf_lo(c[j]); t2[2 * j + 1] = bf_hi(c[j]);
          cs[j] = c0[j]; cs[4 + j] = c1[j]; sn[j] = s0[j]; sn[4 + j] = s1[j]; }
#pragma unroll
        for (int j = 0; j < 8; ++j) o[j] = (g == 0) ? (t1[j] * cs[j] - t2[j] * sn[j]) : (t2[j] * cs[j] + t1[j] * sn[j]);
#pragma unroll
        for (int j = 0; j < 4; ++j) w[j] = pk_bf16(o[2 * j], o[2 * j + 1]);
      }
      qf[0] = as_bf8(w);
      qf[1] = as_bf8(*(const u32x4*)(qsrc + 32 + 8 * g));
    }
    f32x4 sc[10];
#pragma unroll
    for (int t = 0; t < 10; ++t) {
      sc[t] = (f32x4){0.f, 0.f, 0.f, 0.f};
#pragma unroll
      for (int s = 0; s < 2; ++s) {
        const bf16x8 kf = *(const bf16x8*)(Ksm + (16 * (jt0 + t) + r16) * 72 + 32 * s + 8 * g);
        sc[t] = mfma16(kf, qf[s], sc[t]);
      }
    }
    const float sink = p.sinks[head];
    float mx = sink;
#pragma unroll
    for (int t = 0; t < 10; ++t)
#pragma unroll
      for (int r = 0; r < 4; ++r) {
        const int kk = 16 * (jt0 + t) + 4 * g + r, d = kk - qi;
        const bool ok = (d >= 1) && (d <= 128) && (kp0 + kk >= 0);
        const float v = ok ? sc[t][r] * 0.125f : -1e30f;
        sc[t][r] = v; mx = fmaxf(mx, v);
      }
    mx = fmaxf(mx, shx(mx, 16, lane)); mx = fmaxf(mx, shx(mx, 32, lane));
    float sum = 0.f;
#pragma unroll
    for (int t = 0; t < 10; ++t)
#pragma unroll
      for (int r = 0; r < 4; ++r) { const float e = __expf(sc[t][r] - mx); sc[t][r] = e; sum += e; }
    sum += shx(sum, 16, lane); sum += shx(sum, 32, lane);
    const float inv = rcp_f(sum + __expf(sink - mx));
    f32x4 oacc[4];
#pragma unroll
    for (int dt = 0; dt < 4; ++dt) oacc[dt] = (f32x4){0.f, 0.f, 0.f, 0.f};
#pragma unroll
    for (int s2 = 0; s2 < 5; ++s2) {
      const bf16x8 pb = pack8(sc[2 * s2], sc[2 * s2 + 1]);
#pragma unroll
      for (int dt = 0; dt < 4; ++dt) {
        const u16* vr = Vt + (16 * dt + r16) * 200 + 16 * (jt0 + 2 * s2) + 4 * g;
        const u32x2 lo = *(const u32x2*)vr, hi = *(const u32x2*)(vr + 16);
        oacc[dt] = mfma16(as_bf8((u32x4){lo.x, lo.y, hi.x, hi.y}), pb, oacc[dt]);
      }
    }
#pragma unroll
    for (int dt = 0; dt < 4; ++dt) {
      const int dcol = head * 64 + 16 * dt + 4 * g;
      const u32x2 z = *(const u32x2*)(h + (size_t)tq * NC + C_SWZ + dcol);
      u32x2 w;
      w.x = pk_bf16(oacc[dt][0] * inv * silu_f(bf_lo(z.x)), oacc[dt][1] * inv * silu_f(bf_hi(z.x)));
      w.y = pk_bf16(oacc[dt][2] * inv * silu_f(bf_lo(z.y)), oacc[dt][3] * inv * silu_f(bf_hi(z.y)));
      *(u32x2*)(h + (size_t)tq * NC + C_SWQ + dcol) = w;
    }
  }
}

DI void phase_ya(const Params& p, int wvs) {
  u16* h = (u16*)(p.ws + OFF_H);
  const int ltid = opaque_tid(), lane = ltid & 63;
  const size_t gt = (size_t)blockIdx.x * 512 + ltid, gs = (size_t)gridDim.x * 512;
  const float* nwp = p.dn_norm_w + (ltid & 15) * 8;
  const f32x4 nw0 = *(const f32x4*)nwp, nw1 = *(const f32x4*)(nwp + 4);
  for (size_t i0 = gt; i0 < (size_t)T_TOK * 64; i0 += 4 * gs) {
    u32x4 v[4], z[4];
#pragma unroll
    for (int k = 0; k < 4; ++k) {
      const size_t i = i0 + k * gs;
      if (i < (size_t)T_TOK * 64) {
        const u16* ptr = h + (size_t)(i >> 6) * NC + (i & 63) * 8;
        v[k] = *(const u32x4*)ptr; z[k] = *(const u32x4*)(ptr + C_DNZ);
      } else { v[k] = (u32x4){0, 0, 0, 0}; z[k] = v[k]; }
    }
#pragma unroll
    for (int k = 0; k < 4; ++k) {
      const size_t i = i0 + k * gs;
      float o[8]; float ss = 0.f;
#pragma unroll
      for (int j = 0; j < 4; ++j) { o[2 * j] = bf_lo(v[k][j]); o[2 * j + 1] = bf_hi(v[k][j]); }
#pragma unroll
      for (int j = 0; j < 8; ++j) ss += o[j] * o[j];
      ss += shx(ss, 1, lane); ss += shx(ss, 2, lane); ss += shx(ss, 4, lane); ss += shx(ss, 8, lane);
      const float rs = rsqrtf(ss * (1.0f / 128.0f) + 1e-6f);
      float y[8];
#pragma unroll
      for (int j = 0; j < 4; ++j) {
        const float w0 = (j < 2) ? nw0[2 * j] : nw1[2 * j - 4], w1 = (j < 2) ? nw0[2 * j + 1] : nw1[2 * j - 3];
        y[2 * j] = o[2 * j] * rs * w0 * silu_f(bf_lo(z[k][j]));
        y[2 * j + 1] = o[2 * j + 1] * rs * w1 * silu_f(bf_hi(z[k][j]));
      }
      u32x4 w; w.x = pk_bf16(y[0], y[1]); w.y = pk_bf16(y[2], y[3]); w.z = pk_bf16(y[4], y[5]); w.w = pk_bf16(y[6], y[7]);
      if (i < (size_t)T_TOK * 64) *(u32x4*)(h + (size_t)(i >> 6) * NC + (i & 63) * 8) = w;
    }
  }
}

DI void phase4(const Params& p, int wvs, int vb, int nvb, unsigned char* smem) {
  const int xcd = vb & 7, lb = vb >> 3, nlb = nvb >> 3;
  const u16* h = (const u16*)(p.ws + OFF_H);
  const u16* wat = (const u16*)(p.ws + OFF_WAT);
  const u16* wbt = (const u16*)(p.ws + OFF_WBT);
  u16* mg = (u16*)(p.ws + OFF_SC);
  const int tid0 = opaque_tid(); const int lane = tid0 & 63, wv = tid0 >> 6, wm = wv >> 1, wn = wv & 1, r16 = lane & 15, g = lane >> 4;
  for (int li = lb;; li += nlb) {
    int mt, nt; if (!tile_of(li, 4, xcd, mt, nt)) break;
    f32x4 acc[4][8]; zero_acc(acc);
    gemm_kloop(p, wvs, h, NC, wat, 512, 16, mt * 128, nt * 256, acc, smem);
#pragma unroll
    for (int mi = 0; mi < 4; ++mi) {
      const int row = mt * 128 + wm * 64 + mi * 16 + r16;
#pragma unroll
      for (int ni = 0; ni < 8; ++ni) {
        const int col = nt * 256 + wn * 128 + ni * 16 + 4 * g;
        const u32x2 ga = *(const u32x2*)(h + (size_t)row * NC + C_GA + col), gb = *(const u32x2*)(h + (size_t)row * NC + C_GB + col);
        acc[mi][ni][0] *= (1.f + __expf(-bf_lo(gb.x))) * rcp_f(1.f + __expf(-bf_lo(ga.x)));
        acc[mi][ni][1] *= (1.f + __expf(-bf_hi(gb.x))) * rcp_f(1.f + __expf(-bf_hi(ga.x)));
        acc[mi][ni][2] *= (1.f + __expf(-bf_lo(gb.y))) * rcp_f(1.f + __expf(-bf_lo(ga.y)));
        acc[mi][ni][3] *= (1.f + __expf(-bf_hi(gb.y))) * rcp_f(1.f + __expf(-bf_hi(ga.y)));
      }
      if (mi & 1) __builtin_amdgcn_sched_barrier(0);
    }
    gemm_kloop(p, wvs, h + C_SWQ, NC, wbt, 512, 16, mt * 128, nt * 256, acc, smem);
#pragma unroll
    for (int mi = 0; mi < 4; ++mi) {
      const int row = mt * 128 + wm * 64 + mi * 16 + r16;
#pragma unroll
      for (int ni = 0; ni < 8; ++ni) {
        const int col = nt * 256 + wn * 128 + ni * 16 + 4 * g;
        const u32x2 gb = *(const u32x2*)(h + (size_t)row * NC + C_GB + col);
        u32x2 w;
        w.x = pk_bf16(acc[mi][ni][0] * sigmoid_f(bf_lo(gb.x)), acc[mi][ni][1] * sigmoid_f(bf_hi(gb.x)));
        w.y = pk_bf16(acc[mi][ni][2] * sigmoid_f(bf_lo(gb.y)), acc[mi][ni][3] * sigmoid_f(bf_hi(gb.y)));
        *(u32x2*)(mg + (size_t)row * 1024 + col) = w;
      }
      if (mi & 1) __builtin_amdgcn_sched_barrier(0);
    }
  }
}

DI void phase5(const Params& p, int wvs, unsigned char* smem) {
  const int xcd = blockIdx.x & 7, lb = blockIdx.x >> 3, nlb = gridDim.x >> 3;
  const u16* mg = (const u16*)(p.ws + OFF_SC);
  const u16* wot = (const u16*)(p.ws + OFF_WOT);
  const int tid0 = opaque_tid(); const int lane = tid0 & 63, wv = tid0 >> 6, wm = wv >> 1, wn = wv & 1, r16 = lane & 15, g = lane >> 4;
  for (int li = lb;; li += nlb) {
    int mt, nt; if (!tile_of(li, 4, xcd, mt, nt)) break;
    f32x4 acc[4][8]; zero_acc(acc);
    gemm_kloop(p, wvs, mg, 1024, wot, 1024, 32, mt * 128, nt * 256, acc, smem);
#pragma unroll
    for (int mi = 0; mi < 4; ++mi) {
      const int row = mt * 128 + wm * 64 + mi * 16 + r16;
#pragma unroll
      for (int ni = 0; ni < 8; ++ni) {
        const int col = nt * 256 + wn * 128 + ni * 16 + 4 * g;
        const f32x4 xv = *(const f32x4*)(p.x + (size_t)row * 1024 + col);
        *(f32x4*)(p.out + (size_t)row * 1024 + col) = xv * 1.189207115002721f + acc[mi][ni];
      }
    }
  }
}

DI float wave_sum(float v, int lane) {
#pragma unroll
  for (int o = 32; o > 0; o >>= 1) v += shx(v, o, lane);
  return v;
}
DI void phase6(const Params& p, int wvs, unsigned char* smem) {
  const int tid = opaque_tid(), lane = tid & 63, wv = tid >> 6;
  f32x4 gm[4], bt[4];
#pragma unroll
  for (int j = 0; j < 4; ++j) { gm[j] = *(const f32x4*)(p.ln_g + 4 * (lane + 64 * j)); bt[j] = *(const f32x4*)(p.ln_b + 4 * (lane + 64 * j)); }
  const int xcd6 = blockIdx.x & 7, lb6 = blockIdx.x >> 3, nlb6 = gridDim.x >> 3;
  for (int lr = (lb6 * 8 + wv) * 2; lr < 4096; lr += nlb6 * 16) {
    float* r0 = p.out + (size_t)(4096 * xcd6 + (4095 - lr)) * 1024;
    float* r1 = p.out + (size_t)(4096 * xcd6 + (4094 - lr)) * 1024;
    f32x4 a[4], b[4];
#pragma unroll
    for (int j = 0; j < 4; ++j) { a[j] = *(const f32x4*)(r0 + 4 * (lane + 64 * j)); b[j] = *(const f32x4*)(r1 + 4 * (lane + 64 * j)); }
    float sa = 0.f, sb = 0.f;
#pragma unroll
    for (int j = 0; j < 4; ++j) { sa += (a[j][0] + a[j][1]) + (a[j][2] + a[j][3]); sb += (b[j][0] + b[j][1]) + (b[j][2] + b[j][3]); }
    const float ma = wave_sum(sa, lane) * (1.0f / 1024.0f), mb = wave_sum(sb, lane) * (1.0f / 1024.0f);
    float qa = 0.f, qb = 0.f;
#pragma unroll
    for (int j = 0; j < 4; ++j) {
      a[j] = a[j] - ma; b[j] = b[j] - mb;
      qa += (a[j][0] * a[j][0] + a[j][1] * a[j][1]) + (a[j][2] * a[j][2] + a[j][3] * a[j][3]);
      qb += (b[j][0] * b[j][0] + b[j][1] * b[j][1]) + (b[j][2] * b[j][2] + b[j][3] * b[j][3]);
    }
    const float ra = rsqrtf(wave_sum(qa, lane) * (1.0f / 1024.0f) + 1e-5f), rb = rsqrtf(wave_sum(qb, lane) * (1.0f / 1024.0f) + 1e-5f);
#pragma unroll
    for (int j = 0; j < 4; ++j) {
      *(f32x4*)(r0 + 4 * (lane + 64 * j)) = a[j] * ra * gm[j] + bt[j];
      *(f32x4*)(r1 + 4 * (lane + 64 * j)) = b[j] * rb * gm[j] + bt[j];
    }
  }
}

#define XB_TMO      128
#define XB_XCNT(j)  (256  + 64 * (j))
#define XB_XSUB(j)  (1280 + 64 * (j))
#define XB_XGEN(j)  (2304 + 64 * (j))
#define XB_TOP      3328
#define XB_TOPGEN   3392
#define XCD_BAR_WORDS 3456
#define XB_SPIN_CAP (1u << 22)
#define LAS __attribute__((address_space(3)))
DI unsigned xb_ld(unsigned* p) { return __hip_atomic_load(p, __ATOMIC_RELAXED, __HIP_MEMORY_SCOPE_AGENT); }
DI unsigned xb_add(unsigned* p, unsigned v) { return __hip_atomic_fetch_add(p, v, __ATOMIC_RELAXED, __HIP_MEMORY_SCOPE_AGENT); }
DI unsigned xb_xcc_id() { return (unsigned)__builtin_amdgcn_s_getreg((3 << 11) | 20) & 0xFu; }
#define XB_SPIN(cond, bar) do { unsigned _sp = 0; while (cond) { __builtin_amdgcn_s_sleep(1); \
    if ((++_sp & 255u) == 0u) { if (xb_ld(&(bar)[XB_TMO])) break; if (_sp > XB_SPIN_CAP) { atomicAdd(&(bar)[XB_TMO], 1u); break; } } } } while (0)
struct XcdBarrier { unsigned* bar; unsigned x; volatile LAS unsigned* st; };
DI bool xb_leader(int wvs) { return wvs == 0 && __builtin_amdgcn_mbcnt_hi(~0u, __builtin_amdgcn_mbcnt_lo(~0u, 0u)) == 0u; }
DI XcdBarrier xcd_barrier_post(unsigned* bar, volatile LAS unsigned* st, int wvs) {
  XcdBarrier b; b.bar = bar; b.x = xb_xcc_id(); b.st = st;
  if (xb_leader(wvs)) (void)xb_add(&bar[XB_XCNT(b.x)], 1u);
  return b;
}
DI void xcd_barrier_complete(unsigned* bar, unsigned x, unsigned& nloc, unsigned& nx) {
  const unsigned G = gridDim.x * gridDim.y * gridDim.z;
  unsigned sum, cnt, mine, sp = 0u;
  for (;;) {
    sum = 0u; cnt = 0u; mine = 0u;
#pragma unroll
    for (unsigned j = 0; j < 16; ++j) { const unsigned c = xb_ld(&bar[XB_XCNT(j)]); sum += c; cnt += (c > 0u) ? 1u : 0u; mine = (j == x) ? c : mine; }
    if (sum == G) break;
    __builtin_amdgcn_s_sleep(1);
    if ((++sp & 255u) == 0u) { if (xb_ld(&bar[XB_TMO])) break; if (sp > XB_SPIN_CAP) { atomicAdd(&bar[XB_TMO], 1u); break; } }
  }
  nloc = mine > 0u ? mine : 1u; nx = cnt > 0u ? cnt : 1u;
}
DI void xcd_barrier_(const XcdBarrier& b, int wvs) {
  asm volatile("s_waitcnt vmcnt(0)" ::: "memory");
  __syncthreads();
  if (xb_leader(wvs)) {
    unsigned* bar = b.bar;
    __builtin_amdgcn_s_waitcnt(0);
    unsigned nloc = b.st[0], nx = b.st[1];
    if (nloc == 0u) { xcd_barrier_complete(bar, b.x, nloc, nx); b.st[0] = nloc; b.st[1] = nx; }
    const unsigned old = xb_add(&bar[XB_XSUB(b.x)], 1u);
    const unsigned gen = old / nloc;
    if (old + 1u == (gen + 1u) * nloc) {
      __builtin_amdgcn_fence(__ATOMIC_RELEASE, "agent");
      asm volatile("s_waitcnt vmcnt(0)" ::: "memory");
      const unsigned og = xb_add(&bar[XB_TOP], 1u);
      const unsigned tg = og / nx;
      if (og + 1u == (tg + 1u) * nx) xb_add(&bar[XB_TOPGEN], 1u);
      else XB_SPIN(xb_ld(&bar[XB_TOPGEN]) == tg, bar);
      __builtin_amdgcn_fence(__ATOMIC_ACQUIRE, "agent");
      xb_add(&bar[XB_XGEN(b.x)], 1u);
      asm volatile("s_waitcnt vmcnt(0)" ::: "memory");
    } else {
      XB_SPIN(xb_ld(&bar[XB_XGEN(b.x)]) == gen, bar);
      __builtin_amdgcn_fence(__ATOMIC_ACQUIRE, "agent");
      asm volatile("s_waitcnt vmcnt(0)" ::: "memory");
    }
  }
  __syncthreads();
}

#define xcd_barrier(b) xcd_barrier_(b, w8)
namespace pg8 {
#define PG8_LAS __attribute__((address_space(3)))
typedef unsigned short bf16_t;
typedef short bf16x8 __attribute__((ext_vector_type(8)));
typedef float f32x4 __attribute__((ext_vector_type(4)));
typedef unsigned u32x4 __attribute__((ext_vector_type(4)));
constexpr int BM = 256, BK = 64, HALF = 128, HTB = HALF * BK * 2  , STAGE_BYTES = 8 * HTB, NXCD = 8, WGM = 8;

__host__ __device__ __forceinline__ int lds_byte(int r, int c) { const int st = (r >> 4) * 2 + (c >> 5), rr = r & 15, cc = c & 31, ob = rr * 64 + cc * 2; return st * 1024 + (ob ^ (((ob >> 9) & 1) << 5)); }
__host__ __device__ __forceinline__ void stage_rc(int b, int& R, int& C) { const int st = b / 1024, sb = b % 1024, swz = sb ^ (((sb >> 9) & 1) << 5); R = (st >> 1) * 16 + swz / 64; C = (st & 1) * 32 + (swz % 64) / 2; }
__host__ __device__ __forceinline__ int perm32(int rho) { const int n = rho >> 4, i = rho & 15; return 8 * (i >> 2) + 4 * n + (i & 3); }

struct Unit { int pm, pn; };
struct Gemm { const bf16_t* A; const bf16_t* Bt; int M, N, K; };

struct StaticOrder {
    int nM, nN, nwg, G, c;
    __host__ __device__ void init(int M, int N, int G_, int c_) { nM = M / BM; nN = N / BM; nwg = nM * nN; G = G_; c = c_; }
    __host__ __device__ bool next(int i, Unit& u) const {
        const long L = (long)i * G + c; if (L >= nwg) return false;
        int wgid = (int)L; { const int q = nwg / NXCD, r = nwg % NXCD, xcd = wgid % NXCD, off = wgid / NXCD; wgid = (xcd < r ? xcd * (q + 1) : r * (q + 1) + (xcd - r) * q) + off; }
        const int nig = WGM * nN, gid = wgid / nig, fm = gid * WGM, gsz = (nM - fm) < WGM ? (nM - fm) : WGM;
        u.pm = fm + ((wgid % nig) % gsz); u.pn = (wgid % nig) / gsz; return true;
    }
    __device__ __forceinline__ void a_ready(const Unit&) const {}
    __device__ __forceinline__ void done(const Unit&) const {}
};

template <class Epi, class Sched, bool ALIGN_EPI = false, bool SP2 = false>
__device__ __forceinline__ void gemm_phase(PG8_LAS unsigned char* lds, const Gemm g, const Sched& S, const Epi& E, const int tid) {
    const int wid = __builtin_amdgcn_readfirstlane(tid >> 6), lane = tid & 63, wr = wid >> 2, wc = wid & 3, fr = lane & 15, fq = lane >> 4;
    const int K = g.K, nt = K / BK;
    unsigned voffA[2], voffB[2];
#pragma unroll
    for (int i = 0; i < 2; ++i) { int R, C; stage_rc(tid * 16 + i * 8192, R, C); const int Rb = Epi::PERM ? ((R & ~31) + perm32(R & 31)) : R;
        voffA[i] = (unsigned)(R * K + C) * 2u; voffB[i] = (unsigned)(Rb * K + C) * 2u; }
    const size_t kstep = (size_t)(BK * 2);
    const size_t hstep = (size_t)HALF * K * 2;
    const size_t tstep = 2 * hstep;
    const unsigned ldsw = (unsigned)wid * 1024u;
    const int aoff = lds_byte(wr * 64 + fr, fq * 8), boff = lds_byte(wc * 32 + fr, fq * 8);
#define PG8_SA(b, h) (((b) * 2 + (h)) * HTB)
#define PG8_SB(b, h) ((4 + (b) * 2 + (h)) * HTB)
#define PG8_STAGE(bufoff, gbase, voff) do { _Pragma("unroll") for (int _i = 0; _i < 2; ++_i) \
        __builtin_amdgcn_global_load_lds((const unsigned*)((const char*)(gbase) + (voff)[_i]), (PG8_LAS unsigned*)(lds + (bufoff) + ldsw + _i * 8192), 16, 0, 0); } while (0)
#define PG8_LDA(dst, b, h) do { _Pragma("unroll") for (int m = 0; m < 4; ++m) _Pragma("unroll") for (int k = 0; k < 2; ++k) dst[m][k] = *(const PG8_LAS bf16x8*)(lds + PG8_SA(b, h) + aoff + m * 2048 + k * 1024); } while (0)
#define PG8_LDB(dst, b, h) do { _Pragma("unroll") for (int n = 0; n < 2; ++n) _Pragma("unroll") for (int k = 0; k < 2; ++k) dst[n][k] = *(const PG8_LAS bf16x8*)(lds + PG8_SB(b, h) + boff + n * 2048 + k * 1024); } while (0)
#define PG8_MMA(ai, bj, At, Bt) do { __builtin_amdgcn_s_setprio(1); _Pragma("unroll") for (int m = 0; m < 4; ++m) _Pragma("unroll") for (int n = 0; n < 2; ++n) _Pragma("unroll") for (int k = 0; k < 2; ++k) \
        acc[ai][bj][m][n] = __builtin_amdgcn_mfma_f32_16x16x32_bf16(Bt[n][k], At[m][k], acc[ai][bj][m][n], 0, 0, 0); __builtin_amdgcn_s_setprio(0); } while (0)
#define PG8_WAIT_V(n) asm volatile("s_waitcnt vmcnt(" #n ")" ::: "memory")
#define PG8_WAIT_L(n) asm volatile("s_waitcnt lgkmcnt(" #n ")" ::: "memory")
#define PG8_BAR __builtin_amdgcn_s_barrier()
#define PG8_SCHED __builtin_amdgcn_sched_barrier(0)
    Unit cur, nxt; int ui = 0;
    if (!S.next(0, cur)) return;
    f32x4 acc[2][2][4][2];
#pragma unroll
    for (int a = 0; a < 2; ++a)
#pragma unroll
        for (int b = 0; b < 2; ++b)
#pragma unroll
            for (int m = 0; m < 4; ++m)
#pragma unroll
                for (int n = 0; n < 2; ++n) acc[a][b][m][n] = (f32x4){0.f, 0.f, 0.f, 0.f};
    bf16x8 At[4][2], B0[2][2], B1[2][2];
    const char* cA = (const char*)g.A + (size_t)cur.pm * tstep; const char* cB = (const char*)g.Bt + (size_t)cur.pn * tstep;
    S.a_ready(cur);
    if constexpr (SP2) {
        PG8_STAGE(PG8_SB(0, 0), cB, voffB); PG8_STAGE(PG8_SB(0, 1), cB + hstep, voffB); PG8_STAGE(PG8_SA(0, 0), cA, voffA); PG8_STAGE(PG8_SA(0, 1), cA + hstep, voffA);
        if (wr == 1) PG8_BAR;
        PG8_WAIT_V(2); PG8_BAR;
        PG8_STAGE(PG8_SB(1, 0), cB + kstep, voffB); PG8_STAGE(PG8_SA(1, 0), cA + kstep, voffA); PG8_STAGE(PG8_SB(1, 1), cB + hstep + kstep, voffB);
        PG8_WAIT_V(6); PG8_BAR;
    } else {
        PG8_STAGE(PG8_SB(0, 0), cB, voffB); PG8_STAGE(PG8_SA(0, 0), cA, voffA); PG8_STAGE(PG8_SB(0, 1), cB + hstep, voffB); PG8_STAGE(PG8_SA(0, 1), cA + hstep, voffA);
        if (wr == 1) PG8_BAR;
        PG8_WAIT_V(4); PG8_BAR;
        PG8_STAGE(PG8_SB(1, 0), cB + kstep, voffB); PG8_STAGE(PG8_SA(1, 0), cA + kstep, voffA); PG8_STAGE(PG8_SB(1, 1), cB + hstep + kstep, voffB);
        PG8_WAIT_V(6); PG8_BAR;
    }
    for (;;) {
        const bool has_next = S.next(ui + 1, nxt);
        const char* nA = has_next ? (const char*)g.A + (size_t)nxt.pm * tstep : cA; const char* nB = has_next ? (const char*)g.Bt + (size_t)nxt.pn * tstep : cB;
        for (int t = 0; t < nt; t += 2) {
            const bool last = (t == nt - 2);
            const char* a1 = cA + (size_t)(t + 1) * kstep;
            const char* a2 = last ? nA : cA + (size_t)(t + 2) * kstep; const char* b2 = last ? nB : cB + (size_t)(t + 2) * kstep;
            const char* a3 = a2 + kstep; const char* b3 = b2 + kstep;
            if (last && has_next) S.a_ready(nxt);
            if constexpr (SP2) {
            PG8_LDB(B0, 0, 0); PG8_LDB(B1, 0, 1); PG8_SCHED; PG8_LDA(At, 0, 0); PG8_STAGE(PG8_SA(1, 1), a1 + hstep, voffA);
            PG8_WAIT_V(8); PG8_WAIT_L(0); PG8_BAR; PG8_MMA(0, 0, At, B0); PG8_MMA(0, 1, At, B1); PG8_BAR; PG8_SCHED;
            PG8_LDA(At, 0, 1); PG8_STAGE(PG8_SB(0, 0), b2, voffB); PG8_STAGE(PG8_SB(0, 1), b2 + hstep, voffB); PG8_STAGE(PG8_SA(0, 0), a2, voffA);
            PG8_WAIT_V(8); PG8_WAIT_L(0); PG8_BAR; PG8_MMA(1, 0, At, B0); PG8_MMA(1, 1, At, B1); PG8_BAR; PG8_SCHED;
            PG8_LDB(B0, 1, 0); PG8_LDB(B1, 1, 1); PG8_SCHED; PG8_LDA(At, 1, 0); PG8_STAGE(PG8_SA(0, 1), a2 + hstep, voffA);
            PG8_WAIT_V(8); PG8_WAIT_L(0); PG8_BAR; PG8_MMA(0, 0, At, B0); PG8_MMA(0, 1, At, B1); PG8_BAR; PG8_SCHED;
            PG8_LDA(At, 1, 1); PG8_STAGE(PG8_SB(1, 0), b3, voffB); PG8_STAGE(PG8_SB(1, 1), b3 + hstep, voffB); PG8_STAGE(PG8_SA(1, 0), a3, voffA);
            PG8_WAIT_V(8); PG8_WAIT_L(0); PG8_BAR; PG8_MMA(1, 0, At, B0); PG8_MMA(1, 1, At, B1); PG8_BAR; PG8_SCHED;
            } else {
            PG8_LDB(B0, 0, 0); PG8_SCHED; PG8_LDA(At, 0, 0); PG8_STAGE(PG8_SA(1, 1), a1 + hstep, voffA);
            PG8_WAIT_L(8); PG8_BAR; PG8_WAIT_L(0); PG8_MMA(0, 0, At, B0); PG8_BAR; PG8_SCHED;
            PG8_LDB(B1, 0, 1); PG8_STAGE(PG8_SB(0, 0), b2, voffB);
            PG8_BAR; PG8_WAIT_L(0); PG8_MMA(0, 1, At, B1); PG8_BAR;
            PG8_LDA(At, 0, 1); PG8_STAGE(PG8_SA(0, 0), a2, voffA);
            PG8_BAR; PG8_WAIT_L(0); PG8_MMA(1, 0, At, B0); PG8_BAR; PG8_SCHED;
            PG8_STAGE(PG8_SB(0, 1), b2 + hstep, voffB);
            PG8_WAIT_V(6); PG8_BAR; PG8_MMA(1, 1, At, B1); PG8_BAR;
            PG8_LDB(B0, 1, 0); PG8_SCHED; PG8_LDA(At, 1, 0); PG8_STAGE(PG8_SA(0, 1), a2 + hstep, voffA);
            PG8_WAIT_L(8); PG8_BAR; PG8_WAIT_L(0); PG8_MMA(0, 0, At, B0); PG8_BAR; PG8_SCHED;
            PG8_LDB(B1, 1, 1); PG8_STAGE(PG8_SB(1, 0), b3, voffB);
            PG8_BAR; PG8_WAIT_L(0); PG8_MMA(0, 1, At, B1); PG8_BAR;
            PG8_LDA(At, 1, 1); PG8_STAGE(PG8_SA(1, 0), a3, voffA);
            PG8_BAR; PG8_WAIT_L(0); PG8_MMA(1, 0, At, B0); PG8_BAR; PG8_SCHED;
            PG8_STAGE(PG8_SB(1, 1), b3 + hstep, voffB);
            PG8_WAIT_V(6); PG8_BAR; PG8_MMA(1, 1, At, B1); PG8_BAR;
            }
        }
        if constexpr (ALIGN_EPI) { if (wr == 0) PG8_BAR; }
        if constexpr (!Epi::AFTER_DRAIN) { E(acc, cur, wr, wc, fr, fq); S.done(cur); }
        if (!has_next) break;
#pragma unroll
        for (int a = 0; a < 2; ++a)
#pragma unroll
            for (int b = 0; b < 2; ++b)
#pragma unroll
                for (int m = 0; m < 4; ++m)
#pragma unroll
                    for (int n = 0; n < 2; ++n) acc[a][b][m][n] = (f32x4){0.f, 0.f, 0.f, 0.f};
        cur = nxt; cA = nA; cB = nB; ++ui;
        if constexpr (ALIGN_EPI) { if (wr == 1) PG8_BAR; }
    }
    PG8_WAIT_V(0);
    if constexpr (!ALIGN_EPI) { if (wr == 0) PG8_BAR; }
    PG8_BAR;
    if constexpr (Epi::AFTER_DRAIN) { E.fused(acc, cur, wr, wc, fr, fq, lds, wid, lane); S.done(cur); }
#undef PG8_SA
#undef PG8_SB
#undef PG8_STAGE
#undef PG8_LDA
#undef PG8_LDB
#undef PG8_MMA
#undef PG8_WAIT_V
#undef PG8_WAIT_L
#undef PG8_BAR
#undef PG8_SCHED
}

struct Unit2 { int pm, pn, part; };
struct Gemm2 { const bf16_t* A0; const bf16_t* A1; const bf16_t* B0; const bf16_t* B1; int lda, K; };
struct StaticOrder2 {
    int nM, nN, nwg, G, c;
    __host__ __device__ void init(int M, int N, int G_, int c_) { nM = M / BM; nN = N / BM; nwg = nM * nN; G = G_; c = c_; }
    __host__ __device__ bool next(int i, Unit2& u) const {
        const long L = (long)(i >> 1) * G + c; if (L >= nwg) return false;
        int wgid = (int)L; { const int q = nwg / NXCD, r = nwg % NXCD, xcd = wgid % NXCD, off = wgid / NXCD; wgid = (xcd < r ? xcd * (q + 1) : r * (q + 1) + (xcd - r) * q) + off; }
        const int nig = WGM * nN, gid = wgid / nig, fm = gid * WGM, gsz = (nM - fm) < WGM ? (nM - fm) : WGM;
        u.pm = fm + ((wgid % nig) % gsz); u.pn = (wgid % nig) / gsz; u.part = i & 1; return true;
    }
    __device__ __forceinline__ void a_ready(const Unit2&) const {}
    __device__ __forceinline__ void done(const Unit2&) const {}
};
template <class Epi, class Sched, bool ALIGN_EPI = false, bool SP2 = false>
__device__ __forceinline__ void gemm_phase2(PG8_LAS unsigned char* lds, const Gemm2 g, const Sched& S, const Epi& E, const int tid) {
    const int wid = __builtin_amdgcn_readfirstlane(tid >> 6), lane = tid & 63, wr = wid >> 2, wc = wid & 3, fr = lane & 15, fq = lane >> 4;
    const int K = g.K, nt = K / BK;
    unsigned voffA[2], voffB[2];
#pragma unroll
    for (int i = 0; i < 2; ++i) { int R, C; stage_rc(tid * 16 + i * 8192, R, C); const int Rb = Epi::PERM ? ((R & ~31) + perm32(R & 31)) : R;
        voffA[i] = (unsigned)(R * g.lda + C) * 2u; voffB[i] = (unsigned)(Rb * K + C) * 2u; }
    const size_t kstep = (size_t)(BK * 2);
    const size_t hstep = (size_t)HALF * K * 2;
    const size_t tstep = 2 * hstep;
    const size_t hstepA = (size_t)HALF * g.lda * 2, tstepA = 2 * hstepA;
    const unsigned ldsw = (unsigned)wid * 1024u;
    const int aoff = lds_byte(wr * 64 + fr, fq * 8), boff = lds_byte(wc * 32 + fr, fq * 8);
#define PG8_SA(b, h) (((b) * 2 + (h)) * HTB)
#define PG8_SB(b, h) ((4 + (b) * 2 + (h)) * HTB)
#define PG8_STAGE(bufoff, gbase, voff) do { _Pragma("unroll") for (int _i = 0; _i < 2; ++_i) \
        __builtin_amdgcn_global_load_lds((const unsigned*)((const char*)(gbase) + (voff)[_i]), (PG8_LAS unsigned*)(lds + (bufoff) + ldsw + _i * 8192), 16, 0, 0); } while (0)
#define PG8_LDA(dst, b, h) do { _Pragma("unroll") for (int m = 0; m < 4; ++m) _Pragma("unroll") for (int k = 0; k < 2; ++k) dst[m][k] = *(const PG8_LAS bf16x8*)(lds + PG8_SA(b, h) + aoff + m * 2048 + k * 1024); } while (0)
#define PG8_LDB(dst, b, h) do { _Pragma("unroll") for (int n = 0; n < 2; ++n) _Pragma("unroll") for (int k = 0; k < 2; ++k) dst[n][k] = *(const PG8_LAS bf16x8*)(lds + PG8_SB(b, h) + boff + n * 2048 + k * 1024); } while (0)
#define PG8_MMA(ai, bj, At, Bt) do { __builtin_amdgcn_s_setprio(1); _Pragma("unroll") for (int m = 0; m < 4; ++m) _Pragma("unroll") for (int n = 0; n < 2; ++n) _Pragma("unroll") for (int k = 0; k < 2; ++k) \
        acc[ai][bj][m][n] = __builtin_amdgcn_mfma_f32_16x16x32_bf16(Bt[n][k], At[m][k], acc[ai][bj][m][n], 0, 0, 0); __builtin_amdgcn_s_setprio(0); } while (0)
#define PG8_WAIT_V(n) asm volatile("s_waitcnt vmcnt(" #n ")" ::: "memory")
#define PG8_WAIT_L(n) asm volatile("s_waitcnt lgkmcnt(" #n ")" ::: "memory")
#define PG8_BAR __builtin_amdgcn_s_barrier()
#define PG8_SCHED __builtin_amdgcn_sched_barrier(0)
    Unit2 cur, nxt; int ui = 0;
    if (!S.next(0, cur)) return;
    f32x4 acc[2][2][4][2];
#pragma unroll
    for (int a = 0; a < 2; ++a)
#pragma unroll
        for (int b = 0; b < 2; ++b)
#pragma unroll
            for (int m = 0; m < 4; ++m)
#pragma unroll
                for (int n = 0; n < 2; ++n) acc[a][b][m][n] = (f32x4){0.f, 0.f, 0.f, 0.f};
    bf16x8 At[4][2], B0[2][2], B1[2][2];
    const char* cA = (const char*)(cur.part ? g.A1 : g.A0) + (size_t)cur.pm * tstepA; const char* cB = (const char*)(cur.part ? g.B1 : g.B0) + (size_t)cur.pn * tstep;
    S.a_ready(cur);
    if constexpr (SP2) {
        PG8_STAGE(PG8_SB(0, 0), cB, voffB); PG8_STAGE(PG8_SB(0, 1), cB + hstep, voffB); PG8_STAGE(PG8_SA(0, 0), cA, voffA); PG8_STAGE(PG8_SA(0, 1), cA + hstepA, voffA);
        if (wr == 1) PG8_BAR;
        PG8_WAIT_V(2); PG8_BAR;
        PG8_STAGE(PG8_SB(1, 0), cB + kstep, voffB); PG8_STAGE(PG8_SA(1, 0), cA + kstep, voffA); PG8_STAGE(PG8_SB(1, 1), cB + hstep + kstep, voffB);
        PG8_WAIT_V(6); PG8_BAR;
    } else {
        PG8_STAGE(PG8_SB(0, 0), cB, voffB); PG8_STAGE(PG8_SA(0, 0), cA, voffA); PG8_STAGE(PG8_SB(0, 1), cB + hstep, voffB); PG8_STAGE(PG8_SA(0, 1), cA + hstepA, voffA);
        if (wr == 1) PG8_BAR;
        PG8_WAIT_V(4); PG8_BAR;
        PG8_STAGE(PG8_SB(1, 0), cB + kstep, voffB); PG8_STAGE(PG8_SA(1, 0), cA + kstep, voffA); PG8_STAGE(PG8_SB(1, 1), cB + hstep + kstep, voffB);
        PG8_WAIT_V(6); PG8_BAR;
    }
    for (;;) {
        const bool has_next = S.next(ui + 1, nxt);
        const char* nA = has_next ? (const char*)(nxt.part ? g.A1 : g.A0) + (size_t)nxt.pm * tstepA : cA; const char* nB = has_next ? (const char*)(nxt.part ? g.B1 : g.B0) + (size_t)nxt.pn * tstep : cB;
        for (int t = 0; t < nt; t += 2) {
            const bool last = (t == nt - 2);
            const char* a1 = cA + (size_t)(t + 1) * kstep;
            const char* a2 = last ? nA : cA + (size_t)(t + 2) * kstep; const char* b2 = last ? nB : cB + (size_t)(t + 2) * kstep;
            const char* a3 = a2 + kstep; const char* b3 = b2 + kstep;
            if (last && has_next) S.a_ready(nxt);
            if constexpr (SP2) {
            PG8_LDB(B0, 0, 0); PG8_LDB(B1, 0, 1); PG8_SCHED; PG8_LDA(At, 0, 0); PG8_STAGE(PG8_SA(1, 1), a1 + hstepA, voffA);
            PG8_WAIT_V(8); PG8_WAIT_L(0); PG8_BAR; PG8_MMA(0, 0, At, B0); PG8_MMA(0, 1, At, B1); PG8_BAR; PG8_SCHED;
            PG8_LDA(At, 0, 1); PG8_STAGE(PG8_SB(0, 0), b2, voffB); PG8_STAGE(PG8_SB(0, 1), b2 + hstep, voffB); PG8_STAGE(PG8_SA(0, 0), a2, voffA);
            PG8_WAIT_V(8); PG8_WAIT_L(0); PG8_BAR; PG8_MMA(1, 0, At, B0); PG8_MMA(1, 1, At, B1); PG8_BAR; PG8_SCHED;
            PG8_LDB(B0, 1, 0); PG8_LDB(B1, 1, 1); PG8_SCHED; PG8_LDA(At, 1, 0); PG8_STAGE(PG8_SA(0, 1), a2 + hstepA, voffA);
            PG8_WAIT_V(8); PG8_WAIT_L(0); PG8_BAR; PG8_MMA(0, 0, At, B0); PG8_MMA(0, 1, At, B1); PG8_BAR; PG8_SCHED;
            PG8_LDA(At, 1, 1); PG8_STAGE(PG8_SB(1, 0), b3, voffB); PG8_STAGE(PG8_SB(1, 1), b3 + hstep, voffB); PG8_STAGE(PG8_SA(1, 0), a3, voffA);
            PG8_WAIT_V(8); PG8_WAIT_L(0); PG8_BAR; PG8_MMA(1, 0, At, B0); PG8_MMA(1, 1, At, B1); PG8_BAR; PG8_SCHED;
            } else {
            PG8_LDB(B0, 0, 0); PG8_SCHED; PG8_LDA(At, 0, 0); PG8_STAGE(PG8_SA(1, 1), a1 + hstepA, voffA);
            PG8_WAIT_L(8); PG8_BAR; PG8_WAIT_L(0); PG8_MMA(0, 0, At, B0); PG8_BAR; PG8_SCHED;
            PG8_LDB(B1, 0, 1); PG8_STAGE(PG8_SB(0, 0), b2, voffB);
            PG8_BAR; PG8_WAIT_L(0); PG8_MMA(0, 1, At, B1); PG8_BAR;
            PG8_LDA(At, 0, 1); PG8_STAGE(PG8_SA(0, 0), a2, voffA);
            PG8_BAR; PG8_WAIT_L(0); PG8_MMA(1, 0, At, B0); PG8_BAR; PG8_SCHED;
            PG8_STAGE(PG8_SB(0, 1), b2 + hstep, voffB);
            PG8_WAIT_V(6); PG8_BAR; PG8_MMA(1, 1, At, B1); PG8_BAR;
            PG8_LDB(B0, 1, 0); PG8_SCHED; PG8_LDA(At, 1, 0); PG8_STAGE(PG8_SA(0, 1), a2 + hstepA, voffA);
            PG8_WAIT_L(8); PG8_BAR; PG8_WAIT_L(0); PG8_MMA(0, 0, At, B0); PG8_BAR; PG8_SCHED;
            PG8_LDB(B1, 1, 1); PG8_STAGE(PG8_SB(1, 0), b3, voffB);
            PG8_BAR; PG8_WAIT_L(0); PG8_MMA(0, 1, At, B1); PG8_BAR;
            PG8_LDA(At, 1, 1); PG8_STAGE(PG8_SA(1, 0), a3, voffA);
            PG8_BAR; PG8_WAIT_L(0); PG8_MMA(1, 0, At, B0); PG8_BAR; PG8_SCHED;
            PG8_STAGE(PG8_SB(1, 1), b3 + hstep, voffB);
            PG8_WAIT_V(6); PG8_BAR; PG8_MMA(1, 1, At, B1); PG8_BAR;
            }
        }
        if constexpr (ALIGN_EPI) { if (wr == 0) PG8_BAR; }
        if (cur.part == 0) E.mid(acc, cur, wr, wc, fr, fq); else E(acc, cur, wr, wc, fr, fq);
        if (!has_next) break;
        if (cur.part == 1) {
#pragma unroll
        for (int a = 0; a < 2; ++a)
#pragma unroll
            for (int b = 0; b < 2; ++b)
#pragma unroll
                for (int m = 0; m < 4; ++m)
#pragma unroll
                    for (int n = 0; n < 2; ++n) acc[a][b][m][n] = (f32x4){0.f, 0.f, 0.f, 0.f};
        }
        cur = nxt; cA = nA; cB = nB; ++ui;
        if constexpr (ALIGN_EPI) { if (wr == 1) PG8_BAR; }
    }
    PG8_WAIT_V(0);
    if constexpr (!ALIGN_EPI) { if (wr == 0) PG8_BAR; }
    PG8_BAR;
#undef PG8_SA
#undef PG8_SB
#undef PG8_STAGE
#undef PG8_LDA
#undef PG8_LDB
#undef PG8_MMA
#undef PG8_WAIT_V
#undef PG8_WAIT_L
#undef PG8_BAR
#undef PG8_SCHED
}
}

struct EpiInProj {
  static constexpr bool PERM = true, AFTER_DRAIN = false;
  u16* h;
  DI void operator()(const f32x4 (&acc)[2][2][4][2], const pg8::Unit& u, int wr, int wc, int fr, int fq) const {
    const int shift = (u.pn >= 8) ? 8 : 0;
#pragma unroll
    for (int ai = 0; ai < 2; ++ai)
#pragma unroll
      for (int m = 0; m < 4; ++m) {
        const int row = u.pm * 256 + ai * 128 + wr * 64 + m * 16 + fr;
#pragma unroll
        for (int bj = 0; bj < 2; ++bj) {
          const int col = u.pn * 256 + bj * 128 + wc * 32 + 8 * fq + shift;
          const f32x4 a = acc[ai][bj][m][0], b = acc[ai][bj][m][1];
          u32x4 w; w.x = pk_bf16(a[0], a[1]); w.y = pk_bf16(a[2], a[3]); w.z = pk_bf16(b[0], b[1]); w.w = pk_bf16(b[2], b[3]);
          *(u32x4*)(h + (size_t)row * NC + col) = w;
        }
      }
  }
};

struct EpiMerge {
  static constexpr bool PERM = true, AFTER_DRAIN = false;
  const u16* h; u16* mg;
  DI void mid(f32x4 (&acc)[2][2][4][2], const pg8::Unit2& u, int wr, int wc, int fr, int fq) const {
#pragma unroll
    for (int ai = 0; ai < 2; ++ai)
#pragma unroll
      for (int m = 0; m < 4; ++m) {
        const int row = u.pm * 256 + ai * 128 + wr * 64 + m * 16 + fr;
#pragma unroll
        for (int bj = 0; bj < 2; ++bj) {
          const int col = u.pn * 256 + bj * 128 + wc * 32 + 8 * fq;
          const u32x4 ga = *(const u32x4*)(h + (size_t)row * NC + C_GA + col), gb = *(const u32x4*)(h + (size_t)row * NC + C_GB + col);
#pragma unroll
          for (int j = 0; j < 4; ++j) {
            const float r0 = (1.f + __expf(-bf_lo(gb[j]))) * rcp_f(1.f + __expf(-bf_lo(ga[j])));
            const float r1 = (1.f + __expf(-bf_hi(gb[j]))) * rcp_f(1.f + __expf(-bf_hi(ga[j])));
            acc[ai][bj][m][j >> 1][2 * (j & 1)] *= r0; acc[ai][bj][m][j >> 1][2 * (j & 1) + 1] *= r1;
          }
        }
        __builtin_amdgcn_sched_barrier(0);
      }
  }
  DI void operator()(const f32x4 (&acc)[2][2][4][2], const pg8::Unit2& u, int wr, int wc, int fr, int fq) const {
#pragma unroll
    for (int ai = 0; ai < 2; ++ai)
#pragma unroll
      for (int m = 0; m < 4; ++m) {
        const int row = u.pm * 256 + ai * 128 + wr * 64 + m * 16 + fr;
#pragma unroll
        for (int bj = 0; bj < 2; ++bj) {
          const int col = u.pn * 256 + bj * 128 + wc * 32 + 8 * fq;
          const u32x4 gb = *(const u32x4*)(h + (size_t)row * NC + C_GB + col);
          const f32x4 a = acc[ai][bj][m][0], b = acc[ai][bj][m][1];
          u32x4 w;
          w.x = pk_bf16(a[0] * sigmoid_f(bf_lo(gb[0])), a[1] * sigmoid_f(bf_hi(gb[0])));
          w.y = pk_bf16(a[2] * sigmoid_f(bf_lo(gb[1])), a[3] * sigmoid_f(bf_hi(gb[1])));
          w.z = pk_bf16(b[0] * sigmoid_f(bf_lo(gb[2])), b[1] * sigmoid_f(bf_hi(gb[2])));
          w.w = pk_bf16(b[2] * sigmoid_f(bf_lo(gb[3])), b[3] * sigmoid_f(bf_hi(gb[3])));
          *(u32x4*)(mg + (size_t)row * 1024 + col) = w;
        }
        __builtin_amdgcn_sched_barrier(0);
      }
  }
};

struct EpiOut {
  static constexpr bool PERM = true, AFTER_DRAIN = false;
  const float* x; float* out;
  DI void operator()(const f32x4 (&acc)[2][2][4][2], const pg8::Unit& u, int wr, int wc, int fr, int fq) const {
#pragma unroll
    for (int ai = 0; ai < 2; ++ai)
#pragma unroll
      for (int m = 0; m < 4; ++m) {
        const int row = u.pm * 256 + ai * 128 + wr * 64 + m * 16 + fr;
#pragma unroll
        for (int bj = 0; bj < 2; ++bj) {
          const int col = u.pn * 256 + bj * 128 + wc * 32 + 8 * fq;
          const f32x4 x0 = *(const f32x4*)(x + (size_t)row * 1024 + col), x1 = *(const f32x4*)(x + (size_t)row * 1024 + col + 4);
          *(f32x4*)(out + (size_t)row * 1024 + col) = x0 * 1.189207115002721f + acc[ai][bj][m][0];
          *(f32x4*)(out + (size_t)row * 1024 + col + 4) = x1 * 1.189207115002721f + acc[ai][bj][m][1];
        }
      }
  }
};

#ifndef MK_MULTI
#define MK_MULTI 0
#endif
__global__ void __launch_bounds__(512, 2) fwd_megakernel(Params p) {
  cg::grid_group grid = cg::this_grid();
  __shared__ __attribute__((aligned(16))) unsigned char smem[SMEM_BYTES];
  const int w8 = __builtin_amdgcn_readfirstlane((int)(threadIdx.x >> 6));
  const int wvs = w8 & 3, half = w8 >> 2;
  unsigned char* hsm = smem + half * HALF_SMEM;
  const int vb = blockIdx.x + half * gridDim.x, nvb = 2 * gridDim.x;
  volatile LAS unsigned* st = (volatile LAS unsigned*)(smem + SMEM_BYTES - 16);
  { const int t0_ = opaque_tid(); if (t0_ < 4) st[t0_] = 0u; }
  __syncthreads();
  const XcdBarrier xb = xcd_barrier_post((unsigned*)(p.ws + OFF_BAR), st, w8);
  phase0(p, w8);
  if (p.ws == nullptr) grid.sync();
  xcd_barrier(xb);
  {
    pg8::Gemm g; g.A = (const pg8::bf16_t*)(p.ws + OFF_SC); g.Bt = (const pg8::bf16_t*)(p.ws + OFF_WINT); g.M = T_TOK; g.N = NCP; g.K = 1024;
    pg8::StaticOrder so; so.init(T_TOK, NCP, (int)gridDim.x, (int)blockIdx.x);
    EpiInProj e; e.h = (u16*)(p.ws + OFF_H);
    pg8::gemm_phase<EpiInProj, pg8::StaticOrder, true, true>((PG8_LAS unsigned char*)smem, g, so, e, opaque_tid_(w8));
  }
  xcd_barrier(xb);
  for (int it = vb; it < 2048; it += nvb) prep_item(p, wvs, it, hsm);
  xcd_barrier(xb);
  if (blockIdx.x < 128) {
    if (half == 0) { const int cb = (int)blockIdx.x; scan_chain(p, wvs, (cb & 7) + 8 * ((cb >> 3) >> 3), (cb >> 3) & 7, hsm); }
    else {
      const int cb = (int)blockIdx.x, pr = (cb & 7) + 8 * ((cb >> 3) >> 3), slp = (cb >> 3) & 7, bp = pr >> 2, hp = pr & 3;
      const int ft = opaque_tid();
      const unsigned char* pbase = p.ws + OFF_SC + (size_t)(slp * 72 + (ft < 72 ? ft : 0)) * 128;
      unsigned r0 = 0, r1 = 0, r2 = 0, r3 = 0, accp = 0;
      __syncthreads();
      for (int n = 0; n < 128; ++n) {
        accp ^= r3; r3 = r2; r2 = r1; r1 = r0;
        const int np = n + 6 < 128 ? n + 6 : 127;
        r0 = *(const unsigned*)(pbase + (size_t)((bp * 128 + np) * 4 + hp) * OPB);
        __syncthreads(); __syncthreads();
      }
      accp ^= r0 ^ r1 ^ r2 ^ r3;
      if (accp == 0x9e3779b9u && ft == 300) ((unsigned*)(p.ws + OFF_BAR))[XB_TMO + 1] = accp;
    }
  } else {
    const int nsw = 2 * ((int)gridDim.x - 128), vbl = ((int)blockIdx.x - 128) + half * ((int)gridDim.x - 128);
    for (int k = 0; k * nsw < 1024; ++k) { const int it = vbl + k * nsw; swa_item(p, wvs, it < 1024 ? it : 0, it < 1024, hsm); }
  }
  xcd_barrier(xb);
  phase_ya(p, w8);
  xcd_barrier(xb);
  {
    pg8::Gemm2 g; g.A0 = (const pg8::bf16_t*)(p.ws + OFF_H); g.A1 = g.A0 + C_SWQ; g.B0 = (const pg8::bf16_t*)(p.ws + OFF_WAT); g.B1 = (const pg8::bf16_t*)(p.ws + OFF_WBT);
    g.lda = NC; g.K = 512;
    pg8::StaticOrder2 so; so.init(T_TOK, 1024, (int)gridDim.x, (int)blockIdx.x);
    EpiMerge e; e.h = (const u16*)(p.ws + OFF_H); e.mg = (u16*)(p.ws + OFF_SC);
    pg8::gemm_phase2<EpiMerge, pg8::StaticOrder2, true, true>((PG8_LAS unsigned char*)smem, g, so, e, opaque_tid_(w8));
  }
  xcd_barrier(xb);
  {
    pg8::Gemm g; g.A = (const pg8::bf16_t*)(p.ws + OFF_SC); g.Bt = (const pg8::bf16_t*)(p.ws + OFF_WOT); g.M = T_TOK; g.N = 1024; g.K = 1024;
    pg8::StaticOrder so; so.init(T_TOK, 1024, (int)gridDim.x, (int)blockIdx.x);
    EpiOut e; e.x = p.x; e.out = p.out;
    pg8::gemm_phase<EpiOut, pg8::StaticOrder, true, true>((PG8_LAS unsigned char*)smem, g, so, e, opaque_tid_(w8));
  }
  xcd_barrier(xb);
  phase6(p, w8, smem);
}

extern "C" void kernel_launch(void* const* d_in, const int* in_sizes, int n_in, void* d_out, int out_size,
                              void* d_ws, size_t ws_size, hipStream_t stream) {
  if (ws_size < WS_NEED) { fprintf(stderr, "workspace too small: %zu < %zu\n", ws_size, (size_t)WS_NEED); return; }
  Params p{};
  p.x = (const float*)d_in[0]; p.w_in = (const float*)d_in[1]; p.conv_w = (const float*)d_in[2]; p.a_log = (const float*)d_in[3];
  p.dt_bias = (const float*)d_in[4]; p.dn_norm_w = (const float*)d_in[5]; p.sinks = (const float*)d_in[6];
  p.w_branch = (const float*)d_in[7]; p.w_out = (const float*)d_in[8]; p.ln_g = (const float*)d_in[9]; p.ln_b = (const float*)d_in[10];
  p.out = (float*)d_out; p.ws = (unsigned char*)d_ws;
  for (int i = 0; i < 8; ++i) p.inv_freq[i] = (float)std::pow(500000.0, -(double)i / 8.0);
  static int grid_blocks = 0;
  if (!grid_blocks) {
    int dev = 0, cus = 0, per_cu = 0;
    (void)hipGetDevice(&dev);
    (void)hipDeviceGetAttribute(&cus, hipDeviceAttributeMultiprocessorCount, dev);
    (void)hipOccupancyMaxActiveBlocksPerMultiprocessor(&per_cu, fwd_megakernel, 512, 0);
    if (per_cu < 1) fprintf(stderr, "occupancy query reports %d workgroups per CU\n", per_cu);
    grid_blocks = cus > 256 ? 256 : cus;
    grid_blocks &= ~7;
  }
  (void)hipMemsetAsync(p.ws + OFF_BAR, 0, BAR_BYTES, stream);
  void* args[] = {&p};
  hipError_t e = hipLaunchCooperativeKernel((void*)fwd_megakernel, dim3(grid_blocks), dim3(512), args, 0, stream);
  if (e != hipSuccess) fprintf(stderr, "cooperative launch failed: %s (grid %d)\n", hipGetErrorString(e), grid_blocks);
}
```

```cpp
#include <hip/hip_runtime.h>
#include <hip/hip_cooperative_groups.h>
#include <cstdio>
#include <cmath>
namespace cg = cooperative_groups;

typedef unsigned short u16;
typedef short bf16x8 __attribute__((ext_vector_type(8)));
typedef float f32x4 __attribute__((ext_vector_type(4)));
typedef unsigned u32x4 __attribute__((ext_vector_type(4)));
typedef unsigned u32x2 __attribute__((ext_vector_type(2)));
typedef _Float16 f16x4 __attribute__((ext_vector_type(4)));
#define DI __device__ __forceinline__
DI int opaque_tid_(int wave_s) { int t; asm volatile("v_mbcnt_lo_u32_b32 %0, -1, 0\n\tv_mbcnt_hi_u32_b32 %0, -1, %0" : "=v"(t)); return t + (wave_s << 6); }
#define opaque_tid() opaque_tid_(wvs)

constexpr int T_TOK = 32768, SEQ = 8192, DM = 1024, NC = 5384, NCP = 5376;
constexpr int C_DNZ = 1536, C_SWQ = 2056, C_SWK = 2568, C_SWV = 2696, C_SWZ = 2824, C_GA = 3336, C_GB = 4360;
constexpr size_t OFF_BAR = 0;
constexpr size_t BAR_BYTES = 16384;
constexpr size_t OFF_WINT = BAR_BYTES;
constexpr size_t OFF_WAT = OFF_WINT + (size_t)NCP * 1024 * 2;
constexpr size_t OFF_WBT = OFF_WAT + 1024 * 512 * 2;
constexpr size_t OFF_WOT = OFF_WBT + 1024 * 512 * 2;
constexpr size_t OFF_ROPE = OFF_WOT + 1024 * 1024 * 2;
constexpr size_t OFF_HB = OFF_ROPE + 2 * 8192 * 8 * 4;
constexpr size_t OFF_DEC = OFF_HB + (size_t)T_TOK * 8 * 4;
constexpr size_t OFF_H = OFF_DEC + 2048 * 4;
constexpr size_t OFF_SC = OFF_H + (size_t)T_TOK * NC * 2;
constexpr size_t OPB = 73728;
constexpr size_t WS_NEED = OFF_SC + 2048 * OPB;
constexpr int HALF_SMEM = 73728;
constexpr int SMEM_BYTES = 2 * HALF_SMEM + 16;

struct Params {
  const float *x, *w_in, *conv_w, *a_log, *dt_bias, *dn_norm_w, *sinks, *w_branch, *w_out, *ln_g, *ln_b;
  float* out; unsigned char* ws;
  float inv_freq[8];
};

typedef __bf16 bf16x2_t __attribute__((ext_vector_type(2)));
typedef float f32x2_t __attribute__((ext_vector_type(2)));
DI unsigned pk_bf16(float lo, float hi) { f32x2_t f = {lo, hi}; bf16x2_t v = __builtin_convertvector(f, bf16x2_t); return __builtin_bit_cast(unsigned, v); }
DI float bf_lo(unsigned u) { return __uint_as_float(u << 16); }
DI float bf_hi(unsigned u) { return __uint_as_float(u & 0xffff0000u); }
DI float bf2f(u16 v) { return __uint_as_float(((unsigned)v) << 16); }
DI u16 f2bf(float f) { return (u16)(pk_bf16(f, f) & 0xffffu); }
DI float shx(float v, int m, int lane) { return __uint_as_float((unsigned)__builtin_amdgcn_ds_bpermute((lane ^ m) << 2, (int)__float_as_uint(v))); }
DI float rcp_f(float y) { return __builtin_amdgcn_rcpf(y); }
DI float silu_f(float y) { return y * rcp_f(1.0f + __expf(-y)); }
DI float sigmoid_f(float y) { return rcp_f(1.0f + __expf(-y)); }
DI f32x4 mfma16(bf16x8 a, bf16x8 b, f32x4 c) { return __builtin_amdgcn_mfma_f32_16x16x32_bf16(a, b, c, 0, 0, 0); }
DI bf16x8 as_bf8(u32x4 v) { return __builtin_bit_cast(bf16x8, v); }
DI bf16x8 pack8(f32x4 a, f32x4 b) { u32x4 w; w.x = pk_bf16(a[0], a[1]); w.y = pk_bf16(a[2], a[3]); w.z = pk_bf16(b[0], b[1]); w.w = pk_bf16(b[2], b[3]); return as_bf8(w); }

DI void phase0(const Params& p, int wvs) {
  const size_t gt = (size_t)blockIdx.x * 512 + opaque_tid(), gs = (size_t)gridDim.x * 512;
  {
    const int ltid = (int)(gt & 511), lane = ltid & 63, wv = ltid >> 6;
    float wr[16][8];
#pragma unroll
    for (int j = 0; j < 4; ++j)
#pragma unroll
      for (int c = 0; c < 4; ++c) {
        const float* wp = p.w_in + (size_t)(4 * (lane + 64 * j) + c) * NC + 2048;
        const f32x4 a = *(const f32x4*)wp, b = *(const f32x4*)(wp + 4);
#pragma unroll
        for (int q = 0; q < 4; ++q) { wr[4 * j + c][q] = a[q]; wr[4 * j + c][4 + q] = b[q]; }
      }
    u16* xb = (u16*)(p.ws + OFF_SC);
    float* hb = (float*)(p.ws + OFF_HB);
    const int rstep = gridDim.x * 8;
    for (int row0 = blockIdx.x * 8 + wv; row0 < T_TOK; row0 += 2 * rstep) {
      f32x4 xr[2][4];
#pragma unroll
      for (int u = 0; u < 2; ++u) {
        const int row = row0 + u * rstep;
#pragma unroll
        for (int j = 0; j < 4; ++j) xr[u][j] = (row < T_TOK) ? *(const f32x4*)(p.x + (size_t)row * DM + 4 * (lane + 64 * j)) : (f32x4){0.f, 0.f, 0.f, 0.f};
      }
#pragma unroll
      for (int u = 0; u < 2; ++u) {
        const int row = row0 + u * rstep;
        float v[8];
#pragma unroll
        for (int q = 0; q < 8; ++q) v[q] = 0.f;
#pragma unroll
        for (int j = 0; j < 4; ++j) {
          const f32x4 xv = xr[u][j];
          u32x2 w; w.x = pk_bf16(xv[0], xv[1]); w.y = pk_bf16(xv[2], xv[3]);
          if (row < T_TOK) *(u32x2*)(xb + (size_t)row * DM + 4 * (lane + 64 * j)) = w;
#pragma unroll
          for (int c = 0; c < 4; ++c)
#pragma unroll
            for (int q = 0; q < 8; ++q) v[q] += xv[c] * wr[4 * j + c][q];
        }
        const bool up = (lane & 32) != 0;
        float k4[4];
#pragma unroll
        for (int i = 0; i < 4; ++i) { const float snd = up ? v[i] : v[i + 4]; const float kp = up ? v[i + 4] : v[i]; k4[i] = kp + shx(snd, 32, lane); }
        const bool up2 = (lane & 16) != 0;
        float k2[2];
#pragma unroll
        for (int i = 0; i < 2; ++i) { const float snd = up2 ? k4[i] : k4[i + 2]; const float kp = up2 ? k4[i + 2] : k4[i]; k2[i] = kp + shx(snd, 16, lane); }
        const bool up3 = (lane & 8) != 0;
        float k1 = (up3 ? k2[1] : k2[0]) + shx(up3 ? k2[0] : k2[1], 8, lane);
        k1 += shx(k1, 4, lane); k1 += shx(k1, 2, lane); k1 += shx(k1, 1, lane);
        if ((lane & 7) == 0 && row < T_TOK) hb[(size_t)row * 8 + (lane >> 3)] = k1;
      }
    }
  }
  {
    u32x4* wt = (u32x4*)(p.ws + OFF_WINT);
    for (size_t i = gt; i < (size_t)NCP * 128; i += gs) {
      const int kc = (int)(i / NCP), n = (int)(i % NCP);
      float v[8];
#pragma unroll
      for (int j = 0; j < 8; ++j) v[j] = p.w_in[(size_t)(kc * 8 + j) * NC + n + (n >= 2048 ? 8 : 0)];
      u32x4 w; w.x = pk_bf16(v[0], v[1]); w.y = pk_bf16(v[2], v[3]); w.z = pk_bf16(v[4], v[5]); w.w = pk_bf16(v[6], v[7]);
      wt[(size_t)n * 128 + kc] = w;
    }
  }
  {
    for (size_t i = gt; i < (size_t)2 * 1024 * 64; i += gs) {
      const int br = (int)(i / (1024 * 64)), rem = (int)(i % (1024 * 64)), kc = rem / 1024, n = rem % 1024;
      const float* src = p.w_branch + (size_t)br * 512 * 1024;
      float v[8];
#pragma unroll
      for (int j = 0; j < 8; ++j) v[j] = src[(size_t)(kc * 8 + j) * 1024 + n];
      u32x4 w; w.x = pk_bf16(v[0], v[1]); w.y = pk_bf16(v[2], v[3]); w.z = pk_bf16(v[4], v[5]); w.w = pk_bf16(v[6], v[7]);
      ((u32x4*)(p.ws + (br ? OFF_WBT : OFF_WAT)))[(size_t)n * 64 + kc] = w;
    }
  }
  {
    for (size_t i = gt; i < (size_t)1024 * 128; i += gs) {
      const int kc = (int)(i / 1024), n = (int)(i % 1024);
      float v[8];
#pragma unroll
      for (int j = 0; j < 8; ++j) v[j] = p.w_out[(size_t)(kc * 8 + j) * 1024 + n];
      u32x4 w; w.x = pk_bf16(v[0], v[1]); w.y = pk_bf16(v[2], v[3]); w.z = pk_bf16(v[4], v[5]); w.w = pk_bf16(v[6], v[7]);
      ((u32x4*)(p.ws + OFF_WOT))[(size_t)n * 128 + kc] = w;
    }
  }
  {
    float* rc = (float*)(p.ws + OFF_ROPE); float* rs = rc + 8192 * 8;
    for (size_t i = gt; i < 8192 * 8; i += gs) {
      const int t = (int)(i >> 3), f = (int)(i & 7);
      const float ang = (float)t * p.inv_freq[f];
      const double a = (double)ang;
      const double k = __builtin_rint(a * 0.15915494309189535);
      const float r = (float)(a - k * 6.283185307179586);
      rc[i] = cosf(r); rs[i] = sinf(r);
    }
  }
}

DI int lds_off32(int row, int chunk) { return row * 64 + ((chunk ^ ((0 - (row >> 2)) & 3)) << 4); }
constexpr int GSTAGE = 24576;

DI void gemm_kloop(const Params& p, int wvs, const u16* __restrict__ A, int lda, const u16* __restrict__ Bt, int ldb, int nk, int m0, int n0,
                   f32x4 (&acc)[4][8], unsigned char* smem) {
  const int tid = opaque_tid(), lane = tid & 63, wv = tid >> 6, wm = wv >> 1, wn = wv & 1, r16 = lane & 15, g = lane >> 4;
  const int prow = lane >> 2, pc = (lane & 3) ^ ((0 - (prow >> 2)) & 3);
  const u16* ap = A + (size_t)(m0 + 16 * wv + prow) * lda + pc * 8;
  const u16* bp = Bt + (size_t)(n0 + 16 * wv + prow) * ldb + pc * 8;
  unsigned char* lA = smem + wv * 1024;
  unsigned char* lB = smem + 8192 + wv * 1024;
#define GEMM_ISSUE(kt_, buf_) do { \
    _Pragma("unroll") for (int i_ = 0; i_ < 2; ++i_) \
      __builtin_amdgcn_global_load_lds((const unsigned*)(ap + (size_t)(64 * i_) * lda + (kt_) * 32), (unsigned*)(lA + (buf_) * GSTAGE + i_ * 4096), 16, 0, 0); \
    _Pragma("unroll") for (int i_ = 0; i_ < 4; ++i_) \
      __builtin_amdgcn_global_load_lds((const unsigned*)(bp + (size_t)(64 * i_) * ldb + (kt_) * 32), (unsigned*)(lB + (buf_) * GSTAGE + i_ * 4096), 16, 0, 0); \
  } while (0)
  GEMM_ISSUE(0, 0);
  GEMM_ISSUE(1, 1);
  asm volatile("s_waitcnt vmcnt(6)" ::: "memory");
  __builtin_amdgcn_s_barrier();
  int cb = 0;
  for (int kt = 0; kt < nk; ++kt) {
    int ib = cb + 2; if (ib >= 3) ib -= 3;
    const bool more = (kt + 2 < nk);
    if (more) GEMM_ISSUE(kt + 2, ib);
    const unsigned char* cur = smem + cb * GSTAGE;
    bf16x8 af[4], bfr[8];
#pragma unroll
    for (int i = 0; i < 4; ++i) af[i] = *(const bf16x8*)(cur + lds_off32(wm * 64 + i * 16 + r16, g));
#pragma unroll
    for (int i = 0; i < 8; ++i) bfr[i] = *(const bf16x8*)(cur + 8192 + lds_off32(wn * 128 + i * 16 + r16, g));
#pragma unroll
    for (int mi = 0; mi < 4; ++mi)
#pragma unroll
      for (int ni = 0; ni < 8; ++ni) acc[mi][ni] = mfma16(bfr[ni], af[mi], acc[mi][ni]);
    if (more) asm volatile("s_waitcnt vmcnt(6)" ::: "memory"); else asm volatile("s_waitcnt vmcnt(0)" ::: "memory");
    asm volatile("s_waitcnt lgkmcnt(0)" ::: "memory");
    __builtin_amdgcn_s_barrier();
    cb = cb + 1; if (cb >= 3) cb = 0;
  }
#undef GEMM_ISSUE
}

DI bool tile_of(int li, int ntn, int xcd, int& mt, int& nt) {
  if (li >= 32 * ntn) return false;
  const int grp = li / (8 * ntn), rem = li % (8 * ntn);
  nt = rem >> 3; mt = 32 * xcd + grp * 8 + (rem & 7);
  return true;
}

DI void zero_acc(f32x4 (&acc)[4][8]) {
#pragma unroll
  for (int i = 0; i < 4; ++i)
#pragma unroll
    for (int j = 0; j < 8; ++j) acc[i][j] = (f32x4){0.f, 0.f, 0.f, 0.f};
}

DI void phase1(const Params& p, int wvs, unsigned char* smem) {
  const int xcd = blockIdx.x & 7, lb = blockIdx.x >> 3, nlb = gridDim.x >> 3;
  const u16* xb = (const u16*)(p.ws + OFF_SC);
  const u16* wint = (const u16*)(p.ws + OFF_WINT);
  u16* h = (u16*)(p.ws + OFF_H);
  float* hb = (float*)(p.ws + OFF_HB);
  const int tid0 = opaque_tid(); const int lane = tid0 & 63, wv = tid0 >> 6, wm = wv >> 1, wn = wv & 1, r16 = lane & 15, g = lane >> 4;
  for (int li = lb;; li += nlb) {
    int mt, nt; if (!tile_of(li, 21, xcd, mt, nt)) break;
    f32x4 acc[4][8]; zero_acc(acc);
    gemm_kloop(p, wvs, xb, 1024, wint, 1024, 32, mt * 128, nt * 256, acc, smem);
#pragma unroll
    for (int mi = 0; mi < 4; ++mi) {
      const int row = mt * 128 + wm * 64 + mi * 16 + r16;
#pragma unroll
      for (int ni = 0; ni < 8; ++ni) {
        const int col = nt * 256 + wn * 128 + ni * 16 + 4 * g;
        {
          u32x2 w; w.x = pk_bf16(acc[mi][ni][0], acc[mi][ni][1]); w.y = pk_bf16(acc[mi][ni][2], acc[mi][ni][3]);
          *(u32x2*)(h + (size_t)row * NC + col + (nt >= 8 ? 8 : 0)) = w;
        }
      }
    }
  }
}

template <int I> DI void solve_rows2(f32x2_t (&xv)[64], const float* Lm, int lane, float lcur) {
  if constexpr (I < 64) {
    float lnx = 0.f;
    if constexpr (I + 1 < 64) lnx = Lm[(I + 1) * 68 + lane];
    f32x2_t a0 = xv[I], a1 = {0.f, 0.f}, a2 = {0.f, 0.f}, a3 = {0.f, 0.f};
#pragma unroll
    for (int m = 0; m < I; ++m) {
      const float l = __builtin_bit_cast(float, __builtin_amdgcn_readlane(__builtin_bit_cast(int, lcur), m));
      const f32x2_t lv = {l, l};
      if ((m & 3) == 0) a0 -= lv * xv[m];
      else if ((m & 3) == 1) a1 -= lv * xv[m];
      else if ((m & 3) == 2) a2 -= lv * xv[m];
      else a3 -= lv * xv[m];
    }
    xv[I] = (a0 + a1) + (a2 + a3);
    solve_rows2<I + 1>(xv, Lm, lane, lnx);
  }
}

DI void prep_item(const Params& p, int wvs, int item, unsigned char* smem) {
  const int tid_ = opaque_tid();
  const int tid = tid_, lane = tid & 63, wv = tid >> 6, r16 = lane & 15, g = lane >> 4;
  const int hd = item & 3, n = (item >> 2) & 127, b = item >> 9;
  const int t0 = b * SEQ + n * 64;
  u16* Qs = (u16*)smem; u16* Ks = Qs + 64 * 136; u16* Vs = Ks + 64 * 136;
  float* Lm = (float*)(smem + 52224);
  float* sm_beta = (float*)(smem + 69632);
  float* sm_gc = sm_beta + 64; float* sm_rq = sm_gc + 64; float* sm_rk = sm_rq + 64;
  float* sm_fw = sm_rk + 64; float* sm_fq = sm_fw + 64; float* sm_fk = sm_fq + 64;
  const u16* h = (const u16*)(p.ws + OFF_H);
  const float* hb = (const float*)(p.ws + OFF_HB);
  unsigned char* op = p.ws + OFF_SC + (size_t)item * OPB;
  __syncthreads();
  {
    const int c2 = tid & 63, rbase = (tid >> 6) * 16;
    unsigned raw[3][19];
#pragma unroll
    for (int mat = 0; mat < 3; ++mat) {
      const int col = mat * 512 + hd * 128 + 2 * c2;
#pragma unroll
      for (int j = 0; j < 19; ++j) {
        const int rr = t0 + rbase - 3 + j;
        raw[mat][j] = *(const unsigned*)(h + (size_t)(rr < 0 ? 0 : rr) * NC + col);
      }
    }
    __builtin_amdgcn_sched_barrier(0);
#pragma unroll
    for (int mat = 0; mat < 3; ++mat) {
      const int col = mat * 512 + hd * 128 + 2 * c2;
      float wa[4], wb[4];
#pragma unroll
      for (int j = 0; j < 4; ++j) { wa[j] = p.conv_w[j * 1536 + col]; wb[j] = p.conv_w[j * 1536 + col + 1]; }
      float xa[3], xb[3];
#pragma unroll
      for (int j = 0; j < 3; ++j) {
        const int pos = n * 64 + rbase - 3 + j;
        const unsigned v = (pos >= 0) ? raw[mat][j] : 0u;
        xa[j] = bf_lo(v); xb[j] = bf_hi(v);
      }
      u16* dst = (mat == 0 ? Qs : (mat == 1 ? Ks : Vs));
#pragma unroll
      for (int i = 0; i < 16; ++i) {
        const unsigned v = raw[mat][3 + i];
        const float a3 = bf_lo(v), b3 = bf_hi(v);
        const float ya = wa[0] * xa[0] + wa[1] * xa[1] + wa[2] * xa[2] + wa[3] * a3;
        const float yb = wb[0] * xb[0] + wb[1] * xb[1] + wb[2] * xb[2] + wb[3] * b3;
        xa[0] = xa[1]; xa[1] = xa[2]; xa[2] = a3; xb[0] = xb[1]; xb[1] = xb[2]; xb[2] = b3;
        *(unsigned*)(dst + (rbase + i) * 136 + 2 * c2) = pk_bf16(silu_f(ya), silu_f(yb));
      }
    }
  }
  __syncthreads();
  if (wv == 0) {
    const int row = t0 + lane;
    const float bl = hb[(size_t)row * 8 + hd], al = hb[(size_t)row * 8 + 4 + hd];
    const float xx = al + p.dt_bias[hd];
    const float ee = __expf(-fabsf(xx));
    const float sp = fmaxf(xx, 0.f) + ((ee < 1e-3f) ? ee * (1.f - 0.5f * ee) : __logf(1.f + ee));
    float gg = -__expf(p.a_log[hd]) * sp;
#pragma unroll
    for (int o = 1; o < 64; o <<= 1) { const float t = __uint_as_float((unsigned)__builtin_amdgcn_ds_bpermute(((lane - o) & 63) << 2, (int)__float_as_uint(gg))); if (lane >= o) gg += t; }
    sm_beta[lane] = rcp_f(1.0f + __expf(-bl)); sm_gc[lane] = gg;
  } else if (wv <= 2) {
    const int r = tid - 64;
    const u16* src = (r < 64) ? (Qs + r * 136) : (Ks + (r - 64) * 136);
    float ss = 0.f;
#pragma unroll
    for (int c = 0; c < 16; ++c) {
      const u32x4 v = *(const u32x4*)(src + c * 8);
#pragma unroll
      for (int j = 0; j < 4; ++j) { const float a = bf_lo(v[j]), bb = bf_hi(v[j]); ss += a * a + bb * bb; }
    }
    const float rs = rsqrtf(ss + 1e-6f);
    if (r < 64) sm_rq[r] = rs; else sm_rk[r - 64] = rs;
  }
  __syncthreads();
  if (tid < 64) {
    const float gc = sm_gc[tid], gl = sm_gc[63], eg = __expf(gc);
    sm_fw[tid] = sm_beta[tid] * eg * sm_rk[tid];
    sm_fq[tid] = sm_rq[tid] * 0.08838834764831845f * eg;
    sm_fk[tid] = sm_rk[tid] * __expf(gl - gc);
    if (tid == 0) ((float*)(p.ws + OFF_DEC))[item] = __expf(gl);
  }
  {
    bf16x8 kfi[4], qfi[4];
#pragma unroll
    for (int s = 0; s < 4; ++s) {
      kfi[s] = *(const bf16x8*)(Ks + (16 * wv + r16) * 136 + 32 * s + 8 * g);
      qfi[s] = *(const bf16x8*)(Qs + (16 * wv + r16) * 136 + 32 * s + 8 * g);
    }
    f32x4 at[4];
#pragma unroll
    for (int jt = 0; jt < 4; ++jt) {
      at[jt] = (f32x4){0.f, 0.f, 0.f, 0.f};
      if (jt <= wv) {
        f32x4 la = (f32x4){0.f, 0.f, 0.f, 0.f}, aa = (f32x4){0.f, 0.f, 0.f, 0.f};
#pragma unroll
        for (int s = 0; s < 4; ++s) {
          const bf16x8 kfj = *(const bf16x8*)(Ks + (16 * jt + r16) * 136 + 32 * s + 8 * g);
          la = mfma16(kfi[s], kfj, la);
          aa = mfma16(kfj, qfi[s], aa);
        }
#pragma unroll
        for (int r = 0; r < 4; ++r) {
          { const int i = 16 * wv + 4 * g + r, j = 16 * jt + r16;
            const float v = (i > j) ? sm_beta[i] * sm_rk[i] * sm_rk[j] * __expf(sm_gc[i] - sm_gc[j]) * la[r] : 0.f;
            Lm[i * 68 + j] = v; }
          { const int j = 16 * jt + 4 * g + r, i = 16 * wv + r16;
            at[jt][r] = (j <= i) ? sm_rq[i] * sm_rk[j] * 0.08838834764831845f * __expf(sm_gc[i] - sm_gc[j]) * aa[r] : 0.f; }
        }
      }
    }
#pragma unroll
    for (int s2 = 0; s2 < 2; ++s2)
      *(bf16x8*)(op + 32768 + (size_t)((wv * 2 + s2) * 64 + lane) * 16) = pack8(at[2 * s2], at[2 * s2 + 1]);
  }
  __syncthreads();
  f32x2_t xv[64];
  if (wv < 2) {
#pragma unroll
    for (int i = 0; i < 64; ++i) { xv[i].x = sm_beta[i] * bf2f(Vs[i * 136 + tid]); xv[i].y = sm_fw[i] * bf2f(Ks[i * 136 + tid]); }
    solve_rows2<1>(xv, Lm, lane, Lm[68 + lane]);
    const int sl = tid >> 4, dvl = tid & 15;
#pragma unroll
    for (int mt = 0; mt < 4; ++mt)
#pragma unroll
      for (int gg = 0; gg < 4; ++gg) {
        u32x2 w; w.x = pk_bf16(xv[16 * mt + 4 * gg].x, xv[16 * mt + 4 * gg + 1].x); w.y = pk_bf16(xv[16 * mt + 4 * gg + 2].x, xv[16 * mt + 4 * gg + 3].x);
        *(u32x2*)(op + 57344 + (size_t)((sl * 4 + mt) * 64 + gg * 16 + dvl) * 8) = w;
      }
  } else {
    const int t2 = tid - 128;
#pragma unroll 2
    for (int f = 0; f < 8; ++f) {
      const int e = t2 + 128 * f, frag = e >> 6, ln = e & 63, lr = ln & 15, lg = ln >> 4;
      {
        const int mt = frag >> 2, sx = frag & 3, row = 16 * mt + lr;
        const u32x2 ql = *(const u32x2*)(Qs + row * 136 + 32 * sx + 4 * lg), qh = *(const u32x2*)(Qs + row * 136 + 32 * sx + 16 + 4 * lg);
        const float fq = sm_fq[row];
        u32x4 w;
        w.x = pk_bf16(bf_lo(ql.x) * fq, bf_hi(ql.x) * fq); w.y = pk_bf16(bf_lo(ql.y) * fq, bf_hi(ql.y) * fq);
        w.z = pk_bf16(bf_lo(qh.x) * fq, bf_hi(qh.x) * fq); w.w = pk_bf16(bf_lo(qh.y) * fq, bf_hi(qh.y) * fq);
        *(u32x4*)(op + 16384 + (size_t)e * 16) = w;
      }
      {
        const int mt8 = frag >> 1, s2 = frag & 1, dk = 16 * mt8 + lr;
        float v[8];
#pragma unroll
        for (int j = 0; j < 8; ++j) {
          const int pos = 32 * s2 + 16 * (j >> 2) + 4 * lg + (j & 3);
          v[j] = bf2f(Ks[pos * 136 + dk]) * sm_fk[pos];
        }
        u32x4 w; w.x = pk_bf16(v[0], v[1]); w.y = pk_bf16(v[2], v[3]); w.z = pk_bf16(v[4], v[5]); w.w = pk_bf16(v[6], v[7]);
        *(u32x4*)(op + 40960 + (size_t)e * 16) = w;
      }
    }
  }
  __syncthreads();
  if (wv < 2) {
#pragma unroll
    for (int i = 0; i < 64; ++i) Vs[i * 136 + tid] = f2bf(-xv[i].y);
  }
  __syncthreads();
#pragma unroll
  for (int f = 0; f < 4; ++f) {
    const int e = tid + 256 * f, frag = e >> 6, ln = e & 63, lr = ln & 15, lg = ln >> 4;
    const int mt = frag >> 2, sx = frag & 3, row = 16 * mt + lr;
    const u32x2 lo = *(const u32x2*)(Vs + row * 136 + 32 * sx + 4 * lg), hi = *(const u32x2*)(Vs + row * 136 + 32 * sx + 16 + 4 * lg);
    *(u32x4*)(op + (size_t)e * 16) = (u32x4){lo.x, lo.y, hi.x, hi.y};
  }
}

struct ScanA { u32x4 wf[4]; u32x2 uf; float dec; };
struct ScanB { u32x4 qf[4], af[2], kf[4]; };

DI void scan_load_a(const Params& p, int wvs, ScanA& o, int b, int hd, int sl, int n, int q, int lane) {
  const int item = (b * 128 + n) * 4 + hd;
  const unsigned char* op = p.ws + OFF_SC + (size_t)item * OPB;
#pragma unroll
  for (int s = 0; s < 4; ++s) {
    o.wf[s] = *(const u32x4*)(op + (size_t)((q * 4 + s) * 64 + lane) * 16);
  }
  o.uf = *(const u32x2*)(op + 57344 + (size_t)((sl * 4 + q) * 64 + lane) * 8);
  o.dec = ((const float*)(p.ws + OFF_DEC))[item];
}
DI void scan_load_b(const Params& p, int wvs, ScanB& o, int b, int hd, int n, int q, int lane) {
  const int item = (b * 128 + n) * 4 + hd;
  const unsigned char* op = p.ws + OFF_SC + (size_t)item * OPB;
#pragma unroll
  for (int s = 0; s < 4; ++s) o.qf[s] = *(const u32x4*)(op + 16384 + (size_t)((q * 4 + s) * 64 + lane) * 16);
#pragma unroll
  for (int s2 = 0; s2 < 2; ++s2) o.af[s2] = *(const u32x4*)(op + 32768 + (size_t)((q * 2 + s2) * 64 + lane) * 16);
#pragma unroll
  for (int j = 0; j < 4; ++j) o.kf[j] = *(const u32x4*)(op + 40960 + (size_t)((q * 4 + j) * 64 + lane) * 16);
}

DI void scan_step(const Params& p, int wvs, const ScanA& o, const ScanB& ob, f32x4 (&S)[2], int b, int hd, int sl, int n, int q, int lane, unsigned char* smem) {
  const int r16 = lane & 15, g = lane >> 4;
  u32x4* ldsS = (u32x4*)smem;
  u32x2* ldsV = (u32x2*)(smem + 4096);
  ldsS[q * 64 + lane] = __builtin_bit_cast(u32x4, pack8(S[0], S[1]));
  __syncthreads();
  bf16x8 Sb[4];
#pragma unroll
  for (int s = 0; s < 4; ++s) Sb[s] = as_bf8(ldsS[s * 64 + lane]);
  f32x4 vn = (f32x4){bf_lo(o.uf.x), bf_hi(o.uf.x), bf_lo(o.uf.y), bf_hi(o.uf.y)};
#pragma unroll
  for (int s = 0; s < 4; ++s) vn = mfma16(as_bf8(o.wf[s]), Sb[s], vn);
  { u32x2 w; w.x = pk_bf16(vn[0], vn[1]); w.y = pk_bf16(vn[2], vn[3]); ldsV[((q >> 1) * 64 + lane) * 2 + (q & 1)] = w; }
  f32x4 oa = (f32x4){0.f, 0.f, 0.f, 0.f};
#pragma unroll
  for (int s = 0; s < 4; ++s) oa = mfma16(as_bf8(ob.qf[s]), Sb[s], oa);
  __syncthreads();
  bf16x8 Vb[2];
#pragma unroll
  for (int s2 = 0; s2 < 2; ++s2) Vb[s2] = as_bf8(*(const u32x4*)(ldsV + (s2 * 64 + lane) * 2));
#pragma unroll
  for (int s2 = 0; s2 < 2; ++s2) oa = mfma16(as_bf8(ob.af[s2]), Vb[s2], oa);
  u16* h = (u16*)(p.ws + OFF_H);
  const int t0 = b * SEQ + n * 64;
#pragma unroll
  for (int r = 0; r < 4; ++r) h[(size_t)(t0 + 16 * q + 4 * g + r) * NC + hd * 128 + 16 * sl + r16] = f2bf(oa[r]);
#pragma unroll
  for (int t = 0; t < 2; ++t) {
    S[t] = S[t] * o.dec;
#pragma unroll
    for (int s2 = 0; s2 < 2; ++s2) S[t] = mfma16(as_bf8(ob.kf[t * 2 + s2]), Vb[s2], S[t]);
  }
}

DI void scan_chain(const Params& p, int wvs, int pair, int sl, unsigned char* smem) {
  const int tid0 = opaque_tid(); const int lane = tid0 & 63, q = tid0 >> 6;
  const int b = pair >> 2, hd = pair & 3;
  f32x4 S[2]; S[0] = (f32x4){0.f, 0.f, 0.f, 0.f}; S[1] = S[0];
  ScanA a0, a1, a2; ScanB bc, bn;
  __syncthreads();
  scan_load_a(p, wvs, a0, b, hd, sl, 0, q, lane);
  scan_load_b(p, wvs, bc, b, hd, 0, q, lane);
  scan_load_a(p, wvs, a1, b, hd, sl, 1, q, lane);
#pragma unroll 1
  for (int n = 0; n < 129; n += 3) {
    if (n + 2 < 128) scan_load_a(p, wvs, a2, b, hd, sl, n + 2, q, lane);
    if (n + 1 < 128) scan_load_b(p, wvs, bn, b, hd, n + 1, q, lane);
    if (n < 128) scan_step(p, wvs, a0, bc, S, b, hd, sl, n, q, lane, smem);
    bc = bn;
    if (n + 3 < 128) scan_load_a(p, wvs, a0, b, hd, sl, n + 3, q, lane);
    if (n + 2 < 128) scan_load_b(p, wvs, bn, b, hd, n + 2, q, lane);
    if (n + 1 < 128) scan_step(p, wvs, a1, bc, S, b, hd, sl, n + 1, q, lane, smem);
    bc = bn;
    if (n + 4 < 128) scan_load_a(p, wvs, a1, b, hd, sl, n + 4, q, lane);
    if (n + 3 < 128) scan_load_b(p, wvs, bn, b, hd, n + 3, q, lane);
    if (n + 2 < 128) scan_step(p, wvs, a2, bc, S, b, hd, sl, n + 2, q, lane, smem);
    bc = bn;
  }
}

DI void swa_item(const Params& p, int wvs, int item, bool valid, unsigned char* smem) {
  if (!valid) { __syncthreads(); __syncthreads(); return; }
  const int tid_ = opaque_tid();
  const int tid = tid_, lane = tid & 63, wv = tid >> 6, r16 = lane & 15, g = lane >> 4;
  const int qt = item & 127, kvh = (item >> 7) & 1, b = item >> 8;
  const int kp0 = 64 * qt - 128;
  u16* Ksm = (u16*)smem;
  u16* Vt = (u16*)(smem + 27648);
  u16* h = (u16*)(p.ws + OFF_H);
  const float* rc = (const float*)(p.ws + OFF_ROPE); const float* rs = rc + 8192 * 8;
  __syncthreads();
  if (tid < 192) {
    const int kk = tid, pos = kp0 + kk;
    u32x4 lo = (u32x4){0, 0, 0, 0}, hi = lo;
    if (pos >= 0) {
      const u16* src = h + (size_t)(b * SEQ + pos) * NC + C_SWK + kvh * 64;
      const u32x4 a = *(const u32x4*)src, c = *(const u32x4*)(src + 8);
      const f32x4 c0 = *(const f32x4*)(rc + pos * 8), c1 = *(const f32x4*)(rc + pos * 8 + 4);
      const f32x4 s0 = *(const f32x4*)(rs + pos * 8), s1 = *(const f32x4*)(rs + pos * 8 + 4);
      float t1[8], t2[8], cs[8], sn[8], o1[8], o2[8];
#pragma unroll
      for (int j = 0; j < 4; ++j) { t1[2 * j] = bf_lo(a[j]); t1[2 * j + 1] = bf_hi(a[j]); t2[2 * j] = bf_lo(c[j]); t2[2 * j + 1] = bf_hi(c[j]);
        cs[j] = c0[j]; cs[4 + j] = c1[j]; sn[j] = s0[j]; sn[4 + j] = s1[j]; }
#pragma unroll
      for (int j = 0; j < 8; ++j) { o1[j] = t1[j] * cs[j] - t2[j] * sn[j]; o2[j] = t2[j] * cs[j] + t1[j] * sn[j]; }
#pragma unroll
      for (int j = 0; j < 4; ++j) { lo[j] = pk_bf16(o1[2 * j], o1[2 * j + 1]); hi[j] = pk_bf16(o2[2 * j], o2[2 * j + 1]); }
    }
    *(u32x4*)(Ksm + kk * 72) = lo; *(u32x4*)(Ksm + kk * 72 + 8) = hi;
  }
  for (int e = tid; e < 192 * 6; e += 256) {
    const int kk = e / 6, ch = 2 + e % 6, pos = kp0 + kk;
    u32x4 v = (u32x4){0, 0, 0, 0};
    if (pos >= 0) v = *(const u32x4*)(h + (size_t)(b * SEQ + pos) * NC + C_SWK + kvh * 64 + ch * 8);
    *(u32x4*)(Ksm + kk * 72 + ch * 8) = v;
  }
  for (int e = tid; e < 192 * 8; e += 256) {
    const int kk = e >> 3, ch = e & 7, pos = kp0 + kk;
    u32x4 v = (u32x4){0, 0, 0, 0};
    if (pos >= 0) v = *(const u32x4*)(h + (size_t)(b * SEQ + pos) * NC + C_SWV + kvh * 64 + ch * 8);
#pragma unroll
    for (int j = 0; j < 4; ++j) { Vt[(ch * 8 + 2 * j) * 200 + kk] = (u16)(v[j] & 0xffffu); Vt[(ch * 8 + 2 * j + 1) * 200 + kk] = (u16)(v[j] >> 16); }
  }
  __syncthreads();
  const int st = wv, jt0 = st < 2 ? st : 2;
  const int qi = 16 * st + r16;
  const int qpos = 64 * qt + qi, tq = b * SEQ + qpos;
#pragma unroll 1
  for (int hq = 0; hq < 4; ++hq) {
    const int head = kvh * 4 + hq;
    u16* qsrc = h + (size_t)tq * NC + C_SWQ + head * 64;
    bf16x8 qf[2];
    {
      const u32x4 a = *(const u32x4*)qsrc, c = *(const u32x4*)(qsrc + 8);
      u32x4 w = *(const u32x4*)(qsrc + 8 * g);
      if (g < 2) {
        const f32x4 c0 = *(const f32x4*)(rc + qpos * 8), c1 = *(const f32x4*)(rc + qpos * 8 + 4);
        const f32x4 s0 = *(const f32x4*)(rs + qpos * 8), s1 = *(const f32x4*)(rs + qpos * 8 + 4);
        float t1[8], t2[8], cs[8], sn[8], o[8];
#pragma unroll
        for (int j = 0; j < 4; ++j) { t1[2 * j] = bf_lo(a[j]); t1[2 * j + 1] = bf_hi(a[j]); t2[2 * j] = bf_lo(c[j]); t2[2 * j + 1] = bf_hi(c[j]);
          cs[j] = c0[j]; cs[4 + j] = c1[j]; sn[j] = s0[j]; sn[4 + j] = s1[j]; }
#pragma unroll
        for (int j = 0; j < 8; ++j) o[j] = (g == 0) ? (t1[j] * cs[j] - t2[j] * sn[j]) : (t2[j] * cs[j] + t1[j] * sn[j]);
#pragma unroll
        for (int j = 0; j < 4; ++j) w[j] = pk_bf16(o[2 * j], o[2 * j + 1]);
      }
      qf[0] = as_bf8(w);
      qf[1] = as_bf8(*(const u32x4*)(qsrc + 32 + 8 * g));
    }
    f32x4 sc[10];
#pragma unroll
    for (int t = 0; t < 10; ++t) {
      sc[t] = (f32x4){0.f, 0.f, 0.f, 0.f};
#pragma unroll
      for (int s = 0; s < 2; ++s) {
        const bf16x8 kf = *(const bf16x8*)(Ksm + (16 * (jt0 + t) + r16) * 72 + 32 * s + 8 * g);
        sc[t] = mfma16(kf, qf[s], sc[t]);
      }
    }
    const float sink = p.sinks[head];
    float mx = sink;
#pragma unroll
    for (int t = 0; t < 10; ++t)
#pragma unroll
      for (int r = 0; r < 4; ++r) {
        const int kk = 16 * (jt0 + t) + 4 * g + r, d = kk - qi;
        const bool ok = (d >= 1) && (d <= 128) && (kp0 + kk >= 0);
        const float v = ok ? sc[t][r] * 0.125f : -1e30f;
        sc[t][r] = v; mx = fmaxf(mx, v);
      }
    mx = fmaxf(mx, shx(mx, 16, lane)); mx = fmaxf(mx, shx(mx, 32, lane));
    float sum = 0.f;
#pragma unroll
    for (int t = 0; t < 10; ++t)
#pragma unroll
      for (int r = 0; r < 4; ++r) { const float e = __expf(sc[t][r] - mx); sc[t][r] = e; sum += e; }
    sum += shx(sum, 16, lane); sum += shx(sum, 32, lane);
    const float inv = rcp_f(sum + __expf(sink - mx));
    f32x4 oacc[4];
#pragma unroll
    for (int dt = 0; dt < 4; ++dt) oacc[dt] = (f32x4){0.f, 0.f, 0.f, 0.f};
#pragma unroll
    for (int s2 = 0; s2 < 5; ++s2) {
      const bf16x8 pb = pack8(sc[2 * s2], sc[2 * s2 + 1]);
#pragma unroll
      for (int dt = 0; dt < 4; ++dt) {
        const u16* vr = Vt + (16 * dt + r16) * 200 + 16 * (jt0 + 2 * s2) + 4 * g;
        const u32x2 lo = *(const u32x2*)vr, hi = *(const u32x2*)(vr + 16);
        oacc[dt] = mfma16(as_bf8((u32x4){lo.x, lo.y, hi.x, hi.y}), pb, oacc[dt]);
      }
    }
#pragma unroll
    for (int dt = 0; dt < 4; ++dt) {
      const int dcol = head * 64 + 16 * dt + 4 * g;
      const u32x2 z = *(const u32x2*)(h + (size_t)tq * NC + C_SWZ + dcol);
      u32x2 w;
      w.x = pk_bf16(oacc[dt][0] * inv * silu_f(bf_lo(z.x)), oacc[dt][1] * inv * silu_f(bf_hi(z.x)));
      w.y = pk_bf16(oacc[dt][2] * inv * silu_f(bf_lo(z.y)), oacc[dt][3] * inv * silu_f(bf_hi(z.y)));
      *(u32x2*)(h + (size_t)tq * NC + C_SWQ + dcol) = w;
    }
  }
}

DI void phase_ya(const Params& p, int wvs) {
  u16* h = (u16*)(p.ws + OFF_H);
  const int ltid = opaque_tid(), lane = ltid & 63;
  const size_t gt = (size_t)blockIdx.x * 512 + ltid, gs = (size_t)gridDim.x * 512;
  const float* nwp = p.dn_norm_w + (ltid & 15) * 8;
  const f32x4 nw0 = *(const f32x4*)nwp, nw1 = *(const f32x4*)(nwp + 4);
  for (size_t i0 = gt; i0 < (size_t)T_TOK * 64; i0 += 4 * gs) {
    u32x4 v[4], z[4];
#pragma unroll
    for (int k = 0; k < 4; ++k) {
      const size_t i = i0 + k * gs;
      if (i < (size_t)T_TOK * 64) {
        const u16* ptr = h + (size_t)(i >> 6) * NC + (i & 63) * 8;
        v[k] = *(const u32x4*)ptr; z[k] = *(const u32x4*)(ptr + C_DNZ);
      } else { v[k] = (u32x4){0, 0, 0, 0}; z[k] = v[k]; }
    }
#pragma unroll
    for (int k = 0; k < 4; ++k) {
      const size_t i = i0 + k * gs;
      float o[8]; float ss = 0.f;
#pragma unroll
      for (int j = 0; j < 4; ++j) { o[2 * j] = bf_lo(v[k][j]); o[2 * j + 1] = bf_hi(v[k][j]); }
#pragma unroll
      for (int j = 0; j < 8; ++j) ss += o[j] * o[j];
      ss += shx(ss, 1, lane); ss += shx(ss, 2, lane); ss += shx(ss, 4, lane); ss += shx(ss, 8, lane);
      const float rs = rsqrtf(ss * (1.0f / 128.0f) + 1e-6f);
      float y[8];
#pragma unroll
      for (int j = 0; j < 4; ++j) {
        const float w0 = (j < 2) ? nw0[2 * j] : nw1[2 * j - 4], w1 = (j < 2) ? nw0[2 * j + 1] : nw1[2 * j - 3];
        y[2 * j] = o[2 * j] * rs * w0 * silu_f(bf_lo(z[k][j]));
        y[2 * j + 1] = o[2 * j + 1] * rs * w1 * silu_f(bf_hi(z[k][j]));
      }
      u32x4 w; w.x = pk_bf16(y[0], y[1]); w.y = pk_bf16(y[2], y[3]); w.z = pk_bf16(y[4], y[5]); w.w = pk_bf16(y[6], y[7]);
      if (i < (size_t)T_TOK * 64) *(u32x4*)(h + (size_t)(i >> 6) * NC + (i & 63) * 8) = w;
    }
  }
}

DI void phase4(const Params& p, int wvs, int vb, int nvb, unsigned char* smem) {
  const int xcd = vb & 7, lb = vb >> 3, nlb = nvb >> 3;
  const u16* h = (const u16*)(p.ws + OFF_H);
  const u16* wat = (const u16*)(p.ws + OFF_WAT);
  const u16* wbt = (const u16*)(p.ws + OFF_WBT);
  u16* mg = (u16*)(p.ws + OFF_SC);
  const int tid0 = opaque_tid(); const int lane = tid0 & 63, wv = tid0 >> 6, wm = wv >> 1, wn = wv & 1, r16 = lane & 15, g = lane >> 4;
  for (int li = lb;; li += nlb) {
    int mt, nt; if (!tile_of(li, 4, xcd, mt, nt)) break;
    f32x4 acc[4][8]; zero_acc(acc);
    gemm_kloop(p, wvs, h, NC, wat, 512, 16, mt * 128, nt * 256, acc, smem);
#pragma unroll
    for (int mi = 0; mi < 4; ++mi) {
      const int row = mt * 128 + wm * 64 + mi * 16 + r16;
#pragma unroll
      for (int ni = 0; ni < 8; ++ni) {
        const int col = nt * 256 + wn * 128 + ni * 16 + 4 * g;
        const u32x2 ga = *(const u32x2*)(h + (size_t)row * NC + C_GA + col), gb = *(const u32x2*)(h + (size_t)row * NC + C_GB + col);
        acc[mi][ni][0] *= (1.f + __expf(-bf_lo(gb.x))) * rcp_f(1.f + __expf(-bf_lo(ga.x)));
        acc[mi][ni][1] *= (1.f + __expf(-bf_hi(gb.x))) * rcp_f(1.f + __expf(-bf_hi(ga.x)));
        acc[mi][ni][2] *= (1.f + __expf(-bf_lo(gb.y))) * rcp_f(1.f + __expf(-bf_lo(ga.y)));
        acc[mi][ni][3] *= (1.f + __expf(-bf_hi(gb.y))) * rcp_f(1.f + __expf(-bf_hi(ga.y)));
      }
      if (mi & 1) __builtin_amdgcn_sched_barrier(0);
    }
    gemm_kloop(p, wvs, h + C_SWQ, NC, wbt, 512, 16, mt * 128, nt * 256, acc, smem);
#pragma unroll
    for (int mi = 0; mi < 4; ++mi) {
      const int row = mt * 128 + wm * 64 + mi * 16 + r16;
#pragma unroll
      for (int ni = 0; ni < 8; ++ni) {
        const int col = nt * 256 + wn * 128 + ni * 16 + 4 * g;
        const u32x2 gb = *(const u32x2*)(h + (size_t)row * NC + C_GB + col);
        u32x2 w;
        w.x = pk_bf16(acc[mi][ni][0] * sigmoid_f(bf_lo(gb.x)), acc[mi][ni][1] * sigmoid_f(bf_hi(gb.x)));
        w.y = pk_bf16(acc[mi][ni][2] * sigmoid_f(bf_lo(gb.y)), acc[mi][ni][3] * sigmoid_f(bf_hi(gb.y)));
        *(u32x2*)(mg + (size_t)row * 1024 + col) = w;
      }
      if (mi & 1) __builtin_amdgcn_sched_barrier(0);
    }
  }
}

DI void phase5(const Params& p, int wvs, unsigned char* smem) {
  const int xcd = blockIdx.x & 7, lb = blockIdx.x >> 3, nlb = gridDim.x >> 3;
  const u16* mg = (const u16*)(p.ws + OFF_SC);
  const u16* wot = (const u16*)(p.ws + OFF_WOT);
  const int tid0 = opaque_tid(); const int lane = tid0 & 63, wv = tid0 >> 6, wm = wv >> 1, wn = wv & 1, r16 = lane & 15, g = lane >> 4;
  for (int li = lb;; li += nlb) {
    int mt, nt; if (!tile_of(li, 4, xcd, mt, nt)) break;
    f32x4 acc[4][8]; zero_acc(acc);
    gemm_kloop(p, wvs, mg, 1024, wot, 1024, 32, mt * 128, nt * 256, acc, smem);
#pragma unroll
    for (int mi = 0; mi < 4; ++mi) {
      const int row = mt * 128 + wm * 64 + mi * 16 + r16;
#pragma unroll
      for (int ni = 0; ni < 8; ++ni) {
        const int col = nt * 256 + wn * 128 + ni * 16 + 4 * g;
        const f32x4 xv = *(const f32x4*)(p.x + (size_t)row * 1024 + col);
        *(f32x4*)(p.out + (size_t)row * 1024 + col) = xv * 1.189207115002721f + acc[mi][ni];
      }
    }
  }
}

DI float wave_sum(float v, int lane) {
#pragma unroll
  for (int o = 32; o > 0; o >>= 1) v += shx(v, o, lane);
  return v;
}
DI void phase6(const Params& p, int wvs, unsigned char* smem) {
  const int tid = opaque_tid(), lane = tid & 63, wv = tid >> 6;
  f32x4 gm[4], bt[4];
#pragma unroll
  for (int j = 0; j < 4; ++j) { gm[j] = *(const f32x4*)(p.ln_g + 4 * (lane + 64 * j)); bt[j] = *(const f32x4*)(p.ln_b + 4 * (lane + 64 * j)); }
  const int xcd6 = blockIdx.x & 7, lb6 = blockIdx.x >> 3, nlb6 = gridDim.x >> 3;
  for (int lr = (lb6 * 8 + wv) * 2; lr < 4096; lr += nlb6 * 16) {
    const int row0 = 4096 * xcd6 + (4095 - lr), row1 = row0 - 1;
    float* r0 = p.out + (size_t)row0 * 1024;
    float* r1 = p.out + (size_t)row1 * 1024;
    const _Float16* s0 = (const _Float16*)(p.ws + OFF_H) + (size_t)row0 * 1024;
    const _Float16* s1 = (const _Float16*)(p.ws + OFF_H) + (size_t)row1 * 1024;
    f32x4 a[4], b[4];
#pragma unroll
    for (int j = 0; j < 4; ++j) {
      a[j] = __builtin_convertvector(*(const f16x4*)(s0 + 4 * (lane + 64 * j)), f32x4);
      b[j] = __builtin_convertvector(*(const f16x4*)(s1 + 4 * (lane + 64 * j)), f32x4);
    }
    float sa = 0.f, sb = 0.f;
#pragma unroll
    for (int j = 0; j < 4; ++j) { sa += (a[j][0] + a[j][1]) + (a[j][2] + a[j][3]); sb += (b[j][0] + b[j][1]) + (b[j][2] + b[j][3]); }
    const float ma = wave_sum(sa, lane) * (1.0f / 1024.0f), mb = wave_sum(sb, lane) * (1.0f / 1024.0f);
    float qa = 0.f, qb = 0.f;
#pragma unroll
    for (int j = 0; j < 4; ++j) {
      a[j] = a[j] - ma; b[j] = b[j] - mb;
      qa += (a[j][0] * a[j][0] + a[j][1] * a[j][1]) + (a[j][2] * a[j][2] + a[j][3] * a[j][3]);
      qb += (b[j][0] * b[j][0] + b[j][1] * b[j][1]) + (b[j][2] * b[j][2] + b[j][3] * b[j][3]);
    }
    const float ra = rsqrtf(wave_sum(qa, lane) * (1.0f / 1024.0f) + 1e-5f), rb = rsqrtf(wave_sum(qb, lane) * (1.0f / 1024.0f) + 1e-5f);
#pragma unroll
    for (int j = 0; j < 4; ++j) {
      *(f32x4*)(r0 + 4 * (lane + 64 * j)) = a[j] * ra * gm[j] + bt[j];
      *(f32x4*)(r1 + 4 * (lane + 64 * j)) = b[j] * rb * gm[j] + bt[j];
    }
  }
}

#define XB_TMO      128
#define XB_XCNT(j)  (256  + 64 * (j))
#define XB_XSUB(j)  (1280 + 64 * (j))
#define XB_XGEN(j)  (2304 + 64 * (j))
#define XB_TOP      3328
#define XB_TOPGEN   3392
#define XCD_BAR_WORDS 3456
#define XB_SPIN_CAP (1u << 22)
#define LAS __attribute__((address_space(3)))
DI unsigned xb_ld(unsigned* p) { return __hip_atomic_load(p, __ATOMIC_RELAXED, __HIP_MEMORY_SCOPE_AGENT); }
DI unsigned xb_add(unsigned* p, unsigned v) { return __hip_atomic_fetch_add(p, v, __ATOMIC_RELAXED, __HIP_MEMORY_SCOPE_AGENT); }
DI unsigned xb_xcc_id() { return (unsigned)__builtin_amdgcn_s_getreg((3 << 11) | 20) & 0xFu; }
#define XB_SPIN(cond, bar) do { unsigned _sp = 0; while (cond) { __builtin_amdgcn_s_sleep(1); \
    if ((++_sp & 255u) == 0u) { if (xb_ld(&(bar)[XB_TMO])) break; if (_sp > XB_SPIN_CAP) { atomicAdd(&(bar)[XB_TMO], 1u); break; } } } } while (0)
struct XcdBarrier { unsigned* bar; unsigned x; volatile LAS unsigned* st; };
DI bool xb_leader(int wvs) { return wvs == 0 && __builtin_amdgcn_mbcnt_hi(~0u, __builtin_amdgcn_mbcnt_lo(~0u, 0u)) == 0u; }
DI XcdBarrier xcd_barrier_post(unsigned* bar, volatile LAS unsigned* st, int wvs) {
  XcdBarrier b; b.bar = bar; b.x = xb_xcc_id(); b.st = st;
  if (xb_leader(wvs)) (void)xb_add(&bar[XB_XCNT(b.x)], 1u);
  return b;
}
DI void xcd_barrier_complete(unsigned* bar, unsigned x, unsigned& nloc, unsigned& nx) {
  const unsigned G = gridDim.x * gridDim.y * gridDim.z;
  unsigned sum, cnt, mine, sp = 0u;
  for (;;) {
    sum = 0u; cnt = 0u; mine = 0u;
#pragma unroll
    for (unsigned j = 0; j < 16; ++j) { const unsigned c = xb_ld(&bar[XB_XCNT(j)]); sum += c; cnt += (c > 0u) ? 1u : 0u; mine = (j == x) ? c : mine; }
    if (sum == G) break;
    __builtin_amdgcn_s_sleep(1);
    if ((++sp & 255u) == 0u) { if (xb_ld(&bar[XB_TMO])) break; if (sp > XB_SPIN_CAP) { atomicAdd(&bar[XB_TMO], 1u); break; } }
  }
  nloc = mine > 0u ? mine : 1u; nx = cnt > 0u ? cnt : 1u;
}
DI void xcd_barrier_(const XcdBarrier& b, int wvs) {
  asm volatile("s_waitcnt vmcnt(0)" ::: "memory");
  __syncthreads();
  if (xb_leader(wvs)) {
    unsigned* bar = b.bar;
    __builtin_amdgcn_s_waitcnt(0);
    unsigned nloc = b.st[0], nx = b.st[1];
    if (nloc == 0u) { xcd_barrier_complete(bar, b.x, nloc, nx); b.st[0] = nloc; b.st[1] = nx; }
    const unsigned old = xb_add(&bar[XB_XSUB(b.x)], 1u);
    const unsigned gen = old / nloc;
    if (old + 1u == (gen + 1u) * nloc) {
      __builtin_amdgcn_fence(__ATOMIC_RELEASE, "agent");
      asm volatile("s_waitcnt vmcnt(0)" ::: "memory");
      const unsigned og = xb_add(&bar[XB_TOP], 1u);
      const unsigned tg = og / nx;
      if (og + 1u == (tg + 1u) * nx) xb_add(&bar[XB_TOPGEN], 1u);
      else XB_SPIN(xb_ld(&bar[XB_TOPGEN]) == tg, bar);
      __builtin_amdgcn_fence(__ATOMIC_ACQUIRE, "agent");
      xb_add(&bar[XB_XGEN(b.x)], 1u);
      asm volatile("s_waitcnt vmcnt(0)" ::: "memory");
    } else {
      XB_SPIN(xb_ld(&bar[XB_XGEN(b.x)]) == gen, bar);
      __builtin_amdgcn_fence(__ATOMIC_ACQUIRE, "agent");
      asm volatile("s_waitcnt vmcnt(0)" ::: "memory");
    }
  }
  __syncthreads();
}

#define xcd_barrier(b) xcd_barrier_(b, w8)
namespace pg8 {
#define PG8_LAS __attribute__((address_space(3)))
typedef unsigned short bf16_t;
typedef short bf16x8 __attribute__((ext_vector_type(8)));
typedef float f32x4 __attribute__((ext_vector_type(4)));
typedef unsigned u32x4 __attribute__((ext_vector_type(4)));
constexpr int BM = 256, BK = 64, HALF = 128, HTB = HALF * BK * 2  , STAGE_BYTES = 8 * HTB, NXCD = 8, WGM = 8;

__host__ __device__ __forceinline__ int lds_byte(int r, int c) { const int st = (r >> 4) * 2 + (c >> 5), rr = r & 15, cc = c & 31, ob = rr * 64 + cc * 2; return st * 1024 + (ob ^ (((ob >> 9) & 1) << 5)); }
__host__ __device__ __forceinline__ void stage_rc(int b, int& R, int& C) { const int st = b / 1024, sb = b % 1024, swz = sb ^ (((sb >> 9) & 1) << 5); R = (st >> 1) * 16 + swz / 64; C = (st & 1) * 32 + (swz % 64) / 2; }
__host__ __device__ __forceinline__ int perm32(int rho) { const int n = rho >> 4, i = rho & 15; return 8 * (i >> 2) + 4 * n + (i & 3); }

struct Unit { int pm, pn; };
struct Gemm { const bf16_t* A; const bf16_t* Bt; int M, N, K; };

struct StaticOrder {
    int nM, nN, nwg, G, c;
    __host__ __device__ void init(int M, int N, int G_, int c_) { nM = M / BM; nN = N / BM; nwg = nM * nN; G = G_; c = c_; }
    __host__ __device__ bool next(int i, Unit& u) const {
        const long L = (long)i * G + c; if (L >= nwg) return false;
        int wgid = (int)L; { const int q = nwg / NXCD, r = nwg % NXCD, xcd = wgid % NXCD, off = wgid / NXCD; wgid = (xcd < r ? xcd * (q + 1) : r * (q + 1) + (xcd - r) * q) + off; }
        const int nig = WGM * nN, gid = wgid / nig, fm = gid * WGM, gsz = (nM - fm) < WGM ? (nM - fm) : WGM;
        u.pm = fm + ((wgid % nig) % gsz); u.pn = (wgid % nig) / gsz; return true;
    }
    __device__ __forceinline__ void a_ready(const Unit&) const {}
    __device__ __forceinline__ void done(const Unit&) const {}
};

template <class Epi, class Sched, bool ALIGN_EPI = false, bool SP2 = false>
__device__ __forceinline__ void gemm_phase(PG8_LAS unsigned char* lds, const Gemm g, const Sched& S, const Epi& E, const int tid) {
    const int wid = __builtin_amdgcn_readfirstlane(tid >> 6), lane = tid & 63, wr = wid >> 2, wc = wid & 3, fr = lane & 15, fq = lane >> 4;
    const int K = g.K, nt = K / BK;
    unsigned voffA[2], voffB[2];
#pragma unroll
    for (int i = 0; i < 2; ++i) { int R, C; stage_rc(tid * 16 + i * 8192, R, C); const int Rb = Epi::PERM ? ((R & ~31) + perm32(R & 31)) : R;
        voffA[i] = (unsigned)(R * K + C) * 2u; voffB[i] = (unsigned)(Rb * K + C) * 2u; }
    const size_t kstep = (size_t)(BK * 2);
    const size_t hstep = (size_t)HALF * K * 2;
    const size_t tstep = 2 * hstep;
    const unsigned ldsw = (unsigned)wid * 1024u;
    const int aoff = lds_byte(wr * 64 + fr, fq * 8), boff = lds_byte(wc * 32 + fr, fq * 8);
#define PG8_SA(b, h) (((b) * 2 + (h)) * HTB)
#define PG8_SB(b, h) ((4 + (b) * 2 + (h)) * HTB)
#define PG8_STAGE(bufoff, gbase, voff) do { _Pragma("unroll") for (int _i = 0; _i < 2; ++_i) \
        __builtin_amdgcn_global_load_lds((const unsigned*)((const char*)(gbase) + (voff)[_i]), (PG8_LAS unsigned*)(lds + (bufoff) + ldsw + _i * 8192), 16, 0, 0); } while (0)
#define PG8_LDA(dst, b, h) do { _Pragma("unroll") for (int m = 0; m < 4; ++m) _Pragma("unroll") for (int k = 0; k < 2; ++k) dst[m][k] = *(const PG8_LAS bf16x8*)(lds + PG8_SA(b, h) + aoff + m * 2048 + k * 1024); } while (0)
#define PG8_LDB(dst, b, h) do { _Pragma("unroll") for (int n = 0; n < 2; ++n) _Pragma("unroll") for (int k = 0; k < 2; ++k) dst[n][k] = *(const PG8_LAS bf16x8*)(lds + PG8_SB(b, h) + boff + n * 2048 + k * 1024); } while (0)
#define PG8_MMA(ai, bj, At, Bt) do { __builtin_amdgcn_s_setprio(1); _Pragma("unroll") for (int m = 0; m < 4; ++m) _Pragma("unroll") for (int n = 0; n < 2; ++n) _Pragma("unroll") for (int k = 0; k < 2; ++k) \
        acc[ai][bj][m][n] = __builtin_amdgcn_mfma_f32_16x16x32_bf16(Bt[n][k], At[m][k], acc[ai][bj][m][n], 0, 0, 0); __builtin_amdgcn_s_setprio(0); } while (0)
#define PG8_WAIT_V(n) asm volatile("s_waitcnt vmcnt(" #n ")" ::: "memory")
#define PG8_WAIT_L(n) asm volatile("s_waitcnt lgkmcnt(" #n ")" ::: "memory")
#define PG8_BAR __builtin_amdgcn_s_barrier()
#define PG8_SCHED __builtin_amdgcn_sched_barrier(0)
    Unit cur, nxt; int ui = 0;
    if (!S.next(0, cur)) return;
    f32x4 acc[2][2][4][2];
#pragma unroll
    for (int a = 0; a < 2; ++a)
#pragma unroll
        for (int b = 0; b < 2; ++b)
#pragma unroll
            for (int m = 0; m < 4; ++m)
#pragma unroll
                for (int n = 0; n < 2; ++n) acc[a][b][m][n] = (f32x4){0.f, 0.f, 0.f, 0.f};
    bf16x8 At[4][2], B0[2][2], B1[2][2];
    const char* cA = (const char*)g.A + (size_t)cur.pm * tstep; const char* cB = (const char*)g.Bt + (size_t)cur.pn * tstep;
    S.a_ready(cur);
    if constexpr (SP2) {
        PG8_STAGE(PG8_SB(0, 0), cB, voffB); PG8_STAGE(PG8_SB(0, 1), cB + hstep, voffB); PG8_STAGE(PG8_SA(0, 0), cA, voffA); PG8_STAGE(PG8_SA(0, 1), cA + hstep, voffA);
        if (wr == 1) PG8_BAR;
        PG8_WAIT_V(2); PG8_BAR;
        PG8_STAGE(PG8_SB(1, 0), cB + kstep, voffB); PG8_STAGE(PG8_SA(1, 0), cA + kstep, voffA); PG8_STAGE(PG8_SB(1, 1), cB + hstep + kstep, voffB);
        PG8_WAIT_V(6); PG8_BAR;
    } else {
        PG8_STAGE(PG8_SB(0, 0), cB, voffB); PG8_STAGE(PG8_SA(0, 0), cA, voffA); PG8_STAGE(PG8_SB(0, 1), cB + hstep, voffB); PG8_STAGE(PG8_SA(0, 1), cA + hstep, voffA);
        if (wr == 1) PG8_BAR;
        PG8_WAIT_V(4); PG8_BAR;
        PG8_STAGE(PG8_SB(1, 0), cB + kstep, voffB); PG8_STAGE(PG8_SA(1, 0), cA + kstep, voffA); PG8_STAGE(PG8_SB(1, 1), cB + hstep + kstep, voffB);
        PG8_WAIT_V(6); PG8_BAR;
    }
    for (;;) {
        const bool has_next = S.next(ui + 1, nxt);
        const char* nA = has_next ? (const char*)g.A + (size_t)nxt.pm * tstep : cA; const char* nB = has_next ? (const char*)g.Bt + (size_t)nxt.pn * tstep : cB;
        for (int t = 0; t < nt; t += 2) {
            const bool last = (t == nt - 2);
            const char* a1 = cA + (size_t)(t + 1) * kstep;
            const char* a2 = last ? nA : cA + (size_t)(t + 2) * kstep; const char* b2 = last ? nB : cB + (size_t)(t + 2) * kstep;
            const char* a3 = a2 + kstep; const char* b3 = b2 + kstep;
            if (last && has_next) S.a_ready(nxt);
            if constexpr (SP2) {
            PG8_LDB(B0, 0, 0); PG8_LDB(B1, 0, 1); PG8_SCHED; PG8_LDA(At, 0, 0); PG8_STAGE(PG8_SA(1, 1), a1 + hstep, voffA);
            PG8_WAIT_V(8); PG8_WAIT_L(0); PG8_BAR; PG8_MMA(0, 0, At, B0); PG8_MMA(0, 1, At, B1); PG8_BAR; PG8_SCHED;
            PG8_LDA(At, 0, 1); PG8_STAGE(PG8_SB(0, 0), b2, voffB); PG8_STAGE(PG8_SB(0, 1), b2 + hstep, voffB); PG8_STAGE(PG8_SA(0, 0), a2, voffA);
            PG8_WAIT_V(8); PG8_WAIT_L(0); PG8_BAR; PG8_MMA(1, 0, At, B0); PG8_MMA(1, 1, At, B1); PG8_BAR; PG8_SCHED;
            PG8_LDB(B0, 1, 0); PG8_LDB(B1, 1, 1); PG8_SCHED; PG8_LDA(At, 1, 0); PG8_STAGE(PG8_SA(0, 1), a2 + hstep, voffA);
            PG8_WAIT_V(8); PG8_WAIT_L(0); PG8_BAR; PG8_MMA(0, 0, At, B0); PG8_MMA(0, 1, At, B1); PG8_BAR; PG8_SCHED;
            PG8_LDA(At, 1, 1); PG8_STAGE(PG8_SB(1, 0), b3, voffB); PG8_STAGE(PG8_SB(1, 1), b3 + hstep, voffB); PG8_STAGE(PG8_SA(1, 0), a3, voffA);
            PG8_WAIT_V(8); PG8_WAIT_L(0); PG8_BAR; PG8_MMA(1, 0, At, B0); PG8_MMA(1, 1, At, B1); PG8_BAR; PG8_SCHED;
            } else {
            PG8_LDB(B0, 0, 0); PG8_SCHED; PG8_LDA(At, 0, 0); PG8_STAGE(PG8_SA(1, 1), a1 + hstep, voffA);
            PG8_WAIT_L(8); PG8_BAR; PG8_WAIT_L(0); PG8_MMA(0, 0, At, B0); PG8_BAR; PG8_SCHED;
            PG8_LDB(B1, 0, 1); PG8_STAGE(PG8_SB(0, 0), b2, voffB);
            PG8_BAR; PG8_WAIT_L(0); PG8_MMA(0, 1, At, B1); PG8_BAR;
            PG8_LDA(At, 0, 1); PG8_STAGE(PG8_SA(0, 0), a2, voffA);
            PG8_BAR; PG8_WAIT_L(0); PG8_MMA(1, 0, At, B0); PG8_BAR; PG8_SCHED;
            PG8_STAGE(PG8_SB(0, 1), b2 + hstep, voffB);
            PG8_WAIT_V(6); PG8_BAR; PG8_MMA(1, 1, At, B1); PG8_BAR;
            PG8_LDB(B0, 1, 0); PG8_SCHED; PG8_LDA(At, 1, 0); PG8_STAGE(PG8_SA(0, 1), a2 + hstep, voffA);
            PG8_WAIT_L(8); PG8_BAR; PG8_WAIT_L(0); PG8_MMA(0, 0, At, B0); PG8_BAR; PG8_SCHED;
            PG8_LDB(B1, 1, 1); PG8_STAGE(PG8_SB(1, 0), b3, voffB);
            PG8_BAR; PG8_WAIT_L(0); PG8_MMA(0, 1, At, B1); PG8_BAR;
            PG8_LDA(At, 1, 1); PG8_STAGE(PG8_SA(1, 0), a3, voffA);
            PG8_BAR; PG8_WAIT_L(0); PG8_MMA(1, 0, At, B0); PG8_BAR; PG8_SCHED;
            PG8_STAGE(PG8_SB(1, 1), b3 + hstep, voffB);
            PG8_WAIT_V(6); PG8_BAR; PG8_MMA(1, 1, At, B1); PG8_BAR;
            }
        }
        if constexpr (ALIGN_EPI) { if (wr == 0) PG8_BAR; }
        if constexpr (!Epi::AFTER_DRAIN) { E(acc, cur, wr, wc, fr, fq); S.done(cur); }
        if (!has_next) break;
#pragma unroll
        for (int a = 0; a < 2; ++a)
#pragma unroll
            for (int b = 0; b < 2; ++b)
#pragma unroll
                for (int m = 0; m < 4; ++m)
#pragma unroll
                    for (int n = 0; n < 2; ++n) acc[a][b][m][n] = (f32x4){0.f, 0.f, 0.f, 0.f};
        cur = nxt; cA = nA; cB = nB; ++ui;
        if constexpr (ALIGN_EPI) { if (wr == 1) PG8_BAR; }
    }
    PG8_WAIT_V(0);
    if constexpr (!ALIGN_EPI) { if (wr == 0) PG8_BAR; }
    PG8_BAR;
    if constexpr (Epi::AFTER_DRAIN) { E.fused(acc, cur, wr, wc, fr, fq, lds, wid, lane); S.done(cur); }
#undef PG8_SA
#undef PG8_SB
#undef PG8_STAGE
#undef PG8_LDA
#undef PG8_LDB
#undef PG8_MMA
#undef PG8_WAIT_V
#undef PG8_WAIT_L
#undef PG8_BAR
#undef PG8_SCHED
}

struct Unit2 { int pm, pn, part; };
struct Gemm2 { const bf16_t* A0; const bf16_t* A1; const bf16_t* B0; const bf16_t* B1; int lda, K; };
struct StaticOrder2 {
    int nM, nN, nwg, G, c;
    __host__ __device__ void init(int M, int N, int G_, int c_) { nM = M / BM; nN = N / BM; nwg = nM * nN; G = G_; c = c_; }
    __host__ __device__ bool next(int i, Unit2& u) const {
        const long L = (long)(i >> 1) * G + c; if (L >= nwg) return false;
        int wgid = (int)L; { const int q = nwg / NXCD, r = nwg % NXCD, xcd = wgid % NXCD, off = wgid / NXCD; wgid = (xcd < r ? xcd * (q + 1) : r * (q + 1) + (xcd - r) * q) + off; }
        const int nig = WGM * nN, gid = wgid / nig, fm = gid * WGM, gsz = (nM - fm) < WGM ? (nM - fm) : WGM;
        u.pm = fm + ((wgid % nig) % gsz); u.pn = (wgid % nig) / gsz; u.part = i & 1; return true;
    }
    __device__ __forceinline__ void a_ready(const Unit2&) const {}
    __device__ __forceinline__ void done(const Unit2&) const {}
};
template <class Epi, class Sched, bool ALIGN_EPI = false, bool SP2 = false>
__device__ __forceinline__ void gemm_phase2(PG8_LAS unsigned char* lds, const Gemm2 g, const Sched& S, const Epi& E, const int tid) {
    const int wid = __builtin_amdgcn_readfirstlane(tid >> 6), lane = tid & 63, wr = wid >> 2, wc = wid & 3, fr = lane & 15, fq = lane >> 4;
    const int K = g.K, nt = K / BK;
    unsigned voffA[2], voffB[2];
#pragma unroll
    for (int i = 0; i < 2; ++i) { int R, C; stage_rc(tid * 16 + i * 8192, R, C); const int Rb = Epi::PERM ? ((R & ~31) + perm32(R & 31)) : R;
        voffA[i] = (unsigned)(R * g.lda + C) * 2u; voffB[i] = (unsigned)(Rb * K + C) * 2u; }
    const size_t kstep = (size_t)(BK * 2);
    const size_t hstep = (size_t)HALF * K * 2;
    const size_t tstep = 2 * hstep;
    const size_t hstepA = (size_t)HALF * g.lda * 2, tstepA = 2 * hstepA;
    const unsigned ldsw = (unsigned)wid * 1024u;
    const int aoff = lds_byte(wr * 64 + fr, fq * 8), boff = lds_byte(wc * 32 + fr, fq * 8);
#define PG8_SA(b, h) (((b) * 2 + (h)) * HTB)
#define PG8_SB(b, h) ((4 + (b) * 2 + (h)) * HTB)
#define PG8_STAGE(bufoff, gbase, voff) do { _Pragma("unroll") for (int _i = 0; _i < 2; ++_i) \
        __builtin_amdgcn_global_load_lds((const unsigned*)((const char*)(gbase) + (voff)[_i]), (PG8_LAS unsigned*)(lds + (bufoff) + ldsw + _i * 8192), 16, 0, 0); } while (0)
#define PG8_LDA(dst, b, h) do { _Pragma("unroll") for (int m = 0; m < 4; ++m) _Pragma("unroll") for (int k = 0; k < 2; ++k) dst[m][k] = *(const PG8_LAS bf16x8*)(lds + PG8_SA(b, h) + aoff + m * 2048 + k * 1024); } while (0)
#define PG8_LDB(dst, b, h) do { _Pragma("unroll") for (int n = 0; n < 2; ++n) _Pragma("unroll") for (int k = 0; k < 2; ++k) dst[n][k] = *(const PG8_LAS bf16x8*)(lds + PG8_SB(b, h) + boff + n * 2048 + k * 1024); } while (0)
#define PG8_MMA(ai, bj, At, Bt) do { __builtin_amdgcn_s_setprio(1); _Pragma("unroll") for (int m = 0; m < 4; ++m) _Pragma("unroll") for (int n = 0; n < 2; ++n) _Pragma("unroll") for (int k = 0; k < 2; ++k) \
        acc[ai][bj][m][n] = __builtin_amdgcn_mfma_f32_16x16x32_bf16(Bt[n][k], At[m][k], acc[ai][bj][m][n], 0, 0, 0); __builtin_amdgcn_s_setprio(0); } while (0)
#define PG8_WAIT_V(n) asm volatile("s_waitcnt vmcnt(" #n ")" ::: "memory")
#define PG8_WAIT_L(n) asm volatile("s_waitcnt lgkmcnt(" #n ")" ::: "memory")
#define PG8_BAR __builtin_amdgcn_s_barrier()
#define PG8_SCHED __builtin_amdgcn_sched_barrier(0)
    Unit2 cur, nxt; int ui = 0;
    if (!S.next(0, cur)) return;
    f32x4 acc[2][2][4][2];
#pragma unroll
    for (int a = 0; a < 2; ++a)
#pragma unroll
        for (int b = 0; b < 2; ++b)
#pragma unroll
            for (int m = 0; m < 4; ++m)
#pragma unroll
                for (int n = 0; n < 2; ++n) acc[a][b][m][n] = (f32x4){0.f, 0.f, 0.f, 0.f};
    bf16x8 At[4][2], B0[2][2], B1[2][2];
    const char* cA = (const char*)(cur.part ? g.A1 : g.A0) + (size_t)cur.pm * tstepA; const char* cB = (const char*)(cur.part ? g.B1 : g.B0) + (size_t)cur.pn * tstep;
    S.a_ready(cur);
    if constexpr (SP2) {
        PG8_STAGE(PG8_SB(0, 0), cB, voffB); PG8_STAGE(PG8_SB(0, 1), cB + hstep, voffB); PG8_STAGE(PG8_SA(0, 0), cA, voffA); PG8_STAGE(PG8_SA(0, 1), cA + hstepA, voffA);
        if (wr == 1) PG8_BAR;
        PG8_WAIT_V(2); PG8_BAR;
        PG8_STAGE(PG8_SB(1, 0), cB + kstep, voffB); PG8_STAGE(PG8_SA(1, 0), cA + kstep, voffA); PG8_STAGE(PG8_SB(1, 1), cB + hstep + kstep, voffB);
        PG8_WAIT_V(6); PG8_BAR;
    } else {
        PG8_STAGE(PG8_SB(0, 0), cB, voffB); PG8_STAGE(PG8_SA(0, 0), cA, voffA); PG8_STAGE(PG8_SB(0, 1), cB + hstep, voffB); PG8_STAGE(PG8_SA(0, 1), cA + hstepA, voffA);
        if (wr == 1) PG8_BAR;
        PG8_WAIT_V(4); PG8_BAR;
        PG8_STAGE(PG8_SB(1, 0), cB + kstep, voffB); PG8_STAGE(PG8_SA(1, 0), cA + kstep, voffA); PG8_STAGE(PG8_SB(1, 1), cB + hstep + kstep, voffB);
        PG8_WAIT_V(6); PG8_BAR;
    }
    for (;;) {
        const bool has_next = S.next(ui + 1, nxt);
        const char* nA = has_next ? (const char*)(nxt.part ? g.A1 : g.A0) + (size_t)nxt.pm * tstepA : cA; const char* nB = has_next ? (const char*)(nxt.part ? g.B1 : g.B0) + (size_t)nxt.pn * tstep : cB;
        for (int t = 0; t < nt; t += 2) {
            const bool last = (t == nt - 2);
            const char* a1 = cA + (size_t)(t + 1) * kstep;
            const char* a2 = last ? nA : cA + (size_t)(t + 2) * kstep; const char* b2 = last ? nB : cB + (size_t)(t + 2) * kstep;
            const char* a3 = a2 + kstep; const char* b3 = b2 + kstep;
            if (last && has_next) S.a_ready(nxt);
            if constexpr (SP2) {
            PG8_LDB(B0, 0, 0); PG8_LDB(B1, 0, 1); PG8_SCHED; PG8_LDA(At, 0, 0); PG8_STAGE(PG8_SA(1, 1), a1 + hstepA, voffA);
            PG8_WAIT_V(8); PG8_WAIT_L(0); PG8_BAR; PG8_MMA(0, 0, At, B0); PG8_MMA(0, 1, At, B1); PG8_BAR; PG8_SCHED;
            PG8_LDA(At, 0, 1); PG8_STAGE(PG8_SB(0, 0), b2, voffB); PG8_STAGE(PG8_SB(0, 1), b2 + hstep, voffB); PG8_STAGE(PG8_SA(0, 0), a2, voffA);
            PG8_WAIT_V(8); PG8_WAIT_L(0); PG8_BAR; PG8_MMA(1, 0, At, B0); PG8_MMA(1, 1, At, B1); PG8_BAR; PG8_SCHED;
            PG8_LDB(B0, 1, 0); PG8_LDB(B1, 1, 1); PG8_SCHED; PG8_LDA(At, 1, 0); PG8_STAGE(PG8_SA(0, 1), a2 + hstepA, voffA);
            PG8_WAIT_V(8); PG8_WAIT_L(0); PG8_BAR; PG8_MMA(0, 0, At, B0); PG8_MMA(0, 1, At, B1); PG8_BAR; PG8_SCHED;
            PG8_LDA(At, 1, 1); PG8_STAGE(PG8_SB(1, 0), b3, voffB); PG8_STAGE(PG8_SB(1, 1), b3 + hstep, voffB); PG8_STAGE(PG8_SA(1, 0), a3, voffA);
            PG8_WAIT_V(8); PG8_WAIT_L(0); PG8_BAR; PG8_MMA(1, 0, At, B0); PG8_MMA(1, 1, At, B1); PG8_BAR; PG8_SCHED;
            } else {
            PG8_LDB(B0, 0, 0); PG8_SCHED; PG8_LDA(At, 0, 0); PG8_STAGE(PG8_SA(1, 1), a1 + hstepA, voffA);
            PG8_WAIT_L(8); PG8_BAR; PG8_WAIT_L(0); PG8_MMA(0, 0, At, B0); PG8_BAR; PG8_SCHED;
            PG8_LDB(B1, 0, 1); PG8_STAGE(PG8_SB(0, 0), b2, voffB);
            PG8_BAR; PG8_WAIT_L(0); PG8_MMA(0, 1, At, B1); PG8_BAR;
            PG8_LDA(At, 0, 1); PG8_STAGE(PG8_SA(0, 0), a2, voffA);
            PG8_BAR; PG8_WAIT_L(0); PG8_MMA(1, 0, At, B0); PG8_BAR; PG8_SCHED;
            PG8_STAGE(PG8_SB(0, 1), b2 + hstep, voffB);
            PG8_WAIT_V(6); PG8_BAR; PG8_MMA(1, 1, At, B1); PG8_BAR;
            PG8_LDB(B0, 1, 0); PG8_SCHED; PG8_LDA(At, 1, 0); PG8_STAGE(PG8_SA(0, 1), a2 + hstepA, voffA);
            PG8_WAIT_L(8); PG8_BAR; PG8_WAIT_L(0); PG8_MMA(0, 0, At, B0); PG8_BAR; PG8_SCHED;
            PG8_LDB(B1, 1, 1); PG8_STAGE(PG8_SB(1, 0), b3, voffB);
            PG8_BAR; PG8_WAIT_L(0); PG8_MMA(0, 1, At, B1); PG8_BAR;
            PG8_LDA(At, 1, 1); PG8_STAGE(PG8_SA(1, 0), a3, voffA);
            PG8_BAR; PG8_WAIT_L(0); PG8_MMA(1, 0, At, B0); PG8_BAR; PG8_SCHED;
            PG8_STAGE(PG8_SB(1, 1), b3 + hstep, voffB);
            PG8_WAIT_V(6); PG8_BAR; PG8_MMA(1, 1, At, B1); PG8_BAR;
            }
        }
        if constexpr (ALIGN_EPI) { if (wr == 0) PG8_BAR; }
        if (cur.part == 0) E.mid(acc, cur, wr, wc, fr, fq); else E(acc, cur, wr, wc, fr, fq);
        if (!has_next) break;
        if (cur.part == 1) {
#pragma unroll
        for (int a = 0; a < 2; ++a)
#pragma unroll
            for (int b = 0; b < 2; ++b)
#pragma unroll
                for (int m = 0; m < 4; ++m)
#pragma unroll
                    for (int n = 0; n < 2; ++n) acc[a][b][m][n] = (f32x4){0.f, 0.f, 0.f, 0.f};
        }
        cur = nxt; cA = nA; cB = nB; ++ui;
        if constexpr (ALIGN_EPI) { if (wr == 1) PG8_BAR; }
    }
    PG8_WAIT_V(0);
    if constexpr (!ALIGN_EPI) { if (wr == 0) PG8_BAR; }
    PG8_BAR;
#undef PG8_SA
#undef PG8_SB
#undef PG8_STAGE
#undef PG8_LDA
#undef PG8_LDB
#undef PG8_MMA
#undef PG8_WAIT_V
#undef PG8_WAIT_L
#undef PG8_BAR
#undef PG8_SCHED
}
}

struct EpiInProj {
  static constexpr bool PERM = true, AFTER_DRAIN = false;
  u16* h;
  DI void operator()(const f32x4 (&acc)[2][2][4][2], const pg8::Unit& u, int wr, int wc, int fr, int fq) const {
    const int shift = (u.pn >= 8) ? 8 : 0;
#pragma unroll
    for (int ai = 0; ai < 2; ++ai)
#pragma unroll
      for (int m = 0; m < 4; ++m) {
        const int row = u.pm * 256 + ai * 128 + wr * 64 + m * 16 + fr;
#pragma unroll
        for (int bj = 0; bj < 2; ++bj) {
          const int col = u.pn * 256 + bj * 128 + wc * 32 + 8 * fq + shift;
          const f32x4 a = acc[ai][bj][m][0], b = acc[ai][bj][m][1];
          u32x4 w; w.x = pk_bf16(a[0], a[1]); w.y = pk_bf16(a[2], a[3]); w.z = pk_bf16(b[0], b[1]); w.w = pk_bf16(b[2], b[3]);
          *(u32x4*)(h + (size_t)row * NC + col) = w;
        }
      }
  }
};

struct EpiMerge {
  static constexpr bool PERM = true, AFTER_DRAIN = false;
  const u16* h; u16* mg;
  DI void mid(f32x4 (&acc)[2][2][4][2], const pg8::Unit2& u, int wr, int wc, int fr, int fq) const {
#pragma unroll
    for (int ai = 0; ai < 2; ++ai)
#pragma unroll
      for (int m = 0; m < 4; ++m) {
        const int row = u.pm * 256 + ai * 128 + wr * 64 + m * 16 + fr;
#pragma unroll
        for (int bj = 0; bj < 2; ++bj) {
          const int col = u.pn * 256 + bj * 128 + wc * 32 + 8 * fq;
          const u32x4 ga = *(const u32x4*)(h + (size_t)row * NC + C_GA + col), gb = *(const u32x4*)(h + (size_t)row * NC + C_GB + col);
#pragma unroll
          for (int j = 0; j < 4; ++j) {
            const float r0 = (1.f + __expf(-bf_lo(gb[j]))) * rcp_f(1.f + __expf(-bf_lo(ga[j])));
            const float r1 = (1.f + __expf(-bf_hi(gb[j]))) * rcp_f(1.f + __expf(-bf_hi(ga[j])));
            acc[ai][bj][m][j >> 1][2 * (j & 1)] *= r0; acc[ai][bj][m][j >> 1][2 * (j & 1) + 1] *= r1;
          }
        }
        __builtin_amdgcn_sched_barrier(0);
      }
  }
  DI void operator()(const f32x4 (&acc)[2][2][4][2], const pg8::Unit2& u, int wr, int wc, int fr, int fq) const {
#pragma unroll
    for (int ai = 0; ai < 2; ++ai)
#pragma unroll
      for (int m = 0; m < 4; ++m) {
        const int row = u.pm * 256 + ai * 128 + wr * 64 + m * 16 + fr;
#pragma unroll
        for (int bj = 0; bj < 2; ++bj) {
          const int col = u.pn * 256 + bj * 128 + wc * 32 + 8 * fq;
          const u32x4 gb = *(const u32x4*)(h + (size_t)row * NC + C_GB + col);
          const f32x4 a = acc[ai][bj][m][0], b = acc[ai][bj][m][1];
          u32x4 w;
          w.x = pk_bf16(a[0] * sigmoid_f(bf_lo(gb[0])), a[1] * sigmoid_f(bf_hi(gb[0])));
          w.y = pk_bf16(a[2] * sigmoid_f(bf_lo(gb[1])), a[3] * sigmoid_f(bf_hi(gb[1])));
          w.z = pk_bf16(b[0] * sigmoid_f(bf_lo(gb[2])), b[1] * sigmoid_f(bf_hi(gb[2])));
          w.w = pk_bf16(b[2] * sigmoid_f(bf_lo(gb[3])), b[3] * sigmoid_f(bf_hi(gb[3])));
          *(u32x4*)(mg + (size_t)row * 1024 + col) = w;
        }
        __builtin_amdgcn_sched_barrier(0);
      }
  }
};

struct EpiOut {
  static constexpr bool PERM = true, AFTER_DRAIN = false;
  const float* x; _Float16* r16;
  DI void operator()(const f32x4 (&acc)[2][2][4][2], const pg8::Unit& u, int wr, int wc, int fr, int fq) const {
#pragma unroll
    for (int ai = 0; ai < 2; ++ai)
#pragma unroll
      for (int m = 0; m < 4; ++m) {
        const int row = u.pm * 256 + ai * 128 + wr * 64 + m * 16 + fr;
#pragma unroll
        for (int bj = 0; bj < 2; ++bj) {
          const int col = u.pn * 256 + bj * 128 + wc * 32 + 8 * fq;
          const f32x4 x0 = *(const f32x4*)(x + (size_t)row * 1024 + col), x1 = *(const f32x4*)(x + (size_t)row * 1024 + col + 4);
          const f32x4 v0 = x0 * 1.189207115002721f + acc[ai][bj][m][0], v1 = x1 * 1.189207115002721f + acc[ai][bj][m][1];
          const f16x4 h0 = __builtin_convertvector(v0, f16x4), h1 = __builtin_convertvector(v1, f16x4);
          u32x4 w; const u32x2 p0 = __builtin_bit_cast(u32x2, h0), p1 = __builtin_bit_cast(u32x2, h1);
          w.x = p0.x; w.y = p0.y; w.z = p1.x; w.w = p1.y;
          *(u32x4*)(r16 + (size_t)row * 1024 + col) = w;
        }
      }
  }
};

__global__ void __launch_bounds__(512, 2) fwd_megakernel(Params p) {
  cg::grid_group grid = cg::this_grid();
  __shared__ __attribute__((aligned(16))) unsigned char smem[SMEM_BYTES];
  const int w8 = __builtin_amdgcn_readfirstlane((int)(threadIdx.x >> 6));
  const int wvs = w8 & 3, half = w8 >> 2;
  unsigned char* hsm = smem + half * HALF_SMEM;
  const int vb = blockIdx.x + half * gridDim.x, nvb = 2 * gridDim.x;
  volatile LAS unsigned* st = (volatile LAS unsigned*)(smem + SMEM_BYTES - 16);
  { const int t0_ = opaque_tid(); if (t0_ < 4) st[t0_] = 0u; }
  __syncthreads();
  const XcdBarrier xb = xcd_barrier_post((unsigned*)(p.ws + OFF_BAR), st, w8);
  phase0(p, w8);
  if (p.ws == nullptr) grid.sync();
  xcd_barrier(xb);
  {
    pg8::Gemm g; g.A = (const pg8::bf16_t*)(p.ws + OFF_SC); g.Bt = (const pg8::bf16_t*)(p.ws + OFF_WINT); g.M = T_TOK; g.N = NCP; g.K = 1024;
    pg8::StaticOrder so; so.init(T_TOK, NCP, (int)gridDim.x, (int)blockIdx.x);
    EpiInProj e; e.h = (u16*)(p.ws + OFF_H);
    pg8::gemm_phase<EpiInProj, pg8::StaticOrder, true, true>((PG8_LAS unsigned char*)smem, g, so, e, opaque_tid_(w8));
  }
  xcd_barrier(xb);
  for (int it = vb; it < 2048; it += nvb) prep_item(p, wvs, it, hsm);
  xcd_barrier(xb);
  if (blockIdx.x < 128) {
    if (half == 0) { const int cb = (int)blockIdx.x; scan_chain(p, wvs, (cb & 7) + 8 * ((cb >> 3) >> 3), (cb >> 3) & 7, hsm); }
    else {
      const int cb = (int)blockIdx.x, pr = (cb & 7) + 8 * ((cb >> 3) >> 3), slp = (cb >> 3) & 7, bp = pr >> 2, hp = pr & 3;
      const int ft = opaque_tid();
      const unsigned char* pbase = p.ws + OFF_SC + (size_t)(slp * 72 + (ft < 72 ? ft : 0)) * 128;
      unsigned r0 = 0, r1 = 0, r2 = 0, r3 = 0, accp = 0;
      __syncthreads();
      for (int n = 0; n < 128; ++n) {
        accp ^= r3; r3 = r2; r2 = r1; r1 = r0;
        const int np = n + 6 < 128 ? n + 6 : 127;
        r0 = *(const unsigned*)(pbase + (size_t)((bp * 128 + np) * 4 + hp) * OPB);
        __syncthreads(); __syncthreads();
      }
      accp ^= r0 ^ r1 ^ r2 ^ r3;
      if (accp == 0x9e3779b9u && ft == 300) ((unsigned*)(p.ws + OFF_BAR))[XB_TMO + 1] = accp;
    }
  } else {
    const int nsw = 2 * ((int)gridDim.x - 128), vbl = ((int)blockIdx.x - 128) + half * ((int)gridDim.x - 128);
    for (int k = 0; k * nsw < 1024; ++k) { const int it = vbl + k * nsw; swa_item(p, wvs, it < 1024 ? it : 0, it < 1024, hsm); }
  }
  xcd_barrier(xb);
  phase_ya(p, w8);
  xcd_barrier(xb);
  {
    pg8::Gemm2 g; g.A0 = (const pg8::bf16_t*)(p.ws + OFF_H); g.A1 = g.A0 + C_SWQ; g.B0 = (const pg8::bf16_t*)(p.ws + OFF_WAT); g.B1 = (const pg8::bf16_t*)(p.ws + OFF_WBT);
    g.lda = NC; g.K = 512;
    pg8::StaticOrder2 so; so.init(T_TOK, 1024, (int)gridDim.x, (int)blockIdx.x);
    EpiMerge e; e.h = (const u16*)(p.ws + OFF_H); e.mg = (u16*)(p.ws + OFF_SC);
    pg8::gemm_phase2<EpiMerge, pg8::StaticOrder2, true, true>((PG8_LAS unsigned char*)smem, g, so, e, opaque_tid_(w8));
  }
  xcd_barrier(xb);
  {
    pg8::Gemm g; g.A = (const pg8::bf16_t*)(p.ws + OFF_SC); g.Bt = (const pg8::bf16_t*)(p.ws + OFF_WOT); g.M = T_TOK; g.N = 1024; g.K = 1024;
    pg8::StaticOrder so; so.init(T_TOK, 1024, (int)gridDim.x, (int)blockIdx.x);
    EpiOut e; e.x = p.x; e.r16 = (_Float16*)(p.ws + OFF_H);
    pg8::gemm_phase<EpiOut, pg8::StaticOrder, true, true>((PG8_LAS unsigned char*)smem, g, so, e, opaque_tid_(w8));
  }
  xcd_barrier(xb);
  phase6(p, w8, smem);
}

extern "C" void kernel_launch(void* const* d_in, const int* in_sizes, int n_in, void* d_out, int out_size,
                              void* d_ws, size_t ws_size, hipStream_t stream) {
  if (ws_size < WS_NEED) { fprintf(stderr, "workspace too small: %zu < %zu\n", ws_size, (size_t)WS_NEED); return; }
  Params p{};
  p.x = (const float*)d_in[0]; p.w_in = (const float*)d_in[1]; p.conv_w = (const float*)d_in[2]; p.a_log = (const float*)d_in[3];
  p.dt_bias = (const float*)d_in[4]; p.dn_norm_w = (const float*)d_in[5]; p.sinks = (const float*)d_in[6];
  p.w_branch = (const float*)d_in[7]; p.w_out = (const float*)d_in[8]; p.ln_g = (const float*)d_in[9]; p.ln_b = (const float*)d_in[10];
  p.out = (float*)d_out; p.ws = (unsigned char*)d_ws;
  for (int i = 0; i < 8; ++i) p.inv_freq[i] = (float)std::pow(500000.0, -(double)i / 8.0);
  static int grid_blocks = 0;
  if (!grid_blocks) {
    int dev = 0, cus = 0, per_cu = 0;
    (void)hipGetDevice(&dev);
    (void)hipDeviceGetAttribute(&cus, hipDeviceAttributeMultiprocessorCount, dev);
    (void)hipOccupancyMaxActiveBlocksPerMultiprocessor(&per_cu, fwd_megakernel, 512, 0);
    if (per_cu < 1) fprintf(stderr, "occupancy query reports %d workgroups per CU\n", per_cu);
    grid_blocks = cus > 256 ? 256 : cus;
    grid_blocks &= ~7;
  }
  (void)hipMemsetAsync(p.ws + OFF_BAR, 0, BAR_BYTES, stream);
  void* args[] = {&p};
  hipError_t e = hipLaunchCooperativeKernel((void*)fwd_megakernel, dim3(grid_blocks), dim3(512), args, 0, stream);
  if (e != hipSuccess) fprintf(stderr, "cooperative launch failed: %s (grid %d)\n", hipGetErrorString(e), grid_blocks);
}
```

```cpp
#include <hip/hip_runtime.h>
#include <hip/hip_cooperative_groups.h>
#include <cstdio>
#include <cmath>
namespace cg = cooperative_groups;

typedef unsigned short u16;
typedef short bf16x8 __attribute__((ext_vector_type(8)));
typedef float f32x4 __attribute__((ext_vector_type(4)));
typedef unsigned u32x4 __attribute__((ext_vector_type(4)));
typedef unsigned u32x2 __attribute__((ext_vector_type(2)));
typedef _Float16 f16x4 __attribute__((ext_vector_type(4)));
#define DI __device__ __forceinline__
DI int opaque_tid_(int wave_s) { int t; asm volatile("v_mbcnt_lo_u32_b32 %0, -1, 0\n\tv_mbcnt_hi_u32_b32 %0, -1, %0" : "=v"(t)); return t + (wave_s << 6); }
#define opaque_tid() opaque_tid_(wvs)

constexpr int T_TOK = 32768, SEQ = 8192, DM = 1024, NC = 5384, NCP = 5376;
constexpr int C_DNZ = 1536, C_SWQ = 2056, C_SWK = 2568, C_SWV = 2696, C_SWZ = 2824, C_GA = 3336, C_GB = 4360;
constexpr size_t OFF_BAR = 0;
constexpr size_t BAR_BYTES = 16384;
constexpr size_t OFF_WINT = BAR_BYTES;
constexpr size_t OFF_WAT = OFF_WINT + (size_t)NCP * 1024 * 2;
constexpr size_t OFF_WBT = OFF_WAT + 1024 * 512 * 2;
constexpr size_t OFF_WOT = OFF_WBT + 1024 * 512 * 2;
constexpr size_t OFF_ROPE = OFF_WOT + 1024 * 1024 * 2;
constexpr size_t OFF_HB = OFF_ROPE + 2 * 8192 * 8 * 4;
constexpr size_t OFF_DEC = OFF_HB + (size_t)T_TOK * 8 * 4;
constexpr size_t OFF_H = OFF_DEC + 2048 * 4;
constexpr size_t OFF_SC = OFF_H + (size_t)T_TOK * NC * 2;
constexpr size_t OPB = 73728;
constexpr size_t WS_NEED = OFF_SC + 2048 * OPB;
constexpr int HALF_SMEM = 73728;
constexpr int SMEM_BYTES = 2 * HALF_SMEM + 16;

struct Params {
  const float *x, *w_in, *conv_w, *a_log, *dt_bias, *dn_norm_w, *sinks, *w_branch, *w_out, *ln_g, *ln_b;
  float* out; unsigned char* ws;
  float inv_freq[8];
};

typedef __bf16 bf16x2_t __attribute__((ext_vector_type(2)));
typedef float f32x2_t __attribute__((ext_vector_type(2)));
DI unsigned pk_bf16(float lo, float hi) { f32x2_t f = {lo, hi}; bf16x2_t v = __builtin_convertvector(f, bf16x2_t); return __builtin_bit_cast(unsigned, v); }
DI float bf_lo(unsigned u) { return __uint_as_float(u << 16); }
DI float bf_hi(unsigned u) { return __uint_as_float(u & 0xffff0000u); }
DI float bf2f(u16 v) { return __uint_as_float(((unsigned)v) << 16); }
DI u16 f2bf(float f) { return (u16)(pk_bf16(f, f) & 0xffffu); }
DI float shx(float v, int m, int lane) { return __uint_as_float((unsigned)__builtin_amdgcn_ds_bpermute((lane ^ m) << 2, (int)__float_as_uint(v))); }
DI float rcp_f(float y) { return __builtin_amdgcn_rcpf(y); }
DI float silu_f(float y) { return y * rcp_f(1.0f + __expf(-y)); }
DI float sigmoid_f(float y) { return rcp_f(1.0f + __expf(-y)); }
DI f32x4 mfma16(bf16x8 a, bf16x8 b, f32x4 c) { return __builtin_amdgcn_mfma_f32_16x16x32_bf16(a, b, c, 0, 0, 0); }
DI bf16x8 as_bf8(u32x4 v) { return __builtin_bit_cast(bf16x8, v); }
DI bf16x8 pack8(f32x4 a, f32x4 b) { u32x4 w; w.x = pk_bf16(a[0], a[1]); w.y = pk_bf16(a[2], a[3]); w.z = pk_bf16(b[0], b[1]); w.w = pk_bf16(b[2], b[3]); return as_bf8(w); }

DI void phase0(const Params& p, int wvs) {
  const size_t gt = (size_t)blockIdx.x * 512 + opaque_tid(), gs = (size_t)gridDim.x * 512;
  {
    const int ltid = (int)(gt & 511), lane = ltid & 63, wv = ltid >> 6;
    float wr[16][8];
#pragma unroll
    for (int j = 0; j < 4; ++j)
#pragma unroll
      for (int c = 0; c < 4; ++c) {
        const float* wp = p.w_in + (size_t)(4 * (lane + 64 * j) + c) * NC + 2048;
        const f32x4 a = *(const f32x4*)wp, b = *(const f32x4*)(wp + 4);
#pragma unroll
        for (int q = 0; q < 4; ++q) { wr[4 * j + c][q] = a[q]; wr[4 * j + c][4 + q] = b[q]; }
      }
    u16* xb = (u16*)(p.ws + OFF_SC);
    float* hb = (float*)(p.ws + OFF_HB);
    const int rstep = gridDim.x * 8;
    for (int row0 = blockIdx.x * 8 + wv; row0 < T_TOK; row0 += 2 * rstep) {
      f32x4 xr[2][4];
#pragma unroll
      for (int u = 0; u < 2; ++u) {
        const int row = row0 + u * rstep;
#pragma unroll
        for (int j = 0; j < 4; ++j) xr[u][j] = (row < T_TOK) ? *(const f32x4*)(p.x + (size_t)row * DM + 4 * (lane + 64 * j)) : (f32x4){0.f, 0.f, 0.f, 0.f};
      }
#pragma unroll
      for (int u = 0; u < 2; ++u) {
        const int row = row0 + u * rstep;
        float v[8];
#pragma unroll
        for (int q = 0; q < 8; ++q) v[q] = 0.f;
#pragma unroll
        for (int j = 0; j < 4; ++j) {
          const f32x4 xv = xr[u][j];
          u32x2 w; w.x = pk_bf16(xv[0], xv[1]); w.y = pk_bf16(xv[2], xv[3]);
          if (row < T_TOK) *(u32x2*)(xb + (size_t)row * DM + 4 * (lane + 64 * j)) = w;
#pragma unroll
          for (int c = 0; c < 4; ++c)
#pragma unroll
            for (int q = 0; q < 8; ++q) v[q] += xv[c] * wr[4 * j + c][q];
        }
        const bool up = (lane & 32) != 0;
        float k4[4];
#pragma unroll
        for (int i = 0; i < 4; ++i) { const float snd = up ? v[i] : v[i + 4]; const float kp = up ? v[i + 4] : v[i]; k4[i] = kp + shx(snd, 32, lane); }
        const bool up2 = (lane & 16) != 0;
        float k2[2];
#pragma unroll
        for (int i = 0; i < 2; ++i) { const float snd = up2 ? k4[i] : k4[i + 2]; const float kp = up2 ? k4[i + 2] : k4[i]; k2[i] = kp + shx(snd, 16, lane); }
        const bool up3 = (lane & 8) != 0;
        float k1 = (up3 ? k2[1] : k2[0]) + shx(up3 ? k2[0] : k2[1], 8, lane);
        k1 += shx(k1, 4, lane); k1 += shx(k1, 2, lane); k1 += shx(k1, 1, lane);
        if ((lane & 7) == 0 && row < T_TOK) hb[(size_t)row * 8 + (lane >> 3)] = k1;
      }
    }
  }
  {
    u32x4* wt = (u32x4*)(p.ws + OFF_WINT);
    for (size_t i = gt; i < (size_t)NCP * 128; i += gs) {
      const int kc = (int)(i / NCP), n = (int)(i % NCP);
      float v[8];
#pragma unroll
      for (int j = 0; j < 8; ++j) v[j] = p.w_in[(size_t)(kc * 8 + j) * NC + n + (n >= 2048 ? 8 : 0)];
      u32x4 w; w.x = pk_bf16(v[0], v[1]); w.y = pk_bf16(v[2], v[3]); w.z = pk_bf16(v[4], v[5]); w.w = pk_bf16(v[6], v[7]);
      wt[(size_t)n * 128 + kc] = w;
    }
  }
  {
    for (size_t i = gt; i < (size_t)2 * 1024 * 64; i += gs) {
      const int br = (int)(i / (1024 * 64)), rem = (int)(i % (1024 * 64)), kc = rem / 1024, n = rem % 1024;
      const float* src = p.w_branch + (size_t)br * 512 * 1024;
      float v[8];
#pragma unroll
      for (int j = 0; j < 8; ++j) v[j] = src[(size_t)(kc * 8 + j) * 1024 + n];
      u32x4 w; w.x = pk_bf16(v[0], v[1]); w.y = pk_bf16(v[2], v[3]); w.z = pk_bf16(v[4], v[5]); w.w = pk_bf16(v[6], v[7]);
      ((u32x4*)(p.ws + (br ? OFF_WBT : OFF_WAT)))[(size_t)n * 64 + kc] = w;
    }
  }
  {
    for (size_t i = gt; i < (size_t)1024 * 128; i += gs) {
      const int kc = (int)(i / 1024), n = (int)(i % 1024);
      float v[8];
#pragma unroll
      for (int j = 0; j < 8; ++j) v[j] = p.w_out[(size_t)(kc * 8 + j) * 1024 + n];
      u32x4 w; w.x = pk_bf16(v[0], v[1]); w.y = pk_bf16(v[2], v[3]); w.z = pk_bf16(v[4], v[5]); w.w = pk_bf16(v[6], v[7]);
      ((u32x4*)(p.ws + OFF_WOT))[(size_t)n * 128 + kc] = w;
    }
  }
  {
    float* rc = (float*)(p.ws + OFF_ROPE); float* rs = rc + 8192 * 8;
    for (size_t i = gt; i < 8192 * 8; i += gs) {
      const int t = (int)(i >> 3), f = (int)(i & 7);
      const float ang = (float)t * p.inv_freq[f];
      const double a = (double)ang;
      const double k = __builtin_rint(a * 0.15915494309189535);
      const float r = (float)(a - k * 6.283185307179586);
      rc[i] = cosf(r); rs[i] = sinf(r);
    }
  }
}

DI int lds_off32(int row, int chunk) { return row * 64 + ((chunk ^ ((0 - (row >> 2)) & 3)) << 4); }
constexpr int GSTAGE = 24576;

DI void gemm_kloop(const Params& p, int wvs, const u16* __restrict__ A, int lda, const u16* __restrict__ Bt, int ldb, int nk, int m0, int n0,
                   f32x4 (&acc)[4][8], unsigned char* smem) {
  const int tid = opaque_tid(), lane = tid & 63, wv = tid >> 6, wm = wv >> 1, wn = wv & 1, r16 = lane & 15, g = lane >> 4;
  const int prow = lane >> 2, pc = (lane & 3) ^ ((0 - (prow >> 2)) & 3);
  const u16* ap = A + (size_t)(m0 + 16 * wv + prow) * lda + pc * 8;
  const u16* bp = Bt + (size_t)(n0 + 16 * wv + prow) * ldb + pc * 8;
  unsigned char* lA = smem + wv * 1024;
  unsigned char* lB = smem + 8192 + wv * 1024;
#define GEMM_ISSUE(kt_, buf_) do { \
    _Pragma("unroll") for (int i_ = 0; i_ < 2; ++i_) \
      __builtin_amdgcn_global_load_lds((const unsigned*)(ap + (size_t)(64 * i_) * lda + (kt_) * 32), (unsigned*)(lA + (buf_) * GSTAGE + i_ * 4096), 16, 0, 0); \
    _Pragma("unroll") for (int i_ = 0; i_ < 4; ++i_) \
      __builtin_amdgcn_global_load_lds((const unsigned*)(bp + (size_t)(64 * i_) * ldb + (kt_) * 32), (unsigned*)(lB + (buf_) * GSTAGE + i_ * 4096), 16, 0, 0); \
  } while (0)
  GEMM_ISSUE(0, 0);
  GEMM_ISSUE(1, 1);
  asm volatile("s_waitcnt vmcnt(6)" ::: "memory");
  __builtin_amdgcn_s_barrier();
  int cb = 0;
  for (int kt = 0; kt < nk; ++kt) {
    int ib = cb + 2; if (ib >= 3) ib -= 3;
    const bool more = (kt + 2 < nk);
    if (more) GEMM_ISSUE(kt + 2, ib);
    const unsigned char* cur = smem + cb * GSTAGE;
    bf16x8 af[4], bfr[8];
#pragma unroll
    for (int i = 0; i < 4; ++i) af[i] = *(const bf16x8*)(cur + lds_off32(wm * 64 + i * 16 + r16, g));
#pragma unroll
    for (int i = 0; i < 8; ++i) bfr[i] = *(const bf16x8*)(cur + 8192 + lds_off32(wn * 128 + i * 16 + r16, g));
#pragma unroll
    for (int mi = 0; mi < 4; ++mi)
#pragma unroll
      for (int ni = 0; ni < 8; ++ni) acc[mi][ni] = mfma16(bfr[ni], af[mi], acc[mi][ni]);
    if (more) asm volatile("s_waitcnt vmcnt(6)" ::: "memory"); else asm volatile("s_waitcnt vmcnt(0)" ::: "memory");
    asm volatile("s_waitcnt lgkmcnt(0)" ::: "memory");
    __builtin_amdgcn_s_barrier();
    cb = cb + 1; if (cb >= 3) cb = 0;
  }
#undef GEMM_ISSUE
}

DI bool tile_of(int li, int ntn, int xcd, int& mt, int& nt) {
  if (li >= 32 * ntn) return false;
  const int grp = li / (8 * ntn), rem = li % (8 * ntn);
  nt = rem >> 3; mt = 32 * xcd + grp * 8 + (rem & 7);
  return true;
}

DI void zero_acc(f32x4 (&acc)[4][8]) {
#pragma unroll
  for (int i = 0; i < 4; ++i)
#pragma unroll
    for (int j = 0; j < 8; ++j) acc[i][j] = (f32x4){0.f, 0.f, 0.f, 0.f};
}

DI void phase1(const Params& p, int wvs, unsigned char* smem) {
  const int xcd = blockIdx.x & 7, lb = blockIdx.x >> 3, nlb = gridDim.x >> 3;
  const u16* xb = (const u16*)(p.ws + OFF_SC);
  const u16* wint = (const u16*)(p.ws + OFF_WINT);
  u16* h = (u16*)(p.ws + OFF_H);
  float* hb = (float*)(p.ws + OFF_HB);
  const int tid0 = opaque_tid(); const int lane = tid0 & 63, wv = tid0 >> 6, wm = wv >> 1, wn = wv & 1, r16 = lane & 15, g = lane >> 4;
  for (int li = lb;; li += nlb) {
    int mt, nt; if (!tile_of(li, 21, xcd, mt, nt)) break;
    f32x4 acc[4][8]; zero_acc(acc);
    gemm_kloop(p, wvs, xb, 1024, wint, 1024, 32, mt * 128, nt * 256, acc, smem);
#pragma unroll
    for (int mi = 0; mi < 4; ++mi) {
      const int row = mt * 128 + wm * 64 + mi * 16 + r16;
#pragma unroll
      for (int ni = 0; ni < 8; ++ni) {
        const int col = nt * 256 + wn * 128 + ni * 16 + 4 * g;
        {
          u32x2 w; w.x = pk_bf16(acc[mi][ni][0], acc[mi][ni][1]); w.y = pk_bf16(acc[mi][ni][2], acc[mi][ni][3]);
          *(u32x2*)(h + (size_t)row * NC + col + (nt >= 8 ? 8 : 0)) = w;
        }
      }
    }
  }
}

template <int I> DI void solve_rows2(f32x2_t (&xv)[64], const float* Lm, int lane, float lcur) {
  if constexpr (I < 64) {
    float lnx = 0.f;
    if constexpr (I + 1 < 64) lnx = Lm[(I + 1) * 68 + lane];
    f32x2_t a0 = xv[I], a1 = {0.f, 0.f}, a2 = {0.f, 0.f}, a3 = {0.f, 0.f};
#pragma unroll
    for (int m = 0; m < I; ++m) {
      const float l = __builtin_bit_cast(float, __builtin_amdgcn_readlane(__builtin_bit_cast(int, lcur), m));
      const f32x2_t lv = {l, l};
      if ((m & 3) == 0) a0 -= lv * xv[m];
      else if ((m & 3) == 1) a1 -= lv * xv[m];
      else if ((m & 3) == 2) a2 -= lv * xv[m];
      else a3 -= lv * xv[m];
    }
    xv[I] = (a0 + a1) + (a2 + a3);
    solve_rows2<I + 1>(xv, Lm, lane, lnx);
  }
}

DI void prep_item(const Params& p, int wvs, int item, unsigned char* smem) {
  const int tid_ = opaque_tid();
  const int tid = tid_, lane = tid & 63, wv = tid >> 6, r16 = lane & 15, g = lane >> 4;
  const int hd = item & 3, n = (item >> 2) & 127, b = item >> 9;
  const int t0 = b * SEQ + n * 64;
  u16* Qs = (u16*)smem; u16* Ks = Qs + 64 * 136; u16* Vs = Ks + 64 * 136;
  float* Lm = (float*)(smem + 52224);
  float* sm_beta = (float*)(smem + 69632);
  float* sm_gc = sm_beta + 64; float* sm_rq = sm_gc + 64; float* sm_rk = sm_rq + 64;
  float* sm_fw = sm_rk + 64; float* sm_fq = sm_fw + 64; float* sm_fk = sm_fq + 64;
  const u16* h = (const u16*)(p.ws + OFF_H);
  const float* hb = (const float*)(p.ws + OFF_HB);
  unsigned char* op = p.ws + OFF_SC + (size_t)item * OPB;
  __syncthreads();
  float hb_bl, hb_al;
  {
    const int c2 = tid & 63, rbase = (tid >> 6) * 16;
    unsigned raw[3][19];
#pragma unroll
    for (int mat = 0; mat < 3; ++mat) {
      const int col = mat * 512 + hd * 128 + 2 * c2;
#pragma unroll
      for (int j = 0; j < 19; ++j) {
        const int rr = t0 + rbase - 3 + j;
        raw[mat][j] = *(const unsigned*)(h + (size_t)(rr < 0 ? 0 : rr) * NC + col);
      }
    }
    float2 cw[3][4];
#pragma unroll
    for (int mat = 0; mat < 3; ++mat)
#pragma unroll
      for (int j = 0; j < 4; ++j) cw[mat][j] = *(const float2*)(p.conv_w + j * 1536 + mat * 512 + hd * 128 + 2 * c2);
    hb_bl = hb[(size_t)(t0 + lane) * 8 + hd]; hb_al = hb[(size_t)(t0 + lane) * 8 + 4 + hd];
    __builtin_amdgcn_sched_barrier(0);
#pragma unroll
    for (int mat = 0; mat < 3; ++mat) {
      float wa[4], wb[4];
#pragma unroll
      for (int j = 0; j < 4; ++j) { wa[j] = cw[mat][j].x; wb[j] = cw[mat][j].y; }
      float xa[3], xb[3];
#pragma unroll
      for (int j = 0; j < 3; ++j) {
        const int pos = n * 64 + rbase - 3 + j;
        const unsigned v = (pos >= 0) ? raw[mat][j] : 0u;
        xa[j] = bf_lo(v); xb[j] = bf_hi(v);
      }
      u16* dst = (mat == 0 ? Qs : (mat == 1 ? Ks : Vs));
#pragma unroll
      for (int i = 0; i < 16; ++i) {
        const unsigned v = raw[mat][3 + i];
        const float a3 = bf_lo(v), b3 = bf_hi(v);
        const float ya = wa[0] * xa[0] + wa[1] * xa[1] + wa[2] * xa[2] + wa[3] * a3;
        const float yb = wb[0] * xb[0] + wb[1] * xb[1] + wb[2] * xb[2] + wb[3] * b3;
        xa[0] = xa[1]; xa[1] = xa[2]; xa[2] = a3; xb[0] = xb[1]; xb[1] = xb[2]; xb[2] = b3;
        *(unsigned*)(dst + (rbase + i) * 136 + 2 * c2) = pk_bf16(silu_f(ya), silu_f(yb));
      }
    }
  }
  __syncthreads();
  if (wv == 0) {
    const float bl = hb_bl, al = hb_al;
    const float xx = al + p.dt_bias[hd];
    const float ee = __expf(-fabsf(xx));
    const float sp = fmaxf(xx, 0.f) + ((ee < 1e-3f) ? ee * (1.f - 0.5f * ee) : __logf(1.f + ee));
    float gg = -__expf(p.a_log[hd]) * sp;
#pragma unroll
    for (int o = 1; o < 64; o <<= 1) { const float t = __uint_as_float((unsigned)__builtin_amdgcn_ds_bpermute(((lane - o) & 63) << 2, (int)__float_as_uint(gg))); if (lane >= o) gg += t; }
    sm_beta[lane] = rcp_f(1.0f + __expf(-bl)); sm_gc[lane] = gg;
  } else if (wv <= 2) {
    const int r = tid - 64;
    const u16* src = (r < 64) ? (Qs + r * 136) : (Ks + (r - 64) * 136);
    float ss = 0.f;
#pragma unroll
    for (int c = 0; c < 16; ++c) {
      const u32x4 v = *(const u32x4*)(src + c * 8);
#pragma unroll
      for (int j = 0; j < 4; ++j) { const float a = bf_lo(v[j]), bb = bf_hi(v[j]); ss += a * a + bb * bb; }
    }
    const float rs = rsqrtf(ss + 1e-6f);
    if (r < 64) sm_rq[r] = rs; else sm_rk[r - 64] = rs;
  }
  __syncthreads();
  if (tid < 64) {
    const float gc = sm_gc[tid], gl = sm_gc[63], eg = __expf(gc);
    sm_fw[tid] = sm_beta[tid] * eg * sm_rk[tid];
    sm_fq[tid] = sm_rq[tid] * 0.08838834764831845f * eg;
    sm_fk[tid] = sm_rk[tid] * __expf(gl - gc);
    if (tid == 0) ((float*)(p.ws + OFF_DEC))[item] = __expf(gl);
  }
  {
    bf16x8 kfi[4], qfi[4];
#pragma unroll
    for (int s = 0; s < 4; ++s) {
      kfi[s] = *(const bf16x8*)(Ks + (16 * wv + r16) * 136 + 32 * s + 8 * g);
      qfi[s] = *(const bf16x8*)(Qs + (16 * wv + r16) * 136 + 32 * s + 8 * g);
    }
    f32x4 at[4];
#pragma unroll
    for (int jt = 0; jt < 4; ++jt) {
      at[jt] = (f32x4){0.f, 0.f, 0.f, 0.f};
      if (jt <= wv) {
        f32x4 la = (f32x4){0.f, 0.f, 0.f, 0.f}, aa = (f32x4){0.f, 0.f, 0.f, 0.f};
#pragma unroll
        for (int s = 0; s < 4; ++s) {
          const bf16x8 kfj = *(const bf16x8*)(Ks + (16 * jt + r16) * 136 + 32 * s + 8 * g);
          la = mfma16(kfi[s], kfj, la);
          aa = mfma16(kfj, qfi[s], aa);
        }
#pragma unroll
        for (int r = 0; r < 4; ++r) {
          { const int i = 16 * wv + 4 * g + r, j = 16 * jt + r16;
            const float v = (i > j) ? sm_beta[i] * sm_rk[i] * sm_rk[j] * __expf(sm_gc[i] - sm_gc[j]) * la[r] : 0.f;
            Lm[i * 68 + j] = v; }
          { const int j = 16 * jt + 4 * g + r, i = 16 * wv + r16;
            at[jt][r] = (j <= i) ? sm_rq[i] * sm_rk[j] * 0.08838834764831845f * __expf(sm_gc[i] - sm_gc[j]) * aa[r] : 0.f; }
        }
      }
    }
#pragma unroll
    for (int s2 = 0; s2 < 2; ++s2)
      *(bf16x8*)(op + 32768 + (size_t)((wv * 2 + s2) * 64 + lane) * 16) = pack8(at[2 * s2], at[2 * s2 + 1]);
  }
  __syncthreads();
  f32x2_t xv[64];
  if (wv < 2) {
#pragma unroll
    for (int i = 0; i < 64; ++i) { xv[i].x = sm_beta[i] * bf2f(Vs[i * 136 + tid]); xv[i].y = sm_fw[i] * bf2f(Ks[i * 136 + tid]); }
    solve_rows2<1>(xv, Lm, lane, Lm[68 + lane]);
    const int sl = tid >> 4, dvl = tid & 15;
#pragma unroll
    for (int mt = 0; mt < 4; ++mt)
#pragma unroll
      for (int gg = 0; gg < 4; ++gg) {
        u32x2 w; w.x = pk_bf16(xv[16 * mt + 4 * gg].x, xv[16 * mt + 4 * gg + 1].x); w.y = pk_bf16(xv[16 * mt + 4 * gg + 2].x, xv[16 * mt + 4 * gg + 3].x);
        *(u32x2*)(op + 57344 + (size_t)((sl * 4 + mt) * 64 + gg * 16 + dvl) * 8) = w;
      }
  } else {
    const int t2 = tid - 128;
#pragma unroll 2
    for (int f = 0; f < 8; ++f) {
      const int e = t2 + 128 * f, frag = e >> 6, ln = e & 63, lr = ln & 15, lg = ln >> 4;
      {
        const int mt = frag >> 2, sx = frag & 3, row = 16 * mt + lr;
        const u32x2 ql = *(const u32x2*)(Qs + row * 136 + 32 * sx + 4 * lg), qh = *(const u32x2*)(Qs + row * 136 + 32 * sx + 16 + 4 * lg);
        const float fq = sm_fq[row];
        u32x4 w;
        w.x = pk_bf16(bf_lo(ql.x) * fq, bf_hi(ql.x) * fq); w.y = pk_bf16(bf_lo(ql.y) * fq, bf_hi(ql.y) * fq);
        w.z = pk_bf16(bf_lo(qh.x) * fq, bf_hi(qh.x) * fq); w.w = pk_bf16(bf_lo(qh.y) * fq, bf_hi(qh.y) * fq);
        *(u32x4*)(op + 16384 + (size_t)e * 16) = w;
      }
      {
        const int mt8 = frag >> 1, s2 = frag & 1, dk = 16 * mt8 + lr;
        float v[8];
#pragma unroll
        for (int j = 0; j < 8; ++j) {
          const int pos = 32 * s2 + 16 * (j >> 2) + 4 * lg + (j & 3);
          v[j] = bf2f(Ks[pos * 136 + dk]) * sm_fk[pos];
        }
        u32x4 w; w.x = pk_bf16(v[0], v[1]); w.y = pk_bf16(v[2], v[3]); w.z = pk_bf16(v[4], v[5]); w.w = pk_bf16(v[6], v[7]);
        *(u32x4*)(op + 40960 + (size_t)e * 16) = w;
      }
    }
  }
  __syncthreads();
  if (wv < 2) {
#pragma unroll
    for (int i = 0; i < 64; ++i) Vs[i * 136 + tid] = f2bf(-xv[i].y);
  }
  __syncthreads();
#pragma unroll
  for (int f = 0; f < 4; ++f) {
    const int e = tid + 256 * f, frag = e >> 6, ln = e & 63, lr = ln & 15, lg = ln >> 4;
    const int mt = frag >> 2, sx = frag & 3, row = 16 * mt + lr;
    const u32x2 lo = *(const u32x2*)(Vs + row * 136 + 32 * sx + 4 * lg), hi = *(const u32x2*)(Vs + row * 136 + 32 * sx + 16 + 4 * lg);
    *(u32x4*)(op + (size_t)e * 16) = (u32x4){lo.x, lo.y, hi.x, hi.y};
  }
}

struct ScanA { u32x4 wf[4]; u32x2 uf; float dec; };
struct ScanB { u32x4 qf[4], af[2], kf[4]; };

DI void scan_load_a(const Params& p, int wvs, ScanA& o, int b, int hd, int sl, int n, int q, int lane) {
  const int item = (b * 128 + n) * 4 + hd;
  const unsigned char* op = p.ws + OFF_SC + (size_t)item * OPB;
#pragma unroll
  for (int s = 0; s < 4; ++s) {
    o.wf[s] = *(const u32x4*)(op + (size_t)((q * 4 + s) * 64 + lane) * 16);
  }
  o.uf = *(const u32x2*)(op + 57344 + (size_t)((sl * 4 + q) * 64 + lane) * 8);
  o.dec = ((const float*)(p.ws + OFF_DEC))[item];
}
DI void scan_load_b(const Params& p, int wvs, ScanB& o, int b, int hd, int n, int q, int lane) {
  const int item = (b * 128 + n) * 4 + hd;
  const unsigned char* op = p.ws + OFF_SC + (size_t)item * OPB;
#pragma unroll
  for (int s = 0; s < 4; ++s) o.qf[s] = *(const u32x4*)(op + 16384 + (size_t)((q * 4 + s) * 64 + lane) * 16);
#pragma unroll
  for (int s2 = 0; s2 < 2; ++s2) o.af[s2] = *(const u32x4*)(op + 32768 + (size_t)((q * 2 + s2) * 64 + lane) * 16);
#pragma unroll
  for (int j = 0; j < 4; ++j) o.kf[j] = *(const u32x4*)(op + 40960 + (size_t)((q * 4 + j) * 64 + lane) * 16);
}

DI void scan_step(const Params& p, int wvs, const ScanA& o, const ScanB& ob, f32x4 (&S)[2], int b, int hd, int sl, int n, int q, int lane, unsigned char* smem) {
  const int r16 = lane & 15, g = lane >> 4;
  u32x4* ldsS = (u32x4*)smem;
  u32x2* ldsV = (u32x2*)(smem + 4096);
  ldsS[q * 64 + lane] = __builtin_bit_cast(u32x4, pack8(S[0], S[1]));
  __syncthreads();
  bf16x8 Sb[4];
#pragma unroll
  for (int s = 0; s < 4; ++s) Sb[s] = as_bf8(ldsS[s * 64 + lane]);
  f32x4 vn = (f32x4){bf_lo(o.uf.x), bf_hi(o.uf.x), bf_lo(o.uf.y), bf_hi(o.uf.y)};
#pragma unroll
  for (int s = 0; s < 4; ++s) vn = mfma16(as_bf8(o.wf[s]), Sb[s], vn);
  { u32x2 w; w.x = pk_bf16(vn[0], vn[1]); w.y = pk_bf16(vn[2], vn[3]); ldsV[((q >> 1) * 64 + lane) * 2 + (q & 1)] = w; }
  f32x4 oa = (f32x4){0.f, 0.f, 0.f, 0.f};
#pragma unroll
  for (int s = 0; s < 4; ++s) oa = mfma16(as_bf8(ob.qf[s]), Sb[s], oa);
  __syncthreads();
  bf16x8 Vb[2];
#pragma unroll
  for (int s2 = 0; s2 < 2; ++s2) Vb[s2] = as_bf8(*(const u32x4*)(ldsV + (s2 * 64 + lane) * 2));
#pragma unroll
  for (int s2 = 0; s2 < 2; ++s2) oa = mfma16(as_bf8(ob.af[s2]), Vb[s2], oa);
  u16* h = (u16*)(p.ws + OFF_H);
  const int t0 = b * SEQ + n * 64;
#pragma unroll
  for (int r = 0; r < 4; ++r) h[(size_t)(t0 + 16 * q + 4 * g + r) * NC + hd * 128 + 16 * sl + r16] = f2bf(oa[r]);
#pragma unroll
  for (int t = 0; t < 2; ++t) {
    S[t] = S[t] * o.dec;
#pragma unroll
    for (int s2 = 0; s2 < 2; ++s2) S[t] = mfma16(as_bf8(ob.kf[t * 2 + s2]), Vb[s2], S[t]);
  }
}

DI void scan_chain(const Params& p, int wvs, int pair, int sl, unsigned char* smem) {
  const int tid0 = opaque_tid(); const int lane = tid0 & 63, q = tid0 >> 6;
  const int b = pair >> 2, hd = pair & 3;
  f32x4 S[2]; S[0] = (f32x4){0.f, 0.f, 0.f, 0.f}; S[1] = S[0];
  ScanA a0, a1, a2; ScanB bc, bn;
  __syncthreads();
  scan_load_a(p, wvs, a0, b, hd, sl, 0, q, lane);
  scan_load_b(p, wvs, bc, b, hd, 0, q, lane);
  scan_load_a(p, wvs, a1, b, hd, sl, 1, q, lane);
#pragma unroll 1
  for (int n = 0; n < 129; n += 3) {
    if (n + 2 < 128) scan_load_a(p, wvs, a2, b, hd, sl, n + 2, q, lane);
    if (n + 1 < 128) scan_load_b(p, wvs, bn, b, hd, n + 1, q, lane);
    if (n < 128) scan_step(p, wvs, a0, bc, S, b, hd, sl, n, q, lane, smem);
    bc = bn;
    if (n + 3 < 128) scan_load_a(p, wvs, a0, b, hd, sl, n + 3, q, lane);
    if (n + 2 < 128) scan_load_b(p, wvs, bn, b, hd, n + 2, q, lane);
    if (n + 1 < 128) scan_step(p, wvs, a1, bc, S, b, hd, sl, n + 1, q, lane, smem);
    bc = bn;
    if (n + 4 < 128) scan_load_a(p, wvs, a1, b, hd, sl, n + 4, q, lane);
    if (n + 3 < 128) scan_load_b(p, wvs, bn, b, hd, n + 3, q, lane);
    if (n + 2 < 128) scan_step(p, wvs, a2, bc, S, b, hd, sl, n + 2, q, lane, smem);
    bc = bn;
  }
}

DI void swa_item(const Params& p, int wvs, int item, bool valid, unsigned char* smem) {
  if (!valid) { __syncthreads(); __syncthreads(); return; }
  const int tid_ = opaque_tid();
  const int tid = tid_, lane = tid & 63, wv = tid >> 6, r16 = lane & 15, g = lane >> 4;
  const int qt = item & 127, kvh = (item >> 7) & 1, b = item >> 8;
  const int kp0 = 64 * qt - 128;
  u16* Ksm = (u16*)smem;
  u16* Vt = (u16*)(smem + 27648);
  u16* h = (u16*)(p.ws + OFF_H);
  const float* rc = (const float*)(p.ws + OFF_ROPE); const float* rs = rc + 8192 * 8;
  __syncthreads();
  if (tid < 192) {
    const int kk = tid, pos = kp0 + kk;
    u32x4 lo = (u32x4){0, 0, 0, 0}, hi = lo;
    if (pos >= 0) {
      const u16* src = h + (size_t)(b * SEQ + pos) * NC + C_SWK + kvh * 64;
      const u32x4 a = *(const u32x4*)src, c = *(const u32x4*)(src + 8);
      const f32x4 c0 = *(const f32x4*)(rc + pos * 8), c1 = *(const f32x4*)(rc + pos * 8 + 4);
      const f32x4 s0 = *(const f32x4*)(rs + pos * 8), s1 = *(const f32x4*)(rs + pos * 8 + 4);
      float t1[8], t2[8], cs[8], sn[8], o1[8], o2[8];
#pragma unroll
      for (int j = 0; j < 4; ++j) { t1[2 * j] = bf_lo(a[j]); t1[2 * j + 1] = bf_hi(a[j]); t2[2 * j] = bf_lo(c[j]); t2[2 * j + 1] = bf_hi(c[j]);
        cs[j] = c0[j]; cs[4 + j] = c1[j]; sn[j] = s0[j]; sn[4 + j] = s1[j]; }
#pragma unroll
      for (int j = 0; j < 8; ++j) { o1[j] = t1[j] * cs[j] - t2[j] * sn[j]; o2[j] = t2[j] * cs[j] + t1[j] * sn[j]; }
#pragma unroll
      for (int j = 0; j < 4; ++j) { lo[j] = pk_bf16(o1[2 * j], o1[2 * j + 1]); hi[j] = pk_bf16(o2[2 * j], o2[2 * j + 1]); }
    }
    *(u32x4*)(Ksm + kk * 72) = lo; *(u32x4*)(Ksm + kk * 72 + 8) = hi;
  }
  for (int e = tid; e < 192 * 6; e += 256) {
    const int kk = e / 6, ch = 2 + e % 6, pos = kp0 + kk;
    u32x4 v = (u32x4){0, 0, 0, 0};
    if (pos >= 0) v = *(const u32x4*)(h + (size_t)(b * SEQ + pos) * NC + C_SWK + kvh * 64 + ch * 8);
    *(u32x4*)(Ksm + kk * 72 + ch * 8) = v;
  }
  for (int e = tid; e < 192 * 8; e += 256) {
    const int kk = e >> 3, ch = e & 7, pos = kp0 + kk;
    u32x4 v = (u32x4){0, 0, 0, 0};
    if (pos >= 0) v = *(const u32x4*)(h + (size_t)(b * SEQ + pos) * NC + C_SWV + kvh * 64 + ch * 8);
#pragma unroll
    for (int j = 0; j < 4; ++j) { Vt[(ch * 8 + 2 * j) * 200 + kk] = (u16)(v[j] & 0xffffu); Vt[(ch * 8 + 2 * j + 1) * 200 + kk] = (u16)(v[j] >> 16); }
  }
  __syncthreads();
  const int st = wv, jt0 = st < 2 ? st : 2;
  const int qi = 16 * st + r16;
  const int qpos = 64 * qt + qi, tq = b * SEQ + qpos;
#pragma unroll 1
  for (int hq = 0; hq < 4; ++hq) {
    const int head = kvh * 4 + hq;
    u16* qsrc = h + (size_t)tq * NC + C_SWQ + head * 64;
    bf16x8 qf[2];
    {
      const u32x4 a = *(const u32x4*)qsrc, c = *(const u32x4*)(qsrc + 8);
      u32x4 w = *(const u32x4*)(qsrc + 8 * g);
      if (g < 2) {
        const f32x4 c0 = *(const f32x4*)(rc + qpos * 8), c1 = *(const f32x4*)(rc + qpos * 8 + 4);
        const f32x4 s0 = *(const f32x4*)(rs + qpos * 8), s1 = *(const f32x4*)(rs + qpos * 8 + 4);
        float t1[8], t2[8], cs[8], sn[8], o[8];
#pragma unroll
        for (int j = 0; j < 4; ++j) { t1[2 * j] = bf_lo(a[j]); t1[2 * j + 1] = bf_hi(a[j]); t2[2 * j] = bf_lo(c[j]); t2[2 * j + 1] = bf_hi(c[j]);
          cs[j] = c0[j]; cs[4 + j] = c1[j]; sn[j] = s0[j]; sn[4 + j] = s1[j]; }
#pragma unroll
        for (int j = 0; j < 8; ++j) o[j] = (g == 0) ? (t1[j] * cs[j] - t2[j] * sn[j]) : (t2[j] * cs[j] + t1[j] * sn[j]);
#pragma unroll
        for (int j = 0; j < 4; ++j) w[j] = pk_bf16(o[2 * j], o[2 * j + 1]);
      }
      qf[0] = as_bf8(w);
      qf[1] = as_bf8(*(const u32x4*)(qsrc + 32 + 8 * g));
    }
    f32x4 sc[10];
#pragma unroll
    for (int t = 0; t < 10; ++t) {
      sc[t] = (f32x4){0.f, 0.f, 0.f, 0.f};
#pragma unroll
      for (int s = 0; s < 2; ++s) {
        const bf16x8 kf = *(const bf16x8*)(Ksm + (16 * (jt0 + t) + r16) * 72 + 32 * s + 8 * g);
        sc[t] = mfma16(kf, qf[s], sc[t]);
      }
    }
    const float sink = p.sinks[head];
    float mx = sink;
#pragma unroll
    for (int t = 0; t < 10; ++t)
#pragma unroll
      for (int r = 0; r < 4; ++r) {
        const int kk = 16 * (jt0 + t) + 4 * g + r, d = kk - qi;
        const bool ok = (d >= 1) && (d <= 128) && (kp0 + kk >= 0);
        const float v = ok ? sc[t][r] * 0.125f : -1e30f;
        sc[t][r] = v; mx = fmaxf(mx, v);
      }
    mx = fmaxf(mx, shx(mx, 16, lane)); mx = fmaxf(mx, shx(mx, 32, lane));
    float sum = 0.f;
#pragma unroll
    for (int t = 0; t < 10; ++t)
#pragma unroll
      for (int r = 0; r < 4; ++r) { const float e = __expf(sc[t][r] - mx); sc[t][r] = e; sum += e; }
    sum += shx(sum, 16, lane); sum += shx(sum, 32, lane);
    const float inv = rcp_f(sum + __expf(sink - mx));
    f32x4 oacc[4];
#pragma unroll
    for (int dt = 0; dt < 4; ++dt) oacc[dt] = (f32x4){0.f, 0.f, 0.f, 0.f};
#pragma unroll
    for (int s2 = 0; s2 < 5; ++s2) {
      const bf16x8 pb = pack8(sc[2 * s2], sc[2 * s2 + 1]);
#pragma unroll
      for (int dt = 0; dt < 4; ++dt) {
        const u16* vr = Vt + (16 * dt + r16) * 200 + 16 * (jt0 + 2 * s2) + 4 * g;
        const u32x2 lo = *(const u32x2*)vr, hi = *(const u32x2*)(vr + 16);
        oacc[dt] = mfma16(as_bf8((u32x4){lo.x, lo.y, hi.x, hi.y}), pb, oacc[dt]);
      }
    }
#pragma unroll
    for (int dt = 0; dt < 4; ++dt) {
      const int dcol = head * 64 + 16 * dt + 4 * g;
      const u32x2 z = *(const u32x2*)(h + (size_t)tq * NC + C_SWZ + dcol);
      u32x2 w;
      w.x = pk_bf16(oacc[dt][0] * inv * silu_f(bf_lo(z.x)), oacc[dt][1] * inv * silu_f(bf_hi(z.x)));
      w.y = pk_bf16(oacc[dt][2] * inv * silu_f(bf_lo(z.y)), oacc[dt][3] * inv * silu_f(bf_hi(z.y)));
      *(u32x2*)(h + (size_t)tq * NC + C_SWQ + dcol) = w;
    }
  }
}

DI void phase_ya(const Params& p, int wvs) {
  u16* h = (u16*)(p.ws + OFF_H);
  const int ltid = opaque_tid(), lane = ltid & 63;
  const size_t gt = (size_t)blockIdx.x * 512 + ltid, gs = (size_t)gridDim.x * 512;
  const float* nwp = p.dn_norm_w + (ltid & 15) * 8;
  const f32x4 nw0 = *(const f32x4*)nwp, nw1 = *(const f32x4*)(nwp + 4);
  for (size_t i0 = gt; i0 < (size_t)T_TOK * 64; i0 += 4 * gs) {
    u32x4 v[4], z[4];
#pragma unroll
    for (int k = 0; k < 4; ++k) {
      const size_t i = i0 + k * gs;
      if (i < (size_t)T_TOK * 64) {
        const u16* ptr = h + (size_t)(i >> 6) * NC + (i & 63) * 8;
        v[k] = *(const u32x4*)ptr; z[k] = *(const u32x4*)(ptr + C_DNZ);
      } else { v[k] = (u32x4){0, 0, 0, 0}; z[k] = v[k]; }
    }
#pragma unroll
    for (int k = 0; k < 4; ++k) {
      const size_t i = i0 + k * gs;
      float o[8]; float ss = 0.f;
#pragma unroll
      for (int j = 0; j < 4; ++j) { o[2 * j] = bf_lo(v[k][j]); o[2 * j + 1] = bf_hi(v[k][j]); }
#pragma unroll
      for (int j = 0; j < 8; ++j) ss += o[j] * o[j];
      ss += shx(ss, 1, lane); ss += shx(ss, 2, lane); ss += shx(ss, 4, lane); ss += shx(ss, 8, lane);
      const float rs = rsqrtf(ss * (1.0f / 128.0f) + 1e-6f);
      float y[8];
#pragma unroll
      for (int j = 0; j < 4; ++j) {
        const float w0 = (j < 2) ? nw0[2 * j] : nw1[2 * j - 4], w1 = (j < 2) ? nw0[2 * j + 1] : nw1[2 * j - 3];
        y[2 * j] = o[2 * j] * rs * w0 * silu_f(bf_lo(z[k][j]));
        y[2 * j + 1] = o[2 * j + 1] * rs * w1 * silu_f(bf_hi(z[k][j]));
      }
      u32x4 w; w.x = pk_bf16(y[0], y[1]); w.y = pk_bf16(y[2], y[3]); w.z = pk_bf16(y[4], y[5]); w.w = pk_bf16(y[6], y[7]);
      if (i < (size_t)T_TOK * 64) *(u32x4*)(h + (size_t)(i >> 6) * NC + (i & 63) * 8) = w;
    }
  }
}

DI void phase4(const Params& p, int wvs, int vb, int nvb, unsigned char* smem) {
  const int xcd = vb & 7, lb = vb >> 3, nlb = nvb >> 3;
  const u16* h = (const u16*)(p.ws + OFF_H);
  const u16* wat = (const u16*)(p.ws + OFF_WAT);
  const u16* wbt = (const u16*)(p.ws + OFF_WBT);
  u16* mg = (u16*)(p.ws + OFF_SC);
  const int tid0 = opaque_tid(); const int lane = tid0 & 63, wv = tid0 >> 6, wm = wv >> 1, wn = wv & 1, r16 = lane & 15, g = lane >> 4;
  for (int li = lb;; li += nlb) {
    int mt, nt; if (!tile_of(li, 4, xcd, mt, nt)) break;
    f32x4 acc[4][8]; zero_acc(acc);
    gemm_kloop(p, wvs, h, NC, wat, 512, 16, mt * 128, nt * 256, acc, smem);
#pragma unroll
    for (int mi = 0; mi < 4; ++mi) {
      const int row = mt * 128 + wm * 64 + mi * 16 + r16;
#pragma unroll
      for (int ni = 0; ni < 8; ++ni) {
        const int col = nt * 256 + wn * 128 + ni * 16 + 4 * g;
        const u32x2 ga = *(const u32x2*)(h + (size_t)row * NC + C_GA + col), gb = *(const u32x2*)(h + (size_t)row * NC + C_GB + col);
        acc[mi][ni][0] *= (1.f + __expf(-bf_lo(gb.x))) * rcp_f(1.f + __expf(-bf_lo(ga.x)));
        acc[mi][ni][1] *= (1.f + __expf(-bf_hi(gb.x))) * rcp_f(1.f + __expf(-bf_hi(ga.x)));
        acc[mi][ni][2] *= (1.f + __expf(-bf_lo(gb.y))) * rcp_f(1.f + __expf(-bf_lo(ga.y)));
        acc[mi][ni][3] *= (1.f + __expf(-bf_hi(gb.y))) * rcp_f(1.f + __expf(-bf_hi(ga.y)));
      }
      if (mi & 1) __builtin_amdgcn_sched_barrier(0);
    }
    gemm_kloop(p, wvs, h + C_SWQ, NC, wbt, 512, 16, mt * 128, nt * 256, acc, smem);
#pragma unroll
    for (int mi = 0; mi < 4; ++mi) {
      const int row = mt * 128 + wm * 64 + mi * 16 + r16;
#pragma unroll
      for (int ni = 0; ni < 8; ++ni) {
        const int col = nt * 256 + wn * 128 + ni * 16 + 4 * g;
        const u32x2 gb = *(const u32x2*)(h + (size_t)row * NC + C_GB + col);
        u32x2 w;
        w.x = pk_bf16(acc[mi][ni][0] * sigmoid_f(bf_lo(gb.x)), acc[mi][ni][1] * sigmoid_f(bf_hi(gb.x)));
        w.y = pk_bf16(acc[mi][ni][2] * sigmoid_f(bf_lo(gb.y)), acc[mi][ni][3] * sigmoid_f(bf_hi(gb.y)));
        *(u32x2*)(mg + (size_t)row * 1024 + col) = w;
      }
      if (mi & 1) __builtin_amdgcn_sched_barrier(0);
    }
  }
}

DI void phase5(const Params& p, int wvs, unsigned char* smem) {
  const int xcd = blockIdx.x & 7, lb = blockIdx.x >> 3, nlb = gridDim.x >> 3;
  const u16* mg = (const u16*)(p.ws + OFF_SC);
  const u16* wot = (const u16*)(p.ws + OFF_WOT);
  const int tid0 = opaque_tid(); const int lane = tid0 & 63, wv = tid0 >> 6, wm = wv >> 1, wn = wv & 1, r16 = lane & 15, g = lane >> 4;
  for (int li = lb;; li += nlb) {
    int mt, nt; if (!tile_of(li, 4, xcd, mt, nt)) break;
    f32x4 acc[4][8]; zero_acc(acc);
    gemm_kloop(p, wvs, mg, 1024, wot, 1024, 32, mt * 128, nt * 256, acc, smem);
#pragma unroll
    for (int mi = 0; mi < 4; ++mi) {
      const int row = mt * 128 + wm * 64 + mi * 16 + r16;
#pragma unroll
      for (int ni = 0; ni < 8; ++ni) {
        const int col = nt * 256 + wn * 128 + ni * 16 + 4 * g;
        const f32x4 xv = *(const f32x4*)(p.x + (size_t)row * 1024 + col);
        *(f32x4*)(p.out + (size_t)row * 1024 + col) = xv * 1.189207115002721f + acc[mi][ni];
      }
    }
  }
}

DI float wave_sum(float v, int lane) {
#pragma unroll
  for (int o = 32; o > 0; o >>= 1) v += shx(v, o, lane);
  return v;
}
DI void phase6(const Params& p, int wvs, unsigned char* smem) {
  const int tid = opaque_tid(), lane = tid & 63, wv = tid >> 6;
  f32x4 gm[4], bt[4];
#pragma unroll
  for (int j = 0; j < 4; ++j) { gm[j] = *(const f32x4*)(p.ln_g + 4 * (lane + 64 * j)); bt[j] = *(const f32x4*)(p.ln_b + 4 * (lane + 64 * j)); }
  const int xcd6 = blockIdx.x & 7, lb6 = blockIdx.x >> 3, nlb6 = gridDim.x >> 3;
  for (int lr = (lb6 * 8 + wv) * 2; lr < 4096; lr += nlb6 * 16) {
    const int row0 = 4096 * xcd6 + (4095 - lr), row1 = row0 - 1;
    float* r0 = p.out + (size_t)row0 * 1024;
    float* r1 = p.out + (size_t)row1 * 1024;
    const _Float16* s0 = (const _Float16*)(p.ws + OFF_H) + (size_t)row0 * 1024;
    const _Float16* s1 = (const _Float16*)(p.ws + OFF_H) + (size_t)row1 * 1024;
    f32x4 a[4], b[4];
#pragma unroll
    for (int j = 0; j < 4; ++j) {
      a[j] = __builtin_convertvector(*(const f16x4*)(s0 + 4 * (lane + 64 * j)), f32x4);
      b[j] = __builtin_convertvector(*(const f16x4*)(s1 + 4 * (lane + 64 * j)), f32x4);
    }
    float sa = 0.f, sb = 0.f;
#pragma unroll
    for (int j = 0; j < 4; ++j) { sa += (a[j][0] + a[j][1]) + (a[j][2] + a[j][3]); sb += (b[j][0] + b[j][1]) + (b[j][2] + b[j][3]); }
    const float ma = wave_sum(sa, lane) * (1.0f / 1024.0f), mb = wave_sum(sb, lane) * (1.0f / 1024.0f);
    float qa = 0.f, qb = 0.f;
#pragma unroll
    for (int j = 0; j < 4; ++j) {
      a[j] = a[j] - ma; b[j] = b[j] - mb;
      qa += (a[j][0] * a[j][0] + a[j][1] * a[j][1]) + (a[j][2] * a[j][2] + a[j][3] * a[j][3]);
      qb += (b[j][0] * b[j][0] + b[j][1] * b[j][1]) + (b[j][2] * b[j][2] + b[j][3] * b[j][3]);
    }
    const float ra = rsqrtf(wave_sum(qa, lane) * (1.0f / 1024.0f) + 1e-5f), rb = rsqrtf(wave_sum(qb, lane) * (1.0f / 1024.0f) + 1e-5f);
#pragma unroll
    for (int j = 0; j < 4; ++j) {
      *(f32x4*)(r0 + 4 * (lane + 64 * j)) = a[j] * ra * gm[j] + bt[j];
      *(f32x4*)(r1 + 4 * (lane + 64 * j)) = b[j] * rb * gm[j] + bt[j];
    }
  }
}

#define XB_TMO      128
#define XB_XCNT(j)  (256  + 64 * (j))
#define XB_XSUB(j)  (1280 + 64 * (j))
#define XB_XGEN(j)  (2304 + 64 * (j))
#define XB_TOP      3328
#define XB_TOPGEN   3392
#define XCD_BAR_WORDS 3456
#define XB_SPIN_CAP (1u << 22)
#define LAS __attribute__((address_space(3)))
DI unsigned xb_ld(unsigned* p) { return __hip_atomic_load(p, __ATOMIC_RELAXED, __HIP_MEMORY_SCOPE_AGENT); }
DI unsigned xb_add(unsigned* p, unsigned v) { return __hip_atomic_fetch_add(p, v, __ATOMIC_RELAXED, __HIP_MEMORY_SCOPE_AGENT); }
DI unsigned xb_xcc_id() { return (unsigned)__builtin_amdgcn_s_getreg((3 << 11) | 20) & 0xFu; }
#define XB_SPIN(cond, bar) do { unsigned _sp = 0; while (cond) { __builtin_amdgcn_s_sleep(1); \
    if ((++_sp & 255u) == 0u) { if (xb_ld(&(bar)[XB_TMO])) break; if (_sp > XB_SPIN_CAP) { atomicAdd(&(bar)[XB_TMO], 1u); break; } } } } while (0)
struct XcdBarrier { unsigned* bar; unsigned x; volatile LAS unsigned* st; };
DI bool xb_leader(int wvs) { return wvs == 0 && __builtin_amdgcn_mbcnt_hi(~0u, __builtin_amdgcn_mbcnt_lo(~0u, 0u)) == 0u; }
DI XcdBarrier xcd_barrier_post(unsigned* bar, volatile LAS unsigned* st, int wvs) {
  XcdBarrier b; b.bar = bar; b.x = xb_xcc_id(); b.st = st;
  if (xb_leader(wvs)) (void)xb_add(&bar[XB_XCNT(b.x)], 1u);
  return b;
}
DI void xcd_barrier_complete(unsigned* bar, unsigned x, unsigned& nloc, unsigned& nx) {
  const unsigned G = gridDim.x * gridDim.y * gridDim.z;
  unsigned sum, cnt, mine, sp = 0u;
  for (;;) {
    sum = 0u; cnt = 0u; mine = 0u;
#pragma unroll
    for (unsigned j = 0; j < 16; ++j) { const unsigned c = xb_ld(&bar[XB_XCNT(j)]); sum += c; cnt += (c > 0u) ? 1u : 0u; mine = (j == x) ? c : mine; }
    if (sum == G) break;
    __builtin_amdgcn_s_sleep(1);
    if ((++sp & 255u) == 0u) { if (xb_ld(&bar[XB_TMO])) break; if (sp > XB_SPIN_CAP) { atomicAdd(&bar[XB_TMO], 1u); break; } }
  }
  nloc = mine > 0u ? mine : 1u; nx = cnt > 0u ? cnt : 1u;
}
DI void xcd_barrier_(const XcdBarrier& b, int wvs) {
  asm volatile("s_waitcnt vmcnt(0)" ::: "memory");
  __syncthreads();
  if (xb_leader(wvs)) {
    unsigned* bar = b.bar;
    __builtin_amdgcn_s_waitcnt(0);
    unsigned nloc = b.st[0], nx = b.st[1];
    if (nloc == 0u) { xcd_barrier_complete(bar, b.x, nloc, nx); b.st[0] = nloc; b.st[1] = nx; }
    const unsigned old = xb_add(&bar[XB_XSUB(b.x)], 1u);
    const unsigned gen = old / nloc;
    if (old + 1u == (gen + 1u) * nloc) {
      __builtin_amdgcn_fence(__ATOMIC_RELEASE, "agent");
      asm volatile("s_waitcnt vmcnt(0)" ::: "memory");
      const unsigned og = xb_add(&bar[XB_TOP], 1u);
      const unsigned tg = og / nx;
      if (og + 1u == (tg + 1u) * nx) xb_add(&bar[XB_TOPGEN], 1u);
      else XB_SPIN(xb_ld(&bar[XB_TOPGEN]) == tg, bar);
      __builtin_amdgcn_fence(__ATOMIC_ACQUIRE, "agent");
      xb_add(&bar[XB_XGEN(b.x)], 1u);
      asm volatile("s_waitcnt vmcnt(0)" ::: "memory");
    } else {
      XB_SPIN(xb_ld(&bar[XB_XGEN(b.x)]) == gen, bar);
      __builtin_amdgcn_fence(__ATOMIC_ACQUIRE, "agent");
      asm volatile("s_waitcnt vmcnt(0)" ::: "memory");
    }
  }
  __syncthreads();
}

#define xcd_barrier(b) xcd_barrier_(b, w8)
namespace pg8 {
#define PG8_LAS __attribute__((address_space(3)))
typedef unsigned short bf16_t;
typedef short bf16x8 __attribute__((ext_vector_type(8)));
typedef float f32x4 __attribute__((ext_vector_type(4)));
typedef unsigned u32x4 __attribute__((ext_vector_type(4)));
constexpr int BM = 256, BK = 64, HALF = 128, HTB = HALF * BK * 2  , STAGE_BYTES = 8 * HTB, NXCD = 8, WGM = 8;

__host__ __device__ __forceinline__ int lds_byte(int r, int c) { const int st = (r >> 4) * 2 + (c >> 5), rr = r & 15, cc = c & 31, ob = rr * 64 + cc * 2; return st * 1024 + (ob ^ (((ob >> 9) & 1) << 5)); }
__host__ __device__ __forceinline__ void stage_rc(int b, int& R, int& C) { const int st = b / 1024, sb = b % 1024, swz = sb ^ (((sb >> 9) & 1) << 5); R = (st >> 1) * 16 + swz / 64; C = (st & 1) * 32 + (swz % 64) / 2; }
__host__ __device__ __forceinline__ int perm32(int rho) { const int n = rho >> 4, i = rho & 15; return 8 * (i >> 2) + 4 * n + (i & 3); }

struct Unit { int pm, pn; };
struct Gemm { const bf16_t* A; const bf16_t* Bt; int M, N, K; };

struct StaticOrder {
    int nM, nN, nwg, G, c;
    __host__ __device__ void init(int M, int N, int G_, int c_) { nM = M / BM; nN = N / BM; nwg = nM * nN; G = G_; c = c_; }
    __host__ __device__ bool next(int i, Unit& u) const {
        const long L = (long)i * G + c; if (L >= nwg) return false;
        int wgid = (int)L; { const int q = nwg / NXCD, r = nwg % NXCD, xcd = wgid % NXCD, off = wgid / NXCD; wgid = (xcd < r ? xcd * (q + 1) : r * (q + 1) + (xcd - r) * q) + off; }
        const int nig = WGM * nN, gid = wgid / nig, fm = gid * WGM, gsz = (nM - fm) < WGM ? (nM - fm) : WGM;
        u.pm = fm + ((wgid % nig) % gsz); u.pn = (wgid % nig) / gsz; return true;
    }
    __device__ __forceinline__ void a_ready(const Unit&) const {}
    __device__ __forceinline__ void done(const Unit&) const {}
};

template <class Epi, class Sched, bool ALIGN_EPI = false, bool SP2 = false>
__device__ __forceinline__ void gemm_phase(PG8_LAS unsigned char* lds, const Gemm g, const Sched& S, const Epi& E, const int tid) {
    const int wid = __builtin_amdgcn_readfirstlane(tid >> 6), lane = tid & 63, wr = wid >> 2, wc = wid & 3, fr = lane & 15, fq = lane >> 4;
    const int K = g.K, nt = K / BK;
    unsigned voffA[2], voffB[2];
#pragma unroll
    for (int i = 0; i < 2; ++i) { int R, C; stage_rc(tid * 16 + i * 8192, R, C); const int Rb = Epi::PERM ? ((R & ~31) + perm32(R & 31)) : R;
        voffA[i] = (unsigned)(R * K + C) * 2u; voffB[i] = (unsigned)(Rb * K + C) * 2u; }
    const size_t kstep = (size_t)(BK * 2);
    const size_t hstep = (size_t)HALF * K * 2;
    const size_t tstep = 2 * hstep;
    const unsigned ldsw = (unsigned)wid * 1024u;
    const int aoff = lds_byte(wr * 64 + fr, fq * 8), boff = lds_byte(wc * 32 + fr, fq * 8);
#define PG8_SA(b, h) (((b) * 2 + (h)) * HTB)
#define PG8_SB(b, h) ((4 + (b) * 2 + (h)) * HTB)
#define PG8_STAGE(bufoff, gbase, voff) do { _Pragma("unroll") for (int _i = 0; _i < 2; ++_i) \
        __builtin_amdgcn_global_load_lds((const unsigned*)((const char*)(gbase) + (voff)[_i]), (PG8_LAS unsigned*)(lds + (bufoff) + ldsw + _i * 8192), 16, 0, 0); } while (0)
#define PG8_LDA(dst, b, h) do { _Pragma("unroll") for (int m = 0; m < 4; ++m) _Pragma("unroll") for (int k = 0; k < 2; ++k) dst[m][k] = *(const PG8_LAS bf16x8*)(lds + PG8_SA(b, h) + aoff + m * 2048 + k * 1024); } while (0)
#define PG8_LDB(dst, b, h) do { _Pragma("unroll") for (int n = 0; n < 2; ++n) _Pragma("unroll") for (int k = 0; k < 2; ++k) dst[n][k] = *(const PG8_LAS bf16x8*)(lds + PG8_SB(b, h) + boff + n * 2048 + k * 1024); } while (0)
#define PG8_MMA(ai, bj, At, Bt) do { __builtin_amdgcn_s_setprio(1); _Pragma("unroll") for (int m = 0; m < 4; ++m) _Pragma("unroll") for (int n = 0; n < 2; ++n) _Pragma("unroll") for (int k = 0; k < 2; ++k) \
        acc[ai][bj][m][n] = __builtin_amdgcn_mfma_f32_16x16x32_bf16(Bt[n][k], At[m][k], acc[ai][bj][m][n], 0, 0, 0); __builtin_amdgcn_s_setprio(0); } while (0)
#define PG8_WAIT_V(n) asm volatile("s_waitcnt vmcnt(" #n ")" ::: "memory")
#define PG8_WAIT_L(n) asm volatile("s_waitcnt lgkmcnt(" #n ")" ::: "memory")
#define PG8_BAR __builtin_amdgcn_s_barrier()
#define PG8_SCHED __builtin_amdgcn_sched_barrier(0)
    Unit cur, nxt; int ui = 0;
    if (!S.next(0, cur)) return;
    f32x4 acc[2][2][4][2];
#pragma unroll
    for (int a = 0; a < 2; ++a)
#pragma unroll
        for (int b = 0; b < 2; ++b)
#pragma unroll
            for (int m = 0; m < 4; ++m)
#pragma unroll
                for (int n = 0; n < 2; ++n) acc[a][b][m][n] = (f32x4){0.f, 0.f, 0.f, 0.f};
    bf16x8 At[4][2], B0[2][2], B1[2][2];
    const char* cA = (const char*)g.A + (size_t)cur.pm * tstep; const char* cB = (const char*)g.Bt + (size_t)cur.pn * tstep;
    S.a_ready(cur);
    if constexpr (SP2) {
        PG8_STAGE(PG8_SB(0, 0), cB, voffB); PG8_STAGE(PG8_SB(0, 1), cB + hstep, voffB); PG8_STAGE(PG8_SA(0, 0), cA, voffA); PG8_STAGE(PG8_SA(0, 1), cA + hstep, voffA);
        if (wr == 1) PG8_BAR;
        PG8_WAIT_V(2); PG8_BAR;
        PG8_STAGE(PG8_SB(1, 0), cB + kstep, voffB); PG8_STAGE(PG8_SA(1, 0), cA + kstep, voffA); PG8_STAGE(PG8_SB(1, 1), cB + hstep + kstep, voffB);
        PG8_WAIT_V(6); PG8_BAR;
    } else {
        PG8_STAGE(PG8_SB(0, 0), cB, voffB); PG8_STAGE(PG8_SA(0, 0), cA, voffA); PG8_STAGE(PG8_SB(0, 1), cB + hstep, voffB); PG8_STAGE(PG8_SA(0, 1), cA + hstep, voffA);
        if (wr == 1) PG8_BAR;
        PG8_WAIT_V(4); PG8_BAR;
        PG8_STAGE(PG8_SB(1, 0), cB + kstep, voffB); PG8_STAGE(PG8_SA(1, 0), cA + kstep, voffA); PG8_STAGE(PG8_SB(1, 1), cB + hstep + kstep, voffB);
        PG8_WAIT_V(6); PG8_BAR;
    }
    for (;;) {
        const bool has_next = S.next(ui + 1, nxt);
        const char* nA = has_next ? (const char*)g.A + (size_t)nxt.pm * tstep : cA; const char* nB = has_next ? (const char*)g.Bt + (size_t)nxt.pn * tstep : cB;
        for (int t = 0; t < nt; t += 2) {
            const bool last = (t == nt - 2);
            const char* a1 = cA + (size_t)(t + 1) * kstep;
            const char* a2 = last ? nA : cA + (size_t)(t + 2) * kstep; const char* b2 = last ? nB : cB + (size_t)(t + 2) * kstep;
            const char* a3 = a2 + kstep; const char* b3 = b2 + kstep;
            if (last && has_next) S.a_ready(nxt);
            if constexpr (SP2) {
            PG8_LDB(B0, 0, 0); PG8_LDB(B1, 0, 1); PG8_SCHED; PG8_LDA(At, 0, 0); PG8_STAGE(PG8_SA(1, 1), a1 + hstep, voffA);
            PG8_WAIT_V(8); PG8_WAIT_L(0); PG8_BAR; PG8_MMA(0, 0, At, B0); PG8_MMA(0, 1, At, B1); PG8_BAR; PG8_SCHED;
            PG8_LDA(At, 0, 1); PG8_STAGE(PG8_SB(0, 0), b2, voffB); PG8_STAGE(PG8_SB(0, 1), b2 + hstep, voffB); PG8_STAGE(PG8_SA(0, 0), a2, voffA);
            PG8_WAIT_V(8); PG8_WAIT_L(0); PG8_BAR; PG8_MMA(1, 0, At, B0); PG8_MMA(1, 1, At, B1); PG8_BAR; PG8_SCHED;
            PG8_LDB(B0, 1, 0); PG8_LDB(B1, 1, 1); PG8_SCHED; PG8_LDA(At, 1, 0); PG8_STAGE(PG8_SA(0, 1), a2 + hstep, voffA);
            PG8_WAIT_V(8); PG8_WAIT_L(0); PG8_BAR; PG8_MMA(0, 0, At, B0); PG8_MMA(0, 1, At, B1); PG8_BAR; PG8_SCHED;
            PG8_LDA(At, 1, 1); PG8_STAGE(PG8_SB(1, 0), b3, voffB); PG8_STAGE(PG8_SB(1, 1), b3 + hstep, voffB); PG8_STAGE(PG8_SA(1, 0), a3, voffA);
            PG8_WAIT_V(8); PG8_WAIT_L(0); PG8_BAR; PG8_MMA(1, 0, At, B0); PG8_MMA(1, 1, At, B1); PG8_BAR; PG8_SCHED;
            } else {
            PG8_LDB(B0, 0, 0); PG8_SCHED; PG8_LDA(At, 0, 0); PG8_STAGE(PG8_SA(1, 1), a1 + hstep, voffA);
            PG8_WAIT_L(8); PG8_BAR; PG8_WAIT_L(0); PG8_MMA(0, 0, At, B0); PG8_BAR; PG8_SCHED;
            PG8_LDB(B1, 0, 1); PG8_STAGE(PG8_SB(0, 0), b2, voffB);
            PG8_BAR; PG8_WAIT_L(0); PG8_MMA(0, 1, At, B1); PG8_BAR;
            PG8_LDA(At, 0, 1); PG8_STAGE(PG8_SA(0, 0), a2, voffA);
            PG8_BAR; PG8_WAIT_L(0); PG8_MMA(1, 0, At, B0); PG8_BAR; PG8_SCHED;
            PG8_STAGE(PG8_SB(0, 1), b2 + hstep, voffB);
            PG8_WAIT_V(6); PG8_BAR; PG8_MMA(1, 1, At, B1); PG8_BAR;
            PG8_LDB(B0, 1, 0); PG8_SCHED; PG8_LDA(At, 1, 0); PG8_STAGE(PG8_SA(0, 1), a2 + hstep, voffA);
            PG8_WAIT_L(8); PG8_BAR; PG8_WAIT_L(0); PG8_MMA(0, 0, At, B0); PG8_BAR; PG8_SCHED;
            PG8_LDB(B1, 1, 1); PG8_STAGE(PG8_SB(1, 0), b3, voffB);
            PG8_BAR; PG8_WAIT_L(0); PG8_MMA(0, 1, At, B1); PG8_BAR;
            PG8_LDA(At, 1, 1); PG8_STAGE(PG8_SA(1, 0), a3, voffA);
            PG8_BAR; PG8_WAIT_L(0); PG8_MMA(1, 0, At, B0); PG8_BAR; PG8_SCHED;
            PG8_STAGE(PG8_SB(1, 1), b3 + hstep, voffB);
            PG8_WAIT_V(6); PG8_BAR; PG8_MMA(1, 1, At, B1); PG8_BAR;
            }
        }
        if constexpr (ALIGN_EPI) { if (wr == 0) PG8_BAR; }
        if constexpr (!Epi::AFTER_DRAIN) { E(acc, cur, wr, wc, fr, fq); S.done(cur); }
        if (!has_next) break;
#pragma unroll
        for (int a = 0; a < 2; ++a)
#pragma unroll
            for (int b = 0; b < 2; ++b)
#pragma unroll
                for (int m = 0; m < 4; ++m)
#pragma unroll
                    for (int n = 0; n < 2; ++n) acc[a][b][m][n] = (f32x4){0.f, 0.f, 0.f, 0.f};
        cur = nxt; cA = nA; cB = nB; ++ui;
        if constexpr (ALIGN_EPI) { if (wr == 1) PG8_BAR; }
    }
    PG8_WAIT_V(0);
    if constexpr (!ALIGN_EPI) { if (wr == 0) PG8_BAR; }
    PG8_BAR;
    if constexpr (Epi::AFTER_DRAIN) { E.fused(acc, cur, wr, wc, fr, fq, lds, wid, lane); S.done(cur); }
#undef PG8_SA
#undef PG8_SB
#undef PG8_STAGE
#undef PG8_LDA
#undef PG8_LDB
#undef PG8_MMA
#undef PG8_WAIT_V
#undef PG8_WAIT_L
#undef PG8_BAR
#undef PG8_SCHED
}

struct Unit2 { int pm, pn, part; };
struct Gemm2 { const bf16_t* A0; const bf16_t* A1; const bf16_t* B0; const bf16_t* B1; int lda, K; };
struct StaticOrder2 {
    int nM, nN, nwg, G, c;
    __host__ __device__ void init(int M, int N, int G_, int c_) { nM = M / BM; nN = N / BM; nwg = nM * nN; G = G_; c = c_; }
    __host__ __device__ bool next(int i, Unit2& u) const {
        const long L = (long)(i >> 1) * G + c; if (L >= nwg) return false;
        int wgid = (int)L; { const int q = nwg / NXCD, r = nwg % NXCD, xcd = wgid % NXCD, off = wgid / NXCD; wgid = (xcd < r ? xcd * (q + 1) : r * (q + 1) + (xcd - r) * q) + off; }
        const int nig = WGM * nN, gid = wgid / nig, fm = gid * WGM, gsz = (nM - fm) < WGM ? (nM - fm) : WGM;
        u.pm = fm + ((wgid % nig) % gsz); u.pn = (wgid % nig) / gsz; u.part = i & 1; return true;
    }
    __device__ __forceinline__ void a_ready(const Unit2&) const {}
    __device__ __forceinline__ void done(const Unit2&) const {}
};
template <class Epi, class Sched, bool ALIGN_EPI = false, bool SP2 = false>
__device__ __forceinline__ void gemm_phase2(PG8_LAS unsigned char* lds, const Gemm2 g, const Sched& S, const Epi& E, const int tid) {
    const int wid = __builtin_amdgcn_readfirstlane(tid >> 6), lane = tid & 63, wr = wid >> 2, wc = wid & 3, fr = lane & 15, fq = lane >> 4;
    const int K = g.K, nt = K / BK;
    unsigned voffA[2], voffB[2];
#pragma unroll
    for (int i = 0; i < 2; ++i) { int R, C; stage_rc(tid * 16 + i * 8192, R, C); const int Rb = Epi::PERM ? ((R & ~31) + perm32(R & 31)) : R;
        voffA[i] = (unsigned)(R * g.lda + C) * 2u; voffB[i] = (unsigned)(Rb * K + C) * 2u; }
    const size_t kstep = (size_t)(BK * 2);
    const size_t hstep = (size_t)HALF * K * 2;
    const size_t tstep = 2 * hstep;
    const size_t hstepA = (size_t)HALF * g.lda * 2, tstepA = 2 * hstepA;
    const unsigned ldsw = (unsigned)wid * 1024u;
    const int aoff = lds_byte(wr * 64 + fr, fq * 8), boff = lds_byte(wc * 32 + fr, fq * 8);
#define PG8_SA(b, h) (((b) * 2 + (h)) * HTB)
#define PG8_SB(b, h) ((4 + (b) * 2 + (h)) * HTB)
#define PG8_STAGE(bufoff, gbase, voff) do { _Pragma("unroll") for (int _i = 0; _i < 2; ++_i) \
        __builtin_amdgcn_global_load_lds((const unsigned*)((const char*)(gbase) + (voff)[_i]), (PG8_LAS unsigned*)(lds + (bufoff) + ldsw + _i * 8192), 16, 0, 0); } while (0)
#define PG8_LDA(dst, b, h) do { _Pragma("unroll") for (int m = 0; m < 4; ++m) _Pragma("unroll") for (int k = 0; k < 2; ++k) dst[m][k] = *(const PG8_LAS bf16x8*)(lds + PG8_SA(b, h) + aoff + m * 2048 + k * 1024); } while (0)
#define PG8_LDB(dst, b, h) do { _Pragma("unroll") for (int n = 0; n < 2; ++n) _Pragma("unroll") for (int k = 0; k < 2; ++k) dst[n][k] = *(const PG8_LAS bf16x8*)(lds + PG8_SB(b, h) + boff + n * 2048 + k * 1024); } while (0)
#define PG8_MMA(ai, bj, At, Bt) do { __builtin_amdgcn_s_setprio(1); _Pragma("unroll") for (int m = 0; m < 4; ++m) _Pragma("unroll") for (int n = 0; n < 2; ++n) _Pragma("unroll") for (int k = 0; k < 2; ++k) \
        acc[ai][bj][m][n] = __builtin_amdgcn_mfma_f32_16x16x32_bf16(Bt[n][k], At[m][k], acc[ai][bj][m][n], 0, 0, 0); __builtin_amdgcn_s_setprio(0); } while (0)
#define PG8_WAIT_V(n) asm volatile("s_waitcnt vmcnt(" #n ")" ::: "memory")
#define PG8_WAIT_L(n) asm volatile("s_waitcnt lgkmcnt(" #n ")" ::: "memory")
#define PG8_BAR __builtin_amdgcn_s_barrier()
#define PG8_SCHED __builtin_amdgcn_sched_barrier(0)
    Unit2 cur, nxt; int ui = 0;
    if (!S.next(0, cur)) return;
    f32x4 acc[2][2][4][2];
#pragma unroll
    for (int a = 0; a < 2; ++a)
#pragma unroll
        for (int b = 0; b < 2; ++b)
#pragma unroll
            for (int m = 0; m < 4; ++m)
#pragma unroll
                for (int n = 0; n < 2; ++n) acc[a][b][m][n] = (f32x4){0.f, 0.f, 0.f, 0.f};
    bf16x8 At[4][2], B0[2][2], B1[2][2];
    const char* cA = (const char*)(cur.part ? g.A1 : g.A0) + (size_t)cur.pm * tstepA; const char* cB = (const char*)(cur.part ? g.B1 : g.B0) + (size_t)cur.pn * tstep;
    S.a_ready(cur);
    if constexpr (SP2) {
        PG8_STAGE(PG8_SB(0, 0), cB, voffB); PG8_STAGE(PG8_SB(0, 1), cB + hstep, voffB); PG8_STAGE(PG8_SA(0, 0), cA, voffA); PG8_STAGE(PG8_SA(0, 1), cA + hstepA, voffA);
        if (wr == 1) PG8_BAR;
        PG8_WAIT_V(2); PG8_BAR;
        PG8_STAGE(PG8_SB(1, 0), cB + kstep, voffB); PG8_STAGE(PG8_SA(1, 0), cA + kstep, voffA); PG8_STAGE(PG8_SB(1, 1), cB + hstep + kstep, voffB);
        PG8_WAIT_V(6); PG8_BAR;
    } else {
        PG8_STAGE(PG8_SB(0, 0), cB, voffB); PG8_STAGE(PG8_SA(0, 0), cA, voffA); PG8_STAGE(PG8_SB(0, 1), cB + hstep, voffB); PG8_STAGE(PG8_SA(0, 1), cA + hstepA, voffA);
        if (wr == 1) PG8_BAR;
        PG8_WAIT_V(4); PG8_BAR;
        PG8_STAGE(PG8_SB(1, 0), cB + kstep, voffB); PG8_STAGE(PG8_SA(1, 0), cA + kstep, voffA); PG8_STAGE(PG8_SB(1, 1), cB + hstep + kstep, voffB);
        PG8_WAIT_V(6); PG8_BAR;
    }
    for (;;) {
        const bool has_next = S.next(ui + 1, nxt);
        const char* nA = has_next ? (const char*)(nxt.part ? g.A1 : g.A0) + (size_t)nxt.pm * tstepA : cA; const char* nB = has_next ? (const char*)(nxt.part ? g.B1 : g.B0) + (size_t)nxt.pn * tstep : cB;
        for (int t = 0; t < nt; t += 2) {
            const bool last = (t == nt - 2);
            const char* a1 = cA + (size_t)(t + 1) * kstep;
            const char* a2 = last ? nA : cA + (size_t)(t + 2) * kstep; const char* b2 = last ? nB : cB + (size_t)(t + 2) * kstep;
            const char* a3 = a2 + kstep; const char* b3 = b2 + kstep;
            if (last && has_next) S.a_ready(nxt);
            if constexpr (SP2) {
            PG8_LDB(B0, 0, 0); PG8_LDB(B1, 0, 1); PG8_SCHED; PG8_LDA(At, 0, 0); PG8_STAGE(PG8_SA(1, 1), a1 + hstepA, voffA);
            PG8_WAIT_V(8); PG8_WAIT_L(0); PG8_BAR; PG8_MMA(0, 0, At, B0); PG8_MMA(0, 1, At, B1); PG8_BAR; PG8_SCHED;
            PG8_LDA(At, 0, 1); PG8_STAGE(PG8_SB(0, 0), b2, voffB); PG8_STAGE(PG8_SB(0, 1), b2 + hstep, voffB); PG8_STAGE(PG8_SA(0, 0), a2, voffA);
            PG8_WAIT_V(8); PG8_WAIT_L(0); PG8_BAR; PG8_MMA(1, 0, At, B0); PG8_MMA(1, 1, At, B1); PG8_BAR; PG8_SCHED;
            PG8_LDB(B0, 1, 0); PG8_LDB(B1, 1, 1); PG8_SCHED; PG8_LDA(At, 1, 0); PG8_STAGE(PG8_SA(0, 1), a2 + hstepA, voffA);
            PG8_WAIT_V(8); PG8_WAIT_L(0); PG8_BAR; PG8_MMA(0, 0, At, B0); PG8_MMA(0, 1, At, B1); PG8_BAR; PG8_SCHED;
            PG8_LDA(At, 1, 1); PG8_STAGE(PG8_SB(1, 0), b3, voffB); PG8_STAGE(PG8_SB(1, 1), b3 + hstep, voffB); PG8_STAGE(PG8_SA(1, 0), a3, voffA);
            PG8_WAIT_V(8); PG8_WAIT_L(0); PG8_BAR; PG8_MMA(1, 0, At, B0); PG8_MMA(1, 1, At, B1); PG8_BAR; PG8_SCHED;
            } else {
            PG8_LDB(B0, 0, 0); PG8_SCHED; PG8_LDA(At, 0, 0); PG8_STAGE(PG8_SA(1, 1), a1 + hstepA, voffA);
            PG8_WAIT_L(8); PG8_BAR; PG8_WAIT_L(0); PG8_MMA(0, 0, At, B0); PG8_BAR; PG8_SCHED;
            PG8_LDB(B1, 0, 1); PG8_STAGE(PG8_SB(0, 0), b2, voffB);
            PG8_BAR; PG8_WAIT_L(0); PG8_MMA(0, 1, At, B1); PG8_BAR;
            PG8_LDA(At, 0, 1); PG8_STAGE(PG8_SA(0, 0), a2, voffA);
            PG8_BAR; PG8_WAIT_L(0); PG8_MMA(1, 0, At, B0); PG8_BAR; PG8_SCHED;
            PG8_STAGE(PG8_SB(0, 1), b2 + hstep, voffB);
            PG8_WAIT_V(6); PG8_BAR; PG8_MMA(1, 1, At, B1); PG8_BAR;
            PG8_LDB(B0, 1, 0); PG8_SCHED; PG8_LDA(At, 1, 0); PG8_STAGE(PG8_SA(0, 1), a2 + hstepA, voffA);
            PG8_WAIT_L(8); PG8_BAR; PG8_WAIT_L(0); PG8_MMA(0, 0, At, B0); PG8_BAR; PG8_SCHED;
            PG8_LDB(B1, 1, 1); PG8_STAGE(PG8_SB(1, 0), b3, voffB);
            PG8_BAR; PG8_WAIT_L(0); PG8_MMA(0, 1, At, B1); PG8_BAR;
            PG8_LDA(At, 1, 1); PG8_STAGE(PG8_SA(1, 0), a3, voffA);
            PG8_BAR; PG8_WAIT_L(0); PG8_MMA(1, 0, At, B0); PG8_BAR; PG8_SCHED;
            PG8_STAGE(PG8_SB(1, 1), b3 + hstep, voffB);
            PG8_WAIT_V(6); PG8_BAR; PG8_MMA(1, 1, At, B1); PG8_BAR;
            }
        }
        if constexpr (ALIGN_EPI) { if (wr == 0) PG8_BAR; }
        if (cur.part == 0) E.mid(acc, cur, wr, wc, fr, fq); else E(acc, cur, wr, wc, fr, fq);
        if (!has_next) break;
        if (cur.part == 1) {
#pragma unroll
        for (int a = 0; a < 2; ++a)
#pragma unroll
            for (int b = 0; b < 2; ++b)
#pragma unroll
                for (int m = 0; m < 4; ++m)
#pragma unroll
                    for (int n = 0; n < 2; ++n) acc[a][b][m][n] = (f32x4){0.f, 0.f, 0.f, 0.f};
        }
        cur = nxt; cA = nA; cB = nB; ++ui;
        if constexpr (ALIGN_EPI) { if (wr == 1) PG8_BAR; }
    }
    PG8_WAIT_V(0);
    if constexpr (!ALIGN_EPI) { if (wr == 0) PG8_BAR; }
    PG8_BAR;
#undef PG8_SA
#undef PG8_SB
#undef PG8_STAGE
#undef PG8_LDA
#undef PG8_LDB
#undef PG8_MMA
#undef PG8_WAIT_V
#undef PG8_WAIT_L
#undef PG8_BAR
#undef PG8_SCHED
}
}

struct EpiInProj {
  static constexpr bool PERM = true, AFTER_DRAIN = false;
  u16* h;
  DI void operator()(const f32x4 (&acc)[2][2][4][2], const pg8::Unit& u, int wr, int wc, int fr, int fq) const {
    const int shift = (u.pn >= 8) ? 8 : 0;
#pragma unroll
    for (int ai = 0; ai < 2; ++ai)
#pragma unroll
      for (int m = 0; m < 4; ++m) {
        const int row = u.pm * 256 + ai * 128 + wr * 64 + m * 16 + fr;
#pragma unroll
        for (int bj = 0; bj < 2; ++bj) {
          const int col = u.pn * 256 + bj * 128 + wc * 32 + 8 * fq + shift;
          const f32x4 a = acc[ai][bj][m][0], b = acc[ai][bj][m][1];
          u32x4 w; w.x = pk_bf16(a[0], a[1]); w.y = pk_bf16(a[2], a[3]); w.z = pk_bf16(b[0], b[1]); w.w = pk_bf16(b[2], b[3]);
          *(u32x4*)(h + (size_t)row * NC + col) = w;
        }
      }
  }
};

struct EpiMerge {
  static constexpr bool PERM = true, AFTER_DRAIN = false;
  const u16* h; u16* mg;
  DI void mid(f32x4 (&acc)[2][2][4][2], const pg8::Unit2& u, int wr, int wc, int fr, int fq) const {
#pragma unroll
    for (int ai = 0; ai < 2; ++ai)
#pragma unroll
      for (int m = 0; m < 4; ++m) {
        const int row = u.pm * 256 + ai * 128 + wr * 64 + m * 16 + fr;
#pragma unroll
        for (int bj = 0; bj < 2; ++bj) {
          const int col = u.pn * 256 + bj * 128 + wc * 32 + 8 * fq;
          const u32x4 ga = *(const u32x4*)(h + (size_t)row * NC + C_GA + col), gb = *(const u32x4*)(h + (size_t)row * NC + C_GB + col);
#pragma unroll
          for (int j = 0; j < 4; ++j) {
            const float r0 = (1.f + __expf(-bf_lo(gb[j]))) * rcp_f(1.f + __expf(-bf_lo(ga[j])));
            const float r1 = (1.f + __expf(-bf_hi(gb[j]))) * rcp_f(1.f + __expf(-bf_hi(ga[j])));
            acc[ai][bj][m][j >> 1][2 * (j & 1)] *= r0; acc[ai][bj][m][j >> 1][2 * (j & 1) + 1] *= r1;
          }
        }
        __builtin_amdgcn_sched_barrier(0);
      }
  }
  DI void operator()(const f32x4 (&acc)[2][2][4][2], const pg8::Unit2& u, int wr, int wc, int fr, int fq) const {
#pragma unroll
    for (int ai = 0; ai < 2; ++ai)
#pragma unroll
      for (int m = 0; m < 4; ++m) {
        const int row = u.pm * 256 + ai * 128 + wr * 64 + m * 16 + fr;
#pragma unroll
        for (int bj = 0; bj < 2; ++bj) {
          const int col = u.pn * 256 + bj * 128 + wc * 32 + 8 * fq;
          const u32x4 gb = *(const u32x4*)(h + (size_t)row * NC + C_GB + col);
          const f32x4 a = acc[ai][bj][m][0], b = acc[ai][bj][m][1];
          u32x4 w;
          w.x = pk_bf16(a[0] * sigmoid_f(bf_lo(gb[0])), a[1] * sigmoid_f(bf_hi(gb[0])));
          w.y = pk_bf16(a[2] * sigmoid_f(bf_lo(gb[1])), a[3] * sigmoid_f(bf_hi(gb[1])));
          w.z = pk_bf16(b[0] * sigmoid_f(bf_lo(gb[2])), b[1] * sigmoid_f(bf_hi(gb[2])));
          w.w = pk_bf16(b[2] * sigmoid_f(bf_lo(gb[3])), b[3] * sigmoid_f(bf_hi(gb[3])));
          *(u32x4*)(mg + (size_t)row * 1024 + col) = w;
        }
        __builtin_amdgcn_sched_barrier(0);
      }
  }
};

struct EpiOut {
  static constexpr bool PERM = true, AFTER_DRAIN = false;
  const float* x; _Float16* r16;
  DI void operator()(const f32x4 (&acc)[2][2][4][2], const pg8::Unit& u, int wr, int wc, int fr, int fq) const {
#pragma unroll
    for (int ai = 0; ai < 2; ++ai)
#pragma unroll
      for (int m = 0; m < 4; ++m) {
        const int row = u.pm * 256 + ai * 128 + wr * 64 + m * 16 + fr;
#pragma unroll
        for (int bj = 0; bj < 2; ++bj) {
          const int col = u.pn * 256 + bj * 128 + wc * 32 + 8 * fq;
          const f32x4 x0 = *(const f32x4*)(x + (size_t)row * 1024 + col), x1 = *(const f32x4*)(x + (size_t)row * 1024 + col + 4);
          const f32x4 v0 = x0 * 1.189207115002721f + acc[ai][bj][m][0], v1 = x1 * 1.189207115002721f + acc[ai][bj][m][1];
          const f16x4 h0 = __builtin_convertvector(v0, f16x4), h1 = __builtin_convertvector(v1, f16x4);
          u32x4 w; const u32x2 p0 = __builtin_bit_cast(u32x2, h0), p1 = __builtin_bit_cast(u32x2, h1);
          w.x = p0.x; w.y = p0.y; w.z = p1.x; w.w = p1.y;
          *(u32x4*)(r16 + (size_t)row * 1024 + col) = w;
        }
      }
  }
};

__global__ void __launch_bounds__(512, 2) fwd_megakernel(Params p) {
  cg::grid_group grid = cg::this_grid();
  __shared__ __attribute__((aligned(16))) unsigned char smem[SMEM_BYTES];
  const int w8 = __builtin_amdgcn_readfirstlane((int)(threadIdx.x >> 6));
  const int wvs = w8 & 3, half = w8 >> 2;
  unsigned char* hsm = smem + half * HALF_SMEM;
  const int vb = blockIdx.x + half * gridDim.x, nvb = 2 * gridDim.x;
  volatile LAS unsigned* st = (volatile LAS unsigned*)(smem + SMEM_BYTES - 16);
  { const int t0_ = opaque_tid(); if (t0_ < 4) st[t0_] = 0u; }
  __syncthreads();
  const XcdBarrier xb = xcd_barrier_post((unsigned*)(p.ws + OFF_BAR), st, w8);
  phase0(p, w8);
  if (p.ws == nullptr) grid.sync();
  xcd_barrier(xb);
  {
    pg8::Gemm g; g.A = (const pg8::bf16_t*)(p.ws + OFF_SC); g.Bt = (const pg8::bf16_t*)(p.ws + OFF_WINT); g.M = T_TOK; g.N = NCP; g.K = 1024;
    pg8::StaticOrder so; so.init(T_TOK, NCP, (int)gridDim.x, (int)blockIdx.x);
    EpiInProj e; e.h = (u16*)(p.ws + OFF_H);
    pg8::gemm_phase<EpiInProj, pg8::StaticOrder, true, true>((PG8_LAS unsigned char*)smem, g, so, e, opaque_tid_(w8));
  }
  xcd_barrier(xb);
  for (int it = vb; it < 2048; it += nvb) prep_item(p, wvs, it, hsm);
  xcd_barrier(xb);
  if (blockIdx.x < 128) {
    if (half == 0) { const int cb = (int)blockIdx.x; scan_chain(p, wvs, (cb & 7) + 8 * ((cb >> 3) >> 3), (cb >> 3) & 7, hsm); }
    else {
      const int cb = (int)blockIdx.x, pr = (cb & 7) + 8 * ((cb >> 3) >> 3), slp = (cb >> 3) & 7, bp = pr >> 2, hp = pr & 3;
      const int ft = opaque_tid();
      const unsigned char* pbase = p.ws + OFF_SC + (size_t)(slp * 72 + (ft < 72 ? ft : 0)) * 128;
      unsigned r0 = 0, r1 = 0, r2 = 0, r3 = 0, accp = 0;
      __syncthreads();
      for (int n = 0; n < 128; ++n) {
        accp ^= r3; r3 = r2; r2 = r1; r1 = r0;
        const int np = n + 6 < 128 ? n + 6 : 127;
        r0 = *(const unsigned*)(pbase + (size_t)((bp * 128 + np) * 4 + hp) * OPB);
        __syncthreads(); __syncthreads();
      }
      accp ^= r0 ^ r1 ^ r2 ^ r3;
      if (accp == 0x9e3779b9u && ft == 300) ((unsigned*)(p.ws + OFF_BAR))[XB_TMO + 1] = accp;
    }
  } else {
    const int nsw = 2 * ((int)gridDim.x - 128), vbl = ((int)blockIdx.x - 128) + half * ((int)gridDim.x - 128);
    for (int k = 0; k * nsw < 1024; ++k) { const int it = vbl + k * nsw; swa_item(p, wvs, it < 1024 ? it : 0, it < 1024, hsm); }
  }
  xcd_barrier(xb);
  phase_ya(p, w8);
  xcd_barrier(xb);
  {
    pg8::Gemm2 g; g.A0 = (const pg8::bf16_t*)(p.ws + OFF_H); g.A1 = g.A0 + C_SWQ; g.B0 = (const pg8::bf16_t*)(p.ws + OFF_WAT); g.B1 = (const pg8::bf16_t*)(p.ws + OFF_WBT);
    g.lda = NC; g.K = 512;
    pg8::StaticOrder2 so; so.init(T_TOK, 1024, (int)gridDim.x, (int)blockIdx.x);
    EpiMerge e; e.h = (const u16*)(p.ws + OFF_H); e.mg = (u16*)(p.ws + OFF_SC);
    pg8::gemm_phase2<EpiMerge, pg8::StaticOrder2, true, true>((PG8_LAS unsigned char*)smem, g, so, e, opaque_tid_(w8));
  }
  xcd_barrier(xb);
  {
    pg8::Gemm g; g.A = (const pg8::bf16_t*)(p.ws + OFF_SC); g.Bt = (const pg8::bf16_t*)(p.ws + OFF_WOT); g.M = T_TOK; g.N = 1024; g.K = 1024;
    pg8::StaticOrder so; so.init(T_TOK, 1024, (int)gridDim.x, (int)blockIdx.x);
    EpiOut e; e.x = p.x; e.r16 = (_Float16*)(p.ws + OFF_H);
    pg8::gemm_phase<EpiOut, pg8::StaticOrder, true, true>((PG8_LAS unsigned char*)smem, g, so, e, opaque_tid_(w8));
  }
  xcd_barrier(xb);
  phase6(p, w8, smem);
}

extern "C" void kernel_launch(void* const* d_in, const int* in_sizes, int n_in, void* d_out, int out_size,
                              void* d_ws, size_t ws_size, hipStream_t stream) {
  if (ws_size < WS_NEED) { fprintf(stderr, "workspace too small: %zu < %zu\n", ws_size, (size_t)WS_NEED); return; }
  Params p{};
  p.x = (const float*)d_in[0]; p.w_in = (const float*)d_in[1]; p.conv_w = (const float*)d_in[2]; p.a_log = (const float*)d_in[3];
  p.dt_bias = (const float*)d_in[4]; p.dn_norm_w = (const float*)d_in[5]; p.sinks = (const float*)d_in[6];
  p.w_branch = (const float*)d_in[7]; p.w_out = (const float*)d_in[8]; p.ln_g = (const float*)d_in[9]; p.ln_b = (const float*)d_in[10];
  p.out = (float*)d_out; p.ws = (unsigned char*)d_ws;
  for (int i = 0; i < 8; ++i) p.inv_freq[i] = (float)std::pow(500000.0, -(double)i / 8.0);
  static int grid_blocks = 0;
  if (!grid_blocks) {
    int dev = 0, cus = 0, per_cu = 0;
    (void)hipGetDevice(&dev);
    (void)hipDeviceGetAttribute(&cus, hipDeviceAttributeMultiprocessorCount, dev);
    (void)hipOccupancyMaxActiveBlocksPerMultiprocessor(&per_cu, fwd_megakernel, 512, 0);
    if (per_cu < 1) fprintf(stderr, "occupancy query reports %d workgroups per CU\n", per_cu);
    grid_blocks = cus > 256 ? 256 : cus;
    grid_blocks &= ~7;
  }
  (void)hipMemsetAsync(p.ws + OFF_BAR, 0, BAR_BYTES, stream);
  void* args[] = {&p};
  hipError_t e = hipLaunchCooperativeKernel((void*)fwd_megakernel, dim3(grid_blocks), dim3(512), args, 0, stream);
  if (e != hipSuccess) fprintf(stderr, "cooperative launch failed: %s (grid %d)\n", hipGetErrorString(e), grid_blocks);
}
```

```cpp
#include <hip/hip_runtime.h>
#include <hip/hip_cooperative_groups.h>
#include <cstdio>
#include <cmath>
namespace cg = cooperative_groups;

typedef unsigned short u16;
typedef short bf16x8 __attribute__((ext_vector_type(8)));
typedef float f32x4 __attribute__((ext_vector_type(4)));
typedef unsigned u32x4 __attribute__((ext_vector_type(4)));
typedef unsigned u32x2 __attribute__((ext_vector_type(2)));
typedef _Float16 f16x4 __attribute__((ext_vector_type(4)));
#define DI __device__ __forceinline__
DI int opaque_tid_(int wave_s) { int t; asm volatile("v_mbcnt_lo_u32_b32 %0, -1, 0\n\tv_mbcnt_hi_u32_b32 %0, -1, %0" : "=v"(t)); return t + (wave_s << 6); }
#define opaque_tid() opaque_tid_(wvs)

constexpr int T_TOK = 32768, SEQ = 8192, DM = 1024, NC = 5384, NCP = 5376;
constexpr int C_DNZ = 1536, C_SWQ = 2056, C_SWK = 2568, C_SWV = 2696, C_SWZ = 2824, C_GA = 3336, C_GB = 4360;
constexpr size_t OFF_BAR = 0;
constexpr size_t BAR_BYTES = 16384;
constexpr size_t OFF_WINT = BAR_BYTES;
constexpr size_t OFF_WAT = OFF_WINT + (size_t)NCP * 1024 * 2;
constexpr size_t OFF_WBT = OFF_WAT + 1024 * 512 * 2;
constexpr size_t OFF_WOT = OFF_WBT + 1024 * 512 * 2;
constexpr size_t OFF_ROPE = OFF_WOT + 1024 * 1024 * 2;
constexpr size_t OFF_HB = OFF_ROPE + 2 * 8192 * 8 * 4;
constexpr size_t OFF_DEC = OFF_HB + (size_t)T_TOK * 8 * 4;
constexpr size_t OFF_H = OFF_DEC + 2048 * 4;
constexpr size_t OFF_SC = OFF_H + (size_t)T_TOK * NC * 2;
constexpr size_t OPB = 73728;
constexpr size_t WS_NEED = OFF_SC + 2048 * OPB;
constexpr int HALF_SMEM = 73728;
constexpr int SMEM_BYTES = 2 * HALF_SMEM + 16;

struct Params {
  const float *x, *w_in, *conv_w, *a_log, *dt_bias, *dn_norm_w, *sinks, *w_branch, *w_out, *ln_g, *ln_b;
  float* out; unsigned char* ws;
  float inv_freq[8];
};

typedef __bf16 bf16x2_t __attribute__((ext_vector_type(2)));
typedef float f32x2_t __attribute__((ext_vector_type(2)));
DI unsigned pk_bf16(float lo, float hi) { f32x2_t f = {lo, hi}; bf16x2_t v = __builtin_convertvector(f, bf16x2_t); return __builtin_bit_cast(unsigned, v); }
DI float bf_lo(unsigned u) { return __uint_as_float(u << 16); }
DI float bf_hi(unsigned u) { return __uint_as_float(u & 0xffff0000u); }
DI float bf2f(u16 v) { return __uint_as_float(((unsigned)v) << 16); }
DI u16 f2bf(float f) { return (u16)(pk_bf16(f, f) & 0xffffu); }
DI float shx(float v, int m, int lane) { return __uint_as_float((unsigned)__builtin_amdgcn_ds_bpermute((lane ^ m) << 2, (int)__float_as_uint(v))); }
DI float rcp_f(float y) { return __builtin_amdgcn_rcpf(y); }
DI float silu_f(float y) { return y * rcp_f(1.0f + __expf(-y)); }
DI float sigmoid_f(float y) { return rcp_f(1.0f + __expf(-y)); }
DI f32x4 mfma16(bf16x8 a, bf16x8 b, f32x4 c) { return __builtin_amdgcn_mfma_f32_16x16x32_bf16(a, b, c, 0, 0, 0); }
DI bf16x8 as_bf8(u32x4 v) { return __builtin_bit_cast(bf16x8, v); }
DI bf16x8 pack8(f32x4 a, f32x4 b) { u32x4 w; w.x = pk_bf16(a[0], a[1]); w.y = pk_bf16(a[2], a[3]); w.z = pk_bf16(b[0], b[1]); w.w = pk_bf16(b[2], b[3]); return as_bf8(w); }

DI void phase0(const Params& p, int wvs) {
  const size_t gt = (size_t)blockIdx.x * 512 + opaque_tid(), gs = (size_t)gridDim.x * 512;
  {
    const int ltid = (int)(gt & 511), lane = ltid & 63, wv = ltid >> 6;
    float wr[16][8];
#pragma unroll
    for (int j = 0; j < 4; ++j)
#pragma unroll
      for (int c = 0; c < 4; ++c) {
        const float* wp = p.w_in + (size_t)(4 * (lane + 64 * j) + c) * NC + 2048;
        const f32x4 a = *(const f32x4*)wp, b = *(const f32x4*)(wp + 4);
#pragma unroll
        for (int q = 0; q < 4; ++q) { wr[4 * j + c][q] = a[q]; wr[4 * j + c][4 + q] = b[q]; }
      }
    u16* xb = (u16*)(p.ws + OFF_SC);
    float* hb = (float*)(p.ws + OFF_HB);
    const int rstep = gridDim.x * 8;
    for (int row0 = blockIdx.x * 8 + wv; row0 < T_TOK; row0 += 2 * rstep) {
      f32x4 xr[2][4];
#pragma unroll
      for (int u = 0; u < 2; ++u) {
        const int row = row0 + u * rstep;
#pragma unroll
        for (int j = 0; j < 4; ++j) xr[u][j] = (row < T_TOK) ? *(const f32x4*)(p.x + (size_t)row * DM + 4 * (lane + 64 * j)) : (f32x4){0.f, 0.f, 0.f, 0.f};
      }
#pragma unroll
      for (int u = 0; u < 2; ++u) {
        const int row = row0 + u * rstep;
        float v[8];
#pragma unroll
        for (int q = 0; q < 8; ++q) v[q] = 0.f;
#pragma unroll
        for (int j = 0; j < 4; ++j) {
          const f32x4 xv = xr[u][j];
          u32x2 w; w.x = pk_bf16(xv[0], xv[1]); w.y = pk_bf16(xv[2], xv[3]);
          if (row < T_TOK) *(u32x2*)(xb + (size_t)row * DM + 4 * (lane + 64 * j)) = w;
#pragma unroll
          for (int c = 0; c < 4; ++c)
#pragma unroll
            for (int q = 0; q < 8; ++q) v[q] += xv[c] * wr[4 * j + c][q];
        }
        const bool up = (lane & 32) != 0;
        float k4[4];
#pragma unroll
        for (int i = 0; i < 4; ++i) { const float snd = up ? v[i] : v[i + 4]; const float kp = up ? v[i + 4] : v[i]; k4[i] = kp + shx(snd, 32, lane); }
        const bool up2 = (lane & 16) != 0;
        float k2[2];
#pragma unroll
        for (int i = 0; i < 2; ++i) { const float snd = up2 ? k4[i] : k4[i + 2]; const float kp = up2 ? k4[i + 2] : k4[i]; k2[i] = kp + shx(snd, 16, lane); }
        const bool up3 = (lane & 8) != 0;
        float k1 = (up3 ? k2[1] : k2[0]) + shx(up3 ? k2[0] : k2[1], 8, lane);
        k1 += shx(k1, 4, lane); k1 += shx(k1, 2, lane); k1 += shx(k1, 1, lane);
        if ((lane & 7) == 0 && row < T_TOK) hb[(size_t)row * 8 + (lane >> 3)] = k1;
      }
    }
  }
  {
    u32x4* wt = (u32x4*)(p.ws + OFF_WINT);
    for (size_t i = gt; i < (size_t)NCP * 128; i += gs) {
      const int kc = (int)(i / NCP), n = (int)(i % NCP);
      float v[8];
#pragma unroll
      for (int j = 0; j < 8; ++j) v[j] = p.w_in[(size_t)(kc * 8 + j) * NC + n + (n >= 2048 ? 8 : 0)];
      u32x4 w; w.x = pk_bf16(v[0], v[1]); w.y = pk_bf16(v[2], v[3]); w.z = pk_bf16(v[4], v[5]); w.w = pk_bf16(v[6], v[7]);
      wt[(size_t)n * 128 + kc] = w;
    }
  }
  {
    for (size_t i = gt; i < (size_t)2 * 1024 * 64; i += gs) {
      const int br = (int)(i / (1024 * 64)), rem = (int)(i % (1024 * 64)), kc = rem / 1024, n = rem % 1024;
      const float* src = p.w_branch + (size_t)br * 512 * 1024;
      float v[8];
#pragma unroll
      for (int j = 0; j < 8; ++j) v[j] = src[(size_t)(kc * 8 + j) * 1024 + n];
      u32x4 w; w.x = pk_bf16(v[0], v[1]); w.y = pk_bf16(v[2], v[3]); w.z = pk_bf16(v[4], v[5]); w.w = pk_bf16(v[6], v[7]);
      ((u32x4*)(p.ws + (br ? OFF_WBT : OFF_WAT)))[(size_t)n * 64 + kc] = w;
    }
  }
  {
    for (size_t i = gt; i < (size_t)1024 * 128; i += gs) {
      const int kc = (int)(i / 1024), n = (int)(i % 1024);
      float v[8];
#pragma unroll
      for (int j = 0; j < 8; ++j) v[j] = p.w_out[(size_t)(kc * 8 + j) * 1024 + n];
      u32x4 w; w.x = pk_bf16(v[0], v[1]); w.y = pk_bf16(v[2], v[3]); w.z = pk_bf16(v[4], v[5]); w.w = pk_bf16(v[6], v[7]);
      ((u32x4*)(p.ws + OFF_WOT))[(size_t)n * 128 + kc] = w;
    }
  }
  {
    float* rc = (float*)(p.ws + OFF_ROPE); float* rs = rc + 8192 * 8;
    for (size_t i = gt; i < 8192 * 8; i += gs) {
      const int t = (int)(i >> 3), f = (int)(i & 7);
      const float ang = (float)t * p.inv_freq[f];
      const double a = (double)ang;
      const double k = __builtin_rint(a * 0.15915494309189535);
      const float r = (float)(a - k * 6.283185307179586);
      rc[i] = cosf(r); rs[i] = sinf(r);
    }
  }
}

template <int I> DI void solve_rows2(f32x2_t (&xv)[64], const float* Lm, int lane, float lcur) {
  if constexpr (I < 64) {
    float lnx = 0.f;
    if constexpr (I + 1 < 64) lnx = Lm[(I + 1) * 68 + lane];
    f32x2_t a0 = xv[I], a1 = {0.f, 0.f}, a2 = {0.f, 0.f}, a3 = {0.f, 0.f};
#pragma unroll
    for (int m = 0; m < I; ++m) {
      const float l = __builtin_bit_cast(float, __builtin_amdgcn_readlane(__builtin_bit_cast(int, lcur), m));
      const f32x2_t lv = {l, l};
      if ((m & 3) == 0) a0 -= lv * xv[m];
      else if ((m & 3) == 1) a1 -= lv * xv[m];
      else if ((m & 3) == 2) a2 -= lv * xv[m];
      else a3 -= lv * xv[m];
    }
    xv[I] = (a0 + a1) + (a2 + a3);
    solve_rows2<I + 1>(xv, Lm, lane, lnx);
  }
}

DI void prep_item(const Params& p, int wvs, int item, unsigned char* smem) {
  const int tid_ = opaque_tid();
  const int tid = tid_, lane = tid & 63, wv = tid >> 6, r16 = lane & 15, g = lane >> 4;
  const int hd = item & 3, n = (item >> 2) & 127, b = item >> 9;
  const int t0 = b * SEQ + n * 64;
  u16* Qs = (u16*)smem; u16* Ks = Qs + 64 * 136; u16* Vs = Ks + 64 * 136;
  float* Lm = (float*)(smem + 52224);
  float* sm_beta = (float*)(smem + 69632);
  float* sm_gc = sm_beta + 64; float* sm_rq = sm_gc + 64; float* sm_rk = sm_rq + 64;
  float* sm_fw = sm_rk + 64; float* sm_fq = sm_fw + 64; float* sm_fk = sm_fq + 64;
  const u16* h = (const u16*)(p.ws + OFF_H);
  const float* hb = (const float*)(p.ws + OFF_HB);
  unsigned char* op = p.ws + OFF_SC + (size_t)item * OPB;
  __syncthreads();
  float hb_bl, hb_al;
  {
    const int c2 = tid & 63, rbase = (tid >> 6) * 16;
    unsigned raw[3][19];
#pragma unroll
    for (int mat = 0; mat < 3; ++mat) {
      const int col = mat * 512 + hd * 128 + 2 * c2;
#pragma unroll
      for (int j = 0; j < 19; ++j) {
        const int rr = t0 + rbase - 3 + j;
        raw[mat][j] = *(const unsigned*)(h + (size_t)(rr < 0 ? 0 : rr) * NC + col);
      }
    }
    float2 cw[3][4];
#pragma unroll
    for (int mat = 0; mat < 3; ++mat)
#pragma unroll
      for (int j = 0; j < 4; ++j) cw[mat][j] = *(const float2*)(p.conv_w + j * 1536 + mat * 512 + hd * 128 + 2 * c2);
    hb_bl = hb[(size_t)(t0 + lane) * 8 + hd]; hb_al = hb[(size_t)(t0 + lane) * 8 + 4 + hd];
    __builtin_amdgcn_sched_barrier(0);
#pragma unroll
    for (int mat = 0; mat < 3; ++mat) {
      float wa[4], wb[4];
#pragma unroll
      for (int j = 0; j < 4; ++j) { wa[j] = cw[mat][j].x; wb[j] = cw[mat][j].y; }
      float xa[3], xb[3];
#pragma unroll
      for (int j = 0; j < 3; ++j) {
        const int pos = n * 64 + rbase - 3 + j;
        const unsigned v = (pos >= 0) ? raw[mat][j] : 0u;
        xa[j] = bf_lo(v); xb[j] = bf_hi(v);
      }
      u16* dst = (mat == 0 ? Qs : (mat == 1 ? Ks : Vs));
#pragma unroll
      for (int i = 0; i < 16; ++i) {
        const unsigned v = raw[mat][3 + i];
        const float a3 = bf_lo(v), b3 = bf_hi(v);
        const float ya = wa[0] * xa[0] + wa[1] * xa[1] + wa[2] * xa[2] + wa[3] * a3;
        const float yb = wb[0] * xb[0] + wb[1] * xb[1] + wb[2] * xb[2] + wb[3] * b3;
        xa[0] = xa[1]; xa[1] = xa[2]; xa[2] = a3; xb[0] = xb[1]; xb[1] = xb[2]; xb[2] = b3;
        *(unsigned*)(dst + (rbase + i) * 136 + 2 * c2) = pk_bf16(silu_f(ya), silu_f(yb));
      }
    }
  }
  __syncthreads();
  if (wv == 0) {
    const float bl = hb_bl, al = hb_al;
    const float xx = al + p.dt_bias[hd];
    const float ee = __expf(-fabsf(xx));
    const float sp = fmaxf(xx, 0.f) + ((ee < 1e-3f) ? ee * (1.f - 0.5f * ee) : __logf(1.f + ee));
    float gg = -__expf(p.a_log[hd]) * sp;
#pragma unroll
    for (int o = 1; o < 64; o <<= 1) { const float t = __uint_as_float((unsigned)__builtin_amdgcn_ds_bpermute(((lane - o) & 63) << 2, (int)__float_as_uint(gg))); if (lane >= o) gg += t; }
    sm_beta[lane] = rcp_f(1.0f + __expf(-bl)); sm_gc[lane] = gg;
  } else if (wv <= 2) {
    const int r = tid - 64;
    const u16* src = (r < 64) ? (Qs + r * 136) : (Ks + (r - 64) * 136);
    float ss = 0.f;
#pragma unroll
    for (int c = 0; c < 16; ++c) {
      const u32x4 v = *(const u32x4*)(src + c * 8);
#pragma unroll
      for (int j = 0; j < 4; ++j) { const float a = bf_lo(v[j]), bb = bf_hi(v[j]); ss += a * a + bb * bb; }
    }
    const float rs = rsqrtf(ss + 1e-6f);
    if (r < 64) sm_rq[r] = rs; else sm_rk[r - 64] = rs;
  }
  __syncthreads();
  if (tid < 64) {
    const float gc = sm_gc[tid], gl = sm_gc[63], eg = __expf(gc);
    sm_fw[tid] = sm_beta[tid] * eg * sm_rk[tid];
    sm_fq[tid] = sm_rq[tid] * 0.08838834764831845f * eg;
    sm_fk[tid] = sm_rk[tid] * __expf(gl - gc);
    if (tid == 0) ((float*)(p.ws + OFF_DEC))[item] = __expf(gl);
  }
  {
    bf16x8 kfi[4], qfi[4];
#pragma unroll
    for (int s = 0; s < 4; ++s) {
      kfi[s] = *(const bf16x8*)(Ks + (16 * wv + r16) * 136 + 32 * s + 8 * g);
      qfi[s] = *(const bf16x8*)(Qs + (16 * wv + r16) * 136 + 32 * s + 8 * g);
    }
    f32x4 at[4];
#pragma unroll
    for (int jt = 0; jt < 4; ++jt) {
      at[jt] = (f32x4){0.f, 0.f, 0.f, 0.f};
      if (jt <= wv) {
        f32x4 la = (f32x4){0.f, 0.f, 0.f, 0.f}, aa = (f32x4){0.f, 0.f, 0.f, 0.f};
#pragma unroll
        for (int s = 0; s < 4; ++s) {
          const bf16x8 kfj = *(const bf16x8*)(Ks + (16 * jt + r16) * 136 + 32 * s + 8 * g);
          la = mfma16(kfi[s], kfj, la);
          aa = mfma16(kfj, qfi[s], aa);
        }
#pragma unroll
        for (int r = 0; r < 4; ++r) {
          { const int i = 16 * wv + 4 * g + r, j = 16 * jt + r16;
            const float v = (i > j) ? sm_beta[i] * sm_rk[i] * sm_rk[j] * __expf(sm_gc[i] - sm_gc[j]) * la[r] : 0.f;
            Lm[i * 68 + j] = v; }
          { const int j = 16 * jt + 4 * g + r, i = 16 * wv + r16;
            at[jt][r] = (j <= i) ? sm_rq[i] * sm_rk[j] * 0.08838834764831845f * __expf(sm_gc[i] - sm_gc[j]) * aa[r] : 0.f; }
        }
      }
    }
#pragma unroll
    for (int s2 = 0; s2 < 2; ++s2)
      *(bf16x8*)(op + 32768 + (size_t)((wv * 2 + s2) * 64 + lane) * 16) = pack8(at[2 * s2], at[2 * s2 + 1]);
  }
  __syncthreads();
  f32x2_t xv[64];
  if (wv < 2) {
#pragma unroll
    for (int i = 0; i < 64; ++i) { xv[i].x = sm_beta[i] * bf2f(Vs[i * 136 + tid]); xv[i].y = sm_fw[i] * bf2f(Ks[i * 136 + tid]); }
    solve_rows2<1>(xv, Lm, lane, Lm[68 + lane]);
    const int sl = tid >> 4, dvl = tid & 15;
#pragma unroll
    for (int mt = 0; mt < 4; ++mt)
#pragma unroll
      for (int gg = 0; gg < 4; ++gg) {
        u32x2 w; w.x = pk_bf16(xv[16 * mt + 4 * gg].x, xv[16 * mt + 4 * gg + 1].x); w.y = pk_bf16(xv[16 * mt + 4 * gg + 2].x, xv[16 * mt + 4 * gg + 3].x);
        *(u32x2*)(op + 57344 + (size_t)((sl * 4 + mt) * 64 + gg * 16 + dvl) * 8) = w;
      }
  } else {
    const int t2 = tid - 128;
#pragma unroll 2
    for (int f = 0; f < 8; ++f) {
      const int e = t2 + 128 * f, frag = e >> 6, ln = e & 63, lr = ln & 15, lg = ln >> 4;
      {
        const int mt = frag >> 2, sx = frag & 3, row = 16 * mt + lr;
        const u32x2 ql = *(const u32x2*)(Qs + row * 136 + 32 * sx + 4 * lg), qh = *(const u32x2*)(Qs + row * 136 + 32 * sx + 16 + 4 * lg);
        const float fq = sm_fq[row];
        u32x4 w;
        w.x = pk_bf16(bf_lo(ql.x) * fq, bf_hi(ql.x) * fq); w.y = pk_bf16(bf_lo(ql.y) * fq, bf_hi(ql.y) * fq);
        w.z = pk_bf16(bf_lo(qh.x) * fq, bf_hi(qh.x) * fq); w.w = pk_bf16(bf_lo(qh.y) * fq, bf_hi(qh.y) * fq);
        *(u32x4*)(op + 16384 + (size_t)e * 16) = w;
      }
      {
        const int mt8 = frag >> 1, s2 = frag & 1, dk = 16 * mt8 + lr;
        float v[8];
#pragma unroll
        for (int j = 0; j < 8; ++j) {
          const int pos = 32 * s2 + 16 * (j >> 2) + 4 * lg + (j & 3);
          v[j] = bf2f(Ks[pos * 136 + dk]) * sm_fk[pos];
        }
        u32x4 w; w.x = pk_bf16(v[0], v[1]); w.y = pk_bf16(v[2], v[3]); w.z = pk_bf16(v[4], v[5]); w.w = pk_bf16(v[6], v[7]);
        *(u32x4*)(op + 40960 + (size_t)e * 16) = w;
      }
    }
  }
  __syncthreads();
  if (wv < 2) {
#pragma unroll
    for (int i = 0; i < 64; ++i) Vs[i * 136 + tid] = f2bf(-xv[i].y);
  }
  __syncthreads();
#pragma unroll
  for (int f = 0; f < 4; ++f) {
    const int e = tid + 256 * f, frag = e >> 6, ln = e & 63, lr = ln & 15, lg = ln >> 4;
    const int mt = frag >> 2, sx = frag & 3, row = 16 * mt + lr;
    const u32x2 lo = *(const u32x2*)(Vs + row * 136 + 32 * sx + 4 * lg), hi = *(const u32x2*)(Vs + row * 136 + 32 * sx + 16 + 4 * lg);
    *(u32x4*)(op + (size_t)e * 16) = (u32x4){lo.x, lo.y, hi.x, hi.y};
  }
}

struct ScanA { u32x4 wf[4]; u32x2 uf; float dec; };
struct ScanB { u32x4 qf[4], af[2], kf[4]; };

DI void scan_load_a(const Params& p, int wvs, ScanA& o, int b, int hd, int sl, int n, int q, int lane) {
  const int item = (b * 128 + n) * 4 + hd;
  const unsigned char* op = p.ws + OFF_SC + (size_t)item * OPB;
#pragma unroll
  for (int s = 0; s < 4; ++s) {
    o.wf[s] = *(const u32x4*)(op + (size_t)((q * 4 + s) * 64 + lane) * 16);
  }
  o.uf = *(const u32x2*)(op + 57344 + (size_t)((sl * 4 + q) * 64 + lane) * 8);
  o.dec = ((const float*)(p.ws + OFF_DEC))[item];
}
DI void scan_load_b(const Params& p, int wvs, ScanB& o, int b, int hd, int n, int q, int lane) {
  const int item = (b * 128 + n) * 4 + hd;
  const unsigned char* op = p.ws + OFF_SC + (size_t)item * OPB;
#pragma unroll
  for (int s = 0; s < 4; ++s) o.qf[s] = *(const u32x4*)(op + 16384 + (size_t)((q * 4 + s) * 64 + lane) * 16);
#pragma unroll
  for (int s2 = 0; s2 < 2; ++s2) o.af[s2] = *(const u32x4*)(op + 32768 + (size_t)((q * 2 + s2) * 64 + lane) * 16);
#pragma unroll
  for (int j = 0; j < 4; ++j) o.kf[j] = *(const u32x4*)(op + 40960 + (size_t)((q * 4 + j) * 64 + lane) * 16);
}

DI void scan_step(const Params& p, int wvs, const ScanA& o, const ScanB& ob, f32x4 (&S)[2], int b, int hd, int sl, int n, int q, int lane, unsigned char* smem) {
  const int r16 = lane & 15, g = lane >> 4;
  u32x4* ldsS = (u32x4*)smem;
  u32x2* ldsV = (u32x2*)(smem + 4096);
  ldsS[q * 64 + lane] = __builtin_bit_cast(u32x4, pack8(S[0], S[1]));
  __syncthreads();
  bf16x8 Sb[4];
#pragma unroll
  for (int s = 0; s < 4; ++s) Sb[s] = as_bf8(ldsS[s * 64 + lane]);
  f32x4 vn = (f32x4){bf_lo(o.uf.x), bf_hi(o.uf.x), bf_lo(o.uf.y), bf_hi(o.uf.y)};
#pragma unroll
  for (int s = 0; s < 4; ++s) vn = mfma16(as_bf8(o.wf[s]), Sb[s], vn);
  { u32x2 w; w.x = pk_bf16(vn[0], vn[1]); w.y = pk_bf16(vn[2], vn[3]); ldsV[((q >> 1) * 64 + lane) * 2 + (q & 1)] = w; }
  f32x4 oa = (f32x4){0.f, 0.f, 0.f, 0.f};
#pragma unroll
  for (int s = 0; s < 4; ++s) oa = mfma16(as_bf8(ob.qf[s]), Sb[s], oa);
  __syncthreads();
  bf16x8 Vb[2];
#pragma unroll
  for (int s2 = 0; s2 < 2; ++s2) Vb[s2] = as_bf8(*(const u32x4*)(ldsV + (s2 * 64 + lane) * 2));
#pragma unroll
  for (int s2 = 0; s2 < 2; ++s2) oa = mfma16(as_bf8(ob.af[s2]), Vb[s2], oa);
  u16* h = (u16*)(p.ws + OFF_H);
  const int t0 = b * SEQ + n * 64;
#pragma unroll
  for (int r = 0; r < 4; ++r) h[(size_t)(t0 + 16 * q + 4 * g + r) * NC + hd * 128 + 16 * sl + r16] = f2bf(oa[r]);
#pragma unroll
  for (int t = 0; t < 2; ++t) {
    S[t] = S[t] * o.dec;
#pragma unroll
    for (int s2 = 0; s2 < 2; ++s2) S[t] = mfma16(as_bf8(ob.kf[t * 2 + s2]), Vb[s2], S[t]);
  }
}

DI void scan_chain(const Params& p, int wvs, int pair, int sl, unsigned char* smem) {
  const int tid0 = opaque_tid(); const int lane = tid0 & 63, q = tid0 >> 6;
  const int b = pair >> 2, hd = pair & 3;
  f32x4 S[2]; S[0] = (f32x4){0.f, 0.f, 0.f, 0.f}; S[1] = S[0];
  ScanA a0, a1, a2; ScanB bc, bn;
  __syncthreads();
  scan_load_a(p, wvs, a0, b, hd, sl, 0, q, lane);
  scan_load_b(p, wvs, bc, b, hd, 0, q, lane);
  scan_load_a(p, wvs, a1, b, hd, sl, 1, q, lane);
#pragma unroll 1
  for (int n = 0; n < 129; n += 3) {
    if (n + 2 < 128) scan_load_a(p, wvs, a2, b, hd, sl, n + 2, q, lane);
    if (n + 1 < 128) scan_load_b(p, wvs, bn, b, hd, n + 1, q, lane);
    if (n < 128) scan_step(p, wvs, a0, bc, S, b, hd, sl, n, q, lane, smem);
    bc = bn;
    if (n + 3 < 128) scan_load_a(p, wvs, a0, b, hd, sl, n + 3, q, lane);
    if (n + 2 < 128) scan_load_b(p, wvs, bn, b, hd, n + 2, q, lane);
    if (n + 1 < 128) scan_step(p, wvs, a1, bc, S, b, hd, sl, n + 1, q, lane, smem);
    bc = bn;
    if (n + 4 < 128) scan_load_a(p, wvs, a1, b, hd, sl, n + 4, q, lane);
    if (n + 3 < 128) scan_load_b(p, wvs, bn, b, hd, n + 3, q, lane);
    if (n + 2 < 128) scan_step(p, wvs, a2, bc, S, b, hd, sl, n + 2, q, lane, smem);
    bc = bn;
  }
}

DI void swa_item(const Params& p, int wvs, int item, bool valid, unsigned char* smem) {
  if (!valid) { __syncthreads(); __syncthreads(); return; }
  const int tid_ = opaque_tid();
  const int tid = tid_, lane = tid & 63, wv = tid >> 6, r16 = lane & 15, g = lane >> 4;
  const int qt = item & 127, kvh = (item >> 7) & 1, b = item >> 8;
  const int kp0 = 64 * qt - 128;
  u16* Ksm = (u16*)smem;
  u16* Vt = (u16*)(smem + 27648);
  u16* h = (u16*)(p.ws + OFF_H);
  const float* rc = (const float*)(p.ws + OFF_ROPE); const float* rs = rc + 8192 * 8;
  __syncthreads();
  if (tid < 192) {
    const int kk = tid, pos = kp0 + kk;
    u32x4 lo = (u32x4){0, 0, 0, 0}, hi = lo;
    if (pos >= 0) {
      const u16* src = h + (size_t)(b * SEQ + pos) * NC + C_SWK + kvh * 64;
      const u32x4 a = *(const u32x4*)src, c = *(const u32x4*)(src + 8);
      const f32x4 c0 = *(const f32x4*)(rc + pos * 8), c1 = *(const f32x4*)(rc + pos * 8 + 4);
      const f32x4 s0 = *(const f32x4*)(rs + pos * 8), s1 = *(const f32x4*)(rs + pos * 8 + 4);
      float t1[8], t2[8], cs[8], sn[8], o1[8], o2[8];
#pragma unroll
      for (int j = 0; j < 4; ++j) { t1[2 * j] = bf_lo(a[j]); t1[2 * j + 1] = bf_hi(a[j]); t2[2 * j] = bf_lo(c[j]); t2[2 * j + 1] = bf_hi(c[j]);
        cs[j] = c0[j]; cs[4 + j] = c1[j]; sn[j] = s0[j]; sn[4 + j] = s1[j]; }
#pragma unroll
      for (int j = 0; j < 8; ++j) { o1[j] = t1[j] * cs[j] - t2[j] * sn[j]; o2[j] = t2[j] * cs[j] + t1[j] * sn[j]; }
#pragma unroll
      for (int j = 0; j < 4; ++j) { lo[j] = pk_bf16(o1[2 * j], o1[2 * j + 1]); hi[j] = pk_bf16(o2[2 * j], o2[2 * j + 1]); }
    }
    *(u32x4*)(Ksm + kk * 72) = lo; *(u32x4*)(Ksm + kk * 72 + 8) = hi;
  }
  for (int e = tid; e < 192 * 6; e += 256) {
    const int kk = e / 6, ch = 2 + e % 6, pos = kp0 + kk;
    u32x4 v = (u32x4){0, 0, 0, 0};
    if (pos >= 0) v = *(const u32x4*)(h + (size_t)(b * SEQ + pos) * NC + C_SWK + kvh * 64 + ch * 8);
    *(u32x4*)(Ksm + kk * 72 + ch * 8) = v;
  }
  for (int e = tid; e < 192 * 8; e += 256) {
    const int kk = e >> 3, ch = e & 7, pos = kp0 + kk;
    u32x4 v = (u32x4){0, 0, 0, 0};
    if (pos >= 0) v = *(const u32x4*)(h + (size_t)(b * SEQ + pos) * NC + C_SWV + kvh * 64 + ch * 8);
#pragma unroll
    for (int j = 0; j < 4; ++j) { Vt[(ch * 8 + 2 * j) * 200 + kk] = (u16)(v[j] & 0xffffu); Vt[(ch * 8 + 2 * j + 1) * 200 + kk] = (u16)(v[j] >> 16); }
  }
  __syncthreads();
  const int st = wv, jt0 = st < 2 ? st : 2;
  const int qi = 16 * st + r16;
  const int qpos = 64 * qt + qi, tq = b * SEQ + qpos;
#pragma unroll 1
  for (int hq = 0; hq < 4; ++hq) {
    const int head = kvh * 4 + hq;
    u16* qsrc = h + (size_t)tq * NC + C_SWQ + head * 64;
    bf16x8 qf[2];
    {
      const u32x4 a = *(const u32x4*)qsrc, c = *(const u32x4*)(qsrc + 8);
      u32x4 w = *(const u32x4*)(qsrc + 8 * g);
      if (g < 2) {
        const f32x4 c0 = *(const f32x4*)(rc + qpos * 8), c1 = *(const f32x4*)(rc + qpos * 8 + 4);
        const f32x4 s0 = *(const f32x4*)(rs + qpos * 8), s1 = *(const f32x4*)(rs + qpos * 8 + 4);
        float t1[8], t2[8], cs[8], sn[8], o[8];
#pragma unroll
        for (int j = 0; j < 4; ++j) { t1[2 * j] = bf_lo(a[j]); t1[2 * j + 1] = bf_hi(a[j]); t2[2 * j] = bf_lo(c[j]); t2[2 * j + 1] = bf_hi(c[j]);
          cs[j] = c0[j]; cs[4 + j] = c1[j]; sn[j] = s0[j]; sn[4 + j] = s1[j]; }
#pragma unroll
        for (int j = 0; j < 8; ++j) o[j] = (g == 0) ? (t1[j] * cs[j] - t2[j] * sn[j]) : (t2[j] * cs[j] + t1[j] * sn[j]);
#pragma unroll
        for (int j = 0; j < 4; ++j) w[j] = pk_bf16(o[2 * j], o[2 * j + 1]);
      }
      qf[0] = as_bf8(w);
      qf[1] = as_bf8(*(const u32x4*)(qsrc + 32 + 8 * g));
    }
    f32x4 sc[10];
#pragma unroll
    for (int t = 0; t < 10; ++t) {
      sc[t] = (f32x4){0.f, 0.f, 0.f, 0.f};
#pragma unroll
      for (int s = 0; s < 2; ++s) {
        const bf16x8 kf = *(const bf16x8*)(Ksm + (16 * (jt0 + t) + r16) * 72 + 32 * s + 8 * g);
        sc[t] = mfma16(kf, qf[s], sc[t]);
      }
    }
    const float sink = p.sinks[head];
    float mx = sink;
#pragma unroll
    for (int t = 0; t < 10; ++t)
#pragma unroll
      for (int r = 0; r < 4; ++r) {
        const int kk = 16 * (jt0 + t) + 4 * g + r, d = kk - qi;
        const bool ok = (d >= 1) && (d <= 128) && (kp0 + kk >= 0);
        const float v = ok ? sc[t][r] * 0.125f : -1e30f;
        sc[t][r] = v; mx = fmaxf(mx, v);
      }
    mx = fmaxf(mx, shx(mx, 16, lane)); mx = fmaxf(mx, shx(mx, 32, lane));
    float sum = 0.f;
#pragma unroll
    for (int t = 0; t < 10; ++t)
#pragma unroll
      for (int r = 0; r < 4; ++r) { const float e = __expf(sc[t][r] - mx); sc[t][r] = e; sum += e; }
    sum += shx(sum, 16, lane); sum += shx(sum, 32, lane);
    const float inv = rcp_f(sum + __expf(sink - mx));
    f32x4 oacc[4];
#pragma unroll
    for (int dt = 0; dt < 4; ++dt) oacc[dt] = (f32x4){0.f, 0.f, 0.f, 0.f};
#pragma unroll
    for (int s2 = 0; s2 < 5; ++s2) {
      const bf16x8 pb = pack8(sc[2 * s2], sc[2 * s2 + 1]);
#pragma unroll
      for (int dt = 0; dt < 4; ++dt) {
        const u16* vr = Vt + (16 * dt + r16) * 200 + 16 * (jt0 + 2 * s2) + 4 * g;
        const u32x2 lo = *(const u32x2*)vr, hi = *(const u32x2*)(vr + 16);
        oacc[dt] = mfma16(as_bf8((u32x4){lo.x, lo.y, hi.x, hi.y}), pb, oacc[dt]);
      }
    }
#pragma unroll
    for (int dt = 0; dt < 4; ++dt) {
      const int dcol = head * 64 + 16 * dt + 4 * g;
      const u32x2 z = *(const u32x2*)(h + (size_t)tq * NC + C_SWZ + dcol);
      u32x2 w;
      w.x = pk_bf16(oacc[dt][0] * inv * silu_f(bf_lo(z.x)), oacc[dt][1] * inv * silu_f(bf_hi(z.x)));
      w.y = pk_bf16(oacc[dt][2] * inv * silu_f(bf_lo(z.y)), oacc[dt][3] * inv * silu_f(bf_hi(z.y)));
      *(u32x2*)(h + (size_t)tq * NC + C_SWQ + dcol) = w;
    }
  }
}

DI void phase_ya(const Params& p, int wvs) {
  u16* h = (u16*)(p.ws + OFF_H);
  const int ltid = opaque_tid(), lane = ltid & 63;
  const size_t gt = (size_t)blockIdx.x * 512 + ltid, gs = (size_t)gridDim.x * 512;
  const float* nwp = p.dn_norm_w + (ltid & 15) * 8;
  const f32x4 nw0 = *(const f32x4*)nwp, nw1 = *(const f32x4*)(nwp + 4);
  for (size_t i0 = gt; i0 < (size_t)T_TOK * 64; i0 += 4 * gs) {
    u32x4 v[4], z[4];
#pragma unroll
    for (int k = 0; k < 4; ++k) {
      const size_t i = i0 + k * gs;
      if (i < (size_t)T_TOK * 64) {
        const u16* ptr = h + (size_t)(i >> 6) * NC + (i & 63) * 8;
        v[k] = *(const u32x4*)ptr; z[k] = *(const u32x4*)(ptr + C_DNZ);
      } else { v[k] = (u32x4){0, 0, 0, 0}; z[k] = v[k]; }
    }
#pragma unroll
    for (int k = 0; k < 4; ++k) {
      const size_t i = i0 + k * gs;
      float o[8]; float ss = 0.f;
#pragma unroll
      for (int j = 0; j < 4; ++j) { o[2 * j] = bf_lo(v[k][j]); o[2 * j + 1] = bf_hi(v[k][j]); }
#pragma unroll
      for (int j = 0; j < 8; ++j) ss += o[j] * o[j];
      ss += shx(ss, 1, lane); ss += shx(ss, 2, lane); ss += shx(ss, 4, lane); ss += shx(ss, 8, lane);
      const float rs = rsqrtf(ss * (1.0f / 128.0f) + 1e-6f);
      float y[8];
#pragma unroll
      for (int j = 0; j < 4; ++j) {
        const float w0 = (j < 2) ? nw0[2 * j] : nw1[2 * j - 4], w1 = (j < 2) ? nw0[2 * j + 1] : nw1[2 * j - 3];
        y[2 * j] = o[2 * j] * rs * w0 * silu_f(bf_lo(z[k][j]));
        y[2 * j + 1] = o[2 * j + 1] * rs * w1 * silu_f(bf_hi(z[k][j]));
      }
      u32x4 w; w.x = pk_bf16(y[0], y[1]); w.y = pk_bf16(y[2], y[3]); w.z = pk_bf16(y[4], y[5]); w.w = pk_bf16(y[6], y[7]);
      if (i < (size_t)T_TOK * 64) *(u32x4*)(h + (size_t)(i >> 6) * NC + (i & 63) * 8) = w;
    }
  }
}

DI float wave_sum(float v, int lane) {
#pragma unroll
  for (int o = 32; o > 0; o >>= 1) v += shx(v, o, lane);
  return v;
}
DI void phase6(const Params& p, int wvs, unsigned char* smem) {
  const int tid = opaque_tid(), lane = tid & 63, wv = tid >> 6;
  f32x4 gm[4], bt[4];
#pragma unroll
  for (int j = 0; j < 4; ++j) { gm[j] = *(const f32x4*)(p.ln_g + 4 * (lane + 64 * j)); bt[j] = *(const f32x4*)(p.ln_b + 4 * (lane + 64 * j)); }
  const int xcd6 = blockIdx.x & 7, lb6 = blockIdx.x >> 3, nlb6 = gridDim.x >> 3;
  for (int lr = (lb6 * 8 + wv) * 2; lr < 4096; lr += nlb6 * 16) {
    const int row0 = 4096 * xcd6 + (4095 - lr), row1 = row0 - 1;
    float* r0 = p.out + (size_t)row0 * 1024;
    float* r1 = p.out + (size_t)row1 * 1024;
    const _Float16* s0 = (const _Float16*)(p.ws + OFF_H) + (size_t)row0 * 1024;
    const _Float16* s1 = (const _Float16*)(p.ws + OFF_H) + (size_t)row1 * 1024;
    f32x4 a[4], b[4];
#pragma unroll
    for (int j = 0; j < 4; ++j) {
      a[j] = __builtin_convertvector(*(const f16x4*)(s0 + 4 * (lane + 64 * j)), f32x4);
      b[j] = __builtin_convertvector(*(const f16x4*)(s1 + 4 * (lane + 64 * j)), f32x4);
    }
    float sa = 0.f, sb = 0.f;
#pragma unroll
    for (int j = 0; j < 4; ++j) { sa += (a[j][0] + a[j][1]) + (a[j][2] + a[j][3]); sb += (b[j][0] + b[j][1]) + (b[j][2] + b[j][3]); }
    const float ma = wave_sum(sa, lane) * (1.0f / 1024.0f), mb = wave_sum(sb, lane) * (1.0f / 1024.0f);
    float qa = 0.f, qb = 0.f;
#pragma unroll
    for (int j = 0; j < 4; ++j) {
      a[j] = a[j] - ma; b[j] = b[j] - mb;
      qa += (a[j][0] * a[j][0] + a[j][1] * a[j][1]) + (a[j][2] * a[j][2] + a[j][3] * a[j][3]);
      qb += (b[j][0] * b[j][0] + b[j][1] * b[j][1]) + (b[j][2] * b[j][2] + b[j][3] * b[j][3]);
    }
    const float ra = rsqrtf(wave_sum(qa, lane) * (1.0f / 1024.0f) + 1e-5f), rb = rsqrtf(wave_sum(qb, lane) * (1.0f / 1024.0f) + 1e-5f);
#pragma unroll
    for (int j = 0; j < 4; ++j) {
      *(f32x4*)(r0 + 4 * (lane + 64 * j)) = a[j] * ra * gm[j] + bt[j];
      *(f32x4*)(r1 + 4 * (lane + 64 * j)) = b[j] * rb * gm[j] + bt[j];
    }
  }
}

#define XB_TMO      128
#define XB_XCNT(j)  (256  + 64 * (j))
#define XB_XSUB(j)  (1280 + 64 * (j))
#define XB_XGEN(j)  (2304 + 64 * (j))
#define XB_TOP      3328
#define XB_TOPGEN   3392
#define XCD_BAR_WORDS 3456
#define XB_SPIN_CAP (1u << 22)
#define LAS __attribute__((address_space(3)))
DI unsigned xb_ld(unsigned* p) { return __hip_atomic_load(p, __ATOMIC_RELAXED, __HIP_MEMORY_SCOPE_AGENT); }
DI unsigned xb_add(unsigned* p, unsigned v) { return __hip_atomic_fetch_add(p, v, __ATOMIC_RELAXED, __HIP_MEMORY_SCOPE_AGENT); }
DI unsigned xb_xcc_id() { return (unsigned)__builtin_amdgcn_s_getreg((3 << 11) | 20) & 0xFu; }
#define XB_SPIN(cond, bar) do { unsigned _sp = 0; while (cond) { __builtin_amdgcn_s_sleep(1); \
    if ((++_sp & 255u) == 0u) { if (xb_ld(&(bar)[XB_TMO])) break; if (_sp > XB_SPIN_CAP) { atomicAdd(&(bar)[XB_TMO], 1u); break; } } } } while (0)
struct XcdBarrier { unsigned* bar; unsigned x; volatile LAS unsigned* st; };
DI bool xb_leader(int wvs) { return wvs == 0 && __builtin_amdgcn_mbcnt_hi(~0u, __builtin_amdgcn_mbcnt_lo(~0u, 0u)) == 0u; }
DI XcdBarrier xcd_barrier_post(unsigned* bar, volatile LAS unsigned* st, int wvs) {
  XcdBarrier b; b.bar = bar; b.x = xb_xcc_id(); b.st = st;
  if (xb_leader(wvs)) (void)xb_add(&bar[XB_XCNT(b.x)], 1u);
  return b;
}
DI void xcd_barrier_complete(unsigned* bar, unsigned x, unsigned& nloc, unsigned& nx) {
  const unsigned G = gridDim.x * gridDim.y * gridDim.z;
  unsigned sum, cnt, mine, sp = 0u;
  for (;;) {
    sum = 0u; cnt = 0u; mine = 0u;
#pragma unroll
    for (unsigned j = 0; j < 16; ++j) { const unsigned c = xb_ld(&bar[XB_XCNT(j)]); sum += c; cnt += (c > 0u) ? 1u : 0u; mine = (j == x) ? c : mine; }
    if (sum == G) break;
    __builtin_amdgcn_s_sleep(1);
    if ((++sp & 255u) == 0u) { if (xb_ld(&bar[XB_TMO])) break; if (sp > XB_SPIN_CAP) { atomicAdd(&bar[XB_TMO], 1u); break; } }
  }
  nloc = mine > 0u ? mine : 1u; nx = cnt > 0u ? cnt : 1u;
}
DI void xcd_barrier_(const XcdBarrier& b, int wvs) {
  asm volatile("s_waitcnt vmcnt(0)" ::: "memory");
  __syncthreads();
  if (xb_leader(wvs)) {
    unsigned* bar = b.bar;
    __builtin_amdgcn_s_waitcnt(0);
    unsigned nloc = b.st[0], nx = b.st[1];
    if (nloc == 0u) { xcd_barrier_complete(bar, b.x, nloc, nx); b.st[0] = nloc; b.st[1] = nx; }
    const unsigned old = xb_add(&bar[XB_XSUB(b.x)], 1u);
    const unsigned gen = old / nloc;
    if (old + 1u == (gen + 1u) * nloc) {
      __builtin_amdgcn_fence(__ATOMIC_RELEASE, "agent");
      asm volatile("s_waitcnt vmcnt(0)" ::: "memory");
      const unsigned og = xb_add(&bar[XB_TOP], 1u);
      const unsigned tg = og / nx;
      if (og + 1u == (tg + 1u) * nx) xb_add(&bar[XB_TOPGEN], 1u);
      else XB_SPIN(xb_ld(&bar[XB_TOPGEN]) == tg, bar);
      __builtin_amdgcn_fence(__ATOMIC_ACQUIRE, "agent");
      xb_add(&bar[XB_XGEN(b.x)], 1u);
      asm volatile("s_waitcnt vmcnt(0)" ::: "memory");
    } else {
      XB_SPIN(xb_ld(&bar[XB_XGEN(b.x)]) == gen, bar);
      __builtin_amdgcn_fence(__ATOMIC_ACQUIRE, "agent");
      asm volatile("s_waitcnt vmcnt(0)" ::: "memory");
    }
  }
  __syncthreads();
}

#define xcd_barrier(b) xcd_barrier_(b, w8)
namespace pg8 {
#define PG8_LAS __attribute__((address_space(3)))
typedef unsigned short bf16_t;
typedef short bf16x8 __attribute__((ext_vector_type(8)));
typedef float f32x4 __attribute__((ext_vector_type(4)));
typedef unsigned u32x4 __attribute__((ext_vector_type(4)));
constexpr int BM = 256, BK = 64, HALF = 128, HTB = HALF * BK * 2  , STAGE_BYTES = 8 * HTB, NXCD = 8, WGM = 8;

__host__ __device__ __forceinline__ int lds_byte(int r, int c) { const int st = (r >> 4) * 2 + (c >> 5), rr = r & 15, cc = c & 31, ob = rr * 64 + cc * 2; return st * 1024 + (ob ^ (((ob >> 9) & 1) << 5)); }
__host__ __device__ __forceinline__ void stage_rc(int b, int& R, int& C) { const int st = b / 1024, sb = b % 1024, swz = sb ^ (((sb >> 9) & 1) << 5); R = (st >> 1) * 16 + swz / 64; C = (st & 1) * 32 + (swz % 64) / 2; }
__host__ __device__ __forceinline__ int perm32(int rho) { const int n = rho >> 4, i = rho & 15; return 8 * (i >> 2) + 4 * n + (i & 3); }

struct Unit { int pm, pn; };
struct Gemm { const bf16_t* A; const bf16_t* Bt; int M, N, K; };

struct StaticOrder {
    int nM, nN, nwg, G, c;
    __host__ __device__ void init(int M, int N, int G_, int c_) { nM = M / BM; nN = N / BM; nwg = nM * nN; G = G_; c = c_; }
    __host__ __device__ bool next(int i, Unit& u) const {
        const long L = (long)i * G + c; if (L >= nwg) return false;
        int wgid = (int)L; { const int q = nwg / NXCD, r = nwg % NXCD, xcd = wgid % NXCD, off = wgid / NXCD; wgid = (xcd < r ? xcd * (q + 1) : r * (q + 1) + (xcd - r) * q) + off; }
        const int nig = WGM * nN, gid = wgid / nig, fm = gid * WGM, gsz = (nM - fm) < WGM ? (nM - fm) : WGM;
        u.pm = fm + ((wgid % nig) % gsz); u.pn = (wgid % nig) / gsz; return true;
    }
    __device__ __forceinline__ void a_ready(const Unit&) const {}
    __device__ __forceinline__ void done(const Unit&) const {}
};

template <class Epi, class Sched, bool ALIGN_EPI = false, bool SP2 = false>
__device__ __forceinline__ void gemm_phase(PG8_LAS unsigned char* lds, const Gemm g, const Sched& S, const Epi& E, const int tid) {
    const int wid = __builtin_amdgcn_readfirstlane(tid >> 6), lane = tid & 63, wr = wid >> 2, wc = wid & 3, fr = lane & 15, fq = lane >> 4;
    const int K = g.K, nt = K / BK;
    unsigned voffA[2], voffB[2];
#pragma unroll
    for (int i = 0; i < 2; ++i) { int R, C; stage_rc(tid * 16 + i * 8192, R, C); const int Rb = Epi::PERM ? ((R & ~31) + perm32(R & 31)) : R;
        voffA[i] = (unsigned)(R * K + C) * 2u; voffB[i] = (unsigned)(Rb * K + C) * 2u; }
    const size_t kstep = (size_t)(BK * 2);
    const size_t hstep = (size_t)HALF * K * 2;
    const size_t tstep = 2 * hstep;
    const unsigned ldsw = (unsigned)wid * 1024u;
    const int aoff = lds_byte(wr * 64 + fr, fq * 8), boff = lds_byte(wc * 32 + fr, fq * 8);
#define PG8_SA(b, h) (((b) * 2 + (h)) * HTB)
#define PG8_SB(b, h) ((4 + (b) * 2 + (h)) * HTB)
#define PG8_STAGE(bufoff, gbase, voff) do { _Pragma("unroll") for (int _i = 0; _i < 2; ++_i) \
        __builtin_amdgcn_global_load_lds((const unsigned*)((const char*)(gbase) + (voff)[_i]), (PG8_LAS unsigned*)(lds + (bufoff) + ldsw + _i * 8192), 16, 0, 0); } while (0)
#define PG8_LDA(dst, b, h) do { _Pragma("unroll") for (int m = 0; m < 4; ++m) _Pragma("unroll") for (int k = 0; k < 2; ++k) dst[m][k] = *(const PG8_LAS bf16x8*)(lds + PG8_SA(b, h) + aoff + m * 2048 + k * 1024); } while (0)
#define PG8_LDB(dst, b, h) do { _Pragma("unroll") for (int n = 0; n < 2; ++n) _Pragma("unroll") for (int k = 0; k < 2; ++k) dst[n][k] = *(const PG8_LAS bf16x8*)(lds + PG8_SB(b, h) + boff + n * 2048 + k * 1024); } while (0)
#define PG8_MMA(ai, bj, At, Bt) do { __builtin_amdgcn_s_setprio(1); _Pragma("unroll") for (int m = 0; m < 4; ++m) _Pragma("unroll") for (int n = 0; n < 2; ++n) _Pragma("unroll") for (int k = 0; k < 2; ++k) \
        acc[ai][bj][m][n] = __builtin_amdgcn_mfma_f32_16x16x32_bf16(Bt[n][k], At[m][k], acc[ai][bj][m][n], 0, 0, 0); __builtin_amdgcn_s_setprio(0); } while (0)
#define PG8_WAIT_V(n) asm volatile("s_waitcnt vmcnt(" #n ")" ::: "memory")
#define PG8_WAIT_L(n) asm volatile("s_waitcnt lgkmcnt(" #n ")" ::: "memory")
#define PG8_BAR __builtin_amdgcn_s_barrier()
#define PG8_SCHED __builtin_amdgcn_sched_barrier(0)
    Unit cur, nxt; int ui = 0;
    if (!S.next(0, cur)) return;
    f32x4 acc[2][2][4][2];
#pragma unroll
    for (int a = 0; a < 2; ++a)
#pragma unroll
        for (int b = 0; b < 2; ++b)
#pragma unroll
            for (int m = 0; m < 4; ++m)
#pragma unroll
                for (int n = 0; n < 2; ++n) acc[a][b][m][n] = (f32x4){0.f, 0.f, 0.f, 0.f};
    bf16x8 At[4][2], B0[2][2], B1[2][2];
    const char* cA = (const char*)g.A + (size_t)cur.pm * tstep; const char* cB = (const char*)g.Bt + (size_t)cur.pn * tstep;
    S.a_ready(cur);
    if constexpr (SP2) {
        PG8_STAGE(PG8_SB(0, 0), cB, voffB); PG8_STAGE(PG8_SB(0, 1), cB + hstep, voffB); PG8_STAGE(PG8_SA(0, 0), cA, voffA); PG8_STAGE(PG8_SA(0, 1), cA + hstep, voffA);
        if (wr == 1) PG8_BAR;
        PG8_WAIT_V(2); PG8_BAR;
        PG8_STAGE(PG8_SB(1, 0), cB + kstep, voffB); PG8_STAGE(PG8_SA(1, 0), cA + kstep, voffA); PG8_STAGE(PG8_SB(1, 1), cB + hstep + kstep, voffB);
        PG8_WAIT_V(6); PG8_BAR;
    } else {
        PG8_STAGE(PG8_SB(0, 0), cB, voffB); PG8_STAGE(PG8_SA(0, 0), cA, voffA); PG8_STAGE(PG8_SB(0, 1), cB + hstep, voffB); PG8_STAGE(PG8_SA(0, 1), cA + hstep, voffA);
        if (wr == 1) PG8_BAR;
        PG8_WAIT_V(4); PG8_BAR;
        PG8_STAGE(PG8_SB(1, 0), cB + kstep, voffB); PG8_STAGE(PG8_SA(1, 0), cA + kstep, voffA); PG8_STAGE(PG8_SB(1, 1), cB + hstep + kstep, voffB);
        PG8_WAIT_V(6); PG8_BAR;
    }
    for (;;) {
        const bool has_next = S.next(ui + 1, nxt);
        const char* nA = has_next ? (const char*)g.A + (size_t)nxt.pm * tstep : cA; const char* nB = has_next ? (const char*)g.Bt + (size_t)nxt.pn * tstep : cB;
        for (int t = 0; t < nt; t += 2) {
            const bool last = (t == nt - 2);
            const char* a1 = cA + (size_t)(t + 1) * kstep;
            const char* a2 = last ? nA : cA + (size_t)(t + 2) * kstep; const char* b2 = last ? nB : cB + (size_t)(t + 2) * kstep;
            const char* a3 = a2 + kstep; const char* b3 = b2 + kstep;
            if (last && has_next) S.a_ready(nxt);
            if constexpr (SP2) {
            PG8_LDB(B0, 0, 0); PG8_LDB(B1, 0, 1); PG8_SCHED; PG8_LDA(At, 0, 0); PG8_STAGE(PG8_SA(1, 1), a1 + hstep, voffA);
            PG8_WAIT_V(8); PG8_WAIT_L(0); PG8_BAR; PG8_MMA(0, 0, At, B0); PG8_MMA(0, 1, At, B1); PG8_BAR; PG8_SCHED;
            PG8_LDA(At, 0, 1); PG8_STAGE(PG8_SB(0, 0), b2, voffB); PG8_STAGE(PG8_SB(0, 1), b2 + hstep, voffB); PG8_STAGE(PG8_SA(0, 0), a2, voffA);
            PG8_WAIT_V(8); PG8_WAIT_L(0); PG8_BAR; PG8_MMA(1, 0, At, B0); PG8_MMA(1, 1, At, B1); PG8_BAR; PG8_SCHED;
            PG8_LDB(B0, 1, 0); PG8_LDB(B1, 1, 1); PG8_SCHED; PG8_LDA(At, 1, 0); PG8_STAGE(PG8_SA(0, 1), a2 + hstep, voffA);
            PG8_WAIT_V(8); PG8_WAIT_L(0); PG8_BAR; PG8_MMA(0, 0, At, B0); PG8_MMA(0, 1, At, B1); PG8_BAR; PG8_SCHED;
            PG8_LDA(At, 1, 1); PG8_STAGE(PG8_SB(1, 0), b3, voffB); PG8_STAGE(PG8_SB(1, 1), b3 + hstep, voffB); PG8_STAGE(PG8_SA(1, 0), a3, voffA);
            PG8_WAIT_V(8); PG8_WAIT_L(0); PG8_BAR; PG8_MMA(1, 0, At, B0); PG8_MMA(1, 1, At, B1); PG8_BAR; PG8_SCHED;
            } else {
            PG8_LDB(B0, 0, 0); PG8_SCHED; PG8_LDA(At, 0, 0); PG8_STAGE(PG8_SA(1, 1), a1 + hstep, voffA);
            PG8_WAIT_L(8); PG8_BAR; PG8_WAIT_L(0); PG8_MMA(0, 0, At, B0); PG8_BAR; PG8_SCHED;
            PG8_LDB(B1, 0, 1); PG8_STAGE(PG8_SB(0, 0), b2, voffB);
            PG8_BAR; PG8_WAIT_L(0); PG8_MMA(0, 1, At, B1); PG8_BAR;
            PG8_LDA(At, 0, 1); PG8_STAGE(PG8_SA(0, 0), a2, voffA);
            PG8_BAR; PG8_WAIT_L(0); PG8_MMA(1, 0, At, B0); PG8_BAR; PG8_SCHED;
            PG8_STAGE(PG8_SB(0, 1), b2 + hstep, voffB);
            PG8_WAIT_V(6); PG8_BAR; PG8_MMA(1, 1, At, B1); PG8_BAR;
            PG8_LDB(B0, 1, 0); PG8_SCHED; PG8_LDA(At, 1, 0); PG8_STAGE(PG8_SA(0, 1), a2 + hstep, voffA);
            PG8_WAIT_L(8); PG8_BAR; PG8_WAIT_L(0); PG8_MMA(0, 0, At, B0); PG8_BAR; PG8_SCHED;
            PG8_LDB(B1, 1, 1); PG8_STAGE(PG8_SB(1, 0), b3, voffB);
            PG8_BAR; PG8_WAIT_L(0); PG8_MMA(0, 1, At, B1); PG8_BAR;
            PG8_LDA(At, 1, 1); PG8_STAGE(PG8_SA(1, 0), a3, voffA);
            PG8_BAR; PG8_WAIT_L(0); PG8_MMA(1, 0, At, B0); PG8_BAR; PG8_SCHED;
            PG8_STAGE(PG8_SB(1, 1), b3 + hstep, voffB);
            PG8_WAIT_V(6); PG8_BAR; PG8_MMA(1, 1, At, B1); PG8_BAR;
            }
        }
        if constexpr (ALIGN_EPI) { if (wr == 0) PG8_BAR; }
        if constexpr (!Epi::AFTER_DRAIN) { E(acc, cur, wr, wc, fr, fq); S.done(cur); }
        if (!has_next) break;
#pragma unroll
        for (int a = 0; a < 2; ++a)
#pragma unroll
            for (int b = 0; b < 2; ++b)
#pragma unroll
                for (int m = 0; m < 4; ++m)
#pragma unroll
                    for (int n = 0; n < 2; ++n) acc[a][b][m][n] = (f32x4){0.f, 0.f, 0.f, 0.f};
        cur = nxt; cA = nA; cB = nB; ++ui;
        if constexpr (ALIGN_EPI) { if (wr == 1) PG8_BAR; }
    }
    PG8_WAIT_V(0);
    if constexpr (!ALIGN_EPI) { if (wr == 0) PG8_BAR; }
    PG8_BAR;
    if constexpr (Epi::AFTER_DRAIN) { E.fused(acc, cur, wr, wc, fr, fq, lds, wid, lane); S.done(cur); }
#undef PG8_SA
#undef PG8_SB
#undef PG8_STAGE
#undef PG8_LDA
#undef PG8_LDB
#undef PG8_MMA
#undef PG8_WAIT_V
#undef PG8_WAIT_L
#undef PG8_BAR
#undef PG8_SCHED
}

struct Unit2 { int pm, pn, part; };
struct Gemm2 { const bf16_t* A0; const bf16_t* A1; const bf16_t* B0; const bf16_t* B1; int lda, K; };
struct StaticOrder2 {
    int nM, nN, nwg, G, c;
    __host__ __device__ void init(int M, int N, int G_, int c_) { nM = M / BM; nN = N / BM; nwg = nM * nN; G = G_; c = c_; }
    __host__ __device__ bool next(int i, Unit2& u) const {
        const long L = (long)(i >> 1) * G + c; if (L >= nwg) return false;
        int wgid = (int)L; { const int q = nwg / NXCD, r = nwg % NXCD, xcd = wgid % NXCD, off = wgid / NXCD; wgid = (xcd < r ? xcd * (q + 1) : r * (q + 1) + (xcd - r) * q) + off; }
        const int nig = WGM * nN, gid = wgid / nig, fm = gid * WGM, gsz = (nM - fm) < WGM ? (nM - fm) : WGM;
        u.pm = fm + ((wgid % nig) % gsz); u.pn = (wgid % nig) / gsz; u.part = i & 1; return true;
    }
    __device__ __forceinline__ void a_ready(const Unit2&) const {}
    __device__ __forceinline__ void done(const Unit2&) const {}
};
template <class Epi, class Sched, bool ALIGN_EPI = false, bool SP2 = false>
__device__ __forceinline__ void gemm_phase2(PG8_LAS unsigned char* lds, const Gemm2 g, const Sched& S, const Epi& E, const int tid) {
    const int wid = __builtin_amdgcn_readfirstlane(tid >> 6), lane = tid & 63, wr = wid >> 2, wc = wid & 3, fr = lane & 15, fq = lane >> 4;
    const int K = g.K, nt = K / BK;
    unsigned voffA[2], voffB[2];
#pragma unroll
    for (int i = 0; i < 2; ++i) { int R, C; stage_rc(tid * 16 + i * 8192, R, C); const int Rb = Epi::PERM ? ((R & ~31) + perm32(R & 31)) : R;
        voffA[i] = (unsigned)(R * g.lda + C) * 2u; voffB[i] = (unsigned)(Rb * K + C) * 2u; }
    const size_t kstep = (size_t)(BK * 2);
    const size_t hstep = (size_t)HALF * K * 2;
    const size_t tstep = 2 * hstep;
    const size_t hstepA = (size_t)HALF * g.lda * 2, tstepA = 2 * hstepA;
    const unsigned ldsw = (unsigned)wid * 1024u;
    const int aoff = lds_byte(wr * 64 + fr, fq * 8), boff = lds_byte(wc * 32 + fr, fq * 8);
#define PG8_SA(b, h) (((b) * 2 + (h)) * HTB)
#define PG8_SB(b, h) ((4 + (b) * 2 + (h)) * HTB)
#define PG8_STAGE(bufoff, gbase, voff) do { _Pragma("unroll") for (int _i = 0; _i < 2; ++_i) \
        __builtin_amdgcn_global_load_lds((const unsigned*)((const char*)(gbase) + (voff)[_i]), (PG8_LAS unsigned*)(lds + (bufoff) + ldsw + _i * 8192), 16, 0, 0); } while (0)
#define PG8_LDA(dst, b, h) do { _Pragma("unroll") for (int m = 0; m < 4; ++m) _Pragma("unroll") for (int k = 0; k < 2; ++k) dst[m][k] = *(const PG8_LAS bf16x8*)(lds + PG8_SA(b, h) + aoff + m * 2048 + k * 1024); } while (0)
#define PG8_LDB(dst, b, h) do { _Pragma("unroll") for (int n = 0; n < 2; ++n) _Pragma("unroll") for (int k = 0; k < 2; ++k) dst[n][k] = *(const PG8_LAS bf16x8*)(lds + PG8_SB(b, h) + boff + n * 2048 + k * 1024); } while (0)
#define PG8_MMA(ai, bj, At, Bt) do { __builtin_amdgcn_s_setprio(1); _Pragma("unroll") for (int m = 0; m < 4; ++m) _Pragma("unroll") for (int n = 0; n < 2; ++n) _Pragma("unroll") for (int k = 0; k < 2; ++k) \
        acc[ai][bj][m][n] = __builtin_amdgcn_mfma_f32_16x16x32_bf16(Bt[n][k], At[m][k], acc[ai][bj][m][n], 0, 0, 0); __builtin_amdgcn_s_setprio(0); } while (0)
#define PG8_WAIT_V(n) asm volatile("s_waitcnt vmcnt(" #n ")" ::: "memory")
#define PG8_WAIT_L(n) asm volatile("s_waitcnt lgkmcnt(" #n ")" ::: "memory")
#define PG8_BAR __builtin_amdgcn_s_barrier()
#define PG8_SCHED __builtin_amdgcn_sched_barrier(0)
    Unit2 cur, nxt; int ui = 0;
    if (!S.next(0, cur)) return;
    f32x4 acc[2][2][4][2];
#pragma unroll
    for (int a = 0; a < 2; ++a)
#pragma unroll
        for (int b = 0; b < 2; ++b)
#pragma unroll
            for (int m = 0; m < 4; ++m)
#pragma unroll
                for (int n = 0; n < 2; ++n) acc[a][b][m][n] = (f32x4){0.f, 0.f, 0.f, 0.f};
    bf16x8 At[4][2], B0[2][2], B1[2][2];
    const char* cA = (const char*)(cur.part ? g.A1 : g.A0) + (size_t)cur.pm * tstepA; const char* cB = (const char*)(cur.part ? g.B1 : g.B0) + (size_t)cur.pn * tstep;
    S.a_ready(cur);
    if constexpr (SP2) {
        PG8_STAGE(PG8_SB(0, 0), cB, voffB); PG8_STAGE(PG8_SB(0, 1), cB + hstep, voffB); PG8_STAGE(PG8_SA(0, 0), cA, voffA); PG8_STAGE(PG8_SA(0, 1), cA + hstepA, voffA);
        if (wr == 1) PG8_BAR;
        PG8_WAIT_V(2); PG8_BAR;
        PG8_STAGE(PG8_SB(1, 0), cB + kstep, voffB); PG8_STAGE(PG8_SA(1, 0), cA + kstep, voffA); PG8_STAGE(PG8_SB(1, 1), cB + hstep + kstep, voffB);
        PG8_WAIT_V(6); PG8_BAR;
    } else {
        PG8_STAGE(PG8_SB(0, 0), cB, voffB); PG8_STAGE(PG8_SA(0, 0), cA, voffA); PG8_STAGE(PG8_SB(0, 1), cB + hstep, voffB); PG8_STAGE(PG8_SA(0, 1), cA + hstepA, voffA);
        if (wr == 1) PG8_BAR;
        PG8_WAIT_V(4); PG8_BAR;
        PG8_STAGE(PG8_SB(1, 0), cB + kstep, voffB); PG8_STAGE(PG8_SA(1, 0), cA + kstep, voffA); PG8_STAGE(PG8_SB(1, 1), cB + hstep + kstep, voffB);
        PG8_WAIT_V(6); PG8_BAR;
    }
    for (;;) {
        const bool has_next = S.next(ui + 1, nxt);
        const char* nA = has_next ? (const char*)(nxt.part ? g.A1 : g.A0) + (size_t)nxt.pm * tstepA : cA; const char* nB = has_next ? (const char*)(nxt.part ? g.B1 : g.B0) + (size_t)nxt.pn * tstep : cB;
        for (int t = 0; t < nt; t += 2) {
            const bool last = (t == nt - 2);
            const char* a1 = cA + (size_t)(t + 1) * kstep;
            const char* a2 = last ? nA : cA + (size_t)(t + 2) * kstep; const char* b2 = last ? nB : cB + (size_t)(t + 2) * kstep;
            const char* a3 = a2 + kstep; const char* b3 = b2 + kstep;
            if (last && has_next) S.a_ready(nxt);
            if constexpr (SP2) {
            PG8_LDB(B0, 0, 0); PG8_LDB(B1, 0, 1); PG8_SCHED; PG8_LDA(At, 0, 0); PG8_STAGE(PG8_SA(1, 1), a1 + hstepA, voffA);
            PG8_WAIT_V(8); PG8_WAIT_L(0); PG8_BAR; PG8_MMA(0, 0, At, B0); PG8_MMA(0, 1, At, B1); PG8_BAR; PG8_SCHED;
            PG8_LDA(At, 0, 1); PG8_STAGE(PG8_SB(0, 0), b2, voffB); PG8_STAGE(PG8_SB(0, 1), b2 + hstep, voffB); PG8_STAGE(PG8_SA(0, 0), a2, voffA);
            PG8_WAIT_V(8); PG8_WAIT_L(0); PG8_BAR; PG8_MMA(1, 0, At, B0); PG8_MMA(1, 1, At, B1); PG8_BAR; PG8_SCHED;
            PG8_LDB(B0, 1, 0); PG8_LDB(B1, 1, 1); PG8_SCHED; PG8_LDA(At, 1, 0); PG8_STAGE(PG8_SA(0, 1), a2 + hstepA, voffA);
            PG8_WAIT_V(8); PG8_WAIT_L(0); PG8_BAR; PG8_MMA(0, 0, At, B0); PG8_MMA(0, 1, At, B1); PG8_BAR; PG8_SCHED;
            PG8_LDA(At, 1, 1); PG8_STAGE(PG8_SB(1, 0), b3, voffB); PG8_STAGE(PG8_SB(1, 1), b3 + hstep, voffB); PG8_STAGE(PG8_SA(1, 0), a3, voffA);
            PG8_WAIT_V(8); PG8_WAIT_L(0); PG8_BAR; PG8_MMA(1, 0, At, B0); PG8_MMA(1, 1, At, B1); PG8_BAR; PG8_SCHED;
            } else {
            PG8_LDB(B0, 0, 0); PG8_SCHED; PG8_LDA(At, 0, 0); PG8_STAGE(PG8_SA(1, 1), a1 + hstepA, voffA);
            PG8_WAIT_L(8); PG8_BAR; PG8_WAIT_L(0); PG8_MMA(0, 0, At, B0); PG8_BAR; PG8_SCHED;
            PG8_LDB(B1, 0, 1); PG8_STAGE(PG8_SB(0, 0), b2, voffB);
            PG8_BAR; PG8_WAIT_L(0); PG8_MMA(0, 1, At, B1); PG8_BAR;
            PG8_LDA(At, 0, 1); PG8_STAGE(PG8_SA(0, 0), a2, voffA);
            PG8_BAR; PG8_WAIT_L(0); PG8_MMA(1, 0, At, B0); PG8_BAR; PG8_SCHED;
            PG8_STAGE(PG8_SB(0, 1), b2 + hstep, voffB);
            PG8_WAIT_V(6); PG8_BAR; PG8_MMA(1, 1, At, B1); PG8_BAR;
            PG8_LDB(B0, 1, 0); PG8_SCHED; PG8_LDA(At, 1, 0); PG8_STAGE(PG8_SA(0, 1), a2 + hstepA, voffA);
            PG8_WAIT_L(8); PG8_BAR; PG8_WAIT_L(0); PG8_MMA(0, 0, At, B0); PG8_BAR; PG8_SCHED;
            PG8_LDB(B1, 1, 1); PG8_STAGE(PG8_SB(1, 0), b3, voffB);
            PG8_BAR; PG8_WAIT_L(0); PG8_MMA(0, 1, At, B1); PG8_BAR;
            PG8_LDA(At, 1, 1); PG8_STAGE(PG8_SA(1, 0), a3, voffA);
            PG8_BAR; PG8_WAIT_L(0); PG8_MMA(1, 0, At, B0); PG8_BAR; PG8_SCHED;
            PG8_STAGE(PG8_SB(1, 1), b3 + hstep, voffB);
            PG8_WAIT_V(6); PG8_BAR; PG8_MMA(1, 1, At, B1); PG8_BAR;
            }
        }
        if constexpr (ALIGN_EPI) { if (wr == 0) PG8_BAR; }
        if (cur.part == 0) E.mid(acc, cur, wr, wc, fr, fq); else E(acc, cur, wr, wc, fr, fq);
        if (!has_next) break;
        if (cur.part == 1) {
#pragma unroll
        for (int a = 0; a < 2; ++a)
#pragma unroll
            for (int b = 0; b < 2; ++b)
#pragma unroll
                for (int m = 0; m < 4; ++m)
#pragma unroll
                    for (int n = 0; n < 2; ++n) acc[a][b][m][n] = (f32x4){0.f, 0.f, 0.f, 0.f};
        }
        cur = nxt; cA = nA; cB = nB; ++ui;
        if constexpr (ALIGN_EPI) { if (wr == 1) PG8_BAR; }
    }
    PG8_WAIT_V(0);
    if constexpr (!ALIGN_EPI) { if (wr == 0) PG8_BAR; }
    PG8_BAR;
#undef PG8_SA
#undef PG8_SB
#undef PG8_STAGE
#undef PG8_LDA
#undef PG8_LDB
#undef PG8_MMA
#undef PG8_WAIT_V
#undef PG8_WAIT_L
#undef PG8_BAR
#undef PG8_SCHED
}
}

struct EpiInProj {
  static constexpr bool PERM = true, AFTER_DRAIN = false;
  u16* h;
  DI void operator()(const f32x4 (&acc)[2][2][4][2], const pg8::Unit& u, int wr, int wc, int fr, int fq) const {
    const int shift = (u.pn >= 8) ? 8 : 0;
#pragma unroll
    for (int ai = 0; ai < 2; ++ai)
#pragma unroll
      for (int m = 0; m < 4; ++m) {
        const int row = u.pm * 256 + ai * 128 + wr * 64 + m * 16 + fr;
#pragma unroll
        for (int bj = 0; bj < 2; ++bj) {
          const int col = u.pn * 256 + bj * 128 + wc * 32 + 8 * fq + shift;
          const f32x4 a = acc[ai][bj][m][0], b = acc[ai][bj][m][1];
          u32x4 w; w.x = pk_bf16(a[0], a[1]); w.y = pk_bf16(a[2], a[3]); w.z = pk_bf16(b[0], b[1]); w.w = pk_bf16(b[2], b[3]);
          *(u32x4*)(h + (size_t)row * NC + col) = w;
        }
      }
  }
};

struct EpiMerge {
  static constexpr bool PERM = true, AFTER_DRAIN = false;
  const u16* h; u16* mg;
  DI void mid(f32x4 (&acc)[2][2][4][2], const pg8::Unit2& u, int wr, int wc, int fr, int fq) const {
#pragma unroll
    for (int ai = 0; ai < 2; ++ai)
#pragma unroll
      for (int m = 0; m < 4; ++m) {
        const int row = u.pm * 256 + ai * 128 + wr * 64 + m * 16 + fr;
#pragma unroll
        for (int bj = 0; bj < 2; ++bj) {
          const int col = u.pn * 256 + bj * 128 + wc * 32 + 8 * fq;
          const u32x4 ga = *(const u32x4*)(h + (size_t)row * NC + C_GA + col), gb = *(const u32x4*)(h + (size_t)row * NC + C_GB + col);
#pragma unroll
          for (int j = 0; j < 4; ++j) {
            const float r0 = (1.f + __expf(-bf_lo(gb[j]))) * rcp_f(1.f + __expf(-bf_lo(ga[j])));
            const float r1 = (1.f + __expf(-bf_hi(gb[j]))) * rcp_f(1.f + __expf(-bf_hi(ga[j])));
            acc[ai][bj][m][j >> 1][2 * (j & 1)] *= r0; acc[ai][bj][m][j >> 1][2 * (j & 1) + 1] *= r1;
          }
        }
        __builtin_amdgcn_sched_barrier(0);
      }
  }
  DI void operator()(const f32x4 (&acc)[2][2][4][2], const pg8::Unit2& u, int wr, int wc, int fr, int fq) const {
#pragma unroll
    for (int ai = 0; ai < 2; ++ai)
#pragma unroll
      for (int m = 0; m < 4; ++m) {
        const int row = u.pm * 256 + ai * 128 + wr * 64 + m * 16 + fr;
#pragma unroll
        for (int bj = 0; bj < 2; ++bj) {
          const int col = u.pn * 256 + bj * 128 + wc * 32 + 8 * fq;
          const u32x4 gb = *(const u32x4*)(h + (size_t)row * NC + C_GB + col);
          const f32x4 a = acc[ai][bj][m][0], b = acc[ai][bj][m][1];
          u32x4 w;
          w.x = pk_bf16(a[0] * sigmoid_f(bf_lo(gb[0])), a[1] * sigmoid_f(bf_hi(gb[0])));
          w.y = pk_bf16(a[2] * sigmoid_f(bf_lo(gb[1])), a[3] * sigmoid_f(bf_hi(gb[1])));
          w.z = pk_bf16(b[0] * sigmoid_f(bf_lo(gb[2])), b[1] * sigmoid_f(bf_hi(gb[2])));
          w.w = pk_bf16(b[2] * sigmoid_f(bf_lo(gb[3])), b[3] * sigmoid_f(bf_hi(gb[3])));
          *(u32x4*)(mg + (size_t)row * 1024 + col) = w;
        }
        __builtin_amdgcn_sched_barrier(0);
      }
  }
};

struct EpiOut {
  static constexpr bool PERM = true, AFTER_DRAIN = false;
  const float* x; _Float16* r16;
  DI void operator()(const f32x4 (&acc)[2][2][4][2], const pg8::Unit& u, int wr, int wc, int fr, int fq) const {
#pragma unroll
    for (int ai = 0; ai < 2; ++ai)
#pragma unroll
      for (int m = 0; m < 4; ++m) {
        const int row = u.pm * 256 + ai * 128 + wr * 64 + m * 16 + fr;
#pragma unroll
        for (int bj = 0; bj < 2; ++bj) {
          const int col = u.pn * 256 + bj * 128 + wc * 32 + 8 * fq;
          const f32x4 x0 = *(const f32x4*)(x + (size_t)row * 1024 + col), x1 = *(const f32x4*)(x + (size_t)row * 1024 + col + 4);
          const f32x4 v0 = x0 * 1.189207115002721f + acc[ai][bj][m][0], v1 = x1 * 1.189207115002721f + acc[ai][bj][m][1];
          const f16x4 h0 = __builtin_convertvector(v0, f16x4), h1 = __builtin_convertvector(v1, f16x4);
          u32x4 w; const u32x2 p0 = __builtin_bit_cast(u32x2, h0), p1 = __builtin_bit_cast(u32x2, h1);
          w.x = p0.x; w.y = p0.y; w.z = p1.x; w.w = p1.y;
          *(u32x4*)(r16 + (size_t)row * 1024 + col) = w;
        }
      }
  }
};

__global__ void __launch_bounds__(512, 2) fwd_megakernel(Params p) {
  cg::grid_group grid = cg::this_grid();
  __shared__ __attribute__((aligned(16))) unsigned char smem[SMEM_BYTES];
  const int w8 = __builtin_amdgcn_readfirstlane((int)(threadIdx.x >> 6));
  const int wvs = w8 & 3, half = w8 >> 2;
  unsigned char* hsm = smem + half * HALF_SMEM;
  const int vb = blockIdx.x + half * gridDim.x, nvb = 2 * gridDim.x;
  volatile LAS unsigned* st = (volatile LAS unsigned*)(smem + SMEM_BYTES - 16);
  { const int t0_ = opaque_tid(); if (t0_ < 4) st[t0_] = 0u; }
  __syncthreads();
  const XcdBarrier xb = xcd_barrier_post((unsigned*)(p.ws + OFF_BAR), st, w8);
  phase0(p, w8);
  if (p.ws == nullptr) grid.sync();
  xcd_barrier(xb);
  {
    pg8::Gemm g; g.A = (const pg8::bf16_t*)(p.ws + OFF_SC); g.Bt = (const pg8::bf16_t*)(p.ws + OFF_WINT); g.M = T_TOK; g.N = NCP; g.K = 1024;
    pg8::StaticOrder so; so.init(T_TOK, NCP, (int)gridDim.x, (int)blockIdx.x);
    EpiInProj e; e.h = (u16*)(p.ws + OFF_H);
    pg8::gemm_phase<EpiInProj, pg8::StaticOrder, true, true>((PG8_LAS unsigned char*)smem, g, so, e, opaque_tid_(w8));
  }
  xcd_barrier(xb);
  for (int it = vb; it < 2048; it += nvb) prep_item(p, wvs, it, hsm);
  xcd_barrier(xb);
  if (blockIdx.x < 128) {
    if (half == 0) { const int cb = (int)blockIdx.x; scan_chain(p, wvs, (cb & 7) + 8 * ((cb >> 3) >> 3), (cb >> 3) & 7, hsm); }
    else {
      const int cb = (int)blockIdx.x, pr = (cb & 7) + 8 * ((cb >> 3) >> 3), slp = (cb >> 3) & 7, bp = pr >> 2, hp = pr & 3;
      const int ft = opaque_tid();
      const unsigned char* pbase = p.ws + OFF_SC + (size_t)(slp * 72 + (ft < 72 ? ft : 0)) * 128;
      unsigned r0 = 0, r1 = 0, r2 = 0, r3 = 0, accp = 0;
      __syncthreads();
      for (int n = 0; n < 128; ++n) {
        accp ^= r3; r3 = r2; r2 = r1; r1 = r0;
        const int np = n + 6 < 128 ? n + 6 : 127;
        r0 = *(const unsigned*)(pbase + (size_t)((bp * 128 + np) * 4 + hp) * OPB);
        __syncthreads(); __syncthreads();
      }
      accp ^= r0 ^ r1 ^ r2 ^ r3;
      if (accp == 0x9e3779b9u && ft == 300) ((unsigned*)(p.ws + OFF_BAR))[XB_TMO + 1] = accp;
    }
  } else {
    const int nsw = 2 * ((int)gridDim.x - 128), vbl = ((int)blockIdx.x - 128) + half * ((int)gridDim.x - 128);
    for (int k = 0; k * nsw < 1024; ++k) { const int it = vbl + k * nsw; swa_item(p, wvs, it < 1024 ? it : 0, it < 1024, hsm); }
  }
  xcd_barrier(xb);
  phase_ya(p, w8);
  xcd_barrier(xb);
  {
    pg8::Gemm2 g; g.A0 = (const pg8::bf16_t*)(p.ws + OFF_H); g.A1 = g.A0 + C_SWQ; g.B0 = (const pg8::bf16_t*)(p.ws + OFF_WAT); g.B1 = (const pg8::bf16_t*)(p.ws + OFF_WBT);
    g.lda = NC; g.K = 512;
    pg8::StaticOrder2 so; so.init(T_TOK, 1024, (int)gridDim.x, (int)blockIdx.x);
    EpiMerge e; e.h = (const u16*)(p.ws + OFF_H); e.mg = (u16*)(p.ws + OFF_SC);
    pg8::gemm_phase2<EpiMerge, pg8::StaticOrder2, true, true>((PG8_LAS unsigned char*)smem, g, so, e, opaque_tid_(w8));
  }
  xcd_barrier(xb);
  {
    pg8::Gemm g; g.A = (const pg8::bf16_t*)(p.ws + OFF_SC); g.Bt = (const pg8::bf16_t*)(p.ws + OFF_WOT); g.M = T_TOK; g.N = 1024; g.K = 1024;
    pg8::StaticOrder so; so.init(T_TOK, 1024, (int)gridDim.x, (int)blockIdx.x);
    EpiOut e; e.x = p.x; e.r16 = (_Float16*)(p.ws + OFF_H);
    pg8::gemm_phase<EpiOut, pg8::StaticOrder, true, true>((PG8_LAS unsigned char*)smem, g, so, e, opaque_tid_(w8));
  }
  xcd_barrier(xb);
  phase6(p, w8, smem);
}

extern "C" void kernel_launch(void* const* d_in, const int* in_sizes, int n_in, void* d_out, int out_size,
                              void* d_ws, size_t ws_size, hipStream_t stream) {
  if (ws_size < WS_NEED) { fprintf(stderr, "workspace too small: %zu < %zu\n", ws_size, (size_t)WS_NEED); return; }
  Params p{};
  p.x = (const float*)d_in[0]; p.w_in = (const float*)d_in[1]; p.conv_w = (const float*)d_in[2]; p.a_log = (const float*)d_in[3];
  p.dt_bias = (const float*)d_in[4]; p.dn_norm_w = (const float*)d_in[5]; p.sinks = (const float*)d_in[6];
  p.w_branch = (const float*)d_in[7]; p.w_out = (const float*)d_in[8]; p.ln_g = (const float*)d_in[9]; p.ln_b = (const float*)d_in[10];
  p.out = (float*)d_out; p.ws = (unsigned char*)d_ws;
  for (int i = 0; i < 8; ++i) p.inv_freq[i] = (float)std::pow(500000.0, -(double)i / 8.0);
  static int grid_blocks = 0;
  if (!grid_blocks) {
    int dev = 0, cus = 0, per_cu = 0;
    (void)hipGetDevice(&dev);
    (void)hipDeviceGetAttribute(&cus, hipDeviceAttributeMultiprocessorCount, dev);
    (void)hipOccupancyMaxActiveBlocksPerMultiprocessor(&per_cu, fwd_megakernel, 512, 0);
    if (per_cu < 1) fprintf(stderr, "occupancy query reports %d workgroups per CU\n", per_cu);
    grid_blocks = cus > 256 ? 256 : cus;
    grid_blocks &= ~7;
  }
  (void)hipMemsetAsync(p.ws + OFF_BAR, 0, BAR_BYTES, stream);
  void* args[] = {&p};
  hipError_t e = hipLaunchCooperativeKernel((void*)fwd_megakernel, dim3(grid_blocks), dim3(512), args, 0, stream);
  if (e != hipSuccess) fprintf(stderr, "cooperative launch failed: %s (grid %d)\n", hipGetErrorString(e), grid_blocks);
}
```

```cpp
#include <hip/hip_runtime.h>
#include <hip/hip_cooperative_groups.h>
#include <cstdio>
#include <cmath>
namespace cg = cooperative_groups;

typedef unsigned short u16;
typedef short bf16x8 __attribute__((ext_vector_type(8)));
typedef float f32x4 __attribute__((ext_vector_type(4)));
typedef unsigned u32x4 __attribute__((ext_vector_type(4)));
typedef unsigned u32x2 __attribute__((ext_vector_type(2)));
typedef _Float16 f16x4 __attribute__((ext_vector_type(4)));
#define DI __device__ __forceinline__
DI int opaque_tid_(int wave_s) { int t; asm volatile("v_mbcnt_lo_u32_b32 %0, -1, 0\n\tv_mbcnt_hi_u32_b32 %0, -1, %0" : "=v"(t)); return t + (wave_s << 6); }
#define opaque_tid() opaque_tid_(wvs)

constexpr int T_TOK = 32768, SEQ = 8192, DM = 1024, NC = 5384, NCP = 5376;
constexpr int C_DNZ = 1536, C_SWQ = 2056, C_SWK = 2568, C_SWV = 2696, C_SWZ = 2824, C_GA = 3336, C_GB = 4360;
constexpr size_t OFF_BAR = 0;
constexpr size_t BAR_BYTES = 16384;
constexpr size_t OFF_WINT = BAR_BYTES;
constexpr size_t OFF_WAT = OFF_WINT + (size_t)NCP * 1024 * 2;
constexpr size_t OFF_WBT = OFF_WAT + 1024 * 512 * 2;
constexpr size_t OFF_WOT = OFF_WBT + 1024 * 512 * 2;
constexpr size_t OFF_ROPE = OFF_WOT + 1024 * 1024 * 2;
constexpr size_t OFF_HB = OFF_ROPE + 2 * 8192 * 8 * 4;
constexpr size_t OFF_DEC = OFF_HB + (size_t)T_TOK * 8 * 4;
constexpr size_t OFF_H = OFF_DEC + 2048 * 4;
constexpr size_t OFF_SC = OFF_H + (size_t)T_TOK * NC * 2;
constexpr size_t OPB = 73728;
constexpr size_t WS_NEED = OFF_SC + 2048 * OPB;
constexpr int HALF_SMEM = 73728;
constexpr int SMEM_BYTES = 2 * HALF_SMEM + 16;

struct Params {
  const float *x, *w_in, *conv_w, *a_log, *dt_bias, *dn_norm_w, *sinks, *w_branch, *w_out, *ln_g, *ln_b;
  float* out; unsigned char* ws;
  float inv_freq[8];
};

typedef __bf16 bf16x2_t __attribute__((ext_vector_type(2)));
typedef float f32x2_t __attribute__((ext_vector_type(2)));
DI unsigned pk_bf16(float lo, float hi) { f32x2_t f = {lo, hi}; bf16x2_t v = __builtin_convertvector(f, bf16x2_t); return __builtin_bit_cast(unsigned, v); }
DI float bf_lo(unsigned u) { return __uint_as_float(u << 16); }
DI float bf_hi(unsigned u) { return __uint_as_float(u & 0xffff0000u); }
DI float bf2f(u16 v) { return __uint_as_float(((unsigned)v) << 16); }
DI u16 f2bf(float f) { return (u16)(pk_bf16(f, f) & 0xffffu); }
DI float shx(float v, int m, int lane) { return __uint_as_float((unsigned)__builtin_amdgcn_ds_bpermute((lane ^ m) << 2, (int)__float_as_uint(v))); }
DI float rcp_f(float y) { return __builtin_amdgcn_rcpf(y); }
DI float silu_f(float y) { return y * rcp_f(1.0f + __expf(-y)); }
DI float sigmoid_f(float y) { return rcp_f(1.0f + __expf(-y)); }
DI f32x4 mfma16(bf16x8 a, bf16x8 b, f32x4 c) { return __builtin_amdgcn_mfma_f32_16x16x32_bf16(a, b, c, 0, 0, 0); }
DI bf16x8 as_bf8(u32x4 v) { return __builtin_bit_cast(bf16x8, v); }
DI bf16x8 pack8(f32x4 a, f32x4 b) { u32x4 w; w.x = pk_bf16(a[0], a[1]); w.y = pk_bf16(a[2], a[3]); w.z = pk_bf16(b[0], b[1]); w.w = pk_bf16(b[2], b[3]); return as_bf8(w); }

DI void phase0(const Params& p, int wvs) {
  const size_t gt = (size_t)blockIdx.x * 512 + opaque_tid(), gs = (size_t)gridDim.x * 512;
  {
    const int ltid = (int)(gt & 511), lane = ltid & 63, wv = ltid >> 6;
    float wr[16][8];
#pragma unroll
    for (int j = 0; j < 4; ++j)
#pragma unroll
      for (int c = 0; c < 4; ++c) {
        const float* wp = p.w_in + (size_t)(4 * (lane + 64 * j) + c) * NC + 2048;
        const f32x4 a = *(const f32x4*)wp, b = *(const f32x4*)(wp + 4);
#pragma unroll
        for (int q = 0; q < 4; ++q) { wr[4 * j + c][q] = a[q]; wr[4 * j + c][4 + q] = b[q]; }
      }
    u16* xb = (u16*)(p.ws + OFF_SC);
    float* hb = (float*)(p.ws + OFF_HB);
    const int rstep = gridDim.x * 8;
    for (int row0 = blockIdx.x * 8 + wv; row0 < T_TOK; row0 += 2 * rstep) {
      f32x4 xr[2][4];
#pragma unroll
      for (int u = 0; u < 2; ++u) {
        const int row = row0 + u * rstep;
#pragma unroll
        for (int j = 0; j < 4; ++j) xr[u][j] = (row < T_TOK) ? *(const f32x4*)(p.x + (size_t)row * DM + 4 * (lane + 64 * j)) : (f32x4){0.f, 0.f, 0.f, 0.f};
      }
#pragma unroll
      for (int u = 0; u < 2; ++u) {
        const int row = row0 + u * rstep;
        float v[8];
#pragma unroll
        for (int q = 0; q < 8; ++q) v[q] = 0.f;
#pragma unroll
        for (int j = 0; j < 4; ++j) {
          const f32x4 xv = xr[u][j];
          u32x2 w; w.x = pk_bf16(xv[0], xv[1]); w.y = pk_bf16(xv[2], xv[3]);
          if (row < T_TOK) *(u32x2*)(xb + (size_t)row * DM + 4 * (lane + 64 * j)) = w;
#pragma unroll
          for (int c = 0; c < 4; ++c)
#pragma unroll
            for (int q = 0; q < 8; ++q) v[q] += xv[c] * wr[4 * j + c][q];
        }
        const bool up = (lane & 32) != 0;
        float k4[4];
#pragma unroll
        for (int i = 0; i < 4; ++i) { const float snd = up ? v[i] : v[i + 4]; const float kp = up ? v[i + 4] : v[i]; k4[i] = kp + shx(snd, 32, lane); }
        const bool up2 = (lane & 16) != 0;
        float k2[2];
#pragma unroll
        for (int i = 0; i < 2; ++i) { const float snd = up2 ? k4[i] : k4[i + 2]; const float kp = up2 ? k4[i + 2] : k4[i]; k2[i] = kp + shx(snd, 16, lane); }
        const bool up3 = (lane & 8) != 0;
        float k1 = (up3 ? k2[1] : k2[0]) + shx(up3 ? k2[0] : k2[1], 8, lane);
        k1 += shx(k1, 4, lane); k1 += shx(k1, 2, lane); k1 += shx(k1, 1, lane);
        if ((lane & 7) == 0 && row < T_TOK) hb[(size_t)row * 8 + (lane >> 3)] = k1;
      }
    }
  }
  {
    u32x4* wt = (u32x4*)(p.ws + OFF_WINT);
    for (size_t i = gt; i < (size_t)NCP * 128; i += gs) {
      const int kc = (int)(i / NCP), n = (int)(i % NCP);
      float v[8];
#pragma unroll
      for (int j = 0; j < 8; ++j) v[j] = p.w_in[(size_t)(kc * 8 + j) * NC + n + (n >= 2048 ? 8 : 0)];
      u32x4 w; w.x = pk_bf16(v[0], v[1]); w.y = pk_bf16(v[2], v[3]); w.z = pk_bf16(v[4], v[5]); w.w = pk_bf16(v[6], v[7]);
      wt[(size_t)n * 128 + kc] = w;
    }
  }
  {
    for (size_t i = gt; i < (size_t)2 * 1024 * 64; i += gs) {
      const int br = (int)(i / (1024 * 64)), rem = (int)(i % (1024 * 64)), kc = rem / 1024, n = rem % 1024;
      const float* src = p.w_branch + (size_t)br * 512 * 1024;
      float v[8];
#pragma unroll
      for (int j = 0; j < 8; ++j) v[j] = src[(size_t)(kc * 8 + j) * 1024 + n];
      u32x4 w; w.x = pk_bf16(v[0], v[1]); w.y = pk_bf16(v[2], v[3]); w.z = pk_bf16(v[4], v[5]); w.w = pk_bf16(v[6], v[7]);
      ((u32x4*)(p.ws + (br ? OFF_WBT : OFF_WAT)))[(size_t)n * 64 + kc] = w;
    }
  }
  {
    for (size_t i = gt; i < (size_t)1024 * 128; i += gs) {
      const int kc = (int)(i / 1024), n = (int)(i % 1024);
      float v[8];
#pragma unroll
      for (int j = 0; j < 8; ++j) v[j] = p.w_out[(size_t)(kc * 8 + j) * 1024 + n];
      u32x4 w; w.x = pk_bf16(v[0], v[1]); w.y = pk_bf16(v[2], v[3]); w.z = pk_bf16(v[4], v[5]); w.w = pk_bf16(v[6], v[7]);
      ((u32x4*)(p.ws + OFF_WOT))[(size_t)n * 128 + kc] = w;
    }
  }
  {
    float* rc = (float*)(p.ws + OFF_ROPE); float* rs = rc + 8192 * 8;
    for (size_t i = gt; i < 8192 * 8; i += gs) {
      const int t = (int)(i >> 3), f = (int)(i & 7);
      const float ang = (float)t * p.inv_freq[f];
      const double a = (double)ang;
      const double k = __builtin_rint(a * 0.15915494309189535);
      const float r = (float)(a - k * 6.283185307179586);
      rc[i] = cosf(r); rs[i] = sinf(r);
    }
  }
}

template <int I> DI void solve_rows2(f32x2_t (&xv)[64], const float* Lm, int lane, float lcur) {
  if constexpr (I < 64) {
    float lnx = 0.f;
    if constexpr (I + 1 < 64) lnx = Lm[(I + 1) * 68 + lane];
    f32x2_t a0 = xv[I], a1 = {0.f, 0.f}, a2 = {0.f, 0.f}, a3 = {0.f, 0.f};
#pragma unroll
    for (int m = 0; m < I; ++m) {
      const float l = __builtin_bit_cast(float, __builtin_amdgcn_readlane(__builtin_bit_cast(int, lcur), m));
      const f32x2_t lv = {l, l};
      if ((m & 3) == 0) a0 -= lv * xv[m];
      else if ((m & 3) == 1) a1 -= lv * xv[m];
      else if ((m & 3) == 2) a2 -= lv * xv[m];
      else a3 -= lv * xv[m];
    }
    xv[I] = (a0 + a1) + (a2 + a3);
    solve_rows2<I + 1>(xv, Lm, lane, lnx);
  }
}

DI void prep_item(const Params& p, int wvs, int item, unsigned char* smem) {
  const int tid_ = opaque_tid();
  const int tid = tid_, lane = tid & 63, wv = tid >> 6, r16 = lane & 15, g = lane >> 4;
  const int hd = item & 3, n = (item >> 2) & 127, b = item >> 9;
  const int t0 = b * SEQ + n * 64;
  u16* Qs = (u16*)smem; u16* Ks = Qs + 64 * 136; u16* Vs = Ks + 64 * 136;
  float* Lm = (float*)(smem + 52224);
  float* sm_beta = (float*)(smem + 69632);
  float* sm_gc = sm_beta + 64; float* sm_rq = sm_gc + 64; float* sm_rk = sm_rq + 64;
  float* sm_fw = sm_rk + 64; float* sm_fq = sm_fw + 64; float* sm_fk = sm_fq + 64;
  const u16* h = (const u16*)(p.ws + OFF_H);
  const float* hb = (const float*)(p.ws + OFF_HB);
  unsigned char* op = p.ws + OFF_SC + (size_t)item * OPB;
  __syncthreads();
  float hb_bl, hb_al;
  {
    const int c2 = tid & 63, rbase = (tid >> 6) * 16;
    unsigned raw[3][19];
#pragma unroll
    for (int mat = 0; mat < 3; ++mat) {
      const int col = mat * 512 + hd * 128 + 2 * c2;
#pragma unroll
      for (int j = 0; j < 19; ++j) {
        const int rr = t0 + rbase - 3 + j;
        raw[mat][j] = *(const unsigned*)(h + (size_t)(rr < 0 ? 0 : rr) * NC + col);
      }
    }
    float2 cw[3][4];
#pragma unroll
    for (int mat = 0; mat < 3; ++mat)
#pragma unroll
      for (int j = 0; j < 4; ++j) cw[mat][j] = *(const float2*)(p.conv_w + j * 1536 + mat * 512 + hd * 128 + 2 * c2);
    hb_bl = hb[(size_t)(t0 + lane) * 8 + hd]; hb_al = hb[(size_t)(t0 + lane) * 8 + 4 + hd];
    __builtin_amdgcn_sched_barrier(0);
#pragma unroll
    for (int mat = 0; mat < 3; ++mat) {
      float wa[4], wb[4];
#pragma unroll
      for (int j = 0; j < 4; ++j) { wa[j] = cw[mat][j].x; wb[j] = cw[mat][j].y; }
      float xa[3], xb[3];
#pragma unroll
      for (int j = 0; j < 3; ++j) {
        const int pos = n * 64 + rbase - 3 + j;
        const unsigned v = (pos >= 0) ? raw[mat][j] : 0u;
        xa[j] = bf_lo(v); xb[j] = bf_hi(v);
      }
      u16* dst = (mat == 0 ? Qs : (mat == 1 ? Ks : Vs));
#pragma unroll
      for (int i = 0; i < 16; ++i) {
        const unsigned v = raw[mat][3 + i];
        const float a3 = bf_lo(v), b3 = bf_hi(v);
        const float ya = wa[0] * xa[0] + wa[1] * xa[1] + wa[2] * xa[2] + wa[3] * a3;
        const float yb = wb[0] * xb[0] + wb[1] * xb[1] + wb[2] * xb[2] + wb[3] * b3;
        xa[0] = xa[1]; xa[1] = xa[2]; xa[2] = a3; xb[0] = xb[1]; xb[1] = xb[2]; xb[2] = b3;
        *(unsigned*)(dst + (rbase + i) * 136 + 2 * c2) = pk_bf16(silu_f(ya), silu_f(yb));
      }
    }
  }
  __syncthreads();
  if (wv == 0) {
    const float bl = hb_bl, al = hb_al;
    const float xx = al + p.dt_bias[hd];
    const float ee = __expf(-fabsf(xx));
    const float sp = fmaxf(xx, 0.f) + ((ee < 1e-3f) ? ee * (1.f - 0.5f * ee) : __logf(1.f + ee));
    float gg = -__expf(p.a_log[hd]) * sp;
#pragma unroll
    for (int o = 1; o < 64; o <<= 1) { const float t = __uint_as_float((unsigned)__builtin_amdgcn_ds_bpermute(((lane - o) & 63) << 2, (int)__float_as_uint(gg))); if (lane >= o) gg += t; }
    sm_beta[lane] = rcp_f(1.0f + __expf(-bl)); sm_gc[lane] = gg;
  } else if (wv <= 2) {
    const int r = tid - 64;
    const u16* src = (r < 64) ? (Qs + r * 136) : (Ks + (r - 64) * 136);
    float ss = 0.f;
#pragma unroll
    for (int c = 0; c < 16; ++c) {
      const u32x4 v = *(const u32x4*)(src + c * 8);
#pragma unroll
      for (int j = 0; j < 4; ++j) { const float a = bf_lo(v[j]), bb = bf_hi(v[j]); ss += a * a + bb * bb; }
    }
    const float rs = rsqrtf(ss + 1e-6f);
    if (r < 64) sm_rq[r] = rs; else sm_rk[r - 64] = rs;
  }
  __syncthreads();
  if (tid < 64) {
    const float gc = sm_gc[tid], gl = sm_gc[63], eg = __expf(gc);
    sm_fw[tid] = sm_beta[tid] * eg * sm_rk[tid];
    sm_fq[tid] = sm_rq[tid] * 0.08838834764831845f * eg;
    sm_fk[tid] = sm_rk[tid] * __expf(gl - gc);
    if (tid == 0) ((float*)(p.ws + OFF_DEC))[item] = __expf(gl);
  }
  {
    bf16x8 kfi[4], qfi[4];
#pragma unroll
    for (int s = 0; s < 4; ++s) {
      kfi[s] = *(const bf16x8*)(Ks + (16 * wv + r16) * 136 + 32 * s + 8 * g);
      qfi[s] = *(const bf16x8*)(Qs + (16 * wv + r16) * 136 + 32 * s + 8 * g);
    }
    f32x4 at[4];
#pragma unroll
    for (int jt = 0; jt < 4; ++jt) {
      at[jt] = (f32x4){0.f, 0.f, 0.f, 0.f};
      if (jt <= wv) {
        f32x4 la = (f32x4){0.f, 0.f, 0.f, 0.f}, aa = (f32x4){0.f, 0.f, 0.f, 0.f};
#pragma unroll
        for (int s = 0; s < 4; ++s) {
          const bf16x8 kfj = *(const bf16x8*)(Ks + (16 * jt + r16) * 136 + 32 * s + 8 * g);
          la = mfma16(kfi[s], kfj, la);
          aa = mfma16(kfj, qfi[s], aa);
        }
#pragma unroll
        for (int r = 0; r < 4; ++r) {
          { const int i = 16 * wv + 4 * g + r, j = 16 * jt + r16;
            const float v = (i > j) ? sm_beta[i] * sm_rk[i] * sm_rk[j] * __expf(sm_gc[i] - sm_gc[j]) * la[r] : 0.f;
            Lm[i * 68 + j] = v; }
          { const int j = 16 * jt + 4 * g + r, i = 16 * wv + r16;
            at[jt][r] = (j <= i) ? sm_rq[i] * sm_rk[j] * 0.08838834764831845f * __expf(sm_gc[i] - sm_gc[j]) * aa[r] : 0.f; }
        }
      }
    }
#pragma unroll
    for (int s2 = 0; s2 < 2; ++s2)
      *(bf16x8*)(op + 32768 + (size_t)((wv * 2 + s2) * 64 + lane) * 16) = pack8(at[2 * s2], at[2 * s2 + 1]);
  }
  __syncthreads();
  f32x2_t xv[64];
  if (wv < 2) {
#pragma unroll
    for (int i = 0; i < 64; ++i) { xv[i].x = sm_beta[i] * bf2f(Vs[i * 136 + tid]); xv[i].y = sm_fw[i] * bf2f(Ks[i * 136 + tid]); }
    solve_rows2<1>(xv, Lm, lane, Lm[68 + lane]);
    const int sl = tid >> 4, dvl = tid & 15;
#pragma unroll
    for (int mt = 0; mt < 4; ++mt)
#pragma unroll
      for (int gg = 0; gg < 4; ++gg) {
        u32x2 w; w.x = pk_bf16(xv[16 * mt + 4 * gg].x, xv[16 * mt + 4 * gg + 1].x); w.y = pk_bf16(xv[16 * mt + 4 * gg + 2].x, xv[16 * mt + 4 * gg + 3].x);
        *(u32x2*)(op + 57344 + (size_t)((sl * 4 + mt) * 64 + gg * 16 + dvl) * 8) = w;
      }
  } else {
    const int t2 = tid - 128;
#pragma unroll 2
    for (int f = 0; f < 8; ++f) {
      const int e = t2 + 128 * f, frag = e >> 6, ln = e & 63, lr = ln & 15, lg = ln >> 4;
      {
        const int mt = frag >> 2, sx = frag & 3, row = 16 * mt + lr;
        const u32x2 ql = *(const u32x2*)(Qs + row * 136 + 32 * sx + 4 * lg), qh = *(const u32x2*)(Qs + row * 136 + 32 * sx + 16 + 4 * lg);
        const float fq = sm_fq[row];
        u32x4 w;
        w.x = pk_bf16(bf_lo(ql.x) * fq, bf_hi(ql.x) * fq); w.y = pk_bf16(bf_lo(ql.y) * fq, bf_hi(ql.y) * fq);
        w.z = pk_bf16(bf_lo(qh.x) * fq, bf_hi(qh.x) * fq); w.w = pk_bf16(bf_lo(qh.y) * fq, bf_hi(qh.y) * fq);
        *(u32x4*)(op + 16384 + (size_t)e * 16) = w;
      }
      {
        const int mt8 = frag >> 1, s2 = frag & 1, dk = 16 * mt8 + lr;
        float v[8];
#pragma unroll
        for (int j = 0; j < 8; ++j) {
          const int pos = 32 * s2 + 16 * (j >> 2) + 4 * lg + (j & 3);
          v[j] = bf2f(Ks[pos * 136 + dk]) * sm_fk[pos];
        }
        u32x4 w; w.x = pk_bf16(v[0], v[1]); w.y = pk_bf16(v[2], v[3]); w.z = pk_bf16(v[4], v[5]); w.w = pk_bf16(v[6], v[7]);
        *(u32x4*)(op + 40960 + (size_t)e * 16) = w;
      }
    }
  }
  __syncthreads();
  if (wv < 2) {
#pragma unroll
    for (int i = 0; i < 64; ++i) Vs[i * 136 + tid] = f2bf(-xv[i].y);
  }
  __syncthreads();
#pragma unroll
  for (int f = 0; f < 4; ++f) {
    const int e = tid + 256 * f, frag = e >> 6, ln = e & 63, lr = ln & 15, lg = ln >> 4;
    const int mt = frag >> 2, sx = frag & 3, row = 16 * mt + lr;
    const u32x2 lo = *(const u32x2*)(Vs + row * 136 + 32 * sx + 4 * lg), hi = *(const u32x2*)(Vs + row * 136 + 32 * sx + 16 + 4 * lg);
    *(u32x4*)(op + (size_t)e * 16) = (u32x4){lo.x, lo.y, hi.x, hi.y};
  }
}

struct ScanA { u32x4 wf[4]; u32x2 uf; float dec; };
struct ScanB { u32x4 qf[4], af[2], kf[4]; };

DI void scan_load_a(const Params& p, int wvs, ScanA& o, int b, int hd, int sl, int n, int q, int lane) {
  const int item = (b * 128 + n) * 4 + hd;
  const unsigned char* op = p.ws + OFF_SC + (size_t)item * OPB;
#pragma unroll
  for (int s = 0; s < 4; ++s) {
    o.wf[s] = *(const u32x4*)(op + (size_t)((q * 4 + s) * 64 + lane) * 16);
  }
  o.uf = *(const u32x2*)(op + 57344 + (size_t)((sl * 4 + q) * 64 + lane) * 8);
  o.dec = ((const float*)(p.ws + OFF_DEC))[item];
}
DI void scan_load_b(const Params& p, int wvs, ScanB& o, int b, int hd, int n, int q, int lane) {
  const int item = (b * 128 + n) * 4 + hd;
  const unsigned char* op = p.ws + OFF_SC + (size_t)item * OPB;
#pragma unroll
  for (int s = 0; s < 4; ++s) o.qf[s] = *(const u32x4*)(op + 16384 + (size_t)((q * 4 + s) * 64 + lane) * 16);
#pragma unroll
  for (int s2 = 0; s2 < 2; ++s2) o.af[s2] = *(const u32x4*)(op + 32768 + (size_t)((q * 2 + s2) * 64 + lane) * 16);
#pragma unroll
  for (int j = 0; j < 4; ++j) o.kf[j] = *(const u32x4*)(op + 40960 + (size_t)((q * 4 + j) * 64 + lane) * 16);
}

DI void scan_step(const Params& p, int wvs, const ScanA& o, const ScanB& ob, f32x4 (&S)[2], int b, int hd, int sl, int n, int q, int lane, unsigned char* smem) {
  const int r16 = lane & 15, g = lane >> 4;
  u32x4* ldsS = (u32x4*)smem;
  u32x2* ldsV = (u32x2*)(smem + 4096);
  ldsS[q * 64 + lane] = __builtin_bit_cast(u32x4, pack8(S[0], S[1]));
  __syncthreads();
  bf16x8 Sb[4];
#pragma unroll
  for (int s = 0; s < 4; ++s) Sb[s] = as_bf8(ldsS[s * 64 + lane]);
  f32x4 vn = (f32x4){bf_lo(o.uf.x), bf_hi(o.uf.x), bf_lo(o.uf.y), bf_hi(o.uf.y)};
#pragma unroll
  for (int s = 0; s < 4; ++s) vn = mfma16(as_bf8(o.wf[s]), Sb[s], vn);
  { u32x2 w; w.x = pk_bf16(vn[0], vn[1]); w.y = pk_bf16(vn[2], vn[3]); ldsV[((q >> 1) * 64 + lane) * 2 + (q & 1)] = w; }
  f32x4 oa = (f32x4){0.f, 0.f, 0.f, 0.f};
#pragma unroll
  for (int s = 0; s < 4; ++s) oa = mfma16(as_bf8(ob.qf[s]), Sb[s], oa);
  __syncthreads();
  bf16x8 Vb[2];
#pragma unroll
  for (int s2 = 0; s2 < 2; ++s2) Vb[s2] = as_bf8(*(const u32x4*)(ldsV + (s2 * 64 + lane) * 2));
#pragma unroll
  for (int s2 = 0; s2 < 2; ++s2) oa = mfma16(as_bf8(ob.af[s2]), Vb[s2], oa);
  u16* h = (u16*)(p.ws + OFF_H);
  const int t0 = b * SEQ + n * 64;
#pragma unroll
  for (int r = 0; r < 4; ++r) h[(size_t)(t0 + 16 * q + 4 * g + r) * NC + hd * 128 + 16 * sl + r16] = f2bf(oa[r]);
#pragma unroll
  for (int t = 0; t < 2; ++t) {
    S[t] = S[t] * o.dec;
#pragma unroll
    for (int s2 = 0; s2 < 2; ++s2) S[t] = mfma16(as_bf8(ob.kf[t * 2 + s2]), Vb[s2], S[t]);
  }
}

DI void scan_chain(const Params& p, int wvs, int pair, int sl, unsigned char* smem) {
  const int tid0 = opaque_tid(); const int lane = tid0 & 63, q = tid0 >> 6;
  const int b = pair >> 2, hd = pair & 3;
  f32x4 S[2]; S[0] = (f32x4){0.f, 0.f, 0.f, 0.f}; S[1] = S[0];
  ScanA a0, a1, a2; ScanB bc, bn;
  __syncthreads();
  scan_load_a(p, wvs, a0, b, hd, sl, 0, q, lane);
  scan_load_b(p, wvs, bc, b, hd, 0, q, lane);
  scan_load_a(p, wvs, a1, b, hd, sl, 1, q, lane);
#pragma unroll 1
  for (int n = 0; n < 129; n += 3) {
    if (n + 2 < 128) scan_load_a(p, wvs, a2, b, hd, sl, n + 2, q, lane);
    if (n + 1 < 128) scan_load_b(p, wvs, bn, b, hd, n + 1, q, lane);
    if (n < 128) scan_step(p, wvs, a0, bc, S, b, hd, sl, n, q, lane, smem);
    bc = bn;
    if (n + 3 < 128) scan_load_a(p, wvs, a0, b, hd, sl, n + 3, q, lane);
    if (n + 2 < 128) scan_load_b(p, wvs, bn, b, hd, n + 2, q, lane);
    if (n + 1 < 128) scan_step(p, wvs, a1, bc, S, b, hd, sl, n + 1, q, lane, smem);
    bc = bn;
    if (n + 4 < 128) scan_load_a(p, wvs, a1, b, hd, sl, n + 4, q, lane);
    if (n + 3 < 128) scan_load_b(p, wvs, bn, b, hd, n + 3, q, lane);
    if (n + 2 < 128) scan_step(p, wvs, a2, bc, S, b, hd, sl, n + 2, q, lane, smem);
    bc = bn;
  }
}

DI void swa_item(const Params& p, int wvs, int item, bool valid, unsigned char* smem) {
  if (!valid) { __syncthreads(); __syncthreads(); return; }
  const int tid_ = opaque_tid();
  const int tid = tid_, lane = tid & 63, wv = tid >> 6, r16 = lane & 15, g = lane >> 4;
  const int qt = item & 127, kvh = (item >> 7) & 1, b = item >> 8;
  const int kp0 = 64 * qt - 128;
  u16* Ksm = (u16*)smem;
  u16* Vt = (u16*)(smem + 27648);
  u16* h = (u16*)(p.ws + OFF_H);
  const float* rc = (const float*)(p.ws + OFF_ROPE); const float* rs = rc + 8192 * 8;
  __syncthreads();
  if (tid < 192) {
    const int kk = tid, pos = kp0 + kk;
    u32x4 lo = (u32x4){0, 0, 0, 0}, hi = lo;
    if (pos >= 0) {
      const u16* src = h + (size_t)(b * SEQ + pos) * NC + C_SWK + kvh * 64;
      const u32x4 a = *(const u32x4*)src, c = *(const u32x4*)(src + 8);
      const f32x4 c0 = *(const f32x4*)(rc + pos * 8), c1 = *(const f32x4*)(rc + pos * 8 + 4);
      const f32x4 s0 = *(const f32x4*)(rs + pos * 8), s1 = *(const f32x4*)(rs + pos * 8 + 4);
      float t1[8], t2[8], cs[8], sn[8], o1[8], o2[8];
#pragma unroll
      for (int j = 0; j < 4; ++j) { t1[2 * j] = bf_lo(a[j]); t1[2 * j + 1] = bf_hi(a[j]); t2[2 * j] = bf_lo(c[j]); t2[2 * j + 1] = bf_hi(c[j]);
        cs[j] = c0[j]; cs[4 + j] = c1[j]; sn[j] = s0[j]; sn[4 + j] = s1[j]; }
#pragma unroll
      for (int j = 0; j < 8; ++j) { o1[j] = t1[j] * cs[j] - t2[j] * sn[j]; o2[j] = t2[j] * cs[j] + t1[j] * sn[j]; }
#pragma unroll
      for (int j = 0; j < 4; ++j) { lo[j] = pk_bf16(o1[2 * j], o1[2 * j + 1]); hi[j] = pk_bf16(o2[2 * j], o2[2 * j + 1]); }
    }
    *(u32x4*)(Ksm + kk * 72) = lo; *(u32x4*)(Ksm + kk * 72 + 8) = hi;
  }
  for (int e = tid; e < 192 * 6; e += 256) {
    const int kk = e / 6, ch = 2 + e % 6, pos = kp0 + kk;
    u32x4 v = (u32x4){0, 0, 0, 0};
    if (pos >= 0) v = *(const u32x4*)(h + (size_t)(b * SEQ + pos) * NC + C_SWK + kvh * 64 + ch * 8);
    *(u32x4*)(Ksm + kk * 72 + ch * 8) = v;
  }
  for (int e = tid; e < 192 * 8; e += 256) {
    const int kk = e >> 3, ch = e & 7, pos = kp0 + kk;
    u32x4 v = (u32x4){0, 0, 0, 0};
    if (pos >= 0) v = *(const u32x4*)(h + (size_t)(b * SEQ + pos) * NC + C_SWV + kvh * 64 + ch * 8);
#pragma unroll
    for (int j = 0; j < 4; ++j) { Vt[(ch * 8 + 2 * j) * 200 + kk] = (u16)(v[j] & 0xffffu); Vt[(ch * 8 + 2 * j + 1) * 200 + kk] = (u16)(v[j] >> 16); }
  }
  __syncthreads();
  const int st = wv, jt0 = st < 2 ? st : 2;
  const int qi = 16 * st + r16;
  const int qpos = 64 * qt + qi, tq = b * SEQ + qpos;
#pragma unroll 1
  for (int hq = 0; hq < 4; ++hq) {
    const int head = kvh * 4 + hq;
    u16* qsrc = h + (size_t)tq * NC + C_SWQ + head * 64;
    bf16x8 qf[2];
    {
      const u32x4 a = *(const u32x4*)qsrc, c = *(const u32x4*)(qsrc + 8);
      u32x4 w = *(const u32x4*)(qsrc + 8 * g);
      if (g < 2) {
        const f32x4 c0 = *(const f32x4*)(rc + qpos * 8), c1 = *(const f32x4*)(rc + qpos * 8 + 4);
        const f32x4 s0 = *(const f32x4*)(rs + qpos * 8), s1 = *(const f32x4*)(rs + qpos * 8 + 4);
        float t1[8], t2[8], cs[8], sn[8], o[8];
#pragma unroll
        for (int j = 0; j < 4; ++j) { t1[2 * j] = bf_lo(a[j]); t1[2 * j + 1] = bf_hi(a[j]); t2[2 * j] = bf_lo(c[j]); t2[2 * j + 1] = bf_hi(c[j]);
          cs[j] = c0[j]; cs[4 + j] = c1[j]; sn[j] = s0[j]; sn[4 + j] = s1[j]; }
#pragma unroll
        for (int j = 0; j < 8; ++j) o[j] = (g == 0) ? (t1[j] * cs[j] - t2[j] * sn[j]) : (t2[j] * cs[j] + t1[j] * sn[j]);
#pragma unroll
        for (int j = 0; j < 4; ++j) w[j] = pk_bf16(o[2 * j], o[2 * j + 1]);
      }
      qf[0] = as_bf8(w);
      qf[1] = as_bf8(*(const u32x4*)(qsrc + 32 + 8 * g));
    }
    f32x4 sc[10];
#pragma unroll
    for (int t = 0; t < 10; ++t) {
      sc[t] = (f32x4){0.f, 0.f, 0.f, 0.f};
#pragma unroll
      for (int s = 0; s < 2; ++s) {
        const bf16x8 kf = *(const bf16x8*)(Ksm + (16 * (jt0 + t) + r16) * 72 + 32 * s + 8 * g);
        sc[t] = mfma16(kf, qf[s], sc[t]);
      }
    }
    const float sink = p.sinks[head];
    float mx = sink;
#pragma unroll
    for (int t = 0; t < 10; ++t)
#pragma unroll
      for (int r = 0; r < 4; ++r) {
        const int kk = 16 * (jt0 + t) + 4 * g + r, d = kk - qi;
        const bool ok = (d >= 1) && (d <= 128) && (kp0 + kk >= 0);
        const float v = ok ? sc[t][r] * 0.125f : -1e30f;
        sc[t][r] = v; mx = fmaxf(mx, v);
      }
    mx = fmaxf(mx, shx(mx, 16, lane)); mx = fmaxf(mx, shx(mx, 32, lane));
    float sum = 0.f;
#pragma unroll
    for (int t = 0; t < 10; ++t)
#pragma unroll
      for (int r = 0; r < 4; ++r) { const float e = __expf(sc[t][r] - mx); sc[t][r] = e; sum += e; }
    sum += shx(sum, 16, lane); sum += shx(sum, 32, lane);
    const float inv = rcp_f(sum + __expf(sink - mx));
    f32x4 oacc[4];
#pragma unroll
    for (int dt = 0; dt < 4; ++dt) oacc[dt] = (f32x4){0.f, 0.f, 0.f, 0.f};
#pragma unroll
    for (int s2 = 0; s2 < 5; ++s2) {
      const bf16x8 pb = pack8(sc[2 * s2], sc[2 * s2 + 1]);
#pragma unroll
      for (int dt = 0; dt < 4; ++dt) {
        const u16* vr = Vt + (16 * dt + r16) * 200 + 16 * (jt0 + 2 * s2) + 4 * g;
        const u32x2 lo = *(const u32x2*)vr, hi = *(const u32x2*)(vr + 16);
        oacc[dt] = mfma16(as_bf8((u32x4){lo.x, lo.y, hi.x, hi.y}), pb, oacc[dt]);
      }
    }
#pragma unroll
    for (int dt = 0; dt < 4; ++dt) {
      const int dcol = head * 64 + 16 * dt + 4 * g;
      const u32x2 z = *(const u32x2*)(h + (size_t)tq * NC + C_SWZ + dcol);
      u32x2 w;
      w.x = pk_bf16(oacc[dt][0] * inv * silu_f(bf_lo(z.x)), oacc[dt][1] * inv * silu_f(bf_hi(z.x)));
      w.y = pk_bf16(oacc[dt][2] * inv * silu_f(bf_lo(z.y)), oacc[dt][3] * inv * silu_f(bf_hi(z.y)));
      *(u32x2*)(h + (size_t)tq * NC + C_SWQ + dcol) = w;
    }
  }
}

DI void phase_ya(const Params& p, int wvs) {
  u16* h = (u16*)(p.ws + OFF_H);
  const int ltid = opaque_tid(), lane = ltid & 63;
  const size_t gt = (size_t)blockIdx.x * 512 + ltid, gs = (size_t)gridDim.x * 512;
  const float* nwp = p.dn_norm_w + (ltid & 15) * 8;
  const f32x4 nw0 = *(const f32x4*)nwp, nw1 = *(const f32x4*)(nwp + 4);
  for (size_t i0 = gt; i0 < (size_t)T_TOK * 64; i0 += 4 * gs) {
    u32x4 v[4], z[4];
#pragma unroll
    for (int k = 0; k < 4; ++k) {
      const size_t i = i0 + k * gs;
      if (i < (size_t)T_TOK * 64) {
        const u16* ptr = h + (size_t)(i >> 6) * NC + (i & 63) * 8;
        v[k] = *(const u32x4*)ptr; z[k] = *(const u32x4*)(ptr + C_DNZ);
      } else { v[k] = (u32x4){0, 0, 0, 0}; z[k] = v[k]; }
    }
#pragma unroll
    for (int k = 0; k < 4; ++k) {
      const size_t i = i0 + k * gs;
      float o[8]; float ss = 0.f;
#pragma unroll
      for (int j = 0; j < 4; ++j) { o[2 * j] = bf_lo(v[k][j]); o[2 * j + 1] = bf_hi(v[k][j]); }
#pragma unroll
      for (int j = 0; j < 8; ++j) ss += o[j] * o[j];
      ss += shx(ss, 1, lane); ss += shx(ss, 2, lane); ss += shx(ss, 4, lane); ss += shx(ss, 8, lane);
      const float rs = rsqrtf(ss * (1.0f / 128.0f) + 1e-6f);
      float y[8];
#pragma unroll
      for (int j = 0; j < 4; ++j) {
        const float w0 = (j < 2) ? nw0[2 * j] : nw1[2 * j - 4], w1 = (j < 2) ? nw0[2 * j + 1] : nw1[2 * j - 3];
        y[2 * j] = o[2 * j] * rs * w0 * silu_f(bf_lo(z[k][j]));
        y[2 * j + 1] = o[2 * j + 1] * rs * w1 * silu_f(bf_hi(z[k][j]));
      }
      u32x4 w; w.x = pk_bf16(y[0], y[1]); w.y = pk_bf16(y[2], y[3]); w.z = pk_bf16(y[4], y[5]); w.w = pk_bf16(y[6], y[7]);
      if (i < (size_t)T_TOK * 64) *(u32x4*)(h + (size_t)(i >> 6) * NC + (i & 63) * 8) = w;
    }
  }
}

DI float wave_sum(float v, int lane) {
#pragma unroll
  for (int o = 32; o > 0; o >>= 1) v += shx(v, o, lane);
  return v;
}
DI void phase6(const Params& p, int wvs, unsigned char* smem) {
  const int tid = opaque_tid(), lane = tid & 63, wv = tid >> 6;
  f32x4 gm[4], bt[4];
#pragma unroll
  for (int j = 0; j < 4; ++j) { gm[j] = *(const f32x4*)(p.ln_g + 4 * (lane + 64 * j)); bt[j] = *(const f32x4*)(p.ln_b + 4 * (lane + 64 * j)); }
  const int xcd6 = blockIdx.x & 7, lb6 = blockIdx.x >> 3, nlb6 = gridDim.x >> 3;
  for (int lr = (lb6 * 8 + wv) * 2; lr < 4096; lr += nlb6 * 16) {
    const int row0 = 4096 * xcd6 + (4095 - lr), row1 = row0 - 1;
    float* r0 = p.out + (size_t)row0 * 1024;
    float* r1 = p.out + (size_t)row1 * 1024;
    const _Float16* s0 = (const _Float16*)(p.ws + OFF_H) + (size_t)row0 * 1024;
    const _Float16* s1 = (const _Float16*)(p.ws + OFF_H) + (size_t)row1 * 1024;
    f32x4 a[4], b[4];
#pragma unroll
    for (int j = 0; j < 4; ++j) {
      a[j] = __builtin_convertvector(*(const f16x4*)(s0 + 4 * (lane + 64 * j)), f32x4);
      b[j] = __builtin_convertvector(*(const f16x4*)(s1 + 4 * (lane + 64 * j)), f32x4);
    }
    float sa = 0.f, sb = 0.f;
#pragma unroll
    for (int j = 0; j < 4; ++j) { sa += (a[j][0] + a[j][1]) + (a[j][2] + a[j][3]); sb += (b[j][0] + b[j][1]) + (b[j][2] + b[j][3]); }
    const float ma = wave_sum(sa, lane) * (1.0f / 1024.0f), mb = wave_sum(sb, lane) * (1.0f / 1024.0f);
    float qa = 0.f, qb = 0.f;
#pragma unroll
    for (int j = 0; j < 4; ++j) {
      a[j] = a[j] - ma; b[j] = b[j] - mb;
      qa += (a[j][0] * a[j][0] + a[j][1] * a[j][1]) + (a[j][2] * a[j][2] + a[j][3] * a[j][3]);
      qb += (b[j][0] * b[j][0] + b[j][1] * b[j][1]) + (b[j][2] * b[j][2] + b[j][3] * b[j][3]);
    }
    const float ra = rsqrtf(wave_sum(qa, lane) * (1.0f / 1024.0f) + 1e-5f), rb = rsqrtf(wave_sum(qb, lane) * (1.0f / 1024.0f) + 1e-5f);
#pragma unroll
    for (int j = 0; j < 4; ++j) {
      *(f32x4*)(r0 + 4 * (lane + 64 * j)) = a[j] * ra * gm[j] + bt[j];
      *(f32x4*)(r1 + 4 * (lane + 64 * j)) = b[j] * rb * gm[j] + bt[j];
    }
  }
}

#define XB_TMO      128
#define XB_XCNT(j)  (256  + 64 * (j))
#define XB_XSUB(j)  (1280 + 64 * (j))
#define XB_XGEN(j)  (2304 + 64 * (j))
#define XB_TOP      3328
#define XB_TOPGEN   3392
#define XCD_BAR_WORDS 3456
#define XB_SPIN_CAP (1u << 22)
#define LAS __attribute__((address_space(3)))
DI unsigned xb_ld(unsigned* p) { return __hip_atomic_load(p, __ATOMIC_RELAXED, __HIP_MEMORY_SCOPE_AGENT); }
DI unsigned xb_add(unsigned* p, unsigned v) { return __hip_atomic_fetch_add(p, v, __ATOMIC_RELAXED, __HIP_MEMORY_SCOPE_AGENT); }
DI unsigned xb_xcc_id() { return (unsigned)__builtin_amdgcn_s_getreg((3 << 11) | 20) & 0xFu; }
#define XB_SPIN(cond, bar) do { unsigned _sp = 0; while (cond) { __builtin_amdgcn_s_sleep(1); \
    if ((++_sp & 255u) == 0u) { if (xb_ld(&(bar)[XB_TMO])) break; if (_sp > XB_SPIN_CAP) { atomicAdd(&(bar)[XB_TMO], 1u); break; } } } } while (0)
struct XcdBarrier { unsigned* bar; unsigned x; volatile LAS unsigned* st; };
DI bool xb_leader(int wvs) { return wvs == 0 && __builtin_amdgcn_mbcnt_hi(~0u, __builtin_amdgcn_mbcnt_lo(~0u, 0u)) == 0u; }
DI XcdBarrier xcd_barrier_post(unsigned* bar, volatile LAS unsigned* st, int wvs) {
  XcdBarrier b; b.bar = bar; b.x = xb_xcc_id(); b.st = st;
  if (xb_leader(wvs)) (void)xb_add(&bar[XB_XCNT(b.x)], 1u);
  return b;
}
DI void xcd_barrier_complete(unsigned* bar, unsigned x, unsigned& nloc, unsigned& nx) {
  const unsigned G = gridDim.x * gridDim.y * gridDim.z;
  unsigned sum, cnt, mine, sp = 0u;
  for (;;) {
    sum = 0u; cnt = 0u; mine = 0u;
#pragma unroll
    for (unsigned j = 0; j < 16; ++j) { const unsigned c = xb_ld(&bar[XB_XCNT(j)]); sum += c; cnt += (c > 0u) ? 1u : 0u; mine = (j == x) ? c : mine; }
    if (sum == G) break;
    __builtin_amdgcn_s_sleep(1);
    if ((++sp & 255u) == 0u) { if (xb_ld(&bar[XB_TMO])) break; if (sp > XB_SPIN_CAP) { atomicAdd(&bar[XB_TMO], 1u); break; } }
  }
  nloc = mine > 0u ? mine : 1u; nx = cnt > 0u ? cnt : 1u;
}
DI void xcd_barrier_(const XcdBarrier& b, int wvs) {
  asm volatile("s_waitcnt vmcnt(0)" ::: "memory");
  __syncthreads();
  if (xb_leader(wvs)) {
    unsigned* bar = b.bar;
    __builtin_amdgcn_s_waitcnt(0);
    unsigned nloc = b.st[0], nx = b.st[1];
    if (nloc == 0u) { xcd_barrier_complete(bar, b.x, nloc, nx); b.st[0] = nloc; b.st[1] = nx; }
    const unsigned old = xb_add(&bar[XB_XSUB(b.x)], 1u);
    const unsigned gen = old / nloc;
    if (old + 1u == (gen + 1u) * nloc) {
      __builtin_amdgcn_fence(__ATOMIC_RELEASE, "agent");
      asm volatile("s_waitcnt vmcnt(0)" ::: "memory");
      const unsigned og = xb_add(&bar[XB_TOP], 1u);
      const unsigned tg = og / nx;
      if (og + 1u == (tg + 1u) * nx) xb_add(&bar[XB_TOPGEN], 1u);
      else XB_SPIN(xb_ld(&bar[XB_TOPGEN]) == tg, bar);
      __builtin_amdgcn_fence(__ATOMIC_ACQUIRE, "agent");
      xb_add(&bar[XB_XGEN(b.x)], 1u);
      asm volatile("s_waitcnt vmcnt(0)" ::: "memory");
    } else {
      XB_SPIN(xb_ld(&bar[XB_XGEN(b.x)]) == gen, bar);
      __builtin_amdgcn_fence(__ATOMIC_ACQUIRE, "agent");
      asm volatile("s_waitcnt vmcnt(0)" ::: "memory");
    }
  }
  __syncthreads();
}

#define xcd_barrier(b) xcd_barrier_(b, w8)
namespace pg8 {
#define PG8_LAS __attribute__((address_space(3)))
typedef unsigned short bf16_t;
typedef short bf16x8 __attribute__((ext_vector_type(8)));
typedef float f32x4 __attribute__((ext_vector_type(4)));
typedef unsigned u32x4 __attribute__((ext_vector_type(4)));
constexpr int BM = 256, BK = 64, HALF = 128, HTB = HALF * BK * 2  , STAGE_BYTES = 8 * HTB, NXCD = 8, WGM = 8;

__host__ __device__ __forceinline__ int lds_byte(int r, int c) { const int st = (r >> 4) * 2 + (c >> 5), rr = r & 15, cc = c & 31, ob = rr * 64 + cc * 2; return st * 1024 + (ob ^ (((ob >> 9) & 1) << 5)); }
__host__ __device__ __forceinline__ void stage_rc(int b, int& R, int& C) { const int st = b / 1024, sb = b % 1024, swz = sb ^ (((sb >> 9) & 1) << 5); R = (st >> 1) * 16 + swz / 64; C = (st & 1) * 32 + (swz % 64) / 2; }
__host__ __device__ __forceinline__ int perm32(int rho) { const int n = rho >> 4, i = rho & 15; return 8 * (i >> 2) + 4 * n + (i & 3); }

struct Unit { int pm, pn; };
struct Gemm { const bf16_t* A; const bf16_t* Bt; int M, N, K; };

struct StaticOrder {
    int nM, nN, nwg, G, c;
    __host__ __device__ void init(int M, int N, int G_, int c_) { nM = M / BM; nN = N / BM; nwg = nM * nN; G = G_; c = c_; }
    __host__ __device__ bool next(int i, Unit& u) const {
        const long L = (long)i * G + c; if (L >= nwg) return false;
        int wgid = (int)L; { const int q = nwg / NXCD, r = nwg % NXCD, xcd = wgid % NXCD, off = wgid / NXCD; wgid = (xcd < r ? xcd * (q + 1) : r * (q + 1) + (xcd - r) * q) + off; }
        const int nig = WGM * nN, gid = wgid / nig, fm = gid * WGM, gsz = (nM - fm) < WGM ? (nM - fm) : WGM;
        u.pm = fm + ((wgid % nig) % gsz); u.pn = (wgid % nig) / gsz; return true;
    }
    __device__ __forceinline__ void a_ready(const Unit&) const {}
    __device__ __forceinline__ void done(const Unit&) const {}
};

template <class Epi, class Sched, bool ALIGN_EPI = false, bool SP2 = false>
__device__ __forceinline__ void gemm_phase(PG8_LAS unsigned char* lds, const Gemm g, const Sched& S, const Epi& E, const int tid) {
    const int wid = __builtin_amdgcn_readfirstlane(tid >> 6), lane = tid & 63, wr = wid >> 2, wc = wid & 3, fr = lane & 15, fq = lane >> 4;
    const int K = g.K, nt = K / BK;
    unsigned voffA[2], voffB[2];
#pragma unroll
    for (int i = 0; i < 2; ++i) { int R, C; stage_rc(tid * 16 + i * 8192, R, C); const int Rb = Epi::PERM ? ((R & ~31) + perm32(R & 31)) : R;
        voffA[i] = (unsigned)(R * K + C) * 2u; voffB[i] = (unsigned)(Rb * K + C) * 2u; }
    const size_t kstep = (size_t)(BK * 2);
    const size_t hstep = (size_t)HALF * K * 2;
    const size_t tstep = 2 * hstep;
    const unsigned ldsw = (unsigned)wid * 1024u;
    const int aoff = lds_byte(wr * 64 + fr, fq * 8), boff = lds_byte(wc * 32 + fr, fq * 8);
#define PG8_SA(b, h) (((b) * 2 + (h)) * HTB)
#define PG8_SB(b, h) ((4 + (b) * 2 + (h)) * HTB)
#define PG8_STAGE(bufoff, gbase, voff) do { _Pragma("unroll") for (int _i = 0; _i < 2; ++_i) \
        __builtin_amdgcn_global_load_lds((const unsigned*)((const char*)(gbase) + (voff)[_i]), (PG8_LAS unsigned*)(lds + (bufoff) + ldsw + _i * 8192), 16, 0, 0); } while (0)
#define PG8_LDA(dst, b, h) do { _Pragma("unroll") for (int m = 0; m < 4; ++m) _Pragma("unroll") for (int k = 0; k < 2; ++k) dst[m][k] = *(const PG8_LAS bf16x8*)(lds + PG8_SA(b, h) + aoff + m * 2048 + k * 1024); } while (0)
#define PG8_LDB(dst, b, h) do { _Pragma("unroll") for (int n = 0; n < 2; ++n) _Pragma("unroll") for (int k = 0; k < 2; ++k) dst[n][k] = *(const PG8_LAS bf16x8*)(lds + PG8_SB(b, h) + boff + n * 2048 + k * 1024); } while (0)
#define PG8_MMA(ai, bj, At, Bt) do { __builtin_amdgcn_s_setprio(1); _Pragma("unroll") for (int m = 0; m < 4; ++m) _Pragma("unroll") for (int n = 0; n < 2; ++n) _Pragma("unroll") for (int k = 0; k < 2; ++k) \
        acc[ai][bj][m][n] = __builtin_amdgcn_mfma_f32_16x16x32_bf16(Bt[n][k], At[m][k], acc[ai][bj][m][n], 0, 0, 0); __builtin_amdgcn_s_setprio(0); } while (0)
#define PG8_WAIT_V(n) asm volatile("s_waitcnt vmcnt(" #n ")" ::: "memory")
#define PG8_WAIT_L(n) asm volatile("s_waitcnt lgkmcnt(" #n ")" ::: "memory")
#define PG8_BAR __builtin_amdgcn_s_barrier()
#define PG8_SCHED __builtin_amdgcn_sched_barrier(0)
    Unit cur, nxt; int ui = 0;
    if (!S.next(0, cur)) return;
    f32x4 acc[2][2][4][2];
#pragma unroll
    for (int a = 0; a < 2; ++a)
#pragma unroll
        for (int b = 0; b < 2; ++b)
#pragma unroll
            for (int m = 0; m < 4; ++m)
#pragma unroll
                for (int n = 0; n < 2; ++n) acc[a][b][m][n] = (f32x4){0.f, 0.f, 0.f, 0.f};
    bf16x8 At[4][2], B0[2][2], B1[2][2];
    const char* cA = (const char*)g.A + (size_t)cur.pm * tstep; const char* cB = (const char*)g.Bt + (size_t)cur.pn * tstep;
    S.a_ready(cur);
    if constexpr (SP2) {
        PG8_STAGE(PG8_SB(0, 0), cB, voffB); PG8_STAGE(PG8_SB(0, 1), cB + hstep, voffB); PG8_STAGE(PG8_SA(0, 0), cA, voffA); PG8_STAGE(PG8_SA(0, 1), cA + hstep, voffA);
        if (wr == 1) PG8_BAR;
        PG8_WAIT_V(2); PG8_BAR;
        PG8_STAGE(PG8_SB(1, 0), cB + kstep, voffB); PG8_STAGE(PG8_SA(1, 0), cA + kstep, voffA); PG8_STAGE(PG8_SB(1, 1), cB + hstep + kstep, voffB);
        PG8_WAIT_V(6); PG8_BAR;
    } else {
        PG8_STAGE(PG8_SB(0, 0), cB, voffB); PG8_STAGE(PG8_SA(0, 0), cA, voffA); PG8_STAGE(PG8_SB(0, 1), cB + hstep, voffB); PG8_STAGE(PG8_SA(0, 1), cA + hstep, voffA);
        if (wr == 1) PG8_BAR;
        PG8_WAIT_V(4); PG8_BAR;
        PG8_STAGE(PG8_SB(1, 0), cB + kstep, voffB); PG8_STAGE(PG8_SA(1, 0), cA + kstep, voffA); PG8_STAGE(PG8_SB(1, 1), cB + hstep + kstep, voffB);
        PG8_WAIT_V(6); PG8_BAR;
    }
    for (;;) {
        const bool has_next = S.next(ui + 1, nxt);
        const char* nA = has_next ? (const char*)g.A + (size_t)nxt.pm * tstep : cA; const char* nB = has_next ? (const char*)g.Bt + (size_t)nxt.pn * tstep : cB;
        for (int t = 0; t < nt; t += 2) {
            const bool last = (t == nt - 2);
            const char* a1 = cA + (size_t)(t + 1) * kstep;
            const char* a2 = last ? nA : cA + (size_t)(t + 2) * kstep; const char* b2 = last ? nB : cB + (size_t)(t + 2) * kstep;
            const char* a3 = a2 + kstep; const char* b3 = b2 + kstep;
            if (last && has_next) S.a_ready(nxt);
            if constexpr (SP2) {
            PG8_LDB(B0, 0, 0); PG8_LDB(B1, 0, 1); PG8_SCHED; PG8_LDA(At, 0, 0); PG8_STAGE(PG8_SA(1, 1), a1 + hstep, voffA);
            PG8_WAIT_V(8); PG8_WAIT_L(0); PG8_BAR; PG8_MMA(0, 0, At, B0); PG8_MMA(0, 1, At, B1); PG8_BAR; PG8_SCHED;
            PG8_LDA(At, 0, 1); PG8_STAGE(PG8_SB(0, 0), b2, voffB); PG8_STAGE(PG8_SB(0, 1), b2 + hstep, voffB); PG8_STAGE(PG8_SA(0, 0), a2, voffA);
            PG8_WAIT_V(8); PG8_WAIT_L(0); PG8_BAR; PG8_MMA(1, 0, At, B0); PG8_MMA(1, 1, At, B1); PG8_BAR; PG8_SCHED;
            PG8_LDB(B0, 1, 0); PG8_LDB(B1, 1, 1); PG8_SCHED; PG8_LDA(At, 1, 0); PG8_STAGE(PG8_SA(0, 1), a2 + hstep, voffA);
            PG8_WAIT_V(8); PG8_WAIT_L(0); PG8_BAR; PG8_MMA(0, 0, At, B0); PG8_MMA(0, 1, At, B1); PG8_BAR; PG8_SCHED;
            PG8_LDA(At, 1, 1); PG8_STAGE(PG8_SB(1, 0), b3, voffB); PG8_STAGE(PG8_SB(1, 1), b3 + hstep, voffB); PG8_STAGE(PG8_SA(1, 0), a3, voffA);
            PG8_WAIT_V(8); PG8_WAIT_L(0); PG8_BAR; PG8_MMA(1, 0, At, B0); PG8_MMA(1, 1, At, B1); PG8_BAR; PG8_SCHED;
            } else {
            PG8_LDB(B0, 0, 0); PG8_SCHED; PG8_LDA(At, 0, 0); PG8_STAGE(PG8_SA(1, 1), a1 + hstep, voffA);
            PG8_WAIT_L(8); PG8_BAR; PG8_WAIT_L(0); PG8_MMA(0, 0, At, B0); PG8_BAR; PG8_SCHED;
            PG8_LDB(B1, 0, 1); PG8_STAGE(PG8_SB(0, 0), b2, voffB);
            PG8_BAR; PG8_WAIT_L(0); PG8_MMA(0, 1, At, B1); PG8_BAR;
            PG8_LDA(At, 0, 1); PG8_STAGE(PG8_SA(0, 0), a2, voffA);
            PG8_BAR; PG8_WAIT_L(0); PG8_MMA(1, 0, At, B0); PG8_BAR; PG8_SCHED;
            PG8_STAGE(PG8_SB(0, 1), b2 + hstep, voffB);
            PG8_WAIT_V(6); PG8_BAR; PG8_MMA(1, 1, At, B1); PG8_BAR;
            PG8_LDB(B0, 1, 0); PG8_SCHED; PG8_LDA(At, 1, 0); PG8_STAGE(PG8_SA(0, 1), a2 + hstep, voffA);
            PG8_WAIT_L(8); PG8_BAR; PG8_WAIT_L(0); PG8_MMA(0, 0, At, B0); PG8_BAR; PG8_SCHED;
            PG8_LDB(B1, 1, 1); PG8_STAGE(PG8_SB(1, 0), b3, voffB);
            PG8_BAR; PG8_WAIT_L(0); PG8_MMA(0, 1, At, B1); PG8_BAR;
            PG8_LDA(At, 1, 1); PG8_STAGE(PG8_SA(1, 0), a3, voffA);
            PG8_BAR; PG8_WAIT_L(0); PG8_MMA(1, 0, At, B0); PG8_BAR; PG8_SCHED;
            PG8_STAGE(PG8_SB(1, 1), b3 + hstep, voffB);
            PG8_WAIT_V(6); PG8_BAR; PG8_MMA(1, 1, At, B1); PG8_BAR;
            }
        }
        if constexpr (ALIGN_EPI) { if (wr == 0) PG8_BAR; }
        if constexpr (!Epi::AFTER_DRAIN) { E(acc, cur, wr, wc, fr, fq); S.done(cur); }
        if (!has_next) break;
#pragma unroll
        for (int a = 0; a < 2; ++a)
#pragma unroll
            for (int b = 0; b < 2; ++b)
#pragma unroll
                for (int m = 0; m < 4; ++m)
#pragma unroll
                    for (int n = 0; n < 2; ++n) acc[a][b][m][n] = (f32x4){0.f, 0.f, 0.f, 0.f};
        cur = nxt; cA = nA; cB = nB; ++ui;
        if constexpr (ALIGN_EPI) { if (wr == 1) PG8_BAR; }
    }
    PG8_WAIT_V(0);
    if constexpr (!ALIGN_EPI) { if (wr == 0) PG8_BAR; }
    PG8_BAR;
    if constexpr (Epi::AFTER_DRAIN) { E.fused(acc, cur, wr, wc, fr, fq, lds, wid, lane); S.done(cur); }
#undef PG8_SA
#undef PG8_SB
#undef PG8_STAGE
#undef PG8_LDA
#undef PG8_LDB
#undef PG8_MMA
#undef PG8_WAIT_V
#undef PG8_WAIT_L
#undef PG8_BAR
#undef PG8_SCHED
}

struct Unit2 { int pm, pn, part; };
struct Gemm2 { const bf16_t* A0; const bf16_t* A1; const bf16_t* B0; const bf16_t* B1; int lda, K; };
struct StaticOrder2 {
    int nM, nN, nwg, G, c;
    __host__ __device__ void init(int M, int N, int G_, int c_) { nM = M / BM; nN = N / BM; nwg = nM * nN; G = G_; c = c_; }
    __host__ __device__ bool next(int i, Unit2& u) const {
        const long L = (long)(i >> 1) * G + c; if (L >= nwg) return false;
        int wgid = (int)L; { const int q = nwg / NXCD, r = nwg % NXCD, xcd = wgid % NXCD, off = wgid / NXCD; wgid = (xcd < r ? xcd * (q + 1) : r * (q + 1) + (xcd - r) * q) + off; }
        const int nig = WGM * nN, gid = wgid / nig, fm = gid * WGM, gsz = (nM - fm) < WGM ? (nM - fm) : WGM;
        u.pm = fm + ((wgid % nig) % gsz); u.pn = (wgid % nig) / gsz; u.part = i & 1; return true;
    }
    __device__ __forceinline__ void a_ready(const Unit2&) const {}
    __device__ __forceinline__ void done(const Unit2&) const {}
};
template <class Epi, class Sched, bool ALIGN_EPI = false, bool SP2 = false>
__device__ __forceinline__ void gemm_phase2(PG8_LAS unsigned char* lds, const Gemm2 g, const Sched& S, const Epi& E, const int tid) {
    const int wid = __builtin_amdgcn_readfirstlane(tid >> 6), lane = tid & 63, wr = wid >> 2, wc = wid & 3, fr = lane & 15, fq = lane >> 4;
    const int K = g.K, nt = K / BK;
    unsigned voffA[2], voffB[2];
#pragma unroll
    for (int i = 0; i < 2; ++i) { int R, C; stage_rc(tid * 16 + i * 8192, R, C); const int Rb = Epi::PERM ? ((R & ~31) + perm32(R & 31)) : R;
        voffA[i] = (unsigned)(R * g.lda + C) * 2u; voffB[i] = (unsigned)(Rb * K + C) * 2u; }
    const size_t kstep = (size_t)(BK * 2);
    const size_t hstep = (size_t)HALF * K * 2;
    const size_t tstep = 2 * hstep;
    const size_t hstepA = (size_t)HALF * g.lda * 2, tstepA = 2 * hstepA;
    const unsigned ldsw = (unsigned)wid * 1024u;
    const int aoff = lds_byte(wr * 64 + fr, fq * 8), boff = lds_byte(wc * 32 + fr, fq * 8);
#define PG8_SA(b, h) (((b) * 2 + (h)) * HTB)
#define PG8_SB(b, h) ((4 + (b) * 2 + (h)) * HTB)
#define PG8_STAGE(bufoff, gbase, voff) do { _Pragma("unroll") for (int _i = 0; _i < 2; ++_i) \
        __builtin_amdgcn_global_load_lds((const unsigned*)((const char*)(gbase) + (voff)[_i]), (PG8_LAS unsigned*)(lds + (bufoff) + ldsw + _i * 8192), 16, 0, 0); } while (0)
#define PG8_LDA(dst, b, h) do { _Pragma("unroll") for (int m = 0; m < 4; ++m) _Pragma("unroll") for (int k = 0; k < 2; ++k) dst[m][k] = *(const PG8_LAS bf16x8*)(lds + PG8_SA(b, h) + aoff + m * 2048 + k * 1024); } while (0)
#define PG8_LDB(dst, b, h) do { _Pragma("unroll") for (int n = 0; n < 2; ++n) _Pragma("unroll") for (int k = 0; k < 2; ++k) dst[n][k] = *(const PG8_LAS bf16x8*)(lds + PG8_SB(b, h) + boff + n * 2048 + k * 1024); } while (0)
#define PG8_MMA(ai, bj, At, Bt) do { __builtin_amdgcn_s_setprio(1); _Pragma("unroll") for (int m = 0; m < 4; ++m) _Pragma("unroll") for (int n = 0; n < 2; ++n) _Pragma("unroll") for (int k = 0; k < 2; ++k) \
        acc[ai][bj][m][n] = __builtin_amdgcn_mfma_f32_16x16x32_bf16(Bt[n][k], At[m][k], acc[ai][bj][m][n], 0, 0, 0); __builtin_amdgcn_s_setprio(0); } while (0)
#define PG8_WAIT_V(n) asm volatile("s_waitcnt vmcnt(" #n ")" ::: "memory")
#define PG8_WAIT_L(n) asm volatile("s_waitcnt lgkmcnt(" #n ")" ::: "memory")
#define PG8_BAR __builtin_amdgcn_s_barrier()
#define PG8_SCHED __builtin_amdgcn_sched_barrier(0)
    Unit2 cur, nxt; int ui = 0;
    if (!S.next(0, cur)) return;
    f32x4 acc[2][2][4][2];
#pragma unroll
    for (int a = 0; a < 2; ++a)
#pragma unroll
        for (int b = 0; b < 2; ++b)
#pragma unroll
            for (int m = 0; m < 4; ++m)
#pragma unroll
                for (int n = 0; n < 2; ++n) acc[a][b][m][n] = (f32x4){0.f, 0.f, 0.f, 0.f};
    bf16x8 At[4][2], B0[2][2], B1[2][2];
    const char* cA = (const char*)(cur.part ? g.A1 : g.A0) + (size_t)cur.pm * tstepA; const char* cB = (const char*)(cur.part ? g.B1 : g.B0) + (size_t)cur.pn * tstep;
    S.a_ready(cur);
    if constexpr (SP2) {
        PG8_STAGE(PG8_SB(0, 0), cB, voffB); PG8_STAGE(PG8_SB(0, 1), cB + hstep, voffB); PG8_STAGE(PG8_SA(0, 0), cA, voffA); PG8_STAGE(PG8_SA(0, 1), cA + hstepA, voffA);
        if (wr == 1) PG8_BAR;
        PG8_WAIT_V(2); PG8_BAR;
        PG8_STAGE(PG8_SB(1, 0), cB + kstep, voffB); PG8_STAGE(PG8_SA(1, 0), cA + kstep, voffA); PG8_STAGE(PG8_SB(1, 1), cB + hstep + kstep, voffB);
        PG8_WAIT_V(6); PG8_BAR;
    } else {
        PG8_STAGE(PG8_SB(0, 0), cB, voffB); PG8_STAGE(PG8_SA(0, 0), cA, voffA); PG8_STAGE(PG8_SB(0, 1), cB + hstep, voffB); PG8_STAGE(PG8_SA(0, 1), cA + hstepA, voffA);
        if (wr == 1) PG8_BAR;
        PG8_WAIT_V(4); PG8_BAR;
        PG8_STAGE(PG8_SB(1, 0), cB + kstep, voffB); PG8_STAGE(PG8_SA(1, 0), cA + kstep, voffA); PG8_STAGE(PG8_SB(1, 1), cB + hstep + kstep, voffB);
        PG8_WAIT_V(6); PG8_BAR;
    }
    for (;;) {
        const bool has_next = S.next(ui + 1, nxt);
        const char* nA = has_next ? (const char*)(nxt.part ? g.A1 : g.A0) + (size_t)nxt.pm * tstepA : cA; const char* nB = has_next ? (const char*)(nxt.part ? g.B1 : g.B0) + (size_t)nxt.pn * tstep : cB;
        for (int t = 0; t < nt; t += 2) {
            const bool last = (t == nt - 2);
            const char* a1 = cA + (size_t)(t + 1) * kstep;
            const char* a2 = last ? nA : cA + (size_t)(t + 2) * kstep; const char* b2 = last ? nB : cB + (size_t)(t + 2) * kstep;
            const char* a3 = a2 + kstep; const char* b3 = b2 + kstep;
            if (last && has_next) S.a_ready(nxt);
            if constexpr (SP2) {
            PG8_LDB(B0, 0, 0); PG8_LDB(B1, 0, 1); PG8_SCHED; PG8_LDA(At, 0, 0); PG8_STAGE(PG8_SA(1, 1), a1 + hstepA, voffA);
            PG8_WAIT_V(8); PG8_WAIT_L(0); PG8_BAR; PG8_MMA(0, 0, At, B0); PG8_MMA(0, 1, At, B1); PG8_BAR; PG8_SCHED;
            PG8_LDA(At, 0, 1); PG8_STAGE(PG8_SB(0, 0), b2, voffB); PG8_STAGE(PG8_SB(0, 1), b2 + hstep, voffB); PG8_STAGE(PG8_SA(0, 0), a2, voffA);
            PG8_WAIT_V(8); PG8_WAIT_L(0); PG8_BAR; PG8_MMA(1, 0, At, B0); PG8_MMA(1, 1, At, B1); PG8_BAR; PG8_SCHED;
            PG8_LDB(B0, 1, 0); PG8_LDB(B1, 1, 1); PG8_SCHED; PG8_LDA(At, 1, 0); PG8_STAGE(PG8_SA(0, 1), a2 + hstepA, voffA);
            PG8_WAIT_V(8); PG8_WAIT_L(0); PG8_BAR; PG8_MMA(0, 0, At, B0); PG8_MMA(0, 1, At, B1); PG8_BAR; PG8_SCHED;
            PG8_LDA(At, 1, 1); PG8_STAGE(PG8_SB(1, 0), b3, voffB); PG8_STAGE(PG8_SB(1, 1), b3 + hstep, voffB); PG8_STAGE(PG8_SA(1, 0), a3, voffA);
            PG8_WAIT_V(8); PG8_WAIT_L(0); PG8_BAR; PG8_MMA(1, 0, At, B0); PG8_MMA(1, 1, At, B1); PG8_BAR; PG8_SCHED;
            } else {
            PG8_LDB(B0, 0, 0); PG8_SCHED; PG8_LDA(At, 0, 0); PG8_STAGE(PG8_SA(1, 1), a1 + hstepA, voffA);
            PG8_WAIT_L(8); PG8_BAR; PG8_WAIT_L(0); PG8_MMA(0, 0, At, B0); PG8_BAR; PG8_SCHED;
            PG8_LDB(B1, 0, 1); PG8_STAGE(PG8_SB(0, 0), b2, voffB);
            PG8_BAR; PG8_WAIT_L(0); PG8_MMA(0, 1, At, B1); PG8_BAR;
            PG8_LDA(At, 0, 1); PG8_STAGE(PG8_SA(0, 0), a2, voffA);
            PG8_BAR; PG8_WAIT_L(0); PG8_MMA(1, 0, At, B0); PG8_BAR; PG8_SCHED;
            PG8_STAGE(PG8_SB(0, 1), b2 + hstep, voffB);
            PG8_WAIT_V(6); PG8_BAR; PG8_MMA(1, 1, At, B1); PG8_BAR;
            PG8_LDB(B0, 1, 0); PG8_SCHED; PG8_LDA(At, 1, 0); PG8_STAGE(PG8_SA(0, 1), a2 + hstepA, voffA);
            PG8_WAIT_L(8); PG8_BAR; PG8_WAIT_L(0); PG8_MMA(0, 0, At, B0); PG8_BAR; PG8_SCHED;
            PG8_LDB(B1, 1, 1); PG8_STAGE(PG8_SB(1, 0), b3, voffB);
            PG8_BAR; PG8_WAIT_L(0); PG8_MMA(0, 1, At, B1); PG8_BAR;
            PG8_LDA(At, 1, 1); PG8_STAGE(PG8_SA(1, 0), a3, voffA);
            PG8_BAR; PG8_WAIT_L(0); PG8_MMA(1, 0, At, B0); PG8_BAR; PG8_SCHED;
            PG8_STAGE(PG8_SB(1, 1), b3 + hstep, voffB);
            PG8_WAIT_V(6); PG8_BAR; PG8_MMA(1, 1, At, B1); PG8_BAR;
            }
        }
        if constexpr (ALIGN_EPI) { if (wr == 0) PG8_BAR; }
        if (cur.part == 0) E.mid(acc, cur, wr, wc, fr, fq); else E(acc, cur, wr, wc, fr, fq);
        if (!has_next) break;
        if (cur.part == 1) {
#pragma unroll
        for (int a = 0; a < 2; ++a)
#pragma unroll
            for (int b = 0; b < 2; ++b)
#pragma unroll
                for (int m = 0; m < 4; ++m)
#pragma unroll
                    for (int n = 0; n < 2; ++n) acc[a][b][m][n] = (f32x4){0.f, 0.f, 0.f, 0.f};
        }
        cur = nxt; cA = nA; cB = nB; ++ui;
        if constexpr (ALIGN_EPI) { if (wr == 1) PG8_BAR; }
    }
    PG8_WAIT_V(0);
    if constexpr (!ALIGN_EPI) { if (wr == 0) PG8_BAR; }
    PG8_BAR;
#undef PG8_SA
#undef PG8_SB
#undef PG8_STAGE
#undef PG8_LDA
#undef PG8_LDB
#undef PG8_MMA
#undef PG8_WAIT_V
#undef PG8_WAIT_L
#undef PG8_BAR
#undef PG8_SCHED
}
}

struct EpiInProj {
  static constexpr bool PERM = true, AFTER_DRAIN = false;
  u16* h;
  DI void operator()(const f32x4 (&acc)[2][2][4][2], const pg8::Unit& u, int wr, int wc, int fr, int fq) const {
    const int shift = (u.pn >= 8) ? 8 : 0;
#pragma unroll
    for (int ai = 0; ai < 2; ++ai)
#pragma unroll
      for (int m = 0; m < 4; ++m) {
        const int row = u.pm * 256 + ai * 128 + wr * 64 + m * 16 + fr;
#pragma unroll
        for (int bj = 0; bj < 2; ++bj) {
          const int col = u.pn * 256 + bj * 128 + wc * 32 + 8 * fq + shift;
          const f32x4 a = acc[ai][bj][m][0], b = acc[ai][bj][m][1];
          u32x4 w; w.x = pk_bf16(a[0], a[1]); w.y = pk_bf16(a[2], a[3]); w.z = pk_bf16(b[0], b[1]); w.w = pk_bf16(b[2], b[3]);
          *(u32x4*)(h + (size_t)row * NC + col) = w;
        }
      }
  }
};

struct EpiMerge {
  static constexpr bool PERM = true, AFTER_DRAIN = false;
  const u16* h; u16* mg;
  DI void mid(f32x4 (&acc)[2][2][4][2], const pg8::Unit2& u, int wr, int wc, int fr, int fq) const {
#pragma unroll
    for (int ai = 0; ai < 2; ++ai) {
      u32x4 ga[4][2], gb[4][2];
#pragma unroll
      for (int m = 0; m < 4; ++m)
#pragma unroll
        for (int bj = 0; bj < 2; ++bj) {
          const size_t off = (size_t)(u.pm * 256 + ai * 128 + wr * 64 + m * 16 + fr) * NC + (u.pn * 256 + bj * 128 + wc * 32 + 8 * fq);
          ga[m][bj] = *(const u32x4*)(h + off + C_GA); gb[m][bj] = *(const u32x4*)(h + off + C_GB);
        }
      __builtin_amdgcn_sched_barrier(0);
#pragma unroll
      for (int m = 0; m < 4; ++m)
#pragma unroll
        for (int bj = 0; bj < 2; ++bj)
#pragma unroll
          for (int j = 0; j < 4; ++j) {
            const float r0 = (1.f + __expf(-bf_lo(gb[m][bj][j]))) * rcp_f(1.f + __expf(-bf_lo(ga[m][bj][j])));
            const float r1 = (1.f + __expf(-bf_hi(gb[m][bj][j]))) * rcp_f(1.f + __expf(-bf_hi(ga[m][bj][j])));
            acc[ai][bj][m][j >> 1][2 * (j & 1)] *= r0; acc[ai][bj][m][j >> 1][2 * (j & 1) + 1] *= r1;
          }
      __builtin_amdgcn_sched_barrier(0);
    }
  }
  DI void operator()(const f32x4 (&acc)[2][2][4][2], const pg8::Unit2& u, int wr, int wc, int fr, int fq) const {
#pragma unroll
    for (int ai = 0; ai < 2; ++ai) {
      u32x4 gb[4][2];
#pragma unroll
      for (int m = 0; m < 4; ++m)
#pragma unroll
        for (int bj = 0; bj < 2; ++bj)
          gb[m][bj] = *(const u32x4*)(h + (size_t)(u.pm * 256 + ai * 128 + wr * 64 + m * 16 + fr) * NC + C_GB + (u.pn * 256 + bj * 128 + wc * 32 + 8 * fq));
      __builtin_amdgcn_sched_barrier(0);
#pragma unroll
      for (int m = 0; m < 4; ++m)
#pragma unroll
        for (int bj = 0; bj < 2; ++bj) {
          const int row = u.pm * 256 + ai * 128 + wr * 64 + m * 16 + fr, col = u.pn * 256 + bj * 128 + wc * 32 + 8 * fq;
          const f32x4 a = acc[ai][bj][m][0], b = acc[ai][bj][m][1];
          const u32x4 g = gb[m][bj];
          u32x4 w;
          w.x = pk_bf16(a[0] * sigmoid_f(bf_lo(g[0])), a[1] * sigmoid_f(bf_hi(g[0])));
          w.y = pk_bf16(a[2] * sigmoid_f(bf_lo(g[1])), a[3] * sigmoid_f(bf_hi(g[1])));
          w.z = pk_bf16(b[0] * sigmoid_f(bf_lo(g[2])), b[1] * sigmoid_f(bf_hi(g[2])));
          w.w = pk_bf16(b[2] * sigmoid_f(bf_lo(g[3])), b[3] * sigmoid_f(bf_hi(g[3])));
          *(u32x4*)(mg + (size_t)row * 1024 + col) = w;
        }
      __builtin_amdgcn_sched_barrier(0);
    }
  }
};

struct EpiOut {
  static constexpr bool PERM = true, AFTER_DRAIN = false;
  const float* x; _Float16* r16;
  DI void operator()(const f32x4 (&acc)[2][2][4][2], const pg8::Unit& u, int wr, int wc, int fr, int fq) const {
#pragma unroll
    for (int ai = 0; ai < 2; ++ai) {
      f32x4 xv[4][2][2];
#pragma unroll
      for (int m = 0; m < 4; ++m)
#pragma unroll
        for (int bj = 0; bj < 2; ++bj) {
          const float* xp = x + (size_t)(u.pm * 256 + ai * 128 + wr * 64 + m * 16 + fr) * 1024 + (u.pn * 256 + bj * 128 + wc * 32 + 8 * fq);
          xv[m][bj][0] = *(const f32x4*)xp; xv[m][bj][1] = *(const f32x4*)(xp + 4);
        }
      __builtin_amdgcn_sched_barrier(0);
#pragma unroll
      for (int m = 0; m < 4; ++m)
#pragma unroll
        for (int bj = 0; bj < 2; ++bj) {
          const int row = u.pm * 256 + ai * 128 + wr * 64 + m * 16 + fr, col = u.pn * 256 + bj * 128 + wc * 32 + 8 * fq;
          const f32x4 v0 = xv[m][bj][0] * 1.189207115002721f + acc[ai][bj][m][0], v1 = xv[m][bj][1] * 1.189207115002721f + acc[ai][bj][m][1];
          const f16x4 h0 = __builtin_convertvector(v0, f16x4), h1 = __builtin_convertvector(v1, f16x4);
          u32x4 w; const u32x2 p0 = __builtin_bit_cast(u32x2, h0), p1 = __builtin_bit_cast(u32x2, h1);
          w.x = p0.x; w.y = p0.y; w.z = p1.x; w.w = p1.y;
          *(u32x4*)(r16 + (size_t)row * 1024 + col) = w;
        }
      __builtin_amdgcn_sched_barrier(0);
    }
  }
};

__global__ void __launch_bounds__(512, 2) fwd_megakernel(Params p) {
  cg::grid_group grid = cg::this_grid();
  __shared__ __attribute__((aligned(16))) unsigned char smem[SMEM_BYTES];
  const int w8 = __builtin_amdgcn_readfirstlane((int)(threadIdx.x >> 6));
  const int wvs = w8 & 3, half = w8 >> 2;
  unsigned char* hsm = smem + half * HALF_SMEM;
  const int vb = blockIdx.x + half * gridDim.x, nvb = 2 * gridDim.x;
  volatile LAS unsigned* st = (volatile LAS unsigned*)(smem + SMEM_BYTES - 16);
  { const int t0_ = opaque_tid(); if (t0_ < 4) st[t0_] = 0u; }
  __syncthreads();
  const XcdBarrier xb = xcd_barrier_post((unsigned*)(p.ws + OFF_BAR), st, w8);
  phase0(p, w8);
  if (p.ws == nullptr) grid.sync();
  xcd_barrier(xb);
  {
    pg8::Gemm g; g.A = (const pg8::bf16_t*)(p.ws + OFF_SC); g.Bt = (const pg8::bf16_t*)(p.ws + OFF_WINT); g.M = T_TOK; g.N = NCP; g.K = 1024;
    pg8::StaticOrder so; so.init(T_TOK, NCP, (int)gridDim.x, (int)blockIdx.x);
    EpiInProj e; e.h = (u16*)(p.ws + OFF_H);
    pg8::gemm_phase<EpiInProj, pg8::StaticOrder, true, true>((PG8_LAS unsigned char*)smem, g, so, e, opaque_tid_(w8));
  }
  xcd_barrier(xb);
  for (int it = vb; it < 2048; it += nvb) prep_item(p, wvs, it, hsm);
  xcd_barrier(xb);
  if (blockIdx.x < 128) {
    if (half == 0) { const int cb = (int)blockIdx.x; scan_chain(p, wvs, (cb & 7) + 8 * ((cb >> 3) >> 3), (cb >> 3) & 7, hsm); }
    else {
      const int cb = (int)blockIdx.x, pr = (cb & 7) + 8 * ((cb >> 3) >> 3), slp = (cb >> 3) & 7, bp = pr >> 2, hp = pr & 3;
      const int ft = opaque_tid();
      const unsigned char* pbase = p.ws + OFF_SC + (size_t)(slp * 72 + (ft < 72 ? ft : 0)) * 128;
      unsigned r0 = 0, r1 = 0, r2 = 0, r3 = 0, accp = 0;
      __syncthreads();
      for (int n = 0; n < 128; ++n) {
        accp ^= r3; r3 = r2; r2 = r1; r1 = r0;
        const int np = n + 6 < 128 ? n + 6 : 127;
        r0 = *(const unsigned*)(pbase + (size_t)((bp * 128 + np) * 4 + hp) * OPB);
        __syncthreads(); __syncthreads();
      }
      accp ^= r0 ^ r1 ^ r2 ^ r3;
      if (accp == 0x9e3779b9u && ft == 300) ((unsigned*)(p.ws + OFF_BAR))[XB_TMO + 1] = accp;
    }
  } else {
    const int nsw = 2 * ((int)gridDim.x - 128), vbl = ((int)blockIdx.x - 128) + half * ((int)gridDim.x - 128);
    for (int k = 0; k * nsw < 1024; ++k) { const int it = vbl + k * nsw; swa_item(p, wvs, it < 1024 ? it : 0, it < 1024, hsm); }
  }
  xcd_barrier(xb);
  phase_ya(p, w8);
  xcd_barrier(xb);
  {
    pg8::Gemm2 g; g.A0 = (const pg8::bf16_t*)(p.ws + OFF_H); g.A1 = g.A0 + C_SWQ; g.B0 = (const pg8::bf16_t*)(p.ws + OFF_WAT); g.B1 = (const pg8::bf16_t*)(p.ws + OFF_WBT);
    g.lda = NC; g.K = 512;
    pg8::StaticOrder2 so; so.init(T_TOK, 1024, (int)gridDim.x, (int)blockIdx.x);
    EpiMerge e; e.h = (const u16*)(p.ws + OFF_H); e.mg = (u16*)(p.ws + OFF_SC);
    pg8::gemm_phase2<EpiMerge, pg8::StaticOrder2, true, true>((PG8_LAS unsigned char*)smem, g, so, e, opaque_tid_(w8));
  }
  xcd_barrier(xb);
  {
    pg8::Gemm g; g.A = (const pg8::bf16_t*)(p.ws + OFF_SC); g.Bt = (const pg8::bf16_t*)(p.ws + OFF_WOT); g.M = T_TOK; g.N = 1024; g.K = 1024;
    pg8::StaticOrder so; so.init(T_TOK, 1024, (int)gridDim.x, (int)blockIdx.x);
    EpiOut e; e.x = p.x; e.r16 = (_Float16*)(p.ws + OFF_H);
    pg8::gemm_phase<EpiOut, pg8::StaticOrder, true, true>((PG8_LAS unsigned char*)smem, g, so, e, opaque_tid_(w8));
  }
  xcd_barrier(xb);
  phase6(p, w8, smem);
}

extern "C" void kernel_launch(void* const* d_in, const int* in_sizes, int n_in, void* d_out, int out_size,
                              void* d_ws, size_t ws_size, hipStream_t stream) {
  if (ws_size < WS_NEED) { fprintf(stderr, "workspace too small: %zu < %zu\n", ws_size, (size_t)WS_NEED); return; }
  Params p{};
  p.x = (const float*)d_in[0]; p.w_in = (const float*)d_in[1]; p.conv_w = (const float*)d_in[2]; p.a_log = (const float*)d_in[3];
  p.dt_bias = (const float*)d_in[4]; p.dn_norm_w = (const float*)d_in[5]; p.sinks = (const float*)d_in[6];
  p.w_branch = (const float*)d_in[7]; p.w_out = (const float*)d_in[8]; p.ln_g = (const float*)d_in[9]; p.ln_b = (const float*)d_in[10];
  p.out = (float*)d_out; p.ws = (unsigned char*)d_ws;
  for (int i = 0; i < 8; ++i) p.inv_freq[i] = (float)std::pow(500000.0, -(double)i / 8.0);
  static int grid_blocks = 0;
  if (!grid_blocks) {
    int dev = 0, cus = 0, per_cu = 0;
    (void)hipGetDevice(&dev);
    (void)hipDeviceGetAttribute(&cus, hipDeviceAttributeMultiprocessorCount, dev);
    (void)hipOccupancyMaxActiveBlocksPerMultiprocessor(&per_cu, fwd_megakernel, 512, 0);
    if (per_cu < 1) fprintf(stderr, "occupancy query reports %d workgroups per CU\n", per_cu);
    grid_blocks = cus > 256 ? 256 : cus;
    grid_blocks &= ~7;
  }
  (void)hipMemsetAsync(p.ws + OFF_BAR, 0, BAR_BYTES, stream);
  void* args[] = {&p};
  hipError_t e = hipLaunchCooperativeKernel((void*)fwd_megakernel, dim3(grid_blocks), dim3(512), args, 0, stream);
  if (e != hipSuccess) fprintf(stderr, "cooperative launch failed: %s (grid %d)\n", hipGetErrorString(e), grid_blocks);
}
```

```cpp
#include <hip/hip_runtime.h>
#include <hip/hip_cooperative_groups.h>
#include <cstdio>
#include <cmath>
namespace cg = cooperative_groups;

typedef unsigned short u16;
typedef short bf16x8 __attribute__((ext_vector_type(8)));
typedef float f32x4 __attribute__((ext_vector_type(4)));
typedef unsigned u32x4 __attribute__((ext_vector_type(4)));
typedef unsigned u32x2 __attribute__((ext_vector_type(2)));
typedef _Float16 f16x4 __attribute__((ext_vector_type(4)));
#define DI __device__ __forceinline__
DI int opaque_tid_(int wave_s) { int t; asm volatile("v_mbcnt_lo_u32_b32 %0, -1, 0\n\tv_mbcnt_hi_u32_b32 %0, -1, %0" : "=v"(t)); return t + (wave_s << 6); }
#define opaque_tid() opaque_tid_(wvs)

constexpr int T_TOK = 32768, SEQ = 8192, DM = 1024, NC = 5384, NCP = 5376;
constexpr int C_DNZ = 1536, C_SWQ = 2056, C_SWK = 2568, C_SWV = 2696, C_SWZ = 2824, C_GA = 3336, C_GB = 4360;
constexpr size_t OFF_BAR = 0;
constexpr size_t BAR_BYTES = 16384;
constexpr size_t OFF_WINT = BAR_BYTES;
constexpr size_t OFF_WAT = OFF_WINT + (size_t)NCP * 1024 * 2;
constexpr size_t OFF_WBT = OFF_WAT + 1024 * 512 * 2;
constexpr size_t OFF_WOT = OFF_WBT + 1024 * 512 * 2;
constexpr size_t OFF_ROPE = OFF_WOT + 1024 * 1024 * 2;
constexpr size_t OFF_HB = OFF_ROPE + 2 * 8192 * 8 * 4;
constexpr size_t OFF_DEC = OFF_HB + (size_t)T_TOK * 8 * 4;
constexpr size_t OFF_H = OFF_DEC + 2048 * 4;
constexpr size_t OFF_SC = OFF_H + (size_t)T_TOK * NC * 2;
constexpr size_t OPB = 73728;
constexpr size_t WS_NEED = OFF_SC + 2048 * OPB;
constexpr int HALF_SMEM = 73728;
constexpr int SMEM_BYTES = 2 * HALF_SMEM + 16;

struct Params {
  const float *x, *w_in, *conv_w, *a_log, *dt_bias, *dn_norm_w, *sinks, *w_branch, *w_out, *ln_g, *ln_b;
  float* out; unsigned char* ws;
  float inv_freq[8];
};

typedef __bf16 bf16x2_t __attribute__((ext_vector_type(2)));
typedef float f32x2_t __attribute__((ext_vector_type(2)));
DI unsigned pk_bf16(float lo, float hi) { f32x2_t f = {lo, hi}; bf16x2_t v = __builtin_convertvector(f, bf16x2_t); return __builtin_bit_cast(unsigned, v); }
DI float bf_lo(unsigned u) { return __uint_as_float(u << 16); }
DI float bf_hi(unsigned u) { return __uint_as_float(u & 0xffff0000u); }
DI float bf2f(u16 v) { return __uint_as_float(((unsigned)v) << 16); }
DI u16 f2bf(float f) { return (u16)(pk_bf16(f, f) & 0xffffu); }
DI float shx(float v, int m, int lane) { return __uint_as_float((unsigned)__builtin_amdgcn_ds_bpermute((lane ^ m) << 2, (int)__float_as_uint(v))); }
DI float rcp_f(float y) { return __builtin_amdgcn_rcpf(y); }
DI float silu_f(float y) { return y * rcp_f(1.0f + __expf(-y)); }
DI float sigmoid_f(float y) { return rcp_f(1.0f + __expf(-y)); }
DI f32x4 mfma16(bf16x8 a, bf16x8 b, f32x4 c) { return __builtin_amdgcn_mfma_f32_16x16x32_bf16(a, b, c, 0, 0, 0); }
DI bf16x8 as_bf8(u32x4 v) { return __builtin_bit_cast(bf16x8, v); }
DI bf16x8 pack8(f32x4 a, f32x4 b) { u32x4 w; w.x = pk_bf16(a[0], a[1]); w.y = pk_bf16(a[2], a[3]); w.z = pk_bf16(b[0], b[1]); w.w = pk_bf16(b[2], b[3]); return as_bf8(w); }

DI void phase0(const Params& p, int wvs) {
  const size_t gt = (size_t)blockIdx.x * 512 + opaque_tid(), gs = (size_t)gridDim.x * 512;
  {
    const int ltid = (int)(gt & 511), lane = ltid & 63, wv = ltid >> 6;
    float wr[16][8];
#pragma unroll
    for (int j = 0; j < 4; ++j)
#pragma unroll
      for (int c = 0; c < 4; ++c) {
        const float* wp = p.w_in + (size_t)(4 * (lane + 64 * j) + c) * NC + 2048;
        const f32x4 a = *(const f32x4*)wp, b = *(const f32x4*)(wp + 4);
#pragma unroll
        for (int q = 0; q < 4; ++q) { wr[4 * j + c][q] = a[q]; wr[4 * j + c][4 + q] = b[q]; }
      }
    u16* xb = (u16*)(p.ws + OFF_SC);
    float* hb = (float*)(p.ws + OFF_HB);
    const int rstep = gridDim.x * 8;
    for (int row0 = blockIdx.x * 8 + wv; row0 < T_TOK; row0 += 2 * rstep) {
      f32x4 xr[2][4];
#pragma unroll
      for (int u = 0; u < 2; ++u) {
        const int row = row0 + u * rstep;
#pragma unroll
        for (int j = 0; j < 4; ++j) xr[u][j] = (row < T_TOK) ? *(const f32x4*)(p.x + (size_t)row * DM + 4 * (lane + 64 * j)) : (f32x4){0.f, 0.f, 0.f, 0.f};
      }
#pragma unroll
      for (int u = 0; u < 2; ++u) {
        const int row = row0 + u * rstep;
        float v[8];
#pragma unroll
        for (int q = 0; q < 8; ++q) v[q] = 0.f;
#pragma unroll
        for (int j = 0; j < 4; ++j) {
          const f32x4 xv = xr[u][j];
          u32x2 w; w.x = pk_bf16(xv[0], xv[1]); w.y = pk_bf16(xv[2], xv[3]);
          if (row < T_TOK) *(u32x2*)(xb + (size_t)row * DM + 4 * (lane + 64 * j)) = w;
#pragma unroll
          for (int c = 0; c < 4; ++c)
#pragma unroll
            for (int q = 0; q < 8; ++q) v[q] += xv[c] * wr[4 * j + c][q];
        }
        const bool up = (lane & 32) != 0;
        float k4[4];
#pragma unroll
        for (int i = 0; i < 4; ++i) { const float snd = up ? v[i] : v[i + 4]; const float kp = up ? v[i + 4] : v[i]; k4[i] = kp + shx(snd, 32, lane); }
        const bool up2 = (lane & 16) != 0;
        float k2[2];
#pragma unroll
        for (int i = 0; i < 2; ++i) { const float snd = up2 ? k4[i] : k4[i + 2]; const float kp = up2 ? k4[i + 2] : k4[i]; k2[i] = kp + shx(snd, 16, lane); }
        const bool up3 = (lane & 8) != 0;
        float k1 = (up3 ? k2[1] : k2[0]) + shx(up3 ? k2[0] : k2[1], 8, lane);
        k1 += shx(k1, 4, lane); k1 += shx(k1, 2, lane); k1 += shx(k1, 1, lane);
        if ((lane & 7) == 0 && row < T_TOK) hb[(size_t)row * 8 + (lane >> 3)] = k1;
      }
    }
  }
  {
    u32x4* wt = (u32x4*)(p.ws + OFF_WINT);
    for (size_t i = gt; i < (size_t)NCP * 128; i += gs) {
      const int kc = (int)(i / NCP), n = (int)(i % NCP);
      float v[8];
#pragma unroll
      for (int j = 0; j < 8; ++j) v[j] = p.w_in[(size_t)(kc * 8 + j) * NC + n + (n >= 2048 ? 8 : 0)];
      u32x4 w; w.x = pk_bf16(v[0], v[1]); w.y = pk_bf16(v[2], v[3]); w.z = pk_bf16(v[4], v[5]); w.w = pk_bf16(v[6], v[7]);
      wt[(size_t)n * 128 + kc] = w;
    }
  }
  {
    for (size_t i = gt; i < (size_t)2 * 1024 * 64; i += gs) {
      const int br = (int)(i / (1024 * 64)), rem = (int)(i % (1024 * 64)), kc = rem / 1024, n = rem % 1024;
      const float* src = p.w_branch + (size_t)br * 512 * 1024;
      float v[8];
#pragma unroll
      for (int j = 0; j < 8; ++j) v[j] = src[(size_t)(kc * 8 + j) * 1024 + n];
      u32x4 w; w.x = pk_bf16(v[0], v[1]); w.y = pk_bf16(v[2], v[3]); w.z = pk_bf16(v[4], v[5]); w.w = pk_bf16(v[6], v[7]);
      ((u32x4*)(p.ws + (br ? OFF_WBT : OFF_WAT)))[(size_t)n * 64 + kc] = w;
    }
  }
  {
    for (size_t i = gt; i < (size_t)1024 * 128; i += gs) {
      const int kc = (int)(i / 1024), n = (int)(i % 1024);
      float v[8];
#pragma unroll
      for (int j = 0; j < 8; ++j) v[j] = p.w_out[(size_t)(kc * 8 + j) * 1024 + n];
      u32x4 w; w.x = pk_bf16(v[0], v[1]); w.y = pk_bf16(v[2], v[3]); w.z = pk_bf16(v[4], v[5]); w.w = pk_bf16(v[6], v[7]);
      ((u32x4*)(p.ws + OFF_WOT))[(size_t)n * 128 + kc] = w;
    }
  }
  {
    float* rc = (float*)(p.ws + OFF_ROPE); float* rs = rc + 8192 * 8;
    for (size_t i = gt; i < 8192 * 8; i += gs) {
      const int t = (int)(i >> 3), f = (int)(i & 7);
      const float ang = (float)t * p.inv_freq[f];
      const double a = (double)ang;
      const double k = __builtin_rint(a * 0.15915494309189535);
      const float r = (float)(a - k * 6.283185307179586);
      rc[i] = cosf(r); rs[i] = sinf(r);
    }
  }
}

template <int I> DI void solve_rows2(f32x2_t (&xv)[64], const float* Lm, int lane, float lcur) {
  if constexpr (I < 64) {
    float lnx = 0.f;
    if constexpr (I + 1 < 64) lnx = Lm[(I + 1) * 68 + lane];
    f32x2_t a0 = xv[I], a1 = {0.f, 0.f}, a2 = {0.f, 0.f}, a3 = {0.f, 0.f};
#pragma unroll
    for (int m = 0; m < I; ++m) {
      const float l = __builtin_bit_cast(float, __builtin_amdgcn_readlane(__builtin_bit_cast(int, lcur), m));
      const f32x2_t lv = {l, l};
      if ((m & 3) == 0) a0 -= lv * xv[m];
      else if ((m & 3) == 1) a1 -= lv * xv[m];
      else if ((m & 3) == 2) a2 -= lv * xv[m];
      else a3 -= lv * xv[m];
    }
    xv[I] = (a0 + a1) + (a2 + a3);
    solve_rows2<I + 1>(xv, Lm, lane, lnx);
  }
}

DI void prep_item(const Params& p, int wvs, int item, unsigned char* smem) {
  const int tid_ = opaque_tid();
  const int tid = tid_, lane = tid & 63, wv = tid >> 6, r16 = lane & 15, g = lane >> 4;
  const int hd = item & 3, n = (item >> 2) & 127, b = item >> 9;
  const int t0 = b * SEQ + n * 64;
  u16* Qs = (u16*)smem; u16* Ks = Qs + 64 * 136; u16* Vs = Ks + 64 * 136;
  float* Lm = (float*)(smem + 52224);
  float* sm_beta = (float*)(smem + 69632);
  float* sm_gc = sm_beta + 64; float* sm_rq = sm_gc + 64; float* sm_rk = sm_rq + 64;
  float* sm_fw = sm_rk + 64; float* sm_fq = sm_fw + 64; float* sm_fk = sm_fq + 64;
  const u16* h = (const u16*)(p.ws + OFF_H);
  const float* hb = (const float*)(p.ws + OFF_HB);
  unsigned char* op = p.ws + OFF_SC + (size_t)item * OPB;
  __syncthreads();
  float hb_bl, hb_al;
  {
    const int c2 = tid & 63, rbase = (tid >> 6) * 16;
    unsigned raw[3][19];
#pragma unroll
    for (int mat = 0; mat < 3; ++mat) {
      const int col = mat * 512 + hd * 128 + 2 * c2;
#pragma unroll
      for (int j = 0; j < 19; ++j) {
        const int rr = t0 + rbase - 3 + j;
        raw[mat][j] = *(const unsigned*)(h + (size_t)(rr < 0 ? 0 : rr) * NC + col);
      }
    }
    float2 cw[3][4];
#pragma unroll
    for (int mat = 0; mat < 3; ++mat)
#pragma unroll
      for (int j = 0; j < 4; ++j) cw[mat][j] = *(const float2*)(p.conv_w + j * 1536 + mat * 512 + hd * 128 + 2 * c2);
    hb_bl = hb[(size_t)(t0 + lane) * 8 + hd]; hb_al = hb[(size_t)(t0 + lane) * 8 + 4 + hd];
    __builtin_amdgcn_sched_barrier(0);
#pragma unroll
    for (int mat = 0; mat < 3; ++mat) {
      float wa[4], wb[4];
#pragma unroll
      for (int j = 0; j < 4; ++j) { wa[j] = cw[mat][j].x; wb[j] = cw[mat][j].y; }
      float xa[3], xb[3];
#pragma unroll
      for (int j = 0; j < 3; ++j) {
        const int pos = n * 64 + rbase - 3 + j;
        const unsigned v = (pos >= 0) ? raw[mat][j] : 0u;
        xa[j] = bf_lo(v); xb[j] = bf_hi(v);
      }
      u16* dst = (mat == 0 ? Qs : (mat == 1 ? Ks : Vs));
#pragma unroll
      for (int i = 0; i < 16; ++i) {
        const unsigned v = raw[mat][3 + i];
        const float a3 = bf_lo(v), b3 = bf_hi(v);
        const float ya = wa[0] * xa[0] + wa[1] * xa[1] + wa[2] * xa[2] + wa[3] * a3;
        const float yb = wb[0] * xb[0] + wb[1] * xb[1] + wb[2] * xb[2] + wb[3] * b3;
        xa[0] = xa[1]; xa[1] = xa[2]; xa[2] = a3; xb[0] = xb[1]; xb[1] = xb[2]; xb[2] = b3;
        *(unsigned*)(dst + (rbase + i) * 136 + 2 * c2) = pk_bf16(silu_f(ya), silu_f(yb));
      }
    }
  }
  __syncthreads();
  if (wv == 0) {
    const float bl = hb_bl, al = hb_al;
    const float xx = al + p.dt_bias[hd];
    const float ee = __expf(-fabsf(xx));
    const float sp = fmaxf(xx, 0.f) + ((ee < 1e-3f) ? ee * (1.f - 0.5f * ee) : __logf(1.f + ee));
    float gg = -__expf(p.a_log[hd]) * sp;
#pragma unroll
    for (int o = 1; o < 64; o <<= 1) { const float t = __uint_as_float((unsigned)__builtin_amdgcn_ds_bpermute(((lane - o) & 63) << 2, (int)__float_as_uint(gg))); if (lane >= o) gg += t; }
    sm_beta[lane] = rcp_f(1.0f + __expf(-bl)); sm_gc[lane] = gg;
  } else if (wv <= 2) {
    const int r = tid - 64;
    const u16* src = (r < 64) ? (Qs + r * 136) : (Ks + (r - 64) * 136);
    float ss = 0.f;
#pragma unroll
    for (int c = 0; c < 16; ++c) {
      const u32x4 v = *(const u32x4*)(src + c * 8);
#pragma unroll
      for (int j = 0; j < 4; ++j) { const float a = bf_lo(v[j]), bb = bf_hi(v[j]); ss += a * a + bb * bb; }
    }
    const float rs = rsqrtf(ss + 1e-6f);
    if (r < 64) sm_rq[r] = rs; else sm_rk[r - 64] = rs;
  }
  __syncthreads();
  if (tid < 64) {
    const float gc = sm_gc[tid], gl = sm_gc[63], eg = __expf(gc);
    sm_fw[tid] = sm_beta[tid] * eg * sm_rk[tid];
    sm_fq[tid] = sm_rq[tid] * 0.08838834764831845f * eg;
    sm_fk[tid] = sm_rk[tid] * __expf(gl - gc);
    if (tid == 0) ((float*)(p.ws + OFF_DEC))[item] = __expf(gl);
  }
  {
    bf16x8 kfi[4], qfi[4];
#pragma unroll
    for (int s = 0; s < 4; ++s) {
      kfi[s] = *(const bf16x8*)(Ks + (16 * wv + r16) * 136 + 32 * s + 8 * g);
      qfi[s] = *(const bf16x8*)(Qs + (16 * wv + r16) * 136 + 32 * s + 8 * g);
    }
    f32x4 at[4];
#pragma unroll
    for (int jt = 0; jt < 4; ++jt) {
      at[jt] = (f32x4){0.f, 0.f, 0.f, 0.f};
      if (jt <= wv) {
        f32x4 la = (f32x4){0.f, 0.f, 0.f, 0.f}, aa = (f32x4){0.f, 0.f, 0.f, 0.f};
#pragma unroll
        for (int s = 0; s < 4; ++s) {
          const bf16x8 kfj = *(const bf16x8*)(Ks + (16 * jt + r16) * 136 + 32 * s + 8 * g);
          la = mfma16(kfi[s], kfj, la);
          aa = mfma16(kfj, qfi[s], aa);
        }
#pragma unroll
        for (int r = 0; r < 4; ++r) {
          { const int i = 16 * wv + 4 * g + r, j = 16 * jt + r16;
            const float v = (i > j) ? sm_beta[i] * sm_rk[i] * sm_rk[j] * __expf(sm_gc[i] - sm_gc[j]) * la[r] : 0.f;
            Lm[i * 68 + j] = v; }
          { const int j = 16 * jt + 4 * g + r, i = 16 * wv + r16;
            at[jt][r] = (j <= i) ? sm_rq[i] * sm_rk[j] * 0.08838834764831845f * __expf(sm_gc[i] - sm_gc[j]) * aa[r] : 0.f; }
        }
      }
    }
#pragma unroll
    for (int s2 = 0; s2 < 2; ++s2)
      *(bf16x8*)(op + 32768 + (size_t)((wv * 2 + s2) * 64 + lane) * 16) = pack8(at[2 * s2], at[2 * s2 + 1]);
  }
  __syncthreads();
  f32x2_t xv[64];
  if (wv < 2) {
#pragma unroll
    for (int i = 0; i < 64; ++i) { xv[i].x = sm_beta[i] * bf2f(Vs[i * 136 + tid]); xv[i].y = sm_fw[i] * bf2f(Ks[i * 136 + tid]); }
    solve_rows2<1>(xv, Lm, lane, Lm[68 + lane]);
    const int sl = tid >> 4, dvl = tid & 15;
#pragma unroll
    for (int mt = 0; mt < 4; ++mt)
#pragma unroll
      for (int gg = 0; gg < 4; ++gg) {
        u32x2 w; w.x = pk_bf16(xv[16 * mt + 4 * gg].x, xv[16 * mt + 4 * gg + 1].x); w.y = pk_bf16(xv[16 * mt + 4 * gg + 2].x, xv[16 * mt + 4 * gg + 3].x);
        *(u32x2*)(op + 57344 + (size_t)((sl * 4 + mt) * 64 + gg * 16 + dvl) * 8) = w;
      }
  } else {
    const int t2 = tid - 128;
#pragma unroll 2
    for (int f = 0; f < 8; ++f) {
      const int e = t2 + 128 * f, frag = e >> 6, ln = e & 63, lr = ln & 15, lg = ln >> 4;
      {
        const int mt = frag >> 2, sx = frag & 3, row = 16 * mt + lr;
        const u32x2 ql = *(const u32x2*)(Qs + row * 136 + 32 * sx + 4 * lg), qh = *(const u32x2*)(Qs + row * 136 + 32 * sx + 16 + 4 * lg);
        const float fq = sm_fq[row];
        u32x4 w;
        w.x = pk_bf16(bf_lo(ql.x) * fq, bf_hi(ql.x) * fq); w.y = pk_bf16(bf_lo(ql.y) * fq, bf_hi(ql.y) * fq);
        w.z = pk_bf16(bf_lo(qh.x) * fq, bf_hi(qh.x) * fq); w.w = pk_bf16(bf_lo(qh.y) * fq, bf_hi(qh.y) * fq);
        *(u32x4*)(op + 16384 + (size_t)e * 16) = w;
      }
      {
        const int mt8 = frag >> 1, s2 = frag & 1, dk = 16 * mt8 + lr;
        float v[8];
#pragma unroll
        for (int j = 0; j < 8; ++j) {
          const int pos = 32 * s2 + 16 * (j >> 2) + 4 * lg + (j & 3);
          v[j] = bf2f(Ks[pos * 136 + dk]) * sm_fk[pos];
        }
        u32x4 w; w.x = pk_bf16(v[0], v[1]); w.y = pk_bf16(v[2], v[3]); w.z = pk_bf16(v[4], v[5]); w.w = pk_bf16(v[6], v[7]);
        *(u32x4*)(op + 40960 + (size_t)e * 16) = w;
      }
    }
  }
  __syncthreads();
  if (wv < 2) {
#pragma unroll
    for (int i = 0; i < 64; ++i) Vs[i * 136 + tid] = f2bf(-xv[i].y);
  }
  __syncthreads();
#pragma unroll
  for (int f = 0; f < 4; ++f) {
    const int e = tid + 256 * f, frag = e >> 6, ln = e & 63, lr = ln & 15, lg = ln >> 4;
    const int mt = frag >> 2, sx = frag & 3, row = 16 * mt + lr;
    const u32x2 lo = *(const u32x2*)(Vs + row * 136 + 32 * sx + 4 * lg), hi = *(const u32x2*)(Vs + row * 136 + 32 * sx + 16 + 4 * lg);
    *(u32x4*)(op + (size_t)e * 16) = (u32x4){lo.x, lo.y, hi.x, hi.y};
  }
}

struct ScanA { u32x4 wf[4]; u32x2 uf; float dec; };
struct ScanB { u32x4 qf[4], af[2], kf[4]; };

DI void scan_load_a(const Params& p, int wvs, ScanA& o, int b, int hd, int sl, int n, int q, int lane) {
  const int item = (b * 128 + n) * 4 + hd;
  const unsigned char* op = p.ws + OFF_SC + (size_t)item * OPB;
#pragma unroll
  for (int s = 0; s < 4; ++s) {
    o.wf[s] = *(const u32x4*)(op + (size_t)((q * 4 + s) * 64 + lane) * 16);
  }
  o.uf = *(const u32x2*)(op + 57344 + (size_t)((sl * 4 + q) * 64 + lane) * 8);
  o.dec = ((const float*)(p.ws + OFF_DEC))[item];
}
DI void scan_load_b(const Params& p, int wvs, ScanB& o, int b, int hd, int n, int q, int lane) {
  const int item = (b * 128 + n) * 4 + hd;
  const unsigned char* op = p.ws + OFF_SC + (size_t)item * OPB;
#pragma unroll
  for (int s = 0; s < 4; ++s) o.qf[s] = *(const u32x4*)(op + 16384 + (size_t)((q * 4 + s) * 64 + lane) * 16);
#pragma unroll
  for (int s2 = 0; s2 < 2; ++s2) o.af[s2] = *(const u32x4*)(op + 32768 + (size_t)((q * 2 + s2) * 64 + lane) * 16);
#pragma unroll
  for (int j = 0; j < 4; ++j) o.kf[j] = *(const u32x4*)(op + 40960 + (size_t)((q * 4 + j) * 64 + lane) * 16);
}

DI void scan_step(const Params& p, int wvs, const ScanA& o, const ScanB& ob, f32x4 (&S)[2], int b, int hd, int sl, int n, int q, int lane, unsigned char* smem) {
  const int r16 = lane & 15, g = lane >> 4;
  u32x4* ldsS = (u32x4*)smem;
  u32x2* ldsV = (u32x2*)(smem + 4096);
  ldsS[q * 64 + lane] = __builtin_bit_cast(u32x4, pack8(S[0], S[1]));
  __syncthreads();
  bf16x8 Sb[4];
#pragma unroll
  for (int s = 0; s < 4; ++s) Sb[s] = as_bf8(ldsS[s * 64 + lane]);
  f32x4 vn = (f32x4){bf_lo(o.uf.x), bf_hi(o.uf.x), bf_lo(o.uf.y), bf_hi(o.uf.y)};
#pragma unroll
  for (int s = 0; s < 4; ++s) vn = mfma16(as_bf8(o.wf[s]), Sb[s], vn);
  { u32x2 w; w.x = pk_bf16(vn[0], vn[1]); w.y = pk_bf16(vn[2], vn[3]); ldsV[((q >> 1) * 64 + lane) * 2 + (q & 1)] = w; }
  f32x4 oa = (f32x4){0.f, 0.f, 0.f, 0.f};
#pragma unroll
  for (int s = 0; s < 4; ++s) oa = mfma16(as_bf8(ob.qf[s]), Sb[s], oa);
  __syncthreads();
  bf16x8 Vb[2];
#pragma unroll
  for (int s2 = 0; s2 < 2; ++s2) Vb[s2] = as_bf8(*(const u32x4*)(ldsV + (s2 * 64 + lane) * 2));
#pragma unroll
  for (int s2 = 0; s2 < 2; ++s2) oa = mfma16(as_bf8(ob.af[s2]), Vb[s2], oa);
  u16* h = (u16*)(p.ws + OFF_H);
  const int t0 = b * SEQ + n * 64;
#pragma unroll
  for (int r = 0; r < 4; ++r) h[(size_t)(t0 + 16 * q + 4 * g + r) * NC + hd * 128 + 16 * sl + r16] = f2bf(oa[r]);
#pragma unroll
  for (int t = 0; t < 2; ++t) {
    S[t] = S[t] * o.dec;
#pragma unroll
    for (int s2 = 0; s2 < 2; ++s2) S[t] = mfma16(as_bf8(ob.kf[t * 2 + s2]), Vb[s2], S[t]);
  }
}

DI void scan_chain(const Params& p, int wvs, int pair, int sl, unsigned char* smem) {
  const int tid0 = opaque_tid(); const int lane = tid0 & 63, q = tid0 >> 6;
  const int b = pair >> 2, hd = pair & 3;
  f32x4 S[2]; S[0] = (f32x4){0.f, 0.f, 0.f, 0.f}; S[1] = S[0];
  ScanA a0, a1, a2; ScanB bc, bn;
  __syncthreads();
  scan_load_a(p, wvs, a0, b, hd, sl, 0, q, lane);
  scan_load_b(p, wvs, bc, b, hd, 0, q, lane);
  scan_load_a(p, wvs, a1, b, hd, sl, 1, q, lane);
#pragma unroll 1
  for (int n = 0; n < 129; n += 3) {
    if (n + 2 < 128) scan_load_a(p, wvs, a2, b, hd, sl, n + 2, q, lane);
    if (n + 1 < 128) scan_load_b(p, wvs, bn, b, hd, n + 1, q, lane);
    if (n < 128) scan_step(p, wvs, a0, bc, S, b, hd, sl, n, q, lane, smem);
    bc = bn;
    if (n + 3 < 128) scan_load_a(p, wvs, a0, b, hd, sl, n + 3, q, lane);
    if (n + 2 < 128) scan_load_b(p, wvs, bn, b, hd, n + 2, q, lane);
    if (n + 1 < 128) scan_step(p, wvs, a1, bc, S, b, hd, sl, n + 1, q, lane, smem);
    bc = bn;
    if (n + 4 < 128) scan_load_a(p, wvs, a1, b, hd, sl, n + 4, q, lane);
    if (n + 3 < 128) scan_load_b(p, wvs, bn, b, hd, n + 3, q, lane);
    if (n + 2 < 128) scan_step(p, wvs, a2, bc, S, b, hd, sl, n + 2, q, lane, smem);
    bc = bn;
  }
}

DI void swa_item(const Params& p, int wvs, int item, bool valid, unsigned char* smem) {
  if (!valid) { __syncthreads(); __syncthreads(); return; }
  const int tid_ = opaque_tid();
  const int tid = tid_, lane = tid & 63, wv = tid >> 6, r16 = lane & 15, g = lane >> 4;
  const int qt = item & 127, kvh = (item >> 7) & 1, b = item >> 8;
  const int kp0 = 64 * qt - 128;
  u16* Ksm = (u16*)smem;
  u16* Vt = (u16*)(smem + 27648);
  u16* h = (u16*)(p.ws + OFF_H);
  const float* rc = (const float*)(p.ws + OFF_ROPE); const float* rs = rc + 8192 * 8;
  __syncthreads();
  if (tid < 192) {
    const int kk = tid, pos = kp0 + kk;
    u32x4 lo = (u32x4){0, 0, 0, 0}, hi = lo;
    if (pos >= 0) {
      const u16* src = h + (size_t)(b * SEQ + pos) * NC + C_SWK + kvh * 64;
      const u32x4 a = *(const u32x4*)src, c = *(const u32x4*)(src + 8);
      const f32x4 c0 = *(const f32x4*)(rc + pos * 8), c1 = *(const f32x4*)(rc + pos * 8 + 4);
      const f32x4 s0 = *(const f32x4*)(rs + pos * 8), s1 = *(const f32x4*)(rs + pos * 8 + 4);
      float t1[8], t2[8], cs[8], sn[8], o1[8], o2[8];
#pragma unroll
      for (int j = 0; j < 4; ++j) { t1[2 * j] = bf_lo(a[j]); t1[2 * j + 1] = bf_hi(a[j]); t2[2 * j] = bf_lo(c[j]); t2[2 * j + 1] = bf_hi(c[j]);
        cs[j] = c0[j]; cs[4 + j] = c1[j]; sn[j] = s0[j]; sn[4 + j] = s1[j]; }
#pragma unroll
      for (int j = 0; j < 8; ++j) { o1[j] = t1[j] * cs[j] - t2[j] * sn[j]; o2[j] = t2[j] * cs[j] + t1[j] * sn[j]; }
#pragma unroll
      for (int j = 0; j < 4; ++j) { lo[j] = pk_bf16(o1[2 * j], o1[2 * j + 1]); hi[j] = pk_bf16(o2[2 * j], o2[2 * j + 1]); }
    }
    *(u32x4*)(Ksm + kk * 72) = lo; *(u32x4*)(Ksm + kk * 72 + 8) = hi;
  }
  for (int e = tid; e < 192 * 6; e += 256) {
    const int kk = e / 6, ch = 2 + e % 6, pos = kp0 + kk;
    u32x4 v = (u32x4){0, 0, 0, 0};
    if (pos >= 0) v = *(const u32x4*)(h + (size_t)(b * SEQ + pos) * NC + C_SWK + kvh * 64 + ch * 8);
    *(u32x4*)(Ksm + kk * 72 + ch * 8) = v;
  }
  for (int e = tid; e < 192 * 8; e += 256) {
    const int kk = e >> 3, ch = e & 7, pos = kp0 + kk;
    u32x4 v = (u32x4){0, 0, 0, 0};
    if (pos >= 0) v = *(const u32x4*)(h + (size_t)(b * SEQ + pos) * NC + C_SWV + kvh * 64 + ch * 8);
#pragma unroll
    for (int j = 0; j < 4; ++j) { Vt[(ch * 8 + 2 * j) * 200 + kk] = (u16)(v[j] & 0xffffu); Vt[(ch * 8 + 2 * j + 1) * 200 + kk] = (u16)(v[j] >> 16); }
  }
  __syncthreads();
  const int st = wv, jt0 = st < 2 ? st : 2;
  const int qi = 16 * st + r16;
  const int qpos = 64 * qt + qi, tq = b * SEQ + qpos;
#pragma unroll 1
  for (int hq = 0; hq < 4; ++hq) {
    const int head = kvh * 4 + hq;
    u16* qsrc = h + (size_t)tq * NC + C_SWQ + head * 64;
    bf16x8 qf[2];
    {
      const u32x4 a = *(const u32x4*)qsrc, c = *(const u32x4*)(qsrc + 8);
      u32x4 w = *(const u32x4*)(qsrc + 8 * g);
      if (g < 2) {
        const f32x4 c0 = *(const f32x4*)(rc + qpos * 8), c1 = *(const f32x4*)(rc + qpos * 8 + 4);
        const f32x4 s0 = *(const f32x4*)(rs + qpos * 8), s1 = *(const f32x4*)(rs + qpos * 8 + 4);
        float t1[8], t2[8], cs[8], sn[8], o[8];
#pragma unroll
        for (int j = 0; j < 4; ++j) { t1[2 * j] = bf_lo(a[j]); t1[2 * j + 1] = bf_hi(a[j]); t2[2 * j] = bf_lo(c[j]); t2[2 * j + 1] = bf_hi(c[j]);
          cs[j] = c0[j]; cs[4 + j] = c1[j]; sn[j] = s0[j]; sn[4 + j] = s1[j]; }
#pragma unroll
        for (int j = 0; j < 8; ++j) o[j] = (g == 0) ? (t1[j] * cs[j] - t2[j] * sn[j]) : (t2[j] * cs[j] + t1[j] * sn[j]);
#pragma unroll
        for (int j = 0; j < 4; ++j) w[j] = pk_bf16(o[2 * j], o[2 * j + 1]);
      }
      qf[0] = as_bf8(w);
      qf[1] = as_bf8(*(const u32x4*)(qsrc + 32 + 8 * g));
    }
    f32x4 sc[10];
#pragma unroll
    for (int t = 0; t < 10; ++t) {
      sc[t] = (f32x4){0.f, 0.f, 0.f, 0.f};
#pragma unroll
      for (int s = 0; s < 2; ++s) {
        const bf16x8 kf = *(const bf16x8*)(Ksm + (16 * (jt0 + t) + r16) * 72 + 32 * s + 8 * g);
        sc[t] = mfma16(kf, qf[s], sc[t]);
      }
    }
    const float sink = p.sinks[head];
    float mx = sink;
#pragma unroll
    for (int t = 0; t < 10; ++t)
#pragma unroll
      for (int r = 0; r < 4; ++r) {
        const int kk = 16 * (jt0 + t) + 4 * g + r, d = kk - qi;
        const bool ok = (d >= 1) && (d <= 128) && (kp0 + kk >= 0);
        const float v = ok ? sc[t][r] * 0.125f : -1e30f;
        sc[t][r] = v; mx = fmaxf(mx, v);
      }
    mx = fmaxf(mx, shx(mx, 16, lane)); mx = fmaxf(mx, shx(mx, 32, lane));
    float sum = 0.f;
#pragma unroll
    for (int t = 0; t < 10; ++t)
#pragma unroll
      for (int r = 0; r < 4; ++r) { const float e = __expf(sc[t][r] - mx); sc[t][r] = e; sum += e; }
    sum += shx(sum, 16, lane); sum += shx(sum, 32, lane);
    const float inv = rcp_f(sum + __expf(sink - mx));
    f32x4 oacc[4];
#pragma unroll
    for (int dt = 0; dt < 4; ++dt) oacc[dt] = (f32x4){0.f, 0.f, 0.f, 0.f};
#pragma unroll
    for (int s2 = 0; s2 < 5; ++s2) {
      const bf16x8 pb = pack8(sc[2 * s2], sc[2 * s2 + 1]);
#pragma unroll
      for (int dt = 0; dt < 4; ++dt) {
        const u16* vr = Vt + (16 * dt + r16) * 200 + 16 * (jt0 + 2 * s2) + 4 * g;
        const u32x2 lo = *(const u32x2*)vr, hi = *(const u32x2*)(vr + 16);
        oacc[dt] = mfma16(as_bf8((u32x4){lo.x, lo.y, hi.x, hi.y}), pb, oacc[dt]);
      }
    }
#pragma unroll
    for (int dt = 0; dt < 4; ++dt) {
      const int dcol = head * 64 + 16 * dt + 4 * g;
      const u32x2 z = *(const u32x2*)(h + (size_t)tq * NC + C_SWZ + dcol);
      u32x2 w;
      w.x = pk_bf16(oacc[dt][0] * inv * silu_f(bf_lo(z.x)), oacc[dt][1] * inv * silu_f(bf_hi(z.x)));
      w.y = pk_bf16(oacc[dt][2] * inv * silu_f(bf_lo(z.y)), oacc[dt][3] * inv * silu_f(bf_hi(z.y)));
      *(u32x2*)(h + (size_t)tq * NC + C_SWQ + dcol) = w;
    }
  }
}

DI void phase_ya(const Params& p, int wvs) {
  u16* h = (u16*)(p.ws + OFF_H);
  const int ltid = opaque_tid(), lane = ltid & 63;
  const size_t gt = (size_t)blockIdx.x * 512 + ltid, gs = (size_t)gridDim.x * 512;
  const float* nwp = p.dn_norm_w + (ltid & 15) * 8;
  const f32x4 nw0 = *(const f32x4*)nwp, nw1 = *(const f32x4*)(nwp + 4);
  for (size_t i0 = gt; i0 < (size_t)T_TOK * 64; i0 += 4 * gs) {
    u32x4 v[4], z[4];
#pragma unroll
    for (int k = 0; k < 4; ++k) {
      const size_t i = i0 + k * gs;
      if (i < (size_t)T_TOK * 64) {
        const u16* ptr = h + (size_t)(i >> 6) * NC + (i & 63) * 8;
        v[k] = *(const u32x4*)ptr; z[k] = *(const u32x4*)(ptr + C_DNZ);
      } else { v[k] = (u32x4){0, 0, 0, 0}; z[k] = v[k]; }
    }
#pragma unroll
    for (int k = 0; k < 4; ++k) {
      const size_t i = i0 + k * gs;
      float o[8]; float ss = 0.f;
#pragma unroll
      for (int j = 0; j < 4; ++j) { o[2 * j] = bf_lo(v[k][j]); o[2 * j + 1] = bf_hi(v[k][j]); }
#pragma unroll
      for (int j = 0; j < 8; ++j) ss += o[j] * o[j];
      ss += shx(ss, 1, lane); ss += shx(ss, 2, lane); ss += shx(ss, 4, lane); ss += shx(ss, 8, lane);
      const float rs = rsqrtf(ss * (1.0f / 128.0f) + 1e-6f);
      float y[8];
#pragma unroll
      for (int j = 0; j < 4; ++j) {
        const float w0 = (j < 2) ? nw0[2 * j] : nw1[2 * j - 4], w1 = (j < 2) ? nw0[2 * j + 1] : nw1[2 * j - 3];
        y[2 * j] = o[2 * j] * rs * w0 * silu_f(bf_lo(z[k][j]));
        y[2 * j + 1] = o[2 * j + 1] * rs * w1 * silu_f(bf_hi(z[k][j]));
      }
      u32x4 w; w.x = pk_bf16(y[0], y[1]); w.y = pk_bf16(y[2], y[3]); w.z = pk_bf16(y[4], y[5]); w.w = pk_bf16(y[6], y[7]);
      if (i < (size_t)T_TOK * 64) *(u32x4*)(h + (size_t)(i >> 6) * NC + (i & 63) * 8) = w;
    }
  }
}

DI float wave_sum(float v, int lane) {
#pragma unroll
  for (int o = 32; o > 0; o >>= 1) v += shx(v, o, lane);
  return v;
}
DI void phase6(const Params& p, int wvs, unsigned char* smem) {
  const int tid = opaque_tid(), lane = tid & 63, wv = tid >> 6;
  f32x4 gm[4], bt[4];
#pragma unroll
  for (int j = 0; j < 4; ++j) { gm[j] = *(const f32x4*)(p.ln_g + 4 * (lane + 64 * j)); bt[j] = *(const f32x4*)(p.ln_b + 4 * (lane + 64 * j)); }
  const int xcd6 = blockIdx.x & 7, lb6 = blockIdx.x >> 3, nlb6 = gridDim.x >> 3;
  for (int lr = (lb6 * 8 + wv) * 2; lr < 4096; lr += nlb6 * 16) {
    const int row0 = 4096 * xcd6 + (4095 - lr), row1 = row0 - 1;
    float* r0 = p.out + (size_t)row0 * 1024;
    float* r1 = p.out + (size_t)row1 * 1024;
    const _Float16* s0 = (const _Float16*)(p.ws + OFF_H) + (size_t)row0 * 1024;
    const _Float16* s1 = (const _Float16*)(p.ws + OFF_H) + (size_t)row1 * 1024;
    f32x4 a[4], b[4];
#pragma unroll
    for (int j = 0; j < 4; ++j) {
      a[j] = __builtin_convertvector(*(const f16x4*)(s0 + 4 * (lane + 64 * j)), f32x4);
      b[j] = __builtin_convertvector(*(const f16x4*)(s1 + 4 * (lane + 64 * j)), f32x4);
    }
    float sa = 0.f, sb = 0.f;
#pragma unroll
    for (int j = 0; j < 4; ++j) { sa += (a[j][0] + a[j][1]) + (a[j][2] + a[j][3]); sb += (b[j][0] + b[j][1]) + (b[j][2] + b[j][3]); }
    const float ma = wave_sum(sa, lane) * (1.0f / 1024.0f), mb = wave_sum(sb, lane) * (1.0f / 1024.0f);
    float qa = 0.f, qb = 0.f;
#pragma unroll
    for (int j = 0; j < 4; ++j) {
      a[j] = a[j] - ma; b[j] = b[j] - mb;
      qa += (a[j][0] * a[j][0] + a[j][1] * a[j][1]) + (a[j][2] * a[j][2] + a[j][3] * a[j][3]);
      qb += (b[j][0] * b[j][0] + b[j][1] * b[j][1]) + (b[j][2] * b[j][2] + b[j][3] * b[j][3]);
    }
    const float ra = rsqrtf(wave_sum(qa, lane) * (1.0f / 1024.0f) + 1e-5f), rb = rsqrtf(wave_sum(qb, lane) * (1.0f / 1024.0f) + 1e-5f);
#pragma unroll
    for (int j = 0; j < 4; ++j) {
      *(f32x4*)(r0 + 4 * (lane + 64 * j)) = a[j] * ra * gm[j] + bt[j];
      *(f32x4*)(r1 + 4 * (lane + 64 * j)) = b[j] * rb * gm[j] + bt[j];
    }
  }
}

#define XB_TMO      128
#define XB_XCNT(j)  (256  + 64 * (j))
#define XB_XSUB(j)  (1280 + 64 * (j))
#define XB_XGEN(j)  (2304 + 64 * (j))
#define XB_TOP      3328
#define XB_TOPGEN   3392
#define XCD_BAR_WORDS 3456
#define XB_SPIN_CAP (1u << 22)
#define LAS __attribute__((address_space(3)))
DI unsigned xb_ld(unsigned* p) { return __hip_atomic_load(p, __ATOMIC_RELAXED, __HIP_MEMORY_SCOPE_AGENT); }
DI unsigned xb_add(unsigned* p, unsigned v) { return __hip_atomic_fetch_add(p, v, __ATOMIC_RELAXED, __HIP_MEMORY_SCOPE_AGENT); }
DI unsigned xb_xcc_id() { return (unsigned)__builtin_amdgcn_s_getreg((3 << 11) | 20) & 0xFu; }
#define XB_SPIN(cond, bar) do { unsigned _sp = 0; while (cond) { __builtin_amdgcn_s_sleep(1); \
    if ((++_sp & 255u) == 0u) { if (xb_ld(&(bar)[XB_TMO])) break; if (_sp > XB_SPIN_CAP) { atomicAdd(&(bar)[XB_TMO], 1u); break; } } } } while (0)
struct XcdBarrier { unsigned* bar; unsigned x; volatile LAS unsigned* st; };
DI bool xb_leader(int wvs) { return wvs == 0 && __builtin_amdgcn_mbcnt_hi(~0u, __builtin_amdgcn_mbcnt_lo(~0u, 0u)) == 0u; }
DI XcdBarrier xcd_barrier_post(unsigned* bar, volatile LAS unsigned* st, int wvs) {
  XcdBarrier b; b.bar = bar; b.x = xb_xcc_id(); b.st = st;
  if (xb_leader(wvs)) (void)xb_add(&bar[XB_XCNT(b.x)], 1u);
  return b;
}
DI void xcd_barrier_complete(unsigned* bar, unsigned x, unsigned& nloc, unsigned& nx) {
  const unsigned G = gridDim.x * gridDim.y * gridDim.z;
  unsigned sum, cnt, mine, sp = 0u;
  for (;;) {
    sum = 0u; cnt = 0u; mine = 0u;
#pragma unroll
    for (unsigned j = 0; j < 16; ++j) { const unsigned c = xb_ld(&bar[XB_XCNT(j)]); sum += c; cnt += (c > 0u) ? 1u : 0u; mine = (j == x) ? c : mine; }
    if (sum == G) break;
    __builtin_amdgcn_s_sleep(1);
    if ((++sp & 255u) == 0u) { if (xb_ld(&bar[XB_TMO])) break; if (sp > XB_SPIN_CAP) { atomicAdd(&bar[XB_TMO], 1u); break; } }
  }
  nloc = mine > 0u ? mine : 1u; nx = cnt > 0u ? cnt : 1u;
}
DI void xcd_barrier_(const XcdBarrier& b, int wvs) {
  asm volatile("s_waitcnt vmcnt(0)" ::: "memory");
  __syncthreads();
  if (xb_leader(wvs)) {
    unsigned* bar = b.bar;
    __builtin_amdgcn_s_waitcnt(0);
    unsigned nloc = b.st[0], nx = b.st[1];
    if (nloc == 0u) { xcd_barrier_complete(bar, b.x, nloc, nx); b.st[0] = nloc; b.st[1] = nx; }
    const unsigned old = xb_add(&bar[XB_XSUB(b.x)], 1u);
    const unsigned gen = old / nloc;
    if (old + 1u == (gen + 1u) * nloc) {
      __builtin_amdgcn_fence(__ATOMIC_RELEASE, "agent");
      asm volatile("s_waitcnt vmcnt(0)" ::: "memory");
      const unsigned og = xb_add(&bar[XB_TOP], 1u);
      const unsigned tg = og / nx;
      if (og + 1u == (tg + 1u) * nx) xb_add(&bar[XB_TOPGEN], 1u);
      else XB_SPIN(xb_ld(&bar[XB_TOPGEN]) == tg, bar);
      __builtin_amdgcn_fence(__ATOMIC_ACQUIRE, "agent");
      xb_add(&bar[XB_XGEN(b.x)], 1u);
      asm volatile("s_waitcnt vmcnt(0)" ::: "memory");
    } else {
      XB_SPIN(xb_ld(&bar[XB_XGEN(b.x)]) == gen, bar);
      __builtin_amdgcn_fence(__ATOMIC_ACQUIRE, "agent");
      asm volatile("s_waitcnt vmcnt(0)" ::: "memory");
    }
  }
  __syncthreads();
}

#define xcd_barrier(b) xcd_barrier_(b, w8)
namespace pg8 {
#define PG8_LAS __attribute__((address_space(3)))
typedef unsigned short bf16_t;
typedef short bf16x8 __attribute__((ext_vector_type(8)));
typedef float f32x4 __attribute__((ext_vector_type(4)));
typedef unsigned u32x4 __attribute__((ext_vector_type(4)));
constexpr int BM = 256, BK = 64, HALF = 128, HTB = HALF * BK * 2  , STAGE_BYTES = 8 * HTB, NXCD = 8, WGM = 8;

__host__ __device__ __forceinline__ int lds_byte(int r, int c) { const int st = (r >> 4) * 2 + (c >> 5), rr = r & 15, cc = c & 31, ob = rr * 64 + cc * 2; return st * 1024 + (ob ^ (((ob >> 9) & 1) << 5)); }
__host__ __device__ __forceinline__ void stage_rc(int b, int& R, int& C) { const int st = b / 1024, sb = b % 1024, swz = sb ^ (((sb >> 9) & 1) << 5); R = (st >> 1) * 16 + swz / 64; C = (st & 1) * 32 + (swz % 64) / 2; }
__host__ __device__ __forceinline__ int perm32(int rho) { const int n = rho >> 4, i = rho & 15; return 8 * (i >> 2) + 4 * n + (i & 3); }

struct Unit { int pm, pn; };
struct Gemm { const bf16_t* A; const bf16_t* Bt; int M, N, K; };

struct StaticOrder {
    int nM, nN, nwg, G, c;
    __host__ __device__ void init(int M, int N, int G_, int c_) { nM = M / BM; nN = N / BM; nwg = nM * nN; G = G_; c = c_; }
    __host__ __device__ bool next(int i, Unit& u) const {
        const long L = (long)i * G + c; if (L >= nwg) return false;
        int wgid = (int)L; { const int q = nwg / NXCD, r = nwg % NXCD, xcd = wgid % NXCD, off = wgid / NXCD; wgid = (xcd < r ? xcd * (q + 1) : r * (q + 1) + (xcd - r) * q) + off; }
        const int nig = WGM * nN, gid = wgid / nig, fm = gid * WGM, gsz = (nM - fm) < WGM ? (nM - fm) : WGM;
        u.pm = fm + ((wgid % nig) % gsz); u.pn = (wgid % nig) / gsz; return true;
    }
    __device__ __forceinline__ void a_ready(const Unit&) const {}
    __device__ __forceinline__ void done(const Unit&) const {}
};

template <class Epi, class Sched, bool ALIGN_EPI = false, bool SP2 = false>
__device__ __forceinline__ void gemm_phase(PG8_LAS unsigned char* lds, const Gemm g, const Sched& S, const Epi& E, const int tid) {
    const int wid = __builtin_amdgcn_readfirstlane(tid >> 6), lane = tid & 63, wr = wid >> 2, wc = wid & 3, fr = lane & 15, fq = lane >> 4;
    const int K = g.K, nt = K / BK;
    unsigned voffA[2], voffB[2];
#pragma unroll
    for (int i = 0; i < 2; ++i) { int R, C; stage_rc(tid * 16 + i * 8192, R, C); const int Rb = Epi::PERM ? ((R & ~31) + perm32(R & 31)) : R;
        voffA[i] = (unsigned)(R * K + C) * 2u; voffB[i] = (unsigned)(Rb * K + C) * 2u; }
    const size_t kstep = (size_t)(BK * 2);
    const size_t hstep = (size_t)HALF * K * 2;
    const size_t tstep = 2 * hstep;
    const unsigned ldsw = (unsigned)wid * 1024u;
    const int aoff = lds_byte(wr * 64 + fr, fq * 8), boff = lds_byte(wc * 32 + fr, fq * 8);
#define PG8_SA(b, h) (((b) * 2 + (h)) * HTB)
#define PG8_SB(b, h) ((4 + (b) * 2 + (h)) * HTB)
#define PG8_STAGE(bufoff, gbase, voff) do { _Pragma("unroll") for (int _i = 0; _i < 2; ++_i) \
        __builtin_amdgcn_global_load_lds((const unsigned*)((const char*)(gbase) + (voff)[_i]), (PG8_LAS unsigned*)(lds + (bufoff) + ldsw + _i * 8192), 16, 0, 0); } while (0)
#define PG8_LDA(dst, b, h) do { _Pragma("unroll") for (int m = 0; m < 4; ++m) _Pragma("unroll") for (int k = 0; k < 2; ++k) dst[m][k] = *(const PG8_LAS bf16x8*)(lds + PG8_SA(b, h) + aoff + m * 2048 + k * 1024); } while (0)
#define PG8_LDB(dst, b, h) do { _Pragma("unroll") for (int n = 0; n < 2; ++n) _Pragma("unroll") for (int k = 0; k < 2; ++k) dst[n][k] = *(const PG8_LAS bf16x8*)(lds + PG8_SB(b, h) + boff + n * 2048 + k * 1024); } while (0)
#define PG8_MMA(ai, bj, At, Bt) do { __builtin_amdgcn_s_setprio(1); _Pragma("unroll") for (int m = 0; m < 4; ++m) _Pragma("unroll") for (int n = 0; n < 2; ++n) _Pragma("unroll") for (int k = 0; k < 2; ++k) \
        acc[ai][bj][m][n] = __builtin_amdgcn_mfma_f32_16x16x32_bf16(Bt[n][k], At[m][k], acc[ai][bj][m][n], 0, 0, 0); __builtin_amdgcn_s_setprio(0); } while (0)
#define PG8_WAIT_V(n) asm volatile("s_waitcnt vmcnt(" #n ")" ::: "memory")
#define PG8_WAIT_L(n) asm volatile("s_waitcnt lgkmcnt(" #n ")" ::: "memory")
#define PG8_BAR __builtin_amdgcn_s_barrier()
#define PG8_SCHED __builtin_amdgcn_sched_barrier(0)
    Unit cur, nxt; int ui = 0;
    if (!S.next(0, cur)) return;
    f32x4 acc[2][2][4][2];
#pragma unroll
    for (int a = 0; a < 2; ++a)
#pragma unroll
        for (int b = 0; b < 2; ++b)
#pragma unroll
            for (int m = 0; m < 4; ++m)
#pragma unroll
                for (int n = 0; n < 2; ++n) acc[a][b][m][n] = (f32x4){0.f, 0.f, 0.f, 0.f};
    bf16x8 At[4][2], B0[2][2], B1[2][2];
    const char* cA = (const char*)g.A + (size_t)cur.pm * tstep; const char* cB = (const char*)g.Bt + (size_t)cur.pn * tstep;
    S.a_ready(cur);
    if constexpr (SP2) {
        PG8_STAGE(PG8_SB(0, 0), cB, voffB); PG8_STAGE(PG8_SB(0, 1), cB + hstep, voffB); PG8_STAGE(PG8_SA(0, 0), cA, voffA); PG8_STAGE(PG8_SA(0, 1), cA + hstep, voffA);
        if (wr == 1) PG8_BAR;
        PG8_WAIT_V(2); PG8_BAR;
        PG8_STAGE(PG8_SB(1, 0), cB + kstep, voffB); PG8_STAGE(PG8_SA(1, 0), cA + kstep, voffA); PG8_STAGE(PG8_SB(1, 1), cB + hstep + kstep, voffB);
        PG8_WAIT_V(6); PG8_BAR;
    } else {
        PG8_STAGE(PG8_SB(0, 0), cB, voffB); PG8_STAGE(PG8_SA(0, 0), cA, voffA); PG8_STAGE(PG8_SB(0, 1), cB + hstep, voffB); PG8_STAGE(PG8_SA(0, 1), cA + hstep, voffA);
        if (wr == 1) PG8_BAR;
        PG8_WAIT_V(4); PG8_BAR;
        PG8_STAGE(PG8_SB(1, 0), cB + kstep, voffB); PG8_STAGE(PG8_SA(1, 0), cA + kstep, voffA); PG8_STAGE(PG8_SB(1, 1), cB + hstep + kstep, voffB);
        PG8_WAIT_V(6); PG8_BAR;
    }
    for (;;) {
        const bool has_next = S.next(ui + 1, nxt);
        const char* nA = has_next ? (const char*)g.A + (size_t)nxt.pm * tstep : cA; const char* nB = has_next ? (const char*)g.Bt + (size_t)nxt.pn * tstep : cB;
        for (int t = 0; t < nt; t += 2) {
            const bool last = (t == nt - 2);
            const char* a1 = cA + (size_t)(t + 1) * kstep;
            const char* a2 = last ? nA : cA + (size_t)(t + 2) * kstep; const char* b2 = last ? nB : cB + (size_t)(t + 2) * kstep;
            const char* a3 = a2 + kstep; const char* b3 = b2 + kstep;
            if (last && has_next) S.a_ready(nxt);
            if constexpr (SP2) {
            PG8_LDB(B0, 0, 0); PG8_LDB(B1, 0, 1); PG8_SCHED; PG8_LDA(At, 0, 0); PG8_STAGE(PG8_SA(1, 1), a1 + hstep, voffA);
            PG8_WAIT_V(8); PG8_WAIT_L(0); PG8_BAR; PG8_MMA(0, 0, At, B0); PG8_MMA(0, 1, At, B1); PG8_BAR; PG8_SCHED;
            PG8_LDA(At, 0, 1); PG8_STAGE(PG8_SB(0, 0), b2, voffB); PG8_STAGE(PG8_SB(0, 1), b2 + hstep, voffB); PG8_STAGE(PG8_SA(0, 0), a2, voffA);
            PG8_WAIT_V(8); PG8_WAIT_L(0); PG8_BAR; PG8_MMA(1, 0, At, B0); PG8_MMA(1, 1, At, B1); PG8_BAR; PG8_SCHED;
            PG8_LDB(B0, 1, 0); PG8_LDB(B1, 1, 1); PG8_SCHED; PG8_LDA(At, 1, 0); PG8_STAGE(PG8_SA(0, 1), a2 + hstep, voffA);
            PG8_WAIT_V(8); PG8_WAIT_L(0); PG8_BAR; PG8_MMA(0, 0, At, B0); PG8_MMA(0, 1, At, B1); PG8_BAR; PG8_SCHED;
            PG8_LDA(At, 1, 1); PG8_STAGE(PG8_SB(1, 0), b3, voffB); PG8_STAGE(PG8_SB(1, 1), b3 + hstep, voffB); PG8_STAGE(PG8_SA(1, 0), a3, voffA);
            PG8_WAIT_V(8); PG8_WAIT_L(0); PG8_BAR; PG8_MMA(1, 0, At, B0); PG8_MMA(1, 1, At, B1); PG8_BAR; PG8_SCHED;
            } else {
            PG8_LDB(B0, 0, 0); PG8_SCHED; PG8_LDA(At, 0, 0); PG8_STAGE(PG8_SA(1, 1), a1 + hstep, voffA);
            PG8_WAIT_L(8); PG8_BAR; PG8_WAIT_L(0); PG8_MMA(0, 0, At, B0); PG8_BAR; PG8_SCHED;
            PG8_LDB(B1, 0, 1); PG8_STAGE(PG8_SB(0, 0), b2, voffB);
            PG8_BAR; PG8_WAIT_L(0); PG8_MMA(0, 1, At, B1); PG8_BAR;
            PG8_LDA(At, 0, 1); PG8_STAGE(PG8_SA(0, 0), a2, voffA);
            PG8_BAR; PG8_WAIT_L(0); PG8_MMA(1, 0, At, B0); PG8_BAR; PG8_SCHED;
            PG8_STAGE(PG8_SB(0, 1), b2 + hstep, voffB);
            PG8_WAIT_V(6); PG8_BAR; PG8_MMA(1, 1, At, B1); PG8_BAR;
            PG8_LDB(B0, 1, 0); PG8_SCHED; PG8_LDA(At, 1, 0); PG8_STAGE(PG8_SA(0, 1), a2 + hstep, voffA);
            PG8_WAIT_L(8); PG8_BAR; PG8_WAIT_L(0); PG8_MMA(0, 0, At, B0); PG8_BAR; PG8_SCHED;
            PG8_LDB(B1, 1, 1); PG8_STAGE(PG8_SB(1, 0), b3, voffB);
            PG8_BAR; PG8_WAIT_L(0); PG8_MMA(0, 1, At, B1); PG8_BAR;
            PG8_LDA(At, 1, 1); PG8_STAGE(PG8_SA(1, 0), a3, voffA);
            PG8_BAR; PG8_WAIT_L(0); PG8_MMA(1, 0, At, B0); PG8_BAR; PG8_SCHED;
            PG8_STAGE(PG8_SB(1, 1), b3 + hstep, voffB);
            PG8_WAIT_V(6); PG8_BAR; PG8_MMA(1, 1, At, B1); PG8_BAR;
            }
        }
        if constexpr (ALIGN_EPI) { if (wr == 0) PG8_BAR; }
        if constexpr (!Epi::AFTER_DRAIN) { E(acc, cur, wr, wc, fr, fq); S.done(cur); }
        if (!has_next) break;
#pragma unroll
        for (int a = 0; a < 2; ++a)
#pragma unroll
            for (int b = 0; b < 2; ++b)
#pragma unroll
                for (int m = 0; m < 4; ++m)
#pragma unroll
                    for (int n = 0; n < 2; ++n) acc[a][b][m][n] = (f32x4){0.f, 0.f, 0.f, 0.f};
        cur = nxt; cA = nA; cB = nB; ++ui;
        if constexpr (ALIGN_EPI) { if (wr == 1) PG8_BAR; }
    }
    PG8_WAIT_V(0);
    if constexpr (!ALIGN_EPI) { if (wr == 0) PG8_BAR; }
    PG8_BAR;
    if constexpr (Epi::AFTER_DRAIN) { E.fused(acc, cur, wr, wc, fr, fq, lds, wid, lane); S.done(cur); }
#undef PG8_SA
#undef PG8_SB
#undef PG8_STAGE
#undef PG8_LDA
#undef PG8_LDB
#undef PG8_MMA
#undef PG8_WAIT_V
#undef PG8_WAIT_L
#undef PG8_BAR
#undef PG8_SCHED
}

struct Unit2 { int pm, pn, part; };
struct Gemm2 { const bf16_t* A0; const bf16_t* A1; const bf16_t* B0; const bf16_t* B1; int lda, K; };
struct StaticOrder2 {
    int nM, nN, nwg, G, c;
    __host__ __device__ void init(int M, int N, int G_, int c_) { nM = M / BM; nN = N / BM; nwg = nM * nN; G = G_; c = c_; }
    __host__ __device__ bool next(int i, Unit2& u) const {
        const long L = (long)(i >> 1) * G + c; if (L >= nwg) return false;
        int wgid = (int)L; { const int q = nwg / NXCD, r = nwg % NXCD, xcd = wgid % NXCD, off = wgid / NXCD; wgid = (xcd < r ? xcd * (q + 1) : r * (q + 1) + (xcd - r) * q) + off; }
        const int nig = WGM * nN, gid = wgid / nig, fm = gid * WGM, gsz = (nM - fm) < WGM ? (nM - fm) : WGM;
        u.pm = fm + ((wgid % nig) % gsz); u.pn = (wgid % nig) / gsz; u.part = i & 1; return true;
    }
    __device__ __forceinline__ void a_ready(const Unit2&) const {}
    __device__ __forceinline__ void done(const Unit2&) const {}
};
template <class Epi, class Sched, bool ALIGN_EPI = false, bool SP2 = false>
__device__ __forceinline__ void gemm_phase2(PG8_LAS unsigned char* lds, const Gemm2 g, const Sched& S, const Epi& E, const int tid) {
    const int wid = __builtin_amdgcn_readfirstlane(tid >> 6), lane = tid & 63, wr = wid >> 2, wc = wid & 3, fr = lane & 15, fq = lane >> 4;
    const int K = g.K, nt = K / BK;
    unsigned voffA[2], voffB[2];
#pragma unroll
    for (int i = 0; i < 2; ++i) { int R, C; stage_rc(tid * 16 + i * 8192, R, C); const int Rb = Epi::PERM ? ((R & ~31) + perm32(R & 31)) : R;
        voffA[i] = (unsigned)(R * g.lda + C) * 2u; voffB[i] = (unsigned)(Rb * K + C) * 2u; }
    const size_t kstep = (size_t)(BK * 2);
    const size_t hstep = (size_t)HALF * K * 2;
    const size_t tstep = 2 * hstep;
    const size_t hstepA = (size_t)HALF * g.lda * 2, tstepA = 2 * hstepA;
    const unsigned ldsw = (unsigned)wid * 1024u;
    const int aoff = lds_byte(wr * 64 + fr, fq * 8), boff = lds_byte(wc * 32 + fr, fq * 8);
#define PG8_SA(b, h) (((b) * 2 + (h)) * HTB)
#define PG8_SB(b, h) ((4 + (b) * 2 + (h)) * HTB)
#define PG8_STAGE(bufoff, gbase, voff) do { _Pragma("unroll") for (int _i = 0; _i < 2; ++_i) \
        __builtin_amdgcn_global_load_lds((const unsigned*)((const char*)(gbase) + (voff)[_i]), (PG8_LAS unsigned*)(lds + (bufoff) + ldsw + _i * 8192), 16, 0, 0); } while (0)
#define PG8_LDA(dst, b, h) do { _Pragma("unroll") for (int m = 0; m < 4; ++m) _Pragma("unroll") for (int k = 0; k < 2; ++k) dst[m][k] = *(const PG8_LAS bf16x8*)(lds + PG8_SA(b, h) + aoff + m * 2048 + k * 1024); } while (0)
#define PG8_LDB(dst, b, h) do { _Pragma("unroll") for (int n = 0; n < 2; ++n) _Pragma("unroll") for (int k = 0; k < 2; ++k) dst[n][k] = *(const PG8_LAS bf16x8*)(lds + PG8_SB(b, h) + boff + n * 2048 + k * 1024); } while (0)
#define PG8_MMA(ai, bj, At, Bt) do { __builtin_amdgcn_s_setprio(1); _Pragma("unroll") for (int m = 0; m < 4; ++m) _Pragma("unroll") for (int n = 0; n < 2; ++n) _Pragma("unroll") for (int k = 0; k < 2; ++k) \
        acc[ai][bj][m][n] = __builtin_amdgcn_mfma_f32_16x16x32_bf16(Bt[n][k], At[m][k], acc[ai][bj][m][n], 0, 0, 0); __builtin_amdgcn_s_setprio(0); } while (0)
#define PG8_WAIT_V(n) asm volatile("s_waitcnt vmcnt(" #n ")" ::: "memory")
#define PG8_WAIT_L(n) asm volatile("s_waitcnt lgkmcnt(" #n ")" ::: "memory")
#define PG8_BAR __builtin_amdgcn_s_barrier()
#define PG8_SCHED __builtin_amdgcn_sched_barrier(0)
    Unit2 cur, nxt; int ui = 0;
    if (!S.next(0, cur)) return;
    f32x4 acc[2][2][4][2];
#pragma unroll
    for (int a = 0; a < 2; ++a)
#pragma unroll
        for (int b = 0; b < 2; ++b)
#pragma unroll
            for (int m = 0; m < 4; ++m)
#pragma unroll
                for (int n = 0; n < 2; ++n) acc[a][b][m][n] = (f32x4){0.f, 0.f, 0.f, 0.f};
    bf16x8 At[4][2], B0[2][2], B1[2][2];
    const char* cA = (const char*)(cur.part ? g.A1 : g.A0) + (size_t)cur.pm * tstepA; const char* cB = (const char*)(cur.part ? g.B1 : g.B0) + (size_t)cur.pn * tstep;
    S.a_ready(cur);
    if constexpr (SP2) {
        PG8_STAGE(PG8_SB(0, 0), cB, voffB); PG8_STAGE(PG8_SB(0, 1), cB + hstep, voffB); PG8_STAGE(PG8_SA(0, 0), cA, voffA); PG8_STAGE(PG8_SA(0, 1), cA + hstepA, voffA);
        if (wr == 1) PG8_BAR;
        PG8_WAIT_V(2); PG8_BAR;
        PG8_STAGE(PG8_SB(1, 0), cB + kstep, voffB); PG8_STAGE(PG8_SA(1, 0), cA + kstep, voffA); PG8_STAGE(PG8_SB(1, 1), cB + hstep + kstep, voffB);
        PG8_WAIT_V(6); PG8_BAR;
    } else {
        PG8_STAGE(PG8_SB(0, 0), cB, voffB); PG8_STAGE(PG8_SA(0, 0), cA, voffA); PG8_STAGE(PG8_SB(0, 1), cB + hstep, voffB); PG8_STAGE(PG8_SA(0, 1), cA + hstepA, voffA);
        if (wr == 1) PG8_BAR;
        PG8_WAIT_V(4); PG8_BAR;
        PG8_STAGE(PG8_SB(1, 0), cB + kstep, voffB); PG8_STAGE(PG8_SA(1, 0), cA + kstep, voffA); PG8_STAGE(PG8_SB(1, 1), cB + hstep + kstep, voffB);
        PG8_WAIT_V(6); PG8_BAR;
    }
    for (;;) {
        const bool has_next = S.next(ui + 1, nxt);
        const char* nA = has_next ? (const char*)(nxt.part ? g.A1 : g.A0) + (size_t)nxt.pm * tstepA : cA; const char* nB = has_next ? (const char*)(nxt.part ? g.B1 : g.B0) + (size_t)nxt.pn * tstep : cB;
        for (int t = 0; t < nt; t += 2) {
            const bool last = (t == nt - 2);
            const char* a1 = cA + (size_t)(t + 1) * kstep;
            const char* a2 = last ? nA : cA + (size_t)(t + 2) * kstep; const char* b2 = last ? nB : cB + (size_t)(t + 2) * kstep;
            const char* a3 = a2 + kstep; const char* b3 = b2 + kstep;
            if (last && has_next) S.a_ready(nxt);
            if constexpr (SP2) {
            PG8_LDB(B0, 0, 0); PG8_LDB(B1, 0, 1); PG8_SCHED; PG8_LDA(At, 0, 0); PG8_STAGE(PG8_SA(1, 1), a1 + hstepA, voffA);
            PG8_WAIT_V(8); PG8_WAIT_L(0); PG8_BAR; PG8_MMA(0, 0, At, B0); PG8_MMA(0, 1, At, B1); PG8_BAR; PG8_SCHED;
            PG8_LDA(At, 0, 1); PG8_STAGE(PG8_SB(0, 0), b2, voffB); PG8_STAGE(PG8_SB(0, 1), b2 + hstep, voffB); PG8_STAGE(PG8_SA(0, 0), a2, voffA);
            PG8_WAIT_V(8); PG8_WAIT_L(0); PG8_BAR; PG8_MMA(1, 0, At, B0); PG8_MMA(1, 1, At, B1); PG8_BAR; PG8_SCHED;
            PG8_LDB(B0, 1, 0); PG8_LDB(B1, 1, 1); PG8_SCHED; PG8_LDA(At, 1, 0); PG8_STAGE(PG8_SA(0, 1), a2 + hstepA, voffA);
            PG8_WAIT_V(8); PG8_WAIT_L(0); PG8_BAR; PG8_MMA(0, 0, At, B0); PG8_MMA(0, 1, At, B1); PG8_BAR; PG8_SCHED;
            PG8_LDA(At, 1, 1); PG8_STAGE(PG8_SB(1, 0), b3, voffB); PG8_STAGE(PG8_SB(1, 1), b3 + hstep, voffB); PG8_STAGE(PG8_SA(1, 0), a3, voffA);
            PG8_WAIT_V(8); PG8_WAIT_L(0); PG8_BAR; PG8_MMA(1, 0, At, B0); PG8_MMA(1, 1, At, B1); PG8_BAR; PG8_SCHED;
            } else {
            PG8_LDB(B0, 0, 0); PG8_SCHED; PG8_LDA(At, 0, 0); PG8_STAGE(PG8_SA(1, 1), a1 + hstepA, voffA);
            PG8_WAIT_L(8); PG8_BAR; PG8_WAIT_L(0); PG8_MMA(0, 0, At, B0); PG8_BAR; PG8_SCHED;
            PG8_LDB(B1, 0, 1); PG8_STAGE(PG8_SB(0, 0), b2, voffB);
            PG8_BAR; PG8_WAIT_L(0); PG8_MMA(0, 1, At, B1); PG8_BAR;
            PG8_LDA(At, 0, 1); PG8_STAGE(PG8_SA(0, 0), a2, voffA);
            PG8_BAR; PG8_WAIT_L(0); PG8_MMA(1, 0, At, B0); PG8_BAR; PG8_SCHED;
            PG8_STAGE(PG8_SB(0, 1), b2 + hstep, voffB);
            PG8_WAIT_V(6); PG8_BAR; PG8_MMA(1, 1, At, B1); PG8_BAR;
            PG8_LDB(B0, 1, 0); PG8_SCHED; PG8_LDA(At, 1, 0); PG8_STAGE(PG8_SA(0, 1), a2 + hstepA, voffA);
            PG8_WAIT_L(8); PG8_BAR; PG8_WAIT_L(0); PG8_MMA(0, 0, At, B0); PG8_BAR; PG8_SCHED;
            PG8_LDB(B1, 1, 1); PG8_STAGE(PG8_SB(1, 0), b3, voffB);
            PG8_BAR; PG8_WAIT_L(0); PG8_MMA(0, 1, At, B1); PG8_BAR;
            PG8_LDA(At, 1, 1); PG8_STAGE(PG8_SA(1, 0), a3, voffA);
            PG8_BAR; PG8_WAIT_L(0); PG8_MMA(1, 0, At, B0); PG8_BAR; PG8_SCHED;
            PG8_STAGE(PG8_SB(1, 1), b3 + hstep, voffB);
            PG8_WAIT_V(6); PG8_BAR; PG8_MMA(1, 1, At, B1); PG8_BAR;
            }
        }
        if constexpr (ALIGN_EPI) { if (wr == 0) PG8_BAR; }
        if (cur.part == 0) E.mid(acc, cur, wr, wc, fr, fq); else E(acc, cur, wr, wc, fr, fq);
        if (!has_next) break;
        if (cur.part == 1) {
#pragma unroll
        for (int a = 0; a < 2; ++a)
#pragma unroll
            for (int b = 0; b < 2; ++b)
#pragma unroll
                for (int m = 0; m < 4; ++m)
#pragma unroll
                    for (int n = 0; n < 2; ++n) acc[a][b][m][n] = (f32x4){0.f, 0.f, 0.f, 0.f};
        }
        cur = nxt; cA = nA; cB = nB; ++ui;
        if constexpr (ALIGN_EPI) { if (wr == 1) PG8_BAR; }
    }
    PG8_WAIT_V(0);
    if constexpr (!ALIGN_EPI) { if (wr == 0) PG8_BAR; }
    PG8_BAR;
#undef PG8_SA
#undef PG8_SB
#undef PG8_STAGE
#undef PG8_LDA
#undef PG8_LDB
#undef PG8_MMA
#undef PG8_WAIT_V
#undef PG8_WAIT_L
#undef PG8_BAR
#undef PG8_SCHED
}
}

struct EpiInProj {
  static constexpr bool PERM = true, AFTER_DRAIN = false;
  u16* h;
  DI void operator()(const f32x4 (&acc)[2][2][4][2], const pg8::Unit& u, int wr, int wc, int fr, int fq) const {
    const int shift = (u.pn >= 8) ? 8 : 0;
#pragma unroll
    for (int ai = 0; ai < 2; ++ai)
#pragma unroll
      for (int m = 0; m < 4; ++m) {
        const int row = u.pm * 256 + ai * 128 + wr * 64 + m * 16 + fr;
#pragma unroll
        for (int bj = 0; bj < 2; ++bj) {
          const int col = u.pn * 256 + bj * 128 + wc * 32 + 8 * fq + shift;
          const f32x4 a = acc[ai][bj][m][0], b = acc[ai][bj][m][1];
          u32x4 w; w.x = pk_bf16(a[0], a[1]); w.y = pk_bf16(a[2], a[3]); w.z = pk_bf16(b[0], b[1]); w.w = pk_bf16(b[2], b[3]);
          *(u32x4*)(h + (size_t)row * NC + col) = w;
        }
      }
  }
};

struct EpiMerge {
  static constexpr bool PERM = true, AFTER_DRAIN = false;
  const u16* h; u16* mg;
  DI void mid(f32x4 (&acc)[2][2][4][2], const pg8::Unit2& u, int wr, int wc, int fr, int fq) const {
#pragma unroll
    for (int ai = 0; ai < 2; ++ai) {
      u32x4 ga[4][2], gb[4][2];
#pragma unroll
      for (int m = 0; m < 4; ++m)
#pragma unroll
        for (int bj = 0; bj < 2; ++bj) {
          const size_t off = (size_t)(u.pm * 256 + ai * 128 + wr * 64 + m * 16 + fr) * NC + (u.pn * 256 + bj * 128 + wc * 32 + 8 * fq);
          ga[m][bj] = *(const u32x4*)(h + off + C_GA); gb[m][bj] = *(const u32x4*)(h + off + C_GB);
        }
      __builtin_amdgcn_sched_barrier(0);
#pragma unroll
      for (int m = 0; m < 4; ++m)
#pragma unroll
        for (int bj = 0; bj < 2; ++bj)
#pragma unroll
          for (int j = 0; j < 4; ++j) {
            const float r0 = (1.f + __expf(-bf_lo(gb[m][bj][j]))) * rcp_f(1.f + __expf(-bf_lo(ga[m][bj][j])));
            const float r1 = (1.f + __expf(-bf_hi(gb[m][bj][j]))) * rcp_f(1.f + __expf(-bf_hi(ga[m][bj][j])));
            acc[ai][bj][m][j >> 1][2 * (j & 1)] *= r0; acc[ai][bj][m][j >> 1][2 * (j & 1) + 1] *= r1;
          }
      __builtin_amdgcn_sched_barrier(0);
    }
  }
  DI void operator()(const f32x4 (&acc)[2][2][4][2], const pg8::Unit2& u, int wr, int wc, int fr, int fq) const {
#pragma unroll
    for (int ai = 0; ai < 2; ++ai) {
      u32x4 gb[4][2];
#pragma unroll
      for (int m = 0; m < 4; ++m)
#pragma unroll
        for (int bj = 0; bj < 2; ++bj)
          gb[m][bj] = *(const u32x4*)(h + (size_t)(u.pm * 256 + ai * 128 + wr * 64 + m * 16 + fr) * NC + C_GB + (u.pn * 256 + bj * 128 + wc * 32 + 8 * fq));
      __builtin_amdgcn_sched_barrier(0);
#pragma unroll
      for (int m = 0; m < 4; ++m)
#pragma unroll
        for (int bj = 0; bj < 2; ++bj) {
          const int row = u.pm * 256 + ai * 128 + wr * 64 + m * 16 + fr, col = u.pn * 256 + bj * 128 + wc * 32 + 8 * fq;
          const f32x4 a = acc[ai][bj][m][0], b = acc[ai][bj][m][1];
          const u32x4 g = gb[m][bj];
          u32x4 w;
          w.x = pk_bf16(a[0] * sigmoid_f(bf_lo(g[0])), a[1] * sigmoid_f(bf_hi(g[0])));
          w.y = pk_bf16(a[2] * sigmoid_f(bf_lo(g[1])), a[3] * sigmoid_f(bf_hi(g[1])));
          w.z = pk_bf16(b[0] * sigmoid_f(bf_lo(g[2])), b[1] * sigmoid_f(bf_hi(g[2])));
          w.w = pk_bf16(b[2] * sigmoid_f(bf_lo(g[3])), b[3] * sigmoid_f(bf_hi(g[3])));
          *(u32x4*)(mg + (size_t)row * 1024 + col) = w;
        }
      __builtin_amdgcn_sched_barrier(0);
    }
  }
};

struct EpiOut {
  static constexpr bool PERM = true, AFTER_DRAIN = false;
  const float* x; _Float16* r16;
  DI void operator()(const f32x4 (&acc)[2][2][4][2], const pg8::Unit& u, int wr, int wc, int fr, int fq) const {
#pragma unroll
    for (int ai = 0; ai < 2; ++ai) {
      f32x4 xv[4][2][2];
#pragma unroll
      for (int m = 0; m < 4; ++m)
#pragma unroll
        for (int bj = 0; bj < 2; ++bj) {
          const float* xp = x + (size_t)(u.pm * 256 + ai * 128 + wr * 64 + m * 16 + fr) * 1024 + (u.pn * 256 + bj * 128 + wc * 32 + 8 * fq);
          xv[m][bj][0] = *(const f32x4*)xp; xv[m][bj][1] = *(const f32x4*)(xp + 4);
        }
      __builtin_amdgcn_sched_barrier(0);
#pragma unroll
      for (int m = 0; m < 4; ++m)
#pragma unroll
        for (int bj = 0; bj < 2; ++bj) {
          const int row = u.pm * 256 + ai * 128 + wr * 64 + m * 16 + fr, col = u.pn * 256 + bj * 128 + wc * 32 + 8 * fq;
          const f32x4 v0 = xv[m][bj][0] * 1.189207115002721f + acc[ai][bj][m][0], v1 = xv[m][bj][1] * 1.189207115002721f + acc[ai][bj][m][1];
          const f16x4 h0 = __builtin_convertvector(v0, f16x4), h1 = __builtin_convertvector(v1, f16x4);
          u32x4 w; const u32x2 p0 = __builtin_bit_cast(u32x2, h0), p1 = __builtin_bit_cast(u32x2, h1);
          w.x = p0.x; w.y = p0.y; w.z = p1.x; w.w = p1.y;
          *(u32x4*)(r16 + (size_t)row * 1024 + col) = w;
        }
      __builtin_amdgcn_sched_barrier(0);
    }
  }
};

__global__ void __launch_bounds__(512, 2) fwd_megakernel(Params p) {
  cg::grid_group grid = cg::this_grid();
  __shared__ __attribute__((aligned(16))) unsigned char smem[SMEM_BYTES];
  const int w8 = __builtin_amdgcn_readfirstlane((int)(threadIdx.x >> 6));
  const int wvs = w8 & 3, half = w8 >> 2;
  unsigned char* hsm = smem + half * HALF_SMEM;
  const int vb = blockIdx.x + half * gridDim.x, nvb = 2 * gridDim.x;
  volatile LAS unsigned* st = (volatile LAS unsigned*)(smem + SMEM_BYTES - 16);
  { const int t0_ = opaque_tid(); if (t0_ < 4) st[t0_] = 0u; }
  __syncthreads();
  const XcdBarrier xb = xcd_barrier_post((unsigned*)(p.ws + OFF_BAR), st, w8);
  phase0(p, w8);
  if (p.ws == nullptr) grid.sync();
  xcd_barrier(xb);
  {
    pg8::Gemm g; g.A = (const pg8::bf16_t*)(p.ws + OFF_SC); g.Bt = (const pg8::bf16_t*)(p.ws + OFF_WINT); g.M = T_TOK; g.N = NCP; g.K = 1024;
    pg8::StaticOrder so; so.init(T_TOK, NCP, (int)gridDim.x, (int)blockIdx.x);
    EpiInProj e; e.h = (u16*)(p.ws + OFF_H);
    pg8::gemm_phase<EpiInProj, pg8::StaticOrder, true, true>((PG8_LAS unsigned char*)smem, g, so, e, opaque_tid_(w8));
  }
  xcd_barrier(xb);
  for (int it = vb; it < 2048; it += nvb) prep_item(p, wvs, it, hsm);
  xcd_barrier(xb);
  if (blockIdx.x < 128) {
    if (half == 0) { const int cb = (int)blockIdx.x; scan_chain(p, wvs, (cb & 7) + 8 * ((cb >> 3) >> 3), (cb >> 3) & 7, hsm); }
    else {
      const int cb = (int)blockIdx.x, pr = (cb & 7) + 8 * ((cb >> 3) >> 3), slp = (cb >> 3) & 7, bp = pr >> 2, hp = pr & 3;
      const int ft = opaque_tid();
      const unsigned char* pbase = p.ws + OFF_SC + (size_t)(slp * 72 + (ft < 72 ? ft : 0)) * 128;
      unsigned pr0 = 0, pr1 = 0, pr2 = 0, pr3 = 0, accp = 0;
      __syncthreads();
#define P_ITER(m_, K0) do { accp ^= pr##K0; { const int np_ = (m_) + 6 < 128 ? (m_) + 6 : 127; pr##K0 = *(const unsigned*)(pbase + (size_t)((bp * 128 + np_) * 4 + hp) * OPB); } \
        __syncthreads(); __syncthreads(); } while (0)
#pragma unroll 1
      for (int mm = 0; mm < 128; mm += 4) { P_ITER(mm, 0); P_ITER(mm + 1, 1); P_ITER(mm + 2, 2); P_ITER(mm + 3, 3); }
#undef P_ITER
      accp ^= pr0 ^ pr1 ^ pr2 ^ pr3;
      if (accp == 0x9e3779b9u && ft == 300) ((unsigned*)(p.ws + OFF_BAR))[XB_TMO + 1] = accp;
    }
  } else {
    const int nsw = 2 * ((int)gridDim.x - 128), vbl = ((int)blockIdx.x - 128) + half * ((int)gridDim.x - 128);
    for (int k = 0; k * nsw < 1024; ++k) { const int it = vbl + k * nsw; swa_item(p, wvs, it < 1024 ? it : 0, it < 1024, hsm); }
  }
  xcd_barrier(xb);
  phase_ya(p, w8);
  xcd_barrier(xb);
  {
    pg8::Gemm2 g; g.A0 = (const pg8::bf16_t*)(p.ws + OFF_H); g.A1 = g.A0 + C_SWQ; g.B0 = (const pg8::bf16_t*)(p.ws + OFF_WAT); g.B1 = (const pg8::bf16_t*)(p.ws + OFF_WBT);
    g.lda = NC; g.K = 512;
    pg8::StaticOrder2 so; so.init(T_TOK, 1024, (int)gridDim.x, (int)blockIdx.x);
    EpiMerge e; e.h = (const u16*)(p.ws + OFF_H); e.mg = (u16*)(p.ws + OFF_SC);
    pg8::gemm_phase2<EpiMerge, pg8::StaticOrder2, true, true>((PG8_LAS unsigned char*)smem, g, so, e, opaque_tid_(w8));
  }
  xcd_barrier(xb);
  {
    pg8::Gemm g; g.A = (const pg8::bf16_t*)(p.ws + OFF_SC); g.Bt = (const pg8::bf16_t*)(p.ws + OFF_WOT); g.M = T_TOK; g.N = 1024; g.K = 1024;
    pg8::StaticOrder so; so.init(T_TOK, 1024, (int)gridDim.x, (int)blockIdx.x);
    EpiOut e; e.x = p.x; e.r16 = (_Float16*)(p.ws + OFF_H);
    pg8::gemm_phase<EpiOut, pg8::StaticOrder, true, true>((PG8_LAS unsigned char*)smem, g, so, e, opaque_tid_(w8));
  }
  xcd_barrier(xb);
  phase6(p, w8, smem);
}

extern "C" void kernel_launch(void* const* d_in, const int* in_sizes, int n_in, void* d_out, int out_size,
                              void* d_ws, size_t ws_size, hipStream_t stream) {
  if (ws_size < WS_NEED) { fprintf(stderr, "workspace too small: %zu < %zu\n", ws_size, (size_t)WS_NEED); return; }
  Params p{};
  p.x = (const float*)d_in[0]; p.w_in = (const float*)d_in[1]; p.conv_w = (const float*)d_in[2]; p.a_log = (const float*)d_in[3];
  p.dt_bias = (const float*)d_in[4]; p.dn_norm_w = (const float*)d_in[5]; p.sinks = (const float*)d_in[6];
  p.w_branch = (const float*)d_in[7]; p.w_out = (const float*)d_in[8]; p.ln_g = (const float*)d_in[9]; p.ln_b = (const float*)d_in[10];
  p.out = (float*)d_out; p.ws = (unsigned char*)d_ws;
  for (int i = 0; i < 8; ++i) p.inv_freq[i] = (float)std::pow(500000.0, -(double)i / 8.0);
  static int grid_blocks = 0;
  if (!grid_blocks) {
    int dev = 0, cus = 0, per_cu = 0;
    (void)hipGetDevice(&dev);
    (void)hipDeviceGetAttribute(&cus, hipDeviceAttributeMultiprocessorCount, dev);
    (void)hipOccupancyMaxActiveBlocksPerMultiprocessor(&per_cu, fwd_megakernel, 512, 0);
    if (per_cu < 1) fprintf(stderr, "occupancy query reports %d workgroups per CU\n", per_cu);
    grid_blocks = cus > 256 ? 256 : cus;
    grid_blocks &= ~7;
  }
  (void)hipMemsetAsync(p.ws + OFF_BAR, 0, BAR_BYTES, stream);
  void* args[] = {&p};
  hipError_t e = hipLaunchCooperativeKernel((void*)fwd_megakernel, dim3(grid_blocks), dim3(512), args, 0, stream);
  if (e != hipSuccess) fprintf(stderr, "cooperative launch failed: %s (grid %d)\n", hipGetErrorString(e), grid_blocks);
}
```

```cpp
#include <hip/hip_runtime.h>
#include <hip/hip_cooperative_groups.h>
#include <cstdio>
#include <cmath>
namespace cg = cooperative_groups;

typedef unsigned short u16;
typedef short bf16x8 __attribute__((ext_vector_type(8)));
typedef float f32x4 __attribute__((ext_vector_type(4)));
typedef unsigned u32x4 __attribute__((ext_vector_type(4)));
typedef unsigned u32x2 __attribute__((ext_vector_type(2)));
typedef _Float16 f16x4 __attribute__((ext_vector_type(4)));
#define DI __device__ __forceinline__
DI int opaque_tid_(int wave_s) { int t; asm volatile("v_mbcnt_lo_u32_b32 %0, -1, 0\n\tv_mbcnt_hi_u32_b32 %0, -1, %0" : "=v"(t)); return t + (wave_s << 6); }
#define opaque_tid() opaque_tid_(wvs)

constexpr int T_TOK = 32768, SEQ = 8192, DM = 1024, NC = 5384, NCP = 5376;
constexpr int C_DNZ = 1536, C_SWQ = 2056, C_SWK = 2568, C_SWV = 2696, C_SWZ = 2824, C_GA = 3336, C_GB = 4360;
constexpr size_t OFF_BAR = 0;
constexpr size_t BAR_BYTES = 16384;
constexpr size_t OFF_WINT = BAR_BYTES;
constexpr size_t OFF_WAT = OFF_WINT + (size_t)NCP * 1024 * 2;
constexpr size_t OFF_WBT = OFF_WAT + 1024 * 512 * 2;
constexpr size_t OFF_WOT = OFF_WBT + 1024 * 512 * 2;
constexpr size_t OFF_ROPE = OFF_WOT + 1024 * 1024 * 2;
constexpr size_t OFF_HB = OFF_ROPE + 2 * 8192 * 8 * 4;
constexpr size_t OFF_DEC = OFF_HB + (size_t)T_TOK * 8 * 4;
constexpr size_t OFF_H = OFF_DEC + 2048 * 4;
constexpr size_t OFF_SC = OFF_H + (size_t)T_TOK * NC * 2;
constexpr size_t OPB = 73728;
constexpr size_t OFF_SSQ = OFF_SC + 2048 * OPB;
constexpr size_t WS_NEED = OFF_SSQ + (size_t)T_TOK * 32 * 4;
constexpr int HALF_SMEM = 73728;
constexpr int SMEM_BYTES = 2 * HALF_SMEM + 16;

struct Params {
  const float *x, *w_in, *conv_w, *a_log, *dt_bias, *dn_norm_w, *sinks, *w_branch, *w_out, *ln_g, *ln_b;
  float* out; unsigned char* ws;
  float inv_freq[8];
};

typedef __bf16 bf16x2_t __attribute__((ext_vector_type(2)));
typedef float f32x2_t __attribute__((ext_vector_type(2)));
DI unsigned pk_bf16(float lo, float hi) { f32x2_t f = {lo, hi}; bf16x2_t v = __builtin_convertvector(f, bf16x2_t); return __builtin_bit_cast(unsigned, v); }
DI float bf_lo(unsigned u) { return __uint_as_float(u << 16); }
DI float bf_hi(unsigned u) { return __uint_as_float(u & 0xffff0000u); }
DI float bf2f(u16 v) { return __uint_as_float(((unsigned)v) << 16); }
DI u16 f2bf(float f) { return (u16)(pk_bf16(f, f) & 0xffffu); }
DI float shx(float v, int m, int lane) { return __uint_as_float((unsigned)__builtin_amdgcn_ds_bpermute((lane ^ m) << 2, (int)__float_as_uint(v))); }
DI float rcp_f(float y) { return __builtin_amdgcn_rcpf(y); }
template <int CTRL> DI float dpp_mov(float v) { return __builtin_bit_cast(float, __builtin_amdgcn_update_dpp(0, __builtin_bit_cast(int, v), CTRL, 0xf, 0xf, true)); }
DI float row16_sum(float v) {
  v += dpp_mov<0xB1>(v);
  v += dpp_mov<0x4E>(v);
  v += dpp_mov<0x141>(v);
  v += dpp_mov<0x140>(v);
  return v;
}
DI float silu_f(float y) { return y * rcp_f(1.0f + __expf(-y)); }
DI float sigmoid_f(float y) { return rcp_f(1.0f + __expf(-y)); }
DI f32x4 mfma16(bf16x8 a, bf16x8 b, f32x4 c) { return __builtin_amdgcn_mfma_f32_16x16x32_bf16(a, b, c, 0, 0, 0); }
DI bf16x8 as_bf8(u32x4 v) { return __builtin_bit_cast(bf16x8, v); }
DI bf16x8 pack8(f32x4 a, f32x4 b) { u32x4 w; w.x = pk_bf16(a[0], a[1]); w.y = pk_bf16(a[2], a[3]); w.z = pk_bf16(b[0], b[1]); w.w = pk_bf16(b[2], b[3]); return as_bf8(w); }

DI void phase0(const Params& p, int wvs) {
  const size_t gt = (size_t)blockIdx.x * 512 + opaque_tid(), gs = (size_t)gridDim.x * 512;
  {
    const int ltid = (int)(gt & 511), lane = ltid & 63, wv = ltid >> 6;
    float wr[16][8];
#pragma unroll
    for (int j = 0; j < 4; ++j)
#pragma unroll
      for (int c = 0; c < 4; ++c) {
        const float* wp = p.w_in + (size_t)(4 * (lane + 64 * j) + c) * NC + 2048;
        const f32x4 a = *(const f32x4*)wp, b = *(const f32x4*)(wp + 4);
#pragma unroll
        for (int q = 0; q < 4; ++q) { wr[4 * j + c][q] = a[q]; wr[4 * j + c][4 + q] = b[q]; }
      }
    u16* xb = (u16*)(p.ws + OFF_SC);
    float* hb = (float*)(p.ws + OFF_HB);
    const int rstep = gridDim.x * 8;
    for (int row0 = blockIdx.x * 8 + wv; row0 < T_TOK; row0 += 2 * rstep) {
      f32x4 xr[2][4];
#pragma unroll
      for (int u = 0; u < 2; ++u) {
        const int row = row0 + u * rstep;
#pragma unroll
        for (int j = 0; j < 4; ++j) xr[u][j] = (row < T_TOK) ? *(const f32x4*)(p.x + (size_t)row * DM + 4 * (lane + 64 * j)) : (f32x4){0.f, 0.f, 0.f, 0.f};
      }
#pragma unroll
      for (int u = 0; u < 2; ++u) {
        const int row = row0 + u * rstep;
        float v[8];
#pragma unroll
        for (int q = 0; q < 8; ++q) v[q] = 0.f;
#pragma unroll
        for (int j = 0; j < 4; ++j) {
          const f32x4 xv = xr[u][j];
          u32x2 w; w.x = pk_bf16(xv[0], xv[1]); w.y = pk_bf16(xv[2], xv[3]);
          if (row < T_TOK) *(u32x2*)(xb + (size_t)row * DM + 4 * (lane + 64 * j)) = w;
#pragma unroll
          for (int c = 0; c < 4; ++c)
#pragma unroll
            for (int q = 0; q < 8; ++q) v[q] += xv[c] * wr[4 * j + c][q];
        }
        const bool up = (lane & 32) != 0;
        float k4[4];
#pragma unroll
        for (int i = 0; i < 4; ++i) { const float snd = up ? v[i] : v[i + 4]; const float kp = up ? v[i + 4] : v[i]; k4[i] = kp + shx(snd, 32, lane); }
        const bool up2 = (lane & 16) != 0;
        float k2[2];
#pragma unroll
        for (int i = 0; i < 2; ++i) { const float snd = up2 ? k4[i] : k4[i + 2]; const float kp = up2 ? k4[i + 2] : k4[i]; k2[i] = kp + shx(snd, 16, lane); }
        const bool up3 = (lane & 8) != 0;
        float k1 = (up3 ? k2[1] : k2[0]) + shx(up3 ? k2[0] : k2[1], 8, lane);
        k1 += shx(k1, 4, lane); k1 += shx(k1, 2, lane); k1 += shx(k1, 1, lane);
        if ((lane & 7) == 0 && row < T_TOK) hb[(size_t)row * 8 + (lane >> 3)] = k1;
      }
    }
  }
  {
    u32x4* wt = (u32x4*)(p.ws + OFF_WINT);
    for (size_t i = gt; i < (size_t)NCP * 128; i += gs) {
      const int kc = (int)(i / NCP), n = (int)(i % NCP);
      float v[8];
#pragma unroll
      for (int j = 0; j < 8; ++j) v[j] = p.w_in[(size_t)(kc * 8 + j) * NC + n + (n >= 2048 ? 8 : 0)];
      u32x4 w; w.x = pk_bf16(v[0], v[1]); w.y = pk_bf16(v[2], v[3]); w.z = pk_bf16(v[4], v[5]); w.w = pk_bf16(v[6], v[7]);
      wt[(size_t)n * 128 + kc] = w;
    }
  }
  {
    for (size_t i = gt; i < (size_t)2 * 1024 * 64; i += gs) {
      const int br = (int)(i / (1024 * 64)), rem = (int)(i % (1024 * 64)), kc = rem / 1024, n = rem % 1024;
      const float* src = p.w_branch + (size_t)br * 512 * 1024;
      float v[8];
#pragma unroll
      for (int j = 0; j < 8; ++j) v[j] = src[(size_t)(kc * 8 + j) * 1024 + n];
      u32x4 w; w.x = pk_bf16(v[0], v[1]); w.y = pk_bf16(v[2], v[3]); w.z = pk_bf16(v[4], v[5]); w.w = pk_bf16(v[6], v[7]);
      ((u32x4*)(p.ws + (br ? OFF_WBT : OFF_WAT)))[(size_t)n * 64 + kc] = w;
    }
  }
  {
    for (size_t i = gt; i < (size_t)1024 * 128; i += gs) {
      const int kc = (int)(i / 1024), n = (int)(i % 1024);
      float v[8];
#pragma unroll
      for (int j = 0; j < 8; ++j) v[j] = p.w_out[(size_t)(kc * 8 + j) * 1024 + n];
      u32x4 w; w.x = pk_bf16(v[0], v[1]); w.y = pk_bf16(v[2], v[3]); w.z = pk_bf16(v[4], v[5]); w.w = pk_bf16(v[6], v[7]);
      ((u32x4*)(p.ws + OFF_WOT))[(size_t)n * 128 + kc] = w;
    }
  }
  {
    float* rc = (float*)(p.ws + OFF_ROPE); float* rs = rc + 8192 * 8;
    for (size_t i = gt; i < 8192 * 8; i += gs) {
      const int t = (int)(i >> 3), f = (int)(i & 7);
      const float ang = (float)t * p.inv_freq[f];
      const double a = (double)ang;
      const double k = __builtin_rint(a * 0.15915494309189535);
      const float r = (float)(a - k * 6.283185307179586);
      rc[i] = cosf(r); rs[i] = sinf(r);
    }
  }
}

template <int I> DI void solve_rows2(f32x2_t (&xv)[64], const float* Lm, int lane, float lcur) {
  if constexpr (I < 64) {
    float lnx = 0.f;
    if constexpr (I + 1 < 64) lnx = Lm[(I + 1) * 68 + lane];
    f32x2_t a0 = xv[I], a1 = {0.f, 0.f}, a2 = {0.f, 0.f}, a3 = {0.f, 0.f};
#pragma unroll
    for (int m = 0; m < I; ++m) {
      const float l = __builtin_bit_cast(float, __builtin_amdgcn_readlane(__builtin_bit_cast(int, lcur), m));
      const f32x2_t lv = {l, l};
      if ((m & 3) == 0) a0 -= lv * xv[m];
      else if ((m & 3) == 1) a1 -= lv * xv[m];
      else if ((m & 3) == 2) a2 -= lv * xv[m];
      else a3 -= lv * xv[m];
    }
    xv[I] = (a0 + a1) + (a2 + a3);
    solve_rows2<I + 1>(xv, Lm, lane, lnx);
  }
}

DI void prep_item(const Params& p, int wvs, int item, unsigned char* smem) {
  const int tid_ = opaque_tid();
  const int tid = tid_, lane = tid & 63, wv = tid >> 6, r16 = lane & 15, g = lane >> 4;
  const int hd = item & 3, n = (item >> 2) & 127, b = item >> 9;
  const int t0 = b * SEQ + n * 64;
  u16* Qs = (u16*)smem; u16* Ks = Qs + 64 * 136; u16* Vs = Ks + 64 * 136;
  float* Lm = (float*)(smem + 52224);
  float* sm_beta = (float*)(smem + 69632);
  float* sm_gc = sm_beta + 64; float* sm_rq = sm_gc + 64; float* sm_rk = sm_rq + 64;
  float* sm_fw = sm_rk + 64; float* sm_fq = sm_fw + 64; float* sm_fk = sm_fq + 64;
  const u16* h = (const u16*)(p.ws + OFF_H);
  const float* hb = (const float*)(p.ws + OFF_HB);
  unsigned char* op = p.ws + OFF_SC + (size_t)item * OPB;
  __syncthreads();
  float hb_bl, hb_al;
  {
    const int c2 = tid & 63, rbase = (tid >> 6) * 16;
    unsigned raw[3][19];
#pragma unroll
    for (int mat = 0; mat < 3; ++mat) {
      const int col = mat * 512 + hd * 128 + 2 * c2;
#pragma unroll
      for (int j = 0; j < 19; ++j) {
        const int rr = t0 + rbase - 3 + j;
        raw[mat][j] = *(const unsigned*)(h + (size_t)(rr < 0 ? 0 : rr) * NC + col);
      }
    }
    float2 cw[3][4];
#pragma unroll
    for (int mat = 0; mat < 3; ++mat)
#pragma unroll
      for (int j = 0; j < 4; ++j) cw[mat][j] = *(const float2*)(p.conv_w + j * 1536 + mat * 512 + hd * 128 + 2 * c2);
    hb_bl = hb[(size_t)(t0 + lane) * 8 + hd]; hb_al = hb[(size_t)(t0 + lane) * 8 + 4 + hd];
    __builtin_amdgcn_sched_barrier(0);
#pragma unroll
    for (int mat = 0; mat < 3; ++mat) {
      float wa[4], wb[4];
#pragma unroll
      for (int j = 0; j < 4; ++j) { wa[j] = cw[mat][j].x; wb[j] = cw[mat][j].y; }
      float xa[3], xb[3];
#pragma unroll
      for (int j = 0; j < 3; ++j) {
        const int pos = n * 64 + rbase - 3 + j;
        const unsigned v = (pos >= 0) ? raw[mat][j] : 0u;
        xa[j] = bf_lo(v); xb[j] = bf_hi(v);
      }
      u16* dst = (mat == 0 ? Qs : (mat == 1 ? Ks : Vs));
#pragma unroll
      for (int i = 0; i < 16; ++i) {
        const unsigned v = raw[mat][3 + i];
        const float a3 = bf_lo(v), b3 = bf_hi(v);
        const float ya = wa[0] * xa[0] + wa[1] * xa[1] + wa[2] * xa[2] + wa[3] * a3;
        const float yb = wb[0] * xb[0] + wb[1] * xb[1] + wb[2] * xb[2] + wb[3] * b3;
        xa[0] = xa[1]; xa[1] = xa[2]; xa[2] = a3; xb[0] = xb[1]; xb[1] = xb[2]; xb[2] = b3;
        *(unsigned*)(dst + (rbase + i) * 136 + 2 * c2) = pk_bf16(silu_f(ya), silu_f(yb));
      }
    }
  }
  __syncthreads();
  if (wv == 0) {
    const float bl = hb_bl, al = hb_al;
    const float xx = al + p.dt_bias[hd];
    const float ee = __expf(-fabsf(xx));
    const float sp = fmaxf(xx, 0.f) + ((ee < 1e-3f) ? ee * (1.f - 0.5f * ee) : __logf(1.f + ee));
    float gg = -__expf(p.a_log[hd]) * sp;
#pragma unroll
    for (int o = 1; o < 64; o <<= 1) { const float t = __uint_as_float((unsigned)__builtin_amdgcn_ds_bpermute(((lane - o) & 63) << 2, (int)__float_as_uint(gg))); if (lane >= o) gg += t; }
    sm_beta[lane] = rcp_f(1.0f + __expf(-bl)); sm_gc[lane] = gg;
  } else if (wv <= 2) {
    const int r = tid - 64;
    const u16* src = (r < 64) ? (Qs + r * 136) : (Ks + (r - 64) * 136);
    float ss = 0.f;
#pragma unroll
    for (int c = 0; c < 16; ++c) {
      const u32x4 v = *(const u32x4*)(src + c * 8);
#pragma unroll
      for (int j = 0; j < 4; ++j) { const float a = bf_lo(v[j]), bb = bf_hi(v[j]); ss += a * a + bb * bb; }
    }
    const float rs = rsqrtf(ss + 1e-6f);
    if (r < 64) sm_rq[r] = rs; else sm_rk[r - 64] = rs;
  }
  __syncthreads();
  if (tid < 64) {
    const float gc = sm_gc[tid], gl = sm_gc[63], eg = __expf(gc);
    sm_fw[tid] = sm_beta[tid] * eg * sm_rk[tid];
    sm_fq[tid] = sm_rq[tid] * 0.08838834764831845f * eg;
    sm_fk[tid] = sm_rk[tid] * __expf(gl - gc);
    if (tid == 0) ((float*)(p.ws + OFF_DEC))[item] = __expf(gl);
  }
  {
    bf16x8 kfi[4], qfi[4];
#pragma unroll
    for (int s = 0; s < 4; ++s) {
      kfi[s] = *(const bf16x8*)(Ks + (16 * wv + r16) * 136 + 32 * s + 8 * g);
      qfi[s] = *(const bf16x8*)(Qs + (16 * wv + r16) * 136 + 32 * s + 8 * g);
    }
    f32x4 at[4];
#pragma unroll
    for (int jt = 0; jt < 4; ++jt) {
      at[jt] = (f32x4){0.f, 0.f, 0.f, 0.f};
      if (jt <= wv) {
        f32x4 la = (f32x4){0.f, 0.f, 0.f, 0.f}, aa = (f32x4){0.f, 0.f, 0.f, 0.f};
#pragma unroll
        for (int s = 0; s < 4; ++s) {
          const bf16x8 kfj = *(const bf16x8*)(Ks + (16 * jt + r16) * 136 + 32 * s + 8 * g);
          la = mfma16(kfi[s], kfj, la);
          aa = mfma16(kfj, qfi[s], aa);
        }
#pragma unroll
        for (int r = 0; r < 4; ++r) {
          { const int i = 16 * wv + 4 * g + r, j = 16 * jt + r16;
            const float v = (i > j) ? sm_beta[i] * sm_rk[i] * sm_rk[j] * __expf(sm_gc[i] - sm_gc[j]) * la[r] : 0.f;
            Lm[i * 68 + j] = v; }
          { const int j = 16 * jt + 4 * g + r, i = 16 * wv + r16;
            at[jt][r] = (j <= i) ? sm_rq[i] * sm_rk[j] * 0.08838834764831845f * __expf(sm_gc[i] - sm_gc[j]) * aa[r] : 0.f; }
        }
      }
    }
#pragma unroll
    for (int s2 = 0; s2 < 2; ++s2)
      *(bf16x8*)(op + 32768 + (size_t)((wv * 2 + s2) * 64 + lane) * 16) = pack8(at[2 * s2], at[2 * s2 + 1]);
  }
  __syncthreads();
  f32x2_t xv[64];
  if (wv < 2) {
#pragma unroll
    for (int i = 0; i < 64; ++i) { xv[i].x = sm_beta[i] * bf2f(Vs[i * 136 + tid]); xv[i].y = sm_fw[i] * bf2f(Ks[i * 136 + tid]); }
    solve_rows2<1>(xv, Lm, lane, Lm[68 + lane]);
    const int sl = tid >> 4, dvl = tid & 15;
#pragma unroll
    for (int mt = 0; mt < 4; ++mt)
#pragma unroll
      for (int gg = 0; gg < 4; ++gg) {
        u32x2 w; w.x = pk_bf16(xv[16 * mt + 4 * gg].x, xv[16 * mt + 4 * gg + 1].x); w.y = pk_bf16(xv[16 * mt + 4 * gg + 2].x, xv[16 * mt + 4 * gg + 3].x);
        *(u32x2*)(op + 57344 + (size_t)((sl * 4 + mt) * 64 + gg * 16 + dvl) * 8) = w;
      }
  } else {
    const int t2 = tid - 128;
#pragma unroll 2
    for (int f = 0; f < 8; ++f) {
      const int e = t2 + 128 * f, frag = e >> 6, ln = e & 63, lr = ln & 15, lg = ln >> 4;
      {
        const int mt = frag >> 2, sx = frag & 3, row = 16 * mt + lr;
        const u32x2 ql = *(const u32x2*)(Qs + row * 136 + 32 * sx + 4 * lg), qh = *(const u32x2*)(Qs + row * 136 + 32 * sx + 16 + 4 * lg);
        const float fq = sm_fq[row];
        u32x4 w;
        w.x = pk_bf16(bf_lo(ql.x) * fq, bf_hi(ql.x) * fq); w.y = pk_bf16(bf_lo(ql.y) * fq, bf_hi(ql.y) * fq);
        w.z = pk_bf16(bf_lo(qh.x) * fq, bf_hi(qh.x) * fq); w.w = pk_bf16(bf_lo(qh.y) * fq, bf_hi(qh.y) * fq);
        *(u32x4*)(op + 16384 + (size_t)e * 16) = w;
      }
      {
        const int mt8 = frag >> 1, s2 = frag & 1, dk = 16 * mt8 + lr;
        float v[8];
#pragma unroll
        for (int j = 0; j < 8; ++j) {
          const int pos = 32 * s2 + 16 * (j >> 2) + 4 * lg + (j & 3);
          v[j] = bf2f(Ks[pos * 136 + dk]) * sm_fk[pos];
        }
        u32x4 w; w.x = pk_bf16(v[0], v[1]); w.y = pk_bf16(v[2], v[3]); w.z = pk_bf16(v[4], v[5]); w.w = pk_bf16(v[6], v[7]);
        *(u32x4*)(op + 40960 + (size_t)e * 16) = w;
      }
    }
  }
  __syncthreads();
  if (wv < 2) {
#pragma unroll
    for (int i = 0; i < 64; ++i) Vs[i * 136 + tid] = f2bf(-xv[i].y);
  }
  __syncthreads();
#pragma unroll
  for (int f = 0; f < 4; ++f) {
    const int e = tid + 256 * f, frag = e >> 6, ln = e & 63, lr = ln & 15, lg = ln >> 4;
    const int mt = frag >> 2, sx = frag & 3, row = 16 * mt + lr;
    const u32x2 lo = *(const u32x2*)(Vs + row * 136 + 32 * sx + 4 * lg), hi = *(const u32x2*)(Vs + row * 136 + 32 * sx + 16 + 4 * lg);
    *(u32x4*)(op + (size_t)e * 16) = (u32x4){lo.x, lo.y, hi.x, hi.y};
  }
}

struct ScanA { u32x4 wf[4]; };
struct ScanB { u32x4 qf[4], af[2], kf[4]; };

DI void scan_load_a(const Params& p, int wvs, ScanA& o, int b, int hd, int sl, int n, int q, int lane) {
  const int item = (b * 128 + n) * 4 + hd;
  const unsigned char* op = p.ws + OFF_SC + (size_t)item * OPB;
#pragma unroll
  for (int s = 0; s < 4; ++s) {
    o.wf[s] = *(const u32x4*)(op + (size_t)((q * 4 + s) * 64 + lane) * 16);
  }
}
DI void scan_load_b(const Params& p, int wvs, ScanB& o, int b, int hd, int sl, int n, int q, int lane) {
  const int item = (b * 128 + n) * 4 + hd;

  const unsigned char* op = p.ws + OFF_SC + (size_t)item * OPB;
#pragma unroll
  for (int s = 0; s < 4; ++s) o.qf[s] = *(const u32x4*)(op + 16384 + (size_t)((q * 4 + s) * 64 + lane) * 16);
#pragma unroll
  for (int s2 = 0; s2 < 2; ++s2) o.af[s2] = *(const u32x4*)(op + 32768 + (size_t)((q * 2 + s2) * 64 + lane) * 16);
#pragma unroll
  for (int j = 0; j < 4; ++j) o.kf[j] = *(const u32x4*)(op + 40960 + (size_t)((q * 4 + j) * 64 + lane) * 16);
}

DI void scan_step(const Params& p, int wvs, const ScanA& o, const ScanB& ob, f32x4 (&S)[2], int b, int hd, int sl, int n, int q, int lane, unsigned char* smem) {
  const int r16 = lane & 15, g = lane >> 4;
  u32x4* ldsS = (u32x4*)smem;
  u32x2* ldsV = (u32x2*)(smem + 4096);
  ldsS[q * 64 + lane] = __builtin_bit_cast(u32x4, pack8(S[0], S[1]));
  __syncthreads();
  bf16x8 Sb[4];
#pragma unroll
  for (int s = 0; s < 4; ++s) Sb[s] = as_bf8(ldsS[s * 64 + lane]);
  const unsigned char* ring = smem + 8192 + (n % 3) * 6400;
  const u32x2 uf = *(const u32x2*)(ring + 4096 + (q * 64 + lane) * 8);
  f32x4 vn = (f32x4){bf_lo(uf.x), bf_hi(uf.x), bf_lo(uf.y), bf_hi(uf.y)};
#pragma unroll
  for (int s = 0; s < 4; ++s) vn = mfma16(as_bf8(o.wf[s]), Sb[s], vn);
  { u32x2 w; w.x = pk_bf16(vn[0], vn[1]); w.y = pk_bf16(vn[2], vn[3]); ldsV[((q >> 1) * 64 + lane) * 2 + (q & 1)] = w; }
  f32x4 oa = (f32x4){0.f, 0.f, 0.f, 0.f};
#pragma unroll
  for (int s = 0; s < 4; ++s) oa = mfma16(as_bf8(ob.qf[s]), Sb[s], oa);
  __syncthreads();
  bf16x8 Vb[2];
#pragma unroll
  for (int s2 = 0; s2 < 2; ++s2) Vb[s2] = as_bf8(*(const u32x4*)(ldsV + (s2 * 64 + lane) * 2));
#pragma unroll
  for (int s2 = 0; s2 < 2; ++s2) oa = mfma16(as_bf8(ob.af[s2]), Vb[s2], oa);
  u16* h = (u16*)(p.ws + OFF_H);
  const int t0 = b * SEQ + n * 64;
  *(f32x4*)(smem + 8192 + (n % 3) * 6400 + (q * 64 + lane) * 16) = oa;
  const float dec_ = *(const float*)(ring + 6144);
#pragma unroll
  for (int t = 0; t < 2; ++t) {
    S[t] = S[t] * dec_;
#pragma unroll
    for (int s2 = 0; s2 < 2; ++s2) S[t] = mfma16(as_bf8(ob.kf[t * 2 + s2]), Vb[s2], S[t]);
  }
}

DI void scan_chain(const Params& p, int wvs, int pair, int sl, unsigned char* smem) {
  const int tid0 = opaque_tid(); const int lane = tid0 & 63, q = tid0 >> 6;
  const int b = pair >> 2, hd = pair & 3;
  f32x4 S[2]; S[0] = (f32x4){0.f, 0.f, 0.f, 0.f}; S[1] = S[0];
  ScanA a0, a1, a2; ScanB bc, bn;
  __builtin_amdgcn_s_setprio(3);
  __syncthreads();
  scan_load_a(p, wvs, a0, b, hd, sl, 0, q, lane);
  scan_load_b(p, wvs, bc, b, hd, sl, 0, q, lane);
  scan_load_a(p, wvs, a1, b, hd, sl, 1, q, lane);
#pragma unroll 1
  for (int n = 0; n < 129; n += 3) {
    if (n + 2 < 128) scan_load_a(p, wvs, a2, b, hd, sl, n + 2, q, lane);
    if (n + 1 < 128) scan_load_b(p, wvs, bn, b, hd, sl, n + 1, q, lane);
    if (n < 128) scan_step(p, wvs, a0, bc, S, b, hd, sl, n, q, lane, smem);
    bc = bn;
    if (n + 3 < 128) scan_load_a(p, wvs, a0, b, hd, sl, n + 3, q, lane);
    if (n + 2 < 128) scan_load_b(p, wvs, bn, b, hd, sl, n + 2, q, lane);
    if (n + 1 < 128) scan_step(p, wvs, a1, bc, S, b, hd, sl, n + 1, q, lane, smem);
    bc = bn;
    if (n + 4 < 128) scan_load_a(p, wvs, a1, b, hd, sl, n + 4, q, lane);
    if (n + 3 < 128) scan_load_b(p, wvs, bn, b, hd, sl, n + 3, q, lane);
    if (n + 2 < 128) scan_step(p, wvs, a2, bc, S, b, hd, sl, n + 2, q, lane, smem);
    bc = bn;
  }
  __syncthreads();
  __builtin_amdgcn_s_setprio(0);
}

DI void swa_item(const Params& p, int wvs, int item, bool valid, unsigned char* smem) {
  if (!valid) { __syncthreads(); __syncthreads(); return; }
  const int tid_ = opaque_tid();
  const int tid = tid_, lane = tid & 63, wv = tid >> 6, r16 = lane & 15, g = lane >> 4;
  const int qt = item & 127, kvh = (item >> 7) & 1, b = item >> 8;
  const int kp0 = 64 * qt - 128;
  u16* Ksm = (u16*)smem;
  u16* Vt = (u16*)(smem + 27648);
  u16* h = (u16*)(p.ws + OFF_H);
  const float* rc = (const float*)(p.ws + OFF_ROPE); const float* rs = rc + 8192 * 8;
  __syncthreads();
  if (tid < 192) {
    const int kk = tid, pos = kp0 + kk;
    u32x4 lo = (u32x4){0, 0, 0, 0}, hi = lo;
    if (pos >= 0) {
      const u16* src = h + (size_t)(b * SEQ + pos) * NC + C_SWK + kvh * 64;
      const u32x4 a = *(const u32x4*)src, c = *(const u32x4*)(src + 8);
      const f32x4 c0 = *(const f32x4*)(rc + pos * 8), c1 = *(const f32x4*)(rc + pos * 8 + 4);
      const f32x4 s0 = *(const f32x4*)(rs + pos * 8), s1 = *(const f32x4*)(rs + pos * 8 + 4);
      float t1[8], t2[8], cs[8], sn[8], o1[8], o2[8];
#pragma unroll
      for (int j = 0; j < 4; ++j) { t1[2 * j] = bf_lo(a[j]); t1[2 * j + 1] = bf_hi(a[j]); t2[2 * j] = bf_lo(c[j]); t2[2 * j + 1] = bf_hi(c[j]);
        cs[j] = c0[j]; cs[4 + j] = c1[j]; sn[j] = s0[j]; sn[4 + j] = s1[j]; }
#pragma unroll
      for (int j = 0; j < 8; ++j) { o1[j] = t1[j] * cs[j] - t2[j] * sn[j]; o2[j] = t2[j] * cs[j] + t1[j] * sn[j]; }
#pragma unroll
      for (int j = 0; j < 4; ++j) { lo[j] = pk_bf16(o1[2 * j], o1[2 * j + 1]); hi[j] = pk_bf16(o2[2 * j], o2[2 * j + 1]); }
    }
    *(u32x4*)(Ksm + kk * 72) = lo; *(u32x4*)(Ksm + kk * 72 + 8) = hi;
  }
  for (int e = tid; e < 192 * 6; e += 256) {
    const int kk = e / 6, ch = 2 + e % 6, pos = kp0 + kk;
    u32x4 v = (u32x4){0, 0, 0, 0};
    if (pos >= 0) v = *(const u32x4*)(h + (size_t)(b * SEQ + pos) * NC + C_SWK + kvh * 64 + ch * 8);
    *(u32x4*)(Ksm + kk * 72 + ch * 8) = v;
  }
  for (int e = tid; e < 192 * 8; e += 256) {
    const int kk = e >> 3, ch = e & 7, pos = kp0 + kk;
    u32x4 v = (u32x4){0, 0, 0, 0};
    if (pos >= 0) v = *(const u32x4*)(h + (size_t)(b * SEQ + pos) * NC + C_SWV + kvh * 64 + ch * 8);
#pragma unroll
    for (int j = 0; j < 4; ++j) { Vt[(ch * 8 + 2 * j) * 200 + kk] = (u16)(v[j] & 0xffffu); Vt[(ch * 8 + 2 * j + 1) * 200 + kk] = (u16)(v[j] >> 16); }
  }
  __syncthreads();
  const int st = wv, jt0 = st < 2 ? st : 2;
  const int qi = 16 * st + r16;
  const int qpos = 64 * qt + qi, tq = b * SEQ + qpos;
#pragma unroll 1
  for (int hq = 0; hq < 4; ++hq) {
    const int head = kvh * 4 + hq;
    u16* qsrc = h + (size_t)tq * NC + C_SWQ + head * 64;
    bf16x8 qf[2];
    {
      const u32x4 a = *(const u32x4*)qsrc, c = *(const u32x4*)(qsrc + 8);
      u32x4 w = *(const u32x4*)(qsrc + 8 * g);
      if (g < 2) {
        const f32x4 c0 = *(const f32x4*)(rc + qpos * 8), c1 = *(const f32x4*)(rc + qpos * 8 + 4);
        const f32x4 s0 = *(const f32x4*)(rs + qpos * 8), s1 = *(const f32x4*)(rs + qpos * 8 + 4);
        float t1[8], t2[8], cs[8], sn[8], o[8];
#pragma unroll
        for (int j = 0; j < 4; ++j) { t1[2 * j] = bf_lo(a[j]); t1[2 * j + 1] = bf_hi(a[j]); t2[2 * j] = bf_lo(c[j]); t2[2 * j + 1] = bf_hi(c[j]);
          cs[j] = c0[j]; cs[4 + j] = c1[j]; sn[j] = s0[j]; sn[4 + j] = s1[j]; }
#pragma unroll
        for (int j = 0; j < 8; ++j) o[j] = (g == 0) ? (t1[j] * cs[j] - t2[j] * sn[j]) : (t2[j] * cs[j] + t1[j] * sn[j]);
#pragma unroll
        for (int j = 0; j < 4; ++j) w[j] = pk_bf16(o[2 * j], o[2 * j + 1]);
      }
      qf[0] = as_bf8(w);
      qf[1] = as_bf8(*(const u32x4*)(qsrc + 32 + 8 * g));
    }
    f32x4 sc[10];
#pragma unroll
    for (int t = 0; t < 10; ++t) {
      sc[t] = (f32x4){0.f, 0.f, 0.f, 0.f};
#pragma unroll
      for (int s = 0; s < 2; ++s) {
        const bf16x8 kf = *(const bf16x8*)(Ksm + (16 * (jt0 + t) + r16) * 72 + 32 * s + 8 * g);
        sc[t] = mfma16(kf, qf[s], sc[t]);
      }
    }
    const float sink = p.sinks[head];
    float mx = sink;
#pragma unroll
    for (int t = 0; t < 10; ++t)
#pragma unroll
      for (int r = 0; r < 4; ++r) {
        const int kk = 16 * (jt0 + t) + 4 * g + r, d = kk - qi;
        const bool ok = (d >= 1) && (d <= 128) && (kp0 + kk >= 0);
        const float v = ok ? sc[t][r] * 0.125f : -1e30f;
        sc[t][r] = v; mx = fmaxf(mx, v);
      }
    mx = fmaxf(mx, shx(mx, 16, lane)); mx = fmaxf(mx, shx(mx, 32, lane));
    float sum = 0.f;
#pragma unroll
    for (int t = 0; t < 10; ++t)
#pragma unroll
      for (int r = 0; r < 4; ++r) { const float e = __expf(sc[t][r] - mx); sc[t][r] = e; sum += e; }
    sum += shx(sum, 16, lane); sum += shx(sum, 32, lane);
    const float inv = rcp_f(sum + __expf(sink - mx));
    f32x4 oacc[4];
#pragma unroll
    for (int dt = 0; dt < 4; ++dt) oacc[dt] = (f32x4){0.f, 0.f, 0.f, 0.f};
#pragma unroll
    for (int s2 = 0; s2 < 5; ++s2) {
      const bf16x8 pb = pack8(sc[2 * s2], sc[2 * s2 + 1]);
#pragma unroll
      for (int dt = 0; dt < 4; ++dt) {
        const u16* vr = Vt + (16 * dt + r16) * 200 + 16 * (jt0 + 2 * s2) + 4 * g;
        const u32x2 lo = *(const u32x2*)vr, hi = *(const u32x2*)(vr + 16);
        oacc[dt] = mfma16(as_bf8((u32x4){lo.x, lo.y, hi.x, hi.y}), pb, oacc[dt]);
      }
    }
#pragma unroll
    for (int dt = 0; dt < 4; ++dt) {
      const int dcol = head * 64 + 16 * dt + 4 * g;
      const u32x2 z = *(const u32x2*)(h + (size_t)tq * NC + C_SWZ + dcol);
      u32x2 w;
      w.x = pk_bf16(oacc[dt][0] * inv * silu_f(bf_lo(z.x)), oacc[dt][1] * inv * silu_f(bf_hi(z.x)));
      w.y = pk_bf16(oacc[dt][2] * inv * silu_f(bf_lo(z.y)), oacc[dt][3] * inv * silu_f(bf_hi(z.y)));
      *(u32x2*)(h + (size_t)tq * NC + C_SWQ + dcol) = w;
    }
  }
}

DI void phase_ya(const Params& p, int wvs) {
  u16* h = (u16*)(p.ws + OFF_H);
  const int ltid = opaque_tid(), lane = ltid & 63;
  const size_t gt = (size_t)blockIdx.x * 512 + ltid, gs = (size_t)gridDim.x * 512;
  const float* nwp = p.dn_norm_w + (ltid & 15) * 8;
  const f32x4 nw0 = *(const f32x4*)nwp, nw1 = *(const f32x4*)(nwp + 4);
  for (size_t i0 = gt; i0 < (size_t)T_TOK * 64; i0 += 4 * gs) {
    u32x4 v[4], z[4];
#pragma unroll
    for (int k = 0; k < 4; ++k) {
      const size_t i = i0 + k * gs;
      if (i < (size_t)T_TOK * 64) {
        const u16* ptr = h + (size_t)(i >> 6) * NC + (i & 63) * 8;
        v[k] = *(const u32x4*)ptr; z[k] = *(const u32x4*)(ptr + C_DNZ);
      } else { v[k] = (u32x4){0, 0, 0, 0}; z[k] = v[k]; }
    }
#pragma unroll
    for (int k = 0; k < 4; ++k) {
      const size_t i = i0 + k * gs;
      float o[8]; float ss = 0.f;
#pragma unroll
      for (int j = 0; j < 4; ++j) { o[2 * j] = bf_lo(v[k][j]); o[2 * j + 1] = bf_hi(v[k][j]); }
#pragma unroll
      for (int j = 0; j < 8; ++j) ss += o[j] * o[j];
      ss += shx(ss, 1, lane); ss += shx(ss, 2, lane); ss += shx(ss, 4, lane); ss += shx(ss, 8, lane);
      const float rs = rsqrtf(ss * (1.0f / 128.0f) + 1e-6f);
      float y[8];
#pragma unroll
      for (int j = 0; j < 4; ++j) {
        const float w0 = (j < 2) ? nw0[2 * j] : nw1[2 * j - 4], w1 = (j < 2) ? nw0[2 * j + 1] : nw1[2 * j - 3];
        y[2 * j] = o[2 * j] * rs * w0 * silu_f(bf_lo(z[k][j]));
        y[2 * j + 1] = o[2 * j + 1] * rs * w1 * silu_f(bf_hi(z[k][j]));
      }
      u32x4 w; w.x = pk_bf16(y[0], y[1]); w.y = pk_bf16(y[2], y[3]); w.z = pk_bf16(y[4], y[5]); w.w = pk_bf16(y[6], y[7]);
      if (i < (size_t)T_TOK * 64) *(u32x4*)(h + (size_t)(i >> 6) * NC + (i & 63) * 8) = w;
    }
  }
}

DI float wave_sum(float v, int lane) {
#pragma unroll
  for (int o = 32; o > 0; o >>= 1) v += shx(v, o, lane);
  return v;
}
DI void phase6(const Params& p, int wvs, unsigned char* smem) {
  const int tid = opaque_tid(), lane = tid & 63, wv = tid >> 6;
  f32x4 gm[4], bt[4];
#pragma unroll
  for (int j = 0; j < 4; ++j) { gm[j] = *(const f32x4*)(p.ln_g + 4 * (lane + 64 * j)); bt[j] = *(const f32x4*)(p.ln_b + 4 * (lane + 64 * j)); }
  const int xcd6 = blockIdx.x & 7, lb6 = blockIdx.x >> 3, nlb6 = gridDim.x >> 3;
  for (int lr = (lb6 * 8 + wv) * 2; lr < 4096; lr += nlb6 * 16) {
    const int row0 = 4096 * xcd6 + (4095 - lr), row1 = row0 - 1;
    float* r0 = p.out + (size_t)row0 * 1024;
    float* r1 = p.out + (size_t)row1 * 1024;
    const _Float16* s0 = (const _Float16*)(p.ws + OFF_H) + (size_t)row0 * 1024;
    const _Float16* s1 = (const _Float16*)(p.ws + OFF_H) + (size_t)row1 * 1024;
    f32x4 a[4], b[4];
#pragma unroll
    for (int j = 0; j < 4; ++j) {
      a[j] = __builtin_convertvector(*(const f16x4*)(s0 + 4 * (lane + 64 * j)), f32x4);
      b[j] = __builtin_convertvector(*(const f16x4*)(s1 + 4 * (lane + 64 * j)), f32x4);
    }
    float sa = 0.f, sb = 0.f;
#pragma unroll
    for (int j = 0; j < 4; ++j) { sa += (a[j][0] + a[j][1]) + (a[j][2] + a[j][3]); sb += (b[j][0] + b[j][1]) + (b[j][2] + b[j][3]); }
    const float ma = wave_sum(sa, lane) * (1.0f / 1024.0f), mb = wave_sum(sb, lane) * (1.0f / 1024.0f);
    float qa = 0.f, qb = 0.f;
#pragma unroll
    for (int j = 0; j < 4; ++j) {
      a[j] = a[j] - ma; b[j] = b[j] - mb;
      qa += (a[j][0] * a[j][0] + a[j][1] * a[j][1]) + (a[j][2] * a[j][2] + a[j][3] * a[j][3]);
      qb += (b[j][0] * b[j][0] + b[j][1] * b[j][1]) + (b[j][2] * b[j][2] + b[j][3] * b[j][3]);
    }
    const float ra = rsqrtf(wave_sum(qa, lane) * (1.0f / 1024.0f) + 1e-5f), rb = rsqrtf(wave_sum(qb, lane) * (1.0f / 1024.0f) + 1e-5f);
#pragma unroll
    for (int j = 0; j < 4; ++j) {
      *(f32x4*)(r0 + 4 * (lane + 64 * j)) = a[j] * ra * gm[j] + bt[j];
      *(f32x4*)(r1 + 4 * (lane + 64 * j)) = b[j] * rb * gm[j] + bt[j];
    }
  }
}

#define XB_TMO      128
#define XB_XCNT(j)  (256  + 64 * (j))
#define XB_XSUB(j)  (1280 + 64 * (j))
#define XB_XGEN(j)  (2304 + 64 * (j))
#define XB_TOP      3328
#define XB_TOPGEN   3392
#define XCD_BAR_WORDS 3456
#define XB_SPIN_CAP (1u << 22)
#define LAS __attribute__((address_space(3)))
DI unsigned xb_ld(unsigned* p) { return __hip_atomic_load(p, __ATOMIC_RELAXED, __HIP_MEMORY_SCOPE_AGENT); }
DI unsigned xb_add(unsigned* p, unsigned v) { return __hip_atomic_fetch_add(p, v, __ATOMIC_RELAXED, __HIP_MEMORY_SCOPE_AGENT); }
DI unsigned xb_xcc_id() { return (unsigned)__builtin_amdgcn_s_getreg((3 << 11) | 20) & 0xFu; }
#define XB_SPIN(cond, bar) do { unsigned _sp = 0; while (cond) { __builtin_amdgcn_s_sleep(1); \
    if ((++_sp & 255u) == 0u) { if (xb_ld(&(bar)[XB_TMO])) break; if (_sp > XB_SPIN_CAP) { atomicAdd(&(bar)[XB_TMO], 1u); break; } } } } while (0)
struct XcdBarrier { unsigned* bar; unsigned x; volatile LAS unsigned* st; };
DI bool xb_leader(int wvs) { return wvs == 0 && __builtin_amdgcn_mbcnt_hi(~0u, __builtin_amdgcn_mbcnt_lo(~0u, 0u)) == 0u; }
DI XcdBarrier xcd_barrier_post(unsigned* bar, volatile LAS unsigned* st, int wvs) {
  XcdBarrier b; b.bar = bar; b.x = xb_xcc_id(); b.st = st;
  if (xb_leader(wvs)) (void)xb_add(&bar[XB_XCNT(b.x)], 1u);
  return b;
}
DI void xcd_barrier_complete(unsigned* bar, unsigned x, unsigned& nloc, unsigned& nx) {
  const unsigned G = gridDim.x * gridDim.y * gridDim.z;
  unsigned sum, cnt, mine, sp = 0u;
  for (;;) {
    sum = 0u; cnt = 0u; mine = 0u;
#pragma unroll
    for (unsigned j = 0; j < 16; ++j) { const unsigned c = xb_ld(&bar[XB_XCNT(j)]); sum += c; cnt += (c > 0u) ? 1u : 0u; mine = (j == x) ? c : mine; }
    if (sum == G) break;
    __builtin_amdgcn_s_sleep(1);
    if ((++sp & 255u) == 0u) { if (xb_ld(&bar[XB_TMO])) break; if (sp > XB_SPIN_CAP) { atomicAdd(&bar[XB_TMO], 1u); break; } }
  }
  nloc = mine > 0u ? mine : 1u; nx = cnt > 0u ? cnt : 1u;
}
DI void xcd_barrier_(const XcdBarrier& b, int wvs) {
  asm volatile("s_waitcnt vmcnt(0)" ::: "memory");
  __syncthreads();
  if (xb_leader(wvs)) {
    unsigned* bar = b.bar;
    __builtin_amdgcn_s_waitcnt(0);
    unsigned nloc = b.st[0], nx = b.st[1];
    if (nloc == 0u) { xcd_barrier_complete(bar, b.x, nloc, nx); b.st[0] = nloc; b.st[1] = nx; }
    const unsigned old = xb_add(&bar[XB_XSUB(b.x)], 1u);
    const unsigned gen = old / nloc;
    if (old + 1u == (gen + 1u) * nloc) {
      __builtin_amdgcn_fence(__ATOMIC_RELEASE, "agent");
      asm volatile("s_waitcnt vmcnt(0)" ::: "memory");
      const unsigned og = xb_add(&bar[XB_TOP], 1u);
      const unsigned tg = og / nx;
      if (og + 1u == (tg + 1u) * nx) xb_add(&bar[XB_TOPGEN], 1u);
      else XB_SPIN(xb_ld(&bar[XB_TOPGEN]) == tg, bar);
      __builtin_amdgcn_fence(__ATOMIC_ACQUIRE, "agent");
      xb_add(&bar[XB_XGEN(b.x)], 1u);
      asm volatile("s_waitcnt vmcnt(0)" ::: "memory");
    } else {
      XB_SPIN(xb_ld(&bar[XB_XGEN(b.x)]) == gen, bar);
      __builtin_amdgcn_fence(__ATOMIC_ACQUIRE, "agent");
      asm volatile("s_waitcnt vmcnt(0)" ::: "memory");
    }
  }
  __syncthreads();
}

#define xcd_barrier(b) xcd_barrier_(b, w8)
namespace pg8 {
#define PG8_LAS __attribute__((address_space(3)))
typedef unsigned short bf16_t;
typedef short bf16x8 __attribute__((ext_vector_type(8)));
typedef float f32x4 __attribute__((ext_vector_type(4)));
typedef unsigned u32x4 __attribute__((ext_vector_type(4)));
constexpr int BM = 256, BK = 64, HALF = 128, HTB = HALF * BK * 2  , STAGE_BYTES = 8 * HTB, NXCD = 8, WGM = 8;

__host__ __device__ __forceinline__ int lds_byte(int r, int c) { const int st = (r >> 4) * 2 + (c >> 5), rr = r & 15, cc = c & 31, ob = rr * 64 + cc * 2; return st * 1024 + (ob ^ (((ob >> 9) & 1) << 5)); }
__host__ __device__ __forceinline__ void stage_rc(int b, int& R, int& C) { const int st = b / 1024, sb = b % 1024, swz = sb ^ (((sb >> 9) & 1) << 5); R = (st >> 1) * 16 + swz / 64; C = (st & 1) * 32 + (swz % 64) / 2; }
__host__ __device__ __forceinline__ int perm32(int rho) { const int n = rho >> 4, i = rho & 15; return 8 * (i >> 2) + 4 * n + (i & 3); }

struct Unit { int pm, pn; };
struct Gemm { const bf16_t* A; const bf16_t* Bt; int M, N, K; };

struct StaticOrder {
    int nM, nN, nwg, G, c;
    __host__ __device__ void init(int M, int N, int G_, int c_) { nM = M / BM; nN = N / BM; nwg = nM * nN; G = G_; c = c_; }
    __host__ __device__ bool next(int i, Unit& u) const {
        const long L = (long)i * G + c; if (L >= nwg) return false;
        int wgid = (int)L; { const int q = nwg / NXCD, r = nwg % NXCD, xcd = wgid % NXCD, off = wgid / NXCD; wgid = (xcd < r ? xcd * (q + 1) : r * (q + 1) + (xcd - r) * q) + off; }
        const int nig = WGM * nN, gid = wgid / nig, fm = gid * WGM, gsz = (nM - fm) < WGM ? (nM - fm) : WGM;
        u.pm = fm + ((wgid % nig) % gsz); u.pn = (wgid % nig) / gsz; return true;
    }
    __device__ __forceinline__ void a_ready(const Unit&) const {}
    __device__ __forceinline__ void done(const Unit&) const {}
};

template <class Epi, class Sched, bool ALIGN_EPI = false, bool SP2 = false>
__device__ __forceinline__ void gemm_phase(PG8_LAS unsigned char* lds, const Gemm g, const Sched& S, const Epi& E, const int tid) {
    const int wid = __builtin_amdgcn_readfirstlane(tid >> 6), lane = tid & 63, wr = wid >> 2, wc = wid & 3, fr = lane & 15, fq = lane >> 4;
    const int K = g.K, nt = K / BK;
    unsigned voffA[2], voffB[2];
#pragma unroll
    for (int i = 0; i < 2; ++i) { int R, C; stage_rc(tid * 16 + i * 8192, R, C); const int Rb = Epi::PERM ? ((R & ~31) + perm32(R & 31)) : R;
        voffA[i] = (unsigned)(R * K + C) * 2u; voffB[i] = (unsigned)(Rb * K + C) * 2u; }
    const size_t kstep = (size_t)(BK * 2);
    const size_t hstep = (size_t)HALF * K * 2;
    const size_t tstep = 2 * hstep;
    const unsigned ldsw = (unsigned)wid * 1024u;
    const int aoff = lds_byte(wr * 64 + fr, fq * 8), boff = lds_byte(wc * 32 + fr, fq * 8);
#define PG8_SA(b, h) (((b) * 2 + (h)) * HTB)
#define PG8_SB(b, h) ((4 + (b) * 2 + (h)) * HTB)
#define PG8_STAGE(bufoff, gbase, voff) do { _Pragma("unroll") for (int _i = 0; _i < 2; ++_i) \
        __builtin_amdgcn_global_load_lds((const unsigned*)((const char*)(gbase) + (voff)[_i]), (PG8_LAS unsigned*)(lds + (bufoff) + ldsw + _i * 8192), 16, 0, 0); } while (0)
#define PG8_LDA(dst, b, h) do { _Pragma("unroll") for (int m = 0; m < 4; ++m) _Pragma("unroll") for (int k = 0; k < 2; ++k) dst[m][k] = *(const PG8_LAS bf16x8*)(lds + PG8_SA(b, h) + aoff + m * 2048 + k * 1024); } while (0)
#define PG8_LDB(dst, b, h) do { _Pragma("unroll") for (int n = 0; n < 2; ++n) _Pragma("unroll") for (int k = 0; k < 2; ++k) dst[n][k] = *(const PG8_LAS bf16x8*)(lds + PG8_SB(b, h) + boff + n * 2048 + k * 1024); } while (0)
#define PG8_MMA(ai, bj, At, Bt) do { __builtin_amdgcn_s_setprio(1); _Pragma("unroll") for (int m = 0; m < 4; ++m) _Pragma("unroll") for (int n = 0; n < 2; ++n) _Pragma("unroll") for (int k = 0; k < 2; ++k) \
        acc[ai][bj][m][n] = __builtin_amdgcn_mfma_f32_16x16x32_bf16(Bt[n][k], At[m][k], acc[ai][bj][m][n], 0, 0, 0); __builtin_amdgcn_s_setprio(0); } while (0)
#define PG8_WAIT_V(n) asm volatile("s_waitcnt vmcnt(" #n ")" ::: "memory")
#define PG8_WAIT_L(n) asm volatile("s_waitcnt lgkmcnt(" #n ")" ::: "memory")
#define PG8_BAR __builtin_amdgcn_s_barrier()
#define PG8_SCHED __builtin_amdgcn_sched_barrier(0)
    Unit cur, nxt; int ui = 0;
    if (!S.next(0, cur)) return;
    f32x4 acc[2][2][4][2];
#pragma unroll
    for (int a = 0; a < 2; ++a)
#pragma unroll
        for (int b = 0; b < 2; ++b)
#pragma unroll
            for (int m = 0; m < 4; ++m)
#pragma unroll
                for (int n = 0; n < 2; ++n) acc[a][b][m][n] = (f32x4){0.f, 0.f, 0.f, 0.f};
    bf16x8 At[4][2], B0[2][2], B1[2][2];
    const char* cA = (const char*)g.A + (size_t)cur.pm * tstep; const char* cB = (const char*)g.Bt + (size_t)cur.pn * tstep;
    S.a_ready(cur);
    if constexpr (SP2) {
        PG8_STAGE(PG8_SB(0, 0), cB, voffB); PG8_STAGE(PG8_SB(0, 1), cB + hstep, voffB); PG8_STAGE(PG8_SA(0, 0), cA, voffA); PG8_STAGE(PG8_SA(0, 1), cA + hstep, voffA);
        if (wr == 1) PG8_BAR;
        PG8_WAIT_V(2); PG8_BAR;
        PG8_STAGE(PG8_SB(1, 0), cB + kstep, voffB); PG8_STAGE(PG8_SA(1, 0), cA + kstep, voffA); PG8_STAGE(PG8_SB(1, 1), cB + hstep + kstep, voffB);
        PG8_WAIT_V(6); PG8_BAR;
    } else {
        PG8_STAGE(PG8_SB(0, 0), cB, voffB); PG8_STAGE(PG8_SA(0, 0), cA, voffA); PG8_STAGE(PG8_SB(0, 1), cB + hstep, voffB); PG8_STAGE(PG8_SA(0, 1), cA + hstep, voffA);
        if (wr == 1) PG8_BAR;
        PG8_WAIT_V(4); PG8_BAR;
        PG8_STAGE(PG8_SB(1, 0), cB + kstep, voffB); PG8_STAGE(PG8_SA(1, 0), cA + kstep, voffA); PG8_STAGE(PG8_SB(1, 1), cB + hstep + kstep, voffB);
        PG8_WAIT_V(6); PG8_BAR;
    }
    for (;;) {
        const bool has_next = S.next(ui + 1, nxt);
        const char* nA = has_next ? (const char*)g.A + (size_t)nxt.pm * tstep : cA; const char* nB = has_next ? (const char*)g.Bt + (size_t)nxt.pn * tstep : cB;
        for (int t = 0; t < nt; t += 2) {
            const bool last = (t == nt - 2);
            const char* a1 = cA + (size_t)(t + 1) * kstep;
            const char* a2 = last ? nA : cA + (size_t)(t + 2) * kstep; const char* b2 = last ? nB : cB + (size_t)(t + 2) * kstep;
            const char* a3 = a2 + kstep; const char* b3 = b2 + kstep;
            if (last && has_next) S.a_ready(nxt);
            if constexpr (SP2) {
            PG8_LDB(B0, 0, 0); PG8_LDB(B1, 0, 1); PG8_SCHED; PG8_LDA(At, 0, 0); PG8_STAGE(PG8_SA(1, 1), a1 + hstep, voffA);
            PG8_WAIT_V(8); PG8_WAIT_L(0); PG8_BAR; PG8_MMA(0, 0, At, B0); PG8_MMA(0, 1, At, B1); PG8_BAR; PG8_SCHED;
            PG8_LDA(At, 0, 1); PG8_STAGE(PG8_SB(0, 0), b2, voffB); PG8_STAGE(PG8_SB(0, 1), b2 + hstep, voffB); PG8_STAGE(PG8_SA(0, 0), a2, voffA);
            PG8_WAIT_V(8); PG8_WAIT_L(0); PG8_BAR; PG8_MMA(1, 0, At, B0); PG8_MMA(1, 1, At, B1); PG8_BAR; PG8_SCHED;
            PG8_LDB(B0, 1, 0); PG8_LDB(B1, 1, 1); PG8_SCHED; PG8_LDA(At, 1, 0); PG8_STAGE(PG8_SA(0, 1), a2 + hstep, voffA);
            PG8_WAIT_V(8); PG8_WAIT_L(0); PG8_BAR; PG8_MMA(0, 0, At, B0); PG8_MMA(0, 1, At, B1); PG8_BAR; PG8_SCHED;
            PG8_LDA(At, 1, 1); PG8_STAGE(PG8_SB(1, 0), b3, voffB); PG8_STAGE(PG8_SB(1, 1), b3 + hstep, voffB); PG8_STAGE(PG8_SA(1, 0), a3, voffA);
            PG8_WAIT_V(8); PG8_WAIT_L(0); PG8_BAR; PG8_MMA(1, 0, At, B0); PG8_MMA(1, 1, At, B1); PG8_BAR; PG8_SCHED;
            } else {
            PG8_LDB(B0, 0, 0); PG8_SCHED; PG8_LDA(At, 0, 0); PG8_STAGE(PG8_SA(1, 1), a1 + hstep, voffA);
            PG8_WAIT_L(8); PG8_BAR; PG8_WAIT_L(0); PG8_MMA(0, 0, At, B0); PG8_BAR; PG8_SCHED;
            PG8_LDB(B1, 0, 1); PG8_STAGE(PG8_SB(0, 0), b2, voffB);
            PG8_BAR; PG8_WAIT_L(0); PG8_MMA(0, 1, At, B1); PG8_BAR;
            PG8_LDA(At, 0, 1); PG8_STAGE(PG8_SA(0, 0), a2, voffA);
            PG8_BAR; PG8_WAIT_L(0); PG8_MMA(1, 0, At, B0); PG8_BAR; PG8_SCHED;
            PG8_STAGE(PG8_SB(0, 1), b2 + hstep, voffB);
            PG8_WAIT_V(6); PG8_BAR; PG8_MMA(1, 1, At, B1); PG8_BAR;
            PG8_LDB(B0, 1, 0); PG8_SCHED; PG8_LDA(At, 1, 0); PG8_STAGE(PG8_SA(0, 1), a2 + hstep, voffA);
            PG8_WAIT_L(8); PG8_BAR; PG8_WAIT_L(0); PG8_MMA(0, 0, At, B0); PG8_BAR; PG8_SCHED;
            PG8_LDB(B1, 1, 1); PG8_STAGE(PG8_SB(1, 0), b3, voffB);
            PG8_BAR; PG8_WAIT_L(0); PG8_MMA(0, 1, At, B1); PG8_BAR;
            PG8_LDA(At, 1, 1); PG8_STAGE(PG8_SA(1, 0), a3, voffA);
            PG8_BAR; PG8_WAIT_L(0); PG8_MMA(1, 0, At, B0); PG8_BAR; PG8_SCHED;
            PG8_STAGE(PG8_SB(1, 1), b3 + hstep, voffB);
            PG8_WAIT_V(6); PG8_BAR; PG8_MMA(1, 1, At, B1); PG8_BAR;
            }
        }
        if constexpr (ALIGN_EPI) { if (wr == 0) PG8_BAR; }
        if constexpr (!Epi::AFTER_DRAIN) { E(acc, cur, wr, wc, fr, fq); S.done(cur); }
        if (!has_next) break;
#pragma unroll
        for (int a = 0; a < 2; ++a)
#pragma unroll
            for (int b = 0; b < 2; ++b)
#pragma unroll
                for (int m = 0; m < 4; ++m)
#pragma unroll
                    for (int n = 0; n < 2; ++n) acc[a][b][m][n] = (f32x4){0.f, 0.f, 0.f, 0.f};
        cur = nxt; cA = nA; cB = nB; ++ui;
        if constexpr (ALIGN_EPI) { if (wr == 1) PG8_BAR; }
    }
    PG8_WAIT_V(0);
    if constexpr (!ALIGN_EPI) { if (wr == 0) PG8_BAR; }
    PG8_BAR;
    if constexpr (Epi::AFTER_DRAIN) { E.fused(acc, cur, wr, wc, fr, fq, lds, wid, lane); S.done(cur); }
#undef PG8_SA
#undef PG8_SB
#undef PG8_STAGE
#undef PG8_LDA
#undef PG8_LDB
#undef PG8_MMA
#undef PG8_WAIT_V
#undef PG8_WAIT_L
#undef PG8_BAR
#undef PG8_SCHED
}

struct Unit2 { int pm, pn, part; };
struct Gemm2 { const bf16_t* A0; const bf16_t* A1; const bf16_t* B0; const bf16_t* B1; int lda, K; };
struct StaticOrder2 {
    int nM, nN, nwg, G, c;
    __host__ __device__ void init(int M, int N, int G_, int c_) { nM = M / BM; nN = N / BM; nwg = nM * nN; G = G_; c = c_; }
    __host__ __device__ bool next(int i, Unit2& u) const {
        const long L = (long)(i >> 1) * G + c; if (L >= nwg) return false;
        int wgid = (int)L; { const int q = nwg / NXCD, r = nwg % NXCD, xcd = wgid % NXCD, off = wgid / NXCD; wgid = (xcd < r ? xcd * (q + 1) : r * (q + 1) + (xcd - r) * q) + off; }
        const int nig = WGM * nN, gid = wgid / nig, fm = gid * WGM, gsz = (nM - fm) < WGM ? (nM - fm) : WGM;
        u.pm = fm + ((wgid % nig) % gsz); u.pn = (wgid % nig) / gsz; u.part = i & 1; return true;
    }
    __device__ __forceinline__ void a_ready(const Unit2&) const {}
    __device__ __forceinline__ void done(const Unit2&) const {}
    const float* ssq; PG8_LAS float* rs; int tid;
    __device__ __forceinline__ void prep_rows(const Unit2& u) const {
        const int row = tid >> 1, h0 = (tid & 1) * 2;
        const float* sp = ssq + (size_t)(h0 * 8) * 32768 + (u.pm * 256 + row);
        float sa = 0.f, sb = 0.f;
#pragma unroll
        for (int k = 0; k < 8; ++k) { sa += sp[(size_t)k * 32768]; sb += sp[(size_t)(8 + k) * 32768]; }
        rs[row * 4 + h0] = __builtin_amdgcn_rsqf(sa * (1.0f / 128.0f) + 1e-6f);
        rs[row * 4 + h0 + 1] = __builtin_amdgcn_rsqf(sb * (1.0f / 128.0f) + 1e-6f);
    }
};
template <class Epi, class Sched, bool ALIGN_EPI = false, bool SP2 = false>
__device__ __forceinline__ void gemm_phase2(PG8_LAS unsigned char* lds, const Gemm2 g, const Sched& S, const Epi& E, const int tid) {
    const int wid = __builtin_amdgcn_readfirstlane(tid >> 6), lane = tid & 63, wr = wid >> 2, wc = wid & 3, fr = lane & 15, fq = lane >> 4;
    const int K = g.K, nt = K / BK;
    unsigned voffA[2], voffB[2];
#pragma unroll
    for (int i = 0; i < 2; ++i) { int R, C; stage_rc(tid * 16 + i * 8192, R, C); const int Rb = Epi::PERM ? ((R & ~31) + perm32(R & 31)) : R;
        voffA[i] = (unsigned)(R * g.lda + C) * 2u; voffB[i] = (unsigned)(Rb * K + C) * 2u; }
    const size_t kstep = (size_t)(BK * 2);
    const size_t hstep = (size_t)HALF * K * 2;
    const size_t tstep = 2 * hstep;
    const size_t hstepA = (size_t)HALF * g.lda * 2, tstepA = 2 * hstepA;
    const unsigned ldsw = (unsigned)wid * 1024u;
    const int aoff = lds_byte(wr * 64 + fr, fq * 8), boff = lds_byte(wc * 32 + fr, fq * 8);
#define PG8_SA(b, h) (((b) * 2 + (h)) * HTB)
#define PG8_SB(b, h) ((4 + (b) * 2 + (h)) * HTB)
#define PG8_STAGE(bufoff, gbase, voff) do { _Pragma("unroll") for (int _i = 0; _i < 2; ++_i) \
        __builtin_amdgcn_global_load_lds((const unsigned*)((const char*)(gbase) + (voff)[_i]), (PG8_LAS unsigned*)(lds + (bufoff) + ldsw + _i * 8192), 16, 0, 0); } while (0)
#define PG8_LDA(dst, b, h) do { _Pragma("unroll") for (int m = 0; m < 4; ++m) _Pragma("unroll") for (int k = 0; k < 2; ++k) dst[m][k] = *(const PG8_LAS bf16x8*)(lds + PG8_SA(b, h) + aoff + m * 2048 + k * 1024); } while (0)
#define PG8_LDB(dst, b, h) do { _Pragma("unroll") for (int n = 0; n < 2; ++n) _Pragma("unroll") for (int k = 0; k < 2; ++k) dst[n][k] = *(const PG8_LAS bf16x8*)(lds + PG8_SB(b, h) + boff + n * 2048 + k * 1024); } while (0)
#define PG8_MMA(ai, bj, At, Bt) do { __builtin_amdgcn_s_setprio(1); _Pragma("unroll") for (int m = 0; m < 4; ++m) _Pragma("unroll") for (int n = 0; n < 2; ++n) _Pragma("unroll") for (int k = 0; k < 2; ++k) \
        acc[ai][bj][m][n] = __builtin_amdgcn_mfma_f32_16x16x32_bf16(Bt[n][k], At[m][k], acc[ai][bj][m][n], 0, 0, 0); __builtin_amdgcn_s_setprio(0); } while (0)
#define PG8_WAIT_V(n) asm volatile("s_waitcnt vmcnt(" #n ")" ::: "memory")
#define PG8_WAIT_L(n) asm volatile("s_waitcnt lgkmcnt(" #n ")" ::: "memory")
#define PG8_BAR __builtin_amdgcn_s_barrier()
#define PG8_SCHED __builtin_amdgcn_sched_barrier(0)
    Unit2 cur, nxt; int ui = 0;
    if (!S.next(0, cur)) return;
    f32x4 acc[2][2][4][2];
#pragma unroll
    for (int a = 0; a < 2; ++a)
#pragma unroll
        for (int b = 0; b < 2; ++b)
#pragma unroll
            for (int m = 0; m < 4; ++m)
#pragma unroll
                for (int n = 0; n < 2; ++n) acc[a][b][m][n] = (f32x4){0.f, 0.f, 0.f, 0.f};
    bf16x8 At[4][2], B0[2][2], B1[2][2];
    const char* cA = (const char*)(cur.part ? g.A1 : g.A0) + (size_t)cur.pm * tstepA; const char* cB = (const char*)(cur.part ? g.B1 : g.B0) + (size_t)cur.pn * tstep;
    S.a_ready(cur);
    S.prep_rows(cur);
    if constexpr (SP2) {
        PG8_STAGE(PG8_SB(0, 0), cB, voffB); PG8_STAGE(PG8_SB(0, 1), cB + hstep, voffB); PG8_STAGE(PG8_SA(0, 0), cA, voffA); PG8_STAGE(PG8_SA(0, 1), cA + hstepA, voffA);
        if (wr == 1) PG8_BAR;
        PG8_WAIT_V(2); PG8_BAR;
        PG8_STAGE(PG8_SB(1, 0), cB + kstep, voffB); PG8_STAGE(PG8_SA(1, 0), cA + kstep, voffA); PG8_STAGE(PG8_SB(1, 1), cB + hstep + kstep, voffB);
        PG8_WAIT_V(6); PG8_BAR;
    } else {
        PG8_STAGE(PG8_SB(0, 0), cB, voffB); PG8_STAGE(PG8_SA(0, 0), cA, voffA); PG8_STAGE(PG8_SB(0, 1), cB + hstep, voffB); PG8_STAGE(PG8_SA(0, 1), cA + hstepA, voffA);
        if (wr == 1) PG8_BAR;
        PG8_WAIT_V(4); PG8_BAR;
        PG8_STAGE(PG8_SB(1, 0), cB + kstep, voffB); PG8_STAGE(PG8_SA(1, 0), cA + kstep, voffA); PG8_STAGE(PG8_SB(1, 1), cB + hstep + kstep, voffB);
        PG8_WAIT_V(6); PG8_BAR;
    }
    for (;;) {
        const bool has_next = S.next(ui + 1, nxt);
        const char* nA = has_next ? (const char*)(nxt.part ? g.A1 : g.A0) + (size_t)nxt.pm * tstepA : cA; const char* nB = has_next ? (const char*)(nxt.part ? g.B1 : g.B0) + (size_t)nxt.pn * tstep : cB;
        for (int t = 0; t < nt; t += 2) {
            const bool last = (t == nt - 2);
            const char* a1 = cA + (size_t)(t + 1) * kstep;
            const char* a2 = last ? nA : cA + (size_t)(t + 2) * kstep; const char* b2 = last ? nB : cB + (size_t)(t + 2) * kstep;
            const char* a3 = a2 + kstep; const char* b3 = b2 + kstep;
            if (last && has_next) S.a_ready(nxt);
            if constexpr (SP2) {
            PG8_LDB(B0, 0, 0); PG8_LDB(B1, 0, 1); PG8_SCHED; PG8_LDA(At, 0, 0); PG8_STAGE(PG8_SA(1, 1), a1 + hstepA, voffA);
            PG8_WAIT_V(8); PG8_WAIT_L(0); PG8_BAR; PG8_MMA(0, 0, At, B0); PG8_MMA(0, 1, At, B1); PG8_BAR; PG8_SCHED;
            PG8_LDA(At, 0, 1); PG8_STAGE(PG8_SB(0, 0), b2, voffB); PG8_STAGE(PG8_SB(0, 1), b2 + hstep, voffB); PG8_STAGE(PG8_SA(0, 0), a2, voffA);
            PG8_WAIT_V(8); PG8_WAIT_L(0); PG8_BAR; PG8_MMA(1, 0, At, B0); PG8_MMA(1, 1, At, B1); PG8_BAR; PG8_SCHED;
            PG8_LDB(B0, 1, 0); PG8_LDB(B1, 1, 1); PG8_SCHED; PG8_LDA(At, 1, 0); PG8_STAGE(PG8_SA(0, 1), a2 + hstepA, voffA);
            PG8_WAIT_V(8); PG8_WAIT_L(0); PG8_BAR; PG8_MMA(0, 0, At, B0); PG8_MMA(0, 1, At, B1); PG8_BAR; PG8_SCHED;
            PG8_LDA(At, 1, 1); PG8_STAGE(PG8_SB(1, 0), b3, voffB); PG8_STAGE(PG8_SB(1, 1), b3 + hstep, voffB); PG8_STAGE(PG8_SA(1, 0), a3, voffA);
            PG8_WAIT_V(8); PG8_WAIT_L(0); PG8_BAR; PG8_MMA(1, 0, At, B0); PG8_MMA(1, 1, At, B1); PG8_BAR; PG8_SCHED;
            } else {
            PG8_LDB(B0, 0, 0); PG8_SCHED; PG8_LDA(At, 0, 0); PG8_STAGE(PG8_SA(1, 1), a1 + hstepA, voffA);
            PG8_WAIT_L(8); PG8_BAR; PG8_WAIT_L(0); PG8_MMA(0, 0, At, B0); PG8_BAR; PG8_SCHED;
            PG8_LDB(B1, 0, 1); PG8_STAGE(PG8_SB(0, 0), b2, voffB);
            PG8_BAR; PG8_WAIT_L(0); PG8_MMA(0, 1, At, B1); PG8_BAR;
            PG8_LDA(At, 0, 1); PG8_STAGE(PG8_SA(0, 0), a2, voffA);
            PG8_BAR; PG8_WAIT_L(0); PG8_MMA(1, 0, At, B0); PG8_BAR; PG8_SCHED;
            PG8_STAGE(PG8_SB(0, 1), b2 + hstep, voffB);
            PG8_WAIT_V(6); PG8_BAR; PG8_MMA(1, 1, At, B1); PG8_BAR;
            PG8_LDB(B0, 1, 0); PG8_SCHED; PG8_LDA(At, 1, 0); PG8_STAGE(PG8_SA(0, 1), a2 + hstepA, voffA);
            PG8_WAIT_L(8); PG8_BAR; PG8_WAIT_L(0); PG8_MMA(0, 0, At, B0); PG8_BAR; PG8_SCHED;
            PG8_LDB(B1, 1, 1); PG8_STAGE(PG8_SB(1, 0), b3, voffB);
            PG8_BAR; PG8_WAIT_L(0); PG8_MMA(0, 1, At, B1); PG8_BAR;
            PG8_LDA(At, 1, 1); PG8_STAGE(PG8_SA(1, 0), a3, voffA);
            PG8_BAR; PG8_WAIT_L(0); PG8_MMA(1, 0, At, B0); PG8_BAR; PG8_SCHED;
            PG8_STAGE(PG8_SB(1, 1), b3 + hstep, voffB);
            PG8_WAIT_V(6); PG8_BAR; PG8_MMA(1, 1, At, B1); PG8_BAR;
            }
            if (cur.part == 0 && !last) E.kscale(acc, t >> 1, wr, fr);
        }
        if constexpr (ALIGN_EPI) { if (wr == 0) PG8_BAR; }
        if (cur.part == 0) E.mid(acc, cur, wr, wc, fr, fq); else E(acc, cur, wr, wc, fr, fq);
        if (!has_next) break;
        if (cur.part == 1) S.prep_rows(nxt);
        if (cur.part == 1) {
#pragma unroll
        for (int a = 0; a < 2; ++a)
#pragma unroll
            for (int b = 0; b < 2; ++b)
#pragma unroll
                for (int m = 0; m < 4; ++m)
#pragma unroll
                    for (int n = 0; n < 2; ++n) acc[a][b][m][n] = (f32x4){0.f, 0.f, 0.f, 0.f};
        }
        cur = nxt; cA = nA; cB = nB; ++ui;
        if constexpr (ALIGN_EPI) { if (wr == 1) PG8_BAR; }
    }
    PG8_WAIT_V(0);
    if constexpr (!ALIGN_EPI) { if (wr == 0) PG8_BAR; }
    PG8_BAR;
#undef PG8_SA
#undef PG8_SB
#undef PG8_STAGE
#undef PG8_LDA
#undef PG8_LDB
#undef PG8_MMA
#undef PG8_WAIT_V
#undef PG8_WAIT_L
#undef PG8_BAR
#undef PG8_SCHED
}
}

struct EpiInProj {
  static constexpr bool PERM = true, AFTER_DRAIN = false;
  u16* h;
  DI void operator()(const f32x4 (&acc)[2][2][4][2], const pg8::Unit& u, int wr, int wc, int fr, int fq) const {
    const int shift = (u.pn >= 8) ? 8 : 0;
#pragma unroll
    for (int ai = 0; ai < 2; ++ai)
#pragma unroll
      for (int m = 0; m < 4; ++m) {
        const int row = u.pm * 256 + ai * 128 + wr * 64 + m * 16 + fr;
#pragma unroll
        for (int bj = 0; bj < 2; ++bj) {
          const int col = u.pn * 256 + bj * 128 + wc * 32 + 8 * fq + shift;
          const f32x4 a = acc[ai][bj][m][0], b = acc[ai][bj][m][1];
          u32x4 w; w.x = pk_bf16(a[0], a[1]); w.y = pk_bf16(a[2], a[3]); w.z = pk_bf16(b[0], b[1]); w.w = pk_bf16(b[2], b[3]);
          *(u32x4*)(h + (size_t)row * NC + col) = w;
        }
      }
  }
};

struct EpiMerge {
  static constexpr bool PERM = true, AFTER_DRAIN = false;
  const u16* h; u16* mg; PG8_LAS float* rs;
  DI void kscale(f32x4 (&acc)[2][2][4][2], int hh, int wr, int fr) const {
#pragma unroll
    for (int ai = 0; ai < 2; ++ai)
#pragma unroll
      for (int m = 0; m < 4; ++m) {
        const int rl = ai * 128 + wr * 64 + m * 16 + fr;
        const float f = rs[rl * 4 + hh] * rcp_f(rs[rl * 4 + hh + 1]);
#pragma unroll
        for (int bj = 0; bj < 2; ++bj) { acc[ai][bj][m][0] *= f; acc[ai][bj][m][1] *= f; }
      }
  }
  DI void mid(f32x4 (&acc)[2][2][4][2], const pg8::Unit2& u, int wr, int wc, int fr, int fq) const {
#pragma unroll
    for (int ai = 0; ai < 2; ++ai) {
      u32x4 ga[4][2], gb[4][2];
#pragma unroll
      for (int m = 0; m < 4; ++m)
#pragma unroll
        for (int bj = 0; bj < 2; ++bj) {
          const size_t off = (size_t)(u.pm * 256 + ai * 128 + wr * 64 + m * 16 + fr) * NC + (u.pn * 256 + bj * 128 + wc * 32 + 8 * fq);
          ga[m][bj] = *(const u32x4*)(h + off + C_GA); gb[m][bj] = *(const u32x4*)(h + off + C_GB);
        }
      __builtin_amdgcn_sched_barrier(0);
#pragma unroll
      for (int m = 0; m < 4; ++m)
#pragma unroll
        for (int bj = 0; bj < 2; ++bj)
#pragma unroll
          for (int j = 0; j < 4; ++j) {
            const float r3 = rs[(ai * 128 + wr * 64 + m * 16 + fr) * 4 + 3];
            const float r0 = r3 * (1.f + __expf(-bf_lo(gb[m][bj][j]))) * rcp_f(1.f + __expf(-bf_lo(ga[m][bj][j])));
            const float r1 = r3 * (1.f + __expf(-bf_hi(gb[m][bj][j]))) * rcp_f(1.f + __expf(-bf_hi(ga[m][bj][j])));
            acc[ai][bj][m][j >> 1][2 * (j & 1)] *= r0; acc[ai][bj][m][j >> 1][2 * (j & 1) + 1] *= r1;
          }
      __builtin_amdgcn_sched_barrier(0);
    }
  }
  DI void operator()(const f32x4 (&acc)[2][2][4][2], const pg8::Unit2& u, int wr, int wc, int fr, int fq) const {
#pragma unroll
    for (int ai = 0; ai < 2; ++ai) {
      u32x4 gb[4][2];
#pragma unroll
      for (int m = 0; m < 4; ++m)
#pragma unroll
        for (int bj = 0; bj < 2; ++bj)
          gb[m][bj] = *(const u32x4*)(h + (size_t)(u.pm * 256 + ai * 128 + wr * 64 + m * 16 + fr) * NC + C_GB + (u.pn * 256 + bj * 128 + wc * 32 + 8 * fq));
      __builtin_amdgcn_sched_barrier(0);
#pragma unroll
      for (int m = 0; m < 4; ++m)
#pragma unroll
        for (int bj = 0; bj < 2; ++bj) {
          const int row = u.pm * 256 + ai * 128 + wr * 64 + m * 16 + fr, col = u.pn * 256 + bj * 128 + wc * 32 + 8 * fq;
          const f32x4 a = acc[ai][bj][m][0], b = acc[ai][bj][m][1];
          const u32x4 g = gb[m][bj];
          u32x4 w;
          w.x = pk_bf16(a[0] * sigmoid_f(bf_lo(g[0])), a[1] * sigmoid_f(bf_hi(g[0])));
          w.y = pk_bf16(a[2] * sigmoid_f(bf_lo(g[1])), a[3] * sigmoid_f(bf_hi(g[1])));
          w.z = pk_bf16(b[0] * sigmoid_f(bf_lo(g[2])), b[1] * sigmoid_f(bf_hi(g[2])));
          w.w = pk_bf16(b[2] * sigmoid_f(bf_lo(g[3])), b[3] * sigmoid_f(bf_hi(g[3])));
          *(u32x4*)(mg + (size_t)row * 1024 + col) = w;
        }
      __builtin_amdgcn_sched_barrier(0);
    }
  }
};

struct EpiOut {
  static constexpr bool PERM = true, AFTER_DRAIN = false;
  const float* x; _Float16* r16;
  DI void operator()(const f32x4 (&acc)[2][2][4][2], const pg8::Unit& u, int wr, int wc, int fr, int fq) const {
#pragma unroll
    for (int ai = 0; ai < 2; ++ai) {
      f32x4 xv[4][2][2];
#pragma unroll
      for (int m = 0; m < 4; ++m)
#pragma unroll
        for (int bj = 0; bj < 2; ++bj) {
          const float* xp = x + (size_t)(u.pm * 256 + ai * 128 + wr * 64 + m * 16 + fr) * 1024 + (u.pn * 256 + bj * 128 + wc * 32 + 8 * fq);
          xv[m][bj][0] = *(const f32x4*)xp; xv[m][bj][1] = *(const f32x4*)(xp + 4);
        }
      __builtin_amdgcn_sched_barrier(0);
#pragma unroll
      for (int m = 0; m < 4; ++m)
#pragma unroll
        for (int bj = 0; bj < 2; ++bj) {
          const int row = u.pm * 256 + ai * 128 + wr * 64 + m * 16 + fr, col = u.pn * 256 + bj * 128 + wc * 32 + 8 * fq;
          const f32x4 v0 = xv[m][bj][0] * 1.189207115002721f + acc[ai][bj][m][0], v1 = xv[m][bj][1] * 1.189207115002721f + acc[ai][bj][m][1];
          const f16x4 h0 = __builtin_convertvector(v0, f16x4), h1 = __builtin_convertvector(v1, f16x4);
          u32x4 w; const u32x2 p0 = __builtin_bit_cast(u32x2, h0), p1 = __builtin_bit_cast(u32x2, h1);
          w.x = p0.x; w.y = p0.y; w.z = p1.x; w.w = p1.y;
          *(u32x4*)(r16 + (size_t)row * 1024 + col) = w;
        }
      __builtin_amdgcn_sched_barrier(0);
    }
  }
};

__global__ void __launch_bounds__(512, 2) fwd_megakernel(Params p) {
  cg::grid_group grid = cg::this_grid();
  __shared__ __attribute__((aligned(16))) unsigned char smem[SMEM_BYTES];
  const int w8 = __builtin_amdgcn_readfirstlane((int)(threadIdx.x >> 6));
  const int wvs = w8 & 3, half = w8 >> 2;
  unsigned char* hsm = smem + half * HALF_SMEM;
  const int vb = blockIdx.x + half * gridDim.x, nvb = 2 * gridDim.x;
  volatile LAS unsigned* st = (volatile LAS unsigned*)(smem + SMEM_BYTES - 16);
  { const int t0_ = opaque_tid(); if (t0_ < 4) st[t0_] = 0u; }
  __syncthreads();
  const XcdBarrier xb = xcd_barrier_post((unsigned*)(p.ws + OFF_BAR), st, w8);
  phase0(p, w8);
  if (p.ws == nullptr) grid.sync();
  xcd_barrier(xb);
  {
    pg8::Gemm g; g.A = (const pg8::bf16_t*)(p.ws + OFF_SC); g.Bt = (const pg8::bf16_t*)(p.ws + OFF_WINT); g.M = T_TOK; g.N = NCP; g.K = 1024;
    pg8::StaticOrder so; so.init(T_TOK, NCP, (int)gridDim.x, (int)blockIdx.x);
    EpiInProj e; e.h = (u16*)(p.ws + OFF_H);
    pg8::gemm_phase<EpiInProj, pg8::StaticOrder, true, true>((PG8_LAS unsigned char*)smem, g, so, e, opaque_tid_(w8));
  }
  xcd_barrier(xb);
  for (int it = vb; it < 2048; it += nvb) prep_item(p, wvs, it, hsm);
  xcd_barrier(xb);
  if (blockIdx.x < 128) {
    if (half == 0) { const int cb = (int)blockIdx.x; scan_chain(p, wvs, (cb & 7) + 8 * ((cb >> 3) >> 3), (cb >> 3) & 7, hsm); }
    else {
      const int cb = (int)blockIdx.x, pr = (cb & 7) + 8 * ((cb >> 3) >> 3), slp = (cb >> 3) & 7, bp = pr >> 2, hp = pr & 3;
      const int ft = opaque_tid();
      const unsigned char* pbase = p.ws + OFF_SC + (size_t)(slp * 72 + (ft < 72 ? ft : 0)) * 128;
      const int zq = ft >> 6, zl = ft & 63;
      const u16* zbase = (const u16*)(p.ws + OFF_H) + (size_t)(bp * SEQ + 16 * zq + 4 * (zl >> 4)) * NC + C_DNZ + hp * 128 + 16 * slp + (zl & 15);
      const float nwp = p.dn_norm_w[16 * slp + (zl & 15)];
      unsigned char* ringp = smem + 8192;
      const unsigned char* ubase = p.ws + OFF_SC + 57344 + slp * 2048 + ft * 8;
      const float* dbase = (const float*)(p.ws + OFF_DEC);
#define Z_LOAD(dst, step_) do { const int st_ = (step_) < 0 ? 0 : ((step_) < 128 ? (step_) : 127); const u16* zp_ = zbase + (size_t)st_ * 64 * NC; \
        _Pragma("unroll") for (int r_ = 0; r_ < 4; ++r_) dst[r_] = zp_[(size_t)r_ * NC]; } while (0)
#define U_LOAD(du, dd, step_) do { const int it_ = (bp * 128 + ((step_) < 128 ? (step_) : 127)) * 4 + hp; du = *(const u32x2*)(ubase + (size_t)it_ * OPB); dd = dbase[it_]; } while (0)
#define U_STORE(su, sd, step_) do { *(u32x2*)(ringp + ((step_) % 3) * 6400 + 4096 + ft * 8) = su; if (ft == 0) *(float*)(ringp + ((step_) % 3) * 6400 + 6144) = sd; } while (0)
#define O_DRAIN(zsrc, step_) do { const f32x4 o_ = *(const f32x4*)(ringp + ((step_) % 3) * 6400 + ft * 16); \
        const size_t row0_ = (size_t)(bp * SEQ + (step_) * 64 + 16 * zq + 4 * (zl >> 4)); \
        f32x4 sq_; \
        _Pragma("unroll") for (int r_ = 0; r_ < 4; ++r_) { \
          hout[(row0_ + r_) * NC + hp * 128 + 16 * slp + (zl & 15)] = f2bf(o_[r_] * nwp * silu_f(bf2f(zsrc[r_]))); \
          sq_[r_] = row16_sum(o_[r_] * o_[r_]); } \
        if ((zl & 15) == 0) *(f32x4*)(ssqp + (size_t)(hp * 8 + slp) * T_TOK + row0_) = sq_; } while (0)
      u16* hout = (u16*)(p.ws + OFF_H);
      float* ssqp = (float*)(p.ws + OFF_SSQ);
      u16 zr0[4], zr1[4], zr2[4], zr3[4];
      u32x2 ur0, ur1, ur2, ur3; float dr0, dr1, dr2, dr3;
      unsigned pr0 = 0, pr1 = 0, pr2 = 0, pr3 = 0, accp = 0;
      Z_LOAD(zr0, 0); Z_LOAD(zr1, 1);
#pragma unroll
      for (int r = 0; r < 4; ++r) { zr2[r] = 0; zr3[r] = 0; }
      U_LOAD(ur0, dr0, 0); U_LOAD(ur1, dr1, 1); U_LOAD(ur2, dr2, 2); U_LOAD(ur3, dr3, 3);
      U_STORE(ur0, dr0, 0);
      __syncthreads();
#define P_ITER(m_, K0, K1, K2) do { \
        U_STORE(ur##K1, dr##K1, (m_) + 1); U_LOAD(ur##K0, dr##K0, (m_) + 4); \
        if ((m_) >= 2) O_DRAIN(zr##K2, (m_) - 2); \
        Z_LOAD(zr##K2, (m_) + 2); \
        accp ^= pr##K0; { const int np_ = (m_) + 6 < 128 ? (m_) + 6 : 127; pr##K0 = *(const unsigned*)(pbase + (size_t)((bp * 128 + np_) * 4 + hp) * OPB); } \
        __syncthreads(); __syncthreads(); } while (0)
#pragma unroll 1
      for (int mm = 0; mm < 128; mm += 4) { P_ITER(mm, 0, 1, 2); P_ITER(mm + 1, 1, 2, 3); P_ITER(mm + 2, 2, 3, 0); P_ITER(mm + 3, 3, 0, 1); }
#undef P_ITER
      __syncthreads();
      O_DRAIN(zr2, 126); O_DRAIN(zr3, 127);
      accp ^= pr0 ^ pr1 ^ pr2 ^ pr3;
#undef Z_LOAD
#undef U_LOAD
#undef U_STORE
#undef O_DRAIN
      if (accp == 0x9e3779b9u && ft == 300) ((unsigned*)(p.ws + OFF_BAR))[XB_TMO + 1] = accp;
    }
  } else {
    const int nsw = 2 * ((int)gridDim.x - 128), vbl = ((int)blockIdx.x - 128) + half * ((int)gridDim.x - 128);
    for (int k = 0; k * nsw < 1024; ++k) { const int it = vbl + k * nsw; swa_item(p, wvs, it < 1024 ? it : 0, it < 1024, hsm); }
  }
  xcd_barrier(xb);
  {
    pg8::Gemm2 g; g.A0 = (const pg8::bf16_t*)(p.ws + OFF_H); g.A1 = g.A0 + C_SWQ; g.B0 = (const pg8::bf16_t*)(p.ws + OFF_WAT); g.B1 = (const pg8::bf16_t*)(p.ws + OFF_WBT);
    g.lda = NC; g.K = 512;
    pg8::StaticOrder2 so; so.init(T_TOK, 1024, (int)gridDim.x, (int)blockIdx.x);
    so.ssq = (const float*)(p.ws + OFF_SSQ); so.rs = (PG8_LAS float*)(smem + 131072); so.tid = opaque_tid_(w8);
    EpiMerge e; e.h = (const u16*)(p.ws + OFF_H); e.mg = (u16*)(p.ws + OFF_SC); e.rs = (PG8_LAS float*)(smem + 131072);
    pg8::gemm_phase2<EpiMerge, pg8::StaticOrder2, true, true>((PG8_LAS unsigned char*)smem, g, so, e, opaque_tid_(w8));
  }
  xcd_barrier(xb);
  {
    pg8::Gemm g; g.A = (const pg8::bf16_t*)(p.ws + OFF_SC); g.Bt = (const pg8::bf16_t*)(p.ws + OFF_WOT); g.M = T_TOK; g.N = 1024; g.K = 1024;
    pg8::StaticOrder so; so.init(T_TOK, 1024, (int)gridDim.x, (int)blockIdx.x);
    EpiOut e; e.x = p.x; e.r16 = (_Float16*)(p.ws + OFF_H);
    pg8::gemm_phase<EpiOut, pg8::StaticOrder, true, true>((PG8_LAS unsigned char*)smem, g, so, e, opaque_tid_(w8));
  }
  xcd_barrier(xb);
  phase6(p, w8, smem);
}

extern "C" void kernel_launch(void* const* d_in, const int* in_sizes, int n_in, void* d_out, int out_size,
                              void* d_ws, size_t ws_size, hipStream_t stream) {
  if (ws_size < WS_NEED) { fprintf(stderr, "workspace too small: %zu < %zu\n", ws_size, (size_t)WS_NEED); return; }
  Params p{};
  p.x = (const float*)d_in[0]; p.w_in = (const float*)d_in[1]; p.conv_w = (const float*)d_in[2]; p.a_log = (const float*)d_in[3];
  p.dt_bias = (const float*)d_in[4]; p.dn_norm_w = (const float*)d_in[5]; p.sinks = (const float*)d_in[6];
  p.w_branch = (const float*)d_in[7]; p.w_out = (const float*)d_in[8]; p.ln_g = (const float*)d_in[9]; p.ln_b = (const float*)d_in[10];
  p.out = (float*)d_out; p.ws = (unsigned char*)d_ws;
  for (int i = 0; i < 8; ++i) p.inv_freq[i] = (float)std::pow(500000.0, -(double)i / 8.0);
  static int grid_blocks = 0;
  if (!grid_blocks) {
    int dev = 0, cus = 0, per_cu = 0;
    (void)hipGetDevice(&dev);
    (void)hipDeviceGetAttribute(&cus, hipDeviceAttributeMultiprocessorCount, dev);
    (void)hipOccupancyMaxActiveBlocksPerMultiprocessor(&per_cu, fwd_megakernel, 512, 0);
    if (per_cu < 1) fprintf(stderr, "occupancy query reports %d workgroups per CU\n", per_cu);
    grid_blocks = cus > 256 ? 256 : cus;
    grid_blocks &= ~7;
  }
  (void)hipMemsetAsync(p.ws + OFF_BAR, 0, BAR_BYTES, stream);
  void* args[] = {&p};
  hipError_t e = hipLaunchCooperativeKernel((void*)fwd_megakernel, dim3(grid_blocks), dim3(512), args, 0, stream);
  if (e != hipSuccess) fprintf(stderr, "cooperative launch failed: %s (grid %d)\n", hipGetErrorString(e), grid_blocks);
}
```

```cpp
#include <hip/hip_runtime.h>
#include <hip/hip_cooperative_groups.h>
#include <cstdio>
#include <cmath>
namespace cg = cooperative_groups;

typedef unsigned short u16;
typedef short bf16x8 __attribute__((ext_vector_type(8)));
typedef float f32x4 __attribute__((ext_vector_type(4)));
typedef unsigned u32x4 __attribute__((ext_vector_type(4)));
typedef unsigned u32x2 __attribute__((ext_vector_type(2)));
typedef _Float16 f16x4 __attribute__((ext_vector_type(4)));
#define DI __device__ __forceinline__
DI int opaque_tid_(int wave_s) { int t; asm volatile("v_mbcnt_lo_u32_b32 %0, -1, 0\n\tv_mbcnt_hi_u32_b32 %0, -1, %0" : "=v"(t)); return t + (wave_s << 6); }
#define opaque_tid() opaque_tid_(wvs)

constexpr int T_TOK = 32768, SEQ = 8192, DM = 1024, NC = 5384, NCP = 5376;
constexpr int C_DNZ = 1536, C_SWQ = 2056, C_SWK = 2568, C_SWV = 2696, C_SWZ = 2824, C_GA = 3336, C_GB = 4360;
constexpr size_t OFF_BAR = 0;
constexpr size_t BAR_BYTES = 16384;
constexpr size_t OFF_WINT = BAR_BYTES;
constexpr size_t OFF_WAT = OFF_WINT + (size_t)NCP * 1024 * 2;
constexpr size_t OFF_WBT = OFF_WAT + 1024 * 512 * 2;
constexpr size_t OFF_WOT = OFF_WBT + 1024 * 512 * 2;
constexpr size_t OFF_ROPE = OFF_WOT + 1024 * 1024 * 2;
constexpr size_t OFF_HB = OFF_ROPE + 2 * 8192 * 8 * 4;
constexpr size_t OFF_DEC = OFF_HB + (size_t)T_TOK * 8 * 4;
constexpr size_t OFF_H = OFF_DEC + 2048 * 4;
constexpr size_t OFF_SC = OFF_H + (size_t)T_TOK * NC * 2;
constexpr size_t OPB = 73728;
constexpr size_t OFF_SSQ = OFF_SC + 2048 * OPB;
constexpr size_t WS_NEED = OFF_SSQ + (size_t)T_TOK * 32 * 4;
constexpr int HALF_SMEM = 73728;
constexpr int SMEM_BYTES = 2 * HALF_SMEM + 16;

struct Params {
  const float *x, *w_in, *conv_w, *a_log, *dt_bias, *dn_norm_w, *sinks, *w_branch, *w_out, *ln_g, *ln_b;
  float* out; unsigned char* ws;
  float inv_freq[8];
};

typedef __bf16 bf16x2_t __attribute__((ext_vector_type(2)));
typedef float f32x2_t __attribute__((ext_vector_type(2)));
DI unsigned pk_bf16(float lo, float hi) { f32x2_t f = {lo, hi}; bf16x2_t v = __builtin_convertvector(f, bf16x2_t); return __builtin_bit_cast(unsigned, v); }
DI float bf_lo(unsigned u) { return __uint_as_float(u << 16); }
DI float bf_hi(unsigned u) { return __uint_as_float(u & 0xffff0000u); }
DI float bf2f(u16 v) { return __uint_as_float(((unsigned)v) << 16); }
DI u16 f2bf(float f) { return (u16)(pk_bf16(f, f) & 0xffffu); }
DI float shx(float v, int m, int lane) { return __uint_as_float((unsigned)__builtin_amdgcn_ds_bpermute((lane ^ m) << 2, (int)__float_as_uint(v))); }
DI float rcp_f(float y) { return __builtin_amdgcn_rcpf(y); }
template <int CTRL> DI float dpp_mov(float v) { return __builtin_bit_cast(float, __builtin_amdgcn_update_dpp(0, __builtin_bit_cast(int, v), CTRL, 0xf, 0xf, true)); }
DI float row16_sum(float v) {
  v += dpp_mov<0xB1>(v);
  v += dpp_mov<0x4E>(v);
  v += dpp_mov<0x141>(v);
  v += dpp_mov<0x140>(v);
  return v;
}
DI float silu_f(float y) { return y * rcp_f(1.0f + __expf(-y)); }
DI float sigmoid_f(float y) { return rcp_f(1.0f + __expf(-y)); }
DI f32x4 mfma16(bf16x8 a, bf16x8 b, f32x4 c) { return __builtin_amdgcn_mfma_f32_16x16x32_bf16(a, b, c, 0, 0, 0); }
DI bf16x8 as_bf8(u32x4 v) { return __builtin_bit_cast(bf16x8, v); }
DI bf16x8 pack8(f32x4 a, f32x4 b) { u32x4 w; w.x = pk_bf16(a[0], a[1]); w.y = pk_bf16(a[2], a[3]); w.z = pk_bf16(b[0], b[1]); w.w = pk_bf16(b[2], b[3]); return as_bf8(w); }

DI void phase0(const Params& p, int wvs) {
  const size_t gt = (size_t)blockIdx.x * 512 + opaque_tid(), gs = (size_t)gridDim.x * 512;
  {
    const int ltid = (int)(gt & 511), lane = ltid & 63, wv = ltid >> 6;
    float wr[16][8];
#pragma unroll
    for (int j = 0; j < 4; ++j)
#pragma unroll
      for (int c = 0; c < 4; ++c) {
        const float* wp = p.w_in + (size_t)(4 * (lane + 64 * j) + c) * NC + 2048;
        const f32x4 a = *(const f32x4*)wp, b = *(const f32x4*)(wp + 4);
#pragma unroll
        for (int q = 0; q < 4; ++q) { wr[4 * j + c][q] = a[q]; wr[4 * j + c][4 + q] = b[q]; }
      }
    u16* xb = (u16*)(p.ws + OFF_SC);
    float* hb = (float*)(p.ws + OFF_HB);
    const int rstep = gridDim.x * 8;
    for (int row0 = blockIdx.x * 8 + wv; row0 < T_TOK; row0 += 2 * rstep) {
      f32x4 xr[2][4];
#pragma unroll
      for (int u = 0; u < 2; ++u) {
        const int row = row0 + u * rstep;
#pragma unroll
        for (int j = 0; j < 4; ++j) xr[u][j] = (row < T_TOK) ? *(const f32x4*)(p.x + (size_t)row * DM + 4 * (lane + 64 * j)) : (f32x4){0.f, 0.f, 0.f, 0.f};
      }
#pragma unroll
      for (int u = 0; u < 2; ++u) {
        const int row = row0 + u * rstep;
        float v[8];
#pragma unroll
        for (int q = 0; q < 8; ++q) v[q] = 0.f;
#pragma unroll
        for (int j = 0; j < 4; ++j) {
          const f32x4 xv = xr[u][j];
          u32x2 w; w.x = pk_bf16(xv[0], xv[1]); w.y = pk_bf16(xv[2], xv[3]);
          if (row < T_TOK) *(u32x2*)(xb + (size_t)row * DM + 4 * (lane + 64 * j)) = w;
#pragma unroll
          for (int c = 0; c < 4; ++c)
#pragma unroll
            for (int q = 0; q < 8; ++q) v[q] += xv[c] * wr[4 * j + c][q];
        }
        const bool up = (lane & 32) != 0;
        float k4[4];
#pragma unroll
        for (int i = 0; i < 4; ++i) { const float snd = up ? v[i] : v[i + 4]; const float kp = up ? v[i + 4] : v[i]; k4[i] = kp + shx(snd, 32, lane); }
        const bool up2 = (lane & 16) != 0;
        float k2[2];
#pragma unroll
        for (int i = 0; i < 2; ++i) { const float snd = up2 ? k4[i] : k4[i + 2]; const float kp = up2 ? k4[i + 2] : k4[i]; k2[i] = kp + shx(snd, 16, lane); }
        const bool up3 = (lane & 8) != 0;
        float k1 = (up3 ? k2[1] : k2[0]) + shx(up3 ? k2[0] : k2[1], 8, lane);
        k1 += shx(k1, 4, lane); k1 += shx(k1, 2, lane); k1 += shx(k1, 1, lane);
        if ((lane & 7) == 0 && row < T_TOK) hb[(size_t)row * 8 + (lane >> 3)] = k1;
      }
    }
  }
  {
    u32x4* wt = (u32x4*)(p.ws + OFF_WINT);
    for (size_t i = gt; i < (size_t)NCP * 128; i += gs) {
      const int kc = (int)(i / NCP), n = (int)(i % NCP);
      float v[8];
#pragma unroll
      for (int j = 0; j < 8; ++j) v[j] = p.w_in[(size_t)(kc * 8 + j) * NC + n + (n >= 2048 ? 8 : 0)];
      u32x4 w; w.x = pk_bf16(v[0], v[1]); w.y = pk_bf16(v[2], v[3]); w.z = pk_bf16(v[4], v[5]); w.w = pk_bf16(v[6], v[7]);
      wt[(size_t)n * 128 + kc] = w;
    }
  }
  {
    for (size_t i = gt; i < (size_t)2 * 1024 * 64; i += gs) {
      const int br = (int)(i / (1024 * 64)), rem = (int)(i % (1024 * 64)), kc = rem / 1024, n = rem % 1024;
      const float* src = p.w_branch + (size_t)br * 512 * 1024;
      float v[8];
#pragma unroll
      for (int j = 0; j < 8; ++j) v[j] = src[(size_t)(kc * 8 + j) * 1024 + n];
      u32x4 w; w.x = pk_bf16(v[0], v[1]); w.y = pk_bf16(v[2], v[3]); w.z = pk_bf16(v[4], v[5]); w.w = pk_bf16(v[6], v[7]);
      ((u32x4*)(p.ws + (br ? OFF_WBT : OFF_WAT)))[(size_t)n * 64 + kc] = w;
    }
  }
  {
    for (size_t i = gt; i < (size_t)1024 * 128; i += gs) {
      const int kc = (int)(i / 1024), n = (int)(i % 1024);
      float v[8];
#pragma unroll
      for (int j = 0; j < 8; ++j) v[j] = p.w_out[(size_t)(kc * 8 + j) * 1024 + n];
      u32x4 w; w.x = pk_bf16(v[0], v[1]); w.y = pk_bf16(v[2], v[3]); w.z = pk_bf16(v[4], v[5]); w.w = pk_bf16(v[6], v[7]);
      ((u32x4*)(p.ws + OFF_WOT))[(size_t)n * 128 + kc] = w;
    }
  }
  {
    float* rc = (float*)(p.ws + OFF_ROPE); float* rs = rc + 8192 * 8;
    for (size_t i = gt; i < 8192 * 8; i += gs) {
      const int t = (int)(i >> 3), f = (int)(i & 7);
      const float ang = (float)t * p.inv_freq[f];
      const double a = (double)ang;
      const double k = __builtin_rint(a * 0.15915494309189535);
      const float r = (float)(a - k * 6.283185307179586);
      rc[i] = cosf(r); rs[i] = sinf(r);
    }
  }
}

template <int I> DI void solve_rows2(f32x2_t (&xv)[64], const float* Lm, int lane, float lcur) {
  if constexpr (I < 64) {
    float lnx = 0.f;
    if constexpr (I + 1 < 64) lnx = Lm[(I + 1) * 68 + lane];
    f32x2_t a0 = xv[I], a1 = {0.f, 0.f}, a2 = {0.f, 0.f}, a3 = {0.f, 0.f};
#pragma unroll
    for (int m = 0; m < I; ++m) {
      const float l = __builtin_bit_cast(float, __builtin_amdgcn_readlane(__builtin_bit_cast(int, lcur), m));
      const f32x2_t lv = {l, l};
      if ((m & 3) == 0) a0 -= lv * xv[m];
      else if ((m & 3) == 1) a1 -= lv * xv[m];
      else if ((m & 3) == 2) a2 -= lv * xv[m];
      else a3 -= lv * xv[m];
    }
    xv[I] = (a0 + a1) + (a2 + a3);
    solve_rows2<I + 1>(xv, Lm, lane, lnx);
  }
}

DI void prep_item(const Params& p, int wvs, int item, unsigned char* smem) {
  const int tid_ = opaque_tid();
  const int tid = tid_, lane = tid & 63, wv = tid >> 6, r16 = lane & 15, g = lane >> 4;
  const int hd = item & 3, n = (item >> 2) & 127, b = item >> 9;
  const int t0 = b * SEQ + n * 64;
  u16* Qs = (u16*)smem; u16* Ks = Qs + 64 * 136; u16* Vs = Ks + 64 * 136;
  float* Lm = (float*)(smem + 52224);
  float* sm_beta = (float*)(smem + 69632);
  float* sm_gc = sm_beta + 64; float* sm_rq = sm_gc + 64; float* sm_rk = sm_rq + 64;
  float* sm_fw = sm_rk + 64; float* sm_fq = sm_fw + 64; float* sm_fk = sm_fq + 64;
  const u16* h = (const u16*)(p.ws + OFF_H);
  const float* hb = (const float*)(p.ws + OFF_HB);
  unsigned char* op = p.ws + OFF_SC + (size_t)item * OPB;
  __syncthreads();
  float hb_bl, hb_al;
  {
    const int c2 = tid & 63, rbase = (tid >> 6) * 16;
    unsigned raw[3][19];
#pragma unroll
    for (int mat = 0; mat < 3; ++mat) {
      const int col = mat * 512 + hd * 128 + 2 * c2;
#pragma unroll
      for (int j = 0; j < 19; ++j) {
        const int rr = t0 + rbase - 3 + j;
        raw[mat][j] = *(const unsigned*)(h + (size_t)(rr < 0 ? 0 : rr) * NC + col);
      }
    }
    float2 cw[3][4];
#pragma unroll
    for (int mat = 0; mat < 3; ++mat)
#pragma unroll
      for (int j = 0; j < 4; ++j) cw[mat][j] = *(const float2*)(p.conv_w + j * 1536 + mat * 512 + hd * 128 + 2 * c2);
    hb_bl = hb[(size_t)(t0 + lane) * 8 + hd]; hb_al = hb[(size_t)(t0 + lane) * 8 + 4 + hd];
    __builtin_amdgcn_sched_barrier(0);
#pragma unroll
    for (int mat = 0; mat < 3; ++mat) {
      float wa[4], wb[4];
#pragma unroll
      for (int j = 0; j < 4; ++j) { wa[j] = cw[mat][j].x; wb[j] = cw[mat][j].y; }
      float xa[3], xb[3];
#pragma unroll
      for (int j = 0; j < 3; ++j) {
        const int pos = n * 64 + rbase - 3 + j;
        const unsigned v = (pos >= 0) ? raw[mat][j] : 0u;
        xa[j] = bf_lo(v); xb[j] = bf_hi(v);
      }
      u16* dst = (mat == 0 ? Qs : (mat == 1 ? Ks : Vs));
#pragma unroll
      for (int i = 0; i < 16; ++i) {
        const unsigned v = raw[mat][3 + i];
        const float a3 = bf_lo(v), b3 = bf_hi(v);
        const float ya = wa[0] * xa[0] + wa[1] * xa[1] + wa[2] * xa[2] + wa[3] * a3;
        const float yb = wb[0] * xb[0] + wb[1] * xb[1] + wb[2] * xb[2] + wb[3] * b3;
        xa[0] = xa[1]; xa[1] = xa[2]; xa[2] = a3; xb[0] = xb[1]; xb[1] = xb[2]; xb[2] = b3;
        *(unsigned*)(dst + (rbase + i) * 136 + 2 * c2) = pk_bf16(silu_f(ya), silu_f(yb));
      }
    }
  }
  __syncthreads();
  if (wv == 0) {
    const float bl = hb_bl, al = hb_al;
    const float xx = al + p.dt_bias[hd];
    const float ee = __expf(-fabsf(xx));
    const float sp = fmaxf(xx, 0.f) + ((ee < 1e-3f) ? ee * (1.f - 0.5f * ee) : __logf(1.f + ee));
    float gg = -__expf(p.a_log[hd]) * sp;
#pragma unroll
    for (int o = 1; o < 64; o <<= 1) { const float t = __uint_as_float((unsigned)__builtin_amdgcn_ds_bpermute(((lane - o) & 63) << 2, (int)__float_as_uint(gg))); if (lane >= o) gg += t; }
    sm_beta[lane] = rcp_f(1.0f + __expf(-bl)); sm_gc[lane] = gg;
  } else if (wv <= 2) {
    const int r = tid - 64;
    const u16* src = (r < 64) ? (Qs + r * 136) : (Ks + (r - 64) * 136);
    float ss = 0.f;
#pragma unroll
    for (int c = 0; c < 16; ++c) {
      const u32x4 v = *(const u32x4*)(src + c * 8);
#pragma unroll
      for (int j = 0; j < 4; ++j) { const float a = bf_lo(v[j]), bb = bf_hi(v[j]); ss += a * a + bb * bb; }
    }
    const float rs = rsqrtf(ss + 1e-6f);
    if (r < 64) sm_rq[r] = rs; else sm_rk[r - 64] = rs;
  }
  __syncthreads();
  if (tid < 64) {
    const float gc = sm_gc[tid], gl = sm_gc[63], eg = __expf(gc);
    sm_fw[tid] = sm_beta[tid] * eg * sm_rk[tid];
    sm_fq[tid] = sm_rq[tid] * 0.08838834764831845f * eg;
    sm_fk[tid] = sm_rk[tid] * __expf(gl - gc);
    if (tid == 0) ((float*)(p.ws + OFF_DEC))[item] = __expf(gl);
  }
  {
    bf16x8 kfi[4], qfi[4];
#pragma unroll
    for (int s = 0; s < 4; ++s) {
      kfi[s] = *(const bf16x8*)(Ks + (16 * wv + r16) * 136 + 32 * s + 8 * g);
      qfi[s] = *(const bf16x8*)(Qs + (16 * wv + r16) * 136 + 32 * s + 8 * g);
    }
    f32x4 at[4];
#pragma unroll
    for (int jt = 0; jt < 4; ++jt) {
      at[jt] = (f32x4){0.f, 0.f, 0.f, 0.f};
      if (jt <= wv) {
        f32x4 la = (f32x4){0.f, 0.f, 0.f, 0.f}, aa = (f32x4){0.f, 0.f, 0.f, 0.f};
#pragma unroll
        for (int s = 0; s < 4; ++s) {
          const bf16x8 kfj = *(const bf16x8*)(Ks + (16 * jt + r16) * 136 + 32 * s + 8 * g);
          la = mfma16(kfi[s], kfj, la);
          aa = mfma16(kfj, qfi[s], aa);
        }
#pragma unroll
        for (int r = 0; r < 4; ++r) {
          { const int i = 16 * wv + 4 * g + r, j = 16 * jt + r16;
            const float v = (i > j) ? sm_beta[i] * sm_rk[i] * sm_rk[j] * __expf(sm_gc[i] - sm_gc[j]) * la[r] : 0.f;
            Lm[i * 68 + j] = v; }
          { const int j = 16 * jt + 4 * g + r, i = 16 * wv + r16;
            at[jt][r] = (j <= i) ? sm_rq[i] * sm_rk[j] * 0.08838834764831845f * __expf(sm_gc[i] - sm_gc[j]) * aa[r] : 0.f; }
        }
      }
    }
#pragma unroll
    for (int s2 = 0; s2 < 2; ++s2)
      *(bf16x8*)(op + 32768 + (size_t)((wv * 2 + s2) * 64 + lane) * 16) = pack8(at[2 * s2], at[2 * s2 + 1]);
  }
  __syncthreads();
  f32x2_t xv[64];
  if (wv < 2) {
#pragma unroll
    for (int i = 0; i < 64; ++i) { xv[i].x = sm_beta[i] * bf2f(Vs[i * 136 + tid]); xv[i].y = sm_fw[i] * bf2f(Ks[i * 136 + tid]); }
    solve_rows2<1>(xv, Lm, lane, Lm[68 + lane]);
    const int sl = tid >> 4, dvl = tid & 15;
#pragma unroll
    for (int mt = 0; mt < 4; ++mt)
#pragma unroll
      for (int gg = 0; gg < 4; ++gg) {
        u32x2 w; w.x = pk_bf16(xv[16 * mt + 4 * gg].x, xv[16 * mt + 4 * gg + 1].x); w.y = pk_bf16(xv[16 * mt + 4 * gg + 2].x, xv[16 * mt + 4 * gg + 3].x);
        *(u32x2*)(op + 57344 + (size_t)((sl * 4 + mt) * 64 + gg * 16 + dvl) * 8) = w;
      }
  } else {
    const int t2 = tid - 128;
#pragma unroll 2
    for (int f = 0; f < 8; ++f) {
      const int e = t2 + 128 * f, frag = e >> 6, ln = e & 63, lr = ln & 15, lg = ln >> 4;
      {
        const int mt = frag >> 2, sx = frag & 3, row = 16 * mt + lr;
        const u32x2 ql = *(const u32x2*)(Qs + row * 136 + 32 * sx + 4 * lg), qh = *(const u32x2*)(Qs + row * 136 + 32 * sx + 16 + 4 * lg);
        const float fq = sm_fq[row];
        u32x4 w;
        w.x = pk_bf16(bf_lo(ql.x) * fq, bf_hi(ql.x) * fq); w.y = pk_bf16(bf_lo(ql.y) * fq, bf_hi(ql.y) * fq);
        w.z = pk_bf16(bf_lo(qh.x) * fq, bf_hi(qh.x) * fq); w.w = pk_bf16(bf_lo(qh.y) * fq, bf_hi(qh.y) * fq);
        *(u32x4*)(op + 16384 + (size_t)e * 16) = w;
      }
      {
        const int mt8 = frag >> 1, s2 = frag & 1, dk = 16 * mt8 + lr;
        float v[8];
#pragma unroll
        for (int j = 0; j < 8; ++j) {
          const int pos = 32 * s2 + 16 * (j >> 2) + 4 * lg + (j & 3);
          v[j] = bf2f(Ks[pos * 136 + dk]) * sm_fk[pos];
        }
        u32x4 w; w.x = pk_bf16(v[0], v[1]); w.y = pk_bf16(v[2], v[3]); w.z = pk_bf16(v[4], v[5]); w.w = pk_bf16(v[6], v[7]);
        *(u32x4*)(op + 40960 + (size_t)e * 16) = w;
      }
    }
  }
  __syncthreads();
  if (wv < 2) {
#pragma unroll
    for (int i = 0; i < 64; ++i) Vs[i * 136 + tid] = f2bf(-xv[i].y);
  }
  __syncthreads();
#pragma unroll
  for (int f = 0; f < 4; ++f) {
    const int e = tid + 256 * f, frag = e >> 6, ln = e & 63, lr = ln & 15, lg = ln >> 4;
    const int mt = frag >> 2, sx = frag & 3, row = 16 * mt + lr;
    const u32x2 lo = *(const u32x2*)(Vs + row * 136 + 32 * sx + 4 * lg), hi = *(const u32x2*)(Vs + row * 136 + 32 * sx + 16 + 4 * lg);
    *(u32x4*)(op + (size_t)e * 16) = (u32x4){lo.x, lo.y, hi.x, hi.y};
  }
}

struct ScanA { u32x4 wf[4]; };
struct ScanB { u32x4 qf[4], af[2], kf[4]; };

DI void scan_load_a(const Params& p, int wvs, ScanA& o, int b, int hd, int sl, int n, int q, int lane) {
  const int item = (b * 128 + n) * 4 + hd;
  const unsigned char* op = p.ws + OFF_SC + (size_t)item * OPB;
#pragma unroll
  for (int s = 0; s < 4; ++s) {
    o.wf[s] = *(const u32x4*)(op + (size_t)((q * 4 + s) * 64 + lane) * 16);
  }
}
DI void scan_load_b(const Params& p, int wvs, ScanB& o, int b, int hd, int sl, int n, int q, int lane) {
  const int item = (b * 128 + n) * 4 + hd;

  const unsigned char* op = p.ws + OFF_SC + (size_t)item * OPB;
#pragma unroll
  for (int s = 0; s < 4; ++s) o.qf[s] = *(const u32x4*)(op + 16384 + (size_t)((q * 4 + s) * 64 + lane) * 16);
#pragma unroll
  for (int s2 = 0; s2 < 2; ++s2) o.af[s2] = *(const u32x4*)(op + 32768 + (size_t)((q * 2 + s2) * 64 + lane) * 16);
#pragma unroll
  for (int j = 0; j < 4; ++j) o.kf[j] = *(const u32x4*)(op + 40960 + (size_t)((q * 4 + j) * 64 + lane) * 16);
}

DI void scan_step(const Params& p, int wvs, const ScanA& o, const ScanB& ob, f32x4 (&S)[2], int b, int hd, int sl, int n, int q, int lane, unsigned char* smem) {
  const int r16 = lane & 15, g = lane >> 4;
  u32x4* ldsS = (u32x4*)smem;
  u32x2* ldsV = (u32x2*)(smem + 4096);
  ldsS[q * 64 + lane] = __builtin_bit_cast(u32x4, pack8(S[0], S[1]));
  __syncthreads();
  bf16x8 Sb[4];
#pragma unroll
  for (int s = 0; s < 4; ++s) Sb[s] = as_bf8(ldsS[s * 64 + lane]);
  const unsigned char* ring = smem + 8192 + (n % 3) * 6400;
  const u32x2 uf = *(const u32x2*)(ring + 4096 + (q * 64 + lane) * 8);
  f32x4 vn = (f32x4){bf_lo(uf.x), bf_hi(uf.x), bf_lo(uf.y), bf_hi(uf.y)};
#pragma unroll
  for (int s = 0; s < 4; ++s) vn = mfma16(as_bf8(o.wf[s]), Sb[s], vn);
  { u32x2 w; w.x = pk_bf16(vn[0], vn[1]); w.y = pk_bf16(vn[2], vn[3]); ldsV[((q >> 1) * 64 + lane) * 2 + (q & 1)] = w; }
  f32x4 oa = (f32x4){0.f, 0.f, 0.f, 0.f};
#pragma unroll
  for (int s = 0; s < 4; ++s) oa = mfma16(as_bf8(ob.qf[s]), Sb[s], oa);
  __syncthreads();
  bf16x8 Vb[2];
#pragma unroll
  for (int s2 = 0; s2 < 2; ++s2) Vb[s2] = as_bf8(*(const u32x4*)(ldsV + (s2 * 64 + lane) * 2));
#pragma unroll
  for (int s2 = 0; s2 < 2; ++s2) oa = mfma16(as_bf8(ob.af[s2]), Vb[s2], oa);
  u16* h = (u16*)(p.ws + OFF_H);
  const int t0 = b * SEQ + n * 64;
  *(f32x4*)(smem + 8192 + (n % 3) * 6400 + (q * 64 + lane) * 16) = oa;
  const float dec_ = *(const float*)(ring + 6144);
#pragma unroll
  for (int t = 0; t < 2; ++t) {
    S[t] = S[t] * dec_;
#pragma unroll
    for (int s2 = 0; s2 < 2; ++s2) S[t] = mfma16(as_bf8(ob.kf[t * 2 + s2]), Vb[s2], S[t]);
  }
}

DI void scan_chain(const Params& p, int wvs, int pair, int sl, unsigned char* smem) {
  const int tid0 = opaque_tid(); const int lane = tid0 & 63, q = tid0 >> 6;
  const int b = pair >> 2, hd = pair & 3;
  f32x4 S[2]; S[0] = (f32x4){0.f, 0.f, 0.f, 0.f}; S[1] = S[0];
  ScanA a0, a1, a2; ScanB bc, bn;
  __builtin_amdgcn_s_setprio(3);
  __syncthreads();
  scan_load_a(p, wvs, a0, b, hd, sl, 0, q, lane);
  scan_load_b(p, wvs, bc, b, hd, sl, 0, q, lane);
  scan_load_a(p, wvs, a1, b, hd, sl, 1, q, lane);
#pragma unroll 1
  for (int n = 0; n < 129; n += 3) {
    if (n + 2 < 128) scan_load_a(p, wvs, a2, b, hd, sl, n + 2, q, lane);
    if (n + 1 < 128) scan_load_b(p, wvs, bn, b, hd, sl, n + 1, q, lane);
    if (n < 128) scan_step(p, wvs, a0, bc, S, b, hd, sl, n, q, lane, smem);
    bc = bn;
    if (n + 3 < 128) scan_load_a(p, wvs, a0, b, hd, sl, n + 3, q, lane);
    if (n + 2 < 128) scan_load_b(p, wvs, bn, b, hd, sl, n + 2, q, lane);
    if (n + 1 < 128) scan_step(p, wvs, a1, bc, S, b, hd, sl, n + 1, q, lane, smem);
    bc = bn;
    if (n + 4 < 128) scan_load_a(p, wvs, a1, b, hd, sl, n + 4, q, lane);
    if (n + 3 < 128) scan_load_b(p, wvs, bn, b, hd, sl, n + 3, q, lane);
    if (n + 2 < 128) scan_step(p, wvs, a2, bc, S, b, hd, sl, n + 2, q, lane, smem);
    bc = bn;
  }
  __syncthreads();
  __builtin_amdgcn_s_setprio(0);
}

DI void swa_item(const Params& p, int wvs, int item, bool valid, unsigned char* smem) {
  if (!valid) { __syncthreads(); __syncthreads(); return; }
  const int tid_ = opaque_tid();
  const int tid = tid_, lane = tid & 63, wv = tid >> 6, r16 = lane & 15, g = lane >> 4;
  const int qt = item & 127, kvh = (item >> 7) & 1, b = item >> 8;
  const int kp0 = 64 * qt - 128;
  u16* Ksm = (u16*)smem;
  u16* Vt = (u16*)(smem + 27648);
  u16* h = (u16*)(p.ws + OFF_H);
  const float* rc = (const float*)(p.ws + OFF_ROPE); const float* rs = rc + 8192 * 8;
  __syncthreads();
  if (tid < 192) {
    const int kk = tid, pos = kp0 + kk;
    u32x4 lo = (u32x4){0, 0, 0, 0}, hi = lo;
    if (pos >= 0) {
      const u16* src = h + (size_t)(b * SEQ + pos) * NC + C_SWK + kvh * 64;
      const u32x4 a = *(const u32x4*)src, c = *(const u32x4*)(src + 8);
      const f32x4 c0 = *(const f32x4*)(rc + pos * 8), c1 = *(const f32x4*)(rc + pos * 8 + 4);
      const f32x4 s0 = *(const f32x4*)(rs + pos * 8), s1 = *(const f32x4*)(rs + pos * 8 + 4);
      float t1[8], t2[8], cs[8], sn[8], o1[8], o2[8];
#pragma unroll
      for (int j = 0; j < 4; ++j) { t1[2 * j] = bf_lo(a[j]); t1[2 * j + 1] = bf_hi(a[j]); t2[2 * j] = bf_lo(c[j]); t2[2 * j + 1] = bf_hi(c[j]);
        cs[j] = c0[j]; cs[4 + j] = c1[j]; sn[j] = s0[j]; sn[4 + j] = s1[j]; }
#pragma unroll
      for (int j = 0; j < 8; ++j) { o1[j] = t1[j] * cs[j] - t2[j] * sn[j]; o2[j] = t2[j] * cs[j] + t1[j] * sn[j]; }
#pragma unroll
      for (int j = 0; j < 4; ++j) { lo[j] = pk_bf16(o1[2 * j], o1[2 * j + 1]); hi[j] = pk_bf16(o2[2 * j], o2[2 * j + 1]); }
    }
    *(u32x4*)(Ksm + kk * 72) = lo; *(u32x4*)(Ksm + kk * 72 + 8) = hi;
  }
  for (int e = tid; e < 192 * 6; e += 256) {
    const int kk = e / 6, ch = 2 + e % 6, pos = kp0 + kk;
    u32x4 v = (u32x4){0, 0, 0, 0};
    if (pos >= 0) v = *(const u32x4*)(h + (size_t)(b * SEQ + pos) * NC + C_SWK + kvh * 64 + ch * 8);
    *(u32x4*)(Ksm + kk * 72 + ch * 8) = v;
  }
  for (int e = tid; e < 192 * 8; e += 256) {
    const int kk = e >> 3, ch = e & 7, pos = kp0 + kk;
    u32x4 v = (u32x4){0, 0, 0, 0};
    if (pos >= 0) v = *(const u32x4*)(h + (size_t)(b * SEQ + pos) * NC + C_SWV + kvh * 64 + ch * 8);
#pragma unroll
    for (int j = 0; j < 4; ++j) { Vt[(ch * 8 + 2 * j) * 200 + kk] = (u16)(v[j] & 0xffffu); Vt[(ch * 8 + 2 * j + 1) * 200 + kk] = (u16)(v[j] >> 16); }
  }
  __syncthreads();
  const int st = wv, jt0 = st < 2 ? st : 2;
  const int qi = 16 * st + r16;
  const int qpos = 64 * qt + qi, tq = b * SEQ + qpos;
#pragma unroll 1
  for (int hq = 0; hq < 4; ++hq) {
    const int head = kvh * 4 + hq;
    u16* qsrc = h + (size_t)tq * NC + C_SWQ + head * 64;
    bf16x8 qf[2];
    {
      const u32x4 a = *(const u32x4*)qsrc, c = *(const u32x4*)(qsrc + 8);
      u32x4 w = *(const u32x4*)(qsrc + 8 * g);
      if (g < 2) {
        const f32x4 c0 = *(const f32x4*)(rc + qpos * 8), c1 = *(const f32x4*)(rc + qpos * 8 + 4);
        const f32x4 s0 = *(const f32x4*)(rs + qpos * 8), s1 = *(const f32x4*)(rs + qpos * 8 + 4);
        float t1[8], t2[8], cs[8], sn[8], o[8];
#pragma unroll
        for (int j = 0; j < 4; ++j) { t1[2 * j] = bf_lo(a[j]); t1[2 * j + 1] = bf_hi(a[j]); t2[2 * j] = bf_lo(c[j]); t2[2 * j + 1] = bf_hi(c[j]);
          cs[j] = c0[j]; cs[4 + j] = c1[j]; sn[j] = s0[j]; sn[4 + j] = s1[j]; }
#pragma unroll
        for (int j = 0; j < 8; ++j) o[j] = (g == 0) ? (t1[j] * cs[j] - t2[j] * sn[j]) : (t2[j] * cs[j] + t1[j] * sn[j]);
#pragma unroll
        for (int j = 0; j < 4; ++j) w[j] = pk_bf16(o[2 * j], o[2 * j + 1]);
      }
      qf[0] = as_bf8(w);
      qf[1] = as_bf8(*(const u32x4*)(qsrc + 32 + 8 * g));
    }
    f32x4 sc[10];
#pragma unroll
    for (int t = 0; t < 10; ++t) {
      sc[t] = (f32x4){0.f, 0.f, 0.f, 0.f};
#pragma unroll
      for (int s = 0; s < 2; ++s) {
        const bf16x8 kf = *(const bf16x8*)(Ksm + (16 * (jt0 + t) + r16) * 72 + 32 * s + 8 * g);
        sc[t] = mfma16(kf, qf[s], sc[t]);
      }
    }
    const float sink = p.sinks[head];
    float mx = sink;
#pragma unroll
    for (int t = 0; t < 10; ++t)
#pragma unroll
      for (int r = 0; r < 4; ++r) {
        const int kk = 16 * (jt0 + t) + 4 * g + r, d = kk - qi;
        const bool ok = (d >= 1) && (d <= 128) && (kp0 + kk >= 0);
        const float v = ok ? sc[t][r] * 0.125f : -1e30f;
        sc[t][r] = v; mx = fmaxf(mx, v);
      }
    mx = fmaxf(mx, shx(mx, 16, lane)); mx = fmaxf(mx, shx(mx, 32, lane));
    float sum = 0.f;
#pragma unroll
    for (int t = 0; t < 10; ++t)
#pragma unroll
      for (int r = 0; r < 4; ++r) { const float e = __expf(sc[t][r] - mx); sc[t][r] = e; sum += e; }
    sum += shx(sum, 16, lane); sum += shx(sum, 32, lane);
    const float inv = rcp_f(sum + __expf(sink - mx));
    f32x4 oacc[4];
#pragma unroll
    for (int dt = 0; dt < 4; ++dt) oacc[dt] = (f32x4){0.f, 0.f, 0.f, 0.f};
#pragma unroll
    for (int s2 = 0; s2 < 5; ++s2) {
      const bf16x8 pb = pack8(sc[2 * s2], sc[2 * s2 + 1]);
#pragma unroll
      for (int dt = 0; dt < 4; ++dt) {
        const u16* vr = Vt + (16 * dt + r16) * 200 + 16 * (jt0 + 2 * s2) + 4 * g;
        const u32x2 lo = *(const u32x2*)vr, hi = *(const u32x2*)(vr + 16);
        oacc[dt] = mfma16(as_bf8((u32x4){lo.x, lo.y, hi.x, hi.y}), pb, oacc[dt]);
      }
    }
#pragma unroll
    for (int dt = 0; dt < 4; ++dt) {
      const int dcol = head * 64 + 16 * dt + 4 * g;
      const u32x2 z = *(const u32x2*)(h + (size_t)tq * NC + C_SWZ + dcol);
      u32x2 w;
      w.x = pk_bf16(oacc[dt][0] * inv * silu_f(bf_lo(z.x)), oacc[dt][1] * inv * silu_f(bf_hi(z.x)));
      w.y = pk_bf16(oacc[dt][2] * inv * silu_f(bf_lo(z.y)), oacc[dt][3] * inv * silu_f(bf_hi(z.y)));
      *(u32x2*)(h + (size_t)tq * NC + C_SWQ + dcol) = w;
    }
  }
}

DI void phase_ya(const Params& p, int wvs) {
  u16* h = (u16*)(p.ws + OFF_H);
  const int ltid = opaque_tid(), lane = ltid & 63;
  const size_t gt = (size_t)blockIdx.x * 512 + ltid, gs = (size_t)gridDim.x * 512;
  const float* nwp = p.dn_norm_w + (ltid & 15) * 8;
  const f32x4 nw0 = *(const f32x4*)nwp, nw1 = *(const f32x4*)(nwp + 4);
  for (size_t i0 = gt; i0 < (size_t)T_TOK * 64; i0 += 4 * gs) {
    u32x4 v[4], z[4];
#pragma unroll
    for (int k = 0; k < 4; ++k) {
      const size_t i = i0 + k * gs;
      if (i < (size_t)T_TOK * 64) {
        const u16* ptr = h + (size_t)(i >> 6) * NC + (i & 63) * 8;
        v[k] = *(const u32x4*)ptr; z[k] = *(const u32x4*)(ptr + C_DNZ);
      } else { v[k] = (u32x4){0, 0, 0, 0}; z[k] = v[k]; }
    }
#pragma unroll
    for (int k = 0; k < 4; ++k) {
      const size_t i = i0 + k * gs;
      float o[8]; float ss = 0.f;
#pragma unroll
      for (int j = 0; j < 4; ++j) { o[2 * j] = bf_lo(v[k][j]); o[2 * j + 1] = bf_hi(v[k][j]); }
#pragma unroll
      for (int j = 0; j < 8; ++j) ss += o[j] * o[j];
      ss += shx(ss, 1, lane); ss += shx(ss, 2, lane); ss += shx(ss, 4, lane); ss += shx(ss, 8, lane);
      const float rs = rsqrtf(ss * (1.0f / 128.0f) + 1e-6f);
      float y[8];
#pragma unroll
      for (int j = 0; j < 4; ++j) {
        const float w0 = (j < 2) ? nw0[2 * j] : nw1[2 * j - 4], w1 = (j < 2) ? nw0[2 * j + 1] : nw1[2 * j - 3];
        y[2 * j] = o[2 * j] * rs * w0 * silu_f(bf_lo(z[k][j]));
        y[2 * j + 1] = o[2 * j + 1] * rs * w1 * silu_f(bf_hi(z[k][j]));
      }
      u32x4 w; w.x = pk_bf16(y[0], y[1]); w.y = pk_bf16(y[2], y[3]); w.z = pk_bf16(y[4], y[5]); w.w = pk_bf16(y[6], y[7]);
      if (i < (size_t)T_TOK * 64) *(u32x4*)(h + (size_t)(i >> 6) * NC + (i & 63) * 8) = w;
    }
  }
}

DI float wave_sum(float v, int lane) {
#pragma unroll
  for (int o = 32; o > 0; o >>= 1) v += shx(v, o, lane);
  return v;
}
DI void phase6(const Params& p, int wvs, unsigned char* smem) {
  const int tid = opaque_tid(), lane = tid & 63, wv = tid >> 6;
  f32x4 gm[4], bt[4];
#pragma unroll
  for (int j = 0; j < 4; ++j) { gm[j] = *(const f32x4*)(p.ln_g + 4 * (lane + 64 * j)); bt[j] = *(const f32x4*)(p.ln_b + 4 * (lane + 64 * j)); }
  const int xcd6 = blockIdx.x & 7, lb6 = blockIdx.x >> 3, nlb6 = gridDim.x >> 3;
  for (int lr = (lb6 * 8 + wv) * 2; lr < 4096; lr += nlb6 * 16) {
    const int row0 = 4096 * xcd6 + (4095 - lr), row1 = row0 - 1;
    float* r0 = p.out + (size_t)row0 * 1024;
    float* r1 = p.out + (size_t)row1 * 1024;
    const _Float16* s0 = (const _Float16*)(p.ws + OFF_H) + (size_t)row0 * 1024;
    const _Float16* s1 = (const _Float16*)(p.ws + OFF_H) + (size_t)row1 * 1024;
    f32x4 a[4], b[4];
#pragma unroll
    for (int j = 0; j < 4; ++j) {
      a[j] = __builtin_convertvector(*(const f16x4*)(s0 + 4 * (lane + 64 * j)), f32x4);
      b[j] = __builtin_convertvector(*(const f16x4*)(s1 + 4 * (lane + 64 * j)), f32x4);
    }
    float sa = 0.f, sb = 0.f;
#pragma unroll
    for (int j = 0; j < 4; ++j) { sa += (a[j][0] + a[j][1]) + (a[j][2] + a[j][3]); sb += (b[j][0] + b[j][1]) + (b[j][2] + b[j][3]); }
    const float ma = wave_sum(sa, lane) * (1.0f / 1024.0f), mb = wave_sum(sb, lane) * (1.0f / 1024.0f);
    float qa = 0.f, qb = 0.f;
#pragma unroll
    for (int j = 0; j < 4; ++j) {
      a[j] = a[j] - ma; b[j] = b[j] - mb;
      qa += (a[j][0] * a[j][0] + a[j][1] * a[j][1]) + (a[j][2] * a[j][2] + a[j][3] * a[j][3]);
      qb += (b[j][0] * b[j][0] + b[j][1] * b[j][1]) + (b[j][2] * b[j][2] + b[j][3] * b[j][3]);
    }
    const float ra = rsqrtf(wave_sum(qa, lane) * (1.0f / 1024.0f) + 1e-5f), rb = rsqrtf(wave_sum(qb, lane) * (1.0f / 1024.0f) + 1e-5f);
#pragma unroll
    for (int j = 0; j < 4; ++j) {
      *(f32x4*)(r0 + 4 * (lane + 64 * j)) = a[j] * ra * gm[j] + bt[j];
      *(f32x4*)(r1 + 4 * (lane + 64 * j)) = b[j] * rb * gm[j] + bt[j];
    }
  }
}

#define XB_TMO      128
#define XB_XCNT(j)  (256  + 64 * (j))
#define XB_XSUB(j)  (1280 + 64 * (j))
#define XB_XGEN(j)  (2304 + 64 * (j))
#define XB_TOP      3328
#define XB_TOPGEN   3392
#define XCD_BAR_WORDS 3456
#define XB_SPIN_CAP (1u << 22)
#define LAS __attribute__((address_space(3)))
DI unsigned xb_ld(unsigned* p) { return __hip_atomic_load(p, __ATOMIC_RELAXED, __HIP_MEMORY_SCOPE_AGENT); }
DI unsigned xb_add(unsigned* p, unsigned v) { return __hip_atomic_fetch_add(p, v, __ATOMIC_RELAXED, __HIP_MEMORY_SCOPE_AGENT); }
DI unsigned xb_xcc_id() { return (unsigned)__builtin_amdgcn_s_getreg((3 << 11) | 20) & 0xFu; }
#define XB_SPIN(cond, bar) do { unsigned _sp = 0; while (cond) { __builtin_amdgcn_s_sleep(1); \
    if ((++_sp & 255u) == 0u) { if (xb_ld(&(bar)[XB_TMO])) break; if (_sp > XB_SPIN_CAP) { atomicAdd(&(bar)[XB_TMO], 1u); break; } } } } while (0)
struct XcdBarrier { unsigned* bar; unsigned x; volatile LAS unsigned* st; };
DI bool xb_leader(int wvs) { return wvs == 0 && __builtin_amdgcn_mbcnt_hi(~0u, __builtin_amdgcn_mbcnt_lo(~0u, 0u)) == 0u; }
DI XcdBarrier xcd_barrier_post(unsigned* bar, volatile LAS unsigned* st, int wvs) {
  XcdBarrier b; b.bar = bar; b.x = xb_xcc_id(); b.st = st;
  if (xb_leader(wvs)) (void)xb_add(&bar[XB_XCNT(b.x)], 1u);
  return b;
}
DI void xcd_barrier_complete(unsigned* bar, unsigned x, unsigned& nloc, unsigned& nx) {
  const unsigned G = gridDim.x * gridDim.y * gridDim.z;
  unsigned sum, cnt, mine, sp = 0u;
  for (;;) {
    sum = 0u; cnt = 0u; mine = 0u;
#pragma unroll
    for (unsigned j = 0; j < 16; ++j) { const unsigned c = xb_ld(&bar[XB_XCNT(j)]); sum += c; cnt += (c > 0u) ? 1u : 0u; mine = (j == x) ? c : mine; }
    if (sum == G) break;
    __builtin_amdgcn_s_sleep(1);
    if ((++sp & 255u) == 0u) { if (xb_ld(&bar[XB_TMO])) break; if (sp > XB_SPIN_CAP) { atomicAdd(&bar[XB_TMO], 1u); break; } }
  }
  nloc = mine > 0u ? mine : 1u; nx = cnt > 0u ? cnt : 1u;
}
DI void xcd_barrier_(const XcdBarrier& b, int wvs) {
  asm volatile("s_waitcnt vmcnt(0)" ::: "memory");
  __syncthreads();
  if (xb_leader(wvs)) {
    unsigned* bar = b.bar;
    __builtin_amdgcn_s_waitcnt(0);
    unsigned nloc = b.st[0], nx = b.st[1];
    if (nloc == 0u) { xcd_barrier_complete(bar, b.x, nloc, nx); b.st[0] = nloc; b.st[1] = nx; }
    const unsigned old = xb_add(&bar[XB_XSUB(b.x)], 1u);
    const unsigned gen = old / nloc;
    if (old + 1u == (gen + 1u) * nloc) {
      __builtin_amdgcn_fence(__ATOMIC_RELEASE, "agent");
      asm volatile("s_waitcnt vmcnt(0)" ::: "memory");
      const unsigned og = xb_add(&bar[XB_TOP], 1u);
      const unsigned tg = og / nx;
      if (og + 1u == (tg + 1u) * nx) xb_add(&bar[XB_TOPGEN], 1u);
      else XB_SPIN(xb_ld(&bar[XB_TOPGEN]) == tg, bar);
      __builtin_amdgcn_fence(__ATOMIC_ACQUIRE, "agent");
      xb_add(&bar[XB_XGEN(b.x)], 1u);
      asm volatile("s_waitcnt vmcnt(0)" ::: "memory");
    } else {
      XB_SPIN(xb_ld(&bar[XB_XGEN(b.x)]) == gen, bar);
      __builtin_amdgcn_fence(__ATOMIC_ACQUIRE, "agent");
      asm volatile("s_waitcnt vmcnt(0)" ::: "memory");
    }
  }
  __syncthreads();
}

#define xcd_barrier(b) xcd_barrier_(b, w8)
namespace pg8 {
#define PG8_LAS __attribute__((address_space(3)))
typedef unsigned short bf16_t;
typedef short bf16x8 __attribute__((ext_vector_type(8)));
typedef float f32x4 __attribute__((ext_vector_type(4)));
typedef unsigned u32x4 __attribute__((ext_vector_type(4)));
constexpr int BM = 256, BK = 64, HALF = 128, HTB = HALF * BK * 2  , STAGE_BYTES = 8 * HTB, NXCD = 8, WGM = 8;

__host__ __device__ __forceinline__ int lds_byte(int r, int c) { const int st = (r >> 4) * 2 + (c >> 5), rr = r & 15, cc = c & 31, ob = rr * 64 + cc * 2; return st * 1024 + (ob ^ (((ob >> 9) & 1) << 5)); }
__host__ __device__ __forceinline__ void stage_rc(int b, int& R, int& C) { const int st = b / 1024, sb = b % 1024, swz = sb ^ (((sb >> 9) & 1) << 5); R = (st >> 1) * 16 + swz / 64; C = (st & 1) * 32 + (swz % 64) / 2; }
__host__ __device__ __forceinline__ int perm32(int rho) { const int n = rho >> 4, i = rho & 15; return 8 * (i >> 2) + 4 * n + (i & 3); }

struct Unit { int pm, pn; };
struct Gemm { const bf16_t* A; const bf16_t* Bt; int M, N, K; };

struct StaticOrder {
    int nM, nN, nwg, G, c;
    __host__ __device__ void init(int M, int N, int G_, int c_) { nM = M / BM; nN = N / BM; nwg = nM * nN; G = G_; c = c_; }
    __host__ __device__ bool next(int i, Unit& u) const {
        const long L = (long)i * G + c; if (L >= nwg) return false;
        int wgid = (int)L; { const int q = nwg / NXCD, r = nwg % NXCD, xcd = wgid % NXCD, off = wgid / NXCD; wgid = (xcd < r ? xcd * (q + 1) : r * (q + 1) + (xcd - r) * q) + off; }
        const int nig = WGM * nN, gid = wgid / nig, fm = gid * WGM, gsz = (nM - fm) < WGM ? (nM - fm) : WGM;
        u.pm = fm + ((wgid % nig) % gsz); u.pn = (wgid % nig) / gsz; return true;
    }
    __device__ __forceinline__ void a_ready(const Unit&) const {}
    __device__ __forceinline__ void done(const Unit&) const {}
};

template <class Epi, class Sched, bool ALIGN_EPI = false, bool SP2 = false>
__device__ __forceinline__ void gemm_phase(PG8_LAS unsigned char* lds, const Gemm g, const Sched& S, const Epi& E, const int tid) {
    const int wid = __builtin_amdgcn_readfirstlane(tid >> 6), lane = tid & 63, wr = wid >> 2, wc = wid & 3, fr = lane & 15, fq = lane >> 4;
    const int K = g.K, nt = K / BK;
    unsigned voffA[2], voffB[2];
#pragma unroll
    for (int i = 0; i < 2; ++i) { int R, C; stage_rc(tid * 16 + i * 8192, R, C); const int Rb = Epi::PERM ? ((R & ~31) + perm32(R & 31)) : R;
        voffA[i] = (unsigned)(R * K + C) * 2u; voffB[i] = (unsigned)(Rb * K + C) * 2u; }
    const size_t kstep = (size_t)(BK * 2);
    const size_t hstep = (size_t)HALF * K * 2;
    const size_t tstep = 2 * hstep;
    const unsigned ldsw = (unsigned)wid * 1024u;
    const int aoff = lds_byte(wr * 64 + fr, fq * 8), boff = lds_byte(wc * 32 + fr, fq * 8);
#define PG8_SA(b, h) (((b) * 2 + (h)) * HTB)
#define PG8_SB(b, h) ((4 + (b) * 2 + (h)) * HTB)
#define PG8_STAGE(bufoff, gbase, voff) do { _Pragma("unroll") for (int _i = 0; _i < 2; ++_i) \
        __builtin_amdgcn_global_load_lds((const unsigned*)((const char*)(gbase) + (voff)[_i]), (PG8_LAS unsigned*)(lds + (bufoff) + ldsw + _i * 8192), 16, 0, 0); } while (0)
#define PG8_LDA(dst, b, h) do { _Pragma("unroll") for (int m = 0; m < 4; ++m) _Pragma("unroll") for (int k = 0; k < 2; ++k) dst[m][k] = *(const PG8_LAS bf16x8*)(lds + PG8_SA(b, h) + aoff + m * 2048 + k * 1024); } while (0)
#define PG8_LDB(dst, b, h) do { _Pragma("unroll") for (int n = 0; n < 2; ++n) _Pragma("unroll") for (int k = 0; k < 2; ++k) dst[n][k] = *(const PG8_LAS bf16x8*)(lds + PG8_SB(b, h) + boff + n * 2048 + k * 1024); } while (0)
#define PG8_MMA(ai, bj, At, Bt) do { __builtin_amdgcn_s_setprio(1); _Pragma("unroll") for (int m = 0; m < 4; ++m) _Pragma("unroll") for (int n = 0; n < 2; ++n) _Pragma("unroll") for (int k = 0; k < 2; ++k) \
        acc[ai][bj][m][n] = __builtin_amdgcn_mfma_f32_16x16x32_bf16(Bt[n][k], At[m][k], acc[ai][bj][m][n], 0, 0, 0); __builtin_amdgcn_s_setprio(0); } while (0)
#define PG8_WAIT_V(n) asm volatile("s_waitcnt vmcnt(" #n ")" ::: "memory")
#define PG8_WAIT_L(n) asm volatile("s_waitcnt lgkmcnt(" #n ")" ::: "memory")
#define PG8_BAR __builtin_amdgcn_s_barrier()
#define PG8_SCHED __builtin_amdgcn_sched_barrier(0)
    Unit cur, nxt; int ui = 0;
    if (!S.next(0, cur)) return;
    f32x4 acc[2][2][4][2];
#pragma unroll
    for (int a = 0; a < 2; ++a)
#pragma unroll
        for (int b = 0; b < 2; ++b)
#pragma unroll
            for (int m = 0; m < 4; ++m)
#pragma unroll
                for (int n = 0; n < 2; ++n) acc[a][b][m][n] = (f32x4){0.f, 0.f, 0.f, 0.f};
    bf16x8 At[4][2], B0[2][2], B1[2][2];
    const char* cA = (const char*)g.A + (size_t)cur.pm * tstep; const char* cB = (const char*)g.Bt + (size_t)cur.pn * tstep;
    S.a_ready(cur);
    if constexpr (SP2) {
        PG8_STAGE(PG8_SB(0, 0), cB, voffB); PG8_STAGE(PG8_SB(0, 1), cB + hstep, voffB); PG8_STAGE(PG8_SA(0, 0), cA, voffA); PG8_STAGE(PG8_SA(0, 1), cA + hstep, voffA);
        if (wr == 1) PG8_BAR;
        PG8_WAIT_V(2); PG8_BAR;
        PG8_STAGE(PG8_SB(1, 0), cB + kstep, voffB); PG8_STAGE(PG8_SA(1, 0), cA + kstep, voffA); PG8_STAGE(PG8_SB(1, 1), cB + hstep + kstep, voffB);
        PG8_WAIT_V(6); PG8_BAR;
    } else {
        PG8_STAGE(PG8_SB(0, 0), cB, voffB); PG8_STAGE(PG8_SA(0, 0), cA, voffA); PG8_STAGE(PG8_SB(0, 1), cB + hstep, voffB); PG8_STAGE(PG8_SA(0, 1), cA + hstep, voffA);
        if (wr == 1) PG8_BAR;
        PG8_WAIT_V(4); PG8_BAR;
        PG8_STAGE(PG8_SB(1, 0), cB + kstep, voffB); PG8_STAGE(PG8_SA(1, 0), cA + kstep, voffA); PG8_STAGE(PG8_SB(1, 1), cB + hstep + kstep, voffB);
        PG8_WAIT_V(6); PG8_BAR;
    }
    for (;;) {
        const bool has_next = S.next(ui + 1, nxt);
        const char* nA = has_next ? (const char*)g.A + (size_t)nxt.pm * tstep : cA; const char* nB = has_next ? (const char*)g.Bt + (size_t)nxt.pn * tstep : cB;
        for (int t = 0; t < nt; t += 2) {
            const bool last = (t == nt - 2);
            const char* a1 = cA + (size_t)(t + 1) * kstep;
            const char* a2 = last ? nA : cA + (size_t)(t + 2) * kstep; const char* b2 = last ? nB : cB + (size_t)(t + 2) * kstep;
            const char* a3 = a2 + kstep; const char* b3 = b2 + kstep;
            if (last && has_next) S.a_ready(nxt);
            if constexpr (SP2) {
            PG8_LDB(B0, 0, 0); PG8_LDB(B1, 0, 1); PG8_SCHED; PG8_LDA(At, 0, 0); PG8_STAGE(PG8_SA(1, 1), a1 + hstep, voffA);
            PG8_WAIT_V(8); PG8_WAIT_L(0); PG8_BAR; PG8_MMA(0, 0, At, B0); PG8_MMA(0, 1, At, B1); PG8_BAR; PG8_SCHED;
            PG8_LDA(At, 0, 1); PG8_STAGE(PG8_SB(0, 0), b2, voffB); PG8_STAGE(PG8_SB(0, 1), b2 + hstep, voffB); PG8_STAGE(PG8_SA(0, 0), a2, voffA);
            PG8_WAIT_V(8); PG8_WAIT_L(0); PG8_BAR; PG8_MMA(1, 0, At, B0); PG8_MMA(1, 1, At, B1); PG8_BAR; PG8_SCHED;
            PG8_LDB(B0, 1, 0); PG8_LDB(B1, 1, 1); PG8_SCHED; PG8_LDA(At, 1, 0); PG8_STAGE(PG8_SA(0, 1), a2 + hstep, voffA);
            PG8_WAIT_V(8); PG8_WAIT_L(0); PG8_BAR; PG8_MMA(0, 0, At, B0); PG8_MMA(0, 1, At, B1); PG8_BAR; PG8_SCHED;
            PG8_LDA(At, 1, 1); PG8_STAGE(PG8_SB(1, 0), b3, voffB); PG8_STAGE(PG8_SB(1, 1), b3 + hstep, voffB); PG8_STAGE(PG8_SA(1, 0), a3, voffA);
            PG8_WAIT_V(8); PG8_WAIT_L(0); PG8_BAR; PG8_MMA(1, 0, At, B0); PG8_MMA(1, 1, At, B1); PG8_BAR; PG8_SCHED;
            } else {
            PG8_LDB(B0, 0, 0); PG8_SCHED; PG8_LDA(At, 0, 0); PG8_STAGE(PG8_SA(1, 1), a1 + hstep, voffA);
            PG8_WAIT_L(8); PG8_BAR; PG8_WAIT_L(0); PG8_MMA(0, 0, At, B0); PG8_BAR; PG8_SCHED;
            PG8_LDB(B1, 0, 1); PG8_STAGE(PG8_SB(0, 0), b2, voffB);
            PG8_BAR; PG8_WAIT_L(0); PG8_MMA(0, 1, At, B1); PG8_BAR;
            PG8_LDA(At, 0, 1); PG8_STAGE(PG8_SA(0, 0), a2, voffA);
            PG8_BAR; PG8_WAIT_L(0); PG8_MMA(1, 0, At, B0); PG8_BAR; PG8_SCHED;
            PG8_STAGE(PG8_SB(0, 1), b2 + hstep, voffB);
            PG8_WAIT_V(6); PG8_BAR; PG8_MMA(1, 1, At, B1); PG8_BAR;
            PG8_LDB(B0, 1, 0); PG8_SCHED; PG8_LDA(At, 1, 0); PG8_STAGE(PG8_SA(0, 1), a2 + hstep, voffA);
            PG8_WAIT_L(8); PG8_BAR; PG8_WAIT_L(0); PG8_MMA(0, 0, At, B0); PG8_BAR; PG8_SCHED;
            PG8_LDB(B1, 1, 1); PG8_STAGE(PG8_SB(1, 0), b3, voffB);
            PG8_BAR; PG8_WAIT_L(0); PG8_MMA(0, 1, At, B1); PG8_BAR;
            PG8_LDA(At, 1, 1); PG8_STAGE(PG8_SA(1, 0), a3, voffA);
            PG8_BAR; PG8_WAIT_L(0); PG8_MMA(1, 0, At, B0); PG8_BAR; PG8_SCHED;
            PG8_STAGE(PG8_SB(1, 1), b3 + hstep, voffB);
            PG8_WAIT_V(6); PG8_BAR; PG8_MMA(1, 1, At, B1); PG8_BAR;
            }
        }
        if constexpr (ALIGN_EPI) { if (wr == 0) PG8_BAR; }
        if constexpr (!Epi::AFTER_DRAIN) { E(acc, cur, wr, wc, fr, fq); S.done(cur); }
        if (!has_next) break;
#pragma unroll
        for (int a = 0; a < 2; ++a)
#pragma unroll
            for (int b = 0; b < 2; ++b)
#pragma unroll
                for (int m = 0; m < 4; ++m)
#pragma unroll
                    for (int n = 0; n < 2; ++n) acc[a][b][m][n] = (f32x4){0.f, 0.f, 0.f, 0.f};
        cur = nxt; cA = nA; cB = nB; ++ui;
        if constexpr (ALIGN_EPI) { if (wr == 1) PG8_BAR; }
    }
    PG8_WAIT_V(0);
    if constexpr (!ALIGN_EPI) { if (wr == 0) PG8_BAR; }
    PG8_BAR;
    if constexpr (Epi::AFTER_DRAIN) { E.fused(acc, cur, wr, wc, fr, fq, lds, wid, lane); S.done(cur); }
#undef PG8_SA
#undef PG8_SB
#undef PG8_STAGE
#undef PG8_LDA
#undef PG8_LDB
#undef PG8_MMA
#undef PG8_WAIT_V
#undef PG8_WAIT_L
#undef PG8_BAR
#undef PG8_SCHED
}

struct Unit2 { int pm, pn, part; };
struct Gemm2 { const bf16_t* A0; const bf16_t* A1; const bf16_t* B0; const bf16_t* B1; int lda, K; };
struct StaticOrder2 {
    int nM, nN, nwg, G, c;
    __host__ __device__ void init(int M, int N, int G_, int c_) { nM = M / BM; nN = N / BM; nwg = nM * nN; G = G_; c = c_; }
    __host__ __device__ bool next(int i, Unit2& u) const {
        const long L = (long)(i >> 1) * G + c; if (L >= nwg) return false;
        int wgid = (int)L; { const int q = nwg / NXCD, r = nwg % NXCD, xcd = wgid % NXCD, off = wgid / NXCD; wgid = (xcd < r ? xcd * (q + 1) : r * (q + 1) + (xcd - r) * q) + off; }
        const int nig = WGM * nN, gid = wgid / nig, fm = gid * WGM, gsz = (nM - fm) < WGM ? (nM - fm) : WGM;
        u.pm = fm + ((wgid % nig) % gsz); u.pn = (wgid % nig) / gsz; u.part = i & 1; return true;
    }
    __device__ __forceinline__ void a_ready(const Unit2&) const {}
    __device__ __forceinline__ void done(const Unit2&) const {}
    const float* ssq; PG8_LAS float* rs; int tid;
    __device__ __forceinline__ void prep_rows(const Unit2& u) const {
        const int row = tid >> 1, h0 = (tid & 1) * 2;
        const float* sp = ssq + (size_t)(h0 * 8) * 32768 + (u.pm * 256 + row);
        float sa = 0.f, sb = 0.f;
#pragma unroll
        for (int k = 0; k < 8; ++k) { sa += sp[(size_t)k * 32768]; sb += sp[(size_t)(8 + k) * 32768]; }
        rs[row * 4 + h0] = __builtin_amdgcn_rsqf(sa * (1.0f / 128.0f) + 1e-6f);
        rs[row * 4 + h0 + 1] = __builtin_amdgcn_rsqf(sb * (1.0f / 128.0f) + 1e-6f);
    }
};
template <class Epi, class Sched, bool ALIGN_EPI = false, bool SP2 = false>
__device__ __forceinline__ void gemm_phase2(PG8_LAS unsigned char* lds, const Gemm2 g, const Sched& S, const Epi& E, const int tid) {
    const int wid = __builtin_amdgcn_readfirstlane(tid >> 6), lane = tid & 63, wr = wid >> 2, wc = wid & 3, fr = lane & 15, fq = lane >> 4;
    const int K = g.K, nt = K / BK;
    unsigned voffA[2], voffB[2];
#pragma unroll
    for (int i = 0; i < 2; ++i) { int R, C; stage_rc(tid * 16 + i * 8192, R, C); const int Rb = Epi::PERM ? ((R & ~31) + perm32(R & 31)) : R;
        voffA[i] = (unsigned)(R * g.lda + C) * 2u; voffB[i] = (unsigned)(Rb * K + C) * 2u; }
    const size_t kstep = (size_t)(BK * 2);
    const size_t hstep = (size_t)HALF * K * 2;
    const size_t tstep = 2 * hstep;
    const size_t hstepA = (size_t)HALF * g.lda * 2, tstepA = 2 * hstepA;
    const unsigned ldsw = (unsigned)wid * 1024u;
    const int aoff = lds_byte(wr * 64 + fr, fq * 8), boff = lds_byte(wc * 32 + fr, fq * 8);
#define PG8_SA(b, h) (((b) * 2 + (h)) * HTB)
#define PG8_SB(b, h) ((4 + (b) * 2 + (h)) * HTB)
#define PG8_STAGE(bufoff, gbase, voff) do { _Pragma("unroll") for (int _i = 0; _i < 2; ++_i) \
        __builtin_amdgcn_global_load_lds((const unsigned*)((const char*)(gbase) + (voff)[_i]), (PG8_LAS unsigned*)(lds + (bufoff) + ldsw + _i * 8192), 16, 0, 0); } while (0)
#define PG8_LDA(dst, b, h) do { _Pragma("unroll") for (int m = 0; m < 4; ++m) _Pragma("unroll") for (int k = 0; k < 2; ++k) dst[m][k] = *(const PG8_LAS bf16x8*)(lds + PG8_SA(b, h) + aoff + m * 2048 + k * 1024); } while (0)
#define PG8_LDB(dst, b, h) do { _Pragma("unroll") for (int n = 0; n < 2; ++n) _Pragma("unroll") for (int k = 0; k < 2; ++k) dst[n][k] = *(const PG8_LAS bf16x8*)(lds + PG8_SB(b, h) + boff + n * 2048 + k * 1024); } while (0)
#define PG8_MMA(ai, bj, At, Bt) do { __builtin_amdgcn_s_setprio(1); _Pragma("unroll") for (int m = 0; m < 4; ++m) _Pragma("unroll") for (int n = 0; n < 2; ++n) _Pragma("unroll") for (int k = 0; k < 2; ++k) \
        acc[ai][bj][m][n] = __builtin_amdgcn_mfma_f32_16x16x32_bf16(Bt[n][k], At[m][k], acc[ai][bj][m][n], 0, 0, 0); __builtin_amdgcn_s_setprio(0); } while (0)
#define PG8_WAIT_V(n) asm volatile("s_waitcnt vmcnt(" #n ")" ::: "memory")
#define PG8_WAIT_L(n) asm volatile("s_waitcnt lgkmcnt(" #n ")" ::: "memory")
#define PG8_BAR __builtin_amdgcn_s_barrier()
#define PG8_SCHED __builtin_amdgcn_sched_barrier(0)
    Unit2 cur, nxt; int ui = 0;
    if (!S.next(0, cur)) return;
    f32x4 acc[2][2][4][2];
#pragma unroll
    for (int a = 0; a < 2; ++a)
#pragma unroll
        for (int b = 0; b < 2; ++b)
#pragma unroll
            for (int m = 0; m < 4; ++m)
#pragma unroll
                for (int n = 0; n < 2; ++n) acc[a][b][m][n] = (f32x4){0.f, 0.f, 0.f, 0.f};
    bf16x8 At[4][2], B0[2][2], B1[2][2];
    const char* cA = (const char*)(cur.part ? g.A1 : g.A0) + (size_t)cur.pm * tstepA; const char* cB = (const char*)(cur.part ? g.B1 : g.B0) + (size_t)cur.pn * tstep;
    S.a_ready(cur);
    S.prep_rows(cur);
    if constexpr (SP2) {
        PG8_STAGE(PG8_SB(0, 0), cB, voffB); PG8_STAGE(PG8_SB(0, 1), cB + hstep, voffB); PG8_STAGE(PG8_SA(0, 0), cA, voffA); PG8_STAGE(PG8_SA(0, 1), cA + hstepA, voffA);
        if (wr == 1) PG8_BAR;
        PG8_WAIT_V(2); PG8_BAR;
        PG8_STAGE(PG8_SB(1, 0), cB + kstep, voffB); PG8_STAGE(PG8_SA(1, 0), cA + kstep, voffA); PG8_STAGE(PG8_SB(1, 1), cB + hstep + kstep, voffB);
        PG8_WAIT_V(6); PG8_BAR;
    } else {
        PG8_STAGE(PG8_SB(0, 0), cB, voffB); PG8_STAGE(PG8_SA(0, 0), cA, voffA); PG8_STAGE(PG8_SB(0, 1), cB + hstep, voffB); PG8_STAGE(PG8_SA(0, 1), cA + hstepA, voffA);
        if (wr == 1) PG8_BAR;
        PG8_WAIT_V(4); PG8_BAR;
        PG8_STAGE(PG8_SB(1, 0), cB + kstep, voffB); PG8_STAGE(PG8_SA(1, 0), cA + kstep, voffA); PG8_STAGE(PG8_SB(1, 1), cB + hstep + kstep, voffB);
        PG8_WAIT_V(6); PG8_BAR;
    }
    for (;;) {
        const bool has_next = S.next(ui + 1, nxt);
        const char* nA = has_next ? (const char*)(nxt.part ? g.A1 : g.A0) + (size_t)nxt.pm * tstepA : cA; const char* nB = has_next ? (const char*)(nxt.part ? g.B1 : g.B0) + (size_t)nxt.pn * tstep : cB;
        for (int t = 0; t < nt; t += 2) {
            const bool last = (t == nt - 2);
            const char* a1 = cA + (size_t)(t + 1) * kstep;
            const char* a2 = last ? nA : cA + (size_t)(t + 2) * kstep; const char* b2 = last ? nB : cB + (size_t)(t + 2) * kstep;
            const char* a3 = a2 + kstep; const char* b3 = b2 + kstep;
            if (last && has_next) S.a_ready(nxt);
            if constexpr (SP2) {
            PG8_LDB(B0, 0, 0); PG8_LDB(B1, 0, 1); PG8_SCHED; PG8_LDA(At, 0, 0); PG8_STAGE(PG8_SA(1, 1), a1 + hstepA, voffA);
            PG8_WAIT_V(8); PG8_WAIT_L(0); PG8_BAR; PG8_MMA(0, 0, At, B0); PG8_MMA(0, 1, At, B1); PG8_BAR; PG8_SCHED;
            PG8_LDA(At, 0, 1); PG8_STAGE(PG8_SB(0, 0), b2, voffB); PG8_STAGE(PG8_SB(0, 1), b2 + hstep, voffB); PG8_STAGE(PG8_SA(0, 0), a2, voffA);
            PG8_WAIT_V(8); PG8_WAIT_L(0); PG8_BAR; PG8_MMA(1, 0, At, B0); PG8_MMA(1, 1, At, B1); PG8_BAR; PG8_SCHED;
            PG8_LDB(B0, 1, 0); PG8_LDB(B1, 1, 1); PG8_SCHED; PG8_LDA(At, 1, 0); PG8_STAGE(PG8_SA(0, 1), a2 + hstepA, voffA);
            PG8_WAIT_V(8); PG8_WAIT_L(0); PG8_BAR; PG8_MMA(0, 0, At, B0); PG8_MMA(0, 1, At, B1); PG8_BAR; PG8_SCHED;
            PG8_LDA(At, 1, 1); PG8_STAGE(PG8_SB(1, 0), b3, voffB); PG8_STAGE(PG8_SB(1, 1), b3 + hstep, voffB); PG8_STAGE(PG8_SA(1, 0), a3, voffA);
            PG8_WAIT_V(8); PG8_WAIT_L(0); PG8_BAR; PG8_MMA(1, 0, At, B0); PG8_MMA(1, 1, At, B1); PG8_BAR; PG8_SCHED;
            } else {
            PG8_LDB(B0, 0, 0); PG8_SCHED; PG8_LDA(At, 0, 0); PG8_STAGE(PG8_SA(1, 1), a1 + hstepA, voffA);
            PG8_WAIT_L(8); PG8_BAR; PG8_WAIT_L(0); PG8_MMA(0, 0, At, B0); PG8_BAR; PG8_SCHED;
            PG8_LDB(B1, 0, 1); PG8_STAGE(PG8_SB(0, 0), b2, voffB);
            PG8_BAR; PG8_WAIT_L(0); PG8_MMA(0, 1, At, B1); PG8_BAR;
            PG8_LDA(At, 0, 1); PG8_STAGE(PG8_SA(0, 0), a2, voffA);
            PG8_BAR; PG8_WAIT_L(0); PG8_MMA(1, 0, At, B0); PG8_BAR; PG8_SCHED;
            PG8_STAGE(PG8_SB(0, 1), b2 + hstep, voffB);
            PG8_WAIT_V(6); PG8_BAR; PG8_MMA(1, 1, At, B1); PG8_BAR;
            PG8_LDB(B0, 1, 0); PG8_SCHED; PG8_LDA(At, 1, 0); PG8_STAGE(PG8_SA(0, 1), a2 + hstepA, voffA);
            PG8_WAIT_L(8); PG8_BAR; PG8_WAIT_L(0); PG8_MMA(0, 0, At, B0); PG8_BAR; PG8_SCHED;
            PG8_LDB(B1, 1, 1); PG8_STAGE(PG8_SB(1, 0), b3, voffB);
            PG8_BAR; PG8_WAIT_L(0); PG8_MMA(0, 1, At, B1); PG8_BAR;
            PG8_LDA(At, 1, 1); PG8_STAGE(PG8_SA(1, 0), a3, voffA);
            PG8_BAR; PG8_WAIT_L(0); PG8_MMA(1, 0, At, B0); PG8_BAR; PG8_SCHED;
            PG8_STAGE(PG8_SB(1, 1), b3 + hstep, voffB);
            PG8_WAIT_V(6); PG8_BAR; PG8_MMA(1, 1, At, B1); PG8_BAR;
            }
            if (cur.part == 0 && !last) E.kscale(acc, t >> 1, wr, fr);
        }
        if constexpr (ALIGN_EPI) { if (wr == 0) PG8_BAR; }
        if (cur.part == 0) E.mid(acc, cur, wr, wc, fr, fq); else E(acc, cur, wr, wc, fr, fq);
        if (!has_next) break;
        if (cur.part == 1) S.prep_rows(nxt);
        if (cur.part == 1) {
#pragma unroll
        for (int a = 0; a < 2; ++a)
#pragma unroll
            for (int b = 0; b < 2; ++b)
#pragma unroll
                for (int m = 0; m < 4; ++m)
#pragma unroll
                    for (int n = 0; n < 2; ++n) acc[a][b][m][n] = (f32x4){0.f, 0.f, 0.f, 0.f};
        }
        cur = nxt; cA = nA; cB = nB; ++ui;
        if constexpr (ALIGN_EPI) { if (wr == 1) PG8_BAR; }
    }
    PG8_WAIT_V(0);
    if constexpr (!ALIGN_EPI) { if (wr == 0) PG8_BAR; }
    PG8_BAR;
#undef PG8_SA
#undef PG8_SB
#undef PG8_STAGE
#undef PG8_LDA
#undef PG8_LDB
#undef PG8_MMA
#undef PG8_WAIT_V
#undef PG8_WAIT_L
#undef PG8_BAR
#undef PG8_SCHED
}
}

struct EpiInProj {
  static constexpr bool PERM = true, AFTER_DRAIN = false;
  u16* h;
  DI void operator()(const f32x4 (&acc)[2][2][4][2], const pg8::Unit& u, int wr, int wc, int fr, int fq) const {
    const int shift = (u.pn >= 8) ? 8 : 0;
#pragma unroll
    for (int ai = 0; ai < 2; ++ai)
#pragma unroll
      for (int m = 0; m < 4; ++m) {
        const int row = u.pm * 256 + ai * 128 + wr * 64 + m * 16 + fr;
#pragma unroll
        for (int bj = 0; bj < 2; ++bj) {
          const int col = u.pn * 256 + bj * 128 + wc * 32 + 8 * fq + shift;
          const f32x4 a = acc[ai][bj][m][0], b = acc[ai][bj][m][1];
          u32x4 w; w.x = pk_bf16(a[0], a[1]); w.y = pk_bf16(a[2], a[3]); w.z = pk_bf16(b[0], b[1]); w.w = pk_bf16(b[2], b[3]);
          *(u32x4*)(h + (size_t)row * NC + col) = w;
        }
      }
  }
};

struct EpiMerge {
  static constexpr bool PERM = true, AFTER_DRAIN = false;
  const u16* h; u16* mg; PG8_LAS float* rs;
  DI void kscale(f32x4 (&acc)[2][2][4][2], int hh, int wr, int fr) const {
#pragma unroll
    for (int ai = 0; ai < 2; ++ai)
#pragma unroll
      for (int m = 0; m < 4; ++m) {
        const int rl = ai * 128 + wr * 64 + m * 16 + fr;
        const float f = rs[rl * 4 + hh] * rcp_f(rs[rl * 4 + hh + 1]);
#pragma unroll
        for (int bj = 0; bj < 2; ++bj) { acc[ai][bj][m][0] *= f; acc[ai][bj][m][1] *= f; }
      }
  }
  DI void mid(f32x4 (&acc)[2][2][4][2], const pg8::Unit2& u, int wr, int wc, int fr, int fq) const {
#pragma unroll
    for (int ai = 0; ai < 2; ++ai) {
      u32x4 ga[4][2], gb[4][2];
#pragma unroll
      for (int m = 0; m < 4; ++m)
#pragma unroll
        for (int bj = 0; bj < 2; ++bj) {
          const size_t off = (size_t)(u.pm * 256 + ai * 128 + wr * 64 + m * 16 + fr) * NC + (u.pn * 256 + bj * 128 + wc * 32 + 8 * fq);
          ga[m][bj] = *(const u32x4*)(h + off + C_GA); gb[m][bj] = *(const u32x4*)(h + off + C_GB);
        }
      __builtin_amdgcn_sched_barrier(0);
#pragma unroll
      for (int m = 0; m < 4; ++m)
#pragma unroll
        for (int bj = 0; bj < 2; ++bj)
#pragma unroll
          for (int j = 0; j < 4; ++j) {
            const float r3 = rs[(ai * 128 + wr * 64 + m * 16 + fr) * 4 + 3];
            const float r0 = r3 * (1.f + __expf(-bf_lo(gb[m][bj][j]))) * rcp_f(1.f + __expf(-bf_lo(ga[m][bj][j])));
            const float r1 = r3 * (1.f + __expf(-bf_hi(gb[m][bj][j]))) * rcp_f(1.f + __expf(-bf_hi(ga[m][bj][j])));
            acc[ai][bj][m][j >> 1][2 * (j & 1)] *= r0; acc[ai][bj][m][j >> 1][2 * (j & 1) + 1] *= r1;
          }
      __builtin_amdgcn_sched_barrier(0);
    }
  }
  DI void operator()(const f32x4 (&acc)[2][2][4][2], const pg8::Unit2& u, int wr, int wc, int fr, int fq) const {
#pragma unroll
    for (int ai = 0; ai < 2; ++ai) {
      u32x4 gb[4][2];
#pragma unroll
      for (int m = 0; m < 4; ++m)
#pragma unroll
        for (int bj = 0; bj < 2; ++bj)
          gb[m][bj] = *(const u32x4*)(h + (size_t)(u.pm * 256 + ai * 128 + wr * 64 + m * 16 + fr) * NC + C_GB + (u.pn * 256 + bj * 128 + wc * 32 + 8 * fq));
      __builtin_amdgcn_sched_barrier(0);
#pragma unroll
      for (int m = 0; m < 4; ++m)
#pragma unroll
        for (int bj = 0; bj < 2; ++bj) {
          const int row = u.pm * 256 + ai * 128 + wr * 64 + m * 16 + fr, col = u.pn * 256 + bj * 128 + wc * 32 + 8 * fq;
          const f32x4 a = acc[ai][bj][m][0], b = acc[ai][bj][m][1];
          const u32x4 g = gb[m][bj];
          u32x4 w;
          w.x = pk_bf16(a[0] * sigmoid_f(bf_lo(g[0])), a[1] * sigmoid_f(bf_hi(g[0])));
          w.y = pk_bf16(a[2] * sigmoid_f(bf_lo(g[1])), a[3] * sigmoid_f(bf_hi(g[1])));
          w.z = pk_bf16(b[0] * sigmoid_f(bf_lo(g[2])), b[1] * sigmoid_f(bf_hi(g[2])));
          w.w = pk_bf16(b[2] * sigmoid_f(bf_lo(g[3])), b[3] * sigmoid_f(bf_hi(g[3])));
          *(u32x4*)(mg + (size_t)row * 1024 + col) = w;
        }
      __builtin_amdgcn_sched_barrier(0);
    }
  }
};

struct EpiOut {
  static constexpr bool PERM = true, AFTER_DRAIN = false;
  const float* x; _Float16* r16;
  DI void operator()(const f32x4 (&acc)[2][2][4][2], const pg8::Unit& u, int wr, int wc, int fr, int fq) const {
#pragma unroll
    for (int ai = 0; ai < 2; ++ai) {
      f32x4 xv[4][2][2];
#pragma unroll
      for (int m = 0; m < 4; ++m)
#pragma unroll
        for (int bj = 0; bj < 2; ++bj) {
          const float* xp = x + (size_t)(u.pm * 256 + ai * 128 + wr * 64 + m * 16 + fr) * 1024 + (u.pn * 256 + bj * 128 + wc * 32 + 8 * fq);
          xv[m][bj][0] = *(const f32x4*)xp; xv[m][bj][1] = *(const f32x4*)(xp + 4);
        }
      __builtin_amdgcn_sched_barrier(0);
#pragma unroll
      for (int m = 0; m < 4; ++m)
#pragma unroll
        for (int bj = 0; bj < 2; ++bj) {
          const int row = u.pm * 256 + ai * 128 + wr * 64 + m * 16 + fr, col = u.pn * 256 + bj * 128 + wc * 32 + 8 * fq;
          const f32x4 v0 = xv[m][bj][0] * 1.189207115002721f + acc[ai][bj][m][0], v1 = xv[m][bj][1] * 1.189207115002721f + acc[ai][bj][m][1];
          const f16x4 h0 = __builtin_convertvector(v0, f16x4), h1 = __builtin_convertvector(v1, f16x4);
          u32x4 w; const u32x2 p0 = __builtin_bit_cast(u32x2, h0), p1 = __builtin_bit_cast(u32x2, h1);
          w.x = p0.x; w.y = p0.y; w.z = p1.x; w.w = p1.y;
          *(u32x4*)(r16 + (size_t)row * 1024 + col) = w;
        }
      __builtin_amdgcn_sched_barrier(0);
    }
  }
};

__global__ void __launch_bounds__(512, 2) fwd_megakernel(Params p) {
  cg::grid_group grid = cg::this_grid();
  __shared__ __attribute__((aligned(16))) unsigned char smem[SMEM_BYTES];
  const int w8 = __builtin_amdgcn_readfirstlane((int)(threadIdx.x >> 6));
  const int wvs = w8 & 3, half = w8 >> 2;
  unsigned char* hsm = smem + half * HALF_SMEM;
  const int vb = blockIdx.x + half * gridDim.x, nvb = 2 * gridDim.x;
  volatile LAS unsigned* st = (volatile LAS unsigned*)(smem + SMEM_BYTES - 16);
  { const int t0_ = opaque_tid(); if (t0_ < 4) st[t0_] = 0u; }
  __syncthreads();
  const XcdBarrier xb = xcd_barrier_post((unsigned*)(p.ws + OFF_BAR), st, w8);
  phase0(p, w8);
  if (p.ws == nullptr) grid.sync();
  xcd_barrier(xb);
  {
    pg8::Gemm g; g.A = (const pg8::bf16_t*)(p.ws + OFF_SC); g.Bt = (const pg8::bf16_t*)(p.ws + OFF_WINT); g.M = T_TOK; g.N = NCP; g.K = 1024;
    pg8::StaticOrder so; so.init(T_TOK, NCP, (int)gridDim.x, (int)blockIdx.x);
    EpiInProj e; e.h = (u16*)(p.ws + OFF_H);
    pg8::gemm_phase<EpiInProj, pg8::StaticOrder, true, true>((PG8_LAS unsigned char*)smem, g, so, e, opaque_tid_(w8));
  }
  xcd_barrier(xb);
  for (int it = vb; it < 2048; it += nvb) prep_item(p, wvs, it, hsm);
  xcd_barrier(xb);
  if (blockIdx.x < 128) {
    if (half == 0) { const int cb = (int)blockIdx.x; scan_chain(p, wvs, (cb & 7) + 8 * ((cb >> 3) >> 3), (cb >> 3) & 7, hsm); }
    else {
      const int cb = (int)blockIdx.x, pr = (cb & 7) + 8 * ((cb >> 3) >> 3), slp = (cb >> 3) & 7, bp = pr >> 2, hp = pr & 3;
      const int ft = opaque_tid();
      const unsigned char* pbase = p.ws + OFF_SC + (size_t)(slp * 72 + (ft < 72 ? ft : 0)) * 128;
      const int dR = ft >> 2, dc0 = (ft & 3) * 4;
      const u16* zbase = (const u16*)(p.ws + OFF_H) + (size_t)(bp * SEQ + dR) * NC + C_DNZ + hp * 128 + 16 * slp + dc0;
      const f32x4 nw4 = *(const f32x4*)(p.dn_norm_w + 16 * slp + dc0);
      unsigned char* ringp = smem + 8192;
      const unsigned char* ubase = p.ws + OFF_SC + 57344 + slp * 2048 + ft * 8;
      const float* dbase = (const float*)(p.ws + OFF_DEC);
      const int doff = ((dR >> 4) * 64 + ((dR >> 2) & 3) * 16 + dc0) * 16 + (dR & 3) * 4;
#define Z_LOAD(dst, step_) do { const int st_ = (step_) < 0 ? 0 : ((step_) < 128 ? (step_) : 127); dst = *(const u32x2*)(zbase + (size_t)st_ * 64 * NC); } while (0)
#define U_LOAD(du, dd, step_) do { const int it_ = (bp * 128 + ((step_) < 128 ? (step_) : 127)) * 4 + hp; du = *(const u32x2*)(ubase + (size_t)it_ * OPB); dd = dbase[it_]; } while (0)
#define U_STORE(su, sd, step_) do { *(u32x2*)(ringp + ((step_) % 3) * 6400 + 4096 + ft * 8) = su; if (ft == 0) *(float*)(ringp + ((step_) % 3) * 6400 + 6144) = sd; } while (0)
#define O_DRAIN(zsrc, step_) do { const unsigned char* os_ = ringp + ((step_) % 3) * 6400 + doff; \
        const float o0_ = *(const float*)os_, o1_ = *(const float*)(os_ + 16), o2_ = *(const float*)(os_ + 32), o3_ = *(const float*)(os_ + 48); \
        const size_t row_ = (size_t)(bp * SEQ + (step_) * 64 + dR); \
        u32x2 w_; w_.x = pk_bf16(o0_ * nw4[0] * silu_f(bf_lo(zsrc.x)), o1_ * nw4[1] * silu_f(bf_hi(zsrc.x))); \
        w_.y = pk_bf16(o2_ * nw4[2] * silu_f(bf_lo(zsrc.y)), o3_ * nw4[3] * silu_f(bf_hi(zsrc.y))); \
        *(u32x2*)(hout + row_ * NC + hp * 128 + 16 * slp + dc0) = w_; \
        float sq_ = (o0_ * o0_ + o1_ * o1_) + (o2_ * o2_ + o3_ * o3_); \
        sq_ += dpp_mov<0xB1>(sq_); sq_ += dpp_mov<0x4E>(sq_); \
        if ((ft & 3) == 0) ssqp[(size_t)(hp * 8 + slp) * T_TOK + row_] = sq_; } while (0)
      u16* hout = (u16*)(p.ws + OFF_H);
      float* ssqp = (float*)(p.ws + OFF_SSQ);
      u32x2 zr0, zr1, zr2 = {0u, 0u}, zr3 = {0u, 0u};
      u32x2 ur0, ur1, ur2, ur3; float dr0, dr1, dr2, dr3;
      unsigned pr0 = 0, pr1 = 0, pr2 = 0, pr3 = 0, accp = 0;
      Z_LOAD(zr0, 0); Z_LOAD(zr1, 1);
      U_LOAD(ur0, dr0, 0); U_LOAD(ur1, dr1, 1); U_LOAD(ur2, dr2, 2); U_LOAD(ur3, dr3, 3);
      U_STORE(ur0, dr0, 0);
      __syncthreads();
#define P_ITER(m_, K0, K1, K2) do { \
        U_STORE(ur##K1, dr##K1, (m_) + 1); U_LOAD(ur##K0, dr##K0, (m_) + 4); \
        if ((m_) >= 2) O_DRAIN(zr##K2, (m_) - 2); \
        Z_LOAD(zr##K2, (m_) + 2); \
        accp ^= pr##K0; { const int np_ = (m_) + 6 < 128 ? (m_) + 6 : 127; pr##K0 = *(const unsigned*)(pbase + (size_t)((bp * 128 + np_) * 4 + hp) * OPB); } \
        __syncthreads(); __syncthreads(); } while (0)
#pragma unroll 1
      for (int mm = 0; mm < 128; mm += 4) { P_ITER(mm, 0, 1, 2); P_ITER(mm + 1, 1, 2, 3); P_ITER(mm + 2, 2, 3, 0); P_ITER(mm + 3, 3, 0, 1); }
#undef P_ITER
      __syncthreads();
      O_DRAIN(zr2, 126); O_DRAIN(zr3, 127);
      accp ^= pr0 ^ pr1 ^ pr2 ^ pr3;
#undef Z_LOAD
#undef U_LOAD
#undef U_STORE
#undef O_DRAIN
      if (accp == 0x9e3779b9u && ft == 300) ((unsigned*)(p.ws + OFF_BAR))[XB_TMO + 1] = accp;
    }
  } else {
    const int nsw = 2 * ((int)gridDim.x - 128), vbl = ((int)blockIdx.x - 128) + half * ((int)gridDim.x - 128);
    for (int k = 0; k * nsw < 1024; ++k) { const int it = vbl + k * nsw; swa_item(p, wvs, it < 1024 ? it : 0, it < 1024, hsm); }
  }
  xcd_barrier(xb);
  {
    pg8::Gemm2 g; g.A0 = (const pg8::bf16_t*)(p.ws + OFF_H); g.A1 = g.A0 + C_SWQ; g.B0 = (const pg8::bf16_t*)(p.ws + OFF_WAT); g.B1 = (const pg8::bf16_t*)(p.ws + OFF_WBT);
    g.lda = NC; g.K = 512;
    pg8::StaticOrder2 so; so.init(T_TOK, 1024, (int)gridDim.x, (int)blockIdx.x);
    so.ssq = (const float*)(p.ws + OFF_SSQ); so.rs = (PG8_LAS float*)(smem + 131072); so.tid = opaque_tid_(w8);
    EpiMerge e; e.h = (const u16*)(p.ws + OFF_H); e.mg = (u16*)(p.ws + OFF_SC); e.rs = (PG8_LAS float*)(smem + 131072);
    pg8::gemm_phase2<EpiMerge, pg8::StaticOrder2, true, true>((PG8_LAS unsigned char*)smem, g, so, e, opaque_tid_(w8));
  }
  xcd_barrier(xb);
  {
    pg8::Gemm g; g.A = (const pg8::bf16_t*)(p.ws + OFF_SC); g.Bt = (const pg8::bf16_t*)(p.ws + OFF_WOT); g.M = T_TOK; g.N = 1024; g.K = 1024;
    pg8::StaticOrder so; so.init(T_TOK, 1024, (int)gridDim.x, (int)blockIdx.x);
    EpiOut e; e.x = p.x; e.r16 = (_Float16*)(p.ws + OFF_H);
    pg8::gemm_phase<EpiOut, pg8::StaticOrder, true, true>((PG8_LAS unsigned char*)smem, g, so, e, opaque_tid_(w8));
  }
  xcd_barrier(xb);
  phase6(p, w8, smem);
}

extern "C" void kernel_launch(void* const* d_in, const int* in_sizes, int n_in, void* d_out, int out_size,
                              void* d_ws, size_t ws_size, hipStream_t stream) {
  if (ws_size < WS_NEED) { fprintf(stderr, "workspace too small: %zu < %zu\n", ws_size, (size_t)WS_NEED); return; }
  Params p{};
  p.x = (const float*)d_in[0]; p.w_in = (const float*)d_in[1]; p.conv_w = (const float*)d_in[2]; p.a_log = (const float*)d_in[3];
  p.dt_bias = (const float*)d_in[4]; p.dn_norm_w = (const float*)d_in[5]; p.sinks = (const float*)d_in[6];
  p.w_branch = (const float*)d_in[7]; p.w_out = (const float*)d_in[8]; p.ln_g = (const float*)d_in[9]; p.ln_b = (const float*)d_in[10];
  p.out = (float*)d_out; p.ws = (unsigned char*)d_ws;
  for (int i = 0; i < 8; ++i) p.inv_freq[i] = (float)std::pow(500000.0, -(double)i / 8.0);
  static int grid_blocks = 0;
  if (!grid_blocks) {
    int dev = 0, cus = 0, per_cu = 0;
    (void)hipGetDevice(&dev);
    (void)hipDeviceGetAttribute(&cus, hipDeviceAttributeMultiprocessorCount, dev);
    (void)hipOccupancyMaxActiveBlocksPerMultiprocessor(&per_cu, fwd_megakernel, 512, 0);
    if (per_cu < 1) fprintf(stderr, "occupancy query reports %d workgroups per CU\n", per_cu);
    grid_blocks = cus > 256 ? 256 : cus;
    grid_blocks &= ~7;
  }
  (void)hipMemsetAsync(p.ws + OFF_BAR, 0, BAR_BYTES, stream);
  void* args[] = {&p};
  hipError_t e = hipLaunchCooperativeKernel((void*)fwd_megakernel, dim3(grid_blocks), dim3(512), args, 0, stream);
  if (e != hipSuccess) fprintf(stderr, "cooperative launch failed: %s (grid %d)\n", hipGetErrorString(e), grid_blocks);
}
```

```cpp
#include <hip/hip_runtime.h>
#include <hip/hip_cooperative_groups.h>
#include <cstdio>
#include <cmath>
namespace cg = cooperative_groups;

typedef unsigned short u16;
typedef short bf16x8 __attribute__((ext_vector_type(8)));
typedef float f32x4 __attribute__((ext_vector_type(4)));
typedef unsigned u32x4 __attribute__((ext_vector_type(4)));
typedef unsigned u32x2 __attribute__((ext_vector_type(2)));
typedef _Float16 f16x4 __attribute__((ext_vector_type(4)));
#define DI __device__ __forceinline__
DI int opaque_tid_(int wave_s) { int t; asm volatile("v_mbcnt_lo_u32_b32 %0, -1, 0\n\tv_mbcnt_hi_u32_b32 %0, -1, %0" : "=v"(t)); return t + (wave_s << 6); }
#define opaque_tid() opaque_tid_(wvs)

constexpr int T_TOK = 32768, SEQ = 8192, DM = 1024, NC = 5384, NCP = 5376;
constexpr int C_DNZ = 1536, C_SWQ = 2056, C_SWK = 2568, C_SWV = 2696, C_SWZ = 2824, C_GA = 3336, C_GB = 4360;
constexpr size_t OFF_BAR = 0;
constexpr size_t BAR_BYTES = 16384;
constexpr size_t OFF_WINT = BAR_BYTES;
constexpr size_t OFF_WAT = OFF_WINT + (size_t)NCP * 1024 * 2;
constexpr size_t OFF_WBT = OFF_WAT + 1024 * 512 * 2;
constexpr size_t OFF_WOT = OFF_WBT + 1024 * 512 * 2;
constexpr size_t OFF_ROPE = OFF_WOT + 1024 * 1024 * 2;
constexpr size_t OFF_HB = OFF_ROPE + 2 * 8192 * 8 * 4;
constexpr size_t OFF_DEC = OFF_HB + (size_t)T_TOK * 8 * 4;
constexpr size_t OFF_H = OFF_DEC + 2048 * 4;
constexpr size_t OFF_SC = OFF_H + (size_t)T_TOK * NC * 2;
constexpr size_t OPB = 73728;
constexpr size_t OFF_SSQ = OFF_SC + 2048 * OPB;
constexpr size_t WS_NEED = OFF_SSQ + (size_t)T_TOK * 32 * 4;
constexpr int HALF_SMEM = 73728;
constexpr int SMEM_BYTES = 2 * HALF_SMEM + 16;

struct Params {
  const float *x, *w_in, *conv_w, *a_log, *dt_bias, *dn_norm_w, *sinks, *w_branch, *w_out, *ln_g, *ln_b;
  float* out; unsigned char* ws;
  float inv_freq[8];
};

typedef __bf16 bf16x2_t __attribute__((ext_vector_type(2)));
typedef float f32x2_t __attribute__((ext_vector_type(2)));
DI unsigned pk_bf16(float lo, float hi) { f32x2_t f = {lo, hi}; bf16x2_t v = __builtin_convertvector(f, bf16x2_t); return __builtin_bit_cast(unsigned, v); }
DI float bf_lo(unsigned u) { return __uint_as_float(u << 16); }
DI float bf_hi(unsigned u) { return __uint_as_float(u & 0xffff0000u); }
DI float bf2f(u16 v) { return __uint_as_float(((unsigned)v) << 16); }
DI u16 f2bf(float f) { return (u16)(pk_bf16(f, f) & 0xffffu); }
DI float shx(float v, int m, int lane) { return __uint_as_float((unsigned)__builtin_amdgcn_ds_bpermute((lane ^ m) << 2, (int)__float_as_uint(v))); }
DI float rcp_f(float y) { return __builtin_amdgcn_rcpf(y); }
template <int CTRL> DI float dpp_mov(float v) { return __builtin_bit_cast(float, __builtin_amdgcn_update_dpp(0, __builtin_bit_cast(int, v), CTRL, 0xf, 0xf, true)); }
DI float row16_sum(float v) {
  v += dpp_mov<0xB1>(v);
  v += dpp_mov<0x4E>(v);
  v += dpp_mov<0x141>(v);
  v += dpp_mov<0x140>(v);
  return v;
}
DI float silu_f(float y) { return y * rcp_f(1.0f + __expf(-y)); }
DI float sigmoid_f(float y) { return rcp_f(1.0f + __expf(-y)); }
DI f32x4 mfma16(bf16x8 a, bf16x8 b, f32x4 c) { return __builtin_amdgcn_mfma_f32_16x16x32_bf16(a, b, c, 0, 0, 0); }
DI bf16x8 as_bf8(u32x4 v) { return __builtin_bit_cast(bf16x8, v); }
DI bf16x8 pack8(f32x4 a, f32x4 b) { u32x4 w; w.x = pk_bf16(a[0], a[1]); w.y = pk_bf16(a[2], a[3]); w.z = pk_bf16(b[0], b[1]); w.w = pk_bf16(b[2], b[3]); return as_bf8(w); }

DI void phase0(const Params& p, int wvs) {
  const size_t gt = (size_t)blockIdx.x * 512 + opaque_tid(), gs = (size_t)gridDim.x * 512;
  {
    const int ltid = (int)(gt & 511), lane = ltid & 63, wv = ltid >> 6;
    float wr[16][8];
#pragma unroll
    for (int j = 0; j < 4; ++j)
#pragma unroll
      for (int c = 0; c < 4; ++c) {
        const float* wp = p.w_in + (size_t)(4 * (lane + 64 * j) + c) * NC + 2048;
        const f32x4 a = *(const f32x4*)wp, b = *(const f32x4*)(wp + 4);
#pragma unroll
        for (int q = 0; q < 4; ++q) { wr[4 * j + c][q] = a[q]; wr[4 * j + c][4 + q] = b[q]; }
      }
    u16* xb = (u16*)(p.ws + OFF_SC);
    float* hb = (float*)(p.ws + OFF_HB);
    const int rstep = gridDim.x * 8;
    for (int row0 = blockIdx.x * 8 + wv; row0 < T_TOK; row0 += 2 * rstep) {
      f32x4 xr[2][4];
#pragma unroll
      for (int u = 0; u < 2; ++u) {
        const int row = row0 + u * rstep;
#pragma unroll
        for (int j = 0; j < 4; ++j) xr[u][j] = (row < T_TOK) ? *(const f32x4*)(p.x + (size_t)row * DM + 4 * (lane + 64 * j)) : (f32x4){0.f, 0.f, 0.f, 0.f};
      }
#pragma unroll
      for (int u = 0; u < 2; ++u) {
        const int row = row0 + u * rstep;
        float v[8];
#pragma unroll
        for (int q = 0; q < 8; ++q) v[q] = 0.f;
#pragma unroll
        for (int j = 0; j < 4; ++j) {
          const f32x4 xv = xr[u][j];
          u32x2 w; w.x = pk_bf16(xv[0], xv[1]); w.y = pk_bf16(xv[2], xv[3]);
          if (row < T_TOK) *(u32x2*)(xb + (size_t)row * DM + 4 * (lane + 64 * j)) = w;
#pragma unroll
          for (int c = 0; c < 4; ++c)
#pragma unroll
            for (int q = 0; q < 8; ++q) v[q] += xv[c] * wr[4 * j + c][q];
        }
        const bool up = (lane & 32) != 0;
        float k4[4];
#pragma unroll
        for (int i = 0; i < 4; ++i) { const float snd = up ? v[i] : v[i + 4]; const float kp = up ? v[i + 4] : v[i]; k4[i] = kp + shx(snd, 32, lane); }
        const bool up2 = (lane & 16) != 0;
        float k2[2];
#pragma unroll
        for (int i = 0; i < 2; ++i) { const float snd = up2 ? k4[i] : k4[i + 2]; const float kp = up2 ? k4[i + 2] : k4[i]; k2[i] = kp + shx(snd, 16, lane); }
        const bool up3 = (lane & 8) != 0;
        float k1 = (up3 ? k2[1] : k2[0]) + shx(up3 ? k2[0] : k2[1], 8, lane);
        k1 += shx(k1, 4, lane); k1 += shx(k1, 2, lane); k1 += shx(k1, 1, lane);
        if ((lane & 7) == 0 && row < T_TOK) hb[(size_t)row * 8 + (lane >> 3)] = k1;
      }
    }
  }
  {
    u32x4* wt = (u32x4*)(p.ws + OFF_WINT);
    for (size_t i = gt; i < (size_t)NCP * 128; i += gs) {
      const int kc = (int)(i / NCP), n = (int)(i % NCP);
      float v[8];
#pragma unroll
      for (int j = 0; j < 8; ++j) v[j] = p.w_in[(size_t)(kc * 8 + j) * NC + n + (n >= 2048 ? 8 : 0)];
      u32x4 w; w.x = pk_bf16(v[0], v[1]); w.y = pk_bf16(v[2], v[3]); w.z = pk_bf16(v[4], v[5]); w.w = pk_bf16(v[6], v[7]);
      wt[(size_t)n * 128 + kc] = w;
    }
  }
  {
    for (size_t i = gt; i < (size_t)2 * 1024 * 64; i += gs) {
      const int br = (int)(i / (1024 * 64)), rem = (int)(i % (1024 * 64)), kc = rem / 1024, n = rem % 1024;
      const float* src = p.w_branch + (size_t)br * 512 * 1024;
      float v[8];
#pragma unroll
      for (int j = 0; j < 8; ++j) v[j] = src[(size_t)(kc * 8 + j) * 1024 + n];
      u32x4 w; w.x = pk_bf16(v[0], v[1]); w.y = pk_bf16(v[2], v[3]); w.z = pk_bf16(v[4], v[5]); w.w = pk_bf16(v[6], v[7]);
      ((u32x4*)(p.ws + (br ? OFF_WBT : OFF_WAT)))[(size_t)n * 64 + kc] = w;
    }
  }
  {
    for (size_t i = gt; i < (size_t)1024 * 128; i += gs) {
      const int kc = (int)(i / 1024), n = (int)(i % 1024);
      float v[8];
#pragma unroll
      for (int j = 0; j < 8; ++j) v[j] = p.w_out[(size_t)(kc * 8 + j) * 1024 + n];
      u32x4 w; w.x = pk_bf16(v[0], v[1]); w.y = pk_bf16(v[2], v[3]); w.z = pk_bf16(v[4], v[5]); w.w = pk_bf16(v[6], v[7]);
      ((u32x4*)(p.ws + OFF_WOT))[(size_t)n * 128 + kc] = w;
    }
  }
  {
    float* rc = (float*)(p.ws + OFF_ROPE); float* rs = rc + 8192 * 8;
    for (size_t i = gt; i < 8192 * 8; i += gs) {
      const int t = (int)(i >> 3), f = (int)(i & 7);
      const float ang = (float)t * p.inv_freq[f];
      const double a = (double)ang;
      const double k = __builtin_rint(a * 0.15915494309189535);
      const float r = (float)(a - k * 6.283185307179586);
      rc[i] = cosf(r); rs[i] = sinf(r);
    }
  }
}

template <int I> DI void solve_rows2(f32x2_t (&xv)[64], const float* Lm, int lane, float lcur) {
  if constexpr (I < 64) {
    float lnx = 0.f;
    if constexpr (I + 1 < 64) lnx = Lm[(I + 1) * 68 + lane];
    f32x2_t a0 = xv[I], a1 = {0.f, 0.f}, a2 = {0.f, 0.f}, a3 = {0.f, 0.f};
#pragma unroll
    for (int m = 0; m < I; ++m) {
      const float l = __builtin_bit_cast(float, __builtin_amdgcn_readlane(__builtin_bit_cast(int, lcur), m));
      const f32x2_t lv = {l, l};
      if ((m & 3) == 0) a0 -= lv * xv[m];
      else if ((m & 3) == 1) a1 -= lv * xv[m];
      else if ((m & 3) == 2) a2 -= lv * xv[m];
      else a3 -= lv * xv[m];
    }
    xv[I] = (a0 + a1) + (a2 + a3);
    solve_rows2<I + 1>(xv, Lm, lane, lnx);
  }
}

DI void prep_item(const Params& p, int wvs, int item, unsigned char* smem) {
  const int tid_ = opaque_tid();
  const int tid = tid_, lane = tid & 63, wv = tid >> 6, r16 = lane & 15, g = lane >> 4;
  const int hd = item & 3, n = (item >> 2) & 127, b = item >> 9;
  const int t0 = b * SEQ + n * 64;
  u16* Qs = (u16*)smem; u16* Ks = Qs + 64 * 136; u16* Vs = Ks + 64 * 136;
  float* Lm = (float*)(smem + 52224);
  float* sm_beta = (float*)(smem + 69632);
  float* sm_gc = sm_beta + 64; float* sm_rq = sm_gc + 64; float* sm_rk = sm_rq + 64;
  float* sm_fw = sm_rk + 64; float* sm_fq = sm_fw + 64; float* sm_fk = sm_fq + 64;
  const u16* h = (const u16*)(p.ws + OFF_H);
  const float* hb = (const float*)(p.ws + OFF_HB);
  unsigned char* op = p.ws + OFF_SC + (size_t)item * OPB;
  __syncthreads();
  float hb_bl, hb_al;
  {
    const int c2 = tid & 63, rbase = (tid >> 6) * 16;
    unsigned raw[3][19];
#pragma unroll
    for (int mat = 0; mat < 3; ++mat) {
      const int col = mat * 512 + hd * 128 + 2 * c2;
#pragma unroll
      for (int j = 0; j < 19; ++j) {
        const int rr = t0 + rbase - 3 + j;
        raw[mat][j] = *(const unsigned*)(h + (size_t)(rr < 0 ? 0 : rr) * NC + col);
      }
    }
    float2 cw[3][4];
#pragma unroll
    for (int mat = 0; mat < 3; ++mat)
#pragma unroll
      for (int j = 0; j < 4; ++j) cw[mat][j] = *(const float2*)(p.conv_w + j * 1536 + mat * 512 + hd * 128 + 2 * c2);
    hb_bl = hb[(size_t)(t0 + lane) * 8 + hd]; hb_al = hb[(size_t)(t0 + lane) * 8 + 4 + hd];
    __builtin_amdgcn_sched_barrier(0);
#pragma unroll
    for (int mat = 0; mat < 3; ++mat) {
      float wa[4], wb[4];
#pragma unroll
      for (int j = 0; j < 4; ++j) { wa[j] = cw[mat][j].x; wb[j] = cw[mat][j].y; }
      float xa[3], xb[3];
#pragma unroll
      for (int j = 0; j < 3; ++j) {
        const int pos = n * 64 + rbase - 3 + j;
        const unsigned v = (pos >= 0) ? raw[mat][j] : 0u;
        xa[j] = bf_lo(v); xb[j] = bf_hi(v);
      }
      u16* dst = (mat == 0 ? Qs : (mat == 1 ? Ks : Vs));
#pragma unroll
      for (int i = 0; i < 16; ++i) {
        const unsigned v = raw[mat][3 + i];
        const float a3 = bf_lo(v), b3 = bf_hi(v);
        const float ya = wa[0] * xa[0] + wa[1] * xa[1] + wa[2] * xa[2] + wa[3] * a3;
        const float yb = wb[0] * xb[0] + wb[1] * xb[1] + wb[2] * xb[2] + wb[3] * b3;
        xa[0] = xa[1]; xa[1] = xa[2]; xa[2] = a3; xb[0] = xb[1]; xb[1] = xb[2]; xb[2] = b3;
        *(unsigned*)(dst + (rbase + i) * 136 + 2 * c2) = pk_bf16(silu_f(ya), silu_f(yb));
      }
    }
  }
  __syncthreads();
  if (wv == 0) {
    const float bl = hb_bl, al = hb_al;
    const float xx = al + p.dt_bias[hd];
    const float ee = __expf(-fabsf(xx));
    const float sp = fmaxf(xx, 0.f) + ((ee < 1e-3f) ? ee * (1.f - 0.5f * ee) : __logf(1.f + ee));
    float gg = -__expf(p.a_log[hd]) * sp;
#pragma unroll
    for (int o = 1; o < 64; o <<= 1) { const float t = __uint_as_float((unsigned)__builtin_amdgcn_ds_bpermute(((lane - o) & 63) << 2, (int)__float_as_uint(gg))); if (lane >= o) gg += t; }
    sm_beta[lane] = rcp_f(1.0f + __expf(-bl)); sm_gc[lane] = gg;
  } else if (wv <= 2) {
    const int r = tid - 64;
    const u16* src = (r < 64) ? (Qs + r * 136) : (Ks + (r - 64) * 136);
    float ss = 0.f;
#pragma unroll
    for (int c = 0; c < 16; ++c) {
      const u32x4 v = *(const u32x4*)(src + c * 8);
#pragma unroll
      for (int j = 0; j < 4; ++j) { const float a = bf_lo(v[j]), bb = bf_hi(v[j]); ss += a * a + bb * bb; }
    }
    const float rs = rsqrtf(ss + 1e-6f);
    if (r < 64) sm_rq[r] = rs; else sm_rk[r - 64] = rs;
  }
  __syncthreads();
  if (tid < 64) {
    const float gc = sm_gc[tid], gl = sm_gc[63], eg = __expf(gc);
    sm_fw[tid] = sm_beta[tid] * eg * sm_rk[tid];
    sm_fq[tid] = sm_rq[tid] * 0.08838834764831845f * eg;
    sm_fk[tid] = sm_rk[tid] * __expf(gl - gc);
    if (tid == 0) ((float*)(p.ws + OFF_DEC))[item] = __expf(gl);
  }
  {
    bf16x8 kfi[4], qfi[4];
#pragma unroll
    for (int s = 0; s < 4; ++s) {
      kfi[s] = *(const bf16x8*)(Ks + (16 * wv + r16) * 136 + 32 * s + 8 * g);
      qfi[s] = *(const bf16x8*)(Qs + (16 * wv + r16) * 136 + 32 * s + 8 * g);
    }
    f32x4 at[4];
#pragma unroll
    for (int jt = 0; jt < 4; ++jt) {
      at[jt] = (f32x4){0.f, 0.f, 0.f, 0.f};
      if (jt <= wv) {
        f32x4 la = (f32x4){0.f, 0.f, 0.f, 0.f}, aa = (f32x4){0.f, 0.f, 0.f, 0.f};
#pragma unroll
        for (int s = 0; s < 4; ++s) {
          const bf16x8 kfj = *(const bf16x8*)(Ks + (16 * jt + r16) * 136 + 32 * s + 8 * g);
          la = mfma16(kfi[s], kfj, la);
          aa = mfma16(kfj, qfi[s], aa);
        }
#pragma unroll
        for (int r = 0; r < 4; ++r) {
          { const int i = 16 * wv + 4 * g + r, j = 16 * jt + r16;
            const float v = (i > j) ? sm_beta[i] * sm_rk[i] * sm_rk[j] * __expf(sm_gc[i] - sm_gc[j]) * la[r] : 0.f;
            Lm[i * 68 + j] = v; }
          { const int j = 16 * jt + 4 * g + r, i = 16 * wv + r16;
            at[jt][r] = (j <= i) ? sm_rq[i] * sm_rk[j] * 0.08838834764831845f * __expf(sm_gc[i] - sm_gc[j]) * aa[r] : 0.f; }
        }
      }
    }
#pragma unroll
    for (int s2 = 0; s2 < 2; ++s2)
      *(bf16x8*)(op + 32768 + (size_t)((wv * 2 + s2) * 64 + lane) * 16) = pack8(at[2 * s2], at[2 * s2 + 1]);
  }
  __syncthreads();
  f32x2_t xv[64];
  if (wv < 2) {
#pragma unroll
    for (int i = 0; i < 64; ++i) { xv[i].x = sm_beta[i] * bf2f(Vs[i * 136 + tid]); xv[i].y = sm_fw[i] * bf2f(Ks[i * 136 + tid]); }
    solve_rows2<1>(xv, Lm, lane, Lm[68 + lane]);
    const int sl = tid >> 4, dvl = tid & 15;
#pragma unroll
    for (int mt = 0; mt < 4; ++mt)
#pragma unroll
      for (int gg = 0; gg < 4; ++gg) {
        u32x2 w; w.x = pk_bf16(xv[16 * mt + 4 * gg].x, xv[16 * mt + 4 * gg + 1].x); w.y = pk_bf16(xv[16 * mt + 4 * gg + 2].x, xv[16 * mt + 4 * gg + 3].x);
        *(u32x2*)(op + 57344 + (size_t)((sl * 4 + mt) * 64 + gg * 16 + dvl) * 8) = w;
      }
  } else {
    const int t2 = tid - 128;
#pragma unroll 2
    for (int f = 0; f < 8; ++f) {
      const int e = t2 + 128 * f, frag = e >> 6, ln = e & 63, lr = ln & 15, lg = ln >> 4;
      {
        const int mt = frag >> 2, sx = frag & 3, row = 16 * mt + lr;
        const u32x2 ql = *(const u32x2*)(Qs + row * 136 + 32 * sx + 4 * lg), qh = *(const u32x2*)(Qs + row * 136 + 32 * sx + 16 + 4 * lg);
        const float fq = sm_fq[row];
        u32x4 w;
        w.x = pk_bf16(bf_lo(ql.x) * fq, bf_hi(ql.x) * fq); w.y = pk_bf16(bf_lo(ql.y) * fq, bf_hi(ql.y) * fq);
        w.z = pk_bf16(bf_lo(qh.x) * fq, bf_hi(qh.x) * fq); w.w = pk_bf16(bf_lo(qh.y) * fq, bf_hi(qh.y) * fq);
        *(u32x4*)(op + 16384 + (size_t)e * 16) = w;
      }
      {
        const int mt8 = frag >> 1, s2 = frag & 1, dk = 16 * mt8 + lr;
        float v[8];
#pragma unroll
        for (int j = 0; j < 8; ++j) {
          const int pos = 32 * s2 + 16 * (j >> 2) + 4 * lg + (j & 3);
          v[j] = bf2f(Ks[pos * 136 + dk]) * sm_fk[pos];
        }
        u32x4 w; w.x = pk_bf16(v[0], v[1]); w.y = pk_bf16(v[2], v[3]); w.z = pk_bf16(v[4], v[5]); w.w = pk_bf16(v[6], v[7]);
        *(u32x4*)(op + 40960 + (size_t)e * 16) = w;
      }
    }
  }
  __syncthreads();
  if (wv < 2) {
#pragma unroll
    for (int i = 0; i < 64; ++i) Vs[i * 136 + tid] = f2bf(-xv[i].y);
  }
  __syncthreads();
#pragma unroll
  for (int f = 0; f < 4; ++f) {
    const int e = tid + 256 * f, frag = e >> 6, ln = e & 63, lr = ln & 15, lg = ln >> 4;
    const int mt = frag >> 2, sx = frag & 3, row = 16 * mt + lr;
    const u32x2 lo = *(const u32x2*)(Vs + row * 136 + 32 * sx + 4 * lg), hi = *(const u32x2*)(Vs + row * 136 + 32 * sx + 16 + 4 * lg);
    *(u32x4*)(op + (size_t)e * 16) = (u32x4){lo.x, lo.y, hi.x, hi.y};
  }
}

struct ScanA { u32x4 wf[4]; };
struct ScanB { u32x4 qf[4], af[2], kf[4]; };

DI void scan_load_a(const Params& p, int wvs, ScanA& o, int b, int hd, int sl, int n, int q, int lane) {
  const int item = (b * 128 + n) * 4 + hd;
  const unsigned char* op = p.ws + OFF_SC + (size_t)item * OPB;
#pragma unroll
  for (int s = 0; s < 4; ++s) {
    o.wf[s] = *(const u32x4*)(op + (size_t)((q * 4 + s) * 64 + lane) * 16);
  }
}
DI void scan_load_b(const Params& p, int wvs, ScanB& o, int b, int hd, int sl, int n, int q, int lane) {
  const int item = (b * 128 + n) * 4 + hd;

  const unsigned char* op = p.ws + OFF_SC + (size_t)item * OPB;
#pragma unroll
  for (int s = 0; s < 4; ++s) o.qf[s] = *(const u32x4*)(op + 16384 + (size_t)((q * 4 + s) * 64 + lane) * 16);
#pragma unroll
  for (int s2 = 0; s2 < 2; ++s2) o.af[s2] = *(const u32x4*)(op + 32768 + (size_t)((q * 2 + s2) * 64 + lane) * 16);
#pragma unroll
  for (int j = 0; j < 4; ++j) o.kf[j] = *(const u32x4*)(op + 40960 + (size_t)((q * 4 + j) * 64 + lane) * 16);
}

DI void scan_step(const Params& p, int wvs, const ScanA& o, const ScanB& ob, f32x4 (&S)[2], int b, int hd, int sl, int n, int q, int lane, unsigned char* smem) {
  const int r16 = lane & 15, g = lane >> 4;
  u32x4* ldsS = (u32x4*)smem;
  u32x2* ldsV = (u32x2*)(smem + 4096);
  ldsS[q * 64 + lane] = __builtin_bit_cast(u32x4, pack8(S[0], S[1]));
  __syncthreads();
  bf16x8 Sb[4];
#pragma unroll
  for (int s = 0; s < 4; ++s) Sb[s] = as_bf8(ldsS[s * 64 + lane]);
  const unsigned char* ring = smem + 8192 + (n % 3) * 6400;
  const u32x2 uf = *(const u32x2*)(ring + 4096 + (q * 64 + lane) * 8);
  f32x4 vn = (f32x4){bf_lo(uf.x), bf_hi(uf.x), bf_lo(uf.y), bf_hi(uf.y)};
#pragma unroll
  for (int s = 0; s < 4; ++s) vn = mfma16(as_bf8(o.wf[s]), Sb[s], vn);
  { u32x2 w; w.x = pk_bf16(vn[0], vn[1]); w.y = pk_bf16(vn[2], vn[3]); ldsV[((q >> 1) * 64 + lane) * 2 + (q & 1)] = w; }
  f32x4 oa = (f32x4){0.f, 0.f, 0.f, 0.f};
#pragma unroll
  for (int s = 0; s < 4; ++s) oa = mfma16(as_bf8(ob.qf[s]), Sb[s], oa);
  __syncthreads();
  bf16x8 Vb[2];
#pragma unroll
  for (int s2 = 0; s2 < 2; ++s2) Vb[s2] = as_bf8(*(const u32x4*)(ldsV + (s2 * 64 + lane) * 2));
#pragma unroll
  for (int s2 = 0; s2 < 2; ++s2) oa = mfma16(as_bf8(ob.af[s2]), Vb[s2], oa);
  u16* h = (u16*)(p.ws + OFF_H);
  const int t0 = b * SEQ + n * 64;
  *(f32x4*)(smem + 8192 + (n % 3) * 6400 + (q * 64 + lane) * 16) = oa;
  const float dec_ = *(const float*)(ring + 6144);
#pragma unroll
  for (int t = 0; t < 2; ++t) {
    S[t] = S[t] * dec_;
#pragma unroll
    for (int s2 = 0; s2 < 2; ++s2) S[t] = mfma16(as_bf8(ob.kf[t * 2 + s2]), Vb[s2], S[t]);
  }
}

DI void scan_chain(const Params& p, int wvs, int pair, int sl, unsigned char* smem) {
  const int tid0 = opaque_tid(); const int lane = tid0 & 63, q = tid0 >> 6;
  const int b = pair >> 2, hd = pair & 3;
  f32x4 S[2]; S[0] = (f32x4){0.f, 0.f, 0.f, 0.f}; S[1] = S[0];
  ScanA a0, a1, a2; ScanB b0, b1;
  __builtin_amdgcn_s_setprio(3);
  __syncthreads();
  scan_load_a(p, wvs, a0, b, hd, sl, 0, q, lane);
  scan_load_b(p, wvs, b0, b, hd, sl, 0, q, lane);
  scan_load_a(p, wvs, a1, b, hd, sl, 1, q, lane);
#define SC_ITER(k_, AC, AL, BC, BL) do { \
    if (n + (k_) + 2 < 128) scan_load_a(p, wvs, AL, b, hd, sl, n + (k_) + 2, q, lane); \
    if (n + (k_) + 1 < 128) scan_load_b(p, wvs, BL, b, hd, sl, n + (k_) + 1, q, lane); \
    if (n + (k_) < 128) scan_step(p, wvs, AC, BC, S, b, hd, sl, n + (k_), q, lane, smem); } while (0)
#pragma unroll 1
  for (int n = 0; n < 128; n += 6) {
    SC_ITER(0, a0, a2, b0, b1); SC_ITER(1, a1, a0, b1, b0); SC_ITER(2, a2, a1, b0, b1);
    SC_ITER(3, a0, a2, b1, b0); SC_ITER(4, a1, a0, b0, b1); SC_ITER(5, a2, a1, b1, b0);
  }
#undef SC_ITER
  __syncthreads();
  __builtin_amdgcn_s_setprio(0);
}

DI void swa_item(const Params& p, int wvs, int item, bool valid, unsigned char* smem) {
  if (!valid) { __syncthreads(); __syncthreads(); return; }
  const int tid_ = opaque_tid();
  const int tid = tid_, lane = tid & 63, wv = tid >> 6, r16 = lane & 15, g = lane >> 4;
  const int qt = item & 127, kvh = (item >> 7) & 1, b = item >> 8;
  const int kp0 = 64 * qt - 128;
  u16* Ksm = (u16*)smem;
  u16* Vt = (u16*)(smem + 27648);
  u16* h = (u16*)(p.ws + OFF_H);
  const float* rc = (const float*)(p.ws + OFF_ROPE); const float* rs = rc + 8192 * 8;
  __syncthreads();
  if (tid < 192) {
    const int kk = tid, pos = kp0 + kk;
    u32x4 lo = (u32x4){0, 0, 0, 0}, hi = lo;
    if (pos >= 0) {
      const u16* src = h + (size_t)(b * SEQ + pos) * NC + C_SWK + kvh * 64;
      const u32x4 a = *(const u32x4*)src, c = *(const u32x4*)(src + 8);
      const f32x4 c0 = *(const f32x4*)(rc + pos * 8), c1 = *(const f32x4*)(rc + pos * 8 + 4);
      const f32x4 s0 = *(const f32x4*)(rs + pos * 8), s1 = *(const f32x4*)(rs + pos * 8 + 4);
      float t1[8], t2[8], cs[8], sn[8], o1[8], o2[8];
#pragma unroll
      for (int j = 0; j < 4; ++j) { t1[2 * j] = bf_lo(a[j]); t1[2 * j + 1] = bf_hi(a[j]); t2[2 * j] = bf_lo(c[j]); t2[2 * j + 1] = bf_hi(c[j]);
        cs[j] = c0[j]; cs[4 + j] = c1[j]; sn[j] = s0[j]; sn[4 + j] = s1[j]; }
#pragma unroll
      for (int j = 0; j < 8; ++j) { o1[j] = t1[j] * cs[j] - t2[j] * sn[j]; o2[j] = t2[j] * cs[j] + t1[j] * sn[j]; }
#pragma unroll
      for (int j = 0; j < 4; ++j) { lo[j] = pk_bf16(o1[2 * j], o1[2 * j + 1]); hi[j] = pk_bf16(o2[2 * j], o2[2 * j + 1]); }
    }
    *(u32x4*)(Ksm + kk * 72) = lo; *(u32x4*)(Ksm + kk * 72 + 8) = hi;
  }
  for (int e = tid; e < 192 * 6; e += 256) {
    const int kk = e / 6, ch = 2 + e % 6, pos = kp0 + kk;
    u32x4 v = (u32x4){0, 0, 0, 0};
    if (pos >= 0) v = *(const u32x4*)(h + (size_t)(b * SEQ + pos) * NC + C_SWK + kvh * 64 + ch * 8);
    *(u32x4*)(Ksm + kk * 72 + ch * 8) = v;
  }
  for (int e = tid; e < 192 * 8; e += 256) {
    const int kk = e >> 3, ch = e & 7, pos = kp0 + kk;
    u32x4 v = (u32x4){0, 0, 0, 0};
    if (pos >= 0) v = *(const u32x4*)(h + (size_t)(b * SEQ + pos) * NC + C_SWV + kvh * 64 + ch * 8);
#pragma unroll
    for (int j = 0; j < 4; ++j) { Vt[(ch * 8 + 2 * j) * 200 + kk] = (u16)(v[j] & 0xffffu); Vt[(ch * 8 + 2 * j + 1) * 200 + kk] = (u16)(v[j] >> 16); }
  }
  __syncthreads();
  const int st = wv, jt0 = st < 2 ? st : 2;
  const int qi = 16 * st + r16;
  const int qpos = 64 * qt + qi, tq = b * SEQ + qpos;
#pragma unroll 1
  for (int hq = 0; hq < 4; ++hq) {
    const int head = kvh * 4 + hq;
    u16* qsrc = h + (size_t)tq * NC + C_SWQ + head * 64;
    bf16x8 qf[2];
    {
      const u32x4 a = *(const u32x4*)qsrc, c = *(const u32x4*)(qsrc + 8);
      u32x4 w = *(const u32x4*)(qsrc + 8 * g);
      if (g < 2) {
        const f32x4 c0 = *(const f32x4*)(rc + qpos * 8), c1 = *(const f32x4*)(rc + qpos * 8 + 4);
        const f32x4 s0 = *(const f32x4*)(rs + qpos * 8), s1 = *(const f32x4*)(rs + qpos * 8 + 4);
        float t1[8], t2[8], cs[8], sn[8], o[8];
#pragma unroll
        for (int j = 0; j < 4; ++j) { t1[2 * j] = bf_lo(a[j]); t1[2 * j + 1] = bf_hi(a[j]); t2[2 * j] = bf_lo(c[j]); t2[2 * j + 1] = bf_hi(c[j]);
          cs[j] = c0[j]; cs[4 + j] = c1[j]; sn[j] = s0[j]; sn[4 + j] = s1[j]; }
#pragma unroll
        for (int j = 0; j < 8; ++j) o[j] = (g == 0) ? (t1[j] * cs[j] - t2[j] * sn[j]) : (t2[j] * cs[j] + t1[j] * sn[j]);
#pragma unroll
        for (int j = 0; j < 4; ++j) w[j] = pk_bf16(o[2 * j], o[2 * j + 1]);
      }
      qf[0] = as_bf8(w);
      qf[1] = as_bf8(*(const u32x4*)(qsrc + 32 + 8 * g));
    }
    f32x4 sc[10];
#pragma unroll
    for (int t = 0; t < 10; ++t) {
      sc[t] = (f32x4){0.f, 0.f, 0.f, 0.f};
#pragma unroll
      for (int s = 0; s < 2; ++s) {
        const bf16x8 kf = *(const bf16x8*)(Ksm + (16 * (jt0 + t) + r16) * 72 + 32 * s + 8 * g);
        sc[t] = mfma16(kf, qf[s], sc[t]);
      }
    }
    const float sink = p.sinks[head];
    float mx = sink;
#pragma unroll
    for (int t = 0; t < 10; ++t)
#pragma unroll
      for (int r = 0; r < 4; ++r) {
        const int kk = 16 * (jt0 + t) + 4 * g + r, d = kk - qi;
        const bool ok = (d >= 1) && (d <= 128) && (kp0 + kk >= 0);
        const float v = ok ? sc[t][r] * 0.125f : -1e30f;
        sc[t][r] = v; mx = fmaxf(mx, v);
      }
    mx = fmaxf(mx, shx(mx, 16, lane)); mx = fmaxf(mx, shx(mx, 32, lane));
    float sum = 0.f;
#pragma unroll
    for (int t = 0; t < 10; ++t)
#pragma unroll
      for (int r = 0; r < 4; ++r) { const float e = __expf(sc[t][r] - mx); sc[t][r] = e; sum += e; }
    sum += shx(sum, 16, lane); sum += shx(sum, 32, lane);
    const float inv = rcp_f(sum + __expf(sink - mx));
    f32x4 oacc[4];
#pragma unroll
    for (int dt = 0; dt < 4; ++dt) oacc[dt] = (f32x4){0.f, 0.f, 0.f, 0.f};
#pragma unroll
    for (int s2 = 0; s2 < 5; ++s2) {
      const bf16x8 pb = pack8(sc[2 * s2], sc[2 * s2 + 1]);
#pragma unroll
      for (int dt = 0; dt < 4; ++dt) {
        const u16* vr = Vt + (16 * dt + r16) * 200 + 16 * (jt0 + 2 * s2) + 4 * g;
        const u32x2 lo = *(const u32x2*)vr, hi = *(const u32x2*)(vr + 16);
        oacc[dt] = mfma16(as_bf8((u32x4){lo.x, lo.y, hi.x, hi.y}), pb, oacc[dt]);
      }
    }
#pragma unroll
    for (int dt = 0; dt < 4; ++dt) {
      const int dcol = head * 64 + 16 * dt + 4 * g;
      const u32x2 z = *(const u32x2*)(h + (size_t)tq * NC + C_SWZ + dcol);
      u32x2 w;
      w.x = pk_bf16(oacc[dt][0] * inv * silu_f(bf_lo(z.x)), oacc[dt][1] * inv * silu_f(bf_hi(z.x)));
      w.y = pk_bf16(oacc[dt][2] * inv * silu_f(bf_lo(z.y)), oacc[dt][3] * inv * silu_f(bf_hi(z.y)));
      *(u32x2*)(h + (size_t)tq * NC + C_SWQ + dcol) = w;
    }
  }
}

DI void phase_ya(const Params& p, int wvs) {
  u16* h = (u16*)(p.ws + OFF_H);
  const int ltid = opaque_tid(), lane = ltid & 63;
  const size_t gt = (size_t)blockIdx.x * 512 + ltid, gs = (size_t)gridDim.x * 512;
  const float* nwp = p.dn_norm_w + (ltid & 15) * 8;
  const f32x4 nw0 = *(const f32x4*)nwp, nw1 = *(const f32x4*)(nwp + 4);
  for (size_t i0 = gt; i0 < (size_t)T_TOK * 64; i0 += 4 * gs) {
    u32x4 v[4], z[4];
#pragma unroll
    for (int k = 0; k < 4; ++k) {
      const size_t i = i0 + k * gs;
      if (i < (size_t)T_TOK * 64) {
        const u16* ptr = h + (size_t)(i >> 6) * NC + (i & 63) * 8;
        v[k] = *(const u32x4*)ptr; z[k] = *(const u32x4*)(ptr + C_DNZ);
      } else { v[k] = (u32x4){0, 0, 0, 0}; z[k] = v[k]; }
    }
#pragma unroll
    for (int k = 0; k < 4; ++k) {
      const size_t i = i0 + k * gs;
      float o[8]; float ss = 0.f;
#pragma unroll
      for (int j = 0; j < 4; ++j) { o[2 * j] = bf_lo(v[k][j]); o[2 * j + 1] = bf_hi(v[k][j]); }
#pragma unroll
      for (int j = 0; j < 8; ++j) ss += o[j] * o[j];
      ss += shx(ss, 1, lane); ss += shx(ss, 2, lane); ss += shx(ss, 4, lane); ss += shx(ss, 8, lane);
      const float rs = rsqrtf(ss * (1.0f / 128.0f) + 1e-6f);
      float y[8];
#pragma unroll
      for (int j = 0; j < 4; ++j) {
        const float w0 = (j < 2) ? nw0[2 * j] : nw1[2 * j - 4], w1 = (j < 2) ? nw0[2 * j + 1] : nw1[2 * j - 3];
        y[2 * j] = o[2 * j] * rs * w0 * silu_f(bf_lo(z[k][j]));
        y[2 * j + 1] = o[2 * j + 1] * rs * w1 * silu_f(bf_hi(z[k][j]));
      }
      u32x4 w; w.x = pk_bf16(y[0], y[1]); w.y = pk_bf16(y[2], y[3]); w.z = pk_bf16(y[4], y[5]); w.w = pk_bf16(y[6], y[7]);
      if (i < (size_t)T_TOK * 64) *(u32x4*)(h + (size_t)(i >> 6) * NC + (i & 63) * 8) = w;
    }
  }
}

DI float wave_sum(float v, int lane) {
#pragma unroll
  for (int o = 32; o > 0; o >>= 1) v += shx(v, o, lane);
  return v;
}
DI void phase6(const Params& p, int wvs, unsigned char* smem) {
  const int tid = opaque_tid(), lane = tid & 63, wv = tid >> 6;
  f32x4 gm[4], bt[4];
#pragma unroll
  for (int j = 0; j < 4; ++j) { gm[j] = *(const f32x4*)(p.ln_g + 4 * (lane + 64 * j)); bt[j] = *(const f32x4*)(p.ln_b + 4 * (lane + 64 * j)); }
  const int xcd6 = blockIdx.x & 7, lb6 = blockIdx.x >> 3, nlb6 = gridDim.x >> 3;
  for (int lr = (lb6 * 8 + wv) * 2; lr < 4096; lr += nlb6 * 16) {
    const int row0 = 4096 * xcd6 + (4095 - lr), row1 = row0 - 1;
    float* r0 = p.out + (size_t)row0 * 1024;
    float* r1 = p.out + (size_t)row1 * 1024;
    const _Float16* s0 = (const _Float16*)(p.ws + OFF_H) + (size_t)row0 * 1024;
    const _Float16* s1 = (const _Float16*)(p.ws + OFF_H) + (size_t)row1 * 1024;
    f32x4 a[4], b[4];
#pragma unroll
    for (int j = 0; j < 4; ++j) {
      a[j] = __builtin_convertvector(*(const f16x4*)(s0 + 4 * (lane + 64 * j)), f32x4);
      b[j] = __builtin_convertvector(*(const f16x4*)(s1 + 4 * (lane + 64 * j)), f32x4);
    }
    float sa = 0.f, sb = 0.f;
#pragma unroll
    for (int j = 0; j < 4; ++j) { sa += (a[j][0] + a[j][1]) + (a[j][2] + a[j][3]); sb += (b[j][0] + b[j][1]) + (b[j][2] + b[j][3]); }
    const float ma = wave_sum(sa, lane) * (1.0f / 1024.0f), mb = wave_sum(sb, lane) * (1.0f / 1024.0f);
    float qa = 0.f, qb = 0.f;
#pragma unroll
    for (int j = 0; j < 4; ++j) {
      a[j] = a[j] - ma; b[j] = b[j] - mb;
      qa += (a[j][0] * a[j][0] + a[j][1] * a[j][1]) + (a[j][2] * a[j][2] + a[j][3] * a[j][3]);
      qb += (b[j][0] * b[j][0] + b[j][1] * b[j][1]) + (b[j][2] * b[j][2] + b[j][3] * b[j][3]);
    }
    const float ra = rsqrtf(wave_sum(qa, lane) * (1.0f / 1024.0f) + 1e-5f), rb = rsqrtf(wave_sum(qb, lane) * (1.0f / 1024.0f) + 1e-5f);
#pragma unroll
    for (int j = 0; j < 4; ++j) {
      *(f32x4*)(r0 + 4 * (lane + 64 * j)) = a[j] * ra * gm[j] + bt[j];
      *(f32x4*)(r1 + 4 * (lane + 64 * j)) = b[j] * rb * gm[j] + bt[j];
    }
  }
}

#define XB_TMO      128
#define XB_XCNT(j)  (256  + 64 * (j))
#define XB_XSUB(j)  (1280 + 64 * (j))
#define XB_XGEN(j)  (2304 + 64 * (j))
#define XB_TOP      3328
#define XB_TOPGEN   3392
#define XCD_BAR_WORDS 3456
#define XB_SPIN_CAP (1u << 22)
#define LAS __attribute__((address_space(3)))
DI unsigned xb_ld(unsigned* p) { return __hip_atomic_load(p, __ATOMIC_RELAXED, __HIP_MEMORY_SCOPE_AGENT); }
DI unsigned xb_add(unsigned* p, unsigned v) { return __hip_atomic_fetch_add(p, v, __ATOMIC_RELAXED, __HIP_MEMORY_SCOPE_AGENT); }
DI unsigned xb_xcc_id() { return (unsigned)__builtin_amdgcn_s_getreg((3 << 11) | 20) & 0xFu; }
#define XB_SPIN(cond, bar) do { unsigned _sp = 0; while (cond) { __builtin_amdgcn_s_sleep(1); \
    if ((++_sp & 255u) == 0u) { if (xb_ld(&(bar)[XB_TMO])) break; if (_sp > XB_SPIN_CAP) { atomicAdd(&(bar)[XB_TMO], 1u); break; } } } } while (0)
struct XcdBarrier { unsigned* bar; unsigned x; volatile LAS unsigned* st; };
DI bool xb_leader(int wvs) { return wvs == 0 && __builtin_amdgcn_mbcnt_hi(~0u, __builtin_amdgcn_mbcnt_lo(~0u, 0u)) == 0u; }
DI XcdBarrier xcd_barrier_post(unsigned* bar, volatile LAS unsigned* st, int wvs) {
  XcdBarrier b; b.bar = bar; b.x = xb_xcc_id(); b.st = st;
  if (xb_leader(wvs)) (void)xb_add(&bar[XB_XCNT(b.x)], 1u);
  return b;
}
DI void xcd_barrier_complete(unsigned* bar, unsigned x, unsigned& nloc, unsigned& nx) {
  const unsigned G = gridDim.x * gridDim.y * gridDim.z;
  unsigned sum, cnt, mine, sp = 0u;
  for (;;) {
    sum = 0u; cnt = 0u; mine = 0u;
#pragma unroll
    for (unsigned j = 0; j < 16; ++j) { const unsigned c = xb_ld(&bar[XB_XCNT(j)]); sum += c; cnt += (c > 0u) ? 1u : 0u; mine = (j == x) ? c : mine; }
    if (sum == G) break;
    __builtin_amdgcn_s_sleep(1);
    if ((++sp & 255u) == 0u) { if (xb_ld(&bar[XB_TMO])) break; if (sp > XB_SPIN_CAP) { atomicAdd(&bar[XB_TMO], 1u); break; } }
  }
  nloc = mine > 0u ? mine : 1u; nx = cnt > 0u ? cnt : 1u;
}
DI void xcd_barrier_(const XcdBarrier& b, int wvs) {
  asm volatile("s_waitcnt vmcnt(0)" ::: "memory");
  __syncthreads();
  if (xb_leader(wvs)) {
    unsigned* bar = b.bar;
    __builtin_amdgcn_s_waitcnt(0);
    unsigned nloc = b.st[0], nx = b.st[1];
    if (nloc == 0u) { xcd_barrier_complete(bar, b.x, nloc, nx); b.st[0] = nloc; b.st[1] = nx; }
    const unsigned old = xb_add(&bar[XB_XSUB(b.x)], 1u);
    const unsigned gen = old / nloc;
    if (old + 1u == (gen + 1u) * nloc) {
      __builtin_amdgcn_fence(__ATOMIC_RELEASE, "agent");
      asm volatile("s_waitcnt vmcnt(0)" ::: "memory");
      const unsigned og = xb_add(&bar[XB_TOP], 1u);
      const unsigned tg = og / nx;
      if (og + 1u == (tg + 1u) * nx) xb_add(&bar[XB_TOPGEN], 1u);
      else XB_SPIN(xb_ld(&bar[XB_TOPGEN]) == tg, bar);
      __builtin_amdgcn_fence(__ATOMIC_ACQUIRE, "agent");
      xb_add(&bar[XB_XGEN(b.x)], 1u);
      asm volatile("s_waitcnt vmcnt(0)" ::: "memory");
    } else {
      XB_SPIN(xb_ld(&bar[XB_XGEN(b.x)]) == gen, bar);
      __builtin_amdgcn_fence(__ATOMIC_ACQUIRE, "agent");
      asm volatile("s_waitcnt vmcnt(0)" ::: "memory");
    }
  }
  __syncthreads();
}

#define xcd_barrier(b) xcd_barrier_(b, w8)
namespace pg8 {
#define PG8_LAS __attribute__((address_space(3)))
typedef unsigned short bf16_t;
typedef short bf16x8 __attribute__((ext_vector_type(8)));
typedef float f32x4 __attribute__((ext_vector_type(4)));
typedef unsigned u32x4 __attribute__((ext_vector_type(4)));
constexpr int BM = 256, BK = 64, HALF = 128, HTB = HALF * BK * 2  , STAGE_BYTES = 8 * HTB, NXCD = 8, WGM = 8;

__host__ __device__ __forceinline__ int lds_byte(int r, int c) { const int st = (r >> 4) * 2 + (c >> 5), rr = r & 15, cc = c & 31, ob = rr * 64 + cc * 2; return st * 1024 + (ob ^ (((ob >> 9) & 1) << 5)); }
__host__ __device__ __forceinline__ void stage_rc(int b, int& R, int& C) { const int st = b / 1024, sb = b % 1024, swz = sb ^ (((sb >> 9) & 1) << 5); R = (st >> 1) * 16 + swz / 64; C = (st & 1) * 32 + (swz % 64) / 2; }
__host__ __device__ __forceinline__ int perm32(int rho) { const int n = rho >> 4, i = rho & 15; return 8 * (i >> 2) + 4 * n + (i & 3); }

struct Unit { int pm, pn; };
struct Gemm { const bf16_t* A; const bf16_t* Bt; int M, N, K; };

struct StaticOrder {
    int nM, nN, nwg, G, c;
    __host__ __device__ void init(int M, int N, int G_, int c_) { nM = M / BM; nN = N / BM; nwg = nM * nN; G = G_; c = c_; }
    __host__ __device__ bool next(int i, Unit& u) const {
        const long L = (long)i * G + c; if (L >= nwg) return false;
        int wgid = (int)L; { const int q = nwg / NXCD, r = nwg % NXCD, xcd = wgid % NXCD, off = wgid / NXCD; wgid = (xcd < r ? xcd * (q + 1) : r * (q + 1) + (xcd - r) * q) + off; }
        const int nig = WGM * nN, gid = wgid / nig, fm = gid * WGM, gsz = (nM - fm) < WGM ? (nM - fm) : WGM;
        u.pm = fm + ((wgid % nig) % gsz); u.pn = (wgid % nig) / gsz; return true;
    }
    __device__ __forceinline__ void a_ready(const Unit&) const {}
    __device__ __forceinline__ void done(const Unit&) const {}
};

template <class Epi, class Sched, bool ALIGN_EPI = false, bool SP2 = false>
__device__ __forceinline__ void gemm_phase(PG8_LAS unsigned char* lds, const Gemm g, const Sched& S, const Epi& E, const int tid) {
    const int wid = __builtin_amdgcn_readfirstlane(tid >> 6), lane = tid & 63, wr = wid >> 2, wc = wid & 3, fr = lane & 15, fq = lane >> 4;
    const int K = g.K, nt = K / BK;
    unsigned voffA[2], voffB[2];
#pragma unroll
    for (int i = 0; i < 2; ++i) { int R, C; stage_rc(tid * 16 + i * 8192, R, C); const int Rb = Epi::PERM ? ((R & ~31) + perm32(R & 31)) : R;
        voffA[i] = (unsigned)(R * K + C) * 2u; voffB[i] = (unsigned)(Rb * K + C) * 2u; }
    const size_t kstep = (size_t)(BK * 2);
    const size_t hstep = (size_t)HALF * K * 2;
    const size_t tstep = 2 * hstep;
    const unsigned ldsw = (unsigned)wid * 1024u;
    const int aoff = lds_byte(wr * 64 + fr, fq * 8), boff = lds_byte(wc * 32 + fr, fq * 8);
#define PG8_SA(b, h) (((b) * 2 + (h)) * HTB)
#define PG8_SB(b, h) ((4 + (b) * 2 + (h)) * HTB)
#define PG8_STAGE(bufoff, gbase, voff) do { _Pragma("unroll") for (int _i = 0; _i < 2; ++_i) \
        __builtin_amdgcn_global_load_lds((const unsigned*)((const char*)(gbase) + (voff)[_i]), (PG8_LAS unsigned*)(lds + (bufoff) + ldsw + _i * 8192), 16, 0, 0); } while (0)
#define PG8_LDA(dst, b, h) do { _Pragma("unroll") for (int m = 0; m < 4; ++m) _Pragma("unroll") for (int k = 0; k < 2; ++k) dst[m][k] = *(const PG8_LAS bf16x8*)(lds + PG8_SA(b, h) + aoff + m * 2048 + k * 1024); } while (0)
#define PG8_LDB(dst, b, h) do { _Pragma("unroll") for (int n = 0; n < 2; ++n) _Pragma("unroll") for (int k = 0; k < 2; ++k) dst[n][k] = *(const PG8_LAS bf16x8*)(lds + PG8_SB(b, h) + boff + n * 2048 + k * 1024); } while (0)
#define PG8_MMA(ai, bj, At, Bt) do { __builtin_amdgcn_s_setprio(1); _Pragma("unroll") for (int m = 0; m < 4; ++m) _Pragma("unroll") for (int n = 0; n < 2; ++n) _Pragma("unroll") for (int k = 0; k < 2; ++k) \
        acc[ai][bj][m][n] = __builtin_amdgcn_mfma_f32_16x16x32_bf16(Bt[n][k], At[m][k], acc[ai][bj][m][n], 0, 0, 0); __builtin_amdgcn_s_setprio(0); } while (0)
#define PG8_WAIT_V(n) asm volatile("s_waitcnt vmcnt(" #n ")" ::: "memory")
#define PG8_WAIT_L(n) asm volatile("s_waitcnt lgkmcnt(" #n ")" ::: "memory")
#define PG8_BAR __builtin_amdgcn_s_barrier()
#define PG8_SCHED __builtin_amdgcn_sched_barrier(0)
    Unit cur, nxt; int ui = 0;
    if (!S.next(0, cur)) return;
    f32x4 acc[2][2][4][2];
#pragma unroll
    for (int a = 0; a < 2; ++a)
#pragma unroll
        for (int b = 0; b < 2; ++b)
#pragma unroll
            for (int m = 0; m < 4; ++m)
#pragma unroll
                for (int n = 0; n < 2; ++n) acc[a][b][m][n] = (f32x4){0.f, 0.f, 0.f, 0.f};
    bf16x8 At[4][2], B0[2][2], B1[2][2];
    const char* cA = (const char*)g.A + (size_t)cur.pm * tstep; const char* cB = (const char*)g.Bt + (size_t)cur.pn * tstep;
    S.a_ready(cur);
    if constexpr (SP2) {
        PG8_STAGE(PG8_SB(0, 0), cB, voffB); PG8_STAGE(PG8_SB(0, 1), cB + hstep, voffB); PG8_STAGE(PG8_SA(0, 0), cA, voffA); PG8_STAGE(PG8_SA(0, 1), cA + hstep, voffA);
        if (wr == 1) PG8_BAR;
        PG8_WAIT_V(2); PG8_BAR;
        PG8_STAGE(PG8_SB(1, 0), cB + kstep, voffB); PG8_STAGE(PG8_SA(1, 0), cA + kstep, voffA); PG8_STAGE(PG8_SB(1, 1), cB + hstep + kstep, voffB);
        PG8_WAIT_V(6); PG8_BAR;
    } else {
        PG8_STAGE(PG8_SB(0, 0), cB, voffB); PG8_STAGE(PG8_SA(0, 0), cA, voffA); PG8_STAGE(PG8_SB(0, 1), cB + hstep, voffB); PG8_STAGE(PG8_SA(0, 1), cA + hstep, voffA);
        if (wr == 1) PG8_BAR;
        PG8_WAIT_V(4); PG8_BAR;
        PG8_STAGE(PG8_SB(1, 0), cB + kstep, voffB); PG8_STAGE(PG8_SA(1, 0), cA + kstep, voffA); PG8_STAGE(PG8_SB(1, 1), cB + hstep + kstep, voffB);
        PG8_WAIT_V(6); PG8_BAR;
    }
    for (;;) {
        const bool has_next = S.next(ui + 1, nxt);
        const char* nA = has_next ? (const char*)g.A + (size_t)nxt.pm * tstep : cA; const char* nB = has_next ? (const char*)g.Bt + (size_t)nxt.pn * tstep : cB;
        for (int t = 0; t < nt; t += 2) {
            const bool last = (t == nt - 2);
            const char* a1 = cA + (size_t)(t + 1) * kstep;
            const char* a2 = last ? nA : cA + (size_t)(t + 2) * kstep; const char* b2 = last ? nB : cB + (size_t)(t + 2) * kstep;
            const char* a3 = a2 + kstep; const char* b3 = b2 + kstep;
            if (last && has_next) S.a_ready(nxt);
            if constexpr (SP2) {
            PG8_LDB(B0, 0, 0); PG8_LDB(B1, 0, 1); PG8_SCHED; PG8_LDA(At, 0, 0); PG8_STAGE(PG8_SA(1, 1), a1 + hstep, voffA);
            PG8_WAIT_V(8); PG8_WAIT_L(0); PG8_BAR; PG8_MMA(0, 0, At, B0); PG8_MMA(0, 1, At, B1); PG8_BAR; PG8_SCHED;
            PG8_LDA(At, 0, 1); PG8_STAGE(PG8_SB(0, 0), b2, voffB); PG8_STAGE(PG8_SB(0, 1), b2 + hstep, voffB); PG8_STAGE(PG8_SA(0, 0), a2, voffA);
            PG8_WAIT_V(8); PG8_WAIT_L(0); PG8_BAR; PG8_MMA(1, 0, At, B0); PG8_MMA(1, 1, At, B1); PG8_BAR; PG8_SCHED;
            PG8_LDB(B0, 1, 0); PG8_LDB(B1, 1, 1); PG8_SCHED; PG8_LDA(At, 1, 0); PG8_STAGE(PG8_SA(0, 1), a2 + hstep, voffA);
            PG8_WAIT_V(8); PG8_WAIT_L(0); PG8_BAR; PG8_MMA(0, 0, At, B0); PG8_MMA(0, 1, At, B1); PG8_BAR; PG8_SCHED;
            PG8_LDA(At, 1, 1); PG8_STAGE(PG8_SB(1, 0), b3, voffB); PG8_STAGE(PG8_SB(1, 1), b3 + hstep, voffB); PG8_STAGE(PG8_SA(1, 0), a3, voffA);
            PG8_WAIT_V(8); PG8_WAIT_L(0); PG8_BAR; PG8_MMA(1, 0, At, B0); PG8_MMA(1, 1, At, B1); PG8_BAR; PG8_SCHED;
            } else {
            PG8_LDB(B0, 0, 0); PG8_SCHED; PG8_LDA(At, 0, 0); PG8_STAGE(PG8_SA(1, 1), a1 + hstep, voffA);
            PG8_WAIT_L(8); PG8_BAR; PG8_WAIT_L(0); PG8_MMA(0, 0, At, B0); PG8_BAR; PG8_SCHED;
            PG8_LDB(B1, 0, 1); PG8_STAGE(PG8_SB(0, 0), b2, voffB);
            PG8_BAR; PG8_WAIT_L(0); PG8_MMA(0, 1, At, B1); PG8_BAR;
            PG8_LDA(At, 0, 1); PG8_STAGE(PG8_SA(0, 0), a2, voffA);
            PG8_BAR; PG8_WAIT_L(0); PG8_MMA(1, 0, At, B0); PG8_BAR; PG8_SCHED;
            PG8_STAGE(PG8_SB(0, 1), b2 + hstep, voffB);
            PG8_WAIT_V(6); PG8_BAR; PG8_MMA(1, 1, At, B1); PG8_BAR;
            PG8_LDB(B0, 1, 0); PG8_SCHED; PG8_LDA(At, 1, 0); PG8_STAGE(PG8_SA(0, 1), a2 + hstep, voffA);
            PG8_WAIT_L(8); PG8_BAR; PG8_WAIT_L(0); PG8_MMA(0, 0, At, B0); PG8_BAR; PG8_SCHED;
            PG8_LDB(B1, 1, 1); PG8_STAGE(PG8_SB(1, 0), b3, voffB);
            PG8_BAR; PG8_WAIT_L(0); PG8_MMA(0, 1, At, B1); PG8_BAR;
            PG8_LDA(At, 1, 1); PG8_STAGE(PG8_SA(1, 0), a3, voffA);
            PG8_BAR; PG8_WAIT_L(0); PG8_MMA(1, 0, At, B0); PG8_BAR; PG8_SCHED;
            PG8_STAGE(PG8_SB(1, 1), b3 + hstep, voffB);
            PG8_WAIT_V(6); PG8_BAR; PG8_MMA(1, 1, At, B1); PG8_BAR;
            }
        }
        if constexpr (ALIGN_EPI) { if (wr == 0) PG8_BAR; }
        if constexpr (!Epi::AFTER_DRAIN) { E(acc, cur, wr, wc, fr, fq); S.done(cur); }
        if (!has_next) break;
#pragma unroll
        for (int a = 0; a < 2; ++a)
#pragma unroll
            for (int b = 0; b < 2; ++b)
#pragma unroll
                for (int m = 0; m < 4; ++m)
#pragma unroll
                    for (int n = 0; n < 2; ++n) acc[a][b][m][n] = (f32x4){0.f, 0.f, 0.f, 0.f};
        cur = nxt; cA = nA; cB = nB; ++ui;
        if constexpr (ALIGN_EPI) { if (wr == 1) PG8_BAR; }
    }
    PG8_WAIT_V(0);
    if constexpr (!ALIGN_EPI) { if (wr == 0) PG8_BAR; }
    PG8_BAR;
    if constexpr (Epi::AFTER_DRAIN) { E.fused(acc, cur, wr, wc, fr, fq, lds, wid, lane); S.done(cur); }
#undef PG8_SA
#undef PG8_SB
#undef PG8_STAGE
#undef PG8_LDA
#undef PG8_LDB
#undef PG8_MMA
#undef PG8_WAIT_V
#undef PG8_WAIT_L
#undef PG8_BAR
#undef PG8_SCHED
}

struct Unit2 { int pm, pn, part; };
struct Gemm2 { const bf16_t* A0; const bf16_t* A1; const bf16_t* B0; const bf16_t* B1; int lda, K; };
struct StaticOrder2 {
    int nM, nN, nwg, G, c;
    __host__ __device__ void init(int M, int N, int G_, int c_) { nM = M / BM; nN = N / BM; nwg = nM * nN; G = G_; c = c_; }
    __host__ __device__ bool next(int i, Unit2& u) const {
        const long L = (long)(i >> 1) * G + c; if (L >= nwg) return false;
        int wgid = (int)L; { const int q = nwg / NXCD, r = nwg % NXCD, xcd = wgid % NXCD, off = wgid / NXCD; wgid = (xcd < r ? xcd * (q + 1) : r * (q + 1) + (xcd - r) * q) + off; }
        const int nig = WGM * nN, gid = wgid / nig, fm = gid * WGM, gsz = (nM - fm) < WGM ? (nM - fm) : WGM;
        u.pm = fm + ((wgid % nig) % gsz); u.pn = (wgid % nig) / gsz; u.part = i & 1; return true;
    }
    __device__ __forceinline__ void a_ready(const Unit2&) const {}
    __device__ __forceinline__ void done(const Unit2&) const {}
    const float* ssq; PG8_LAS float* rs; int tid;
    __device__ __forceinline__ void prep_rows(const Unit2& u) const {
        const int row = tid >> 1, h0 = (tid & 1) * 2;
        const float* sp = ssq + (size_t)(h0 * 8) * 32768 + (u.pm * 256 + row);
        float sa = 0.f, sb = 0.f;
#pragma unroll
        for (int k = 0; k < 8; ++k) { sa += sp[(size_t)k * 32768]; sb += sp[(size_t)(8 + k) * 32768]; }
        rs[row * 4 + h0] = __builtin_amdgcn_rsqf(sa * (1.0f / 128.0f) + 1e-6f);
        rs[row * 4 + h0 + 1] = __builtin_amdgcn_rsqf(sb * (1.0f / 128.0f) + 1e-6f);
    }
};
template <class Epi, class Sched, bool ALIGN_EPI = false, bool SP2 = false>
__device__ __forceinline__ void gemm_phase2(PG8_LAS unsigned char* lds, const Gemm2 g, const Sched& S, const Epi& E, const int tid) {
    const int wid = __builtin_amdgcn_readfirstlane(tid >> 6), lane = tid & 63, wr = wid >> 2, wc = wid & 3, fr = lane & 15, fq = lane >> 4;
    const int K = g.K, nt = K / BK;
    unsigned voffA[2], voffB[2];
#pragma unroll
    for (int i = 0; i < 2; ++i) { int R, C; stage_rc(tid * 16 + i * 8192, R, C); const int Rb = Epi::PERM ? ((R & ~31) + perm32(R & 31)) : R;
        voffA[i] = (unsigned)(R * g.lda + C) * 2u; voffB[i] = (unsigned)(Rb * K + C) * 2u; }
    const size_t kstep = (size_t)(BK * 2);
    const size_t hstep = (size_t)HALF * K * 2;
    const size_t tstep = 2 * hstep;
    const size_t hstepA = (size_t)HALF * g.lda * 2, tstepA = 2 * hstepA;
    const unsigned ldsw = (unsigned)wid * 1024u;
    const int aoff = lds_byte(wr * 64 + fr, fq * 8), boff = lds_byte(wc * 32 + fr, fq * 8);
#define PG8_SA(b, h) (((b) * 2 + (h)) * HTB)
#define PG8_SB(b, h) ((4 + (b) * 2 + (h)) * HTB)
#define PG8_STAGE(bufoff, gbase, voff) do { _Pragma("unroll") for (int _i = 0; _i < 2; ++_i) \
        __builtin_amdgcn_global_load_lds((const unsigned*)((const char*)(gbase) + (voff)[_i]), (PG8_LAS unsigned*)(lds + (bufoff) + ldsw + _i * 8192), 16, 0, 0); } while (0)
#define PG8_LDA(dst, b, h) do { _Pragma("unroll") for (int m = 0; m < 4; ++m) _Pragma("unroll") for (int k = 0; k < 2; ++k) dst[m][k] = *(const PG8_LAS bf16x8*)(lds + PG8_SA(b, h) + aoff + m * 2048 + k * 1024); } while (0)
#define PG8_LDB(dst, b, h) do { _Pragma("unroll") for (int n = 0; n < 2; ++n) _Pragma("unroll") for (int k = 0; k < 2; ++k) dst[n][k] = *(const PG8_LAS bf16x8*)(lds + PG8_SB(b, h) + boff + n * 2048 + k * 1024); } while (0)
#define PG8_MMA(ai, bj, At, Bt) do { __builtin_amdgcn_s_setprio(1); _Pragma("unroll") for (int m = 0; m < 4; ++m) _Pragma("unroll") for (int n = 0; n < 2; ++n) _Pragma("unroll") for (int k = 0; k < 2; ++k) \
        acc[ai][bj][m][n] = __builtin_amdgcn_mfma_f32_16x16x32_bf16(Bt[n][k], At[m][k], acc[ai][bj][m][n], 0, 0, 0); __builtin_amdgcn_s_setprio(0); } while (0)
#define PG8_WAIT_V(n) asm volatile("s_waitcnt vmcnt(" #n ")" ::: "memory")
#define PG8_WAIT_L(n) asm volatile("s_waitcnt lgkmcnt(" #n ")" ::: "memory")
#define PG8_BAR __builtin_amdgcn_s_barrier()
#define PG8_SCHED __builtin_amdgcn_sched_barrier(0)
    Unit2 cur, nxt; int ui = 0;
    if (!S.next(0, cur)) return;
    f32x4 acc[2][2][4][2];
#pragma unroll
    for (int a = 0; a < 2; ++a)
#pragma unroll
        for (int b = 0; b < 2; ++b)
#pragma unroll
            for (int m = 0; m < 4; ++m)
#pragma unroll
                for (int n = 0; n < 2; ++n) acc[a][b][m][n] = (f32x4){0.f, 0.f, 0.f, 0.f};
    bf16x8 At[4][2], B0[2][2], B1[2][2];
    const char* cA = (const char*)(cur.part ? g.A1 : g.A0) + (size_t)cur.pm * tstepA; const char* cB = (const char*)(cur.part ? g.B1 : g.B0) + (size_t)cur.pn * tstep;
    S.a_ready(cur);
    S.prep_rows(cur);
    if constexpr (SP2) {
        PG8_STAGE(PG8_SB(0, 0), cB, voffB); PG8_STAGE(PG8_SB(0, 1), cB + hstep, voffB); PG8_STAGE(PG8_SA(0, 0), cA, voffA); PG8_STAGE(PG8_SA(0, 1), cA + hstepA, voffA);
        if (wr == 1) PG8_BAR;
        PG8_WAIT_V(2); PG8_BAR;
        PG8_STAGE(PG8_SB(1, 0), cB + kstep, voffB); PG8_STAGE(PG8_SA(1, 0), cA + kstep, voffA); PG8_STAGE(PG8_SB(1, 1), cB + hstep + kstep, voffB);
        PG8_WAIT_V(6); PG8_BAR;
    } else {
        PG8_STAGE(PG8_SB(0, 0), cB, voffB); PG8_STAGE(PG8_SA(0, 0), cA, voffA); PG8_STAGE(PG8_SB(0, 1), cB + hstep, voffB); PG8_STAGE(PG8_SA(0, 1), cA + hstepA, voffA);
        if (wr == 1) PG8_BAR;
        PG8_WAIT_V(4); PG8_BAR;
        PG8_STAGE(PG8_SB(1, 0), cB + kstep, voffB); PG8_STAGE(PG8_SA(1, 0), cA + kstep, voffA); PG8_STAGE(PG8_SB(1, 1), cB + hstep + kstep, voffB);
        PG8_WAIT_V(6); PG8_BAR;
    }
    for (;;) {
        const bool has_next = S.next(ui + 1, nxt);
        const char* nA = has_next ? (const char*)(nxt.part ? g.A1 : g.A0) + (size_t)nxt.pm * tstepA : cA; const char* nB = has_next ? (const char*)(nxt.part ? g.B1 : g.B0) + (size_t)nxt.pn * tstep : cB;
        for (int t = 0; t < nt; t += 2) {
            const bool last = (t == nt - 2);
            const char* a1 = cA + (size_t)(t + 1) * kstep;
            const char* a2 = last ? nA : cA + (size_t)(t + 2) * kstep; const char* b2 = last ? nB : cB + (size_t)(t + 2) * kstep;
            const char* a3 = a2 + kstep; const char* b3 = b2 + kstep;
            if (last && has_next) S.a_ready(nxt);
            if constexpr (SP2) {
            PG8_LDB(B0, 0, 0); PG8_LDB(B1, 0, 1); PG8_SCHED; PG8_LDA(At, 0, 0); PG8_STAGE(PG8_SA(1, 1), a1 + hstepA, voffA);
            PG8_WAIT_V(8); PG8_WAIT_L(0); PG8_BAR; PG8_MMA(0, 0, At, B0); PG8_MMA(0, 1, At, B1); PG8_BAR; PG8_SCHED;
            PG8_LDA(At, 0, 1); PG8_STAGE(PG8_SB(0, 0), b2, voffB); PG8_STAGE(PG8_SB(0, 1), b2 + hstep, voffB); PG8_STAGE(PG8_SA(0, 0), a2, voffA);
            PG8_WAIT_V(8); PG8_WAIT_L(0); PG8_BAR; PG8_MMA(1, 0, At, B0); PG8_MMA(1, 1, At, B1); PG8_BAR; PG8_SCHED;
            PG8_LDB(B0, 1, 0); PG8_LDB(B1, 1, 1); PG8_SCHED; PG8_LDA(At, 1, 0); PG8_STAGE(PG8_SA(0, 1), a2 + hstepA, voffA);
            PG8_WAIT_V(8); PG8_WAIT_L(0); PG8_BAR; PG8_MMA(0, 0, At, B0); PG8_MMA(0, 1, At, B1); PG8_BAR; PG8_SCHED;
            PG8_LDA(At, 1, 1); PG8_STAGE(PG8_SB(1, 0), b3, voffB); PG8_STAGE(PG8_SB(1, 1), b3 + hstep, voffB); PG8_STAGE(PG8_SA(1, 0), a3, voffA);
            PG8_WAIT_V(8); PG8_WAIT_L(0); PG8_BAR; PG8_MMA(1, 0, At, B0); PG8_MMA(1, 1, At, B1); PG8_BAR; PG8_SCHED;
            } else {
            PG8_LDB(B0, 0, 0); PG8_SCHED; PG8_LDA(At, 0, 0); PG8_STAGE(PG8_SA(1, 1), a1 + hstepA, voffA);
            PG8_WAIT_L(8); PG8_BAR; PG8_WAIT_L(0); PG8_MMA(0, 0, At, B0); PG8_BAR; PG8_SCHED;
            PG8_LDB(B1, 0, 1); PG8_STAGE(PG8_SB(0, 0), b2, voffB);
            PG8_BAR; PG8_WAIT_L(0); PG8_MMA(0, 1, At, B1); PG8_BAR;
            PG8_LDA(At, 0, 1); PG8_STAGE(PG8_SA(0, 0), a2, voffA);
            PG8_BAR; PG8_WAIT_L(0); PG8_MMA(1, 0, At, B0); PG8_BAR; PG8_SCHED;
            PG8_STAGE(PG8_SB(0, 1), b2 + hstep, voffB);
            PG8_WAIT_V(6); PG8_BAR; PG8_MMA(1, 1, At, B1); PG8_BAR;
            PG8_LDB(B0, 1, 0); PG8_SCHED; PG8_LDA(At, 1, 0); PG8_STAGE(PG8_SA(0, 1), a2 + hstepA, voffA);
            PG8_WAIT_L(8); PG8_BAR; PG8_WAIT_L(0); PG8_MMA(0, 0, At, B0); PG8_BAR; PG8_SCHED;
            PG8_LDB(B1, 1, 1); PG8_STAGE(PG8_SB(1, 0), b3, voffB);
            PG8_BAR; PG8_WAIT_L(0); PG8_MMA(0, 1, At, B1); PG8_BAR;
            PG8_LDA(At, 1, 1); PG8_STAGE(PG8_SA(1, 0), a3, voffA);
            PG8_BAR; PG8_WAIT_L(0); PG8_MMA(1, 0, At, B0); PG8_BAR; PG8_SCHED;
            PG8_STAGE(PG8_SB(1, 1), b3 + hstep, voffB);
            PG8_WAIT_V(6); PG8_BAR; PG8_MMA(1, 1, At, B1); PG8_BAR;
            }
            if (cur.part == 0 && !last) E.kscale(acc, t >> 1, wr, fr);
        }
        if constexpr (ALIGN_EPI) { if (wr == 0) PG8_BAR; }
        if (cur.part == 0) E.mid(acc, cur, wr, wc, fr, fq); else E(acc, cur, wr, wc, fr, fq);
        if (!has_next) break;
        if (cur.part == 1) S.prep_rows(nxt);
        if (cur.part == 1) {
#pragma unroll
        for (int a = 0; a < 2; ++a)
#pragma unroll
            for (int b = 0; b < 2; ++b)
#pragma unroll
                for (int m = 0; m < 4; ++m)
#pragma unroll
                    for (int n = 0; n < 2; ++n) acc[a][b][m][n] = (f32x4){0.f, 0.f, 0.f, 0.f};
        }
        cur = nxt; cA = nA; cB = nB; ++ui;
        if constexpr (ALIGN_EPI) { if (wr == 1) PG8_BAR; }
    }
    PG8_WAIT_V(0);
    if constexpr (!ALIGN_EPI) { if (wr == 0) PG8_BAR; }
    PG8_BAR;
#undef PG8_SA
#undef PG8_SB
#undef PG8_STAGE
#undef PG8_LDA
#undef PG8_LDB
#undef PG8_MMA
#undef PG8_WAIT_V
#undef PG8_WAIT_L
#undef PG8_BAR
#undef PG8_SCHED
}
}

struct EpiInProj {
  static constexpr bool PERM = true, AFTER_DRAIN = false;
  u16* h;
  DI void operator()(const f32x4 (&acc)[2][2][4][2], const pg8::Unit& u, int wr, int wc, int fr, int fq) const {
    const int shift = (u.pn >= 8) ? 8 : 0;
#pragma unroll
    for (int ai = 0; ai < 2; ++ai)
#pragma unroll
      for (int m = 0; m < 4; ++m) {
        const int row = u.pm * 256 + ai * 128 + wr * 64 + m * 16 + fr;
#pragma unroll
        for (int bj = 0; bj < 2; ++bj) {
          const int col = u.pn * 256 + bj * 128 + wc * 32 + 8 * fq + shift;
          const f32x4 a = acc[ai][bj][m][0], b = acc[ai][bj][m][1];
          u32x4 w; w.x = pk_bf16(a[0], a[1]); w.y = pk_bf16(a[2], a[3]); w.z = pk_bf16(b[0], b[1]); w.w = pk_bf16(b[2], b[3]);
          *(u32x4*)(h + (size_t)row * NC + col) = w;
        }
      }
  }
};

struct EpiMerge {
  static constexpr bool PERM = true, AFTER_DRAIN = false;
  const u16* h; u16* mg; PG8_LAS float* rs;
  DI void kscale(f32x4 (&acc)[2][2][4][2], int hh, int wr, int fr) const {
#pragma unroll
    for (int ai = 0; ai < 2; ++ai)
#pragma unroll
      for (int m = 0; m < 4; ++m) {
        const int rl = ai * 128 + wr * 64 + m * 16 + fr;
        const float f = rs[rl * 4 + hh] * rcp_f(rs[rl * 4 + hh + 1]);
#pragma unroll
        for (int bj = 0; bj < 2; ++bj) { acc[ai][bj][m][0] *= f; acc[ai][bj][m][1] *= f; }
      }
  }
  DI void mid(f32x4 (&acc)[2][2][4][2], const pg8::Unit2& u, int wr, int wc, int fr, int fq) const {
#pragma unroll
    for (int ai = 0; ai < 2; ++ai) {
      u32x4 ga[4][2], gb[4][2];
#pragma unroll
      for (int m = 0; m < 4; ++m)
#pragma unroll
        for (int bj = 0; bj < 2; ++bj) {
          const size_t off = (size_t)(u.pm * 256 + ai * 128 + wr * 64 + m * 16 + fr) * NC + (u.pn * 256 + bj * 128 + wc * 32 + 8 * fq);
          ga[m][bj] = *(const u32x4*)(h + off + C_GA); gb[m][bj] = *(const u32x4*)(h + off + C_GB);
        }
      __builtin_amdgcn_sched_barrier(0);
#pragma unroll
      for (int m = 0; m < 4; ++m)
#pragma unroll
        for (int bj = 0; bj < 2; ++bj)
#pragma unroll
          for (int j = 0; j < 4; ++j) {
            const float r3 = rs[(ai * 128 + wr * 64 + m * 16 + fr) * 4 + 3];
            const float r0 = r3 * (1.f + __expf(-bf_lo(gb[m][bj][j]))) * rcp_f(1.f + __expf(-bf_lo(ga[m][bj][j])));
            const float r1 = r3 * (1.f + __expf(-bf_hi(gb[m][bj][j]))) * rcp_f(1.f + __expf(-bf_hi(ga[m][bj][j])));
            acc[ai][bj][m][j >> 1][2 * (j & 1)] *= r0; acc[ai][bj][m][j >> 1][2 * (j & 1) + 1] *= r1;
          }
      __builtin_amdgcn_sched_barrier(0);
    }
  }
  DI void operator()(const f32x4 (&acc)[2][2][4][2], const pg8::Unit2& u, int wr, int wc, int fr, int fq) const {
#pragma unroll
    for (int ai = 0; ai < 2; ++ai) {
      u32x4 gb[4][2];
#pragma unroll
      for (int m = 0; m < 4; ++m)
#pragma unroll
        for (int bj = 0; bj < 2; ++bj)
          gb[m][bj] = *(const u32x4*)(h + (size_t)(u.pm * 256 + ai * 128 + wr * 64 + m * 16 + fr) * NC + C_GB + (u.pn * 256 + bj * 128 + wc * 32 + 8 * fq));
      __builtin_amdgcn_sched_barrier(0);
#pragma unroll
      for (int m = 0; m < 4; ++m)
#pragma unroll
        for (int bj = 0; bj < 2; ++bj) {
          const int row = u.pm * 256 + ai * 128 + wr * 64 + m * 16 + fr, col = u.pn * 256 + bj * 128 + wc * 32 + 8 * fq;
          const f32x4 a = acc[ai][bj][m][0], b = acc[ai][bj][m][1];
          const u32x4 g = gb[m][bj];
          u32x4 w;
          w.x = pk_bf16(a[0] * sigmoid_f(bf_lo(g[0])), a[1] * sigmoid_f(bf_hi(g[0])));
          w.y = pk_bf16(a[2] * sigmoid_f(bf_lo(g[1])), a[3] * sigmoid_f(bf_hi(g[1])));
          w.z = pk_bf16(b[0] * sigmoid_f(bf_lo(g[2])), b[1] * sigmoid_f(bf_hi(g[2])));
          w.w = pk_bf16(b[2] * sigmoid_f(bf_lo(g[3])), b[3] * sigmoid_f(bf_hi(g[3])));
          *(u32x4*)(mg + (size_t)row * 1024 + col) = w;
        }
      __builtin_amdgcn_sched_barrier(0);
    }
  }
};

struct EpiOut {
  static constexpr bool PERM = true, AFTER_DRAIN = false;
  const float* x; _Float16* r16;
  DI void operator()(const f32x4 (&acc)[2][2][4][2], const pg8::Unit& u, int wr, int wc, int fr, int fq) const {
#pragma unroll
    for (int ai = 0; ai < 2; ++ai) {
      f32x4 xv[4][2][2];
#pragma unroll
      for (int m = 0; m < 4; ++m)
#pragma unroll
        for (int bj = 0; bj < 2; ++bj) {
          const float* xp = x + (size_t)(u.pm * 256 + ai * 128 + wr * 64 + m * 16 + fr) * 1024 + (u.pn * 256 + bj * 128 + wc * 32 + 8 * fq);
          xv[m][bj][0] = *(const f32x4*)xp; xv[m][bj][1] = *(const f32x4*)(xp + 4);
        }
      __builtin_amdgcn_sched_barrier(0);
#pragma unroll
      for (int m = 0; m < 4; ++m)
#pragma unroll
        for (int bj = 0; bj < 2; ++bj) {
          const int row = u.pm * 256 + ai * 128 + wr * 64 + m * 16 + fr, col = u.pn * 256 + bj * 128 + wc * 32 + 8 * fq;
          const f32x4 v0 = xv[m][bj][0] * 1.189207115002721f + acc[ai][bj][m][0], v1 = xv[m][bj][1] * 1.189207115002721f + acc[ai][bj][m][1];
          const f16x4 h0 = __builtin_convertvector(v0, f16x4), h1 = __builtin_convertvector(v1, f16x4);
          u32x4 w; const u32x2 p0 = __builtin_bit_cast(u32x2, h0), p1 = __builtin_bit_cast(u32x2, h1);
          w.x = p0.x; w.y = p0.y; w.z = p1.x; w.w = p1.y;
          *(u32x4*)(r16 + (size_t)row * 1024 + col) = w;
        }
      __builtin_amdgcn_sched_barrier(0);
    }
  }
};

__global__ void __launch_bounds__(512, 2) fwd_megakernel(Params p) {
  cg::grid_group grid = cg::this_grid();
  __shared__ __attribute__((aligned(16))) unsigned char smem[SMEM_BYTES];
  const int w8 = __builtin_amdgcn_readfirstlane((int)(threadIdx.x >> 6));
  const int wvs = w8 & 3, half = w8 >> 2;
  unsigned char* hsm = smem + half * HALF_SMEM;
  const int vb = blockIdx.x + half * gridDim.x, nvb = 2 * gridDim.x;
  volatile LAS unsigned* st = (volatile LAS unsigned*)(smem + SMEM_BYTES - 16);
  { const int t0_ = opaque_tid(); if (t0_ < 4) st[t0_] = 0u; }
  __syncthreads();
  const XcdBarrier xb = xcd_barrier_post((unsigned*)(p.ws + OFF_BAR), st, w8);
  phase0(p, w8);
  if (p.ws == nullptr) grid.sync();
  xcd_barrier(xb);
  {
    pg8::Gemm g; g.A = (const pg8::bf16_t*)(p.ws + OFF_SC); g.Bt = (const pg8::bf16_t*)(p.ws + OFF_WINT); g.M = T_TOK; g.N = NCP; g.K = 1024;
    pg8::StaticOrder so; so.init(T_TOK, NCP, (int)gridDim.x, (int)blockIdx.x);
    EpiInProj e; e.h = (u16*)(p.ws + OFF_H);
    pg8::gemm_phase<EpiInProj, pg8::StaticOrder, true, true>((PG8_LAS unsigned char*)smem, g, so, e, opaque_tid_(w8));
  }
  xcd_barrier(xb);
  for (int it = vb; it < 2048; it += nvb) prep_item(p, wvs, it, hsm);
  xcd_barrier(xb);
  if (blockIdx.x < 128) {
    if (half == 0) { const int cb = (int)blockIdx.x; scan_chain(p, wvs, (cb & 7) + 8 * ((cb >> 3) >> 3), (cb >> 3) & 7, hsm); }
    else {
      const int cb = (int)blockIdx.x, pr = (cb & 7) + 8 * ((cb >> 3) >> 3), slp = (cb >> 3) & 7, bp = pr >> 2, hp = pr & 3;
      const int ft = opaque_tid();
      const unsigned char* pbase = p.ws + OFF_SC + (size_t)(slp * 72 + (ft < 72 ? ft : 0)) * 128;
      const int dR = ft >> 2, dc0 = (ft & 3) * 4;
      const u16* zbase = (const u16*)(p.ws + OFF_H) + (size_t)(bp * SEQ + dR) * NC + C_DNZ + hp * 128 + 16 * slp + dc0;
      const f32x4 nw4 = *(const f32x4*)(p.dn_norm_w + 16 * slp + dc0);
      unsigned char* ringp = smem + 8192;
      const unsigned char* ubase = p.ws + OFF_SC + 57344 + slp * 2048 + ft * 8;
      const float* dbase = (const float*)(p.ws + OFF_DEC);
      const int doff = ((dR >> 4) * 64 + ((dR >> 2) & 3) * 16 + dc0) * 16 + (dR & 3) * 4;
#define Z_LOAD(dst, step_) do { const int st_ = (step_) < 0 ? 0 : ((step_) < 128 ? (step_) : 127); dst = *(const u32x2*)(zbase + (size_t)st_ * 64 * NC); } while (0)
#define U_LOAD(du, dd, step_) do { const int it_ = (bp * 128 + ((step_) < 128 ? (step_) : 127)) * 4 + hp; du = *(const u32x2*)(ubase + (size_t)it_ * OPB); dd = dbase[it_]; } while (0)
#define U_STORE(su, sd, step_) do { *(u32x2*)(ringp + ((step_) % 3) * 6400 + 4096 + ft * 8) = su; if (ft == 0) *(float*)(ringp + ((step_) % 3) * 6400 + 6144) = sd; } while (0)
#define O_DRAIN(zsrc, step_) do { const unsigned char* os_ = ringp + ((step_) % 3) * 6400 + doff; \
        const float o0_ = *(const float*)os_, o1_ = *(const float*)(os_ + 16), o2_ = *(const float*)(os_ + 32), o3_ = *(const float*)(os_ + 48); \
        const size_t row_ = (size_t)(bp * SEQ + (step_) * 64 + dR); \
        u32x2 w_; w_.x = pk_bf16(o0_ * nw4[0] * silu_f(bf_lo(zsrc.x)), o1_ * nw4[1] * silu_f(bf_hi(zsrc.x))); \
        w_.y = pk_bf16(o2_ * nw4[2] * silu_f(bf_lo(zsrc.y)), o3_ * nw4[3] * silu_f(bf_hi(zsrc.y))); \
        *(u32x2*)(hout + row_ * NC + hp * 128 + 16 * slp + dc0) = w_; \
        float sq_ = (o0_ * o0_ + o1_ * o1_) + (o2_ * o2_ + o3_ * o3_); \
        sq_ += dpp_mov<0xB1>(sq_); sq_ += dpp_mov<0x4E>(sq_); \
        if ((ft & 3) == 0) ssqp[(size_t)(hp * 8 + slp) * T_TOK + row_] = sq_; } while (0)
      u16* hout = (u16*)(p.ws + OFF_H);
      float* ssqp = (float*)(p.ws + OFF_SSQ);
      u32x2 zr0, zr1, zr2 = {0u, 0u}, zr3 = {0u, 0u};
      u32x2 ur0, ur1, ur2, ur3; float dr0, dr1, dr2, dr3;
      unsigned pr0 = 0, pr1 = 0, pr2 = 0, pr3 = 0, accp = 0;
      Z_LOAD(zr0, 0); Z_LOAD(zr1, 1);
      U_LOAD(ur0, dr0, 0); U_LOAD(ur1, dr1, 1); U_LOAD(ur2, dr2, 2); U_LOAD(ur3, dr3, 3);
      U_STORE(ur0, dr0, 0);
      __syncthreads();
#define P_ITER(m_, K0, K1, K2) do { \
        U_STORE(ur##K1, dr##K1, (m_) + 1); U_LOAD(ur##K0, dr##K0, (m_) + 4); \
        if ((m_) >= 2) O_DRAIN(zr##K2, (m_) - 2); \
        Z_LOAD(zr##K2, (m_) + 2); \
        accp ^= pr##K0; { const int np_ = (m_) + 6 < 128 ? (m_) + 6 : 127; pr##K0 = *(const unsigned*)(pbase + (size_t)((bp * 128 + np_) * 4 + hp) * OPB); } \
        __syncthreads(); __syncthreads(); } while (0)
#pragma unroll 1
      for (int mm = 0; mm < 128; mm += 4) { P_ITER(mm, 0, 1, 2); P_ITER(mm + 1, 1, 2, 3); P_ITER(mm + 2, 2, 3, 0); P_ITER(mm + 3, 3, 0, 1); }
#undef P_ITER
      __syncthreads();
      O_DRAIN(zr2, 126); O_DRAIN(zr3, 127);
      accp ^= pr0 ^ pr1 ^ pr2 ^ pr3;
#undef Z_LOAD
#undef U_LOAD
#undef U_STORE
#undef O_DRAIN
      if (accp == 0x9e3779b9u && ft == 300) ((unsigned*)(p.ws + OFF_BAR))[XB_TMO + 1] = accp;
    }
  } else {
    const int nsw = 2 * ((int)gridDim.x - 128), vbl = ((int)blockIdx.x - 128) + half * ((int)gridDim.x - 128);
    for (int k = 0; k * nsw < 1024; ++k) { const int it = vbl + k * nsw; swa_item(p, wvs, it < 1024 ? it : 0, it < 1024, hsm); }
  }
  xcd_barrier(xb);
  {
    pg8::Gemm2 g; g.A0 = (const pg8::bf16_t*)(p.ws + OFF_H); g.A1 = g.A0 + C_SWQ; g.B0 = (const pg8::bf16_t*)(p.ws + OFF_WAT); g.B1 = (const pg8::bf16_t*)(p.ws + OFF_WBT);
    g.lda = NC; g.K = 512;
    pg8::StaticOrder2 so; so.init(T_TOK, 1024, (int)gridDim.x, (int)blockIdx.x);
    so.ssq = (const float*)(p.ws + OFF_SSQ); so.rs = (PG8_LAS float*)(smem + 131072); so.tid = opaque_tid_(w8);
    EpiMerge e; e.h = (const u16*)(p.ws + OFF_H); e.mg = (u16*)(p.ws + OFF_SC); e.rs = (PG8_LAS float*)(smem + 131072);
    pg8::gemm_phase2<EpiMerge, pg8::StaticOrder2, true, true>((PG8_LAS unsigned char*)smem, g, so, e, opaque_tid_(w8));
  }
  xcd_barrier(xb);
  {
    pg8::Gemm g; g.A = (const pg8::bf16_t*)(p.ws + OFF_SC); g.Bt = (const pg8::bf16_t*)(p.ws + OFF_WOT); g.M = T_TOK; g.N = 1024; g.K = 1024;
    pg8::StaticOrder so; so.init(T_TOK, 1024, (int)gridDim.x, (int)blockIdx.x);
    EpiOut e; e.x = p.x; e.r16 = (_Float16*)(p.ws + OFF_H);
    pg8::gemm_phase<EpiOut, pg8::StaticOrder, true, true>((PG8_LAS unsigned char*)smem, g, so, e, opaque_tid_(w8));
  }
  xcd_barrier(xb);
  phase6(p, w8, smem);
}

extern "C" void kernel_launch(void* const* d_in, const int* in_sizes, int n_in, void* d_out, int out_size,
                              void* d_ws, size_t ws_size, hipStream_t stream) {
  if (ws_size < WS_NEED) { fprintf(stderr, "workspace too small: %zu < %zu\n", ws_size, (size_t)WS_NEED); return; }
  Params p{};
  p.x = (const float*)d_in[0]; p.w_in = (const float*)d_in[1]; p.conv_w = (const float*)d_in[2]; p.a_log = (const float*)d_in[3];
  p.dt_bias = (const float*)d_in[4]; p.dn_norm_w = (const float*)d_in[5]; p.sinks = (const float*)d_in[6];
  p.w_branch = (const float*)d_in[7]; p.w_out = (const float*)d_in[8]; p.ln_g = (const float*)d_in[9]; p.ln_b = (const float*)d_in[10];
  p.out = (float*)d_out; p.ws = (unsigned char*)d_ws;
  for (int i = 0; i < 8; ++i) p.inv_freq[i] = (float)std::pow(500000.0, -(double)i / 8.0);
  static int grid_blocks = 0;
  if (!grid_blocks) {
    int dev = 0, cus = 0, per_cu = 0;
    (void)hipGetDevice(&dev);
    (void)hipDeviceGetAttribute(&cus, hipDeviceAttributeMultiprocessorCount, dev);
    (void)hipOccupancyMaxActiveBlocksPerMultiprocessor(&per_cu, fwd_megakernel, 512, 0);
    if (per_cu < 1) fprintf(stderr, "occupancy query reports %d workgroups per CU\n", per_cu);
    grid_blocks = cus > 256 ? 256 : cus;
    grid_blocks &= ~7;
  }
  (void)hipMemsetAsync(p.ws + OFF_BAR, 0, BAR_BYTES, stream);
  void* args[] = {&p};
  hipError_t e = hipLaunchCooperativeKernel((void*)fwd_megakernel, dim3(grid_blocks), dim3(512), args, 0, stream);
  if (e != hipSuccess) fprintf(stderr, "cooperative launch failed: %s (grid %d)\n", hipGetErrorString(e), grid_blocks);
}
```

```cpp
#include <hip/hip_runtime.h>
#include <hip/hip_cooperative_groups.h>
#include <cstdio>
#include <cmath>
namespace cg = cooperative_groups;

typedef unsigned short u16;
typedef short bf16x8 __attribute__((ext_vector_type(8)));
typedef float f32x4 __attribute__((ext_vector_type(4)));
typedef unsigned u32x4 __attribute__((ext_vector_type(4)));
typedef unsigned u32x2 __attribute__((ext_vector_type(2)));
typedef _Float16 f16x4 __attribute__((ext_vector_type(4)));
#define DI __device__ __forceinline__
DI int opaque_tid_(int wave_s) { int t; asm volatile("v_mbcnt_lo_u32_b32 %0, -1, 0\n\tv_mbcnt_hi_u32_b32 %0, -1, %0" : "=v"(t)); return t + (wave_s << 6); }
#define opaque_tid() opaque_tid_(wvs)

constexpr int T_TOK = 32768, SEQ = 8192, DM = 1024, NC = 5384, NCP = 5376;
constexpr int C_DNZ = 1536, C_SWQ = 2056, C_SWK = 2568, C_SWV = 2696, C_SWZ = 2824, C_GA = 3336, C_GB = 4360;
constexpr size_t OFF_BAR = 0;
constexpr size_t BAR_BYTES = 16384;
constexpr size_t OFF_WINT = BAR_BYTES;
constexpr size_t OFF_WAT = OFF_WINT + (size_t)NCP * 1024 * 2;
constexpr size_t OFF_WBT = OFF_WAT + 1024 * 512 * 2;
constexpr size_t OFF_WOT = OFF_WBT + 1024 * 512 * 2;
constexpr size_t OFF_ROPE = OFF_WOT + 1024 * 1024 * 2;
constexpr size_t OFF_HB = OFF_ROPE + 2 * 8192 * 8 * 4;
constexpr size_t OFF_DEC = OFF_HB + (size_t)T_TOK * 8 * 4;
constexpr size_t OFF_H = OFF_DEC + 2048 * 4;
constexpr size_t OFF_SC = OFF_H + (size_t)T_TOK * NC * 2;
constexpr size_t OPB = 73728;
constexpr size_t OFF_SSQ = OFF_SC + 2048 * OPB;
constexpr size_t WS_NEED = OFF_SSQ + (size_t)T_TOK * 32 * 4;
constexpr int HALF_SMEM = 73728;
constexpr int SMEM_BYTES = 2 * HALF_SMEM + 16;

struct Params {
  const float *x, *w_in, *conv_w, *a_log, *dt_bias, *dn_norm_w, *sinks, *w_branch, *w_out, *ln_g, *ln_b;
  float* out; unsigned char* ws;
  float inv_freq[8];
};

typedef __bf16 bf16x2_t __attribute__((ext_vector_type(2)));
typedef float f32x2_t __attribute__((ext_vector_type(2)));
DI unsigned pk_bf16(float lo, float hi) { f32x2_t f = {lo, hi}; bf16x2_t v = __builtin_convertvector(f, bf16x2_t); return __builtin_bit_cast(unsigned, v); }
DI float bf_lo(unsigned u) { return __uint_as_float(u << 16); }
DI float bf_hi(unsigned u) { return __uint_as_float(u & 0xffff0000u); }
DI float bf2f(u16 v) { return __uint_as_float(((unsigned)v) << 16); }
DI u16 f2bf(float f) { return (u16)(pk_bf16(f, f) & 0xffffu); }
DI float shx(float v, int m, int lane) { return __uint_as_float((unsigned)__builtin_amdgcn_ds_bpermute((lane ^ m) << 2, (int)__float_as_uint(v))); }
DI float rcp_f(float y) { return __builtin_amdgcn_rcpf(y); }
template <int CTRL> DI float dpp_mov(float v) { return __builtin_bit_cast(float, __builtin_amdgcn_update_dpp(0, __builtin_bit_cast(int, v), CTRL, 0xf, 0xf, true)); }
DI float row16_sum(float v) {
  v += dpp_mov<0xB1>(v);
  v += dpp_mov<0x4E>(v);
  v += dpp_mov<0x141>(v);
  v += dpp_mov<0x140>(v);
  return v;
}
DI float silu_f(float y) { return y * rcp_f(1.0f + __expf(-y)); }
DI float sigmoid_f(float y) { return rcp_f(1.0f + __expf(-y)); }
DI f32x4 mfma16(bf16x8 a, bf16x8 b, f32x4 c) { return __builtin_amdgcn_mfma_f32_16x16x32_bf16(a, b, c, 0, 0, 0); }
DI bf16x8 as_bf8(u32x4 v) { return __builtin_bit_cast(bf16x8, v); }
DI bf16x8 pack8(f32x4 a, f32x4 b) { u32x4 w; w.x = pk_bf16(a[0], a[1]); w.y = pk_bf16(a[2], a[3]); w.z = pk_bf16(b[0], b[1]); w.w = pk_bf16(b[2], b[3]); return as_bf8(w); }

DI void phase0(const Params& p, int wvs) {
  const size_t gt = (size_t)blockIdx.x * 512 + opaque_tid(), gs = (size_t)gridDim.x * 512;
  {
    const int ltid = (int)(gt & 511), lane = ltid & 63, wv = ltid >> 6;
    float wr[16][8];
#pragma unroll
    for (int j = 0; j < 4; ++j)
#pragma unroll
      for (int c = 0; c < 4; ++c) {
        const float* wp = p.w_in + (size_t)(4 * (lane + 64 * j) + c) * NC + 2048;
        const f32x4 a = *(const f32x4*)wp, b = *(const f32x4*)(wp + 4);
#pragma unroll
        for (int q = 0; q < 4; ++q) { wr[4 * j + c][q] = a[q]; wr[4 * j + c][4 + q] = b[q]; }
      }
    u16* xb = (u16*)(p.ws + OFF_SC);
    float* hb = (float*)(p.ws + OFF_HB);
    const int rstep = gridDim.x * 8;
    for (int row0 = blockIdx.x * 8 + wv; row0 < T_TOK; row0 += 2 * rstep) {
      f32x4 xr[2][4];
#pragma unroll
      for (int u = 0; u < 2; ++u) {
        const int row = row0 + u * rstep;
#pragma unroll
        for (int j = 0; j < 4; ++j) xr[u][j] = (row < T_TOK) ? *(const f32x4*)(p.x + (size_t)row * DM + 4 * (lane + 64 * j)) : (f32x4){0.f, 0.f, 0.f, 0.f};
      }
#pragma unroll
      for (int u = 0; u < 2; ++u) {
        const int row = row0 + u * rstep;
        float v[8];
#pragma unroll
        for (int q = 0; q < 8; ++q) v[q] = 0.f;
#pragma unroll
        for (int j = 0; j < 4; ++j) {
          const f32x4 xv = xr[u][j];
          u32x2 w; w.x = pk_bf16(xv[0], xv[1]); w.y = pk_bf16(xv[2], xv[3]);
          if (row < T_TOK) *(u32x2*)(xb + (size_t)row * DM + 4 * (lane + 64 * j)) = w;
#pragma unroll
          for (int c = 0; c < 4; ++c)
#pragma unroll
            for (int q = 0; q < 8; ++q) v[q] += xv[c] * wr[4 * j + c][q];
        }
        const bool up = (lane & 32) != 0;
        float k4[4];
#pragma unroll
        for (int i = 0; i < 4; ++i) { const float snd = up ? v[i] : v[i + 4]; const float kp = up ? v[i + 4] : v[i]; k4[i] = kp + shx(snd, 32, lane); }
        const bool up2 = (lane & 16) != 0;
        float k2[2];
#pragma unroll
        for (int i = 0; i < 2; ++i) { const float snd = up2 ? k4[i] : k4[i + 2]; const float kp = up2 ? k4[i + 2] : k4[i]; k2[i] = kp + shx(snd, 16, lane); }
        const bool up3 = (lane & 8) != 0;
        float k1 = (up3 ? k2[1] : k2[0]) + shx(up3 ? k2[0] : k2[1], 8, lane);
        k1 += shx(k1, 4, lane); k1 += shx(k1, 2, lane); k1 += shx(k1, 1, lane);
        if ((lane & 7) == 0 && row < T_TOK) hb[(size_t)row * 8 + (lane >> 3)] = k1;
      }
    }
  }
  {
    u32x4* wt = (u32x4*)(p.ws + OFF_WINT);
    for (size_t i = gt; i < (size_t)NCP * 128; i += gs) {
      const int kc = (int)(i / NCP), n = (int)(i % NCP);
      float v[8];
#pragma unroll
      for (int j = 0; j < 8; ++j) v[j] = p.w_in[(size_t)(kc * 8 + j) * NC + n + (n >= 2048 ? 8 : 0)];
      u32x4 w; w.x = pk_bf16(v[0], v[1]); w.y = pk_bf16(v[2], v[3]); w.z = pk_bf16(v[4], v[5]); w.w = pk_bf16(v[6], v[7]);
      wt[(size_t)n * 128 + kc] = w;
    }
  }
  {
    for (size_t i = gt; i < (size_t)2 * 1024 * 64; i += gs) {
      const int br = (int)(i / (1024 * 64)), rem = (int)(i % (1024 * 64)), kc = rem / 1024, n = rem % 1024;
      const float* src = p.w_branch + (size_t)br * 512 * 1024;
      float v[8];
#pragma unroll
      for (int j = 0; j < 8; ++j) v[j] = src[(size_t)(kc * 8 + j) * 1024 + n];
      u32x4 w; w.x = pk_bf16(v[0], v[1]); w.y = pk_bf16(v[2], v[3]); w.z = pk_bf16(v[4], v[5]); w.w = pk_bf16(v[6], v[7]);
      ((u32x4*)(p.ws + (br ? OFF_WBT : OFF_WAT)))[(size_t)n * 64 + kc] = w;
    }
  }
  {
    for (size_t i = gt; i < (size_t)1024 * 128; i += gs) {
      const int kc = (int)(i / 1024), n = (int)(i % 1024);
      float v[8];
#pragma unroll
      for (int j = 0; j < 8; ++j) v[j] = p.w_out[(size_t)(kc * 8 + j) * 1024 + n];
      u32x4 w; w.x = pk_bf16(v[0], v[1]); w.y = pk_bf16(v[2], v[3]); w.z = pk_bf16(v[4], v[5]); w.w = pk_bf16(v[6], v[7]);
      ((u32x4*)(p.ws + OFF_WOT))[(size_t)n * 128 + kc] = w;
    }
  }
  {
    float* rc = (float*)(p.ws + OFF_ROPE); float* rs = rc + 8192 * 8;
    for (size_t i = gt; i < 8192 * 8; i += gs) {
      const int t = (int)(i >> 3), f = (int)(i & 7);
      const float ang = (float)t * p.inv_freq[f];
      const double a = (double)ang;
      const double k = __builtin_rint(a * 0.15915494309189535);
      const float r = (float)(a - k * 6.283185307179586);
      rc[i] = cosf(r); rs[i] = sinf(r);
    }
  }
}

template <int I> DI void solve_rows2(f32x2_t (&xv)[64], const float* Lm, int lane, float lcur) {
  if constexpr (I < 64) {
    float lnx = 0.f;
    if constexpr (I + 1 < 64) lnx = Lm[(I + 1) * 68 + lane];
    f32x2_t a0 = xv[I], a1 = {0.f, 0.f}, a2 = {0.f, 0.f}, a3 = {0.f, 0.f};
#pragma unroll
    for (int m = 0; m < I; ++m) {
      const float l = __builtin_bit_cast(float, __builtin_amdgcn_readlane(__builtin_bit_cast(int, lcur), m));
      const f32x2_t lv = {l, l};
      if ((m & 3) == 0) a0 -= lv * xv[m];
      else if ((m & 3) == 1) a1 -= lv * xv[m];
      else if ((m & 3) == 2) a2 -= lv * xv[m];
      else a3 -= lv * xv[m];
    }
    xv[I] = (a0 + a1) + (a2 + a3);
    solve_rows2<I + 1>(xv, Lm, lane, lnx);
  }
}

DI void prep_item(const Params& p, int wvs, int item, unsigned char* smem) {
  const int tid_ = opaque_tid();
  const int tid = tid_, lane = tid & 63, wv = tid >> 6, r16 = lane & 15, g = lane >> 4;
  const int hd = item & 3, n = (item >> 2) & 127, b = item >> 9;
  const int t0 = b * SEQ + n * 64;
  u16* Qs = (u16*)smem; u16* Ks = Qs + 64 * 136; u16* Vs = Ks + 64 * 136;
  float* Lm = (float*)(smem + 52224);
  float* sm_beta = (float*)(smem + 69632);
  float* sm_gc = sm_beta + 64; float* sm_rq = sm_gc + 64; float* sm_rk = sm_rq + 64;
  float* sm_fw = sm_rk + 64; float* sm_fq = sm_fw + 64; float* sm_fk = sm_fq + 64;
  const u16* h = (const u16*)(p.ws + OFF_H);
  const float* hb = (const float*)(p.ws + OFF_HB);
  unsigned char* op = p.ws + OFF_SC + (size_t)item * OPB;
  __syncthreads();
  float hb_bl, hb_al;
  {
    const int c2 = tid & 63, rbase = (tid >> 6) * 16;
    unsigned raw[3][19];
#pragma unroll
    for (int mat = 0; mat < 3; ++mat) {
      const int col = mat * 512 + hd * 128 + 2 * c2;
#pragma unroll
      for (int j = 0; j < 19; ++j) {
        const int rr = t0 + rbase - 3 + j;
        raw[mat][j] = *(const unsigned*)(h + (size_t)(rr < 0 ? 0 : rr) * NC + col);
      }
    }
    float2 cw[3][4];
#pragma unroll
    for (int mat = 0; mat < 3; ++mat)
#pragma unroll
      for (int j = 0; j < 4; ++j) cw[mat][j] = *(const float2*)(p.conv_w + j * 1536 + mat * 512 + hd * 128 + 2 * c2);
    hb_bl = hb[(size_t)(t0 + lane) * 8 + hd]; hb_al = hb[(size_t)(t0 + lane) * 8 + 4 + hd];
    __builtin_amdgcn_sched_barrier(0);
#pragma unroll
    for (int mat = 0; mat < 3; ++mat) {
      float wa[4], wb[4];
#pragma unroll
      for (int j = 0; j < 4; ++j) { wa[j] = cw[mat][j].x; wb[j] = cw[mat][j].y; }
      float xa[3], xb[3];
#pragma unroll
      for (int j = 0; j < 3; ++j) {
        const int pos = n * 64 + rbase - 3 + j;
        const unsigned v = (pos >= 0) ? raw[mat][j] : 0u;
        xa[j] = bf_lo(v); xb[j] = bf_hi(v);
      }
      u16* dst = (mat == 0 ? Qs : (mat == 1 ? Ks : Vs));
#pragma unroll
      for (int i = 0; i < 16; ++i) {
        const unsigned v = raw[mat][3 + i];
        const float a3 = bf_lo(v), b3 = bf_hi(v);
        const float ya = wa[0] * xa[0] + wa[1] * xa[1] + wa[2] * xa[2] + wa[3] * a3;
        const float yb = wb[0] * xb[0] + wb[1] * xb[1] + wb[2] * xb[2] + wb[3] * b3;
        xa[0] = xa[1]; xa[1] = xa[2]; xa[2] = a3; xb[0] = xb[1]; xb[1] = xb[2]; xb[2] = b3;
        *(unsigned*)(dst + (rbase + i) * 136 + 2 * c2) = pk_bf16(silu_f(ya), silu_f(yb));
      }
    }
  }
  __syncthreads();
  if (wv == 0) {
    const float bl = hb_bl, al = hb_al;
    const float xx = al + p.dt_bias[hd];
    const float ee = __expf(-fabsf(xx));
    const float sp = fmaxf(xx, 0.f) + ((ee < 1e-3f) ? ee * (1.f - 0.5f * ee) : __logf(1.f + ee));
    float gg = -__expf(p.a_log[hd]) * sp;
#pragma unroll
    for (int o = 1; o < 64; o <<= 1) { const float t = __uint_as_float((unsigned)__builtin_amdgcn_ds_bpermute(((lane - o) & 63) << 2, (int)__float_as_uint(gg))); if (lane >= o) gg += t; }
    sm_beta[lane] = rcp_f(1.0f + __expf(-bl)); sm_gc[lane] = gg;
  } else if (wv <= 2) {
    const int r = tid - 64;
    const u16* src = (r < 64) ? (Qs + r * 136) : (Ks + (r - 64) * 136);
    float ss = 0.f;
#pragma unroll
    for (int c = 0; c < 16; ++c) {
      const u32x4 v = *(const u32x4*)(src + c * 8);
#pragma unroll
      for (int j = 0; j < 4; ++j) { const float a = bf_lo(v[j]), bb = bf_hi(v[j]); ss += a * a + bb * bb; }
    }
    const float rs = rsqrtf(ss + 1e-6f);
    if (r < 64) sm_rq[r] = rs; else sm_rk[r - 64] = rs;
  }
  __syncthreads();
  if (tid < 64) {
    const float gc = sm_gc[tid], gl = sm_gc[63], eg = __expf(gc);
    sm_fw[tid] = sm_beta[tid] * eg * sm_rk[tid];
    sm_fq[tid] = sm_rq[tid] * 0.08838834764831845f * eg;
    sm_fk[tid] = sm_rk[tid] * __expf(gl - gc);
    if (tid == 0) ((float*)(p.ws + OFF_DEC))[item] = __expf(gl);
  }
  {
    bf16x8 kfi[4], qfi[4];
#pragma unroll
    for (int s = 0; s < 4; ++s) {
      kfi[s] = *(const bf16x8*)(Ks + (16 * wv + r16) * 136 + 32 * s + 8 * g);
      qfi[s] = *(const bf16x8*)(Qs + (16 * wv + r16) * 136 + 32 * s + 8 * g);
    }
    f32x4 at[4];
#pragma unroll
    for (int jt = 0; jt < 4; ++jt) {
      at[jt] = (f32x4){0.f, 0.f, 0.f, 0.f};
      if (jt <= wv) {
        f32x4 la = (f32x4){0.f, 0.f, 0.f, 0.f}, aa = (f32x4){0.f, 0.f, 0.f, 0.f};
#pragma unroll
        for (int s = 0; s < 4; ++s) {
          const bf16x8 kfj = *(const bf16x8*)(Ks + (16 * jt + r16) * 136 + 32 * s + 8 * g);
          la = mfma16(kfi[s], kfj, la);
          aa = mfma16(kfj, qfi[s], aa);
        }
#pragma unroll
        for (int r = 0; r < 4; ++r) {
          { const int i = 16 * wv + 4 * g + r, j = 16 * jt + r16;
            const float v = (i > j) ? sm_beta[i] * sm_rk[i] * sm_rk[j] * __expf(sm_gc[i] - sm_gc[j]) * la[r] : 0.f;
            Lm[i * 68 + j] = v; }
          { const int j = 16 * jt + 4 * g + r, i = 16 * wv + r16;
            at[jt][r] = (j <= i) ? sm_rq[i] * sm_rk[j] * 0.08838834764831845f * __expf(sm_gc[i] - sm_gc[j]) * aa[r] : 0.f; }
        }
      }
    }
#pragma unroll
    for (int s2 = 0; s2 < 2; ++s2)
      *(bf16x8*)(op + 32768 + (size_t)((wv * 2 + s2) * 64 + lane) * 16) = pack8(at[2 * s2], at[2 * s2 + 1]);
  }
  __syncthreads();
  f32x2_t xv[64];
  if (wv < 2) {
#pragma unroll
    for (int i = 0; i < 64; ++i) { xv[i].x = sm_beta[i] * bf2f(Vs[i * 136 + tid]); xv[i].y = sm_fw[i] * bf2f(Ks[i * 136 + tid]); }
    solve_rows2<1>(xv, Lm, lane, Lm[68 + lane]);
    const int sl = tid >> 4, dvl = tid & 15;
#pragma unroll
    for (int mt = 0; mt < 4; ++mt)
#pragma unroll
      for (int gg = 0; gg < 4; ++gg) {
        u32x2 w; w.x = pk_bf16(xv[16 * mt + 4 * gg].x, xv[16 * mt + 4 * gg + 1].x); w.y = pk_bf16(xv[16 * mt + 4 * gg + 2].x, xv[16 * mt + 4 * gg + 3].x);
        *(u32x2*)(op + 57344 + (size_t)((sl * 4 + mt) * 64 + gg * 16 + dvl) * 8) = w;
      }
  } else {
    const int t2 = tid - 128;
#pragma unroll 2
    for (int f = 0; f < 8; ++f) {
      const int e = t2 + 128 * f, frag = e >> 6, ln = e & 63, lr = ln & 15, lg = ln >> 4;
      {
        const int mt = frag >> 2, sx = frag & 3, row = 16 * mt + lr;
        const u32x2 ql = *(const u32x2*)(Qs + row * 136 + 32 * sx + 4 * lg), qh = *(const u32x2*)(Qs + row * 136 + 32 * sx + 16 + 4 * lg);
        const float fq = sm_fq[row];
        u32x4 w;
        w.x = pk_bf16(bf_lo(ql.x) * fq, bf_hi(ql.x) * fq); w.y = pk_bf16(bf_lo(ql.y) * fq, bf_hi(ql.y) * fq);
        w.z = pk_bf16(bf_lo(qh.x) * fq, bf_hi(qh.x) * fq); w.w = pk_bf16(bf_lo(qh.y) * fq, bf_hi(qh.y) * fq);
        *(u32x4*)(op + 16384 + (size_t)e * 16) = w;
      }
      {
        const int mt8 = frag >> 1, s2 = frag & 1, dk = 16 * mt8 + lr;
        float v[8];
#pragma unroll
        for (int j = 0; j < 8; ++j) {
          const int pos = 32 * s2 + 16 * (j >> 2) + 4 * lg + (j & 3);
          v[j] = bf2f(Ks[pos * 136 + dk]) * sm_fk[pos];
        }
        u32x4 w; w.x = pk_bf16(v[0], v[1]); w.y = pk_bf16(v[2], v[3]); w.z = pk_bf16(v[4], v[5]); w.w = pk_bf16(v[6], v[7]);
        *(u32x4*)(op + 40960 + (size_t)e * 16) = w;
      }
    }
  }
  __syncthreads();
  if (wv < 2) {
#pragma unroll
    for (int i = 0; i < 64; ++i) Vs[i * 136 + tid] = f2bf(-xv[i].y);
  }
  __syncthreads();
#pragma unroll
  for (int f = 0; f < 4; ++f) {
    const int e = tid + 256 * f, frag = e >> 6, ln = e & 63, lr = ln & 15, lg = ln >> 4;
    const int mt = frag >> 2, sx = frag & 3, row = 16 * mt + lr;
    const u32x2 lo = *(const u32x2*)(Vs + row * 136 + 32 * sx + 4 * lg), hi = *(const u32x2*)(Vs + row * 136 + 32 * sx + 16 + 4 * lg);
    *(u32x4*)(op + (size_t)e * 16) = (u32x4){lo.x, lo.y, hi.x, hi.y};
  }
}

struct ScanA { u32x4 wf[4]; };
struct ScanB { u32x4 qf[4], af[2], kf[4]; };

DI void scan_load_a(const Params& p, int wvs, ScanA& o, int b, int hd, int sl, int n, int q, int lane) {
  const int item = (b * 128 + n) * 4 + hd;
  const unsigned char* op = p.ws + OFF_SC + (size_t)item * OPB;
#pragma unroll
  for (int s = 0; s < 4; ++s) {
    o.wf[s] = *(const u32x4*)(op + (size_t)((q * 4 + s) * 64 + lane) * 16);
  }
}
DI void scan_load_b(const Params& p, int wvs, ScanB& o, int b, int hd, int sl, int n, int q, int lane) {
  const int item = (b * 128 + n) * 4 + hd;

  const unsigned char* op = p.ws + OFF_SC + (size_t)item * OPB;
#pragma unroll
  for (int s = 0; s < 4; ++s) o.qf[s] = *(const u32x4*)(op + 16384 + (size_t)((q * 4 + s) * 64 + lane) * 16);
#pragma unroll
  for (int s2 = 0; s2 < 2; ++s2) o.af[s2] = *(const u32x4*)(op + 32768 + (size_t)((q * 2 + s2) * 64 + lane) * 16);
#pragma unroll
  for (int j = 0; j < 4; ++j) o.kf[j] = *(const u32x4*)(op + 40960 + (size_t)((q * 4 + j) * 64 + lane) * 16);
}

DI void scan_step(const Params& p, int wvs, const ScanA& o, const ScanB& ob, f32x4 (&S)[2], int b, int hd, int sl, int n, int q, int lane, unsigned char* smem) {
  const int r16 = lane & 15, g = lane >> 4;
  u32x4* ldsS = (u32x4*)smem;
  u32x2* ldsV = (u32x2*)(smem + 4096);
  ldsS[q * 64 + lane] = __builtin_bit_cast(u32x4, pack8(S[0], S[1]));
  __syncthreads();
  bf16x8 Sb[4];
#pragma unroll
  for (int s = 0; s < 4; ++s) Sb[s] = as_bf8(ldsS[s * 64 + lane]);
  const unsigned char* ring = smem + 8192 + (n % 3) * 6400;
  const u32x2 uf = *(const u32x2*)(ring + 4096 + (q * 64 + lane) * 8);
  f32x4 vn = (f32x4){bf_lo(uf.x), bf_hi(uf.x), bf_lo(uf.y), bf_hi(uf.y)};
#pragma unroll
  for (int s = 0; s < 4; ++s) vn = mfma16(as_bf8(o.wf[s]), Sb[s], vn);
  { u32x2 w; w.x = pk_bf16(vn[0], vn[1]); w.y = pk_bf16(vn[2], vn[3]); ldsV[((q >> 1) * 64 + lane) * 2 + (q & 1)] = w; }
  f32x4 oa = (f32x4){0.f, 0.f, 0.f, 0.f};
#pragma unroll
  for (int s = 0; s < 4; ++s) oa = mfma16(as_bf8(ob.qf[s]), Sb[s], oa);
  __syncthreads();
  bf16x8 Vb[2];
#pragma unroll
  for (int s2 = 0; s2 < 2; ++s2) Vb[s2] = as_bf8(*(const u32x4*)(ldsV + (s2 * 64 + lane) * 2));
#pragma unroll
  for (int s2 = 0; s2 < 2; ++s2) oa = mfma16(as_bf8(ob.af[s2]), Vb[s2], oa);
  u16* h = (u16*)(p.ws + OFF_H);
  const int t0 = b * SEQ + n * 64;
  *(f32x4*)(smem + 8192 + (n % 3) * 6400 + (q * 64 + lane) * 16) = oa;
  const float dec_ = *(const float*)(ring + 6144);
#pragma unroll
  for (int t = 0; t < 2; ++t) {
    S[t] = S[t] * dec_;
#pragma unroll
    for (int s2 = 0; s2 < 2; ++s2) S[t] = mfma16(as_bf8(ob.kf[t * 2 + s2]), Vb[s2], S[t]);
  }
}

DI void scan_chain(const Params& p, int wvs, int pair, int sl, unsigned char* smem) {
  const int tid0 = opaque_tid(); const int lane = tid0 & 63, q = tid0 >> 6;
  const int b = pair >> 2, hd = pair & 3;
  f32x4 S[2]; S[0] = (f32x4){0.f, 0.f, 0.f, 0.f}; S[1] = S[0];
  ScanA a0, a1, a2; ScanB b0, b1, b2;
  __builtin_amdgcn_s_setprio(3);
  __syncthreads();
  scan_load_a(p, wvs, a0, b, hd, sl, 0, q, lane); scan_load_b(p, wvs, b0, b, hd, sl, 0, q, lane);
  scan_load_a(p, wvs, a1, b, hd, sl, 1, q, lane); scan_load_b(p, wvs, b1, b, hd, sl, 1, q, lane);
#define SC_ITER(k_, AC, BC, AL, BL) do { \
    if (n + (k_) + 2 < 128) { scan_load_a(p, wvs, AL, b, hd, sl, n + (k_) + 2, q, lane); scan_load_b(p, wvs, BL, b, hd, sl, n + (k_) + 2, q, lane); } \
    if (n + (k_) < 128) scan_step(p, wvs, AC, BC, S, b, hd, sl, n + (k_), q, lane, smem); } while (0)
#pragma unroll 1
  for (int n = 0; n < 128; n += 3) { SC_ITER(0, a0, b0, a2, b2); SC_ITER(1, a1, b1, a0, b0); SC_ITER(2, a2, b2, a1, b1); }
#undef SC_ITER
  __syncthreads();
  __builtin_amdgcn_s_setprio(0);
}

DI void swa_item(const Params& p, int wvs, int item, bool valid, unsigned char* smem) {
  if (!valid) { __syncthreads(); __syncthreads(); return; }
  const int tid_ = opaque_tid();
  const int tid = tid_, lane = tid & 63, wv = tid >> 6, r16 = lane & 15, g = lane >> 4;
  const int qt = item & 127, kvh = (item >> 7) & 1, b = item >> 8;
  const int kp0 = 64 * qt - 128;
  u16* Ksm = (u16*)smem;
  u16* Vt = (u16*)(smem + 27648);
  u16* h = (u16*)(p.ws + OFF_H);
  const float* rc = (const float*)(p.ws + OFF_ROPE); const float* rs = rc + 8192 * 8;
  __syncthreads();
  if (tid < 192) {
    const int kk = tid, pos = kp0 + kk;
    u32x4 lo = (u32x4){0, 0, 0, 0}, hi = lo;
    if (pos >= 0) {
      const u16* src = h + (size_t)(b * SEQ + pos) * NC + C_SWK + kvh * 64;
      const u32x4 a = *(const u32x4*)src, c = *(const u32x4*)(src + 8);
      const f32x4 c0 = *(const f32x4*)(rc + pos * 8), c1 = *(const f32x4*)(rc + pos * 8 + 4);
      const f32x4 s0 = *(const f32x4*)(rs + pos * 8), s1 = *(const f32x4*)(rs + pos * 8 + 4);
      float t1[8], t2[8], cs[8], sn[8], o1[8], o2[8];
#pragma unroll
      for (int j = 0; j < 4; ++j) { t1[2 * j] = bf_lo(a[j]); t1[2 * j + 1] = bf_hi(a[j]); t2[2 * j] = bf_lo(c[j]); t2[2 * j + 1] = bf_hi(c[j]);
        cs[j] = c0[j]; cs[4 + j] = c1[j]; sn[j] = s0[j]; sn[4 + j] = s1[j]; }
#pragma unroll
      for (int j = 0; j < 8; ++j) { o1[j] = t1[j] * cs[j] - t2[j] * sn[j]; o2[j] = t2[j] * cs[j] + t1[j] * sn[j]; }
#pragma unroll
      for (int j = 0; j < 4; ++j) { lo[j] = pk_bf16(o1[2 * j], o1[2 * j + 1]); hi[j] = pk_bf16(o2[2 * j], o2[2 * j + 1]); }
    }
    *(u32x4*)(Ksm + kk * 72) = lo; *(u32x4*)(Ksm + kk * 72 + 8) = hi;
  }
  for (int e = tid; e < 192 * 6; e += 256) {
    const int kk = e / 6, ch = 2 + e % 6, pos = kp0 + kk;
    u32x4 v = (u32x4){0, 0, 0, 0};
    if (pos >= 0) v = *(const u32x4*)(h + (size_t)(b * SEQ + pos) * NC + C_SWK + kvh * 64 + ch * 8);
    *(u32x4*)(Ksm + kk * 72 + ch * 8) = v;
  }
  for (int e = tid; e < 192 * 8; e += 256) {
    const int kk = e >> 3, ch = e & 7, pos = kp0 + kk;
    u32x4 v = (u32x4){0, 0, 0, 0};
    if (pos >= 0) v = *(const u32x4*)(h + (size_t)(b * SEQ + pos) * NC + C_SWV + kvh * 64 + ch * 8);
#pragma unroll
    for (int j = 0; j < 4; ++j) { Vt[(ch * 8 + 2 * j) * 200 + kk] = (u16)(v[j] & 0xffffu); Vt[(ch * 8 + 2 * j + 1) * 200 + kk] = (u16)(v[j] >> 16); }
  }
  __syncthreads();
  const int st = wv, jt0 = st < 2 ? st : 2;
  const int qi = 16 * st + r16;
  const int qpos = 64 * qt + qi, tq = b * SEQ + qpos;
#pragma unroll 1
  for (int hq = 0; hq < 4; ++hq) {
    const int head = kvh * 4 + hq;
    u16* qsrc = h + (size_t)tq * NC + C_SWQ + head * 64;
    bf16x8 qf[2];
    {
      const u32x4 a = *(const u32x4*)qsrc, c = *(const u32x4*)(qsrc + 8);
      u32x4 w = *(const u32x4*)(qsrc + 8 * g);
      if (g < 2) {
        const f32x4 c0 = *(const f32x4*)(rc + qpos * 8), c1 = *(const f32x4*)(rc + qpos * 8 + 4);
        const f32x4 s0 = *(const f32x4*)(rs + qpos * 8), s1 = *(const f32x4*)(rs + qpos * 8 + 4);
        float t1[8], t2[8], cs[8], sn[8], o[8];
#pragma unroll
        for (int j = 0; j < 4; ++j) { t1[2 * j] = bf_lo(a[j]); t1[2 * j + 1] = bf_hi(a[j]); t2[2 * j] = bf_lo(c[j]); t2[2 * j + 1] = bf_hi(c[j]);
          cs[j] = c0[j]; cs[4 + j] = c1[j]; sn[j] = s0[j]; sn[4 + j] = s1[j]; }
#pragma unroll
        for (int j = 0; j < 8; ++j) o[j] = (g == 0) ? (t1[j] * cs[j] - t2[j] * sn[j]) : (t2[j] * cs[j] + t1[j] * sn[j]);
#pragma unroll
        for (int j = 0; j < 4; ++j) w[j] = pk_bf16(o[2 * j], o[2 * j + 1]);
      }
      qf[0] = as_bf8(w);
      qf[1] = as_bf8(*(const u32x4*)(qsrc + 32 + 8 * g));
    }
    f32x4 sc[10];
#pragma unroll
    for (int t = 0; t < 10; ++t) {
      sc[t] = (f32x4){0.f, 0.f, 0.f, 0.f};
#pragma unroll
      for (int s = 0; s < 2; ++s) {
        const bf16x8 kf = *(const bf16x8*)(Ksm + (16 * (jt0 + t) + r16) * 72 + 32 * s + 8 * g);
        sc[t] = mfma16(kf, qf[s], sc[t]);
      }
    }
    const float sink = p.sinks[head];
    float mx = sink;
#pragma unroll
    for (int t = 0; t < 10; ++t)
#pragma unroll
      for (int r = 0; r < 4; ++r) {
        const int kk = 16 * (jt0 + t) + 4 * g + r, d = kk - qi;
        const bool ok = (d >= 1) && (d <= 128) && (kp0 + kk >= 0);
        const float v = ok ? sc[t][r] * 0.125f : -1e30f;
        sc[t][r] = v; mx = fmaxf(mx, v);
      }
    mx = fmaxf(mx, shx(mx, 16, lane)); mx = fmaxf(mx, shx(mx, 32, lane));
    float sum = 0.f;
#pragma unroll
    for (int t = 0; t < 10; ++t)
#pragma unroll
      for (int r = 0; r < 4; ++r) { const float e = __expf(sc[t][r] - mx); sc[t][r] = e; sum += e; }
    sum += shx(sum, 16, lane); sum += shx(sum, 32, lane);
    const float inv = rcp_f(sum + __expf(sink - mx));
    f32x4 oacc[4];
#pragma unroll
    for (int dt = 0; dt < 4; ++dt) oacc[dt] = (f32x4){0.f, 0.f, 0.f, 0.f};
#pragma unroll
    for (int s2 = 0; s2 < 5; ++s2) {
      const bf16x8 pb = pack8(sc[2 * s2], sc[2 * s2 + 1]);
#pragma unroll
      for (int dt = 0; dt < 4; ++dt) {
        const u16* vr = Vt + (16 * dt + r16) * 200 + 16 * (jt0 + 2 * s2) + 4 * g;
        const u32x2 lo = *(const u32x2*)vr, hi = *(const u32x2*)(vr + 16);
        oacc[dt] = mfma16(as_bf8((u32x4){lo.x, lo.y, hi.x, hi.y}), pb, oacc[dt]);
      }
    }
#pragma unroll
    for (int dt = 0; dt < 4; ++dt) {
      const int dcol = head * 64 + 16 * dt + 4 * g;
      const u32x2 z = *(const u32x2*)(h + (size_t)tq * NC + C_SWZ + dcol);
      u32x2 w;
      w.x = pk_bf16(oacc[dt][0] * inv * silu_f(bf_lo(z.x)), oacc[dt][1] * inv * silu_f(bf_hi(z.x)));
      w.y = pk_bf16(oacc[dt][2] * inv * silu_f(bf_lo(z.y)), oacc[dt][3] * inv * silu_f(bf_hi(z.y)));
      *(u32x2*)(h + (size_t)tq * NC + C_SWQ + dcol) = w;
    }
  }
}

DI void phase_ya(const Params& p, int wvs) {
  u16* h = (u16*)(p.ws + OFF_H);
  const int ltid = opaque_tid(), lane = ltid & 63;
  const size_t gt = (size_t)blockIdx.x * 512 + ltid, gs = (size_t)gridDim.x * 512;
  const float* nwp = p.dn_norm_w + (ltid & 15) * 8;
  const f32x4 nw0 = *(const f32x4*)nwp, nw1 = *(const f32x4*)(nwp + 4);
  for (size_t i0 = gt; i0 < (size_t)T_TOK * 64; i0 += 4 * gs) {
    u32x4 v[4], z[4];
#pragma unroll
    for (int k = 0; k < 4; ++k) {
      const size_t i = i0 + k * gs;
      if (i < (size_t)T_TOK * 64) {
        const u16* ptr = h + (size_t)(i >> 6) * NC + (i & 63) * 8;
        v[k] = *(const u32x4*)ptr; z[k] = *(const u32x4*)(ptr + C_DNZ);
      } else { v[k] = (u32x4){0, 0, 0, 0}; z[k] = v[k]; }
    }
#pragma unroll
    for (int k = 0; k < 4; ++k) {
      const size_t i = i0 + k * gs;
      float o[8]; float ss = 0.f;
#pragma unroll
      for (int j = 0; j < 4; ++j) { o[2 * j] = bf_lo(v[k][j]); o[2 * j + 1] = bf_hi(v[k][j]); }
#pragma unroll
      for (int j = 0; j < 8; ++j) ss += o[j] * o[j];
      ss += shx(ss, 1, lane); ss += shx(ss, 2, lane); ss += shx(ss, 4, lane); ss += shx(ss, 8, lane);
      const float rs = rsqrtf(ss * (1.0f / 128.0f) + 1e-6f);
      float y[8];
#pragma unroll
      for (int j = 0; j < 4; ++j) {
        const float w0 = (j < 2) ? nw0[2 * j] : nw1[2 * j - 4], w1 = (j < 2) ? nw0[2 * j + 1] : nw1[2 * j - 3];
        y[2 * j] = o[2 * j] * rs * w0 * silu_f(bf_lo(z[k][j]));
        y[2 * j + 1] = o[2 * j + 1] * rs * w1 * silu_f(bf_hi(z[k][j]));
      }
      u32x4 w; w.x = pk_bf16(y[0], y[1]); w.y = pk_bf16(y[2], y[3]); w.z = pk_bf16(y[4], y[5]); w.w = pk_bf16(y[6], y[7]);
      if (i < (size_t)T_TOK * 64) *(u32x4*)(h + (size_t)(i >> 6) * NC + (i & 63) * 8) = w;
    }
  }
}

DI float wave_sum(float v, int lane) {
#pragma unroll
  for (int o = 32; o > 0; o >>= 1) v += shx(v, o, lane);
  return v;
}
DI void phase6(const Params& p, int wvs, unsigned char* smem) {
  const int tid = opaque_tid(), lane = tid & 63, wv = tid >> 6;
  f32x4 gm[4], bt[4];
#pragma unroll
  for (int j = 0; j < 4; ++j) { gm[j] = *(const f32x4*)(p.ln_g + 4 * (lane + 64 * j)); bt[j] = *(const f32x4*)(p.ln_b + 4 * (lane + 64 * j)); }
  const int xcd6 = blockIdx.x & 7, lb6 = blockIdx.x >> 3, nlb6 = gridDim.x >> 3;
  for (int lr = (lb6 * 8 + wv) * 2; lr < 4096; lr += nlb6 * 16) {
    const int row0 = 4096 * xcd6 + (4095 - lr), row1 = row0 - 1;
    float* r0 = p.out + (size_t)row0 * 1024;
    float* r1 = p.out + (size_t)row1 * 1024;
    const _Float16* s0 = (const _Float16*)(p.ws + OFF_H) + (size_t)row0 * 1024;
    const _Float16* s1 = (const _Float16*)(p.ws + OFF_H) + (size_t)row1 * 1024;
    f32x4 a[4], b[4];
#pragma unroll
    for (int j = 0; j < 4; ++j) {
      a[j] = __builtin_convertvector(*(const f16x4*)(s0 + 4 * (lane + 64 * j)), f32x4);
      b[j] = __builtin_convertvector(*(const f16x4*)(s1 + 4 * (lane + 64 * j)), f32x4);
    }
    float sa = 0.f, sb = 0.f;
#pragma unroll
    for (int j = 0; j < 4; ++j) { sa += (a[j][0] + a[j][1]) + (a[j][2] + a[j][3]); sb += (b[j][0] + b[j][1]) + (b[j][2] + b[j][3]); }
    const float ma = wave_sum(sa, lane) * (1.0f / 1024.0f), mb = wave_sum(sb, lane) * (1.0f / 1024.0f);
    float qa = 0.f, qb = 0.f;
#pragma unroll
    for (int j = 0; j < 4; ++j) {
      a[j] = a[j] - ma; b[j] = b[j] - mb;
      qa += (a[j][0] * a[j][0] + a[j][1] * a[j][1]) + (a[j][2] * a[j][2] + a[j][3] * a[j][3]);
      qb += (b[j][0] * b[j][0] + b[j][1] * b[j][1]) + (b[j][2] * b[j][2] + b[j][3] * b[j][3]);
    }
    const float ra = rsqrtf(wave_sum(qa, lane) * (1.0f / 1024.0f) + 1e-5f), rb = rsqrtf(wave_sum(qb, lane) * (1.0f / 1024.0f) + 1e-5f);
#pragma unroll
    for (int j = 0; j < 4; ++j) {
      *(f32x4*)(r0 + 4 * (lane + 64 * j)) = a[j] * ra * gm[j] + bt[j];
      *(f32x4*)(r1 + 4 * (lane + 64 * j)) = b[j] * rb * gm[j] + bt[j];
    }
  }
}

#define XB_TMO      128
#define XB_XCNT(j)  (256  + 64 * (j))
#define XB_XSUB(j)  (1280 + 64 * (j))
#define XB_XGEN(j)  (2304 + 64 * (j))
#define XB_TOP      3328
#define XB_TOPGEN   3392
#define XCD_BAR_WORDS 3456
#define XB_SPIN_CAP (1u << 22)
#define LAS __attribute__((address_space(3)))
DI unsigned xb_ld(unsigned* p) { return __hip_atomic_load(p, __ATOMIC_RELAXED, __HIP_MEMORY_SCOPE_AGENT); }
DI unsigned xb_add(unsigned* p, unsigned v) { return __hip_atomic_fetch_add(p, v, __ATOMIC_RELAXED, __HIP_MEMORY_SCOPE_AGENT); }
DI unsigned xb_xcc_id() { return (unsigned)__builtin_amdgcn_s_getreg((3 << 11) | 20) & 0xFu; }
#define XB_SPIN(cond, bar) do { unsigned _sp = 0; while (cond) { __builtin_amdgcn_s_sleep(1); \
    if ((++_sp & 255u) == 0u) { if (xb_ld(&(bar)[XB_TMO])) break; if (_sp > XB_SPIN_CAP) { atomicAdd(&(bar)[XB_TMO], 1u); break; } } } } while (0)
struct XcdBarrier { unsigned* bar; unsigned x; volatile LAS unsigned* st; };
DI bool xb_leader(int wvs) { return wvs == 0 && __builtin_amdgcn_mbcnt_hi(~0u, __builtin_amdgcn_mbcnt_lo(~0u, 0u)) == 0u; }
DI XcdBarrier xcd_barrier_post(unsigned* bar, volatile LAS unsigned* st, int wvs) {
  XcdBarrier b; b.bar = bar; b.x = xb_xcc_id(); b.st = st;
  if (xb_leader(wvs)) (void)xb_add(&bar[XB_XCNT(b.x)], 1u);
  return b;
}
DI void xcd_barrier_complete(unsigned* bar, unsigned x, unsigned& nloc, unsigned& nx) {
  const unsigned G = gridDim.x * gridDim.y * gridDim.z;
  unsigned sum, cnt, mine, sp = 0u;
  for (;;) {
    sum = 0u; cnt = 0u; mine = 0u;
#pragma unroll
    for (unsigned j = 0; j < 16; ++j) { const unsigned c = xb_ld(&bar[XB_XCNT(j)]); sum += c; cnt += (c > 0u) ? 1u : 0u; mine = (j == x) ? c : mine; }
    if (sum == G) break;
    __builtin_amdgcn_s_sleep(1);
    if ((++sp & 255u) == 0u) { if (xb_ld(&bar[XB_TMO])) break; if (sp > XB_SPIN_CAP) { atomicAdd(&bar[XB_TMO], 1u); break; } }
  }
  nloc = mine > 0u ? mine : 1u; nx = cnt > 0u ? cnt : 1u;
}
DI void xcd_barrier_(const XcdBarrier& b, int wvs) {
  asm volatile("s_waitcnt vmcnt(0)" ::: "memory");
  __syncthreads();
  if (xb_leader(wvs)) {
    unsigned* bar = b.bar;
    __builtin_amdgcn_s_waitcnt(0);
    unsigned nloc = b.st[0], nx = b.st[1];
    if (nloc == 0u) { xcd_barrier_complete(bar, b.x, nloc, nx); b.st[0] = nloc; b.st[1] = nx; }
    const unsigned old = xb_add(&bar[XB_XSUB(b.x)], 1u);
    const unsigned gen = old / nloc;
    if (old + 1u == (gen + 1u) * nloc) {
      __builtin_amdgcn_fence(__ATOMIC_RELEASE, "agent");
      asm volatile("s_waitcnt vmcnt(0)" ::: "memory");
      const unsigned og = xb_add(&bar[XB_TOP], 1u);
      const unsigned tg = og / nx;
      if (og + 1u == (tg + 1u) * nx) xb_add(&bar[XB_TOPGEN], 1u);
      else XB_SPIN(xb_ld(&bar[XB_TOPGEN]) == tg, bar);
      __builtin_amdgcn_fence(__ATOMIC_ACQUIRE, "agent");
      xb_add(&bar[XB_XGEN(b.x)], 1u);
      asm volatile("s_waitcnt vmcnt(0)" ::: "memory");
    } else {
      XB_SPIN(xb_ld(&bar[XB_XGEN(b.x)]) == gen, bar);
      __builtin_amdgcn_fence(__ATOMIC_ACQUIRE, "agent");
      asm volatile("s_waitcnt vmcnt(0)" ::: "memory");
    }
  }
  __syncthreads();
}

#define xcd_barrier(b) xcd_barrier_(b, w8)
namespace pg8 {
#define PG8_LAS __attribute__((address_space(3)))
typedef unsigned short bf16_t;
typedef short bf16x8 __attribute__((ext_vector_type(8)));
typedef float f32x4 __attribute__((ext_vector_type(4)));
typedef unsigned u32x4 __attribute__((ext_vector_type(4)));
constexpr int BM = 256, BK = 64, HALF = 128, HTB = HALF * BK * 2  , STAGE_BYTES = 8 * HTB, NXCD = 8, WGM = 8;

__host__ __device__ __forceinline__ int lds_byte(int r, int c) { const int st = (r >> 4) * 2 + (c >> 5), rr = r & 15, cc = c & 31, ob = rr * 64 + cc * 2; return st * 1024 + (ob ^ (((ob >> 9) & 1) << 5)); }
__host__ __device__ __forceinline__ void stage_rc(int b, int& R, int& C) { const int st = b / 1024, sb = b % 1024, swz = sb ^ (((sb >> 9) & 1) << 5); R = (st >> 1) * 16 + swz / 64; C = (st & 1) * 32 + (swz % 64) / 2; }
__host__ __device__ __forceinline__ int perm32(int rho) { const int n = rho >> 4, i = rho & 15; return 8 * (i >> 2) + 4 * n + (i & 3); }

struct Unit { int pm, pn; };
struct Gemm { const bf16_t* A; const bf16_t* Bt; int M, N, K; };

struct StaticOrder {
    int nM, nN, nwg, G, c;
    __host__ __device__ void init(int M, int N, int G_, int c_) { nM = M / BM; nN = N / BM; nwg = nM * nN; G = G_; c = c_; }
    __host__ __device__ bool next(int i, Unit& u) const {
        const long L = (long)i * G + c; if (L >= nwg) return false;
        int wgid = (int)L; { const int q = nwg / NXCD, r = nwg % NXCD, xcd = wgid % NXCD, off = wgid / NXCD; wgid = (xcd < r ? xcd * (q + 1) : r * (q + 1) + (xcd - r) * q) + off; }
        const int nig = WGM * nN, gid = wgid / nig, fm = gid * WGM, gsz = (nM - fm) < WGM ? (nM - fm) : WGM;
        u.pm = fm + ((wgid % nig) % gsz); u.pn = (wgid % nig) / gsz; return true;
    }
    __device__ __forceinline__ void a_ready(const Unit&) const {}
    __device__ __forceinline__ void done(const Unit&) const {}
};

template <class Epi, class Sched, bool ALIGN_EPI = false, bool SP2 = false>
__device__ __forceinline__ void gemm_phase(PG8_LAS unsigned char* lds, const Gemm g, const Sched& S, const Epi& E, const int tid) {
    const int wid = __builtin_amdgcn_readfirstlane(tid >> 6), lane = tid & 63, wr = wid >> 2, wc = wid & 3, fr = lane & 15, fq = lane >> 4;
    const int K = g.K, nt = K / BK;
    unsigned voffA[2], voffB[2];
#pragma unroll
    for (int i = 0; i < 2; ++i) { int R, C; stage_rc(tid * 16 + i * 8192, R, C); const int Rb = Epi::PERM ? ((R & ~31) + perm32(R & 31)) : R;
        voffA[i] = (unsigned)(R * K + C) * 2u; voffB[i] = (unsigned)(Rb * K + C) * 2u; }
    const size_t kstep = (size_t)(BK * 2);
    const size_t hstep = (size_t)HALF * K * 2;
    const size_t tstep = 2 * hstep;
    const unsigned ldsw = (unsigned)wid * 1024u;
    const int aoff = lds_byte(wr * 64 + fr, fq * 8), boff = lds_byte(wc * 32 + fr, fq * 8);
#define PG8_SA(b, h) (((b) * 2 + (h)) * HTB)
#define PG8_SB(b, h) ((4 + (b) * 2 + (h)) * HTB)
#define PG8_STAGE(bufoff, gbase, voff) do { _Pragma("unroll") for (int _i = 0; _i < 2; ++_i) \
        __builtin_amdgcn_global_load_lds((const unsigned*)((const char*)(gbase) + (voff)[_i]), (PG8_LAS unsigned*)(lds + (bufoff) + ldsw + _i * 8192), 16, 0, 0); } while (0)
#define PG8_LDA(dst, b, h) do { _Pragma("unroll") for (int m = 0; m < 4; ++m) _Pragma("unroll") for (int k = 0; k < 2; ++k) dst[m][k] = *(const PG8_LAS bf16x8*)(lds + PG8_SA(b, h) + aoff + m * 2048 + k * 1024); } while (0)
#define PG8_LDB(dst, b, h) do { _Pragma("unroll") for (int n = 0; n < 2; ++n) _Pragma("unroll") for (int k = 0; k < 2; ++k) dst[n][k] = *(const PG8_LAS bf16x8*)(lds + PG8_SB(b, h) + boff + n * 2048 + k * 1024); } while (0)
#define PG8_MMA(ai, bj, At, Bt) do { __builtin_amdgcn_s_setprio(1); _Pragma("unroll") for (int m = 0; m < 4; ++m) _Pragma("unroll") for (int n = 0; n < 2; ++n) _Pragma("unroll") for (int k = 0; k < 2; ++k) \
        acc[ai][bj][m][n] = __builtin_amdgcn_mfma_f32_16x16x32_bf16(Bt[n][k], At[m][k], acc[ai][bj][m][n], 0, 0, 0); __builtin_amdgcn_s_setprio(0); } while (0)
#define PG8_WAIT_V(n) asm volatile("s_waitcnt vmcnt(" #n ")" ::: "memory")
#define PG8_WAIT_L(n) asm volatile("s_waitcnt lgkmcnt(" #n ")" ::: "memory")
#define PG8_BAR __builtin_amdgcn_s_barrier()
#define PG8_SCHED __builtin_amdgcn_sched_barrier(0)
    Unit cur, nxt; int ui = 0;
    if (!S.next(0, cur)) return;
    f32x4 acc[2][2][4][2];
#pragma unroll
    for (int a = 0; a < 2; ++a)
#pragma unroll
        for (int b = 0; b < 2; ++b)
#pragma unroll
            for (int m = 0; m < 4; ++m)
#pragma unroll
                for (int n = 0; n < 2; ++n) acc[a][b][m][n] = (f32x4){0.f, 0.f, 0.f, 0.f};
    bf16x8 At[4][2], B0[2][2], B1[2][2];
    const char* cA = (const char*)g.A + (size_t)cur.pm * tstep; const char* cB = (const char*)g.Bt + (size_t)cur.pn * tstep;
    S.a_ready(cur);
    if constexpr (SP2) {
        PG8_STAGE(PG8_SB(0, 0), cB, voffB); PG8_STAGE(PG8_SB(0, 1), cB + hstep, voffB); PG8_STAGE(PG8_SA(0, 0), cA, voffA); PG8_STAGE(PG8_SA(0, 1), cA + hstep, voffA);
        if (wr == 1) PG8_BAR;
        PG8_WAIT_V(2); PG8_BAR;
        PG8_STAGE(PG8_SB(1, 0), cB + kstep, voffB); PG8_STAGE(PG8_SA(1, 0), cA + kstep, voffA); PG8_STAGE(PG8_SB(1, 1), cB + hstep + kstep, voffB);
        PG8_WAIT_V(6); PG8_BAR;
    } else {
        PG8_STAGE(PG8_SB(0, 0), cB, voffB); PG8_STAGE(PG8_SA(0, 0), cA, voffA); PG8_STAGE(PG8_SB(0, 1), cB + hstep, voffB); PG8_STAGE(PG8_SA(0, 1), cA + hstep, voffA);
        if (wr == 1) PG8_BAR;
        PG8_WAIT_V(4); PG8_BAR;
        PG8_STAGE(PG8_SB(1, 0), cB + kstep, voffB); PG8_STAGE(PG8_SA(1, 0), cA + kstep, voffA); PG8_STAGE(PG8_SB(1, 1), cB + hstep + kstep, voffB);
        PG8_WAIT_V(6); PG8_BAR;
    }
    for (;;) {
        const bool has_next = S.next(ui + 1, nxt);
        const char* nA = has_next ? (const char*)g.A + (size_t)nxt.pm * tstep : cA; const char* nB = has_next ? (const char*)g.Bt + (size_t)nxt.pn * tstep : cB;
        for (int t = 0; t < nt; t += 2) {
            const bool last = (t == nt - 2);
            const char* a1 = cA + (size_t)(t + 1) * kstep;
            const char* a2 = last ? nA : cA + (size_t)(t + 2) * kstep; const char* b2 = last ? nB : cB + (size_t)(t + 2) * kstep;
            const char* a3 = a2 + kstep; const char* b3 = b2 + kstep;
            if (last && has_next) S.a_ready(nxt);
            if constexpr (SP2) {
            PG8_LDB(B0, 0, 0); PG8_LDB(B1, 0, 1); PG8_SCHED; PG8_LDA(At, 0, 0); PG8_STAGE(PG8_SA(1, 1), a1 + hstep, voffA);
            PG8_WAIT_V(8); PG8_WAIT_L(0); PG8_BAR; PG8_MMA(0, 0, At, B0); PG8_MMA(0, 1, At, B1); PG8_BAR; PG8_SCHED;
            PG8_LDA(At, 0, 1); PG8_STAGE(PG8_SB(0, 0), b2, voffB); PG8_STAGE(PG8_SB(0, 1), b2 + hstep, voffB); PG8_STAGE(PG8_SA(0, 0), a2, voffA);
            PG8_WAIT_V(8); PG8_WAIT_L(0); PG8_BAR; PG8_MMA(1, 0, At, B0); PG8_MMA(1, 1, At, B1); PG8_BAR; PG8_SCHED;
            PG8_LDB(B0, 1, 0); PG8_LDB(B1, 1, 1); PG8_SCHED; PG8_LDA(At, 1, 0); PG8_STAGE(PG8_SA(0, 1), a2 + hstep, voffA);
            PG8_WAIT_V(8); PG8_WAIT_L(0); PG8_BAR; PG8_MMA(0, 0, At, B0); PG8_MMA(0, 1, At, B1); PG8_BAR; PG8_SCHED;
            PG8_LDA(At, 1, 1); PG8_STAGE(PG8_SB(1, 0), b3, voffB); PG8_STAGE(PG8_SB(1, 1), b3 + hstep, voffB); PG8_STAGE(PG8_SA(1, 0), a3, voffA);
            PG8_WAIT_V(8); PG8_WAIT_L(0); PG8_BAR; PG8_MMA(1, 0, At, B0); PG8_MMA(1, 1, At, B1); PG8_BAR; PG8_SCHED;
            } else {
            PG8_LDB(B0, 0, 0); PG8_SCHED; PG8_LDA(At, 0, 0); PG8_STAGE(PG8_SA(1, 1), a1 + hstep, voffA);
            PG8_WAIT_L(8); PG8_BAR; PG8_WAIT_L(0); PG8_MMA(0, 0, At, B0); PG8_BAR; PG8_SCHED;
            PG8_LDB(B1, 0, 1); PG8_STAGE(PG8_SB(0, 0), b2, voffB);
            PG8_BAR; PG8_WAIT_L(0); PG8_MMA(0, 1, At, B1); PG8_BAR;
            PG8_LDA(At, 0, 1); PG8_STAGE(PG8_SA(0, 0), a2, voffA);
            PG8_BAR; PG8_WAIT_L(0); PG8_MMA(1, 0, At, B0); PG8_BAR; PG8_SCHED;
            PG8_STAGE(PG8_SB(0, 1), b2 + hstep, voffB);
            PG8_WAIT_V(6); PG8_BAR; PG8_MMA(1, 1, At, B1); PG8_BAR;
            PG8_LDB(B0, 1, 0); PG8_SCHED; PG8_LDA(At, 1, 0); PG8_STAGE(PG8_SA(0, 1), a2 + hstep, voffA);
            PG8_WAIT_L(8); PG8_BAR; PG8_WAIT_L(0); PG8_MMA(0, 0, At, B0); PG8_BAR; PG8_SCHED;
            PG8_LDB(B1, 1, 1); PG8_STAGE(PG8_SB(1, 0), b3, voffB);
            PG8_BAR; PG8_WAIT_L(0); PG8_MMA(0, 1, At, B1); PG8_BAR;
            PG8_LDA(At, 1, 1); PG8_STAGE(PG8_SA(1, 0), a3, voffA);
            PG8_BAR; PG8_WAIT_L(0); PG8_MMA(1, 0, At, B0); PG8_BAR; PG8_SCHED;
            PG8_STAGE(PG8_SB(1, 1), b3 + hstep, voffB);
            PG8_WAIT_V(6); PG8_BAR; PG8_MMA(1, 1, At, B1); PG8_BAR;
            }
        }
        if constexpr (ALIGN_EPI) { if (wr == 0) PG8_BAR; }
        if constexpr (!Epi::AFTER_DRAIN) { E(acc, cur, wr, wc, fr, fq); S.done(cur); }
        if (!has_next) break;
#pragma unroll
        for (int a = 0; a < 2; ++a)
#pragma unroll
            for (int b = 0; b < 2; ++b)
#pragma unroll
                for (int m = 0; m < 4; ++m)
#pragma unroll
                    for (int n = 0; n < 2; ++n) acc[a][b][m][n] = (f32x4){0.f, 0.f, 0.f, 0.f};
        cur = nxt; cA = nA; cB = nB; ++ui;
        if constexpr (ALIGN_EPI) { if (wr == 1) PG8_BAR; }
    }
    PG8_WAIT_V(0);
    if constexpr (!ALIGN_EPI) { if (wr == 0) PG8_BAR; }
    PG8_BAR;
    if constexpr (Epi::AFTER_DRAIN) { E.fused(acc, cur, wr, wc, fr, fq, lds, wid, lane); S.done(cur); }
#undef PG8_SA
#undef PG8_SB
#undef PG8_STAGE
#undef PG8_LDA
#undef PG8_LDB
#undef PG8_MMA
#undef PG8_WAIT_V
#undef PG8_WAIT_L
#undef PG8_BAR
#undef PG8_SCHED
}

struct Unit2 { int pm, pn, part; };
struct Gemm2 { const bf16_t* A0; const bf16_t* A1; const bf16_t* B0; const bf16_t* B1; int lda, K; };
struct StaticOrder2 {
    int nM, nN, nwg, G, c;
    __host__ __device__ void init(int M, int N, int G_, int c_) { nM = M / BM; nN = N / BM; nwg = nM * nN; G = G_; c = c_; }
    __host__ __device__ bool next(int i, Unit2& u) const {
        const long L = (long)(i >> 1) * G + c; if (L >= nwg) return false;
        int wgid = (int)L; { const int q = nwg / NXCD, r = nwg % NXCD, xcd = wgid % NXCD, off = wgid / NXCD; wgid = (xcd < r ? xcd * (q + 1) : r * (q + 1) + (xcd - r) * q) + off; }
        const int nig = WGM * nN, gid = wgid / nig, fm = gid * WGM, gsz = (nM - fm) < WGM ? (nM - fm) : WGM;
        u.pm = fm + ((wgid % nig) % gsz); u.pn = (wgid % nig) / gsz; u.part = i & 1; return true;
    }
    __device__ __forceinline__ void a_ready(const Unit2&) const {}
    __device__ __forceinline__ void done(const Unit2&) const {}
    const float* ssq; PG8_LAS float* rs; int tid;
    __device__ __forceinline__ void prep_rows(const Unit2& u) const {
        const int row = tid >> 1, h0 = (tid & 1) * 2;
        const float* sp = ssq + (size_t)(h0 * 8) * 32768 + (u.pm * 256 + row);
        float sa = 0.f, sb = 0.f;
#pragma unroll
        for (int k = 0; k < 8; ++k) { sa += sp[(size_t)k * 32768]; sb += sp[(size_t)(8 + k) * 32768]; }
        rs[row * 4 + h0] = __builtin_amdgcn_rsqf(sa * (1.0f / 128.0f) + 1e-6f);
        rs[row * 4 + h0 + 1] = __builtin_amdgcn_rsqf(sb * (1.0f / 128.0f) + 1e-6f);
    }
};
template <class Epi, class Sched, bool ALIGN_EPI = false, bool SP2 = false>
__device__ __forceinline__ void gemm_phase2(PG8_LAS unsigned char* lds, const Gemm2 g, const Sched& S, const Epi& E, const int tid) {
    const int wid = __builtin_amdgcn_readfirstlane(tid >> 6), lane = tid & 63, wr = wid >> 2, wc = wid & 3, fr = lane & 15, fq = lane >> 4;
    const int K = g.K, nt = K / BK;
    unsigned voffA[2], voffB[2];
#pragma unroll
    for (int i = 0; i < 2; ++i) { int R, C; stage_rc(tid * 16 + i * 8192, R, C); const int Rb = Epi::PERM ? ((R & ~31) + perm32(R & 31)) : R;
        voffA[i] = (unsigned)(R * g.lda + C) * 2u; voffB[i] = (unsigned)(Rb * K + C) * 2u; }
    const size_t kstep = (size_t)(BK * 2);
    const size_t hstep = (size_t)HALF * K * 2;
    const size_t tstep = 2 * hstep;
    const size_t hstepA = (size_t)HALF * g.lda * 2, tstepA = 2 * hstepA;
    const unsigned ldsw = (unsigned)wid * 1024u;
    const int aoff = lds_byte(wr * 64 + fr, fq * 8), boff = lds_byte(wc * 32 + fr, fq * 8);
#define PG8_SA(b, h) (((b) * 2 + (h)) * HTB)
#define PG8_SB(b, h) ((4 + (b) * 2 + (h)) * HTB)
#define PG8_STAGE(bufoff, gbase, voff) do { _Pragma("unroll") for (int _i = 0; _i < 2; ++_i) \
        __builtin_amdgcn_global_load_lds((const unsigned*)((const char*)(gbase) + (voff)[_i]), (PG8_LAS unsigned*)(lds + (bufoff) + ldsw + _i * 8192), 16, 0, 0); } while (0)
#define PG8_LDA(dst, b, h) do { _Pragma("unroll") for (int m = 0; m < 4; ++m) _Pragma("unroll") for (int k = 0; k < 2; ++k) dst[m][k] = *(const PG8_LAS bf16x8*)(lds + PG8_SA(b, h) + aoff + m * 2048 + k * 1024); } while (0)
#define PG8_LDB(dst, b, h) do { _Pragma("unroll") for (int n = 0; n < 2; ++n) _Pragma("unroll") for (int k = 0; k < 2; ++k) dst[n][k] = *(const PG8_LAS bf16x8*)(lds + PG8_SB(b, h) + boff + n * 2048 + k * 1024); } while (0)
#define PG8_MMA(ai, bj, At, Bt) do { __builtin_amdgcn_s_setprio(1); _Pragma("unroll") for (int m = 0; m < 4; ++m) _Pragma("unroll") for (int n = 0; n < 2; ++n) _Pragma("unroll") for (int k = 0; k < 2; ++k) \
        acc[ai][bj][m][n] = __builtin_amdgcn_mfma_f32_16x16x32_bf16(Bt[n][k], At[m][k], acc[ai][bj][m][n], 0, 0, 0); __builtin_amdgcn_s_setprio(0); } while (0)
#define PG8_WAIT_V(n) asm volatile("s_waitcnt vmcnt(" #n ")" ::: "memory")
#define PG8_WAIT_L(n) asm volatile("s_waitcnt lgkmcnt(" #n ")" ::: "memory")
#define PG8_BAR __builtin_amdgcn_s_barrier()
#define PG8_SCHED __builtin_amdgcn_sched_barrier(0)
    Unit2 cur, nxt; int ui = 0;
    if (!S.next(0, cur)) return;
    f32x4 acc[2][2][4][2];
#pragma unroll
    for (int a = 0; a < 2; ++a)
#pragma unroll
        for (int b = 0; b < 2; ++b)
#pragma unroll
            for (int m = 0; m < 4; ++m)
#pragma unroll
                for (int n = 0; n < 2; ++n) acc[a][b][m][n] = (f32x4){0.f, 0.f, 0.f, 0.f};
    bf16x8 At[4][2], B0[2][2], B1[2][2];
    const char* cA = (const char*)(cur.part ? g.A1 : g.A0) + (size_t)cur.pm * tstepA; const char* cB = (const char*)(cur.part ? g.B1 : g.B0) + (size_t)cur.pn * tstep;
    S.a_ready(cur);
    S.prep_rows(cur);
    if constexpr (SP2) {
        PG8_STAGE(PG8_SB(0, 0), cB, voffB); PG8_STAGE(PG8_SB(0, 1), cB + hstep, voffB); PG8_STAGE(PG8_SA(0, 0), cA, voffA); PG8_STAGE(PG8_SA(0, 1), cA + hstepA, voffA);
        if (wr == 1) PG8_BAR;
        PG8_WAIT_V(2); PG8_BAR;
        PG8_STAGE(PG8_SB(1, 0), cB + kstep, voffB); PG8_STAGE(PG8_SA(1, 0), cA + kstep, voffA); PG8_STAGE(PG8_SB(1, 1), cB + hstep + kstep, voffB);
        PG8_WAIT_V(6); PG8_BAR;
    } else {
        PG8_STAGE(PG8_SB(0, 0), cB, voffB); PG8_STAGE(PG8_SA(0, 0), cA, voffA); PG8_STAGE(PG8_SB(0, 1), cB + hstep, voffB); PG8_STAGE(PG8_SA(0, 1), cA + hstepA, voffA);
        if (wr == 1) PG8_BAR;
        PG8_WAIT_V(4); PG8_BAR;
        PG8_STAGE(PG8_SB(1, 0), cB + kstep, voffB); PG8_STAGE(PG8_SA(1, 0), cA + kstep, voffA); PG8_STAGE(PG8_SB(1, 1), cB + hstep + kstep, voffB);
        PG8_WAIT_V(6); PG8_BAR;
    }
    for (;;) {
        const bool has_next = S.next(ui + 1, nxt);
        const char* nA = has_next ? (const char*)(nxt.part ? g.A1 : g.A0) + (size_t)nxt.pm * tstepA : cA; const char* nB = has_next ? (const char*)(nxt.part ? g.B1 : g.B0) + (size_t)nxt.pn * tstep : cB;
        for (int t = 0; t < nt; t += 2) {
            const bool last = (t == nt - 2);
            const char* a1 = cA + (size_t)(t + 1) * kstep;
            const char* a2 = last ? nA : cA + (size_t)(t + 2) * kstep; const char* b2 = last ? nB : cB + (size_t)(t + 2) * kstep;
            const char* a3 = a2 + kstep; const char* b3 = b2 + kstep;
            if (last && has_next) S.a_ready(nxt);
            if constexpr (SP2) {
            PG8_LDB(B0, 0, 0); PG8_LDB(B1, 0, 1); PG8_SCHED; PG8_LDA(At, 0, 0); PG8_STAGE(PG8_SA(1, 1), a1 + hstepA, voffA);
            PG8_WAIT_V(8); PG8_WAIT_L(0); PG8_BAR; PG8_MMA(0, 0, At, B0); PG8_MMA(0, 1, At, B1); PG8_BAR; PG8_SCHED;
            PG8_LDA(At, 0, 1); PG8_STAGE(PG8_SB(0, 0), b2, voffB); PG8_STAGE(PG8_SB(0, 1), b2 + hstep, voffB); PG8_STAGE(PG8_SA(0, 0), a2, voffA);
            PG8_WAIT_V(8); PG8_WAIT_L(0); PG8_BAR; PG8_MMA(1, 0, At, B0); PG8_MMA(1, 1, At, B1); PG8_BAR; PG8_SCHED;
            PG8_LDB(B0, 1, 0); PG8_LDB(B1, 1, 1); PG8_SCHED; PG8_LDA(At, 1, 0); PG8_STAGE(PG8_SA(0, 1), a2 + hstepA, voffA);
            PG8_WAIT_V(8); PG8_WAIT_L(0); PG8_BAR; PG8_MMA(0, 0, At, B0); PG8_MMA(0, 1, At, B1); PG8_BAR; PG8_SCHED;
            PG8_LDA(At, 1, 1); PG8_STAGE(PG8_SB(1, 0), b3, voffB); PG8_STAGE(PG8_SB(1, 1), b3 + hstep, voffB); PG8_STAGE(PG8_SA(1, 0), a3, voffA);
            PG8_WAIT_V(8); PG8_WAIT_L(0); PG8_BAR; PG8_MMA(1, 0, At, B0); PG8_MMA(1, 1, At, B1); PG8_BAR; PG8_SCHED;
            } else {
            PG8_LDB(B0, 0, 0); PG8_SCHED; PG8_LDA(At, 0, 0); PG8_STAGE(PG8_SA(1, 1), a1 + hstepA, voffA);
            PG8_WAIT_L(8); PG8_BAR; PG8_WAIT_L(0); PG8_MMA(0, 0, At, B0); PG8_BAR; PG8_SCHED;
            PG8_LDB(B1, 0, 1); PG8_STAGE(PG8_SB(0, 0), b2, voffB);
            PG8_BAR; PG8_WAIT_L(0); PG8_MMA(0, 1, At, B1); PG8_BAR;
            PG8_LDA(At, 0, 1); PG8_STAGE(PG8_SA(0, 0), a2, voffA);
            PG8_BAR; PG8_WAIT_L(0); PG8_MMA(1, 0, At, B0); PG8_BAR; PG8_SCHED;
            PG8_STAGE(PG8_SB(0, 1), b2 + hstep, voffB);
            PG8_WAIT_V(6); PG8_BAR; PG8_MMA(1, 1, At, B1); PG8_BAR;
            PG8_LDB(B0, 1, 0); PG8_SCHED; PG8_LDA(At, 1, 0); PG8_STAGE(PG8_SA(0, 1), a2 + hstepA, voffA);
            PG8_WAIT_L(8); PG8_BAR; PG8_WAIT_L(0); PG8_MMA(0, 0, At, B0); PG8_BAR; PG8_SCHED;
            PG8_LDB(B1, 1, 1); PG8_STAGE(PG8_SB(1, 0), b3, voffB);
            PG8_BAR; PG8_WAIT_L(0); PG8_MMA(0, 1, At, B1); PG8_BAR;
            PG8_LDA(At, 1, 1); PG8_STAGE(PG8_SA(1, 0), a3, voffA);
            PG8_BAR; PG8_WAIT_L(0); PG8_MMA(1, 0, At, B0); PG8_BAR; PG8_SCHED;
            PG8_STAGE(PG8_SB(1, 1), b3 + hstep, voffB);
            PG8_WAIT_V(6); PG8_BAR; PG8_MMA(1, 1, At, B1); PG8_BAR;
            }
            if (cur.part == 0 && !last) E.kscale(acc, t >> 1, wr, fr);
        }
        if constexpr (ALIGN_EPI) { if (wr == 0) PG8_BAR; }
        if (cur.part == 0) E.mid(acc, cur, wr, wc, fr, fq); else E(acc, cur, wr, wc, fr, fq);
        if (!has_next) break;
        if (cur.part == 1) S.prep_rows(nxt);
        if (cur.part == 1) {
#pragma unroll
        for (int a = 0; a < 2; ++a)
#pragma unroll
            for (int b = 0; b < 2; ++b)
#pragma unroll
                for (int m = 0; m < 4; ++m)
#pragma unroll
                    for (int n = 0; n < 2; ++n) acc[a][b][m][n] = (f32x4){0.f, 0.f, 0.f, 0.f};
        }
        cur = nxt; cA = nA; cB = nB; ++ui;
        if constexpr (ALIGN_EPI) { if (wr == 1) PG8_BAR; }
    }
    PG8_WAIT_V(0);
    if constexpr (!ALIGN_EPI) { if (wr == 0) PG8_BAR; }
    PG8_BAR;
#undef PG8_SA
#undef PG8_SB
#undef PG8_STAGE
#undef PG8_LDA
#undef PG8_LDB
#undef PG8_MMA
#undef PG8_WAIT_V
#undef PG8_WAIT_L
#undef PG8_BAR
#undef PG8_SCHED
}
}

struct EpiInProj {
  static constexpr bool PERM = true, AFTER_DRAIN = false;
  u16* h;
  DI void operator()(const f32x4 (&acc)[2][2][4][2], const pg8::Unit& u, int wr, int wc, int fr, int fq) const {
    const int shift = (u.pn >= 8) ? 8 : 0;
#pragma unroll
    for (int ai = 0; ai < 2; ++ai)
#pragma unroll
      for (int m = 0; m < 4; ++m) {
        const int row = u.pm * 256 + ai * 128 + wr * 64 + m * 16 + fr;
#pragma unroll
        for (int bj = 0; bj < 2; ++bj) {
          const int col = u.pn * 256 + bj * 128 + wc * 32 + 8 * fq + shift;
          const f32x4 a = acc[ai][bj][m][0], b = acc[ai][bj][m][1];
          u32x4 w; w.x = pk_bf16(a[0], a[1]); w.y = pk_bf16(a[2], a[3]); w.z = pk_bf16(b[0], b[1]); w.w = pk_bf16(b[2], b[3]);
          *(u32x4*)(h + (size_t)row * NC + col) = w;
        }
      }
  }
};

struct EpiMerge {
  static constexpr bool PERM = true, AFTER_DRAIN = false;
  const u16* h; u16* mg; PG8_LAS float* rs;
  DI void kscale(f32x4 (&acc)[2][2][4][2], int hh, int wr, int fr) const {
#pragma unroll
    for (int ai = 0; ai < 2; ++ai)
#pragma unroll
      for (int m = 0; m < 4; ++m) {
        const int rl = ai * 128 + wr * 64 + m * 16 + fr;
        const float f = rs[rl * 4 + hh] * rcp_f(rs[rl * 4 + hh + 1]);
#pragma unroll
        for (int bj = 0; bj < 2; ++bj) { acc[ai][bj][m][0] *= f; acc[ai][bj][m][1] *= f; }
      }
  }
  DI void mid(f32x4 (&acc)[2][2][4][2], const pg8::Unit2& u, int wr, int wc, int fr, int fq) const {
#pragma unroll
    for (int ai = 0; ai < 2; ++ai) {
      u32x4 ga[4][2], gb[4][2];
#pragma unroll
      for (int m = 0; m < 4; ++m)
#pragma unroll
        for (int bj = 0; bj < 2; ++bj) {
          const size_t off = (size_t)(u.pm * 256 + ai * 128 + wr * 64 + m * 16 + fr) * NC + (u.pn * 256 + bj * 128 + wc * 32 + 8 * fq);
          ga[m][bj] = *(const u32x4*)(h + off + C_GA); gb[m][bj] = *(const u32x4*)(h + off + C_GB);
        }
      __builtin_amdgcn_sched_barrier(0);
#pragma unroll
      for (int m = 0; m < 4; ++m)
#pragma unroll
        for (int bj = 0; bj < 2; ++bj)
#pragma unroll
          for (int j = 0; j < 4; ++j) {
            const float r3 = rs[(ai * 128 + wr * 64 + m * 16 + fr) * 4 + 3];
            const float r0 = r3 * (1.f + __expf(-bf_lo(gb[m][bj][j]))) * rcp_f(1.f + __expf(-bf_lo(ga[m][bj][j])));
            const float r1 = r3 * (1.f + __expf(-bf_hi(gb[m][bj][j]))) * rcp_f(1.f + __expf(-bf_hi(ga[m][bj][j])));
            acc[ai][bj][m][j >> 1][2 * (j & 1)] *= r0; acc[ai][bj][m][j >> 1][2 * (j & 1) + 1] *= r1;
          }
      __builtin_amdgcn_sched_barrier(0);
    }
  }
  DI void operator()(const f32x4 (&acc)[2][2][4][2], const pg8::Unit2& u, int wr, int wc, int fr, int fq) const {
#pragma unroll
    for (int ai = 0; ai < 2; ++ai) {
      u32x4 gb[4][2];
#pragma unroll
      for (int m = 0; m < 4; ++m)
#pragma unroll
        for (int bj = 0; bj < 2; ++bj)
          gb[m][bj] = *(const u32x4*)(h + (size_t)(u.pm * 256 + ai * 128 + wr * 64 + m * 16 + fr) * NC + C_GB + (u.pn * 256 + bj * 128 + wc * 32 + 8 * fq));
      __builtin_amdgcn_sched_barrier(0);
#pragma unroll
      for (int m = 0; m < 4; ++m)
#pragma unroll
        for (int bj = 0; bj < 2; ++bj) {
          const int row = u.pm * 256 + ai * 128 + wr * 64 + m * 16 + fr, col = u.pn * 256 + bj * 128 + wc * 32 + 8 * fq;
          const f32x4 a = acc[ai][bj][m][0], b = acc[ai][bj][m][1];
          const u32x4 g = gb[m][bj];
          u32x4 w;
          w.x = pk_bf16(a[0] * sigmoid_f(bf_lo(g[0])), a[1] * sigmoid_f(bf_hi(g[0])));
          w.y = pk_bf16(a[2] * sigmoid_f(bf_lo(g[1])), a[3] * sigmoid_f(bf_hi(g[1])));
          w.z = pk_bf16(b[0] * sigmoid_f(bf_lo(g[2])), b[1] * sigmoid_f(bf_hi(g[2])));
          w.w = pk_bf16(b[2] * sigmoid_f(bf_lo(g[3])), b[3] * sigmoid_f(bf_hi(g[3])));
          *(u32x4*)(mg + (size_t)row * 1024 + col) = w;
        }
      __builtin_amdgcn_sched_barrier(0);
    }
  }
};

struct EpiOut {
  static constexpr bool PERM = true, AFTER_DRAIN = false;
  const float* x; _Float16* r16;
  DI void operator()(const f32x4 (&acc)[2][2][4][2], const pg8::Unit& u, int wr, int wc, int fr, int fq) const {
#pragma unroll
    for (int ai = 0; ai < 2; ++ai) {
      f32x4 xv[4][2][2];
#pragma unroll
      for (int m = 0; m < 4; ++m)
#pragma unroll
        for (int bj = 0; bj < 2; ++bj) {
          const float* xp = x + (size_t)(u.pm * 256 + ai * 128 + wr * 64 + m * 16 + fr) * 1024 + (u.pn * 256 + bj * 128 + wc * 32 + 8 * fq);
          xv[m][bj][0] = *(const f32x4*)xp; xv[m][bj][1] = *(const f32x4*)(xp + 4);
        }
      __builtin_amdgcn_sched_barrier(0);
#pragma unroll
      for (int m = 0; m < 4; ++m)
#pragma unroll
        for (int bj = 0; bj < 2; ++bj) {
          const int row = u.pm * 256 + ai * 128 + wr * 64 + m * 16 + fr, col = u.pn * 256 + bj * 128 + wc * 32 + 8 * fq;
          const f32x4 v0 = xv[m][bj][0] * 1.189207115002721f + acc[ai][bj][m][0], v1 = xv[m][bj][1] * 1.189207115002721f + acc[ai][bj][m][1];
          const f16x4 h0 = __builtin_convertvector(v0, f16x4), h1 = __builtin_convertvector(v1, f16x4);
          u32x4 w; const u32x2 p0 = __builtin_bit_cast(u32x2, h0), p1 = __builtin_bit_cast(u32x2, h1);
          w.x = p0.x; w.y = p0.y; w.z = p1.x; w.w = p1.y;
          *(u32x4*)(r16 + (size_t)row * 1024 + col) = w;
        }
      __builtin_amdgcn_sched_barrier(0);
    }
  }
};

__global__ void __launch_bounds__(512, 2) fwd_megakernel(Params p) {
  cg::grid_group grid = cg::this_grid();
  __shared__ __attribute__((aligned(16))) unsigned char smem[SMEM_BYTES];
  const int w8 = __builtin_amdgcn_readfirstlane((int)(threadIdx.x >> 6));
  const int wvs = w8 & 3, half = w8 >> 2;
  unsigned char* hsm = smem + half * HALF_SMEM;
  const int vb = blockIdx.x + half * gridDim.x, nvb = 2 * gridDim.x;
  volatile LAS unsigned* st = (volatile LAS unsigned*)(smem + SMEM_BYTES - 16);
  { const int t0_ = opaque_tid(); if (t0_ < 4) st[t0_] = 0u; }
  __syncthreads();
  const XcdBarrier xb = xcd_barrier_post((unsigned*)(p.ws + OFF_BAR), st, w8);
  phase0(p, w8);
  if (p.ws == nullptr) grid.sync();
  xcd_barrier(xb);
  {
    pg8::Gemm g; g.A = (const pg8::bf16_t*)(p.ws + OFF_SC); g.Bt = (const pg8::bf16_t*)(p.ws + OFF_WINT); g.M = T_TOK; g.N = NCP; g.K = 1024;
    pg8::StaticOrder so; so.init(T_TOK, NCP, (int)gridDim.x, (int)blockIdx.x);
    EpiInProj e; e.h = (u16*)(p.ws + OFF_H);
    pg8::gemm_phase<EpiInProj, pg8::StaticOrder, true, true>((PG8_LAS unsigned char*)smem, g, so, e, opaque_tid_(w8));
  }
  xcd_barrier(xb);
  for (int it = vb; it < 2048; it += nvb) prep_item(p, wvs, it, hsm);
  xcd_barrier(xb);
  if (blockIdx.x < 128) {
    if (half == 0) { const int cb = (int)blockIdx.x; scan_chain(p, wvs, (cb & 7) + 8 * ((cb >> 3) >> 3), (cb >> 3) & 7, hsm); }
    else {
      const int cb = (int)blockIdx.x, pr = (cb & 7) + 8 * ((cb >> 3) >> 3), slp = (cb >> 3) & 7, bp = pr >> 2, hp = pr & 3;
      const int ft = opaque_tid();
      const unsigned char* pbase = p.ws + OFF_SC + (size_t)(slp * 72 + (ft < 72 ? ft : 0)) * 128;
      const int dR = ft >> 2, dc0 = (ft & 3) * 4;
      const u16* zbase = (const u16*)(p.ws + OFF_H) + (size_t)(bp * SEQ + dR) * NC + C_DNZ + hp * 128 + 16 * slp + dc0;
      const f32x4 nw4 = *(const f32x4*)(p.dn_norm_w + 16 * slp + dc0);
      unsigned char* ringp = smem + 8192;
      const unsigned char* ubase = p.ws + OFF_SC + 57344 + slp * 2048 + ft * 8;
      const float* dbase = (const float*)(p.ws + OFF_DEC);
      const int doff = ((dR >> 4) * 64 + ((dR >> 2) & 3) * 16 + dc0) * 16 + (dR & 3) * 4;
#define Z_LOAD(dst, step_) do { const int st_ = (step_) < 0 ? 0 : ((step_) < 128 ? (step_) : 127); dst = *(const u32x2*)(zbase + (size_t)st_ * 64 * NC); } while (0)
#define U_LOAD(du, dd, step_) do { const int it_ = (bp * 128 + ((step_) < 128 ? (step_) : 127)) * 4 + hp; du = *(const u32x2*)(ubase + (size_t)it_ * OPB); dd = dbase[it_]; } while (0)
#define U_STORE(su, sd, step_) do { *(u32x2*)(ringp + ((step_) % 3) * 6400 + 4096 + ft * 8) = su; if (ft == 0) *(float*)(ringp + ((step_) % 3) * 6400 + 6144) = sd; } while (0)
#define O_DRAIN(zsrc, step_) do { const unsigned char* os_ = ringp + ((step_) % 3) * 6400 + doff; \
        const float o0_ = *(const float*)os_, o1_ = *(const float*)(os_ + 16), o2_ = *(const float*)(os_ + 32), o3_ = *(const float*)(os_ + 48); \
        const size_t row_ = (size_t)(bp * SEQ + (step_) * 64 + dR); \
        u32x2 w_; w_.x = pk_bf16(o0_ * nw4[0] * silu_f(bf_lo(zsrc.x)), o1_ * nw4[1] * silu_f(bf_hi(zsrc.x))); \
        w_.y = pk_bf16(o2_ * nw4[2] * silu_f(bf_lo(zsrc.y)), o3_ * nw4[3] * silu_f(bf_hi(zsrc.y))); \
        *(u32x2*)(hout + row_ * NC + hp * 128 + 16 * slp + dc0) = w_; \
        float sq_ = (o0_ * o0_ + o1_ * o1_) + (o2_ * o2_ + o3_ * o3_); \
        sq_ += dpp_mov<0xB1>(sq_); sq_ += dpp_mov<0x4E>(sq_); \
        if ((ft & 3) == 0) ssqp[(size_t)(hp * 8 + slp) * T_TOK + row_] = sq_; } while (0)
      u16* hout = (u16*)(p.ws + OFF_H);
      float* ssqp = (float*)(p.ws + OFF_SSQ);
      u32x2 zr0, zr1, zr2 = {0u, 0u}, zr3 = {0u, 0u};
      u32x2 ur0, ur1, ur2, ur3; float dr0, dr1, dr2, dr3;
      unsigned pr0 = 0, pr1 = 0, pr2 = 0, pr3 = 0, accp = 0;
      Z_LOAD(zr0, 0); Z_LOAD(zr1, 1);
      U_LOAD(ur0, dr0, 0); U_LOAD(ur1, dr1, 1); U_LOAD(ur2, dr2, 2); U_LOAD(ur3, dr3, 3);
      U_STORE(ur0, dr0, 0);
      __syncthreads();
#define P_ITER(m_, K0, K1, K2) do { \
        U_STORE(ur##K1, dr##K1, (m_) + 1); U_LOAD(ur##K0, dr##K0, (m_) + 4); \
        if ((m_) >= 2) O_DRAIN(zr##K2, (m_) - 2); \
        Z_LOAD(zr##K2, (m_) + 2); \
        accp ^= pr##K0; { const int np_ = (m_) + 6 < 128 ? (m_) + 6 : 127; pr##K0 = *(const unsigned*)(pbase + (size_t)((bp * 128 + np_) * 4 + hp) * OPB); } \
        __syncthreads(); __syncthreads(); } while (0)
#pragma unroll 1
      for (int mm = 0; mm < 128; mm += 4) { P_ITER(mm, 0, 1, 2); P_ITER(mm + 1, 1, 2, 3); P_ITER(mm + 2, 2, 3, 0); P_ITER(mm + 3, 3, 0, 1); }
#undef P_ITER
      __syncthreads();
      O_DRAIN(zr2, 126); O_DRAIN(zr3, 127);
      accp ^= pr0 ^ pr1 ^ pr2 ^ pr3;
#undef Z_LOAD
#undef U_LOAD
#undef U_STORE
#undef O_DRAIN
      if (accp == 0x9e3779b9u && ft == 300) ((unsigned*)(p.ws + OFF_BAR))[XB_TMO + 1] = accp;
    }
  } else {
    const int nsw = 2 * ((int)gridDim.x - 128), vbl = ((int)blockIdx.x - 128) + half * ((int)gridDim.x - 128);
    for (int k = 0; k * nsw < 1024; ++k) { const int it = vbl + k * nsw; swa_item(p, wvs, it < 1024 ? it : 0, it < 1024, hsm); }
  }
  xcd_barrier(xb);
  {
    pg8::Gemm2 g; g.A0 = (const pg8::bf16_t*)(p.ws + OFF_H); g.A1 = g.A0 + C_SWQ; g.B0 = (const pg8::bf16_t*)(p.ws + OFF_WAT); g.B1 = (const pg8::bf16_t*)(p.ws + OFF_WBT);
    g.lda = NC; g.K = 512;
    pg8::StaticOrder2 so; so.init(T_TOK, 1024, (int)gridDim.x, (int)blockIdx.x);
    so.ssq = (const float*)(p.ws + OFF_SSQ); so.rs = (PG8_LAS float*)(smem + 131072); so.tid = opaque_tid_(w8);
    EpiMerge e; e.h = (const u16*)(p.ws + OFF_H); e.mg = (u16*)(p.ws + OFF_SC); e.rs = (PG8_LAS float*)(smem + 131072);
    pg8::gemm_phase2<EpiMerge, pg8::StaticOrder2, true, true>((PG8_LAS unsigned char*)smem, g, so, e, opaque_tid_(w8));
  }
  xcd_barrier(xb);
  {
    pg8::Gemm g; g.A = (const pg8::bf16_t*)(p.ws + OFF_SC); g.Bt = (const pg8::bf16_t*)(p.ws + OFF_WOT); g.M = T_TOK; g.N = 1024; g.K = 1024;
    pg8::StaticOrder so; so.init(T_TOK, 1024, (int)gridDim.x, (int)blockIdx.x);
    EpiOut e; e.x = p.x; e.r16 = (_Float16*)(p.ws + OFF_H);
    pg8::gemm_phase<EpiOut, pg8::StaticOrder, true, true>((PG8_LAS unsigned char*)smem, g, so, e, opaque_tid_(w8));
  }
  xcd_barrier(xb);
  phase6(p, w8, smem);
}

extern "C" void kernel_launch(void* const* d_in, const int* in_sizes, int n_in, void* d_out, int out_size,
                              void* d_ws, size_t ws_size, hipStream_t stream) {
  if (ws_size < WS_NEED) { fprintf(stderr, "workspace too small: %zu < %zu\n", ws_size, (size_t)WS_NEED); return; }
  Params p{};
  p.x = (const float*)d_in[0]; p.w_in = (const float*)d_in[1]; p.conv_w = (const float*)d_in[2]; p.a_log = (const float*)d_in[3];
  p.dt_bias = (const float*)d_in[4]; p.dn_norm_w = (const float*)d_in[5]; p.sinks = (const float*)d_in[6];
  p.w_branch = (const float*)d_in[7]; p.w_out = (const float*)d_in[8]; p.ln_g = (const float*)d_in[9]; p.ln_b = (const float*)d_in[10];
  p.out = (float*)d_out; p.ws = (unsigned char*)d_ws;
  for (int i = 0; i < 8; ++i) p.inv_freq[i] = (float)std::pow(500000.0, -(double)i / 8.0);
  static int grid_blocks = 0;
  if (!grid_blocks) {
    int dev = 0, cus = 0, per_cu = 0;
    (void)hipGetDevice(&dev);
    (void)hipDeviceGetAttribute(&cus, hipDeviceAttributeMultiprocessorCount, dev);
    (void)hipOccupancyMaxActiveBlocksPerMultiprocessor(&per_cu, fwd_megakernel, 512, 0);
    if (per_cu < 1) fprintf(stderr, "occupancy query reports %d workgroups per CU\n", per_cu);
    grid_blocks = cus > 256 ? 256 : cus;
    grid_blocks &= ~7;
  }
  (void)hipMemsetAsync(p.ws + OFF_BAR, 0, BAR_BYTES, stream);
  void* args[] = {&p};
  hipError_t e = hipLaunchCooperativeKernel((void*)fwd_megakernel, dim3(grid_blocks), dim3(512), args, 0, stream);
  if (e != hipSuccess) fprintf(stderr, "cooperative launch failed: %s (grid %d)\n", hipGetErrorString(e), grid_blocks);
}
```
